# Optimizing an MI355X kernel written in HIP

```python
import math
import jax, jax.numpy as jnp
from jax import lax
import numpy as np

D_MODEL = 2048
BATCH = 4
SEQ = 2048
DEPTH = 2
DEC_BATCH = 8
DEC_SEQ = 4
PAST_LEN = 16384
PAGE_SIZE = 128

HEAD_DIM = 64
D_MIX = D_MODEL
D_RWKV = D_MIX // 2
D_NSA = D_MIX - D_RWKV
H_RWKV = D_RWKV // HEAD_DIM
H_NSA = D_NSA // HEAD_DIM
NSA_KV_HEADS = 4
NSA_GROUP = H_NSA // NSA_KV_HEADS
NSA_KV_COLS = NSA_KV_HEADS * HEAD_DIM
CMP_BLOCK = 32
SEL_BLOCK = 64
SEL_TOPN = 16
WINDOW = 512
Q_BLOCK = 128
W_LORA = 64
A_LORA = 64
G_LORA = 160
RWKV_COLS = 3 * D_RWKV + W_LORA + A_LORA + G_LORA
NSA_COLS = D_NSA + 6 * NSA_KV_COLS + 3 * H_NSA
IN_COLS = RWKV_COLS + NSA_COLS
P_HEADS = 8
N_KEYS = 128
N_EXPERTS = N_KEYS * N_KEYS
P_DKEY = 256
P_TOPK = 16
P_TOK_BLOCK = 128
LN_EPS = 1e-5
GN_EPS = 64e-5
DEEPNORM_ALPHA = (2 * DEPTH) ** 0.25
DEEPNORM_BETA = (8 * DEPTH) ** -0.25
FORCE_SCORE = 1e4
NEG_INF = -1e30

kernel_name = 'hymba_rwkv7_nsa_peer_decode_step'


def layer_norm(x, g, b):
    xf = x.astype(jnp.float32)
    mu = xf.mean(-1, keepdims=True)
    var = jnp.mean(jnp.square(xf - mu), -1, keepdims=True)
    return ((xf - mu) * lax.rsqrt(var + LN_EPS) * g + b).astype(x.dtype)


def masked_softmax(s, mask):
    s = jnp.where(mask, s.astype(jnp.float32), NEG_INF)
    p = jax.nn.softmax(s, axis=-1)
    return jnp.where(mask, p, 0.0)


def rwkv_time_mix(xr, shift_prev, s0, p):
    B, T, _ = xr.shape
    dt = xr.dtype
    prev = jnp.concatenate([shift_prev.astype(dt), xr[:, :-1]], axis=1)
    xs = xr + p['rwkv_mu'] * (prev - xr)
    cuts = [D_RWKV, 2 * D_RWKV, 3 * D_RWKV, 3 * D_RWKV + W_LORA, 3 * D_RWKV + W_LORA + A_LORA]
    r, k, v, wl, al, gl = jnp.split(xs, cuts, axis=-1)
    w = -jax.nn.softplus(-(p['rwkv_w0'] + jnp.tanh(wl) @ p['rwkv_w2'])) - 0.5
    decay = jnp.exp(-jnp.exp(w))
    a = jax.nn.sigmoid(p['rwkv_a0'] + al @ p['rwkv_a2'])
    g = jax.nn.sigmoid(gl) @ p['rwkv_g2']
    hd = lambda t: t.reshape(B, T, H_RWKV, HEAD_DIM)
    kkf = hd(k * p['rwkv_k_k']).astype(jnp.float32)
    kk = (kkf * lax.rsqrt(jnp.maximum(jnp.sum(kkf * kkf, -1, keepdims=True), 1e-24))).astype(dt)
    k = k * (1.0 + (a - 1.0) * p['rwkv_k_a'])
    r, decay, k, v, a = hd(r), hd(decay), hd(k), hd(v), hd(a)

    def step(S, inp):
        r_t, d_t, k_t, v_t, kk_t, a_t = inp
        sk = jnp.einsum('bhvk,bhk->bhv', S, kk_t)
        S = (S * d_t[:, :, None, :] - sk[..., None] * (kk_t * a_t)[:, :, None, :]
             + v_t[..., None] * k_t[:, :, None, :])
        return S, jnp.einsum('bhvk,bhk->bhv', S, r_t)

    seq_first = lambda t: jnp.moveaxis(t, 1, 0)
    s_T, y = lax.scan(step, s0.astype(dt), (seq_first(r), seq_first(decay), seq_first(k),
                                            seq_first(v), seq_first(kk), seq_first(a)))
    y = jnp.moveaxis(y, 0, 1).astype(jnp.float32)
    mu = y.mean(-1, keepdims=True)
    var = jnp.mean(jnp.square(y - mu), -1, keepdims=True)
    yn = ((y - mu) * lax.rsqrt(var + GN_EPS)).reshape(B, T, D_RWKV) * p['rwkv_gn_g'] + p['rwkv_gn_b']
    bonus = jnp.sum(r * k * p['rwkv_r_k'], -1, keepdims=True) * v
    out = (yn.astype(dt) + bonus.reshape(B, T, D_RWKV)) * g
    return out, s_T, xr[:, -1:]


def nsa_mix(xn, past_cmp, past_sel, win_prefix, pos0, n_keep, cmp_w):
    B, T, _ = xn.shape
    dt = xn.dtype
    cuts = [D_NSA + i * NSA_KV_COLS for i in range(7)]
    q, kc, vc, ksl, vsl, kw, vw, gl = jnp.split(xn, cuts, axis=-1)
    kvh = lambda t: t.reshape(B, T, NSA_KV_HEADS, HEAD_DIM)
    new_cmp = jnp.stack([kvh(kc), kvh(vc)], axis=2)
    new_sel = jnp.stack([kvh(ksl), kvh(vsl)], axis=2)
    new_win = jnp.stack([kvh(kw), kvh(vw)], axis=2)
    L = past_cmp.shape[1] + T
    L_pad = -(-L // SEL_BLOCK) * SEL_BLOCK
    pad = lambda t: jnp.pad(t, ((0, 0), (0, L_pad - L), (0, 0), (0, 0), (0, 0)))
    full_cmp = pad(jnp.concatenate([past_cmp.astype(dt), new_cmp], axis=1))
    full_sel = pad(jnp.concatenate([past_sel.astype(dt), new_sel], axis=1))
    n_cmp = L_pad // CMP_BLOCK
    n_sel = L_pad // SEL_BLOCK
    cblk = full_cmp.reshape(B, n_cmp, CMP_BLOCK, 2, NSA_KV_HEADS, HEAD_DIM)
    kcb = jnp.einsum('bnlkd,l->bnkd', cblk[:, :, :, 0], cmp_w[0])
    vcb = jnp.einsum('bnlkd,l->bnkd', cblk[:, :, :, 1], cmp_w[1])
    sblk = full_sel.reshape(B, n_sel, SEL_BLOCK, 2, NSA_KV_HEADS, HEAD_DIM)
    ksb = jnp.transpose(sblk[:, :, :, 0], (0, 3, 1, 2, 4))
    vsb = jnp.transpose(sblk[:, :, :, 1], (0, 3, 1, 2, 4))
    n_prefix = win_prefix.shape[1]
    win_pad = jnp.concatenate([jnp.zeros((B, WINDOW, 2, NSA_KV_HEADS, HEAD_DIM), dt),
                               win_prefix.astype(dt), new_win], axis=1)
    q = q.reshape(B, T, NSA_KV_HEADS, NSA_GROUP, HEAD_DIM)
    gates = jax.nn.sigmoid(gl.reshape(B, T, NSA_KV_HEADS, NSA_GROUP, 3))
    qc = math.gcd(T, Q_BLOCK)
    n_chunks = T // qc
    top_n = min(SEL_TOPN, n_sel)
    scale = HEAD_DIM ** -0.5
    bi = jnp.arange(B)[:, None, None, None]
    hi = jnp.arange(NSA_KV_HEADS)[None, None, :, None]
    cmp_end = (jnp.arange(n_cmp) + 1) * CMP_BLOCK - 1
    blk = jnp.arange(n_sel)
    lw = WINDOW - 1 + qc
    jw = jnp.arange(lw)
    iw = jnp.arange(qc)

    def chunk(args):
        c, q_c, g_c = args
        qpos = pos0 + c * qc + jnp.arange(qc)
        q_c = q_c * scale
        s = jnp.einsum('bqkgd,bnkd->bqkgn', q_c, kcb)
        p_c = masked_softmax(s, (cmp_end[None, :] <= qpos[:, None])[None, :, None, None, :])
        o_cmp = jnp.einsum('bqkgn,bnkd->bqkgd', p_c.astype(dt), vcb)
        imp = p_c.sum(3).reshape(B, qc, NSA_KV_HEADS, n_sel, SEL_BLOCK // CMP_BLOCK).sum(-1)
        cur = (qpos // SEL_BLOCK)[None, :, None, None]
        forced = (blk == 0) | (blk == cur) | (blk == cur - 1)
        imp = jnp.where(blk > cur, -1.0, jnp.where(forced, FORCE_SCORE, imp))
        top_val, top_idx = lax.top_k(imp, top_n)
        k_g = ksb[bi, hi, top_idx]
        v_g = vsb[bi, hi, top_idx]
        s = jnp.einsum('bqkgd,bqknld->bqkgnl', q_c, k_g)
        kpos = top_idx[..., None] * SEL_BLOCK + jnp.arange(SEL_BLOCK)
        m = (top_val >= 0)[..., None] & (kpos <= qpos[None, :, None, None, None])
        p_s = masked_softmax(s.reshape(B, qc, NSA_KV_HEADS, NSA_GROUP, top_n * SEL_BLOCK),
                             m.reshape(B, qc, NSA_KV_HEADS, 1, top_n * SEL_BLOCK))
        o_sel = jnp.einsum('bqkgnl,bqknld->bqkgd',
                           p_s.reshape(B, qc, NSA_KV_HEADS, NSA_GROUP, top_n, SEL_BLOCK).astype(dt), v_g)
        start = n_prefix + c * qc + 1
        wkv = lax.dynamic_slice_in_dim(win_pad, start, lw, axis=1)
        s = jnp.einsum('bqkgd,bjkd->bqkgj', q_c, wkv[:, :, 0])
        m = ((jw[None, :] >= iw[:, None]) & (jw[None, :] <= iw[:, None] + WINDOW - 1)
             & (start + jw[None, :] >= WINDOW))
        p_w = masked_softmax(s, m[None, :, None, None, :])
        o_win = jnp.einsum('bqkgj,bjkd->bqkgd', p_w.astype(dt), wkv[:, :, 1])
        return g_c[..., 0:1] * o_cmp + g_c[..., 1:2] * o_sel + g_c[..., 2:3] * o_win

    chunks = lambda t: jnp.moveaxis(t.reshape(B, n_chunks, qc, *t.shape[2:]), 1, 0)
    out = lax.map(chunk, (jnp.arange(n_chunks), chunks(q), chunks(gates)))
    out = jnp.moveaxis(out, 0, 1).reshape(B, T, D_NSA)
    return out, new_cmp, new_sel, win_pad[:, -n_keep:]


def peer_ffn(x, wq, subkeys, u_tab, v_tab):
    B, T, D = x.shape
    n = B * T
    xt = x.reshape(n, D)
    q = (xt @ wq).reshape(n, P_HEADS, 2, P_DKEY // 2)
    s = jnp.einsum('nhcd,hckd->nhck', q, subkeys).astype(jnp.float32)
    hv, hix = lax.top_k(s, P_TOPK)
    cand = (hv[:, :, 0, :, None] + hv[:, :, 1, None, :]).reshape(n, P_HEADS, P_TOPK * P_TOPK)
    cand_e = (hix[:, :, 0, :, None] * N_KEYS + hix[:, :, 1, None, :]).reshape(n, P_HEADS, P_TOPK * P_TOPK)
    tv, tpos = lax.top_k(cand, P_TOPK)
    expert = jnp.take_along_axis(cand_e, tpos, axis=-1)
    gate = jax.nn.softmax(tv, axis=-1).astype(x.dtype)
    cb = math.gcd(n, P_TOK_BLOCK)

    def block(args):
        xb, eb, gb = args
        h = jax.nn.gelu(jnp.einsum('cd,chkd->chk', xb, u_tab[eb]), approximate=False)
        return jnp.einsum('chk,chkd->cd', gb * h, v_tab[eb])

    out = lax.map(block, (xt.reshape(n // cb, cb, D), expert.reshape(n // cb, cb, P_HEADS, P_TOPK),
                          gate.reshape(n // cb, cb, P_HEADS, P_TOPK)))
    return out.reshape(B, T, D)


def hybrid_layer(x, pos0, past_cmp, past_sel, win_prefix, shift_prev, rwkv_s0, n_keep, p):
    proj = x @ p['w_in']
    y_r, s_T, new_shift = rwkv_time_mix(proj[..., :RWKV_COLS], shift_prev, rwkv_s0, p)
    y_n, new_cmp, new_sel, new_win = nsa_mix(proj[..., RWKV_COLS:], past_cmp, past_sel, win_prefix,
                                             pos0, n_keep, p['nsa_cmp_w'])
    h = jnp.concatenate([y_r, y_n], axis=-1) @ p['w_out']
    x = layer_norm(DEEPNORM_ALPHA * x + h, p['ln1_g'], p['ln1_b'])
    f = peer_ffn(x, p['peer_wq'], p['peer_subkeys'], p['peer_u'], p['peer_v'])
    x = layer_norm(DEEPNORM_ALPHA * x + f, p['ln2_g'], p['ln2_b'])
    return x, (new_cmp, new_sel, new_win, s_T, new_shift)


def setup_inputs(seed: int = 0) -> dict:
    key = jax.random.key(seed)
    ks = jax.random.split(key, 40)
    n_pages = PAST_LEN // PAGE_SIZE
    n_used = DEC_BATCH * n_pages
    n_pool = n_used + n_used // 4
    win_buf = min(WINDOW, PAST_LEN)
    f32 = jnp.float32
    nrm = lambda k, shape, s: s * jax.random.normal(k, shape, f32)
    page_table = jax.random.permutation(ks[0], n_pool)[:n_used].reshape(DEC_BATCH, n_pages).astype(jnp.int32)
    kv_tail = (2, NSA_KV_HEADS, HEAD_DIM)
    return {
        'x_prompt': nrm(ks[1], (BATCH, SEQ, D_MODEL), 1.0),
        'x_sample': nrm(ks[2], (DEC_BATCH, DEC_SEQ, D_MODEL), 1.0),
        'cache_cmp_kv': nrm(ks[3], (DEPTH, n_pool, PAGE_SIZE) + kv_tail, 1.0),
        'cache_sel_kv': nrm(ks[4], (DEPTH, n_pool, PAGE_SIZE) + kv_tail, 1.0),
        'page_table': page_table,
        'state_win_kv': nrm(ks[5], (DEPTH, DEC_BATCH, win_buf) + kv_tail, 1.0),
        'state_rwkv': nrm(ks[6], (DEPTH, DEC_BATCH, H_RWKV, HEAD_DIM, HEAD_DIM), 0.3),
        'state_shift': nrm(ks[7], (DEPTH, DEC_BATCH, 1, RWKV_COLS), 1.0),
        'w_in': nrm(ks[8], (DEPTH, D_MODEL, IN_COLS), D_MODEL ** -0.5),
        'rwkv_mu': jax.random.uniform(ks[9], (DEPTH, RWKV_COLS), f32),
        'rwkv_w0': nrm(ks[10], (DEPTH, D_RWKV), 0.5) - 1.0,
        'rwkv_w2': nrm(ks[11], (DEPTH, W_LORA, D_RWKV), 0.5 * W_LORA ** -0.5),
        'rwkv_a0': nrm(ks[12], (DEPTH, D_RWKV), 0.5),
        'rwkv_a2': nrm(ks[13], (DEPTH, A_LORA, D_RWKV), 0.5 * A_LORA ** -0.5),
        'rwkv_g2': nrm(ks[14], (DEPTH, G_LORA, D_RWKV), G_LORA ** -0.5),
        'rwkv_k_k': 0.85 + nrm(ks[15], (DEPTH, D_RWKV), 0.05),
        'rwkv_k_a': 1.0 + nrm(ks[16], (DEPTH, D_RWKV), 0.05),
        'rwkv_r_k': nrm(ks[17], (DEPTH, H_RWKV, HEAD_DIM), 0.1),
        'rwkv_gn_g': 1.0 + nrm(ks[18], (DEPTH, D_RWKV), 0.01),
        'rwkv_gn_b': nrm(ks[19], (DEPTH, D_RWKV), 0.01),
        'nsa_cmp_w': (1.0 + nrm(ks[20], (DEPTH, 2, CMP_BLOCK), 0.1)) / CMP_BLOCK,
        'w_out': nrm(ks[21], (DEPTH, D_MIX, D_MODEL), DEEPNORM_BETA * D_MIX ** -0.5),
        'ln1_g': 1.0 + nrm(ks[22], (DEPTH, D_MODEL), 0.01),
        'ln1_b': nrm(ks[23], (DEPTH, D_MODEL), 0.01),
        'peer_wq': nrm(ks[24], (DEPTH, D_MODEL, P_HEADS * P_DKEY), D_MODEL ** -0.5),
        'peer_subkeys': nrm(ks[25], (DEPTH, P_HEADS, 2, N_KEYS, P_DKEY // 2), (P_DKEY // 2) ** -0.5),
        'peer_u': nrm(ks[26], (DEPTH, N_EXPERTS, D_MODEL), D_MODEL ** -0.5),
        'peer_v': nrm(ks[27], (DEPTH, N_EXPERTS, D_MODEL), DEEPNORM_BETA * P_HEADS ** -0.5),
        'ln2_g': 1.0 + nrm(ks[28], (DEPTH, D_MODEL), 0.01),
        'ln2_b': nrm(ks[29], (DEPTH, D_MODEL), 0.01),
    }


def reference(x_prompt, x_sample, cache_cmp_kv, cache_sel_kv, page_table, state_win_kv, state_rwkv,
              state_shift, w_in, rwkv_mu, rwkv_w0, rwkv_w2, rwkv_a0, rwkv_a2, rwkv_g2, rwkv_k_k,
              rwkv_k_a, rwkv_r_k, rwkv_gn_g, rwkv_gn_b, nsa_cmp_w, w_out, ln1_g, ln1_b, peer_wq,
              peer_subkeys, peer_u, peer_v, ln2_g, ln2_b):
    bp = x_prompt.shape[0]
    bs = x_sample.shape[0]
    dt = x_prompt.dtype
    n_pages = PAST_LEN // PAGE_SIZE
    past_len = n_pages * PAGE_SIZE
    n_keep = state_win_kv.shape[2]
    empty_kv = jnp.zeros((bp, 0, 2, NSA_KV_HEADS, HEAD_DIM), dt)
    zero_shift = jnp.zeros((bp, 1, RWKV_COLS), dt)
    zero_state = jnp.zeros((bp, H_RWKV, HEAD_DIM, HEAD_DIM), dt)
    yp, ys = x_prompt, x_sample
    st_p, st_s = [], []
    for l in range(DEPTH):
        p = {'w_in': w_in[l], 'rwkv_mu': rwkv_mu[l], 'rwkv_w0': rwkv_w0[l], 'rwkv_w2': rwkv_w2[l],
             'rwkv_a0': rwkv_a0[l], 'rwkv_a2': rwkv_a2[l], 'rwkv_g2': rwkv_g2[l],
             'rwkv_k_k': rwkv_k_k[l], 'rwkv_k_a': rwkv_k_a[l], 'rwkv_r_k': rwkv_r_k[l],
             'rwkv_gn_g': rwkv_gn_g[l], 'rwkv_gn_b': rwkv_gn_b[l], 'nsa_cmp_w': nsa_cmp_w[l],
             'w_out': w_out[l], 'ln1_g': ln1_g[l], 'ln1_b': ln1_b[l], 'peer_wq': peer_wq[l],
             'peer_subkeys': peer_subkeys[l], 'peer_u': peer_u[l], 'peer_v': peer_v[l],
             'ln2_g': ln2_g[l], 'ln2_b': ln2_b[l]}
        yp, sp = hybrid_layer(yp, 0, empty_kv, empty_kv, empty_kv, zero_shift, zero_state, n_keep, p)
        past_cmp = cache_cmp_kv[l, page_table].reshape(bs, past_len, 2, NSA_KV_HEADS, HEAD_DIM)
        past_sel = cache_sel_kv[l, page_table].reshape(bs, past_len, 2, NSA_KV_HEADS, HEAD_DIM)
        ys, ss = hybrid_layer(ys, past_len, past_cmp, past_sel, state_win_kv[l], state_shift[l],
                              state_rwkv[l], n_keep, p)
        st_p.append(sp)
        st_s.append(ss)
    stk = lambda sts, i: jnp.stack([s[i] for s in sts], axis=0)
    return (yp, ys, stk(st_p, 0), stk(st_p, 1), stk(st_p, 2), stk(st_p, 3), stk(st_p, 4),
            stk(st_s, 0), stk(st_s, 1), stk(st_s, 2), stk(st_s, 3), stk(st_s, 4))
```

```cpp
#include <hip/hip_runtime.h>
#include <cstdio>
#include <cstdint>
namespace pg8 {
#define PG8_LAS __attribute__((address_space(3)))
typedef unsigned short bf16_t;
typedef short bf16x8 __attribute__((ext_vector_type(8)));
typedef float f32x4 __attribute__((ext_vector_type(4)));
typedef unsigned u32x4 __attribute__((ext_vector_type(4)));
constexpr int BM = 256, BK = 64, HALF = 128, HTB = HALF * BK * 2  , STAGE_BYTES = 8 * HTB, NXCD = 8, WGM = 8;

__host__ __device__ __forceinline__ int lds_byte(int r, int c) { const int st = (r >> 4) * 2 + (c >> 5), rr = r & 15, cc = c & 31, ob = rr * 64 + cc * 2; return st * 1024 + (ob ^ (((ob >> 9) & 1) << 5)); }
__host__ __device__ __forceinline__ void stage_rc(int b, int& R, int& C) { const int st = b / 1024, sb = b % 1024, swz = sb ^ (((sb >> 9) & 1) << 5); R = (st >> 1) * 16 + swz / 64; C = (st & 1) * 32 + (swz % 64) / 2; }
__host__ __device__ __forceinline__ int perm32(int rho) { const int n = rho >> 4, i = rho & 15; return 8 * (i >> 2) + 4 * n + (i & 3); }

struct Unit { int pm, pn; };
struct Gemm { const bf16_t* A; const bf16_t* Bt; int M, N, K; };

struct StaticOrder {
    int nM, nN, nwg, G, c;
    __host__ __device__ void init(int M, int N, int G_, int c_) { nM = M / BM; nN = N / BM; nwg = nM * nN; G = G_; c = c_; }
    __host__ __device__ bool next(int i, Unit& u) const {
        const long L = (long)i * G + c; if (L >= nwg) return false;
        int wgid = (int)L; { const int q = nwg / NXCD, r = nwg % NXCD, xcd = wgid % NXCD, off = wgid / NXCD; wgid = (xcd < r ? xcd * (q + 1) : r * (q + 1) + (xcd - r) * q) + off; }
        const int nig = WGM * nN, gid = wgid / nig, fm = gid * WGM, gsz = (nM - fm) < WGM ? (nM - fm) : WGM;
        u.pm = fm + ((wgid % nig) % gsz); u.pn = (wgid % nig) / gsz; return true;
    }
    __device__ __forceinline__ void a_ready(const Unit&) const {}
    __device__ __forceinline__ void done(const Unit&) const {}
};

__device__ __forceinline__ unsigned cvt_pk_bf16(float lo, float hi) { unsigned r; asm volatile("v_cvt_pk_bf16_f32 %0, %1, %2" : "=v"(r) : "v"(lo), "v"(hi)); return r; }
typedef float f32x2 __attribute__((ext_vector_type(2)));
struct EpiF32 {
    static constexpr bool PERM = false, AFTER_DRAIN = false;
    float* C; int ldc; const float* bias;
    __device__ __forceinline__ void operator()(const f32x4 (&acc)[2][2][4][2], const Unit& u, int wr, int wc, int fr, int fq) const {
        const int row0 = u.pm * BM + wr * 64 + fr, col0 = u.pn * BM + wc * 32 + 4 * fq;
        f32x4 bv[2][2];
#pragma unroll
        for (int bj = 0; bj < 2; ++bj)
#pragma unroll
            for (int n = 0; n < 2; ++n) bv[bj][n] = bias ? *(const f32x4*)(bias + col0 + bj * HALF + n * 16) : (f32x4){0.f, 0.f, 0.f, 0.f};
#pragma unroll
        for (int ai = 0; ai < 2; ++ai)
#pragma unroll
            for (int m = 0; m < 4; ++m) { float* rowp = C + (size_t)(row0 + ai * HALF + m * 16) * ldc + col0;
#pragma unroll
                for (int bj = 0; bj < 2; ++bj)
#pragma unroll
                    for (int n = 0; n < 2; ++n) *(f32x4*)(rowp + bj * HALF + n * 16) = acc[ai][bj][m][n] + bv[bj][n]; }
    }
};
template <class Epi, class Sched, bool ALIGN_EPI = false, bool SP2 = false>
__device__ __forceinline__ void gemm_phase(PG8_LAS unsigned char* lds, const Gemm g, const Sched& S, const Epi& E) {
    const int tid = threadIdx.x, wid = __builtin_amdgcn_readfirstlane(tid >> 6), lane = tid & 63, wr = wid >> 2, wc = wid & 3, fr = lane & 15, fq = lane >> 4;
    const int K = g.K, nt = K / BK;
    unsigned voffA[2], voffB[2];
#pragma unroll
    for (int i = 0; i < 2; ++i) { int R, C; stage_rc(tid * 16 + i * 8192, R, C); const int Rb = Epi::PERM ? ((R & ~31) + perm32(R & 31)) : R;
        voffA[i] = (unsigned)(R * K + C) * 2u; voffB[i] = (unsigned)(Rb * K + C) * 2u; }
    const size_t kstep = (size_t)(BK * 2);
    const size_t hstep = (size_t)HALF * K * 2;
    const size_t tstep = 2 * hstep;
    const unsigned ldsw = (unsigned)wid * 1024u;
    const int aoff = lds_byte(wr * 64 + fr, fq * 8), boff = lds_byte(wc * 32 + fr, fq * 8);
#define PG8_SA(b, h) (((b) * 2 + (h)) * HTB)
#define PG8_SB(b, h) ((4 + (b) * 2 + (h)) * HTB)
#define PG8_STAGE(bufoff, gbase, voff) do { _Pragma("unroll") for (int _i = 0; _i < 2; ++_i) \
        __builtin_amdgcn_global_load_lds((const unsigned*)((const char*)(gbase) + (voff)[_i]), (PG8_LAS unsigned*)(lds + (bufoff) + ldsw + _i * 8192), 16, 0, 0); } while (0)
#define PG8_LDA(dst, b, h) do { _Pragma("unroll") for (int m = 0; m < 4; ++m) _Pragma("unroll") for (int k = 0; k < 2; ++k) dst[m][k] = *(const PG8_LAS bf16x8*)(lds + PG8_SA(b, h) + aoff + m * 2048 + k * 1024); } while (0)
#define PG8_LDB(dst, b, h) do { _Pragma("unroll") for (int n = 0; n < 2; ++n) _Pragma("unroll") for (int k = 0; k < 2; ++k) dst[n][k] = *(const PG8_LAS bf16x8*)(lds + PG8_SB(b, h) + boff + n * 2048 + k * 1024); } while (0)
#define PG8_MMA(ai, bj, At, Bt) do { __builtin_amdgcn_s_setprio(1); _Pragma("unroll") for (int m = 0; m < 4; ++m) _Pragma("unroll") for (int n = 0; n < 2; ++n) _Pragma("unroll") for (int k = 0; k < 2; ++k) \
        acc[ai][bj][m][n] = __builtin_amdgcn_mfma_f32_16x16x32_bf16(Bt[n][k], At[m][k], acc[ai][bj][m][n], 0, 0, 0); __builtin_amdgcn_s_setprio(0); } while (0)
#define PG8_WAIT_V(n) asm volatile("s_waitcnt vmcnt(" #n ")" ::: "memory")
#define PG8_WAIT_L(n) asm volatile("s_waitcnt lgkmcnt(" #n ")" ::: "memory")
#define PG8_BAR __builtin_amdgcn_s_barrier()
#define PG8_SCHED __builtin_amdgcn_sched_barrier(0)
    Unit cur, nxt; int ui = 0;
    if (!S.next(0, cur)) return;
    f32x4 acc[2][2][4][2];
#pragma unroll
    for (int a = 0; a < 2; ++a)
#pragma unroll
        for (int b = 0; b < 2; ++b)
#pragma unroll
            for (int m = 0; m < 4; ++m)
#pragma unroll
                for (int n = 0; n < 2; ++n) acc[a][b][m][n] = (f32x4){0.f, 0.f, 0.f, 0.f};
    bf16x8 At[4][2], B0[2][2], B1[2][2];
    const char* cA = (const char*)g.A + (size_t)cur.pm * tstep; const char* cB = (const char*)g.Bt + (size_t)cur.pn * tstep;
    S.a_ready(cur);
    if constexpr (SP2) {
        PG8_STAGE(PG8_SB(0, 0), cB, voffB); PG8_STAGE(PG8_SB(0, 1), cB + hstep, voffB); PG8_STAGE(PG8_SA(0, 0), cA, voffA); PG8_STAGE(PG8_SA(0, 1), cA + hstep, voffA);
        if (wr == 1) PG8_BAR;
        PG8_WAIT_V(2); PG8_BAR;
        PG8_STAGE(PG8_SB(1, 0), cB + kstep, voffB); PG8_STAGE(PG8_SA(1, 0), cA + kstep, voffA); PG8_STAGE(PG8_SB(1, 1), cB + hstep + kstep, voffB);
        PG8_WAIT_V(6); PG8_BAR;
    } else {
        PG8_STAGE(PG8_SB(0, 0), cB, voffB); PG8_STAGE(PG8_SA(0, 0), cA, voffA); PG8_STAGE(PG8_SB(0, 1), cB + hstep, voffB); PG8_STAGE(PG8_SA(0, 1), cA + hstep, voffA);
        if (wr == 1) PG8_BAR;
        PG8_WAIT_V(4); PG8_BAR;
        PG8_STAGE(PG8_SB(1, 0), cB + kstep, voffB); PG8_STAGE(PG8_SA(1, 0), cA + kstep, voffA); PG8_STAGE(PG8_SB(1, 1), cB + hstep + kstep, voffB);
        PG8_WAIT_V(6); PG8_BAR;
    }
    for (;;) {
        const bool has_next = S.next(ui + 1, nxt);
        const char* nA = has_next ? (const char*)g.A + (size_t)nxt.pm * tstep : cA; const char* nB = has_next ? (const char*)g.Bt + (size_t)nxt.pn * tstep : cB;
        for (int t = 0; t < nt; t += 2) {
            const bool last = (t == nt - 2);
            const char* a1 = cA + (size_t)(t + 1) * kstep;
            const char* a2 = last ? nA : cA + (size_t)(t + 2) * kstep; const char* b2 = last ? nB : cB + (size_t)(t + 2) * kstep;
            const char* a3 = a2 + kstep; const char* b3 = b2 + kstep;
            if (last && has_next) S.a_ready(nxt);
            if constexpr (SP2) {
            PG8_LDB(B0, 0, 0); PG8_LDB(B1, 0, 1); PG8_SCHED; PG8_LDA(At, 0, 0); PG8_STAGE(PG8_SA(1, 1), a1 + hstep, voffA);
            PG8_WAIT_V(8); PG8_WAIT_L(0); PG8_BAR; PG8_MMA(0, 0, At, B0); PG8_MMA(0, 1, At, B1); PG8_BAR; PG8_SCHED;
            PG8_LDA(At, 0, 1); PG8_STAGE(PG8_SB(0, 0), b2, voffB); PG8_STAGE(PG8_SB(0, 1), b2 + hstep, voffB); PG8_STAGE(PG8_SA(0, 0), a2, voffA);
            PG8_WAIT_V(8); PG8_WAIT_L(0); PG8_BAR; PG8_MMA(1, 0, At, B0); PG8_MMA(1, 1, At, B1); PG8_BAR; PG8_SCHED;
            PG8_LDB(B0, 1, 0); PG8_LDB(B1, 1, 1); PG8_SCHED; PG8_LDA(At, 1, 0); PG8_STAGE(PG8_SA(0, 1), a2 + hstep, voffA);
            PG8_WAIT_V(8); PG8_WAIT_L(0); PG8_BAR; PG8_MMA(0, 0, At, B0); PG8_MMA(0, 1, At, B1); PG8_BAR; PG8_SCHED;
            PG8_LDA(At, 1, 1); PG8_STAGE(PG8_SB(1, 0), b3, voffB); PG8_STAGE(PG8_SB(1, 1), b3 + hstep, voffB); PG8_STAGE(PG8_SA(1, 0), a3, voffA);
            PG8_WAIT_V(8); PG8_WAIT_L(0); PG8_BAR; PG8_MMA(1, 0, At, B0); PG8_MMA(1, 1, At, B1); PG8_BAR; PG8_SCHED;
            } else {
            PG8_LDB(B0, 0, 0); PG8_SCHED; PG8_LDA(At, 0, 0); PG8_STAGE(PG8_SA(1, 1), a1 + hstep, voffA);
            PG8_WAIT_L(8); PG8_BAR; PG8_WAIT_L(0); PG8_MMA(0, 0, At, B0); PG8_BAR; PG8_SCHED;
            PG8_LDB(B1, 0, 1); PG8_STAGE(PG8_SB(0, 0), b2, voffB);
            PG8_BAR; PG8_WAIT_L(0); PG8_MMA(0, 1, At, B1); PG8_BAR;
            PG8_LDA(At, 0, 1); PG8_STAGE(PG8_SA(0, 0), a2, voffA);
            PG8_BAR; PG8_WAIT_L(0); PG8_MMA(1, 0, At, B0); PG8_BAR; PG8_SCHED;
            PG8_STAGE(PG8_SB(0, 1), b2 + hstep, voffB);
            PG8_WAIT_V(6); PG8_BAR; PG8_MMA(1, 1, At, B1); PG8_BAR;
            PG8_LDB(B0, 1, 0); PG8_SCHED; PG8_LDA(At, 1, 0); PG8_STAGE(PG8_SA(0, 1), a2 + hstep, voffA);
            PG8_WAIT_L(8); PG8_BAR; PG8_WAIT_L(0); PG8_MMA(0, 0, At, B0); PG8_BAR; PG8_SCHED;
            PG8_LDB(B1, 1, 1); PG8_STAGE(PG8_SB(1, 0), b3, voffB);
            PG8_BAR; PG8_WAIT_L(0); PG8_MMA(0, 1, At, B1); PG8_BAR;
            PG8_LDA(At, 1, 1); PG8_STAGE(PG8_SA(1, 0), a3, voffA);
            PG8_BAR; PG8_WAIT_L(0); PG8_MMA(1, 0, At, B0); PG8_BAR; PG8_SCHED;
            PG8_STAGE(PG8_SB(1, 1), b3 + hstep, voffB);
            PG8_WAIT_V(6); PG8_BAR; PG8_MMA(1, 1, At, B1); PG8_BAR;
            }
        }
        if constexpr (ALIGN_EPI) { if (wr == 0) PG8_BAR; }
        if constexpr (!Epi::AFTER_DRAIN) { E(acc, cur, wr, wc, fr, fq); S.done(cur); }
        if (!has_next) break;
#pragma unroll
        for (int a = 0; a < 2; ++a)
#pragma unroll
            for (int b = 0; b < 2; ++b)
#pragma unroll
                for (int m = 0; m < 4; ++m)
#pragma unroll
                    for (int n = 0; n < 2; ++n) acc[a][b][m][n] = (f32x4){0.f, 0.f, 0.f, 0.f};
        cur = nxt; cA = nA; cB = nB; ++ui;
        if constexpr (ALIGN_EPI) { if (wr == 1) PG8_BAR; }
    }
    PG8_WAIT_V(0);
    if constexpr (!ALIGN_EPI) { if (wr == 0) PG8_BAR; }
    PG8_BAR;
    if constexpr (Epi::AFTER_DRAIN) { E.fused(acc, cur, wr, wc, fr, fq, lds, wid, lane); S.done(cur); }
#undef PG8_SA
#undef PG8_SB
#undef PG8_STAGE
#undef PG8_LDA
#undef PG8_LDB
#undef PG8_MMA
#undef PG8_WAIT_V
#undef PG8_WAIT_L
#undef PG8_BAR
#undef PG8_SCHED
}
}
#define LAS __attribute__((address_space(3)))
#define XB_TMO      128
#define XB_XCNT(j)  (256  + 64 * (j))
#define XB_XSUB(j)  (1280 + 64 * (j))
#define XB_XGEN(j)  (2304 + 64 * (j))
#define XB_TOP      3328
#define XB_TOPGEN   3392
#define XCD_BAR_WORDS 3456
#define XB_SPIN_CAP (1u << 18)

__device__ __forceinline__ unsigned xb_ld(unsigned* p)              { return __hip_atomic_load(p, __ATOMIC_RELAXED, __HIP_MEMORY_SCOPE_AGENT); }
__device__ __forceinline__ unsigned xb_add(unsigned* p, unsigned v) { return __hip_atomic_fetch_add(p, v, __ATOMIC_RELAXED, __HIP_MEMORY_SCOPE_AGENT); }
__device__ __forceinline__ unsigned xb_xcc_id() { return (unsigned)__builtin_amdgcn_s_getreg((3 << 11) | 20) & 0xFu; }
#define XB_SPIN(cond, bar) do { unsigned _sp = 0; while (cond) { __builtin_amdgcn_s_sleep(1); \
    if ((++_sp & 255u) == 0u) { if (xb_ld(&(bar)[XB_TMO])) break; if (_sp > XB_SPIN_CAP) { atomicAdd(&(bar)[XB_TMO], 1u); break; } } } } while (0)

struct XcdBarrier {
    unsigned* bar; unsigned x;
    volatile LAS unsigned* st;
};

__device__ __forceinline__ XcdBarrier xcd_barrier_post(unsigned* bar, volatile LAS unsigned* st) {
    XcdBarrier b; b.bar = bar; b.x = xb_xcc_id(); b.st = st;
    if (threadIdx.x == 0) (void)xb_add(&bar[XB_XCNT(b.x)], 1u);
    return b;
}
__device__ __forceinline__ void xcd_barrier_complete(unsigned* bar, unsigned x, unsigned& nloc, unsigned& nx) {
    const unsigned G = gridDim.x * gridDim.y * gridDim.z;
    unsigned sum, cnt, mine, sp = 0u;
    for (;;) {
        sum = 0u; cnt = 0u; mine = 0u;
#pragma unroll
        for (unsigned j = 0; j < 16; ++j) { const unsigned c = xb_ld(&bar[XB_XCNT(j)]); sum += c; cnt += (c > 0u) ? 1u : 0u; mine = (j == x) ? c : mine; }
        if (sum == G) break;
        __builtin_amdgcn_s_sleep(1);
        if ((++sp & 255u) == 0u) { if (xb_ld(&bar[XB_TMO])) break; if (sp > XB_SPIN_CAP) { atomicAdd(&bar[XB_TMO], 1u); break; } }
    }
    nloc = mine > 0u ? mine : 1u; nx = cnt > 0u ? cnt : 1u;
}

__device__ __forceinline__ void xcd_barrier(const XcdBarrier& b) {
    asm volatile("s_waitcnt vmcnt(0)" ::: "memory");
    __syncthreads();
    if (threadIdx.x == 0) {
        unsigned* bar = b.bar;
        __builtin_amdgcn_s_waitcnt(0);
        unsigned nloc = b.st[0], nx = b.st[1];
        if (nloc == 0u) { xcd_barrier_complete(bar, b.x, nloc, nx); b.st[0] = nloc; b.st[1] = nx; }
        const unsigned old = xb_add(&bar[XB_XSUB(b.x)], 1u);
        const unsigned gen = old / nloc;
        if (old + 1u == (gen + 1u) * nloc) {
            __builtin_amdgcn_fence(__ATOMIC_RELEASE, "agent");
            asm volatile("s_waitcnt vmcnt(0)" ::: "memory");
            const unsigned og = xb_add(&bar[XB_TOP], 1u);
            const unsigned tg = og / nx;
            if (og + 1u == (tg + 1u) * nx) xb_add(&bar[XB_TOPGEN], 1u);
            else XB_SPIN(xb_ld(&bar[XB_TOPGEN]) == tg, bar);
            __builtin_amdgcn_fence(__ATOMIC_ACQUIRE, "agent");
            xb_add(&bar[XB_XGEN(b.x)], 1u);
            asm volatile("s_waitcnt vmcnt(0)" ::: "memory");
        } else {
            XB_SPIN(xb_ld(&bar[XB_XGEN(b.x)]) == gen, bar);
            __builtin_amdgcn_fence(__ATOMIC_ACQUIRE, "agent");
            asm volatile("s_waitcnt vmcnt(0)" ::: "memory");
        }
    }
    __syncthreads();
}

constexpr int NWAVES = 8, NTHREADS = 512;
constexpr int DM = 2048, NTP = 8192, NTS = 32, NT = 8224, MP = 8448;
constexpr int RW_COLS = 3360, Q_OFF = 3360, KC_OFF = 4384, KS_OFF = 4896, VS_OFF = 5152, KW_OFF = 5408, VW_OFF = 5664, GL_OFF = 5920, IN_COLS = 5968, PLD = 6144;
constexpr int NEXP = 16384, NPOOL = 1280;
constexpr float LN_EPS = 1e-5f, GN_EPS = 64e-5f, DN_ALPHA = 1.4142135623730951f;
constexpr float NEG_BIG = -1e30f;
constexpr size_t O_YP = 0, O_YS = O_YP + (size_t)NTP * DM, O_CMP_P = O_YS + (size_t)NTS * DM, O_SEL_P = O_CMP_P + (size_t)2 * NTP * 512, O_WIN_P = O_SEL_P + (size_t)2 * NTP * 512,
                 O_RW_P = O_WIN_P + (size_t)2 * 4 * 512 * 512, O_SH_P = O_RW_P + (size_t)2 * 4 * 16 * 4096, O_CMP_S = O_SH_P + (size_t)2 * 4 * RW_COLS, O_SEL_S = O_CMP_S + (size_t)2 * NTS * 512,
                 O_WIN_S = O_SEL_S + (size_t)2 * NTS * 512, O_RW_S = O_WIN_S + (size_t)2 * 8 * 512 * 512, O_SH_S = O_RW_S + (size_t)2 * 8 * 16 * 4096, O_END = O_SH_S + (size_t)2 * 8 * RW_COLS;
static_assert(O_END == 41630464, "output size");
constexpr size_t MiB = 1ull << 20;
constexpr size_t WS_CTL = 0, CTL_ZERO_BYTES = 1 * MiB;
constexpr size_t WS_WIN = 1 * MiB;
constexpr size_t WS_WOUT = WS_WIN + 48 * MiB;
constexpr size_t WS_W2 = WS_WOUT + 16 * MiB;
constexpr size_t WS_UB = WS_W2 + 16 * MiB;
constexpr size_t WS_VB = WS_UB + 128 * MiB;
constexpr size_t WS_XB = WS_VB + 128 * MiB;
constexpr size_t WS_X1B = WS_XB + 33 * MiB;
constexpr size_t WS_XF1 = WS_X1B + 33 * MiB;
constexpr size_t WS_X1F = WS_XF1 + 65 * MiB;
constexpr size_t WS_PROJ = WS_X1F + 65 * MiB;
constexpr size_t WS_SC = WS_PROJ + 99 * MiB;
constexpr size_t SC_STRIDE = 33 * MiB;
constexpr size_t WS_GG = WS_SC + 6 * SC_STRIDE;
constexpr size_t WS_BON = WS_GG + 33 * MiB;
constexpr size_t WS_MIX = WS_BON + 1 * MiB;
constexpr size_t WS_HS = WS_MIX + 33 * MiB;
constexpr size_t WS_KCB = WS_HS + 66 * MiB;
constexpr size_t WS_VCBT = WS_KCB + 512 * 1024;
constexpr size_t WS_VTS = WS_KCB + 1 * MiB;
constexpr size_t WS_VTW = WS_VTS + 4 * MiB;
constexpr size_t WS_KCBS = WS_VTW + 4 * MiB;
constexpr size_t WS_VCBS = WS_KCBS + 17 * MiB;
constexpr size_t WS_END = WS_VCBS + 17 * MiB;
constexpr int CW_BAR = 4096, CW_QUEUE = 8192;
constexpr int RING_BYTES = 131072, MISC_OFF = RING_BYTES + 320, LDS_BYTES = 147456;
constexpr int N_PHASES = 15;

typedef unsigned short bf16;
typedef unsigned v4u __attribute__((ext_vector_type(4)));
typedef unsigned v2u __attribute__((ext_vector_type(2)));
typedef float f32x4 __attribute__((ext_vector_type(4)));
typedef float f32x16 __attribute__((ext_vector_type(16)));
typedef short bf16x8 __attribute__((ext_vector_type(8)));
typedef float f32x2_t __attribute__((ext_vector_type(2)));
typedef __bf16 bf16x2_t __attribute__((ext_vector_type(2)));
#define LDS_WAIT() asm volatile("s_waitcnt lgkmcnt(0)" ::: "memory")
#define DI __device__ __forceinline__

DI unsigned pk2(float lo, float hi) { f32x2_t v = {lo, hi}; bf16x2_t b = __builtin_convertvector(v, bf16x2_t); return __builtin_bit_cast(unsigned, b); }
DI float bf2f(unsigned short u) { return __builtin_bit_cast(float, (unsigned)u << 16); }
DI float bflo(unsigned u) { return __builtin_bit_cast(float, u << 16); }
DI float bfhi(unsigned u) { return __builtin_bit_cast(float, u & 0xffff0000u); }
DI float wave_sum(float v) {
#pragma unroll
    for (int o = 1; o < 64; o <<= 1) v += __shfl_xor(v, o);
    return v;
}
DI float wave_max(float v) {
#pragma unroll
    for (int o = 1; o < 64; o <<= 1) v = fmaxf(v, __shfl_xor(v, o));
    return v;
}
DI int wave_min_i(int v) {
#pragma unroll
    for (int o = 1; o < 64; o <<= 1) { int w = __shfl_xor(v, o); v = w < v ? w : v; }
    return v;
}
DI float sigmoidf_(float x) { return 1.f / (1.f + expf(-x)); }
DI int crow(int reg, int h) { return (reg & 3) + 8 * (reg >> 2) + 4 * h; }

struct ArgsK { const float* in[30]; float* out; unsigned char* ws; int ph_lo, ph_hi, use_bar, pad; };
typedef __attribute__((address_space(4))) const ArgsK* kargp_t;
struct Ctx {
    float* out; unsigned char* ws;
    LAS unsigned char* lds; unsigned* ctl;
    int tid, lane, wave, G;
    DI const float* inp(int k) const { kargp_t p = (kargp_t)__builtin_amdgcn_kernarg_segment_ptr(); asm volatile("" : "+s"(p)); return p->in[k]; }
};
template <class T> DI T* wsp(const Ctx& C, size_t off) { return (T*)(C.ws + off); }

struct EpiInProj {
    static constexpr bool PERM = true, AFTER_DRAIN = false;
    bf16* P; float* out; int l;
    DI void operator()(const pg8::f32x4 (&acc)[2][2][4][2], const pg8::Unit& u, int wr, int wc, int fr, int fq) const {
        const int row0 = u.pm * 256 + wr * 64 + fr, col0 = u.pn * 256 + wc * 32 + 8 * fq;
#pragma unroll
        for (int bj = 0; bj < 2; ++bj) {
            const int colb = __builtin_amdgcn_readfirstlane(u.pn * 256 + wc * 32 + bj * 128);
            const int col = col0 + bj * 128;
            const int kind = colb < RW_COLS ? 1 : ((colb >= KC_OFF && colb < GL_OFF) ? 2 : 0);
            const int reg = (colb - KC_OFF) >> 9, cc = (col - KC_OFF) & 511;
#pragma unroll
            for (int ai = 0; ai < 2; ++ai)
#pragma unroll
                for (int m = 0; m < 4; ++m) {
                    const int row = row0 + ai * 128 + m * 16;
                    const pg8::f32x4 v0 = acc[ai][bj][m][0], v1 = acc[ai][bj][m][1];
                    v4u w; w.x = pk2(v0[0], v0[1]); w.y = pk2(v0[2], v0[3]); w.z = pk2(v1[0], v1[1]); w.w = pk2(v1[2], v1[3]);
                    *(v4u*)(P + (size_t)row * PLD + col) = w;
                    if (kind == 0 || row >= NT) continue;
                    unsigned off = 0xffffffffu;
                    if (row < NTP) { const int b = row >> 11, t = row & 2047;
                        if (kind == 1) { if (t == 2047) off = (unsigned)(O_SH_P + (size_t)(l * 4 + b) * RW_COLS + col); }
                        else if (reg == 0) off = (unsigned)(O_CMP_P + ((size_t)l * NTP + row) * 512 + cc);
                        else if (reg == 1) off = (unsigned)(O_SEL_P + ((size_t)l * NTP + row) * 512 + cc);
                        else if (t >= 1536) off = (unsigned)(O_WIN_P + ((size_t)(l * 4 + b) * 512 + (t - 1536)) * 512 + cc);
                    } else { const int j = row - NTP, b = j >> 2, t = j & 3;
                        if (kind == 1) { if (t == 3) off = (unsigned)(O_SH_S + (size_t)(l * 8 + b) * RW_COLS + col); }
                        else if (reg == 0) off = (unsigned)(O_CMP_S + ((size_t)l * NTS + j) * 512 + cc);
                        else if (reg == 1) off = (unsigned)(O_SEL_S + ((size_t)l * NTS + j) * 512 + cc);
                        else off = (unsigned)(O_WIN_S + ((size_t)(l * 8 + b) * 512 + 508 + t) * 512 + cc);
                    }
                    if (off != 0xffffffffu) { *(pg8::f32x4*)(out + off) = v0; *(pg8::f32x4*)(out + off + 4) = v1; }
                }
        }
    }
};

DI void transpose_item(const float* W, int K, int N, int Npad, bf16* WT, LAS float* scr, int item, int lane) {
    const int nblk = Npad / 32, kb = item / nblk, nb = item % nblk, k0 = 64 * kb, n0 = 32 * nb;
#pragma unroll 8
    for (int i = 0; i < 32; ++i) { const int kk = 2 * i + (lane >> 5), n = n0 + (lane & 31); scr[kk * 33 + (lane & 31)] = n < N ? W[(size_t)(k0 + kk) * N + n] : 0.f; }
    LDS_WAIT(); asm volatile("" ::: "memory");
    const int c = lane & 7;
#pragma unroll
    for (int j = 0; j < 4; ++j) { const int n = (lane >> 3) + 8 * j; const LAS float* s = scr + (8 * c) * 33 + n;
        v4u o; o.x = pk2(s[0 * 33], s[1 * 33]); o.y = pk2(s[2 * 33], s[3 * 33]); o.z = pk2(s[4 * 33], s[5 * 33]); o.w = pk2(s[6 * 33], s[7 * 33]);
        *(v4u*)(WT + (size_t)(n0 + n) * K + k0 + 8 * c) = o; }
    LDS_WAIT(); asm volatile("" ::: "memory");
}

constexpr int P0_NT = 2048, P0_NW2 = 2048, P0_NTAB = 16384, P0_NX = 2056, P0_NCC = 2048, P0_NWP = 508;
constexpr int P0_ITEMS = P0_NT + P0_NW2 + P0_NTAB + P0_NX + P0_NCC + P0_NWP;

DI void p0_prologue(const Ctx& C) {
    const int tid = C.tid, lane = C.lane, wave = C.wave;
    for (int it = blockIdx.x; it < P0_ITEMS; it += C.G) {
        int r = it;
        if (r < P0_NTAB) {
            const float* src = (r < 8192 ? C.inp(26) : C.inp(27)) + (size_t)(r & 8191) * 8192;
            bf16* dst = wsp<bf16>(C, r < 8192 ? WS_UB : WS_VB) + (size_t)(r & 8191) * 8192;
            const f32x4* s4 = (const f32x4*)src + tid * 4;
            const f32x4 a = s4[0], b = s4[1], c = s4[2], d = s4[3];
            v4u o0, o1; o0.x = pk2(a[0], a[1]); o0.y = pk2(a[2], a[3]); o0.z = pk2(b[0], b[1]); o0.w = pk2(b[2], b[3]);
            o1.x = pk2(c[0], c[1]); o1.y = pk2(c[2], c[3]); o1.z = pk2(d[0], d[1]); o1.w = pk2(d[2], d[3]);
            v4u* d4 = (v4u*)dst + tid * 2; d4[0] = o0; d4[1] = o1;
            continue;
        }
        r -= P0_NTAB;
        if (r < P0_NCC) {
            const int l = r >> 10, b = (r >> 7) & 7, pi = r & 127;
            const int pid = ((const int*)C.inp(4))[b * 128 + pi];
            const float* src = C.inp(2) + ((size_t)(l * NPOOL + pid) * 128) * 512 + tid;
            const int kv = tid >> 8, kvh = (tid >> 6) & 3, d = tid & 63;
            const float* w = C.inp(20) + (l * 2 + kv) * 32;
            float acc[4] = {0.f, 0.f, 0.f, 0.f};
#pragma unroll
            for (int q = 0; q < 4; ++q)
#pragma unroll 8
                for (int rr = 0; rr < 32; ++rr) acc[q] += w[rr] * src[(size_t)(32 * q + rr) * 512];
            float* dst = wsp<float>(C, kv ? WS_VCBS : WS_KCBS) + ((size_t)((l * 8 + b) * 4 + kvh) * 512 + 4 * pi) * 64 + d;
#pragma unroll
            for (int q = 0; q < 4; ++q) dst[q * 64] = acc[q];
            continue;
        }
        r -= P0_NCC;
        if (r < P0_NT) {
            const int l = r >> 10, w8 = (r & 1023) * 8 + wave;
            LAS float* scr = (LAS float*)(C.lds + wave * 16384);
            if (w8 < 6144) transpose_item(C.inp(8) + (size_t)l * DM * IN_COLS, DM, IN_COLS, PLD, wsp<bf16>(C, WS_WIN) + (size_t)l * PLD * DM, scr, w8, lane);
            else transpose_item(C.inp(21) + (size_t)l * DM * DM, DM, DM, DM, wsp<bf16>(C, WS_WOUT) + (size_t)l * DM * DM, scr, w8 - 6144, lane);
            continue;
        }
        r -= P0_NT;
        if (r < P0_NW2) {
            const int l = r >> 10, hc = (r >> 6) & 15, kb = r & 63;
            LAS float* SK = (LAS float*)C.lds;
            LAS float* WQ = (LAS float*)(C.lds + 128 * 129 * 4);
            __syncthreads();
            const float* sk = C.inp(25) + ((size_t)l * 16 + hc) * 16384;
            for (int i = tid; i < 16384; i += NTHREADS) SK[(i >> 7) * 129 + (i & 127)] = sk[i];
            const float* wq = C.inp(24) + (size_t)l * DM * DM + (size_t)(kb * 32) * DM + hc * 128;
            for (int i = tid; i < 4096; i += NTHREADS) WQ[i] = wq[(size_t)(i >> 7) * DM + (i & 127)];
            __syncthreads();
            const int k = tid & 127, rq = tid >> 7;
            float acc[8];
#pragma unroll
            for (int j = 0; j < 8; ++j) acc[j] = 0.f;
            for (int d = 0; d < 128; d += 4) {
                const float s0 = SK[k * 129 + d], s1 = SK[k * 129 + d + 1], s2 = SK[k * 129 + d + 2], s3 = SK[k * 129 + d + 3];
#pragma unroll
                for (int j = 0; j < 8; ++j) { const f32x4 w = *(const LAS f32x4*)(WQ + (rq * 8 + j) * 128 + d); acc[j] += s0 * w[0] + s1 * w[1] + s2 * w[2] + s3 * w[3]; }
            }
            v4u o; o.x = pk2(acc[0], acc[1]); o.y = pk2(acc[2], acc[3]); o.z = pk2(acc[4], acc[5]); o.w = pk2(acc[6], acc[7]);
            *(v4u*)(wsp<bf16>(C, WS_W2) + (size_t)l * DM * DM + (size_t)(hc * 128 + k) * DM + kb * 32 + rq * 8) = o;
            continue;
        }
        r -= P0_NW2;
        if (r < P0_NX) {
            const size_t e0 = (size_t)r * 8192 + tid * 16;
            const float* src = e0 < (size_t)NTP * DM ? C.inp(0) + e0 : C.inp(1) + (e0 - (size_t)NTP * DM);
            const f32x4* s4 = (const f32x4*)src;
            const f32x4 a = s4[0], b = s4[1], c = s4[2], d = s4[3];
            v4u o0, o1; o0.x = pk2(a[0], a[1]); o0.y = pk2(a[2], a[3]); o0.z = pk2(b[0], b[1]); o0.w = pk2(b[2], b[3]);
            o1.x = pk2(c[0], c[1]); o1.y = pk2(c[2], c[3]); o1.z = pk2(d[0], d[1]); o1.w = pk2(d[2], d[3]);
            v4u* d4 = (v4u*)(wsp<bf16>(C, WS_XB) + e0); d4[0] = o0; d4[1] = o1;
            continue;
        }
        r -= P0_NX;
        {
            const size_t i0 = (size_t)r * 8192 + tid * 16;
            const size_t lb = i0 / 260096, rem = i0 % 260096;
            const f32x4* s4 = (const f32x4*)(C.inp(5) + lb * 262144 + 2048 + rem);
            f32x4* d4 = (f32x4*)(C.out + O_WIN_S + lb * 262144 + rem);
            const f32x4 a = s4[0], b = s4[1], c = s4[2], d = s4[3];
            d4[0] = a; d4[1] = b; d4[2] = c; d4[3] = d;
        }
    }
    __syncthreads();
}

constexpr int PB_NRW = 1028, PB_NPOOL = 256, PB_NVT = 1024, PB_ITEMS = PB_NRW + PB_NPOOL + PB_NVT;
DI float softplusf_(float x) { return x > 20.f ? x : log1pf(expf(x)); }

DI void rwkv_pre_item(const Ctx& C, int l, int item) {
    const int tid = C.tid, lane = C.lane, wave = C.wave;
    LAS float* XS = (LAS float*)C.lds;
    LAS float* ACT = (LAS float*)(C.lds + 8 * RW_COLS * 4);
    const bf16* P = wsp<bf16>(C, WS_PROJ);
    const int m0 = item * 8;
    __syncthreads();
    for (int idx = tid; idx < 8 * 420; idx += NTHREADS) {
        const int j = idx / 420, col = (idx % 420) * 8, m = m0 + j;
        const v4u cu = *(const v4u*)(P + (size_t)m * PLD + col);
        float cur[8] = {bflo(cu.x), bfhi(cu.x), bflo(cu.y), bfhi(cu.y), bflo(cu.z), bfhi(cu.z), bflo(cu.w), bfhi(cu.w)};
        float prev[8];
        int t; const float* sh = nullptr;
        if (m < NTP) t = m & 2047; else { const int jj = m - NTP; t = jj & 3; sh = C.inp(7) + (size_t)(l * 8 + (jj >> 2)) * RW_COLS + col; }
        if (t > 0) { const v4u pu = *(const v4u*)(P + (size_t)(m - 1) * PLD + col);
            prev[0] = bflo(pu.x); prev[1] = bfhi(pu.x); prev[2] = bflo(pu.y); prev[3] = bfhi(pu.y); prev[4] = bflo(pu.z); prev[5] = bfhi(pu.z); prev[6] = bflo(pu.w); prev[7] = bfhi(pu.w);
        } else if (sh) {
#pragma unroll
            for (int e = 0; e < 8; ++e) prev[e] = sh[e];
        } else {
#pragma unroll
            for (int e = 0; e < 8; ++e) prev[e] = 0.f;
        }
        const float* mu = C.inp(9) + (size_t)l * RW_COLS + col;
#pragma unroll
        for (int e = 0; e < 8; ++e) XS[j * RW_COLS + col + e] = cur[e] + mu[e] * (prev[e] - cur[e]);
    }
    __syncthreads();
    for (int idx = tid; idx < 8 * 288; idx += NTHREADS) {
        const int j = idx / 288, a = idx % 288; const float x = XS[j * RW_COLS + 3072 + a];
        ACT[a * 8 + j] = a < 64 ? tanhf(x) : (a < 128 ? x : sigmoidf_(x));
    }
    __syncthreads();
    float wp[2][8], ap[2][8], gp[2][8];
#pragma unroll
    for (int s = 0; s < 2; ++s)
#pragma unroll
        for (int j = 0; j < 8; ++j) { wp[s][j] = 0.f; ap[s][j] = 0.f; gp[s][j] = 0.f; }
    const float* w2 = C.inp(11) + (size_t)l * 64 * 1024 + tid;
    const float* a2 = C.inp(13) + (size_t)l * 64 * 1024 + tid;
    const float* g2 = C.inp(14) + (size_t)l * 160 * 1024 + tid;
#pragma unroll 4
    for (int kk = 0; kk < 64; ++kk) {
        const float wa = w2[kk * 1024], wb = w2[kk * 1024 + 512];
        const f32x4 t0 = *(const LAS f32x4*)(ACT + kk * 8), t1 = *(const LAS f32x4*)(ACT + kk * 8 + 4);
#pragma unroll
        for (int j = 0; j < 4; ++j) { wp[0][j] += t0[j] * wa; wp[1][j] += t0[j] * wb; wp[0][4 + j] += t1[j] * wa; wp[1][4 + j] += t1[j] * wb; }
    }
#pragma unroll 4
    for (int kk = 0; kk < 64; ++kk) {
        const float wa = a2[kk * 1024], wb = a2[kk * 1024 + 512];
        const f32x4 t0 = *(const LAS f32x4*)(ACT + (64 + kk) * 8), t1 = *(const LAS f32x4*)(ACT + (64 + kk) * 8 + 4);
#pragma unroll
        for (int j = 0; j < 4; ++j) { ap[0][j] += t0[j] * wa; ap[1][j] += t0[j] * wb; ap[0][4 + j] += t1[j] * wa; ap[1][4 + j] += t1[j] * wb; }
    }
#pragma unroll 4
    for (int kk = 0; kk < 160; ++kk) {
        const float wa = g2[kk * 1024], wb = g2[kk * 1024 + 512];
        const f32x4 t0 = *(const LAS f32x4*)(ACT + (128 + kk) * 8), t1 = *(const LAS f32x4*)(ACT + (128 + kk) * 8 + 4);
#pragma unroll
        for (int j = 0; j < 4; ++j) { gp[0][j] += t0[j] * wa; gp[1][j] += t0[j] * wb; gp[0][4 + j] += t1[j] * wa; gp[1][4 + j] += t1[j] * wb; }
    }
    float* SC = wsp<float>(C, WS_SC); constexpr size_t SS = SC_STRIDE / 4;
    float* GG = wsp<float>(C, WS_GG); float* BON = wsp<float>(C, WS_BON);
#pragma unroll
    for (int s = 0; s < 2; ++s) {
        const int c = tid + 512 * s, head = wave + 8 * s;
        const float w0v = C.inp(10)[l * 1024 + c], a0v = C.inp(12)[l * 1024 + c], kkv = C.inp(15)[l * 1024 + c], kav = C.inp(16)[l * 1024 + c], rkv = C.inp(17)[l * 1024 + c];
#pragma unroll
        for (int j = 0; j < 8; ++j) {
            const size_t m = m0 + j;
            const float z = w0v + wp[s][j];
            const float w = -softplusf_(-z) - 0.5f;
            const float dec = expf(-expf(w));
            const float a = sigmoidf_(a0v + ap[s][j]);
            const float rr = XS[j * RW_COLS + c], k = XS[j * RW_COLS + 1024 + c], v = XS[j * RW_COLS + 2048 + c];
            const float kkr = k * kkv;
            const float ss = wave_sum(kkr * kkr);
            const float kk = kkr * (1.f / sqrtf(fmaxf(ss, 1e-24f)));
            const float km = k * (1.f + (a - 1.f) * kav);
            const float bon = wave_sum(rr * km * rkv);
            SC[0 * SS + m * 1024 + c] = kk; SC[1 * SS + m * 1024 + c] = dec; SC[2 * SS + m * 1024 + c] = kk * a; SC[3 * SS + m * 1024 + c] = km; SC[4 * SS + m * 1024 + c] = rr; SC[5 * SS + m * 1024 + c] = v;
            GG[m * 1024 + c] = gp[s][j];
            if (lane == 0) BON[m * 16 + head] = bon;
        }
    }
}

DI void phase_b(const Ctx& C, int l) {
    const int tid = C.tid;
    const bf16* P = wsp<bf16>(C, WS_PROJ);
    for (int it = blockIdx.x; it < PB_ITEMS; it += C.G) {
        int r = it;
        if (r < PB_NRW) { rwkv_pre_item(C, l, r); continue; }
        r -= PB_NRW;
        if (r < PB_NPOOL) {
            const int b = r >> 6, n = r & 63, kv = tid >> 8, kvh = (tid >> 6) & 3, d = tid & 63;
            const float* src = C.out + O_CMP_P + ((size_t)l * NTP + b * 2048 + 32 * n) * 512 + tid;
            const float* w = C.inp(20) + (l * 2 + kv) * 32;
            float acc = 0.f;
#pragma unroll 8
            for (int rr = 0; rr < 32; ++rr) acc += w[rr] * src[(size_t)rr * 512];
            const unsigned short hb = (unsigned short)(pk2(acc, 0.f) & 0xffffu);
            if (kv == 0) wsp<bf16>(C, WS_KCB)[((size_t)(b * 4 + kvh) * 64 + n) * 64 + d] = hb;
            else wsp<bf16>(C, WS_VCBT)[((size_t)(b * 4 + kvh) * 64 + d) * 64 + n] = hb;
            continue;
        }
        r -= PB_NPOOL;
        {
            const int which = r >> 9, b = (r >> 7) & 3, kvh = (r >> 5) & 3, tb = r & 31, d = tid & 63, tq = tid >> 6;
            const bf16* src = P + (size_t)(b * 2048 + 64 * tb + 8 * tq) * PLD + (which ? VW_OFF : VS_OFF) + kvh * 64 + d;
            unsigned short e[8];
#pragma unroll
            for (int i = 0; i < 8; ++i) e[i] = src[(size_t)i * PLD];
            v4u o; o.x = e[0] | ((unsigned)e[1] << 16); o.y = e[2] | ((unsigned)e[3] << 16); o.z = e[4] | ((unsigned)e[5] << 16); o.w = e[6] | ((unsigned)e[7] << 16);
            *(v4u*)(wsp<bf16>(C, which ? WS_VTW : WS_VTS) + ((size_t)(b * 4 + kvh) * 64 + d) * 2048 + 64 * tb + 8 * tq) = o;
        }
    }
    __syncthreads();
}

DI void scan_head(const Ctx& C, int l, int row0, int T, int h, const float* S0, float* Sout) {
    const int tid = C.tid, lane = C.lane, wave = C.wave;
    LAS float* STG = (LAS float*)C.lds;
    LAS float* YB = (LAS float*)(C.lds + 6 * 32 * 64 * 4);
    const float* SC = wsp<float>(C, WS_SC); constexpr size_t SS = SC_STRIDE / 4;
    const float* GG = wsp<float>(C, WS_GG); const float* BON = wsp<float>(C, WS_BON);
    bf16* MIX = wsp<bf16>(C, WS_MIX);
    const int r = 8 * wave + (lane >> 3), cg = lane & 7;
    float S[8];
    if (S0) { const f32x4 a = *(const f32x4*)(S0 + r * 64 + 8 * cg), b = *(const f32x4*)(S0 + r * 64 + 8 * cg + 4);
#pragma unroll
        for (int i = 0; i < 4; ++i) { S[i] = a[i]; S[4 + i] = b[i]; } }
    else {
#pragma unroll
        for (int i = 0; i < 8; ++i) S[i] = 0.f; }
    const int nch = (T + 31) >> 5;
    f32x4 pf[6];
#define SCAN_PREFETCH(cc) do { _Pragma("unroll") for (int k = 0; k < 6; ++k) { const int idx = tid + 512 * k, v6 = idx >> 9, rem = idx & 511, st = rem >> 4, f4 = rem & 15, step = (cc) * 32 + st; \
        pf[k] = step < T ? *(const f32x4*)(SC + v6 * SS + (size_t)(row0 + step) * 1024 + h * 64 + f4 * 4) : (f32x4){0.f, 0.f, 0.f, 0.f}; } } while (0)
    SCAN_PREFETCH(0);
    const float gng = C.inp(18)[l * 1024 + h * 64 + lane], gnb = C.inp(19)[l * 1024 + h * 64 + lane];
    for (int c = 0; c < nch; ++c) {
        __syncthreads();
#pragma unroll
        for (int k = 0; k < 6; ++k) ((LAS f32x4*)STG)[tid + 512 * k] = pf[k];
        __syncthreads();
        if (c + 1 < nch) SCAN_PREFETCH(c + 1);
        const int nst = (T - c * 32) < 32 ? (T - c * 32) : 32;
        for (int st = 0; st < nst; ++st) {
            const LAS f32x4* q = (const LAS f32x4*)STG + st * 16 + 2 * cg;
            const f32x4 k0 = q[0 * 512], k1 = q[0 * 512 + 1], d0 = q[1 * 512], d1 = q[1 * 512 + 1], b0 = q[2 * 512], b1 = q[2 * 512 + 1], m0 = q[3 * 512], m1 = q[3 * 512 + 1], r0 = q[4 * 512], r1 = q[4 * 512 + 1];
            const float vv = STG[(5 * 32 + st) * 64 + r];
            float sk = S[0] * k0[0];
#pragma unroll
            for (int i = 1; i < 4; ++i) sk += S[i] * k0[i];
#pragma unroll
            for (int i = 0; i < 4; ++i) sk += S[4 + i] * k1[i];
            sk += __shfl_xor(sk, 1); sk += __shfl_xor(sk, 2); sk += __shfl_xor(sk, 4);
#pragma unroll
            for (int i = 0; i < 4; ++i) { S[i] = S[i] * d0[i] + (vv * m0[i] - sk * b0[i]); S[4 + i] = S[4 + i] * d1[i] + (vv * m1[i] - sk * b1[i]); }
            float y = S[0] * r0[0];
#pragma unroll
            for (int i = 1; i < 4; ++i) y += S[i] * r0[i];
#pragma unroll
            for (int i = 0; i < 4; ++i) y += S[4 + i] * r1[i];
            y += __shfl_xor(y, 1); y += __shfl_xor(y, 2); y += __shfl_xor(y, 4);
            if (cg == 0) YB[st * 64 + r] = y;
        }
        __syncthreads();
#pragma unroll
        for (int qq = 0; qq < 4; ++qq) {
            const int st = wave * 4 + qq;
            if (st < nst) {
                const size_t m = (size_t)row0 + c * 32 + st;
                const float y = YB[st * 64 + lane];
                const float mean = wave_sum(y) * (1.f / 64.f);
                const float dv = y - mean;
                const float var = wave_sum(dv * dv) * (1.f / 64.f);
                const float yn = dv * (1.f / sqrtf(var + GN_EPS)) * gng + gnb;
                const float o = (yn + BON[m * 16 + h] * STG[(5 * 32 + st) * 64 + lane]) * GG[m * 1024 + h * 64 + lane];
                MIX[m * DM + h * 64 + lane] = (unsigned short)(pk2(o, 0.f) & 0xffffu);
            }
        }
    }
#undef SCAN_PREFETCH
    { f32x4 a, b;
#pragma unroll
        for (int i = 0; i < 4; ++i) { a[i] = S[i]; b[i] = S[4 + i]; }
        *(f32x4*)(Sout + r * 64 + 8 * cg) = a; *(f32x4*)(Sout + r * 64 + 8 * cg + 4) = b; }
}

#define MFMA32(a, b, c) __builtin_amdgcn_mfma_f32_32x32x16_bf16((a), (b), (c), 0, 0, 0)
DI bf16x8 pack8(const f32x16& p, int s) {
    v4u o; o.x = pk2(p[8 * s], p[8 * s + 1]); o.y = pk2(p[8 * s + 2], p[8 * s + 3]); o.z = pk2(p[8 * s + 4], p[8 * s + 5]); o.w = pk2(p[8 * s + 6], p[8 * s + 7]);
    return __builtin_bit_cast(bf16x8, o);
}
DI bf16x8 ld_vt(const bf16* p) {
    const v2u a = *(const v2u*)p, b = *(const v2u*)(p + 8);
    v4u o; o.x = a.x; o.y = a.y; o.z = b.x; o.w = b.y; return __builtin_bit_cast(bf16x8, o);
}
#define ATT_TILE(KROW_PTR, VT_PTR0, VT_PTR1, VALID_EXPR) do { \
        f32x16 a_ = zero16; \
        _Pragma("unroll") for (int s = 0; s < 4; ++s) { const bf16x8 kf = *(const bf16x8*)((KROW_PTR) + 16 * s + 8 * hi); a_ = MFMA32(kf, qf[s], a_); } \
        float tm = NEG_BIG; \
        _Pragma("unroll") for (int i = 0; i < 16; ++i) { const int key = key0 + crow(i, hi); const bool ok = (VALID_EXPR); a_[i] = ok ? a_[i] * 0.125f : NEG_BIG; tm = fmaxf(tm, a_[i]); } \
        tm = fmaxf(tm, __shfl_xor(tm, 32)); \
        const float mn = fmaxf(mrun, tm); const float sc_ = expf(mrun - mn); \
        float ps = 0.f; \
        _Pragma("unroll") for (int i = 0; i < 16; ++i) { const float p_ = a_[i] > -1e29f ? expf(a_[i] - mn) : 0.f; a_[i] = p_; ps += p_; } \
        ps += __shfl_xor(ps, 32); \
        lrun = lrun * sc_ + ps; mrun = mn; \
        _Pragma("unroll") for (int i = 0; i < 16; ++i) { oa[0][i] *= sc_; oa[1][i] *= sc_; } \
        _Pragma("unroll") for (int s = 0; s < 2; ++s) { const bf16x8 pb = pack8(a_, s); \
            oa[0] = MFMA32(ld_vt((VT_PTR0) + 16 * s + 4 * hi), pb, oa[0]); oa[1] = MFMA32(ld_vt((VT_PTR1) + 16 * s + 4 * hi), pb, oa[1]); } \
    } while (0)

DI void nsa_prompt_unit(const Ctx& C, int l, int b, int kvh, int qt) {
    const int tid = C.tid, lane = C.lane, wave = C.wave;
    const int g = wave & 3, th = wave >> 2, q = lane & 31, hi = lane >> 5;
    LAS float* IMP = (LAS float*)C.lds;
    LAS float* IMPV = (LAS float*)(C.lds + 65536);
    LAS unsigned* SELM = (LAS unsigned*)(C.lds + 65536 + 8192);
    const bf16* P = wsp<bf16>(C, WS_PROJ);
    const int tok = qt * 64 + th * 32 + q;
    const size_t m = (size_t)b * 2048 + tok;
    const int bk = b * 4 + kvh, head = kvh * 4 + g;
    f32x16 zero16;
#pragma unroll
    for (int i = 0; i < 16; ++i) zero16[i] = 0.f;
    bf16x8 qf[4];
#pragma unroll
    for (int s = 0; s < 4; ++s) qf[s] = *(const bf16x8*)(P + m * PLD + Q_OFF + head * 64 + 16 * s + 8 * hi);
    f32x16 out0 = zero16, out1 = zero16;
    const float g0 = sigmoidf_(bf2f(P[m * PLD + GL_OFF + head * 3 + 0])), g1 = sigmoidf_(bf2f(P[m * PLD + GL_OFF + head * 3 + 1])), g2 = sigmoidf_(bf2f(P[m * PLD + GL_OFF + head * 3 + 2]));
    __syncthreads();
    {
        const bf16* KCB = wsp<bf16>(C, WS_KCB) + (size_t)bk * 4096;
        const bf16* VCBT = wsp<bf16>(C, WS_VCBT) + (size_t)bk * 4096;
        f32x16 sc[2];
        const int nvalid = (tok + 1) >> 5;
        float mx = NEG_BIG;
#pragma unroll
        for (int tile = 0; tile < 2; ++tile) {
            f32x16 a_ = zero16;
#pragma unroll
            for (int s = 0; s < 4; ++s) { const bf16x8 kf = *(const bf16x8*)(KCB + (size_t)(tile * 32 + q) * 64 + 16 * s + 8 * hi); a_ = MFMA32(kf, qf[s], a_); }
#pragma unroll
            for (int i = 0; i < 16; ++i) { const int n = tile * 32 + crow(i, hi); a_[i] = n < nvalid ? a_[i] * 0.125f : NEG_BIG; mx = fmaxf(mx, a_[i]); }
            sc[tile] = a_;
        }
        mx = fmaxf(mx, __shfl_xor(mx, 32));
        float sum = 0.f;
#pragma unroll
        for (int tile = 0; tile < 2; ++tile)
#pragma unroll
            for (int i = 0; i < 16; ++i) { const float p_ = sc[tile][i] > -1e29f ? expf(sc[tile][i] - mx) : 0.f; sc[tile][i] = p_; sum += p_; }
        sum += __shfl_xor(sum, 32);
        const float inv = nvalid > 0 ? 1.f / sum : 0.f;
        f32x16 oc0 = zero16, oc1 = zero16;
#pragma unroll
        for (int tile = 0; tile < 2; ++tile) {
#pragma unroll
            for (int i = 0; i < 16; ++i) sc[tile][i] *= inv;
#pragma unroll
            for (int i4 = 0; i4 < 4; ++i4) { f32x4 v = {sc[tile][4 * i4], sc[tile][4 * i4 + 1], sc[tile][4 * i4 + 2], sc[tile][4 * i4 + 3]};
                *(LAS f32x4*)(IMP + ((size_t)(g * 64 + th * 32 + q)) * 64 + tile * 32 + 8 * i4 + 4 * hi) = v; }
#pragma unroll
            for (int s = 0; s < 2; ++s) { const bf16x8 pb = pack8(sc[tile], s);
                oc0 = MFMA32(ld_vt(VCBT + (size_t)q * 64 + tile * 32 + 16 * s + 4 * hi), pb, oc0);
                oc1 = MFMA32(ld_vt(VCBT + (size_t)(32 + q) * 64 + tile * 32 + 16 * s + 4 * hi), pb, oc1); }
        }
#pragma unroll
        for (int i = 0; i < 16; ++i) { out0[i] = g0 * oc0[i]; out1[i] = g0 * oc1[i]; }
    }
    __syncthreads();
    {
        const int tokl = tid >> 3, jq = tid & 7;
        float v[4];
#pragma unroll
        for (int e = 0; e < 4; ++e) v[e] = 0.f;
#pragma unroll
        for (int gg = 0; gg < 4; ++gg) { const f32x4 a = *(const LAS f32x4*)(IMP + (size_t)(gg * 64 + tokl) * 64 + 8 * jq), bq = *(const LAS f32x4*)(IMP + (size_t)(gg * 64 + tokl) * 64 + 8 * jq + 4);
            v[0] += a[0] + a[1]; v[1] += a[2] + a[3]; v[2] += bq[0] + bq[1]; v[3] += bq[2] + bq[3]; }
        const int cur = qt;
#pragma unroll
        for (int e = 0; e < 4; ++e) { const int j = 4 * jq + e; const bool forced = (j == 0) | (j == cur) | (j == cur - 1); v[e] = j > cur ? -1.f : (forced ? 1e4f : v[e]); }
        *(LAS f32x4*)(IMPV + tokl * 32 + 4 * jq) = (f32x4){v[0], v[1], v[2], v[3]};
        __syncthreads();
        int rank[4] = {0, 0, 0, 0};
#pragma unroll
        for (int jj4 = 0; jj4 < 8; ++jj4) { const f32x4 o = *(const LAS f32x4*)(IMPV + tokl * 32 + 4 * jj4);
#pragma unroll
            for (int u = 0; u < 4; ++u) { const int jp = 4 * jj4 + u; const float ov = o[u];
#pragma unroll
                for (int e = 0; e < 4; ++e) { const int j = 4 * jq + e; rank[e] += (ov > v[e] || (ov == v[e] && jp < j)) ? 1 : 0; } } }
        unsigned bits = 0;
#pragma unroll
        for (int e = 0; e < 4; ++e) if (rank[e] < 16 && v[e] >= 0.f) bits |= 1u << (4 * jq + e);
        bits |= __shfl_xor(bits, 1); bits |= __shfl_xor(bits, 2); bits |= __shfl_xor(bits, 4);
        if (jq == 0) SELM[tokl] = bits;
        __syncthreads();
    }
    const unsigned selm = SELM[th * 32 + q];
    {
        const bf16* VT = wsp<bf16>(C, WS_VTS) + (size_t)bk * 64 * 2048;
        f32x16 oa[2] = {zero16, zero16}; float mrun = NEG_BIG, lrun = 0.f;
        for (int j = 0; j <= qt; ++j) {
            const bool mine = (selm >> j) & 1u;
            if (!__any(mine)) continue;
#pragma unroll
            for (int tile = 0; tile < 2; ++tile) {
                const int key0 = j * 64 + tile * 32;
                ATT_TILE(P + ((size_t)b * 2048 + key0 + q) * PLD + KS_OFF + kvh * 64, VT + (size_t)q * 2048 + key0, VT + (size_t)(32 + q) * 2048 + key0, (mine && key <= tok));
            }
        }
        const float il = g1 / lrun;
#pragma unroll
        for (int i = 0; i < 16; ++i) { out0[i] += il * oa[0][i]; out1[i] += il * oa[1][i]; }
    }
    {
        const bf16* VT = wsp<bf16>(C, WS_VTW) + (size_t)bk * 64 * 2048;
        f32x16 oa[2] = {zero16, zero16}; float mrun = NEG_BIG, lrun = 0.f;
        for (int j = (qt > 8 ? qt - 8 : 0); j <= qt; ++j) {
#pragma unroll
            for (int tile = 0; tile < 2; ++tile) {
                const int key0 = j * 64 + tile * 32;
                ATT_TILE(P + ((size_t)b * 2048 + key0 + q) * PLD + KW_OFF + kvh * 64, VT + (size_t)q * 2048 + key0, VT + (size_t)(32 + q) * 2048 + key0, (key <= tok && key + 511 >= tok));
            }
        }
        const float il = g2 / lrun;
#pragma unroll
        for (int i = 0; i < 16; ++i) { out0[i] += il * oa[0][i]; out1[i] += il * oa[1][i]; }
    }
    bf16* MIX = wsp<bf16>(C, WS_MIX) + m * DM + 1024 + head * 64;
#pragma unroll
    for (int i4 = 0; i4 < 4; ++i4) {
        v2u o; o.x = pk2(out0[4 * i4], out0[4 * i4 + 1]); o.y = pk2(out0[4 * i4 + 2], out0[4 * i4 + 3]); *(v2u*)(MIX + 8 * i4 + 4 * hi) = o;
        o.x = pk2(out1[4 * i4], out1[4 * i4 + 1]); o.y = pk2(out1[4 * i4 + 2], out1[4 * i4 + 3]); *(v2u*)(MIX + 32 + 8 * i4 + 4 * hi) = o;
    }
}

template <class RowFn> DI void samp_block(const RowFn& rowptr, int nvalid, int kvh, const LAS float* QS, LAS float* PWw, int lane, float (&M)[4], float (&L)[4], float (&O)[4]) {
    float s[4] = {0.f, 0.f, 0.f, 0.f};
    const bool ok = lane < nvalid;
    if (ok) {
        const f32x4* kr = (const f32x4*)(rowptr(lane) + kvh * 64);
#pragma unroll 4
        for (int d4 = 0; d4 < 16; ++d4) { const f32x4 kq = kr[d4];
#pragma unroll
            for (int g = 0; g < 4; ++g) { const f32x4 qq = *(const LAS f32x4*)(QS + g * 64 + 4 * d4); s[g] += kq[0] * qq[0] + kq[1] * qq[1] + kq[2] * qq[2] + kq[3] * qq[3]; } }
    }
    float mb[4], lb[4];
#pragma unroll
    for (int g = 0; g < 4; ++g) { const float sv = ok ? s[g] : NEG_BIG; mb[g] = wave_max(sv); const float p = ok ? expf(sv - mb[g]) : 0.f; lb[g] = wave_sum(p); PWw[g * 64 + lane] = p; }
    LDS_WAIT(); asm volatile("" ::: "memory");
    float ob[4] = {0.f, 0.f, 0.f, 0.f};
    for (int r = 0; r < nvalid; ++r) { const float vv = rowptr(r)[256 + kvh * 64 + lane];
#pragma unroll
        for (int g = 0; g < 4; ++g) ob[g] += PWw[g * 64 + r] * vv; }
    LDS_WAIT(); asm volatile("" ::: "memory");
#pragma unroll
    for (int g = 0; g < 4; ++g) { const float mn = fmaxf(M[g], mb[g]); const float a = expf(M[g] - mn), bsc = expf(mb[g] - mn); L[g] = L[g] * a + lb[g] * bsc; O[g] = O[g] * a + ob[g] * bsc; M[g] = mn; }
}
DI float samp_combine(LAS float* WST, int tid, int lane, int wave, const float (&M)[4], const float (&L)[4], const float (&O)[4]) {
    __syncthreads();
#pragma unroll
    for (int g = 0; g < 4; ++g) { WST[wave * 264 + 8 + g * 64 + lane] = O[g]; if (lane == 0) { WST[wave * 264 + g] = M[g]; WST[wave * 264 + 4 + g] = L[g]; } }
    __syncthreads();
    float res = 0.f;
    if (tid < 256) { const int g = tid >> 6, d = tid & 63; float mm = NEG_BIG;
#pragma unroll
        for (int w = 0; w < 8; ++w) mm = fmaxf(mm, WST[w * 264 + g]);
        float ll = 0.f, oo = 0.f;
#pragma unroll
        for (int w = 0; w < 8; ++w) { const float e = expf(WST[w * 264 + g] - mm); ll += WST[w * 264 + 4 + g] * e; oo += WST[w * 264 + 8 + g * 64 + d] * e; }
        res = oo / ll; }
    return res;
}

DI void nsa_sample_item(const Ctx& C, int l, int b, int t, int kvh) {
    const int tid = C.tid, lane = C.lane, wave = C.wave;
    LAS float* F = (LAS float*)C.lds;
    LAS float *QS = F, *PC = F + 256, *IMPS = F + 2304, *RED = F + 2624, *RED2 = F + 2688, *OCP = F + 2752, *PW = F + 4800, *WST = F + 6848;
    LAS int* SELB = (LAS int*)(F + 2560);
    const bf16* P = wsp<bf16>(C, WS_PROJ);
    const size_t m = (size_t)NTP + b * 4 + t;
    __syncthreads();
    if (tid < 256) QS[tid] = bf2f(P[m * PLD + Q_OFF + kvh * 256 + tid]) * 0.125f;
    __syncthreads();
    float ocmp = 0.f;
    {
        const float* KC = wsp<float>(C, WS_KCBS) + ((size_t)((l * 8 + b) * 4 + kvh) * 512) * 64;
        const float* VC = wsp<float>(C, WS_VCBS) + ((size_t)((l * 8 + b) * 4 + kvh) * 512) * 64;
        float s[4] = {0.f, 0.f, 0.f, 0.f};
        const f32x4* kr = (const f32x4*)(KC + (size_t)tid * 64);
#pragma unroll 4
        for (int d4 = 0; d4 < 16; ++d4) { const f32x4 kq = kr[d4];
#pragma unroll
            for (int g = 0; g < 4; ++g) { const f32x4 qq = *(const LAS f32x4*)(QS + g * 64 + 4 * d4); s[g] += kq[0] * qq[0] + kq[1] * qq[1] + kq[2] * qq[2] + kq[3] * qq[3]; } }
#pragma unroll
        for (int g = 0; g < 4; ++g) { const float wm = wave_max(s[g]); if (lane == 0) RED[wave * 4 + g] = wm; }
        __syncthreads();
        float p[4];
#pragma unroll
        for (int g = 0; g < 4; ++g) { float mm = RED[g];
#pragma unroll
            for (int w = 1; w < 8; ++w) mm = fmaxf(mm, RED[w * 4 + g]);
            p[g] = expf(s[g] - mm); const float ws = wave_sum(p[g]); if (lane == 0) RED2[wave * 4 + g] = ws; }
        __syncthreads();
#pragma unroll
        for (int g = 0; g < 4; ++g) { float tot = 0.f;
#pragma unroll
            for (int w = 0; w < 8; ++w) tot += RED2[w * 4 + g];
            PC[g * 512 + tid] = p[g] / tot; }
        __syncthreads();
        if (tid < 256) IMPS[tid] = (PC[2 * tid] + PC[2 * tid + 1]) + (PC[512 + 2 * tid] + PC[512 + 2 * tid + 1]) + (PC[1024 + 2 * tid] + PC[1024 + 2 * tid + 1]) + (PC[1536 + 2 * tid] + PC[1536 + 2 * tid + 1]);
        { const int d = tid & 63, nq = tid >> 6; float acc[4] = {0.f, 0.f, 0.f, 0.f};
#pragma unroll 4
            for (int n = nq * 64; n < nq * 64 + 64; ++n) { const float vv = VC[(size_t)n * 64 + d];
#pragma unroll
                for (int g = 0; g < 4; ++g) acc[g] += PC[g * 512 + n] * vv; }
#pragma unroll
            for (int g = 0; g < 4; ++g) OCP[(nq * 4 + g) * 64 + d] = acc[g]; }
        __syncthreads();
        if (tid < 256) { const int g = tid >> 6, d = tid & 63;
#pragma unroll
            for (int nq = 0; nq < 8; ++nq) ocmp += OCP[(nq * 4 + g) * 64 + d];
            const int j = tid;
            if (j >= 1 && j <= 254) { const float v = IMPS[j]; int rank = 0;
                for (int jp = 1; jp <= 254; ++jp) { const float ov = IMPS[jp]; rank += (ov > v || (ov == v && jp < j)) ? 1 : 0; }
                if (rank < 13) SELB[rank] = j; }
            if (tid == 0) { SELB[13] = 0; SELB[14] = 255; SELB[15] = 256; }
        }
        __syncthreads();
    }
    float osel;
    {
        float M[4] = {NEG_BIG, NEG_BIG, NEG_BIG, NEG_BIG}, L[4] = {0.f, 0.f, 0.f, 0.f}, O[4] = {0.f, 0.f, 0.f, 0.f};
        const int* pt = (const int*)C.inp(4) + b * 128;
        for (int bi = 0; bi < 2; ++bi) {
            const int jb = __builtin_amdgcn_readfirstlane(SELB[2 * wave + bi]);
            if (jb < 256) { const int pid = pt[jb >> 1];
                const float* base = C.inp(3) + ((size_t)(l * NPOOL + pid) * 128 + (jb & 1) * 64) * 512;
                samp_block([&](int r) { return base + (size_t)r * 512; }, 64, kvh, QS, PW + wave * 256, lane, M, L, O);
            } else { const float* base = C.out + O_SEL_S + ((size_t)l * NTS + b * 4) * 512;
                samp_block([&](int r) { return base + (size_t)r * 512; }, t + 1, kvh, QS, PW + wave * 256, lane, M, L, O); }
        }
        osel = samp_combine(WST, tid, lane, wave, M, L, O);
    }
    float owin;
    {
        float M[4] = {NEG_BIG, NEG_BIG, NEG_BIG, NEG_BIG}, L[4] = {0.f, 0.f, 0.f, 0.f}, O[4] = {0.f, 0.f, 0.f, 0.f};
        const float* pre = C.inp(5) + (size_t)(l * 8 + b) * 262144;
        const float* nw = C.out + O_WIN_S + ((size_t)(l * 8 + b) * 512 + 508) * 512;
        samp_block([&](int r) { const int p = t + 1 + 64 * wave + r; return p <= 511 ? pre + (size_t)p * 512 : nw + (size_t)(p - 512) * 512; }, 64, kvh, QS, PW + wave * 256, lane, M, L, O);
        owin = samp_combine(WST, tid, lane, wave, M, L, O);
    }
    if (tid < 256) { const int g = tid >> 6, d = tid & 63, head = kvh * 4 + g;
        const float g0 = sigmoidf_(bf2f(P[m * PLD + GL_OFF + head * 3 + 0])), g1 = sigmoidf_(bf2f(P[m * PLD + GL_OFF + head * 3 + 1])), g2 = sigmoidf_(bf2f(P[m * PLD + GL_OFF + head * 3 + 2]));
        const float o = g0 * ocmp + g1 * osel + g2 * owin;
        wsp<bf16>(C, WS_MIX)[m * DM + 1024 + head * 64 + d] = (unsigned short)(pk2(o, 0.f) & 0xffffu); }
}

#ifndef C_MASK
#define C_MASK 7
#endif
constexpr int PC_SCAN_P = 64, PC_ATT_P = 512, PC_ATT_S = 128, PC_SCAN_S = 128, PC_ITEMS = PC_SCAN_P + PC_ATT_P + PC_ATT_S + PC_SCAN_S;
DI void phase_c(const Ctx& C0, int l) {
    LAS int* slot = (LAS int*)(C0.lds + MISC_OFF + 64);
    for (;;) {
        __syncthreads();
        if (C0.tid == 0) *slot = (int)atomicAdd(C0.ctl + CW_QUEUE + 64 * l, 1u);
        __syncthreads();
        int it = *slot;
        if (it >= PC_ITEMS) break;
        Ctx K = C0; { asm volatile("" : "+s"(K.ws), "+s"(K.out)); int t_ = K.tid; asm volatile("" : "+v"(t_)); K.tid = t_; K.lane = t_ & 63; K.wave = __builtin_amdgcn_readfirstlane(t_ >> 6); }
        const Ctx& C = K;
        if (it < PC_SCAN_P || it >= PC_SCAN_P + PC_ATT_P + PC_ATT_S) {
            int row0, T, h; const float* S0; float* So;
            if (it < PC_SCAN_P) { const int b = it >> 4; h = it & 15; row0 = b * 2048; T = 2048; S0 = nullptr; So = C.out + O_RW_P + ((size_t)(l * 4 + b) * 16 + h) * 4096; }
            else { const int u = it - (PC_SCAN_P + PC_ATT_P + PC_ATT_S), b = u >> 4; h = u & 15; row0 = NTP + b * 4; T = 4; S0 = C.inp(6) + ((size_t)(l * 8 + b) * 16 + h) * 4096; So = C.out + O_RW_S + ((size_t)(l * 8 + b) * 16 + h) * 4096; }
#if (C_MASK & 1)
            scan_head(C, l, row0, T, h, S0, So);
#endif
        } else if (it < PC_SCAN_P + PC_ATT_P) {
            const int u = it - PC_SCAN_P, qt = 31 - (u >> 4), bk = u & 15;
#if (C_MASK & 2)
            nsa_prompt_unit(C, l, bk >> 2, bk & 3, qt);
#endif
        } else {
            const int u = it - (PC_SCAN_P + PC_ATT_P);
#if (C_MASK & 4)
            nsa_sample_item(C, l, u >> 4, (u >> 2) & 3, u & 3);
#endif
        }
    }
    __syncthreads();
}

DI const float* xin_row(const Ctx& C, int l, size_t m) {
    if (l == 0) return m < (size_t)NTP ? C.inp(0) + m * DM : C.inp(1) + (m - NTP) * DM;
    return wsp<float>(C, WS_XF1) + m * DM;
}
DI void phase_e(const Ctx& C, int l) {
    const int lane = C.lane;
    const float* H = wsp<float>(C, WS_HS);
    float* X1F = wsp<float>(C, WS_X1F); bf16* X1B = wsp<bf16>(C, WS_X1B);
    const float* gw = C.inp(22) + (size_t)l * DM; const float* bw = C.inp(23) + (size_t)l * DM;
    for (int m = blockIdx.x * NWAVES + C.wave; m < NT; m += C.G * NWAVES) {
        const f32x4* xr = (const f32x4*)xin_row(C, l, m) + lane; const f32x4* hr = (const f32x4*)(H + (size_t)m * DM) + lane;
        f32x4 v[8]; float s = 0.f;
#pragma unroll
        for (int j = 0; j < 8; ++j) { v[j] = xr[64 * j] * DN_ALPHA + hr[64 * j]; s += (v[j][0] + v[j][1]) + (v[j][2] + v[j][3]); }
        const float mean = wave_sum(s) * (1.f / DM); float s2 = 0.f;
#pragma unroll
        for (int j = 0; j < 8; ++j) { v[j] = v[j] - mean; s2 += (v[j][0] * v[j][0] + v[j][1] * v[j][1]) + (v[j][2] * v[j][2] + v[j][3] * v[j][3]); }
        const float rstd = 1.f / sqrtf(wave_sum(s2) * (1.f / DM) + LN_EPS);
#pragma unroll
        for (int j = 0; j < 8; ++j) { const f32x4 gg = ((const f32x4*)gw)[lane + 64 * j], bb = ((const f32x4*)bw)[lane + 64 * j];
            const f32x4 o = v[j] * rstd * gg + bb;
            ((f32x4*)(X1F + (size_t)m * DM))[lane + 64 * j] = o;
            v2u p; p.x = pk2(o[0], o[1]); p.y = pk2(o[2], o[3]); ((v2u*)(X1B + (size_t)m * DM))[lane + 64 * j] = p; }
    }
}

DI float gelu_erf(float x) { return 0.5f * x * (1.f + erff(x * 0.70710678118654752f)); }
DI void phase_g(const Ctx& C, int l) {
    const int tid = C.tid, lane = C.lane, wave = C.wave;
    LAS float* FACC = (LAS float*)C.lds;
    LAS float* RED = (LAS float*)(C.lds + 65536);
    const float* Sc = wsp<float>(C, WS_HS);
    const float* X1F = wsp<float>(C, WS_X1F);
    const bf16* UB = wsp<bf16>(C, WS_UB) + (size_t)l * NEXP * DM; const bf16* VB = wsp<bf16>(C, WS_VB) + (size_t)l * NEXP * DM;
    const float* gw = C.inp(28) + (size_t)l * DM; const float* bw = C.inp(29) + (size_t)l * DM;
    for (int m = blockIdx.x; m < NT; m += C.G) {
        const float* sr = Sc + (size_t)m * DM + wave * 256;
        float a0 = sr[lane], a1 = sr[64 + lane], b0 = sr[128 + lane], b1 = sr[192 + lane];
        float hv0 = 0.f, hv1 = 0.f; int hi0 = 0, hi1 = 0;
        for (int r = 0; r < 16; ++r) {
            { const float wm = wave_max(fmaxf(a0, a1)); const int c = a0 == wm ? lane : (a1 == wm ? lane + 64 : (1 << 20)); const int wi = wave_min_i(c);
              if (lane == r) { hv0 = wm; hi0 = wi; } if (wi == lane) a0 = -INFINITY; if (wi == lane + 64) a1 = -INFINITY; }
            { const float wm = wave_max(fmaxf(b0, b1)); const int c = b0 == wm ? lane : (b1 == wm ? lane + 64 : (1 << 20)); const int wi = wave_min_i(c);
              if (lane == r) { hv1 = wm; hi1 = wi; } if (wi == lane) b0 = -INFINITY; if (wi == lane + 64) b1 = -INFINITY; }
        }
        float cd[4];
        { const float x0 = __shfl(hv0, lane >> 2);
#pragma unroll
          for (int jj = 0; jj < 4; ++jj) cd[jj] = x0 + __shfl(hv1, (lane & 3) * 4 + jj); }
        float tv = -INFINITY; int tpos = 0;
        for (int r = 0; r < 16; ++r) {
            const float wm = wave_max(fmaxf(fmaxf(cd[0], cd[1]), fmaxf(cd[2], cd[3])));
            const int c = cd[0] == wm ? lane * 4 : (cd[1] == wm ? lane * 4 + 1 : (cd[2] == wm ? lane * 4 + 2 : (cd[3] == wm ? lane * 4 + 3 : (1 << 20))));
            const int wp = wave_min_i(c);
            if (lane == r) { tv = wm; tpos = wp; }
            if ((wp >> 2) == lane) { const int e = wp & 3; cd[0] = e == 0 ? -INFINITY : cd[0]; cd[1] = e == 1 ? -INFINITY : cd[1]; cd[2] = e == 2 ? -INFINITY : cd[2]; cd[3] = e == 3 ? -INFINITY : cd[3]; }
        }
        const int ex = __shfl(hi0, tpos >> 4) * 128 + __shfl(hi1, tpos & 15);
        const float tmax = __shfl(tv, 0);
        const float ev = lane < 16 ? expf(tv - tmax) : 0.f;
        const float gate = ev / wave_sum(ev);
        float x[32];
        { const f32x4* xr = (const f32x4*)(X1F + (size_t)m * DM);
#pragma unroll
          for (int k = 0; k < 4; ++k) { const f32x4 a = xr[2 * lane + 128 * k], b = xr[2 * lane + 128 * k + 1];
#pragma unroll
              for (int e = 0; e < 4; ++e) { x[8 * k + e] = a[e]; x[8 * k + 4 + e] = b[e]; } } }
        float acc[32];
#pragma unroll
        for (int i = 0; i < 32; ++i) acc[i] = 0.f;
        for (int r = 0; r < 16; ++r) {
            const int e = __builtin_amdgcn_readfirstlane(__shfl(ex, r));
            const float gt = __shfl(gate, r);
            const v4u* ur = (const v4u*)(UB + (size_t)e * DM); const v4u* vr = (const v4u*)(VB + (size_t)e * DM);
            v4u uu[4], vv[4];
#pragma unroll
            for (int k = 0; k < 4; ++k) { uu[k] = ur[lane + 64 * k]; vv[k] = vr[lane + 64 * k]; }
            float dot = 0.f;
#pragma unroll
            for (int k = 0; k < 4; ++k) { dot += bflo(uu[k].x) * x[8 * k] + bfhi(uu[k].x) * x[8 * k + 1] + bflo(uu[k].y) * x[8 * k + 2] + bfhi(uu[k].y) * x[8 * k + 3]
                                               + bflo(uu[k].z) * x[8 * k + 4] + bfhi(uu[k].z) * x[8 * k + 5] + bflo(uu[k].w) * x[8 * k + 6] + bfhi(uu[k].w) * x[8 * k + 7]; }
            dot = wave_sum(dot);
            const float wgt = gt * gelu_erf(dot);
#pragma unroll
            for (int k = 0; k < 4; ++k) { acc[8 * k] += wgt * bflo(vv[k].x); acc[8 * k + 1] += wgt * bfhi(vv[k].x); acc[8 * k + 2] += wgt * bflo(vv[k].y); acc[8 * k + 3] += wgt * bfhi(vv[k].y);
                                           acc[8 * k + 4] += wgt * bflo(vv[k].z); acc[8 * k + 5] += wgt * bfhi(vv[k].z); acc[8 * k + 6] += wgt * bflo(vv[k].w); acc[8 * k + 7] += wgt * bfhi(vv[k].w); }
        }
        __syncthreads();
#pragma unroll
        for (int k = 0; k < 4; ++k) { *(LAS f32x4*)(FACC + wave * DM + 8 * lane + 512 * k) = (f32x4){acc[8 * k], acc[8 * k + 1], acc[8 * k + 2], acc[8 * k + 3]};
                                       *(LAS f32x4*)(FACC + wave * DM + 8 * lane + 512 * k + 4) = (f32x4){acc[8 * k + 4], acc[8 * k + 5], acc[8 * k + 6], acc[8 * k + 7]}; }
        __syncthreads();
        f32x4 y = ((const f32x4*)(X1F + (size_t)m * DM))[tid] * DN_ALPHA;
#pragma unroll
        for (int w = 0; w < 8; ++w) y = y + *(const LAS f32x4*)(FACC + w * DM + 4 * tid);
        float s = wave_sum((y[0] + y[1]) + (y[2] + y[3]));
        if (lane == 0) RED[wave] = s;
        __syncthreads();
        float tot = 0.f;
#pragma unroll
        for (int w = 0; w < 8; ++w) tot += RED[w];
        const float mean = tot * (1.f / DM);
        y = y - mean;
        float s2 = wave_sum((y[0] * y[0] + y[1] * y[1]) + (y[2] * y[2] + y[3] * y[3]));
        if (lane == 0) RED[8 + wave] = s2;
        __syncthreads();
        float tot2 = 0.f;
#pragma unroll
        for (int w = 0; w < 8; ++w) tot2 += RED[8 + w];
        const float rstd = 1.f / sqrtf(tot2 * (1.f / DM) + LN_EPS);
        const f32x4 o = y * rstd * ((const f32x4*)gw)[tid] + ((const f32x4*)bw)[tid];
        if (l == 0) { ((f32x4*)(wsp<float>(C, WS_XF1) + (size_t)m * DM))[tid] = o;
            v2u p; p.x = pk2(o[0], o[1]); p.y = pk2(o[2], o[3]); ((v2u*)(wsp<bf16>(C, WS_XB) + (size_t)m * DM))[tid] = p; }
        else { float* dst = m < NTP ? C.out + O_YP + (size_t)m * DM : C.out + O_YS + (size_t)(m - NTP) * DM; ((f32x4*)dst)[tid] = o; }
    }
    __syncthreads();
}

#ifndef PH_MASK
#define PH_MASK 0xFF
#endif
#define IN(k) (lo <= (k) && (k) < hi)
#define EN(s) ((PH_MASK >> (s)) & 1)
#define FRESH(CX) Ctx CX = C; { asm volatile("" : "+s"(CX.ws), "+s"(CX.out)); int t_ = CX.tid; asm volatile("" : "+v"(t_)); CX.tid = t_; CX.lane = t_ & 63; CX.wave = __builtin_amdgcn_readfirstlane(t_ >> 6); CX.ctl = (unsigned*)(CX.ws + WS_CTL); }
#define SEAM(k) do { if (IN(k) && IN((k) + 1)) xcd_barrier(bar); } while (0)
template <int l> DI void run_layer(const Ctx& C, const XcdBarrier& bar, int lo, int hi) {
        const int pb = 1 + 7 * l;
        if (EN(0) && IN(pb + 0)) {
            FRESH(K);
            pg8::Gemm g{wsp<bf16>(K, WS_XB), wsp<bf16>(K, WS_WIN) + (size_t)l * PLD * DM, MP, PLD, DM}; pg8::StaticOrder S; S.init(MP, PLD, K.G, (int)blockIdx.x);
            EpiInProj E{wsp<bf16>(K, WS_PROJ), K.out, l};
            pg8::gemm_phase<EpiInProj, pg8::StaticOrder, true, true>(K.lds, g, S, E);
        }
        SEAM(pb + 0);
        if (EN(1) && IN(pb + 1)) { FRESH(K); phase_b(K, l); }
        SEAM(pb + 1);
        if (EN(2) && IN(pb + 2)) { FRESH(K); phase_c(K, l); }
        SEAM(pb + 2);
        if (EN(3) && IN(pb + 3)) {
            FRESH(K);
            pg8::Gemm g{wsp<bf16>(K, WS_MIX), wsp<bf16>(K, WS_WOUT) + (size_t)l * DM * DM, MP, DM, DM}; pg8::StaticOrder S; S.init(MP, DM, K.G, (int)blockIdx.x);
            pg8::EpiF32 E{wsp<float>(K, WS_HS), DM, nullptr};
            pg8::gemm_phase<pg8::EpiF32, pg8::StaticOrder, true, true>(K.lds, g, S, E);
        }
        SEAM(pb + 3);
        if (EN(4) && IN(pb + 4)) { FRESH(K); phase_e(K, l); }
        SEAM(pb + 4);
        if (EN(5) && IN(pb + 5)) {
            FRESH(K);
            pg8::Gemm g{wsp<bf16>(K, WS_X1B), wsp<bf16>(K, WS_W2) + (size_t)l * DM * DM, MP, DM, DM}; pg8::StaticOrder S; S.init(MP, DM, K.G, (int)blockIdx.x);
            pg8::EpiF32 E{wsp<float>(K, WS_HS), DM, nullptr};
            pg8::gemm_phase<pg8::EpiF32, pg8::StaticOrder, true, true>(K.lds, g, S, E);
        }
        SEAM(pb + 5);
        if (EN(6) && IN(pb + 6)) { FRESH(K); phase_g(K, l); }
        SEAM(pb + 6);
}
typedef ArgsK Args;
__global__ void __launch_bounds__(NTHREADS, 2) fwd_kernel(Args args) {
    extern __shared__ __attribute__((aligned(16))) unsigned char lds[];
    Ctx C;
    C.out = args.out; C.ws = args.ws; C.lds = (LAS unsigned char*)lds; C.ctl = (unsigned*)(args.ws + WS_CTL);
    C.tid = threadIdx.x; C.lane = C.tid & 63; C.wave = __builtin_amdgcn_readfirstlane(C.tid >> 6); C.G = gridDim.x;
    volatile LAS unsigned* MISC = (volatile LAS unsigned*)(C.lds + MISC_OFF);
    for (int u = C.tid; u < (LDS_BYTES - RING_BYTES) / 4; u += NTHREADS) ((LAS unsigned*)(C.lds + RING_BYTES))[u] = 0u;
    __syncthreads();
    XcdBarrier bar; bar.bar = C.ctl + CW_BAR; bar.x = 0; bar.st = nullptr;
    if (args.use_bar) bar = xcd_barrier_post(C.ctl + CW_BAR, MISC + 8);
    const int lo = args.ph_lo, hi = args.ph_hi;
    if (EN(7) && IN(0)) { FRESH(K); p0_prologue(K); }
    SEAM(0);
    run_layer<0>(C, bar, lo, hi);
    run_layer<1>(C, bar, lo, hi);
#undef IN
#undef SEAM
}

#ifndef MK_ONE_LAUNCH
#define MK_ONE_LAUNCH 0
#endif
extern "C" void kernel_launch(void* const* d_in, const int* in_sizes, int n_in, void* d_out, int out_size, void* d_ws, size_t ws_size, hipStream_t stream) {
    static int grid = 0;
    if (grid == 0) {
        if (n_in != 30 || out_size != (int)O_END || ws_size < WS_END) { fprintf(stderr, "kernel_launch: unexpected shapes (n_in %d, out %d, ws %zu < %zu); nothing launched\n", n_in, out_size, ws_size, (size_t)WS_END); grid = -1; return; }
        int dev = 0, cus = 0, per_cu = 0;
        if (hipGetDevice(&dev) != hipSuccess || hipDeviceGetAttribute(&cus, hipDeviceAttributeMultiprocessorCount, dev) != hipSuccess) { grid = -1; return; }
        if (hipFuncSetAttribute((const void*)fwd_kernel, hipFuncAttributeMaxDynamicSharedMemorySize, LDS_BYTES) != hipSuccess) { fprintf(stderr, "kernel_launch: hipFuncSetAttribute failed\n"); grid = -1; return; }
        if (hipOccupancyMaxActiveBlocksPerMultiprocessor(&per_cu, (const void*)fwd_kernel, NTHREADS, LDS_BYTES) != hipSuccess || per_cu < 1) { fprintf(stderr, "kernel_launch: occupancy query says %d blocks per CU\n", per_cu); }
        (void)hipGetLastError();
        grid = cus;
    }
    if (grid < 0) return;
    if (hipMemsetAsync((char*)d_ws + WS_CTL, 0, CTL_ZERO_BYTES, stream) != hipSuccess) return;
    Args a{};
    for (int i = 0; i < 30; ++i) a.in[i] = (const float*)d_in[i];
    a.out = (float*)d_out; a.ws = (unsigned char*)d_ws;
#if MK_ONE_LAUNCH
    a.ph_lo = 0; a.ph_hi = N_PHASES; a.use_bar = 1;
    hipLaunchKernelGGL(fwd_kernel, dim3(grid), dim3(NTHREADS), LDS_BYTES, stream, a);
#else
    for (int p = 0; p < N_PHASES; ++p) { a.ph_lo = p; a.ph_hi = p + 1; a.use_bar = 0; hipLaunchKernelGGL(fwd_kernel, dim3(grid), dim3(NTHREADS), LDS_BYTES, stream, a); }
#endif
}
```

```cpp
#include <hip/hip_runtime.h>
#include <cstdio>
#include <cstdint>
namespace pg8 {
#define PG8_LAS __attribute__((address_space(3)))
typedef unsigned short bf16_t;
typedef short bf16x8 __attribute__((ext_vector_type(8)));
typedef float f32x4 __attribute__((ext_vector_type(4)));
typedef unsigned u32x4 __attribute__((ext_vector_type(4)));
constexpr int BM = 256, BK = 64, HALF = 128, HTB = HALF * BK * 2  , STAGE_BYTES = 8 * HTB, NXCD = 8, WGM = 8;

__host__ __device__ __forceinline__ int lds_byte(int r, int c) { const int st = (r >> 4) * 2 + (c >> 5), rr = r & 15, cc = c & 31, ob = rr * 64 + cc * 2; return st * 1024 + (ob ^ (((ob >> 9) & 1) << 5)); }
__host__ __device__ __forceinline__ void stage_rc(int b, int& R, int& C) { const int st = b / 1024, sb = b % 1024, swz = sb ^ (((sb >> 9) & 1) << 5); R = (st >> 1) * 16 + swz / 64; C = (st & 1) * 32 + (swz % 64) / 2; }
__host__ __device__ __forceinline__ int perm32(int rho) { const int n = rho >> 4, i = rho & 15; return 8 * (i >> 2) + 4 * n + (i & 3); }

struct Unit { int pm, pn; };
struct Gemm { const bf16_t* A; const bf16_t* Bt; int M, N, K; };

struct StaticOrder {
    int nM, nN, nwg, G, c;
    __host__ __device__ void init(int M, int N, int G_, int c_) { nM = M / BM; nN = N / BM; nwg = nM * nN; G = G_; c = c_; }
    __host__ __device__ bool next(int i, Unit& u) const {
        const long L = (long)i * G + c; if (L >= nwg) return false;
        int wgid = (int)L; { const int q = nwg / NXCD, r = nwg % NXCD, xcd = wgid % NXCD, off = wgid / NXCD; wgid = (xcd < r ? xcd * (q + 1) : r * (q + 1) + (xcd - r) * q) + off; }
        const int nig = WGM * nN, gid = wgid / nig, fm = gid * WGM, gsz = (nM - fm) < WGM ? (nM - fm) : WGM;
        u.pm = fm + ((wgid % nig) % gsz); u.pn = (wgid % nig) / gsz; return true;
    }
    __device__ __forceinline__ void a_ready(const Unit&) const {}
    __device__ __forceinline__ void done(const Unit&) const {}
};

__device__ __forceinline__ unsigned cvt_pk_bf16(float lo, float hi) { unsigned r; asm volatile("v_cvt_pk_bf16_f32 %0, %1, %2" : "=v"(r) : "v"(lo), "v"(hi)); return r; }
typedef float f32x2 __attribute__((ext_vector_type(2)));
struct EpiF32 {
    static constexpr bool PERM = false, AFTER_DRAIN = false;
    float* C; int ldc; const float* bias;
    __device__ __forceinline__ void operator()(const f32x4 (&acc)[2][2][4][2], const Unit& u, int wr, int wc, int fr, int fq) const {
        const int row0 = u.pm * BM + wr * 64 + fr, col0 = u.pn * BM + wc * 32 + 4 * fq;
        f32x4 bv[2][2];
#pragma unroll
        for (int bj = 0; bj < 2; ++bj)
#pragma unroll
            for (int n = 0; n < 2; ++n) bv[bj][n] = bias ? *(const f32x4*)(bias + col0 + bj * HALF + n * 16) : (f32x4){0.f, 0.f, 0.f, 0.f};
#pragma unroll
        for (int ai = 0; ai < 2; ++ai)
#pragma unroll
            for (int m = 0; m < 4; ++m) { float* rowp = C + (size_t)(row0 + ai * HALF + m * 16) * ldc + col0;
#pragma unroll
                for (int bj = 0; bj < 2; ++bj)
#pragma unroll
                    for (int n = 0; n < 2; ++n) *(f32x4*)(rowp + bj * HALF + n * 16) = acc[ai][bj][m][n] + bv[bj][n]; }
    }
};
template <class Epi, class Sched, bool ALIGN_EPI = false, bool SP2 = false>
__device__ __forceinline__ void gemm_phase(PG8_LAS unsigned char* lds, const Gemm g, const Sched& S, const Epi& E) {
    const int tid = threadIdx.x, wid = __builtin_amdgcn_readfirstlane(tid >> 6), lane = tid & 63, wr = wid >> 2, wc = wid & 3, fr = lane & 15, fq = lane >> 4;
    const int K = g.K, nt = K / BK;
    unsigned voffA[2], voffB[2];
#pragma unroll
    for (int i = 0; i < 2; ++i) { int R, C; stage_rc(tid * 16 + i * 8192, R, C); const int Rb = Epi::PERM ? ((R & ~31) + perm32(R & 31)) : R;
        voffA[i] = (unsigned)(R * K + C) * 2u; voffB[i] = (unsigned)(Rb * K + C) * 2u; }
    const size_t kstep = (size_t)(BK * 2);
    const size_t hstep = (size_t)HALF * K * 2;
    const size_t tstep = 2 * hstep;
    const unsigned ldsw = (unsigned)wid * 1024u;
    const int aoff = lds_byte(wr * 64 + fr, fq * 8), boff = lds_byte(wc * 32 + fr, fq * 8);
#define PG8_SA(b, h) (((b) * 2 + (h)) * HTB)
#define PG8_SB(b, h) ((4 + (b) * 2 + (h)) * HTB)
#define PG8_STAGE(bufoff, gbase, voff) do { _Pragma("unroll") for (int _i = 0; _i < 2; ++_i) \
        __builtin_amdgcn_global_load_lds((const unsigned*)((const char*)(gbase) + (voff)[_i]), (PG8_LAS unsigned*)(lds + (bufoff) + ldsw + _i * 8192), 16, 0, 0); } while (0)
#define PG8_LDA(dst, b, h) do { _Pragma("unroll") for (int m = 0; m < 4; ++m) _Pragma("unroll") for (int k = 0; k < 2; ++k) dst[m][k] = *(const PG8_LAS bf16x8*)(lds + PG8_SA(b, h) + aoff + m * 2048 + k * 1024); } while (0)
#define PG8_LDB(dst, b, h) do { _Pragma("unroll") for (int n = 0; n < 2; ++n) _Pragma("unroll") for (int k = 0; k < 2; ++k) dst[n][k] = *(const PG8_LAS bf16x8*)(lds + PG8_SB(b, h) + boff + n * 2048 + k * 1024); } while (0)
#define PG8_MMA(ai, bj, At, Bt) do { __builtin_amdgcn_s_setprio(1); _Pragma("unroll") for (int m = 0; m < 4; ++m) _Pragma("unroll") for (int n = 0; n < 2; ++n) _Pragma("unroll") for (int k = 0; k < 2; ++k) \
        acc[ai][bj][m][n] = __builtin_amdgcn_mfma_f32_16x16x32_bf16(Bt[n][k], At[m][k], acc[ai][bj][m][n], 0, 0, 0); __builtin_amdgcn_s_setprio(0); } while (0)
#define PG8_WAIT_V(n) asm volatile("s_waitcnt vmcnt(" #n ")" ::: "memory")
#define PG8_WAIT_L(n) asm volatile("s_waitcnt lgkmcnt(" #n ")" ::: "memory")
#define PG8_BAR __builtin_amdgcn_s_barrier()
#define PG8_SCHED __builtin_amdgcn_sched_barrier(0)
    Unit cur, nxt; int ui = 0;
    if (!S.next(0, cur)) return;
    f32x4 acc[2][2][4][2];
#pragma unroll
    for (int a = 0; a < 2; ++a)
#pragma unroll
        for (int b = 0; b < 2; ++b)
#pragma unroll
            for (int m = 0; m < 4; ++m)
#pragma unroll
                for (int n = 0; n < 2; ++n) acc[a][b][m][n] = (f32x4){0.f, 0.f, 0.f, 0.f};
    bf16x8 At[4][2], B0[2][2], B1[2][2];
    const char* cA = (const char*)g.A + (size_t)cur.pm * tstep; const char* cB = (const char*)g.Bt + (size_t)cur.pn * tstep;
    S.a_ready(cur);
    if constexpr (SP2) {
        PG8_STAGE(PG8_SB(0, 0), cB, voffB); PG8_STAGE(PG8_SB(0, 1), cB + hstep, voffB); PG8_STAGE(PG8_SA(0, 0), cA, voffA); PG8_STAGE(PG8_SA(0, 1), cA + hstep, voffA);
        if (wr == 1) PG8_BAR;
        PG8_WAIT_V(2); PG8_BAR;
        PG8_STAGE(PG8_SB(1, 0), cB + kstep, voffB); PG8_STAGE(PG8_SA(1, 0), cA + kstep, voffA); PG8_STAGE(PG8_SB(1, 1), cB + hstep + kstep, voffB);
        PG8_WAIT_V(6); PG8_BAR;
    } else {
        PG8_STAGE(PG8_SB(0, 0), cB, voffB); PG8_STAGE(PG8_SA(0, 0), cA, voffA); PG8_STAGE(PG8_SB(0, 1), cB + hstep, voffB); PG8_STAGE(PG8_SA(0, 1), cA + hstep, voffA);
        if (wr == 1) PG8_BAR;
        PG8_WAIT_V(4); PG8_BAR;
        PG8_STAGE(PG8_SB(1, 0), cB + kstep, voffB); PG8_STAGE(PG8_SA(1, 0), cA + kstep, voffA); PG8_STAGE(PG8_SB(1, 1), cB + hstep + kstep, voffB);
        PG8_WAIT_V(6); PG8_BAR;
    }
    for (;;) {
        const bool has_next = S.next(ui + 1, nxt);
        const char* nA = has_next ? (const char*)g.A + (size_t)nxt.pm * tstep : cA; const char* nB = has_next ? (const char*)g.Bt + (size_t)nxt.pn * tstep : cB;
        for (int t = 0; t < nt; t += 2) {
            const bool last = (t == nt - 2);
            const char* a1 = cA + (size_t)(t + 1) * kstep;
            const char* a2 = last ? nA : cA + (size_t)(t + 2) * kstep; const char* b2 = last ? nB : cB + (size_t)(t + 2) * kstep;
            const char* a3 = a2 + kstep; const char* b3 = b2 + kstep;
            if (last && has_next) S.a_ready(nxt);
            if constexpr (SP2) {
            PG8_LDB(B0, 0, 0); PG8_LDB(B1, 0, 1); PG8_SCHED; PG8_LDA(At, 0, 0); PG8_STAGE(PG8_SA(1, 1), a1 + hstep, voffA);
            PG8_WAIT_V(8); PG8_WAIT_L(0); PG8_BAR; PG8_MMA(0, 0, At, B0); PG8_MMA(0, 1, At, B1); PG8_BAR; PG8_SCHED;
            PG8_LDA(At, 0, 1); PG8_STAGE(PG8_SB(0, 0), b2, voffB); PG8_STAGE(PG8_SB(0, 1), b2 + hstep, voffB); PG8_STAGE(PG8_SA(0, 0), a2, voffA);
            PG8_WAIT_V(8); PG8_WAIT_L(0); PG8_BAR; PG8_MMA(1, 0, At, B0); PG8_MMA(1, 1, At, B1); PG8_BAR; PG8_SCHED;
            PG8_LDB(B0, 1, 0); PG8_LDB(B1, 1, 1); PG8_SCHED; PG8_LDA(At, 1, 0); PG8_STAGE(PG8_SA(0, 1), a2 + hstep, voffA);
            PG8_WAIT_V(8); PG8_WAIT_L(0); PG8_BAR; PG8_MMA(0, 0, At, B0); PG8_MMA(0, 1, At, B1); PG8_BAR; PG8_SCHED;
            PG8_LDA(At, 1, 1); PG8_STAGE(PG8_SB(1, 0), b3, voffB); PG8_STAGE(PG8_SB(1, 1), b3 + hstep, voffB); PG8_STAGE(PG8_SA(1, 0), a3, voffA);
            PG8_WAIT_V(8); PG8_WAIT_L(0); PG8_BAR; PG8_MMA(1, 0, At, B0); PG8_MMA(1, 1, At, B1); PG8_BAR; PG8_SCHED;
            } else {
            PG8_LDB(B0, 0, 0); PG8_SCHED; PG8_LDA(At, 0, 0); PG8_STAGE(PG8_SA(1, 1), a1 + hstep, voffA);
            PG8_WAIT_L(8); PG8_BAR; PG8_WAIT_L(0); PG8_MMA(0, 0, At, B0); PG8_BAR; PG8_SCHED;
            PG8_LDB(B1, 0, 1); PG8_STAGE(PG8_SB(0, 0), b2, voffB);
            PG8_BAR; PG8_WAIT_L(0); PG8_MMA(0, 1, At, B1); PG8_BAR;
            PG8_LDA(At, 0, 1); PG8_STAGE(PG8_SA(0, 0), a2, voffA);
            PG8_BAR; PG8_WAIT_L(0); PG8_MMA(1, 0, At, B0); PG8_BAR; PG8_SCHED;
            PG8_STAGE(PG8_SB(0, 1), b2 + hstep, voffB);
            PG8_WAIT_V(6); PG8_BAR; PG8_MMA(1, 1, At, B1); PG8_BAR;
            PG8_LDB(B0, 1, 0); PG8_SCHED; PG8_LDA(At, 1, 0); PG8_STAGE(PG8_SA(0, 1), a2 + hstep, voffA);
            PG8_WAIT_L(8); PG8_BAR; PG8_WAIT_L(0); PG8_MMA(0, 0, At, B0); PG8_BAR; PG8_SCHED;
            PG8_LDB(B1, 1, 1); PG8_STAGE(PG8_SB(1, 0), b3, voffB);
            PG8_BAR; PG8_WAIT_L(0); PG8_MMA(0, 1, At, B1); PG8_BAR;
            PG8_LDA(At, 1, 1); PG8_STAGE(PG8_SA(1, 0), a3, voffA);
            PG8_BAR; PG8_WAIT_L(0); PG8_MMA(1, 0, At, B0); PG8_BAR; PG8_SCHED;
            PG8_STAGE(PG8_SB(1, 1), b3 + hstep, voffB);
            PG8_WAIT_V(6); PG8_BAR; PG8_MMA(1, 1, At, B1); PG8_BAR;
            }
        }
        if constexpr (ALIGN_EPI) { if (wr == 0) PG8_BAR; }
        if constexpr (!Epi::AFTER_DRAIN) { E(acc, cur, wr, wc, fr, fq); S.done(cur); }
        if (!has_next) break;
#pragma unroll
        for (int a = 0; a < 2; ++a)
#pragma unroll
            for (int b = 0; b < 2; ++b)
#pragma unroll
                for (int m = 0; m < 4; ++m)
#pragma unroll
                    for (int n = 0; n < 2; ++n) acc[a][b][m][n] = (f32x4){0.f, 0.f, 0.f, 0.f};
        cur = nxt; cA = nA; cB = nB; ++ui;
        if constexpr (ALIGN_EPI) { if (wr == 1) PG8_BAR; }
    }
    PG8_WAIT_V(0);
    if constexpr (!ALIGN_EPI) { if (wr == 0) PG8_BAR; }
    PG8_BAR;
    if constexpr (Epi::AFTER_DRAIN) { E.fused(acc, cur, wr, wc, fr, fq, lds, wid, lane); S.done(cur); }
#undef PG8_SA
#undef PG8_SB
#undef PG8_STAGE
#undef PG8_LDA
#undef PG8_LDB
#undef PG8_MMA
#undef PG8_WAIT_V
#undef PG8_WAIT_L
#undef PG8_BAR
#undef PG8_SCHED
}
}
#define LAS __attribute__((address_space(3)))
#define XB_TMO      128
#define XB_XCNT(j)  (256  + 64 * (j))
#define XB_XSUB(j)  (1280 + 64 * (j))
#define XB_XGEN(j)  (2304 + 64 * (j))
#define XB_TOP      3328
#define XB_TOPGEN   3392
#define XCD_BAR_WORDS 3456
#define XB_SPIN_CAP (1u << 18)

__device__ __forceinline__ unsigned xb_ld(unsigned* p)              { return __hip_atomic_load(p, __ATOMIC_RELAXED, __HIP_MEMORY_SCOPE_AGENT); }
__device__ __forceinline__ unsigned xb_add(unsigned* p, unsigned v) { return __hip_atomic_fetch_add(p, v, __ATOMIC_RELAXED, __HIP_MEMORY_SCOPE_AGENT); }
__device__ __forceinline__ unsigned xb_xcc_id() { return (unsigned)__builtin_amdgcn_s_getreg((3 << 11) | 20) & 0xFu; }
#define XB_SPIN(cond, bar) do { unsigned _sp = 0; while (cond) { __builtin_amdgcn_s_sleep(1); \
    if ((++_sp & 255u) == 0u) { if (xb_ld(&(bar)[XB_TMO])) break; if (_sp > XB_SPIN_CAP) { atomicAdd(&(bar)[XB_TMO], 1u); break; } } } } while (0)

struct XcdBarrier {
    unsigned* bar; unsigned x;
    volatile LAS unsigned* st;
};

__device__ __forceinline__ XcdBarrier xcd_barrier_post(unsigned* bar, volatile LAS unsigned* st) {
    XcdBarrier b; b.bar = bar; b.x = xb_xcc_id(); b.st = st;
    if (threadIdx.x == 0) (void)xb_add(&bar[XB_XCNT(b.x)], 1u);
    return b;
}
__device__ __forceinline__ void xcd_barrier_complete(unsigned* bar, unsigned x, unsigned& nloc, unsigned& nx) {
    const unsigned G = gridDim.x * gridDim.y * gridDim.z;
    unsigned sum, cnt, mine, sp = 0u;
    for (;;) {
        sum = 0u; cnt = 0u; mine = 0u;
#pragma unroll
        for (unsigned j = 0; j < 16; ++j) { const unsigned c = xb_ld(&bar[XB_XCNT(j)]); sum += c; cnt += (c > 0u) ? 1u : 0u; mine = (j == x) ? c : mine; }
        if (sum == G) break;
        __builtin_amdgcn_s_sleep(1);
        if ((++sp & 255u) == 0u) { if (xb_ld(&bar[XB_TMO])) break; if (sp > XB_SPIN_CAP) { atomicAdd(&bar[XB_TMO], 1u); break; } }
    }
    nloc = mine > 0u ? mine : 1u; nx = cnt > 0u ? cnt : 1u;
}

__device__ __forceinline__ void xcd_barrier(const XcdBarrier& b) {
    asm volatile("s_waitcnt vmcnt(0)" ::: "memory");
    __syncthreads();
    if (threadIdx.x == 0) {
        unsigned* bar = b.bar;
        __builtin_amdgcn_s_waitcnt(0);
        unsigned nloc = b.st[0], nx = b.st[1];
        if (nloc == 0u) { xcd_barrier_complete(bar, b.x, nloc, nx); b.st[0] = nloc; b.st[1] = nx; }
        const unsigned old = xb_add(&bar[XB_XSUB(b.x)], 1u);
        const unsigned gen = old / nloc;
        if (old + 1u == (gen + 1u) * nloc) {
            __builtin_amdgcn_fence(__ATOMIC_RELEASE, "agent");
            asm volatile("s_waitcnt vmcnt(0)" ::: "memory");
            const unsigned og = xb_add(&bar[XB_TOP], 1u);
            const unsigned tg = og / nx;
            if (og + 1u == (tg + 1u) * nx) xb_add(&bar[XB_TOPGEN], 1u);
            else XB_SPIN(xb_ld(&bar[XB_TOPGEN]) == tg, bar);
            __builtin_amdgcn_fence(__ATOMIC_ACQUIRE, "agent");
            xb_add(&bar[XB_XGEN(b.x)], 1u);
            asm volatile("s_waitcnt vmcnt(0)" ::: "memory");
        } else {
            XB_SPIN(xb_ld(&bar[XB_XGEN(b.x)]) == gen, bar);
            __builtin_amdgcn_fence(__ATOMIC_ACQUIRE, "agent");
            asm volatile("s_waitcnt vmcnt(0)" ::: "memory");
        }
    }
    __syncthreads();
}

constexpr int NWAVES = 8, NTHREADS = 512;
constexpr int DM = 2048, NTP = 8192, NTS = 32, NT = 8224, MP = 8448;
constexpr int RW_COLS = 3360, Q_OFF = 3360, KC_OFF = 4384, KS_OFF = 4896, VS_OFF = 5152, KW_OFF = 5408, VW_OFF = 5664, GL_OFF = 5920, IN_COLS = 5968, PLD = 6144;
constexpr int NEXP = 16384, NPOOL = 1280;
constexpr float LN_EPS = 1e-5f, GN_EPS = 64e-5f, DN_ALPHA = 1.4142135623730951f;
constexpr float NEG_BIG = -1e30f;
constexpr size_t O_YP = 0, O_YS = O_YP + (size_t)NTP * DM, O_CMP_P = O_YS + (size_t)NTS * DM, O_SEL_P = O_CMP_P + (size_t)2 * NTP * 512, O_WIN_P = O_SEL_P + (size_t)2 * NTP * 512,
                 O_RW_P = O_WIN_P + (size_t)2 * 4 * 512 * 512, O_SH_P = O_RW_P + (size_t)2 * 4 * 16 * 4096, O_CMP_S = O_SH_P + (size_t)2 * 4 * RW_COLS, O_SEL_S = O_CMP_S + (size_t)2 * NTS * 512,
                 O_WIN_S = O_SEL_S + (size_t)2 * NTS * 512, O_RW_S = O_WIN_S + (size_t)2 * 8 * 512 * 512, O_SH_S = O_RW_S + (size_t)2 * 8 * 16 * 4096, O_END = O_SH_S + (size_t)2 * 8 * RW_COLS;
static_assert(O_END == 41630464, "output size");
constexpr size_t MiB = 1ull << 20;
constexpr size_t WS_CTL = 0, CTL_ZERO_BYTES = 1 * MiB;
constexpr size_t WS_WIN = 1 * MiB;
constexpr size_t WS_WOUT = WS_WIN + 48 * MiB;
constexpr size_t WS_W2 = WS_WOUT + 16 * MiB;
constexpr size_t WS_UB = WS_W2 + 16 * MiB;
constexpr size_t WS_VB = WS_UB + 128 * MiB;
constexpr size_t WS_XB = WS_VB + 128 * MiB;
constexpr size_t WS_X1B = WS_XB + 33 * MiB;
constexpr size_t WS_XF1 = WS_X1B + 33 * MiB;
constexpr size_t WS_X1F = WS_XF1 + 65 * MiB;
constexpr size_t WS_PROJ = WS_X1F + 65 * MiB;
constexpr size_t WS_SC = WS_PROJ + 99 * MiB;
constexpr size_t SC_STRIDE = 33 * MiB;
constexpr size_t WS_GG = WS_SC + 6 * SC_STRIDE;
constexpr size_t WS_BON = WS_GG + 33 * MiB;
constexpr size_t WS_MIX = WS_BON + 1 * MiB;
constexpr size_t WS_HS = WS_MIX + 33 * MiB;
constexpr size_t WS_KCB = WS_HS + 66 * MiB;
constexpr size_t WS_VCBT = WS_KCB + 512 * 1024;
constexpr size_t WS_VTS = WS_KCB + 1 * MiB;
constexpr size_t WS_VTW = WS_VTS + 4 * MiB;
constexpr size_t WS_KCBS = WS_VTW + 4 * MiB;
constexpr size_t WS_VCBS = WS_KCBS + 17 * MiB;
constexpr size_t WS_END = WS_VCBS + 17 * MiB;
constexpr int CW_BAR = 4096, CW_QUEUE = 8192;
constexpr int RING_BYTES = 131072, MISC_OFF = RING_BYTES + 320, LDS_BYTES = 147456;
constexpr int N_PHASES = 15;

typedef unsigned short bf16;
typedef unsigned v4u __attribute__((ext_vector_type(4)));
typedef unsigned v2u __attribute__((ext_vector_type(2)));
typedef float f32x4 __attribute__((ext_vector_type(4)));
typedef float f32x16 __attribute__((ext_vector_type(16)));
typedef short bf16x8 __attribute__((ext_vector_type(8)));
typedef float f32x2_t __attribute__((ext_vector_type(2)));
typedef __bf16 bf16x2_t __attribute__((ext_vector_type(2)));
#define LDS_WAIT() asm volatile("s_waitcnt lgkmcnt(0)" ::: "memory")
#define DI __device__ __forceinline__

DI unsigned pk2(float lo, float hi) { f32x2_t v = {lo, hi}; bf16x2_t b = __builtin_convertvector(v, bf16x2_t); return __builtin_bit_cast(unsigned, b); }
DI float bf2f(unsigned short u) { return __builtin_bit_cast(float, (unsigned)u << 16); }
DI float bflo(unsigned u) { return __builtin_bit_cast(float, u << 16); }
DI float bfhi(unsigned u) { return __builtin_bit_cast(float, u & 0xffff0000u); }
DI float wave_sum(float v) {
#pragma unroll
    for (int o = 1; o < 64; o <<= 1) v += __shfl_xor(v, o);
    return v;
}
DI float wave_max(float v) {
#pragma unroll
    for (int o = 1; o < 64; o <<= 1) v = fmaxf(v, __shfl_xor(v, o));
    return v;
}
DI int wave_min_i(int v) {
#pragma unroll
    for (int o = 1; o < 64; o <<= 1) { int w = __shfl_xor(v, o); v = w < v ? w : v; }
    return v;
}
DI float sigmoidf_(float x) { return 1.f / (1.f + expf(-x)); }
DI int crow(int reg, int h) { return (reg & 3) + 8 * (reg >> 2) + 4 * h; }

struct ArgsK { const float* in[30]; float* out; unsigned char* ws; int ph_lo, ph_hi, use_bar, pad; };
typedef __attribute__((address_space(4))) const ArgsK* kargp_t;
struct Ctx {
    float* out; unsigned char* ws;
    LAS unsigned char* lds; unsigned* ctl;
    int tid, lane, wave, G;
    DI const float* inp(int k) const { kargp_t p = (kargp_t)__builtin_amdgcn_kernarg_segment_ptr(); asm volatile("" : "+s"(p)); return p->in[k]; }
};
template <class T> DI T* wsp(const Ctx& C, size_t off) { return (T*)(C.ws + off); }

struct EpiInProj {
    static constexpr bool PERM = true, AFTER_DRAIN = false;
    bf16* P; float* out; int l;
    DI void operator()(const pg8::f32x4 (&acc)[2][2][4][2], const pg8::Unit& u, int wr, int wc, int fr, int fq) const {
        const int row0 = u.pm * 256 + wr * 64 + fr, col0 = u.pn * 256 + wc * 32 + 8 * fq;
#pragma unroll
        for (int bj = 0; bj < 2; ++bj) {
            const int colb = __builtin_amdgcn_readfirstlane(u.pn * 256 + wc * 32 + bj * 128);
            const int col = col0 + bj * 128;
            const int kind = colb < RW_COLS ? 1 : ((colb >= KC_OFF && colb < GL_OFF) ? 2 : 0);
            const int reg = (colb - KC_OFF) >> 9, cc = (col - KC_OFF) & 511;
#pragma unroll
            for (int ai = 0; ai < 2; ++ai)
#pragma unroll
                for (int m = 0; m < 4; ++m) {
                    const int row = row0 + ai * 128 + m * 16;
                    const pg8::f32x4 v0 = acc[ai][bj][m][0], v1 = acc[ai][bj][m][1];
                    v4u w; w.x = pk2(v0[0], v0[1]); w.y = pk2(v0[2], v0[3]); w.z = pk2(v1[0], v1[1]); w.w = pk2(v1[2], v1[3]);
                    *(v4u*)(P + (size_t)row * PLD + col) = w;
                    if (kind == 0 || row >= NT) continue;
                    unsigned off = 0xffffffffu;
                    if (row < NTP) { const int b = row >> 11, t = row & 2047;
                        if (kind == 1) { if (t == 2047) off = (unsigned)(O_SH_P + (size_t)(l * 4 + b) * RW_COLS + col); }
                        else if (reg == 0) off = (unsigned)(O_CMP_P + ((size_t)l * NTP + row) * 512 + cc);
                        else if (reg == 1) off = (unsigned)(O_SEL_P + ((size_t)l * NTP + row) * 512 + cc);
                        else if (t >= 1536) off = (unsigned)(O_WIN_P + ((size_t)(l * 4 + b) * 512 + (t - 1536)) * 512 + cc);
                    } else { const int j = row - NTP, b = j >> 2, t = j & 3;
                        if (kind == 1) { if (t == 3) off = (unsigned)(O_SH_S + (size_t)(l * 8 + b) * RW_COLS + col); }
                        else if (reg == 0) off = (unsigned)(O_CMP_S + ((size_t)l * NTS + j) * 512 + cc);
                        else if (reg == 1) off = (unsigned)(O_SEL_S + ((size_t)l * NTS + j) * 512 + cc);
                        else off = (unsigned)(O_WIN_S + ((size_t)(l * 8 + b) * 512 + 508 + t) * 512 + cc);
                    }
                    if (off != 0xffffffffu) { *(pg8::f32x4*)(out + off) = v0; *(pg8::f32x4*)(out + off + 4) = v1; }
                }
        }
    }
};

DI void transpose_item(const float* W, int K, int N, int Npad, bf16* WT, LAS float* scr, int item, int lane) {
    const int nblk = Npad / 32, kb = item / nblk, nb = item % nblk, k0 = 64 * kb, n0 = 32 * nb;
#pragma unroll 8
    for (int i = 0; i < 32; ++i) { const int kk = 2 * i + (lane >> 5), n = n0 + (lane & 31); scr[kk * 33 + (lane & 31)] = n < N ? W[(size_t)(k0 + kk) * N + n] : 0.f; }
    LDS_WAIT(); asm volatile("" ::: "memory");
    const int c = lane & 7;
#pragma unroll
    for (int j = 0; j < 4; ++j) { const int n = (lane >> 3) + 8 * j; const LAS float* s = scr + (8 * c) * 33 + n;
        v4u o; o.x = pk2(s[0 * 33], s[1 * 33]); o.y = pk2(s[2 * 33], s[3 * 33]); o.z = pk2(s[4 * 33], s[5 * 33]); o.w = pk2(s[6 * 33], s[7 * 33]);
        *(v4u*)(WT + (size_t)(n0 + n) * K + k0 + 8 * c) = o; }
    LDS_WAIT(); asm volatile("" ::: "memory");
}

constexpr int P0_NT = 2048, P0_NW2 = 2048, P0_NTAB = 16384, P0_NX = 2056, P0_NCC = 2048, P0_NWP = 508;
constexpr int P0_ITEMS = P0_NT + P0_NW2 + P0_NTAB + P0_NX + P0_NCC + P0_NWP;

DI void p0_prologue(const Ctx& C) {
    const int tid = C.tid, lane = C.lane, wave = C.wave;
    for (int it = blockIdx.x; it < P0_ITEMS; it += C.G) {
        int r = it;
        if (r < P0_NTAB) {
            const float* src = (r < 8192 ? C.inp(26) : C.inp(27)) + (size_t)(r & 8191) * 8192;
            bf16* dst = wsp<bf16>(C, r < 8192 ? WS_UB : WS_VB) + (size_t)(r & 8191) * 8192;
            const f32x4* s4 = (const f32x4*)src + tid * 4;
            const f32x4 a = s4[0], b = s4[1], c = s4[2], d = s4[3];
            v4u o0, o1; o0.x = pk2(a[0], a[1]); o0.y = pk2(a[2], a[3]); o0.z = pk2(b[0], b[1]); o0.w = pk2(b[2], b[3]);
            o1.x = pk2(c[0], c[1]); o1.y = pk2(c[2], c[3]); o1.z = pk2(d[0], d[1]); o1.w = pk2(d[2], d[3]);
            v4u* d4 = (v4u*)dst + tid * 2; d4[0] = o0; d4[1] = o1;
            continue;
        }
        r -= P0_NTAB;
        if (r < P0_NCC) {
            const int l = r >> 10, b = (r >> 7) & 7, pi = r & 127;
            const int pid = ((const int*)C.inp(4))[b * 128 + pi];
            const float* src = C.inp(2) + ((size_t)(l * NPOOL + pid) * 128) * 512 + tid;
            const int kv = tid >> 8, kvh = (tid >> 6) & 3, d = tid & 63;
            const float* w = C.inp(20) + (l * 2 + kv) * 32;
            float acc[4] = {0.f, 0.f, 0.f, 0.f};
#pragma unroll
            for (int q = 0; q < 4; ++q)
#pragma unroll 8
                for (int rr = 0; rr < 32; ++rr) acc[q] += w[rr] * src[(size_t)(32 * q + rr) * 512];
            float* dst = wsp<float>(C, kv ? WS_VCBS : WS_KCBS) + ((size_t)((l * 8 + b) * 4 + kvh) * 512 + 4 * pi) * 64 + d;
#pragma unroll
            for (int q = 0; q < 4; ++q) dst[q * 64] = acc[q];
            continue;
        }
        r -= P0_NCC;
        if (r < P0_NT) {
            const int l = r >> 10, w8 = (r & 1023) * 8 + wave;
            LAS float* scr = (LAS float*)(C.lds + wave * 16384);
            if (w8 < 6144) transpose_item(C.inp(8) + (size_t)l * DM * IN_COLS, DM, IN_COLS, PLD, wsp<bf16>(C, WS_WIN) + (size_t)l * PLD * DM, scr, w8, lane);
            else transpose_item(C.inp(21) + (size_t)l * DM * DM, DM, DM, DM, wsp<bf16>(C, WS_WOUT) + (size_t)l * DM * DM, scr, w8 - 6144, lane);
            continue;
        }
        r -= P0_NT;
        if (r < P0_NW2) {
            const int l = r >> 10, hc = (r >> 6) & 15, kb = r & 63;
            LAS float* SK = (LAS float*)C.lds;
            LAS float* WQ = (LAS float*)(C.lds + 128 * 129 * 4);
            __syncthreads();
            const float* sk = C.inp(25) + ((size_t)l * 16 + hc) * 16384;
            for (int i = tid; i < 16384; i += NTHREADS) SK[(i >> 7) * 129 + (i & 127)] = sk[i];
            const float* wq = C.inp(24) + (size_t)l * DM * DM + (size_t)(kb * 32) * DM + hc * 128;
            for (int i = tid; i < 4096; i += NTHREADS) WQ[i] = wq[(size_t)(i >> 7) * DM + (i & 127)];
            __syncthreads();
            const int k = tid & 127, rq = tid >> 7;
            float acc[8];
#pragma unroll
            for (int j = 0; j < 8; ++j) acc[j] = 0.f;
            for (int d = 0; d < 128; d += 4) {
                const float s0 = SK[k * 129 + d], s1 = SK[k * 129 + d + 1], s2 = SK[k * 129 + d + 2], s3 = SK[k * 129 + d + 3];
#pragma unroll
                for (int j = 0; j < 8; ++j) { const f32x4 w = *(const LAS f32x4*)(WQ + (rq * 8 + j) * 128 + d); acc[j] += s0 * w[0] + s1 * w[1] + s2 * w[2] + s3 * w[3]; }
            }
            v4u o; o.x = pk2(acc[0], acc[1]); o.y = pk2(acc[2], acc[3]); o.z = pk2(acc[4], acc[5]); o.w = pk2(acc[6], acc[7]);
            *(v4u*)(wsp<bf16>(C, WS_W2) + (size_t)l * DM * DM + (size_t)(hc * 128 + k) * DM + kb * 32 + rq * 8) = o;
            continue;
        }
        r -= P0_NW2;
        if (r < P0_NX) {
            const size_t e0 = (size_t)r * 8192 + tid * 16;
            const float* src = e0 < (size_t)NTP * DM ? C.inp(0) + e0 : C.inp(1) + (e0 - (size_t)NTP * DM);
            const f32x4* s4 = (const f32x4*)src;
            const f32x4 a = s4[0], b = s4[1], c = s4[2], d = s4[3];
            v4u o0, o1; o0.x = pk2(a[0], a[1]); o0.y = pk2(a[2], a[3]); o0.z = pk2(b[0], b[1]); o0.w = pk2(b[2], b[3]);
            o1.x = pk2(c[0], c[1]); o1.y = pk2(c[2], c[3]); o1.z = pk2(d[0], d[1]); o1.w = pk2(d[2], d[3]);
            v4u* d4 = (v4u*)(wsp<bf16>(C, WS_XB) + e0); d4[0] = o0; d4[1] = o1;
            continue;
        }
        r -= P0_NX;
        {
            const size_t i0 = (size_t)r * 8192 + tid * 16;
            const size_t lb = i0 / 260096, rem = i0 % 260096;
            const f32x4* s4 = (const f32x4*)(C.inp(5) + lb * 262144 + 2048 + rem);
            f32x4* d4 = (f32x4*)(C.out + O_WIN_S + lb * 262144 + rem);
            const f32x4 a = s4[0], b = s4[1], c = s4[2], d = s4[3];
            d4[0] = a; d4[1] = b; d4[2] = c; d4[3] = d;
        }
    }
    __syncthreads();
}

constexpr int PB_NRW = 1028, PB_NPOOL = 256, PB_NVT = 1024, PB_ITEMS = PB_NRW + PB_NPOOL + PB_NVT;
DI float softplusf_(float x) { return x > 20.f ? x : log1pf(expf(x)); }

DI void rwkv_pre_item(const Ctx& C, int l, int item) {
    const int tid = C.tid, lane = C.lane, wave = C.wave;
    LAS float* XS = (LAS float*)C.lds;
    LAS float* ACT = (LAS float*)(C.lds + 8 * RW_COLS * 4);
    const bf16* P = wsp<bf16>(C, WS_PROJ);
    const int m0 = item * 8;
    __syncthreads();
    for (int idx = tid; idx < 8 * 420; idx += NTHREADS) {
        const int j = idx / 420, col = (idx % 420) * 8, m = m0 + j;
        const v4u cu = *(const v4u*)(P + (size_t)m * PLD + col);
        float cur[8] = {bflo(cu.x), bfhi(cu.x), bflo(cu.y), bfhi(cu.y), bflo(cu.z), bfhi(cu.z), bflo(cu.w), bfhi(cu.w)};
        float prev[8];
        int t; const float* sh = nullptr;
        if (m < NTP) t = m & 2047; else { const int jj = m - NTP; t = jj & 3; sh = C.inp(7) + (size_t)(l * 8 + (jj >> 2)) * RW_COLS + col; }
        if (t > 0) { const v4u pu = *(const v4u*)(P + (size_t)(m - 1) * PLD + col);
            prev[0] = bflo(pu.x); prev[1] = bfhi(pu.x); prev[2] = bflo(pu.y); prev[3] = bfhi(pu.y); prev[4] = bflo(pu.z); prev[5] = bfhi(pu.z); prev[6] = bflo(pu.w); prev[7] = bfhi(pu.w);
        } else if (sh) {
#pragma unroll
            for (int e = 0; e < 8; ++e) prev[e] = sh[e];
        } else {
#pragma unroll
            for (int e = 0; e < 8; ++e) prev[e] = 0.f;
        }
        const float* mu = C.inp(9) + (size_t)l * RW_COLS + col;
#pragma unroll
        for (int e = 0; e < 8; ++e) XS[j * RW_COLS + col + e] = cur[e] + mu[e] * (prev[e] - cur[e]);
    }
    __syncthreads();
    for (int idx = tid; idx < 8 * 288; idx += NTHREADS) {
        const int j = idx / 288, a = idx % 288; const float x = XS[j * RW_COLS + 3072 + a];
        ACT[a * 8 + j] = a < 64 ? tanhf(x) : (a < 128 ? x : sigmoidf_(x));
    }
    __syncthreads();
    float wp[2][8], ap[2][8], gp[2][8];
#pragma unroll
    for (int s = 0; s < 2; ++s)
#pragma unroll
        for (int j = 0; j < 8; ++j) { wp[s][j] = 0.f; ap[s][j] = 0.f; gp[s][j] = 0.f; }
    const float* w2 = C.inp(11) + (size_t)l * 64 * 1024 + tid;
    const float* a2 = C.inp(13) + (size_t)l * 64 * 1024 + tid;
    const float* g2 = C.inp(14) + (size_t)l * 160 * 1024 + tid;
#pragma unroll 4
    for (int kk = 0; kk < 64; ++kk) {
        const float wa = w2[kk * 1024], wb = w2[kk * 1024 + 512];
        const f32x4 t0 = *(const LAS f32x4*)(ACT + kk * 8), t1 = *(const LAS f32x4*)(ACT + kk * 8 + 4);
#pragma unroll
        for (int j = 0; j < 4; ++j) { wp[0][j] += t0[j] * wa; wp[1][j] += t0[j] * wb; wp[0][4 + j] += t1[j] * wa; wp[1][4 + j] += t1[j] * wb; }
    }
#pragma unroll 4
    for (int kk = 0; kk < 64; ++kk) {
        const float wa = a2[kk * 1024], wb = a2[kk * 1024 + 512];
        const f32x4 t0 = *(const LAS f32x4*)(ACT + (64 + kk) * 8), t1 = *(const LAS f32x4*)(ACT + (64 + kk) * 8 + 4);
#pragma unroll
        for (int j = 0; j < 4; ++j) { ap[0][j] += t0[j] * wa; ap[1][j] += t0[j] * wb; ap[0][4 + j] += t1[j] * wa; ap[1][4 + j] += t1[j] * wb; }
    }
#pragma unroll 4
    for (int kk = 0; kk < 160; ++kk) {
        const float wa = g2[kk * 1024], wb = g2[kk * 1024 + 512];
        const f32x4 t0 = *(const LAS f32x4*)(ACT + (128 + kk) * 8), t1 = *(const LAS f32x4*)(ACT + (128 + kk) * 8 + 4);
#pragma unroll
        for (int j = 0; j < 4; ++j) { gp[0][j] += t0[j] * wa; gp[1][j] += t0[j] * wb; gp[0][4 + j] += t1[j] * wa; gp[1][4 + j] += t1[j] * wb; }
    }
    float* SC = wsp<float>(C, WS_SC); constexpr size_t SS = SC_STRIDE / 4;
    float* GG = wsp<float>(C, WS_GG); float* BON = wsp<float>(C, WS_BON);
#pragma unroll
    for (int s = 0; s < 2; ++s) {
        const int c = tid + 512 * s, head = wave + 8 * s;
        const float w0v = C.inp(10)[l * 1024 + c], a0v = C.inp(12)[l * 1024 + c], kkv = C.inp(15)[l * 1024 + c], kav = C.inp(16)[l * 1024 + c], rkv = C.inp(17)[l * 1024 + c];
#pragma unroll
        for (int j = 0; j < 8; ++j) {
            const size_t m = m0 + j;
            const float z = w0v + wp[s][j];
            const float w = -softplusf_(-z) - 0.5f;
            const float dec = expf(-expf(w));
            const float a = sigmoidf_(a0v + ap[s][j]);
            const float rr = XS[j * RW_COLS + c], k = XS[j * RW_COLS + 1024 + c], v = XS[j * RW_COLS + 2048 + c];
            const float kkr = k * kkv;
            const float ss = wave_sum(kkr * kkr);
            const float kk = kkr * (1.f / sqrtf(fmaxf(ss, 1e-24f)));
            const float km = k * (1.f + (a - 1.f) * kav);
            const float bon = wave_sum(rr * km * rkv);
            SC[0 * SS + m * 1024 + c] = kk; SC[1 * SS + m * 1024 + c] = dec; SC[2 * SS + m * 1024 + c] = kk * a; SC[3 * SS + m * 1024 + c] = km; SC[4 * SS + m * 1024 + c] = rr; SC[5 * SS + m * 1024 + c] = v;
            GG[m * 1024 + c] = gp[s][j];
            if (lane == 0) BON[m * 16 + head] = bon;
        }
    }
}

DI void phase_b(const Ctx& C, int l) {
    const int tid = C.tid;
    const bf16* P = wsp<bf16>(C, WS_PROJ);
    for (int it = blockIdx.x; it < PB_ITEMS; it += C.G) {
        int r = it;
        if (r < PB_NRW) { rwkv_pre_item(C, l, r); continue; }
        r -= PB_NRW;
        if (r < PB_NPOOL) {
            const int b = r >> 6, n = r & 63, kv = tid >> 8, kvh = (tid >> 6) & 3, d = tid & 63;
            const float* src = C.out + O_CMP_P + ((size_t)l * NTP + b * 2048 + 32 * n) * 512 + tid;
            const float* w = C.inp(20) + (l * 2 + kv) * 32;
            float acc = 0.f;
#pragma unroll 8
            for (int rr = 0; rr < 32; ++rr) acc += w[rr] * src[(size_t)rr * 512];
            const unsigned short hb = (unsigned short)(pk2(acc, 0.f) & 0xffffu);
            if (kv == 0) wsp<bf16>(C, WS_KCB)[((size_t)(b * 4 + kvh) * 64 + n) * 64 + d] = hb;
            else wsp<bf16>(C, WS_VCBT)[((size_t)(b * 4 + kvh) * 64 + d) * 64 + n] = hb;
            continue;
        }
        r -= PB_NPOOL;
        {
            const int which = r >> 9, b = (r >> 7) & 3, kvh = (r >> 5) & 3, tb = r & 31, d = tid & 63, tq = tid >> 6;
            const bf16* src = P + (size_t)(b * 2048 + 64 * tb + 8 * tq) * PLD + (which ? VW_OFF : VS_OFF) + kvh * 64 + d;
            unsigned short e[8];
#pragma unroll
            for (int i = 0; i < 8; ++i) e[i] = src[(size_t)i * PLD];
            v4u o; o.x = e[0] | ((unsigned)e[1] << 16); o.y = e[2] | ((unsigned)e[3] << 16); o.z = e[4] | ((unsigned)e[5] << 16); o.w = e[6] | ((unsigned)e[7] << 16);
            *(v4u*)(wsp<bf16>(C, which ? WS_VTW : WS_VTS) + ((size_t)(b * 4 + kvh) * 64 + d) * 2048 + 64 * tb + 8 * tq) = o;
        }
    }
    __syncthreads();
}

DI void scan_head(const Ctx& C, int l, int row0, int T, int h, const float* S0, float* Sout) {
    const int tid = C.tid, lane = C.lane, wave = C.wave;
    LAS float* STG = (LAS float*)C.lds;
    LAS float* YB = (LAS float*)(C.lds + 6 * 32 * 64 * 4);
    const float* SC = wsp<float>(C, WS_SC); constexpr size_t SS = SC_STRIDE / 4;
    const float* GG = wsp<float>(C, WS_GG); const float* BON = wsp<float>(C, WS_BON);
    bf16* MIX = wsp<bf16>(C, WS_MIX);
    const int r = 8 * wave + (lane >> 3), cg = lane & 7;
    float S[8];
    if (S0) { const f32x4 a = *(const f32x4*)(S0 + r * 64 + 8 * cg), b = *(const f32x4*)(S0 + r * 64 + 8 * cg + 4);
#pragma unroll
        for (int i = 0; i < 4; ++i) { S[i] = a[i]; S[4 + i] = b[i]; } }
    else {
#pragma unroll
        for (int i = 0; i < 8; ++i) S[i] = 0.f; }
    const int nch = (T + 31) >> 5;
    f32x4 pf[6];
#define SCAN_PREFETCH(cc) do { _Pragma("unroll") for (int k = 0; k < 6; ++k) { const int idx = tid + 512 * k, v6 = idx >> 9, rem = idx & 511, st = rem >> 4, f4 = rem & 15, step = (cc) * 32 + st; \
        pf[k] = step < T ? *(const f32x4*)(SC + v6 * SS + (size_t)(row0 + step) * 1024 + h * 64 + f4 * 4) : (f32x4){0.f, 0.f, 0.f, 0.f}; } } while (0)
    SCAN_PREFETCH(0);
    const float gng = C.inp(18)[l * 1024 + h * 64 + lane], gnb = C.inp(19)[l * 1024 + h * 64 + lane];
    for (int c = 0; c < nch; ++c) {
        __syncthreads();
#pragma unroll
        for (int k = 0; k < 6; ++k) ((LAS f32x4*)STG)[tid + 512 * k] = pf[k];
        __syncthreads();
        if (c + 1 < nch) SCAN_PREFETCH(c + 1);
        const int nst = (T - c * 32) < 32 ? (T - c * 32) : 32;
        for (int st = 0; st < nst; ++st) {
            const LAS f32x4* q = (const LAS f32x4*)STG + st * 16 + 2 * cg;
            const f32x4 k0 = q[0 * 512], k1 = q[0 * 512 + 1], d0 = q[1 * 512], d1 = q[1 * 512 + 1], b0 = q[2 * 512], b1 = q[2 * 512 + 1], m0 = q[3 * 512], m1 = q[3 * 512 + 1], r0 = q[4 * 512], r1 = q[4 * 512 + 1];
            const float vv = STG[(5 * 32 + st) * 64 + r];
            float sk = S[0] * k0[0];
#pragma unroll
            for (int i = 1; i < 4; ++i) sk += S[i] * k0[i];
#pragma unroll
            for (int i = 0; i < 4; ++i) sk += S[4 + i] * k1[i];
            sk += __shfl_xor(sk, 1); sk += __shfl_xor(sk, 2); sk += __shfl_xor(sk, 4);
#pragma unroll
            for (int i = 0; i < 4; ++i) { S[i] = S[i] * d0[i] + (vv * m0[i] - sk * b0[i]); S[4 + i] = S[4 + i] * d1[i] + (vv * m1[i] - sk * b1[i]); }
            float y = S[0] * r0[0];
#pragma unroll
            for (int i = 1; i < 4; ++i) y += S[i] * r0[i];
#pragma unroll
            for (int i = 0; i < 4; ++i) y += S[4 + i] * r1[i];
            y += __shfl_xor(y, 1); y += __shfl_xor(y, 2); y += __shfl_xor(y, 4);
            if (cg == 0) YB[st * 64 + r] = y;
        }
        __syncthreads();
#pragma unroll
        for (int qq = 0; qq < 4; ++qq) {
            const int st = wave * 4 + qq;
            if (st < nst) {
                const size_t m = (size_t)row0 + c * 32 + st;
                const float y = YB[st * 64 + lane];
                const float mean = wave_sum(y) * (1.f / 64.f);
                const float dv = y - mean;
                const float var = wave_sum(dv * dv) * (1.f / 64.f);
                const float yn = dv * (1.f / sqrtf(var + GN_EPS)) * gng + gnb;
                const float o = (yn + BON[m * 16 + h] * STG[(5 * 32 + st) * 64 + lane]) * GG[m * 1024 + h * 64 + lane];
                MIX[m * DM + h * 64 + lane] = (unsigned short)(pk2(o, 0.f) & 0xffffu);
            }
        }
    }
#undef SCAN_PREFETCH
    { f32x4 a, b;
#pragma unroll
        for (int i = 0; i < 4; ++i) { a[i] = S[i]; b[i] = S[4 + i]; }
        *(f32x4*)(Sout + r * 64 + 8 * cg) = a; *(f32x4*)(Sout + r * 64 + 8 * cg + 4) = b; }
}

#define MFMA32(a, b, c) __builtin_amdgcn_mfma_f32_32x32x16_bf16((a), (b), (c), 0, 0, 0)
DI bf16x8 pack8(const f32x16& p, int s) {
    v4u o; o.x = pk2(p[8 * s], p[8 * s + 1]); o.y = pk2(p[8 * s + 2], p[8 * s + 3]); o.z = pk2(p[8 * s + 4], p[8 * s + 5]); o.w = pk2(p[8 * s + 6], p[8 * s + 7]);
    return __builtin_bit_cast(bf16x8, o);
}
DI bf16x8 ld_vt(const bf16* p) {
    const v2u a = *(const v2u*)p, b = *(const v2u*)(p + 8);
    v4u o; o.x = a.x; o.y = a.y; o.z = b.x; o.w = b.y; return __builtin_bit_cast(bf16x8, o);
}
#define ATT_TILE(KROW_PTR, VT_PTR0, VT_PTR1, VALID_EXPR) do { \
        f32x16 a_ = zero16; \
        _Pragma("unroll") for (int s = 0; s < 4; ++s) { const bf16x8 kf = *(const bf16x8*)((KROW_PTR) + 16 * s + 8 * hi); a_ = MFMA32(kf, qf[s], a_); } \
        float tm = NEG_BIG; \
        _Pragma("unroll") for (int i = 0; i < 16; ++i) { const int key = key0 + crow(i, hi); const bool ok = (VALID_EXPR); a_[i] = ok ? a_[i] * 0.125f : NEG_BIG; tm = fmaxf(tm, a_[i]); } \
        tm = fmaxf(tm, __shfl_xor(tm, 32)); \
        const float mn = fmaxf(mrun, tm); const float sc_ = expf(mrun - mn); \
        float ps = 0.f; \
        _Pragma("unroll") for (int i = 0; i < 16; ++i) { const float p_ = a_[i] > -1e29f ? expf(a_[i] - mn) : 0.f; a_[i] = p_; ps += p_; } \
        ps += __shfl_xor(ps, 32); \
        lrun = lrun * sc_ + ps; mrun = mn; \
        _Pragma("unroll") for (int i = 0; i < 16; ++i) { oa[0][i] *= sc_; oa[1][i] *= sc_; } \
        _Pragma("unroll") for (int s = 0; s < 2; ++s) { const bf16x8 pb = pack8(a_, s); \
            oa[0] = MFMA32(ld_vt((VT_PTR0) + 16 * s + 4 * hi), pb, oa[0]); oa[1] = MFMA32(ld_vt((VT_PTR1) + 16 * s + 4 * hi), pb, oa[1]); } \
    } while (0)

DI void nsa_prompt_unit(const Ctx& C, int l, int b, int kvh, int qt) {
    const int tid = C.tid, lane = C.lane, wave = C.wave;
    const int g = wave & 3, th = wave >> 2, q = lane & 31, hi = lane >> 5;
    LAS float* IMP = (LAS float*)C.lds;
    LAS float* IMPV = (LAS float*)(C.lds + 65536);
    LAS unsigned* SELM = (LAS unsigned*)(C.lds + 65536 + 8192);
    const bf16* P = wsp<bf16>(C, WS_PROJ);
    const int tok = qt * 64 + th * 32 + q;
    const size_t m = (size_t)b * 2048 + tok;
    const int bk = b * 4 + kvh, head = kvh * 4 + g;
    f32x16 zero16;
#pragma unroll
    for (int i = 0; i < 16; ++i) zero16[i] = 0.f;
    bf16x8 qf[4];
#pragma unroll
    for (int s = 0; s < 4; ++s) qf[s] = *(const bf16x8*)(P + m * PLD + Q_OFF + head * 64 + 16 * s + 8 * hi);
    f32x16 out0 = zero16, out1 = zero16;
    const float g0 = sigmoidf_(bf2f(P[m * PLD + GL_OFF + head * 3 + 0])), g1 = sigmoidf_(bf2f(P[m * PLD + GL_OFF + head * 3 + 1])), g2 = sigmoidf_(bf2f(P[m * PLD + GL_OFF + head * 3 + 2]));
    __syncthreads();
    {
        const bf16* KCB = wsp<bf16>(C, WS_KCB) + (size_t)bk * 4096;
        const bf16* VCBT = wsp<bf16>(C, WS_VCBT) + (size_t)bk * 4096;
        f32x16 sc[2];
        const int nvalid = (tok + 1) >> 5;
        float mx = NEG_BIG;
#pragma unroll
        for (int tile = 0; tile < 2; ++tile) {
            f32x16 a_ = zero16;
#pragma unroll
            for (int s = 0; s < 4; ++s) { const bf16x8 kf = *(const bf16x8*)(KCB + (size_t)(tile * 32 + q) * 64 + 16 * s + 8 * hi); a_ = MFMA32(kf, qf[s], a_); }
#pragma unroll
            for (int i = 0; i < 16; ++i) { const int n = tile * 32 + crow(i, hi); a_[i] = n < nvalid ? a_[i] * 0.125f : NEG_BIG; mx = fmaxf(mx, a_[i]); }
            sc[tile] = a_;
        }
        mx = fmaxf(mx, __shfl_xor(mx, 32));
        float sum = 0.f;
#pragma unroll
        for (int tile = 0; tile < 2; ++tile)
#pragma unroll
            for (int i = 0; i < 16; ++i) { const float p_ = sc[tile][i] > -1e29f ? expf(sc[tile][i] - mx) : 0.f; sc[tile][i] = p_; sum += p_; }
        sum += __shfl_xor(sum, 32);
        const float inv = nvalid > 0 ? 1.f / sum : 0.f;
        f32x16 oc0 = zero16, oc1 = zero16;
#pragma unroll
        for (int tile = 0; tile < 2; ++tile) {
#pragma unroll
            for (int i = 0; i < 16; ++i) sc[tile][i] *= inv;
#pragma unroll
            for (int i4 = 0; i4 < 4; ++i4) { f32x4 v = {sc[tile][4 * i4], sc[tile][4 * i4 + 1], sc[tile][4 * i4 + 2], sc[tile][4 * i4 + 3]};
                *(LAS f32x4*)(IMP + ((size_t)(g * 64 + th * 32 + q)) * 64 + tile * 32 + 8 * i4 + 4 * hi) = v; }
#pragma unroll
            for (int s = 0; s < 2; ++s) { const bf16x8 pb = pack8(sc[tile], s);
                oc0 = MFMA32(ld_vt(VCBT + (size_t)q * 64 + tile * 32 + 16 * s + 4 * hi), pb, oc0);
                oc1 = MFMA32(ld_vt(VCBT + (size_t)(32 + q) * 64 + tile * 32 + 16 * s + 4 * hi), pb, oc1); }
        }
#pragma unroll
        for (int i = 0; i < 16; ++i) { out0[i] = g0 * oc0[i]; out1[i] = g0 * oc1[i]; }
    }
    __syncthreads();
    {
        const int tokl = tid >> 3, jq = tid & 7;
        float v[4];
#pragma unroll
        for (int e = 0; e < 4; ++e) v[e] = 0.f;
#pragma unroll
        for (int gg = 0; gg < 4; ++gg) { const f32x4 a = *(const LAS f32x4*)(IMP + (size_t)(gg * 64 + tokl) * 64 + 8 * jq), bq = *(const LAS f32x4*)(IMP + (size_t)(gg * 64 + tokl) * 64 + 8 * jq + 4);
            v[0] += a[0] + a[1]; v[1] += a[2] + a[3]; v[2] += bq[0] + bq[1]; v[3] += bq[2] + bq[3]; }
        const int cur = qt;
#pragma unroll
        for (int e = 0; e < 4; ++e) { const int j = 4 * jq + e; const bool forced = (j == 0) | (j == cur) | (j == cur - 1); v[e] = j > cur ? -1.f : (forced ? 1e4f : v[e]); }
        *(LAS f32x4*)(IMPV + tokl * 32 + 4 * jq) = (f32x4){v[0], v[1], v[2], v[3]};
        __syncthreads();
        int rank[4] = {0, 0, 0, 0};
#pragma unroll
        for (int jj4 = 0; jj4 < 8; ++jj4) { const f32x4 o = *(const LAS f32x4*)(IMPV + tokl * 32 + 4 * jj4);
#pragma unroll
            for (int u = 0; u < 4; ++u) { const int jp = 4 * jj4 + u; const float ov = o[u];
#pragma unroll
                for (int e = 0; e < 4; ++e) { const int j = 4 * jq + e; rank[e] += (ov > v[e] || (ov == v[e] && jp < j)) ? 1 : 0; } } }
        unsigned bits = 0;
#pragma unroll
        for (int e = 0; e < 4; ++e) if (rank[e] < 16 && v[e] >= 0.f) bits |= 1u << (4 * jq + e);
        bits |= __shfl_xor(bits, 1); bits |= __shfl_xor(bits, 2); bits |= __shfl_xor(bits, 4);
        if (jq == 0) SELM[tokl] = bits;
        __syncthreads();
    }
    const unsigned selm = SELM[th * 32 + q];
    {
        const bf16* VT = wsp<bf16>(C, WS_VTS) + (size_t)bk * 64 * 2048;
        f32x16 oa[2] = {zero16, zero16}; float mrun = NEG_BIG, lrun = 0.f;
        for (int j = 0; j <= qt; ++j) {
            const bool mine = (selm >> j) & 1u;
            if (!__any(mine)) continue;
#pragma unroll
            for (int tile = 0; tile < 2; ++tile) {
                const int key0 = j * 64 + tile * 32;
                ATT_TILE(P + ((size_t)b * 2048 + key0 + q) * PLD + KS_OFF + kvh * 64, VT + (size_t)q * 2048 + key0, VT + (size_t)(32 + q) * 2048 + key0, (mine && key <= tok));
            }
        }
        const float il = g1 / lrun;
#pragma unroll
        for (int i = 0; i < 16; ++i) { out0[i] += il * oa[0][i]; out1[i] += il * oa[1][i]; }
    }
    {
        const bf16* VT = wsp<bf16>(C, WS_VTW) + (size_t)bk * 64 * 2048;
        f32x16 oa[2] = {zero16, zero16}; float mrun = NEG_BIG, lrun = 0.f;
        for (int j = (qt > 8 ? qt - 8 : 0); j <= qt; ++j) {
#pragma unroll
            for (int tile = 0; tile < 2; ++tile) {
                const int key0 = j * 64 + tile * 32;
                ATT_TILE(P + ((size_t)b * 2048 + key0 + q) * PLD + KW_OFF + kvh * 64, VT + (size_t)q * 2048 + key0, VT + (size_t)(32 + q) * 2048 + key0, (key <= tok && key + 511 >= tok));
            }
        }
        const float il = g2 / lrun;
#pragma unroll
        for (int i = 0; i < 16; ++i) { out0[i] += il * oa[0][i]; out1[i] += il * oa[1][i]; }
    }
    bf16* MIX = wsp<bf16>(C, WS_MIX) + m * DM + 1024 + head * 64;
#pragma unroll
    for (int i4 = 0; i4 < 4; ++i4) {
        v2u o; o.x = pk2(out0[4 * i4], out0[4 * i4 + 1]); o.y = pk2(out0[4 * i4 + 2], out0[4 * i4 + 3]); *(v2u*)(MIX + 8 * i4 + 4 * hi) = o;
        o.x = pk2(out1[4 * i4], out1[4 * i4 + 1]); o.y = pk2(out1[4 * i4 + 2], out1[4 * i4 + 3]); *(v2u*)(MIX + 32 + 8 * i4 + 4 * hi) = o;
    }
}

template <class RowFn> DI void samp_block(const RowFn& rowptr, int nvalid, int kvh, const LAS float* QS, LAS float* PWw, int lane, float (&M)[4], float (&L)[4], float (&O)[4]) {
    float s[4] = {0.f, 0.f, 0.f, 0.f};
    const bool ok = lane < nvalid;
    if (ok) {
        const f32x4* kr = (const f32x4*)(rowptr(lane) + kvh * 64);
#pragma unroll 4
        for (int d4 = 0; d4 < 16; ++d4) { const f32x4 kq = kr[d4];
#pragma unroll
            for (int g = 0; g < 4; ++g) { const f32x4 qq = *(const LAS f32x4*)(QS + g * 64 + 4 * d4); s[g] += kq[0] * qq[0] + kq[1] * qq[1] + kq[2] * qq[2] + kq[3] * qq[3]; } }
    }
    float mb[4], lb[4];
#pragma unroll
    for (int g = 0; g < 4; ++g) { const float sv = ok ? s[g] : NEG_BIG; mb[g] = wave_max(sv); const float p = ok ? expf(sv - mb[g]) : 0.f; lb[g] = wave_sum(p); PWw[g * 64 + lane] = p; }
    LDS_WAIT(); asm volatile("" ::: "memory");
    float ob[4] = {0.f, 0.f, 0.f, 0.f};
    for (int r = 0; r < nvalid; ++r) { const float vv = rowptr(r)[256 + kvh * 64 + lane];
#pragma unroll
        for (int g = 0; g < 4; ++g) ob[g] += PWw[g * 64 + r] * vv; }
    LDS_WAIT(); asm volatile("" ::: "memory");
#pragma unroll
    for (int g = 0; g < 4; ++g) { const float mn = fmaxf(M[g], mb[g]); const float a = expf(M[g] - mn), bsc = expf(mb[g] - mn); L[g] = L[g] * a + lb[g] * bsc; O[g] = O[g] * a + ob[g] * bsc; M[g] = mn; }
}
DI float samp_combine(LAS float* WST, int tid, int lane, int wave, const float (&M)[4], const float (&L)[4], const float (&O)[4]) {
    __syncthreads();
#pragma unroll
    for (int g = 0; g < 4; ++g) { WST[wave * 264 + 8 + g * 64 + lane] = O[g]; if (lane == 0) { WST[wave * 264 + g] = M[g]; WST[wave * 264 + 4 + g] = L[g]; } }
    __syncthreads();
    float res = 0.f;
    if (tid < 256) { const int g = tid >> 6, d = tid & 63; float mm = NEG_BIG;
#pragma unroll
        for (int w = 0; w < 8; ++w) mm = fmaxf(mm, WST[w * 264 + g]);
        float ll = 0.f, oo = 0.f;
#pragma unroll
        for (int w = 0; w < 8; ++w) { const float e = expf(WST[w * 264 + g] - mm); ll += WST[w * 264 + 4 + g] * e; oo += WST[w * 264 + 8 + g * 64 + d] * e; }
        res = oo / ll; }
    return res;
}

DI void nsa_sample_item(const Ctx& C, int l, int b, int t, int kvh) {
    const int tid = C.tid, lane = C.lane, wave = C.wave;
    LAS float* F = (LAS float*)C.lds;
    LAS float *QS = F, *PC = F + 256, *IMPS = F + 2304, *RED = F + 2624, *RED2 = F + 2688, *OCP = F + 2752, *PW = F + 4800, *WST = F + 6848;
    LAS int* SELB = (LAS int*)(F + 2560);
    const bf16* P = wsp<bf16>(C, WS_PROJ);
    const size_t m = (size_t)NTP + b * 4 + t;
    __syncthreads();
    if (tid < 256) QS[tid] = bf2f(P[m * PLD + Q_OFF + kvh * 256 + tid]) * 0.125f;
    __syncthreads();
    float ocmp = 0.f;
    {
        const float* KC = wsp<float>(C, WS_KCBS) + ((size_t)((l * 8 + b) * 4 + kvh) * 512) * 64;
        const float* VC = wsp<float>(C, WS_VCBS) + ((size_t)((l * 8 + b) * 4 + kvh) * 512) * 64;
        float s[4] = {0.f, 0.f, 0.f, 0.f};
        const f32x4* kr = (const f32x4*)(KC + (size_t)tid * 64);
#pragma unroll 4
        for (int d4 = 0; d4 < 16; ++d4) { const f32x4 kq = kr[d4];
#pragma unroll
            for (int g = 0; g < 4; ++g) { const f32x4 qq = *(const LAS f32x4*)(QS + g * 64 + 4 * d4); s[g] += kq[0] * qq[0] + kq[1] * qq[1] + kq[2] * qq[2] + kq[3] * qq[3]; } }
#pragma unroll
        for (int g = 0; g < 4; ++g) { const float wm = wave_max(s[g]); if (lane == 0) RED[wave * 4 + g] = wm; }
        __syncthreads();
        float p[4];
#pragma unroll
        for (int g = 0; g < 4; ++g) { float mm = RED[g];
#pragma unroll
            for (int w = 1; w < 8; ++w) mm = fmaxf(mm, RED[w * 4 + g]);
            p[g] = expf(s[g] - mm); const float ws = wave_sum(p[g]); if (lane == 0) RED2[wave * 4 + g] = ws; }
        __syncthreads();
#pragma unroll
        for (int g = 0; g < 4; ++g) { float tot = 0.f;
#pragma unroll
            for (int w = 0; w < 8; ++w) tot += RED2[w * 4 + g];
            PC[g * 512 + tid] = p[g] / tot; }
        __syncthreads();
        if (tid < 256) IMPS[tid] = (PC[2 * tid] + PC[2 * tid + 1]) + (PC[512 + 2 * tid] + PC[512 + 2 * tid + 1]) + (PC[1024 + 2 * tid] + PC[1024 + 2 * tid + 1]) + (PC[1536 + 2 * tid] + PC[1536 + 2 * tid + 1]);
        { const int d = tid & 63, nq = tid >> 6; float acc[4] = {0.f, 0.f, 0.f, 0.f};
#pragma unroll 4
            for (int n = nq * 64; n < nq * 64 + 64; ++n) { const float vv = VC[(size_t)n * 64 + d];
#pragma unroll
                for (int g = 0; g < 4; ++g) acc[g] += PC[g * 512 + n] * vv; }
#pragma unroll
            for (int g = 0; g < 4; ++g) OCP[(nq * 4 + g) * 64 + d] = acc[g]; }
        __syncthreads();
        if (tid < 256) { const int g = tid >> 6, d = tid & 63;
#pragma unroll
            for (int nq = 0; nq < 8; ++nq) ocmp += OCP[(nq * 4 + g) * 64 + d];
            const int j = tid;
            if (j >= 1 && j <= 254) { const float v = IMPS[j]; int rank = 0;
                for (int jp = 1; jp <= 254; ++jp) { const float ov = IMPS[jp]; rank += (ov > v || (ov == v && jp < j)) ? 1 : 0; }
                if (rank < 13) SELB[rank] = j; }
            if (tid == 0) { SELB[13] = 0; SELB[14] = 255; SELB[15] = 256; }
        }
        __syncthreads();
    }
    float osel;
    {
        float M[4] = {NEG_BIG, NEG_BIG, NEG_BIG, NEG_BIG}, L[4] = {0.f, 0.f, 0.f, 0.f}, O[4] = {0.f, 0.f, 0.f, 0.f};
        const int* pt = (const int*)C.inp(4) + b * 128;
        for (int bi = 0; bi < 2; ++bi) {
            const int jb = __builtin_amdgcn_readfirstlane(SELB[2 * wave + bi]);
            if (jb < 256) { const int pid = pt[jb >> 1];
                const float* base = C.inp(3) + ((size_t)(l * NPOOL + pid) * 128 + (jb & 1) * 64) * 512;
                samp_block([&](int r) { return base + (size_t)r * 512; }, 64, kvh, QS, PW + wave * 256, lane, M, L, O);
            } else { const float* base = C.out + O_SEL_S + ((size_t)l * NTS + b * 4) * 512;
                samp_block([&](int r) { return base + (size_t)r * 512; }, t + 1, kvh, QS, PW + wave * 256, lane, M, L, O); }
        }
        osel = samp_combine(WST, tid, lane, wave, M, L, O);
    }
    float owin;
    {
        float M[4] = {NEG_BIG, NEG_BIG, NEG_BIG, NEG_BIG}, L[4] = {0.f, 0.f, 0.f, 0.f}, O[4] = {0.f, 0.f, 0.f, 0.f};
        const float* pre = C.inp(5) + (size_t)(l * 8 + b) * 262144;
        const float* nw = C.out + O_WIN_S + ((size_t)(l * 8 + b) * 512 + 508) * 512;
        samp_block([&](int r) { const int p = t + 1 + 64 * wave + r; return p <= 511 ? pre + (size_t)p * 512 : nw + (size_t)(p - 512) * 512; }, 64, kvh, QS, PW + wave * 256, lane, M, L, O);
        owin = samp_combine(WST, tid, lane, wave, M, L, O);
    }
    if (tid < 256) { const int g = tid >> 6, d = tid & 63, head = kvh * 4 + g;
        const float g0 = sigmoidf_(bf2f(P[m * PLD + GL_OFF + head * 3 + 0])), g1 = sigmoidf_(bf2f(P[m * PLD + GL_OFF + head * 3 + 1])), g2 = sigmoidf_(bf2f(P[m * PLD + GL_OFF + head * 3 + 2]));
        const float o = g0 * ocmp + g1 * osel + g2 * owin;
        wsp<bf16>(C, WS_MIX)[m * DM + 1024 + head * 64 + d] = (unsigned short)(pk2(o, 0.f) & 0xffffu); }
}

#ifndef C_MASK
#define C_MASK 7
#endif
constexpr int PC_SCAN_P = 64, PC_ATT_P = 512, PC_ATT_S = 128, PC_SCAN_S = 128, PC_ITEMS = PC_SCAN_P + PC_ATT_P + PC_ATT_S + PC_SCAN_S;
DI void phase_c(const Ctx& C0, int l) {
    LAS int* slot = (LAS int*)(C0.lds + MISC_OFF + 64);
    for (;;) {
        __syncthreads();
        if (C0.tid == 0) *slot = (int)atomicAdd(C0.ctl + CW_QUEUE + 64 * l, 1u);
        __syncthreads();
        int it = *slot;
        if (it >= PC_ITEMS) break;
        Ctx K = C0; { asm volatile("" : "+s"(K.ws), "+s"(K.out)); int t_ = K.tid; asm volatile("" : "+v"(t_)); K.tid = t_; K.lane = t_ & 63; K.wave = __builtin_amdgcn_readfirstlane(t_ >> 6); }
        const Ctx& C = K;
        if (it < PC_SCAN_P || it >= PC_SCAN_P + PC_ATT_P + PC_ATT_S) {
            int row0, T, h; const float* S0; float* So;
            if (it < PC_SCAN_P) { const int b = it >> 4; h = it & 15; row0 = b * 2048; T = 2048; S0 = nullptr; So = C.out + O_RW_P + ((size_t)(l * 4 + b) * 16 + h) * 4096; }
            else { const int u = it - (PC_SCAN_P + PC_ATT_P + PC_ATT_S), b = u >> 4; h = u & 15; row0 = NTP + b * 4; T = 4; S0 = C.inp(6) + ((size_t)(l * 8 + b) * 16 + h) * 4096; So = C.out + O_RW_S + ((size_t)(l * 8 + b) * 16 + h) * 4096; }
#if (C_MASK & 1)
            scan_head(C, l, row0, T, h, S0, So);
#endif
        } else if (it < PC_SCAN_P + PC_ATT_P) {
            const int u = it - PC_SCAN_P, qt = 31 - (u >> 4), bk = u & 15;
#if (C_MASK & 2)
            nsa_prompt_unit(C, l, bk >> 2, bk & 3, qt);
#endif
        } else {
            const int u = it - (PC_SCAN_P + PC_ATT_P);
#if (C_MASK & 4)
            nsa_sample_item(C, l, u >> 4, (u >> 2) & 3, u & 3);
#endif
        }
    }
    __syncthreads();
}

DI const float* xin_row(const Ctx& C, int l, size_t m) {
    if (l == 0) return m < (size_t)NTP ? C.inp(0) + m * DM : C.inp(1) + (m - NTP) * DM;
    return wsp<float>(C, WS_XF1) + m * DM;
}
DI void phase_e(const Ctx& C, int l) {
    const int lane = C.lane;
    const float* H = wsp<float>(C, WS_HS);
    float* X1F = wsp<float>(C, WS_X1F); bf16* X1B = wsp<bf16>(C, WS_X1B);
    const float* gw = C.inp(22) + (size_t)l * DM; const float* bw = C.inp(23) + (size_t)l * DM;
    for (int m = blockIdx.x * NWAVES + C.wave; m < NT; m += C.G * NWAVES) {
        const f32x4* xr = (const f32x4*)xin_row(C, l, m) + lane; const f32x4* hr = (const f32x4*)(H + (size_t)m * DM) + lane;
        f32x4 v[8]; float s = 0.f;
#pragma unroll
        for (int j = 0; j < 8; ++j) { v[j] = xr[64 * j] * DN_ALPHA + hr[64 * j]; s += (v[j][0] + v[j][1]) + (v[j][2] + v[j][3]); }
        const float mean = wave_sum(s) * (1.f / DM); float s2 = 0.f;
#pragma unroll
        for (int j = 0; j < 8; ++j) { v[j] = v[j] - mean; s2 += (v[j][0] * v[j][0] + v[j][1] * v[j][1]) + (v[j][2] * v[j][2] + v[j][3] * v[j][3]); }
        const float rstd = 1.f / sqrtf(wave_sum(s2) * (1.f / DM) + LN_EPS);
#pragma unroll
        for (int j = 0; j < 8; ++j) { const f32x4 gg = ((const f32x4*)gw)[lane + 64 * j], bb = ((const f32x4*)bw)[lane + 64 * j];
            const f32x4 o = v[j] * rstd * gg + bb;
            ((f32x4*)(X1F + (size_t)m * DM))[lane + 64 * j] = o;
            v2u p; p.x = pk2(o[0], o[1]); p.y = pk2(o[2], o[3]); ((v2u*)(X1B + (size_t)m * DM))[lane + 64 * j] = p; }
    }
}

DI float gelu_erf(float x) { return 0.5f * x * (1.f + erff(x * 0.70710678118654752f)); }
DI void phase_g(const Ctx& C, int l) {
    const int tid = C.tid, lane = C.lane, wave = C.wave;
    LAS float* FACC = (LAS float*)C.lds;
    LAS float* RED = (LAS float*)(C.lds + 65536);
    const float* Sc = wsp<float>(C, WS_HS);
    const float* X1F = wsp<float>(C, WS_X1F);
    const bf16* UB = wsp<bf16>(C, WS_UB) + (size_t)l * NEXP * DM; const bf16* VB = wsp<bf16>(C, WS_VB) + (size_t)l * NEXP * DM;
    const float* gw = C.inp(28) + (size_t)l * DM; const float* bw = C.inp(29) + (size_t)l * DM;
    for (int m = blockIdx.x; m < NT; m += C.G) {
        const float* sr = Sc + (size_t)m * DM + wave * 256;
        float a0 = sr[lane], a1 = sr[64 + lane], b0 = sr[128 + lane], b1 = sr[192 + lane];
        float hv0 = 0.f, hv1 = 0.f; int hi0 = 0, hi1 = 0;
        for (int r = 0; r < 16; ++r) {
            { const float wm = wave_max(fmaxf(a0, a1)); const int c = a0 == wm ? lane : (a1 == wm ? lane + 64 : (1 << 20)); const int wi = wave_min_i(c);
              if (lane == r) { hv0 = wm; hi0 = wi; } if (wi == lane) a0 = -INFINITY; if (wi == lane + 64) a1 = -INFINITY; }
            { const float wm = wave_max(fmaxf(b0, b1)); const int c = b0 == wm ? lane : (b1 == wm ? lane + 64 : (1 << 20)); const int wi = wave_min_i(c);
              if (lane == r) { hv1 = wm; hi1 = wi; } if (wi == lane) b0 = -INFINITY; if (wi == lane + 64) b1 = -INFINITY; }
        }
        float cd[4];
        { const float x0 = __shfl(hv0, lane >> 2);
#pragma unroll
          for (int jj = 0; jj < 4; ++jj) cd[jj] = x0 + __shfl(hv1, (lane & 3) * 4 + jj); }
        float tv = -INFINITY; int tpos = 0;
        for (int r = 0; r < 16; ++r) {
            const float wm = wave_max(fmaxf(fmaxf(cd[0], cd[1]), fmaxf(cd[2], cd[3])));
            const int c = cd[0] == wm ? lane * 4 : (cd[1] == wm ? lane * 4 + 1 : (cd[2] == wm ? lane * 4 + 2 : (cd[3] == wm ? lane * 4 + 3 : (1 << 20))));
            const int wp = wave_min_i(c);
            if (lane == r) { tv = wm; tpos = wp; }
            if ((wp >> 2) == lane) { const int e = wp & 3; cd[0] = e == 0 ? -INFINITY : cd[0]; cd[1] = e == 1 ? -INFINITY : cd[1]; cd[2] = e == 2 ? -INFINITY : cd[2]; cd[3] = e == 3 ? -INFINITY : cd[3]; }
        }
        const int ex = __shfl(hi0, tpos >> 4) * 128 + __shfl(hi1, tpos & 15);
        const float tmax = __shfl(tv, 0);
        const float ev = lane < 16 ? expf(tv - tmax) : 0.f;
        const float gate = ev / wave_sum(ev);
        float x[32];
        { const f32x4* xr = (const f32x4*)(X1F + (size_t)m * DM);
#pragma unroll
          for (int k = 0; k < 4; ++k) { const f32x4 a = xr[2 * lane + 128 * k], b = xr[2 * lane + 128 * k + 1];
#pragma unroll
              for (int e = 0; e < 4; ++e) { x[8 * k + e] = a[e]; x[8 * k + 4 + e] = b[e]; } } }
        float acc[32];
#pragma unroll
        for (int i = 0; i < 32; ++i) acc[i] = 0.f;
        for (int r = 0; r < 16; ++r) {
            const int e = __builtin_amdgcn_readfirstlane(__shfl(ex, r));
            const float gt = __shfl(gate, r);
            const v4u* ur = (const v4u*)(UB + (size_t)e * DM); const v4u* vr = (const v4u*)(VB + (size_t)e * DM);
            v4u uu[4], vv[4];
#pragma unroll
            for (int k = 0; k < 4; ++k) { uu[k] = ur[lane + 64 * k]; vv[k] = vr[lane + 64 * k]; }
            float dot = 0.f;
#pragma unroll
            for (int k = 0; k < 4; ++k) { dot += bflo(uu[k].x) * x[8 * k] + bfhi(uu[k].x) * x[8 * k + 1] + bflo(uu[k].y) * x[8 * k + 2] + bfhi(uu[k].y) * x[8 * k + 3]
                                               + bflo(uu[k].z) * x[8 * k + 4] + bfhi(uu[k].z) * x[8 * k + 5] + bflo(uu[k].w) * x[8 * k + 6] + bfhi(uu[k].w) * x[8 * k + 7]; }
            dot = wave_sum(dot);
            const float wgt = gt * gelu_erf(dot);
#pragma unroll
            for (int k = 0; k < 4; ++k) { acc[8 * k] += wgt * bflo(vv[k].x); acc[8 * k + 1] += wgt * bfhi(vv[k].x); acc[8 * k + 2] += wgt * bflo(vv[k].y); acc[8 * k + 3] += wgt * bfhi(vv[k].y);
                                           acc[8 * k + 4] += wgt * bflo(vv[k].z); acc[8 * k + 5] += wgt * bfhi(vv[k].z); acc[8 * k + 6] += wgt * bflo(vv[k].w); acc[8 * k + 7] += wgt * bfhi(vv[k].w); }
        }
        __syncthreads();
#pragma unroll
        for (int k = 0; k < 4; ++k) { *(LAS f32x4*)(FACC + wave * DM + 8 * lane + 512 * k) = (f32x4){acc[8 * k], acc[8 * k + 1], acc[8 * k + 2], acc[8 * k + 3]};
                                       *(LAS f32x4*)(FACC + wave * DM + 8 * lane + 512 * k + 4) = (f32x4){acc[8 * k + 4], acc[8 * k + 5], acc[8 * k + 6], acc[8 * k + 7]}; }
        __syncthreads();
        f32x4 y = ((const f32x4*)(X1F + (size_t)m * DM))[tid] * DN_ALPHA;
#pragma unroll
        for (int w = 0; w < 8; ++w) y = y + *(const LAS f32x4*)(FACC + w * DM + 4 * tid);
        float s = wave_sum((y[0] + y[1]) + (y[2] + y[3]));
        if (lane == 0) RED[wave] = s;
        __syncthreads();
        float tot = 0.f;
#pragma unroll
        for (int w = 0; w < 8; ++w) tot += RED[w];
        const float mean = tot * (1.f / DM);
        y = y - mean;
        float s2 = wave_sum((y[0] * y[0] + y[1] * y[1]) + (y[2] * y[2] + y[3] * y[3]));
        if (lane == 0) RED[8 + wave] = s2;
        __syncthreads();
        float tot2 = 0.f;
#pragma unroll
        for (int w = 0; w < 8; ++w) tot2 += RED[8 + w];
        const float rstd = 1.f / sqrtf(tot2 * (1.f / DM) + LN_EPS);
        const f32x4 o = y * rstd * ((const f32x4*)gw)[tid] + ((const f32x4*)bw)[tid];
        if (l == 0) { ((f32x4*)(wsp<float>(C, WS_XF1) + (size_t)m * DM))[tid] = o;
            v2u p; p.x = pk2(o[0], o[1]); p.y = pk2(o[2], o[3]); ((v2u*)(wsp<bf16>(C, WS_XB) + (size_t)m * DM))[tid] = p; }
        else { float* dst = m < NTP ? C.out + O_YP + (size_t)m * DM : C.out + O_YS + (size_t)(m - NTP) * DM; ((f32x4*)dst)[tid] = o; }
    }
    __syncthreads();
}

#ifndef PH_MASK
#define PH_MASK 0xFF
#endif
#define IN(k) (lo <= (k) && (k) < hi)
#define EN(s) ((PH_MASK >> (s)) & 1)
#define FRESH(CX) Ctx CX = C; { asm volatile("" : "+s"(CX.ws), "+s"(CX.out)); int t_ = CX.tid; asm volatile("" : "+v"(t_)); CX.tid = t_; CX.lane = t_ & 63; CX.wave = __builtin_amdgcn_readfirstlane(t_ >> 6); CX.ctl = (unsigned*)(CX.ws + WS_CTL); }
#define SEAM(k) do { if (IN(k) && IN((k) + 1)) xcd_barrier(bar); } while (0)
template <int l> DI void run_layer(const Ctx& C, const XcdBarrier& bar, int lo, int hi) {
        const int pb = 1 + 7 * l;
        if (EN(0) && IN(pb + 0)) {
            FRESH(K);
            pg8::Gemm g{wsp<bf16>(K, WS_XB), wsp<bf16>(K, WS_WIN) + (size_t)l * PLD * DM, MP, PLD, DM}; pg8::StaticOrder S; S.init(MP, PLD, K.G, (int)blockIdx.x);
            EpiInProj E{wsp<bf16>(K, WS_PROJ), K.out, l};
            pg8::gemm_phase<EpiInProj, pg8::StaticOrder, true, true>(K.lds, g, S, E);
        }
        SEAM(pb + 0);
        if (EN(1) && IN(pb + 1)) { FRESH(K); phase_b(K, l); }
        SEAM(pb + 1);
        if (EN(2) && IN(pb + 2)) { FRESH(K); phase_c(K, l); }
        SEAM(pb + 2);
        if (EN(3) && IN(pb + 3)) {
            FRESH(K);
            pg8::Gemm g{wsp<bf16>(K, WS_MIX), wsp<bf16>(K, WS_WOUT) + (size_t)l * DM * DM, MP, DM, DM}; pg8::StaticOrder S; S.init(MP, DM, K.G, (int)blockIdx.x);
            pg8::EpiF32 E{wsp<float>(K, WS_HS), DM, nullptr};
            pg8::gemm_phase<pg8::EpiF32, pg8::StaticOrder, true, true>(K.lds, g, S, E);
        }
        SEAM(pb + 3);
        if (EN(4) && IN(pb + 4)) { FRESH(K); phase_e(K, l); }
        SEAM(pb + 4);
        if (EN(5) && IN(pb + 5)) {
            FRESH(K);
            pg8::Gemm g{wsp<bf16>(K, WS_X1B), wsp<bf16>(K, WS_W2) + (size_t)l * DM * DM, MP, DM, DM}; pg8::StaticOrder S; S.init(MP, DM, K.G, (int)blockIdx.x);
            pg8::EpiF32 E{wsp<float>(K, WS_HS), DM, nullptr};
            pg8::gemm_phase<pg8::EpiF32, pg8::StaticOrder, true, true>(K.lds, g, S, E);
        }
        SEAM(pb + 5);
        if (EN(6) && IN(pb + 6)) { FRESH(K); phase_g(K, l); }
        SEAM(pb + 6);
}
typedef ArgsK Args;
__global__ void __launch_bounds__(NTHREADS, 2) fwd_kernel(Args args) {
    extern __shared__ __attribute__((aligned(16))) unsigned char lds[];
    Ctx C;
    C.out = args.out; C.ws = args.ws; C.lds = (LAS unsigned char*)lds; C.ctl = (unsigned*)(args.ws + WS_CTL);
    C.tid = threadIdx.x; C.lane = C.tid & 63; C.wave = __builtin_amdgcn_readfirstlane(C.tid >> 6); C.G = gridDim.x;
    volatile LAS unsigned* MISC = (volatile LAS unsigned*)(C.lds + MISC_OFF);
    for (int u = C.tid; u < (LDS_BYTES - RING_BYTES) / 4; u += NTHREADS) ((LAS unsigned*)(C.lds + RING_BYTES))[u] = 0u;
    __syncthreads();
    XcdBarrier bar; bar.bar = C.ctl + CW_BAR; bar.x = 0; bar.st = nullptr;
    if (args.use_bar) bar = xcd_barrier_post(C.ctl + CW_BAR, MISC + 8);
    const int lo = args.ph_lo, hi = args.ph_hi;
    if (EN(7) && IN(0)) { FRESH(K); p0_prologue(K); }
    SEAM(0);
    run_layer<0>(C, bar, lo, hi);
    run_layer<1>(C, bar, lo, hi);
#undef IN
#undef SEAM
}

#ifndef MK_ONE_LAUNCH
#define MK_ONE_LAUNCH 1
#endif
extern "C" void kernel_launch(void* const* d_in, const int* in_sizes, int n_in, void* d_out, int out_size, void* d_ws, size_t ws_size, hipStream_t stream) {
    static int grid = 0;
    if (grid == 0) {
        if (n_in != 30 || out_size != (int)O_END || ws_size < WS_END) { fprintf(stderr, "kernel_launch: unexpected shapes (n_in %d, out %d, ws %zu < %zu); nothing launched\n", n_in, out_size, ws_size, (size_t)WS_END); grid = -1; return; }
        int dev = 0, cus = 0, per_cu = 0;
        if (hipGetDevice(&dev) != hipSuccess || hipDeviceGetAttribute(&cus, hipDeviceAttributeMultiprocessorCount, dev) != hipSuccess) { grid = -1; return; }
        if (hipFuncSetAttribute((const void*)fwd_kernel, hipFuncAttributeMaxDynamicSharedMemorySize, LDS_BYTES) != hipSuccess) { fprintf(stderr, "kernel_launch: hipFuncSetAttribute failed\n"); grid = -1; return; }
        if (hipOccupancyMaxActiveBlocksPerMultiprocessor(&per_cu, (const void*)fwd_kernel, NTHREADS, LDS_BYTES) != hipSuccess || per_cu < 1) { fprintf(stderr, "kernel_launch: occupancy query says %d blocks per CU\n", per_cu); }
        (void)hipGetLastError();
        grid = cus;
    }
    if (grid < 0) return;
    if (hipMemsetAsync((char*)d_ws + WS_CTL, 0, CTL_ZERO_BYTES, stream) != hipSuccess) return;
    Args a{};
    for (int i = 0; i < 30; ++i) a.in[i] = (const float*)d_in[i];
    a.out = (float*)d_out; a.ws = (unsigned char*)d_ws;
#if MK_ONE_LAUNCH
    a.ph_lo = 0; a.ph_hi = N_PHASES; a.use_bar = 1;
    hipLaunchKernelGGL(fwd_kernel, dim3(grid), dim3(NTHREADS), LDS_BYTES, stream, a);
#else
    for (int p = 0; p < N_PHASES; ++p) { a.ph_lo = p; a.ph_hi = p + 1; a.use_bar = 0; hipLaunchKernelGGL(fwd_kernel, dim3(grid), dim3(NTHREADS), LDS_BYTES, stream, a); }
#endif
}
```

```cpp
#include <hip/hip_runtime.h>
#include <cstdio>
#include <cstdint>
namespace pg8 {
#define PG8_LAS __attribute__((address_space(3)))
typedef unsigned short bf16_t;
typedef short bf16x8 __attribute__((ext_vector_type(8)));
typedef float f32x4 __attribute__((ext_vector_type(4)));
typedef unsigned u32x4 __attribute__((ext_vector_type(4)));
constexpr int BM = 256, BK = 64, HALF = 128, HTB = HALF * BK * 2  , STAGE_BYTES = 8 * HTB, NXCD = 8, WGM = 8;

__host__ __device__ __forceinline__ int lds_byte(int r, int c) { const int st = (r >> 4) * 2 + (c >> 5), rr = r & 15, cc = c & 31, ob = rr * 64 + cc * 2; return st * 1024 + (ob ^ (((ob >> 9) & 1) << 5)); }
__host__ __device__ __forceinline__ void stage_rc(int b, int& R, int& C) { const int st = b / 1024, sb = b % 1024, swz = sb ^ (((sb >> 9) & 1) << 5); R = (st >> 1) * 16 + swz / 64; C = (st & 1) * 32 + (swz % 64) / 2; }
__host__ __device__ __forceinline__ int perm32(int rho) { const int n = rho >> 4, i = rho & 15; return 8 * (i >> 2) + 4 * n + (i & 3); }

struct Unit { int pm, pn; };
struct Gemm { const bf16_t* A; const bf16_t* Bt; int M, N, K; };

struct StaticOrder {
    int nM, nN, nwg, G, c;
    __host__ __device__ void init(int M, int N, int G_, int c_) { nM = M / BM; nN = N / BM; nwg = nM * nN; G = G_; c = c_; }
    __host__ __device__ bool next(int i, Unit& u) const {
        const long L = (long)i * G + c; if (L >= nwg) return false;
        int wgid = (int)L; { const int q = nwg / NXCD, r = nwg % NXCD, xcd = wgid % NXCD, off = wgid / NXCD; wgid = (xcd < r ? xcd * (q + 1) : r * (q + 1) + (xcd - r) * q) + off; }
        const int nig = WGM * nN, gid = wgid / nig, fm = gid * WGM, gsz = (nM - fm) < WGM ? (nM - fm) : WGM;
        u.pm = fm + ((wgid % nig) % gsz); u.pn = (wgid % nig) / gsz; return true;
    }
    __device__ __forceinline__ void a_ready(const Unit&) const {}
    __device__ __forceinline__ void done(const Unit&) const {}
};

__device__ __forceinline__ unsigned cvt_pk_bf16(float lo, float hi) { unsigned r; asm volatile("v_cvt_pk_bf16_f32 %0, %1, %2" : "=v"(r) : "v"(lo), "v"(hi)); return r; }
typedef float f32x2 __attribute__((ext_vector_type(2)));
struct EpiF32 {
    static constexpr bool PERM = false, AFTER_DRAIN = false;
    float* C; int ldc; const float* bias;
    __device__ __forceinline__ void operator()(const f32x4 (&acc)[2][2][4][2], const Unit& u, int wr, int wc, int fr, int fq) const {
        const int row0 = u.pm * BM + wr * 64 + fr, col0 = u.pn * BM + wc * 32 + 4 * fq;
        f32x4 bv[2][2];
#pragma unroll
        for (int bj = 0; bj < 2; ++bj)
#pragma unroll
            for (int n = 0; n < 2; ++n) bv[bj][n] = bias ? *(const f32x4*)(bias + col0 + bj * HALF + n * 16) : (f32x4){0.f, 0.f, 0.f, 0.f};
#pragma unroll
        for (int ai = 0; ai < 2; ++ai)
#pragma unroll
            for (int m = 0; m < 4; ++m) { float* rowp = C + (size_t)(row0 + ai * HALF + m * 16) * ldc + col0;
#pragma unroll
                for (int bj = 0; bj < 2; ++bj)
#pragma unroll
                    for (int n = 0; n < 2; ++n) *(f32x4*)(rowp + bj * HALF + n * 16) = acc[ai][bj][m][n] + bv[bj][n]; }
    }
};
template <class Epi, class Sched, bool ALIGN_EPI = false, bool SP2 = false>
__device__ __forceinline__ void gemm_phase(PG8_LAS unsigned char* lds, const Gemm g, const Sched& S, const Epi& E) {
    const int tid = threadIdx.x, wid = __builtin_amdgcn_readfirstlane(tid >> 6), lane = tid & 63, wr = wid >> 2, wc = wid & 3, fr = lane & 15, fq = lane >> 4;
    const int K = g.K, nt = K / BK;
    unsigned voffA[2], voffB[2];
#pragma unroll
    for (int i = 0; i < 2; ++i) { int R, C; stage_rc(tid * 16 + i * 8192, R, C); const int Rb = Epi::PERM ? ((R & ~31) + perm32(R & 31)) : R;
        voffA[i] = (unsigned)(R * K + C) * 2u; voffB[i] = (unsigned)(Rb * K + C) * 2u; }
    const size_t kstep = (size_t)(BK * 2);
    const size_t hstep = (size_t)HALF * K * 2;
    const size_t tstep = 2 * hstep;
    const unsigned ldsw = (unsigned)wid * 1024u;
    const int aoff = lds_byte(wr * 64 + fr, fq * 8), boff = lds_byte(wc * 32 + fr, fq * 8);
#define PG8_SA(b, h) (((b) * 2 + (h)) * HTB)
#define PG8_SB(b, h) ((4 + (b) * 2 + (h)) * HTB)
#define PG8_STAGE(bufoff, gbase, voff) do { _Pragma("unroll") for (int _i = 0; _i < 2; ++_i) \
        __builtin_amdgcn_global_load_lds((const unsigned*)((const char*)(gbase) + (voff)[_i]), (PG8_LAS unsigned*)(lds + (bufoff) + ldsw + _i * 8192), 16, 0, 0); } while (0)
#define PG8_LDA(dst, b, h) do { _Pragma("unroll") for (int m = 0; m < 4; ++m) _Pragma("unroll") for (int k = 0; k < 2; ++k) dst[m][k] = *(const PG8_LAS bf16x8*)(lds + PG8_SA(b, h) + aoff + m * 2048 + k * 1024); } while (0)
#define PG8_LDB(dst, b, h) do { _Pragma("unroll") for (int n = 0; n < 2; ++n) _Pragma("unroll") for (int k = 0; k < 2; ++k) dst[n][k] = *(const PG8_LAS bf16x8*)(lds + PG8_SB(b, h) + boff + n * 2048 + k * 1024); } while (0)
#define PG8_MMA(ai, bj, At, Bt) do { __builtin_amdgcn_s_setprio(1); _Pragma("unroll") for (int m = 0; m < 4; ++m) _Pragma("unroll") for (int n = 0; n < 2; ++n) _Pragma("unroll") for (int k = 0; k < 2; ++k) \
        acc[ai][bj][m][n] = __builtin_amdgcn_mfma_f32_16x16x32_bf16(Bt[n][k], At[m][k], acc[ai][bj][m][n], 0, 0, 0); __builtin_amdgcn_s_setprio(0); } while (0)
#define PG8_WAIT_V(n) asm volatile("s_waitcnt vmcnt(" #n ")" ::: "memory")
#define PG8_WAIT_L(n) asm volatile("s_waitcnt lgkmcnt(" #n ")" ::: "memory")
#define PG8_BAR __builtin_amdgcn_s_barrier()
#define PG8_SCHED __builtin_amdgcn_sched_barrier(0)
    Unit cur, nxt; int ui = 0;
    if (!S.next(0, cur)) return;
    f32x4 acc[2][2][4][2];
#pragma unroll
    for (int a = 0; a < 2; ++a)
#pragma unroll
        for (int b = 0; b < 2; ++b)
#pragma unroll
            for (int m = 0; m < 4; ++m)
#pragma unroll
                for (int n = 0; n < 2; ++n) acc[a][b][m][n] = (f32x4){0.f, 0.f, 0.f, 0.f};
    bf16x8 At[4][2], B0[2][2], B1[2][2];
    const char* cA = (const char*)g.A + (size_t)cur.pm * tstep; const char* cB = (const char*)g.Bt + (size_t)cur.pn * tstep;
    S.a_ready(cur);
    if constexpr (SP2) {
        PG8_STAGE(PG8_SB(0, 0), cB, voffB); PG8_STAGE(PG8_SB(0, 1), cB + hstep, voffB); PG8_STAGE(PG8_SA(0, 0), cA, voffA); PG8_STAGE(PG8_SA(0, 1), cA + hstep, voffA);
        if (wr == 1) PG8_BAR;
        PG8_WAIT_V(2); PG8_BAR;
        PG8_STAGE(PG8_SB(1, 0), cB + kstep, voffB); PG8_STAGE(PG8_SA(1, 0), cA + kstep, voffA); PG8_STAGE(PG8_SB(1, 1), cB + hstep + kstep, voffB);
        PG8_WAIT_V(6); PG8_BAR;
    } else {
        PG8_STAGE(PG8_SB(0, 0), cB, voffB); PG8_STAGE(PG8_SA(0, 0), cA, voffA); PG8_STAGE(PG8_SB(0, 1), cB + hstep, voffB); PG8_STAGE(PG8_SA(0, 1), cA + hstep, voffA);
        if (wr == 1) PG8_BAR;
        PG8_WAIT_V(4); PG8_BAR;
        PG8_STAGE(PG8_SB(1, 0), cB + kstep, voffB); PG8_STAGE(PG8_SA(1, 0), cA + kstep, voffA); PG8_STAGE(PG8_SB(1, 1), cB + hstep + kstep, voffB);
        PG8_WAIT_V(6); PG8_BAR;
    }
    for (;;) {
        const bool has_next = S.next(ui + 1, nxt);
        const char* nA = has_next ? (const char*)g.A + (size_t)nxt.pm * tstep : cA; const char* nB = has_next ? (const char*)g.Bt + (size_t)nxt.pn * tstep : cB;
        for (int t = 0; t < nt; t += 2) {
            const bool last = (t == nt - 2);
            const char* a1 = cA + (size_t)(t + 1) * kstep;
            const char* a2 = last ? nA : cA + (size_t)(t + 2) * kstep; const char* b2 = last ? nB : cB + (size_t)(t + 2) * kstep;
            const char* a3 = a2 + kstep; const char* b3 = b2 + kstep;
            if (last && has_next) S.a_ready(nxt);
            if constexpr (SP2) {
            PG8_LDB(B0, 0, 0); PG8_LDB(B1, 0, 1); PG8_SCHED; PG8_LDA(At, 0, 0); PG8_STAGE(PG8_SA(1, 1), a1 + hstep, voffA);
            PG8_WAIT_V(8); PG8_WAIT_L(0); PG8_BAR; PG8_MMA(0, 0, At, B0); PG8_MMA(0, 1, At, B1); PG8_BAR; PG8_SCHED;
            PG8_LDA(At, 0, 1); PG8_STAGE(PG8_SB(0, 0), b2, voffB); PG8_STAGE(PG8_SB(0, 1), b2 + hstep, voffB); PG8_STAGE(PG8_SA(0, 0), a2, voffA);
            PG8_WAIT_V(8); PG8_WAIT_L(0); PG8_BAR; PG8_MMA(1, 0, At, B0); PG8_MMA(1, 1, At, B1); PG8_BAR; PG8_SCHED;
            PG8_LDB(B0, 1, 0); PG8_LDB(B1, 1, 1); PG8_SCHED; PG8_LDA(At, 1, 0); PG8_STAGE(PG8_SA(0, 1), a2 + hstep, voffA);
            PG8_WAIT_V(8); PG8_WAIT_L(0); PG8_BAR; PG8_MMA(0, 0, At, B0); PG8_MMA(0, 1, At, B1); PG8_BAR; PG8_SCHED;
            PG8_LDA(At, 1, 1); PG8_STAGE(PG8_SB(1, 0), b3, voffB); PG8_STAGE(PG8_SB(1, 1), b3 + hstep, voffB); PG8_STAGE(PG8_SA(1, 0), a3, voffA);
            PG8_WAIT_V(8); PG8_WAIT_L(0); PG8_BAR; PG8_MMA(1, 0, At, B0); PG8_MMA(1, 1, At, B1); PG8_BAR; PG8_SCHED;
            } else {
            PG8_LDB(B0, 0, 0); PG8_SCHED; PG8_LDA(At, 0, 0); PG8_STAGE(PG8_SA(1, 1), a1 + hstep, voffA);
            PG8_WAIT_L(8); PG8_BAR; PG8_WAIT_L(0); PG8_MMA(0, 0, At, B0); PG8_BAR; PG8_SCHED;
            PG8_LDB(B1, 0, 1); PG8_STAGE(PG8_SB(0, 0), b2, voffB);
            PG8_BAR; PG8_WAIT_L(0); PG8_MMA(0, 1, At, B1); PG8_BAR;
            PG8_LDA(At, 0, 1); PG8_STAGE(PG8_SA(0, 0), a2, voffA);
            PG8_BAR; PG8_WAIT_L(0); PG8_MMA(1, 0, At, B0); PG8_BAR; PG8_SCHED;
            PG8_STAGE(PG8_SB(0, 1), b2 + hstep, voffB);
            PG8_WAIT_V(6); PG8_BAR; PG8_MMA(1, 1, At, B1); PG8_BAR;
            PG8_LDB(B0, 1, 0); PG8_SCHED; PG8_LDA(At, 1, 0); PG8_STAGE(PG8_SA(0, 1), a2 + hstep, voffA);
            PG8_WAIT_L(8); PG8_BAR; PG8_WAIT_L(0); PG8_MMA(0, 0, At, B0); PG8_BAR; PG8_SCHED;
            PG8_LDB(B1, 1, 1); PG8_STAGE(PG8_SB(1, 0), b3, voffB);
            PG8_BAR; PG8_WAIT_L(0); PG8_MMA(0, 1, At, B1); PG8_BAR;
            PG8_LDA(At, 1, 1); PG8_STAGE(PG8_SA(1, 0), a3, voffA);
            PG8_BAR; PG8_WAIT_L(0); PG8_MMA(1, 0, At, B0); PG8_BAR; PG8_SCHED;
            PG8_STAGE(PG8_SB(1, 1), b3 + hstep, voffB);
            PG8_WAIT_V(6); PG8_BAR; PG8_MMA(1, 1, At, B1); PG8_BAR;
            }
        }
        if constexpr (ALIGN_EPI) { if (wr == 0) PG8_BAR; }
        if constexpr (!Epi::AFTER_DRAIN) { E(acc, cur, wr, wc, fr, fq); S.done(cur); }
        if (!has_next) break;
#pragma unroll
        for (int a = 0; a < 2; ++a)
#pragma unroll
            for (int b = 0; b < 2; ++b)
#pragma unroll
                for (int m = 0; m < 4; ++m)
#pragma unroll
                    for (int n = 0; n < 2; ++n) acc[a][b][m][n] = (f32x4){0.f, 0.f, 0.f, 0.f};
        cur = nxt; cA = nA; cB = nB; ++ui;
        if constexpr (ALIGN_EPI) { if (wr == 1) PG8_BAR; }
    }
    PG8_WAIT_V(0);
    if constexpr (!ALIGN_EPI) { if (wr == 0) PG8_BAR; }
    PG8_BAR;
    if constexpr (Epi::AFTER_DRAIN) { E.fused(acc, cur, wr, wc, fr, fq, lds, wid, lane); S.done(cur); }
#undef PG8_SA
#undef PG8_SB
#undef PG8_STAGE
#undef PG8_LDA
#undef PG8_LDB
#undef PG8_MMA
#undef PG8_WAIT_V
#undef PG8_WAIT_L
#undef PG8_BAR
#undef PG8_SCHED
}
}
#define LAS __attribute__((address_space(3)))
#define XB_TMO      128
#define XB_XCNT(j)  (256  + 64 * (j))
#define XB_XSUB(j)  (1280 + 64 * (j))
#define XB_XGEN(j)  (2304 + 64 * (j))
#define XB_TOP      3328
#define XB_TOPGEN   3392
#define XCD_BAR_WORDS 3456
#define XB_SPIN_CAP (1u << 18)

__device__ __forceinline__ unsigned xb_ld(unsigned* p)              { return __hip_atomic_load(p, __ATOMIC_RELAXED, __HIP_MEMORY_SCOPE_AGENT); }
__device__ __forceinline__ unsigned xb_add(unsigned* p, unsigned v) { return __hip_atomic_fetch_add(p, v, __ATOMIC_RELAXED, __HIP_MEMORY_SCOPE_AGENT); }
__device__ __forceinline__ unsigned xb_xcc_id() { return (unsigned)__builtin_amdgcn_s_getreg((3 << 11) | 20) & 0xFu; }
#define XB_SPIN(cond, bar) do { unsigned _sp = 0; while (cond) { __builtin_amdgcn_s_sleep(1); \
    if ((++_sp & 255u) == 0u) { if (xb_ld(&(bar)[XB_TMO])) break; if (_sp > XB_SPIN_CAP) { atomicAdd(&(bar)[XB_TMO], 1u); break; } } } } while (0)

struct XcdBarrier {
    unsigned* bar; unsigned x;
    volatile LAS unsigned* st;
};

__device__ __forceinline__ XcdBarrier xcd_barrier_post(unsigned* bar, volatile LAS unsigned* st) {
    XcdBarrier b; b.bar = bar; b.x = xb_xcc_id(); b.st = st;
    if (threadIdx.x == 0) (void)xb_add(&bar[XB_XCNT(b.x)], 1u);
    return b;
}
__device__ __forceinline__ void xcd_barrier_complete(unsigned* bar, unsigned x, unsigned& nloc, unsigned& nx) {
    const unsigned G = gridDim.x * gridDim.y * gridDim.z;
    unsigned sum, cnt, mine, sp = 0u;
    for (;;) {
        sum = 0u; cnt = 0u; mine = 0u;
#pragma unroll
        for (unsigned j = 0; j < 16; ++j) { const unsigned c = xb_ld(&bar[XB_XCNT(j)]); sum += c; cnt += (c > 0u) ? 1u : 0u; mine = (j == x) ? c : mine; }
        if (sum == G) break;
        __builtin_amdgcn_s_sleep(1);
        if ((++sp & 255u) == 0u) { if (xb_ld(&bar[XB_TMO])) break; if (sp > XB_SPIN_CAP) { atomicAdd(&bar[XB_TMO], 1u); break; } }
    }
    nloc = mine > 0u ? mine : 1u; nx = cnt > 0u ? cnt : 1u;
}

__device__ __forceinline__ void xcd_barrier(const XcdBarrier& b) {
    asm volatile("s_waitcnt vmcnt(0)" ::: "memory");
    __syncthreads();
    if (threadIdx.x == 0) {
        unsigned* bar = b.bar;
        __builtin_amdgcn_s_waitcnt(0);
        unsigned nloc = b.st[0], nx = b.st[1];
        if (nloc == 0u) { xcd_barrier_complete(bar, b.x, nloc, nx); b.st[0] = nloc; b.st[1] = nx; }
        const unsigned old = xb_add(&bar[XB_XSUB(b.x)], 1u);
        const unsigned gen = old / nloc;
        if (old + 1u == (gen + 1u) * nloc) {
            __builtin_amdgcn_fence(__ATOMIC_RELEASE, "agent");
            asm volatile("s_waitcnt vmcnt(0)" ::: "memory");
            const unsigned og = xb_add(&bar[XB_TOP], 1u);
            const unsigned tg = og / nx;
            if (og + 1u == (tg + 1u) * nx) xb_add(&bar[XB_TOPGEN], 1u);
            else XB_SPIN(xb_ld(&bar[XB_TOPGEN]) == tg, bar);
            __builtin_amdgcn_fence(__ATOMIC_ACQUIRE, "agent");
            xb_add(&bar[XB_XGEN(b.x)], 1u);
            asm volatile("s_waitcnt vmcnt(0)" ::: "memory");
        } else {
            XB_SPIN(xb_ld(&bar[XB_XGEN(b.x)]) == gen, bar);
            __builtin_amdgcn_fence(__ATOMIC_ACQUIRE, "agent");
            asm volatile("s_waitcnt vmcnt(0)" ::: "memory");
        }
    }
    __syncthreads();
}

constexpr int NWAVES = 8, NTHREADS = 512;
constexpr int DM = 2048, NTP = 8192, NTS = 32, NT = 8224, MP = 8448;
constexpr int RW_COLS = 3360, Q_OFF = 3360, KC_OFF = 4384, KS_OFF = 4896, VS_OFF = 5152, KW_OFF = 5408, VW_OFF = 5664, GL_OFF = 5920, IN_COLS = 5968, PLD = 6144;
constexpr int NEXP = 16384, NPOOL = 1280;
constexpr float LN_EPS = 1e-5f, GN_EPS = 64e-5f, DN_ALPHA = 1.4142135623730951f;
constexpr float NEG_BIG = -1e30f;
constexpr size_t O_YP = 0, O_YS = O_YP + (size_t)NTP * DM, O_CMP_P = O_YS + (size_t)NTS * DM, O_SEL_P = O_CMP_P + (size_t)2 * NTP * 512, O_WIN_P = O_SEL_P + (size_t)2 * NTP * 512,
                 O_RW_P = O_WIN_P + (size_t)2 * 4 * 512 * 512, O_SH_P = O_RW_P + (size_t)2 * 4 * 16 * 4096, O_CMP_S = O_SH_P + (size_t)2 * 4 * RW_COLS, O_SEL_S = O_CMP_S + (size_t)2 * NTS * 512,
                 O_WIN_S = O_SEL_S + (size_t)2 * NTS * 512, O_RW_S = O_WIN_S + (size_t)2 * 8 * 512 * 512, O_SH_S = O_RW_S + (size_t)2 * 8 * 16 * 4096, O_END = O_SH_S + (size_t)2 * 8 * RW_COLS;
static_assert(O_END == 41630464, "output size");
constexpr size_t MiB = 1ull << 20;
constexpr size_t WS_CTL = 0, CTL_ZERO_BYTES = 1 * MiB;
constexpr size_t WS_WIN = 1 * MiB;
constexpr size_t WS_WOUT = WS_WIN + 48 * MiB;
constexpr size_t WS_W2 = WS_WOUT + 16 * MiB;
constexpr size_t WS_UB = WS_W2 + 16 * MiB;
constexpr size_t WS_VB = WS_UB + 64 * MiB;
constexpr size_t WS_USC = WS_VB + 64 * MiB;
constexpr size_t WS_XB = WS_USC + 1 * MiB;
constexpr size_t WS_X1B = WS_XB + 33 * MiB;
constexpr size_t WS_XF1 = WS_X1B + 33 * MiB;
constexpr size_t WS_X1F = WS_XF1 + 65 * MiB;
constexpr size_t WS_PROJ = WS_X1F + 65 * MiB;
constexpr size_t WS_SC = WS_PROJ + 99 * MiB;
constexpr size_t SC_STRIDE = 33 * MiB;
constexpr size_t WS_GG = WS_SC + 6 * SC_STRIDE;
constexpr size_t WS_BON = WS_GG + 33 * MiB;
constexpr size_t WS_MIX = WS_BON + 1 * MiB;
constexpr size_t WS_HS = WS_MIX + 33 * MiB;
constexpr size_t WS_KCB = WS_HS + 66 * MiB;
constexpr size_t WS_VCBT = WS_KCB + 512 * 1024;
constexpr size_t WS_VTS = WS_KCB + 1 * MiB;
constexpr size_t WS_VTW = WS_VTS + 4 * MiB;
constexpr size_t WS_KCBS = WS_VTW + 4 * MiB;
constexpr size_t WS_VCBS = WS_KCBS + 17 * MiB;
constexpr size_t WS_END = WS_VCBS + 17 * MiB;
constexpr int CW_BAR = 4096, CW_QUEUE = 8192;
constexpr int RING_BYTES = 131072, MISC_OFF = RING_BYTES + 320, LDS_BYTES = 147456;
constexpr int N_PHASES = 15;

typedef unsigned short bf16;
typedef unsigned v4u __attribute__((ext_vector_type(4)));
typedef unsigned v2u __attribute__((ext_vector_type(2)));
typedef float f32x4 __attribute__((ext_vector_type(4)));
typedef float f32x16 __attribute__((ext_vector_type(16)));
typedef short bf16x8 __attribute__((ext_vector_type(8)));
typedef float f32x2_t __attribute__((ext_vector_type(2)));
typedef __bf16 bf16x2_t __attribute__((ext_vector_type(2)));
#define LDS_WAIT() asm volatile("s_waitcnt lgkmcnt(0)" ::: "memory")
#define DI __device__ __forceinline__

DI unsigned pk2(float lo, float hi) { f32x2_t v = {lo, hi}; bf16x2_t b = __builtin_convertvector(v, bf16x2_t); return __builtin_bit_cast(unsigned, b); }
DI float bf2f(unsigned short u) { return __builtin_bit_cast(float, (unsigned)u << 16); }
DI float bflo(unsigned u) { return __builtin_bit_cast(float, u << 16); }
DI float bfhi(unsigned u) { return __builtin_bit_cast(float, u & 0xffff0000u); }
template <int CTRL> DI float dppf(float v) { return __builtin_bit_cast(float, __builtin_amdgcn_update_dpp(0, __builtin_bit_cast(int, v), CTRL, 0xF, 0xF, false)); }
DI float rdlane(float v, int l) { return __builtin_bit_cast(float, __builtin_amdgcn_readlane(__builtin_bit_cast(int, v), l)); }
DI float wave_sum(float v) {
    v += dppf<0xB1>(v); v += dppf<0x4E>(v); v += dppf<0x141>(v); v += dppf<0x140>(v);
    return (rdlane(v, 0) + rdlane(v, 16)) + (rdlane(v, 32) + rdlane(v, 48));
}
DI float wave_max(float v) {
    v = fmaxf(v, dppf<0xB1>(v)); v = fmaxf(v, dppf<0x4E>(v)); v = fmaxf(v, dppf<0x141>(v)); v = fmaxf(v, dppf<0x140>(v));
    return fmaxf(fmaxf(rdlane(v, 0), rdlane(v, 16)), fmaxf(rdlane(v, 32), rdlane(v, 48)));
}
DI float sigmoidf_(float x) { return 1.f / (1.f + expf(-x)); }
DI int crow(int reg, int h) { return (reg & 3) + 8 * (reg >> 2) + 4 * h; }

struct ArgsK { const float* in[30]; float* out; unsigned char* ws; int ph_lo, ph_hi, use_bar, pad; };
typedef __attribute__((address_space(4))) const ArgsK* kargp_t;
struct Ctx {
    float* out; unsigned char* ws;
    LAS unsigned char* lds; unsigned* ctl;
    int tid, lane, wave, G;
    DI const float* inp(int k) const { kargp_t p = (kargp_t)__builtin_amdgcn_kernarg_segment_ptr(); asm volatile("" : "+s"(p)); return p->in[k]; }
};
template <class T> DI T* wsp(const Ctx& C, size_t off) { return (T*)(C.ws + off); }

struct EpiInProj {
    static constexpr bool PERM = true, AFTER_DRAIN = false;
    bf16* P; float* out; int l;
    DI void operator()(const pg8::f32x4 (&acc)[2][2][4][2], const pg8::Unit& u, int wr, int wc, int fr, int fq) const {
        const int row0 = u.pm * 256 + wr * 64 + fr, col0 = u.pn * 256 + wc * 32 + 8 * fq;
#pragma unroll
        for (int bj = 0; bj < 2; ++bj) {
            const int colb = __builtin_amdgcn_readfirstlane(u.pn * 256 + wc * 32 + bj * 128);
            const int col = col0 + bj * 128;
            const int kind = colb < RW_COLS ? 1 : ((colb >= KC_OFF && colb < GL_OFF) ? 2 : 0);
            const int reg = (colb - KC_OFF) >> 9, cc = (col - KC_OFF) & 511;
#pragma unroll
            for (int ai = 0; ai < 2; ++ai)
#pragma unroll
                for (int m = 0; m < 4; ++m) {
                    const int row = row0 + ai * 128 + m * 16;
                    const pg8::f32x4 v0 = acc[ai][bj][m][0], v1 = acc[ai][bj][m][1];
                    v4u w; w.x = pk2(v0[0], v0[1]); w.y = pk2(v0[2], v0[3]); w.z = pk2(v1[0], v1[1]); w.w = pk2(v1[2], v1[3]);
                    *(v4u*)(P + (size_t)row * PLD + col) = w;
                    if (kind == 0 || row >= NT) continue;
                    unsigned off = 0xffffffffu;
                    if (row < NTP) { const int b = row >> 11, t = row & 2047;
                        if (kind == 1) { if (t == 2047) off = (unsigned)(O_SH_P + (size_t)(l * 4 + b) * RW_COLS + col); }
                        else if (reg == 0) off = (unsigned)(O_CMP_P + ((size_t)l * NTP + row) * 512 + cc);
                        else if (reg == 1) off = (unsigned)(O_SEL_P + ((size_t)l * NTP + row) * 512 + cc);
                        else if (t >= 1536) off = (unsigned)(O_WIN_P + ((size_t)(l * 4 + b) * 512 + (t - 1536)) * 512 + cc);
                    } else { const int j = row - NTP, b = j >> 2, t = j & 3;
                        if (kind == 1) { if (t == 3) off = (unsigned)(O_SH_S + (size_t)(l * 8 + b) * RW_COLS + col); }
                        else if (reg == 0) off = (unsigned)(O_CMP_S + ((size_t)l * NTS + j) * 512 + cc);
                        else if (reg == 1) off = (unsigned)(O_SEL_S + ((size_t)l * NTS + j) * 512 + cc);
                        else off = (unsigned)(O_WIN_S + ((size_t)(l * 8 + b) * 512 + 508 + t) * 512 + cc);
                    }
                    if (off != 0xffffffffu) { *(pg8::f32x4*)(out + off) = v0; *(pg8::f32x4*)(out + off + 4) = v1; }
                }
        }
    }
};

DI void transpose_item(const float* W, int K, int N, int Npad, bf16* WT, LAS float* scr, int item, int lane) {
    const int nblk = Npad / 32, kb = item / nblk, nb = item % nblk, k0 = 64 * kb, n0 = 32 * nb;
#pragma unroll 8
    for (int i = 0; i < 32; ++i) { const int kk = 2 * i + (lane >> 5), n = n0 + (lane & 31); scr[kk * 33 + (lane & 31)] = n < N ? W[(size_t)(k0 + kk) * N + n] : 0.f; }
    LDS_WAIT(); asm volatile("" ::: "memory");
    const int c = lane & 7;
#pragma unroll
    for (int j = 0; j < 4; ++j) { const int n = (lane >> 3) + 8 * j; const LAS float* s = scr + (8 * c) * 33 + n;
        v4u o; o.x = pk2(s[0 * 33], s[1 * 33]); o.y = pk2(s[2 * 33], s[3 * 33]); o.z = pk2(s[4 * 33], s[5 * 33]); o.w = pk2(s[6 * 33], s[7 * 33]);
        *(v4u*)(WT + (size_t)(n0 + n) * K + k0 + 8 * c) = o; }
    LDS_WAIT(); asm volatile("" ::: "memory");
}

constexpr int P0_NT = 2048, P0_NW2 = 2048, P0_NTAB = 8192, P0_NX = 2056, P0_NCC = 2048, P0_NWP = 508;
constexpr int P0_ITEMS = P0_NT + P0_NW2 + P0_NTAB + P0_NX + P0_NCC + P0_NWP;

DI void p0_prologue(const Ctx& C) {
    const int tid = C.tid, lane = C.lane, wave = C.wave;
    for (int it = blockIdx.x; it < P0_ITEMS; it += C.G) {
        int r = it;
        if (r < P0_NTAB) {
            const int row = r * 8 + wave;
            const float* src = (row < 32768 ? C.inp(26) : C.inp(27)) + (size_t)(row & 32767) * DM;
            unsigned char* dst = C.ws + (row < 32768 ? WS_UB : WS_VB) + (size_t)(row & 32767) * DM;
            f32x4 v[8]; float am = 0.f;
#pragma unroll
            for (int k = 0; k < 2; ++k)
#pragma unroll
                for (int q = 0; q < 4; ++q) { v[4 * k + q] = ((const f32x4*)src)[4 * lane + 256 * k + q];
                    am = fmaxf(am, fmaxf(fmaxf(fabsf(v[4 * k + q][0]), fabsf(v[4 * k + q][1])), fmaxf(fabsf(v[4 * k + q][2]), fabsf(v[4 * k + q][3])))); }
            am = wave_max(am);
            const float sc = am > 0.f ? am * (1.f / 256.f) : 1.f, inv = 1.f / sc;
#pragma unroll
            for (int k = 0; k < 2; ++k) { v4u o;
#pragma unroll
                for (int q = 0; q < 4; ++q) { const f32x4 x = v[4 * k + q] * inv; int p = __builtin_amdgcn_cvt_pk_fp8_f32(x[0], x[1], 0, false); p = __builtin_amdgcn_cvt_pk_fp8_f32(x[2], x[3], p, true); o[q] = (unsigned)p; }
                ((v4u*)dst)[lane + 64 * k] = o; }
            if (lane == 0) wsp<float>(C, WS_USC)[row] = sc;
            continue;
        }
        r -= P0_NTAB;
        if (r < P0_NCC) {
            const int l = r >> 10, b = (r >> 7) & 7, pi = r & 127;
            const int pid = ((const int*)C.inp(4))[b * 128 + pi];
            const float* src = C.inp(2) + ((size_t)(l * NPOOL + pid) * 128) * 512 + tid;
            const int kv = tid >> 8, kvh = (tid >> 6) & 3, d = tid & 63;
            const float* w = C.inp(20) + (l * 2 + kv) * 32;
            float acc[4] = {0.f, 0.f, 0.f, 0.f};
#pragma unroll
            for (int q = 0; q < 4; ++q)
#pragma unroll 8
                for (int rr = 0; rr < 32; ++rr) acc[q] += w[rr] * src[(size_t)(32 * q + rr) * 512];
            float* dst = wsp<float>(C, kv ? WS_VCBS : WS_KCBS) + ((size_t)((l * 8 + b) * 4 + kvh) * 512 + 4 * pi) * 64 + d;
#pragma unroll
            for (int q = 0; q < 4; ++q) dst[q * 64] = acc[q];
            continue;
        }
        r -= P0_NCC;
        if (r < P0_NT) {
            const int l = r >> 10, w8 = (r & 1023) * 8 + wave;
            LAS float* scr = (LAS float*)(C.lds + wave * 16384);
            if (w8 < 6144) transpose_item(C.inp(8) + (size_t)l * DM * IN_COLS, DM, IN_COLS, PLD, wsp<bf16>(C, WS_WIN) + (size_t)l * PLD * DM, scr, w8, lane);
            else transpose_item(C.inp(21) + (size_t)l * DM * DM, DM, DM, DM, wsp<bf16>(C, WS_WOUT) + (size_t)l * DM * DM, scr, w8 - 6144, lane);
            continue;
        }
        r -= P0_NT;
        if (r < P0_NW2) {
            const int l = r >> 10, hc = (r >> 6) & 15, kb = r & 63;
            LAS float* SK = (LAS float*)C.lds;
            LAS float* WQ = (LAS float*)(C.lds + 128 * 129 * 4);
            __syncthreads();
            const float* sk = C.inp(25) + ((size_t)l * 16 + hc) * 16384;
            for (int i = tid; i < 16384; i += NTHREADS) SK[(i >> 7) * 129 + (i & 127)] = sk[i];
            const float* wq = C.inp(24) + (size_t)l * DM * DM + (size_t)(kb * 32) * DM + hc * 128;
            for (int i = tid; i < 4096; i += NTHREADS) WQ[i] = wq[(size_t)(i >> 7) * DM + (i & 127)];
            __syncthreads();
            const int k = tid & 127, rq = tid >> 7;
            float acc[8];
#pragma unroll
            for (int j = 0; j < 8; ++j) acc[j] = 0.f;
            for (int d = 0; d < 128; d += 4) {
                const float s0 = SK[k * 129 + d], s1 = SK[k * 129 + d + 1], s2 = SK[k * 129 + d + 2], s3 = SK[k * 129 + d + 3];
#pragma unroll
                for (int j = 0; j < 8; ++j) { const f32x4 w = *(const LAS f32x4*)(WQ + (rq * 8 + j) * 128 + d); acc[j] += s0 * w[0] + s1 * w[1] + s2 * w[2] + s3 * w[3]; }
            }
            v4u o; o.x = pk2(acc[0], acc[1]); o.y = pk2(acc[2], acc[3]); o.z = pk2(acc[4], acc[5]); o.w = pk2(acc[6], acc[7]);
            *(v4u*)(wsp<bf16>(C, WS_W2) + (size_t)l * DM * DM + (size_t)(hc * 128 + k) * DM + kb * 32 + rq * 8) = o;
            continue;
        }
        r -= P0_NW2;
        if (r < P0_NX) {
            const size_t e0 = (size_t)r * 8192 + tid * 16;
            const float* src = e0 < (size_t)NTP * DM ? C.inp(0) + e0 : C.inp(1) + (e0 - (size_t)NTP * DM);
            const f32x4* s4 = (const f32x4*)src;
            const f32x4 a = s4[0], b = s4[1], c = s4[2], d = s4[3];
            v4u o0, o1; o0.x = pk2(a[0], a[1]); o0.y = pk2(a[2], a[3]); o0.z = pk2(b[0], b[1]); o0.w = pk2(b[2], b[3]);
            o1.x = pk2(c[0], c[1]); o1.y = pk2(c[2], c[3]); o1.z = pk2(d[0], d[1]); o1.w = pk2(d[2], d[3]);
            v4u* d4 = (v4u*)(wsp<bf16>(C, WS_XB) + e0); d4[0] = o0; d4[1] = o1;
            continue;
        }
        r -= P0_NX;
        {
            const size_t i0 = (size_t)r * 8192 + tid * 16;
            const size_t lb = i0 / 260096, rem = i0 % 260096;
            const f32x4* s4 = (const f32x4*)(C.inp(5) + lb * 262144 + 2048 + rem);
            f32x4* d4 = (f32x4*)(C.out + O_WIN_S + lb * 262144 + rem);
            const f32x4 a = s4[0], b = s4[1], c = s4[2], d = s4[3];
            d4[0] = a; d4[1] = b; d4[2] = c; d4[3] = d;
        }
    }
    __syncthreads();
}

constexpr int PB_NRW = 1028, PB_NPOOL = 256, PB_NVT = 1024, PB_ITEMS = PB_NRW + PB_NPOOL + PB_NVT;
DI float softplusf_(float x) { return x > 20.f ? x : log1pf(expf(x)); }

DI void rwkv_pre_item(const Ctx& C, int l, int item) {
    const int tid = C.tid, lane = C.lane, wave = C.wave;
    LAS float* XS = (LAS float*)C.lds;
    LAS float* ACT = (LAS float*)(C.lds + 8 * RW_COLS * 4);
    const bf16* P = wsp<bf16>(C, WS_PROJ);
    const int m0 = item * 8;
    __syncthreads();
    for (int idx = tid; idx < 8 * 420; idx += NTHREADS) {
        const int j = idx / 420, col = (idx % 420) * 8, m = m0 + j;
        const v4u cu = *(const v4u*)(P + (size_t)m * PLD + col);
        float cur[8] = {bflo(cu.x), bfhi(cu.x), bflo(cu.y), bfhi(cu.y), bflo(cu.z), bfhi(cu.z), bflo(cu.w), bfhi(cu.w)};
        float prev[8];
        int t; const float* sh = nullptr;
        if (m < NTP) t = m & 2047; else { const int jj = m - NTP; t = jj & 3; sh = C.inp(7) + (size_t)(l * 8 + (jj >> 2)) * RW_COLS + col; }
        if (t > 0) { const v4u pu = *(const v4u*)(P + (size_t)(m - 1) * PLD + col);
            prev[0] = bflo(pu.x); prev[1] = bfhi(pu.x); prev[2] = bflo(pu.y); prev[3] = bfhi(pu.y); prev[4] = bflo(pu.z); prev[5] = bfhi(pu.z); prev[6] = bflo(pu.w); prev[7] = bfhi(pu.w);
        } else if (sh) {
#pragma unroll
            for (int e = 0; e < 8; ++e) prev[e] = sh[e];
        } else {
#pragma unroll
            for (int e = 0; e < 8; ++e) prev[e] = 0.f;
        }
        const float* mu = C.inp(9) + (size_t)l * RW_COLS + col;
#pragma unroll
        for (int e = 0; e < 8; ++e) XS[j * RW_COLS + col + e] = cur[e] + mu[e] * (prev[e] - cur[e]);
    }
    __syncthreads();
    for (int idx = tid; idx < 8 * 288; idx += NTHREADS) {
        const int j = idx / 288, a = idx % 288; const float x = XS[j * RW_COLS + 3072 + a];
        ACT[a * 8 + j] = a < 64 ? tanhf(x) : (a < 128 ? x : sigmoidf_(x));
    }
    __syncthreads();
    float wp[2][8], ap[2][8], gp[2][8];
#pragma unroll
    for (int s = 0; s < 2; ++s)
#pragma unroll
        for (int j = 0; j < 8; ++j) { wp[s][j] = 0.f; ap[s][j] = 0.f; gp[s][j] = 0.f; }
    const float* w2 = C.inp(11) + (size_t)l * 64 * 1024 + tid;
    const float* a2 = C.inp(13) + (size_t)l * 64 * 1024 + tid;
    const float* g2 = C.inp(14) + (size_t)l * 160 * 1024 + tid;
#pragma unroll 4
    for (int kk = 0; kk < 64; ++kk) {
        const float wa = w2[kk * 1024], wb = w2[kk * 1024 + 512];
        const f32x4 t0 = *(const LAS f32x4*)(ACT + kk * 8), t1 = *(const LAS f32x4*)(ACT + kk * 8 + 4);
#pragma unroll
        for (int j = 0; j < 4; ++j) { wp[0][j] += t0[j] * wa; wp[1][j] += t0[j] * wb; wp[0][4 + j] += t1[j] * wa; wp[1][4 + j] += t1[j] * wb; }
    }
#pragma unroll 4
    for (int kk = 0; kk < 64; ++kk) {
        const float wa = a2[kk * 1024], wb = a2[kk * 1024 + 512];
        const f32x4 t0 = *(const LAS f32x4*)(ACT + (64 + kk) * 8), t1 = *(const LAS f32x4*)(ACT + (64 + kk) * 8 + 4);
#pragma unroll
        for (int j = 0; j < 4; ++j) { ap[0][j] += t0[j] * wa; ap[1][j] += t0[j] * wb; ap[0][4 + j] += t1[j] * wa; ap[1][4 + j] += t1[j] * wb; }
    }
#pragma unroll 4
    for (int kk = 0; kk < 160; ++kk) {
        const float wa = g2[kk * 1024], wb = g2[kk * 1024 + 512];
        const f32x4 t0 = *(const LAS f32x4*)(ACT + (128 + kk) * 8), t1 = *(const LAS f32x4*)(ACT + (128 + kk) * 8 + 4);
#pragma unroll
        for (int j = 0; j < 4; ++j) { gp[0][j] += t0[j] * wa; gp[1][j] += t0[j] * wb; gp[0][4 + j] += t1[j] * wa; gp[1][4 + j] += t1[j] * wb; }
    }
    float* SC = wsp<float>(C, WS_SC); constexpr size_t SS = SC_STRIDE / 4;
    float* GG = wsp<float>(C, WS_GG); float* BON = wsp<float>(C, WS_BON);
#pragma unroll
    for (int s = 0; s < 2; ++s) {
        const int c = tid + 512 * s, head = wave + 8 * s;
        const float w0v = C.inp(10)[l * 1024 + c], a0v = C.inp(12)[l * 1024 + c], kkv = C.inp(15)[l * 1024 + c], kav = C.inp(16)[l * 1024 + c], rkv = C.inp(17)[l * 1024 + c];
#pragma unroll
        for (int j = 0; j < 8; ++j) {
            const size_t m = m0 + j;
            const float z = w0v + wp[s][j];
            const float w = -softplusf_(-z) - 0.5f;
            const float dec = expf(-expf(w));
            const float a = sigmoidf_(a0v + ap[s][j]);
            const float rr = XS[j * RW_COLS + c], k = XS[j * RW_COLS + 1024 + c], v = XS[j * RW_COLS + 2048 + c];
            const float kkr = k * kkv;
            const float ss = wave_sum(kkr * kkr);
            const float kk = kkr * (1.f / sqrtf(fmaxf(ss, 1e-24f)));
            const float km = k * (1.f + (a - 1.f) * kav);
            const float bon = wave_sum(rr * km * rkv);
            SC[0 * SS + m * 1024 + c] = kk; SC[1 * SS + m * 1024 + c] = dec; SC[2 * SS + m * 1024 + c] = kk * a; SC[3 * SS + m * 1024 + c] = km; SC[4 * SS + m * 1024 + c] = rr; SC[5 * SS + m * 1024 + c] = v;
            GG[m * 1024 + c] = gp[s][j];
            if (lane == 0) BON[m * 16 + head] = bon;
        }
    }
}

DI void phase_b(const Ctx& C, int l) {
    const int tid = C.tid;
    const bf16* P = wsp<bf16>(C, WS_PROJ);
    for (int it = blockIdx.x; it < PB_ITEMS; it += C.G) {
        int r = it;
        if (r < PB_NRW) { rwkv_pre_item(C, l, r); continue; }
        r -= PB_NRW;
        if (r < PB_NPOOL) {
            const int b = r >> 6, n = r & 63, kv = tid >> 8, kvh = (tid >> 6) & 3, d = tid & 63;
            const float* src = C.out + O_CMP_P + ((size_t)l * NTP + b * 2048 + 32 * n) * 512 + tid;
            const float* w = C.inp(20) + (l * 2 + kv) * 32;
            float acc = 0.f;
#pragma unroll 8
            for (int rr = 0; rr < 32; ++rr) acc += w[rr] * src[(size_t)rr * 512];
            const unsigned short hb = (unsigned short)(pk2(acc, 0.f) & 0xffffu);
            if (kv == 0) wsp<bf16>(C, WS_KCB)[((size_t)(b * 4 + kvh) * 64 + n) * 64 + d] = hb;
            else wsp<bf16>(C, WS_VCBT)[((size_t)(b * 4 + kvh) * 64 + d) * 64 + n] = hb;
            continue;
        }
        r -= PB_NPOOL;
        {
            const int which = r >> 9, b = (r >> 7) & 3, kvh = (r >> 5) & 3, tb = r & 31, d = tid & 63, tq = tid >> 6;
            const bf16* src = P + (size_t)(b * 2048 + 64 * tb + 8 * tq) * PLD + (which ? VW_OFF : VS_OFF) + kvh * 64 + d;
            unsigned short e[8];
#pragma unroll
            for (int i = 0; i < 8; ++i) e[i] = src[(size_t)i * PLD];
            v4u o; o.x = e[0] | ((unsigned)e[1] << 16); o.y = e[2] | ((unsigned)e[3] << 16); o.z = e[4] | ((unsigned)e[5] << 16); o.w = e[6] | ((unsigned)e[7] << 16);
            *(v4u*)(wsp<bf16>(C, which ? WS_VTW : WS_VTS) + ((size_t)(b * 4 + kvh) * 64 + d) * 2048 + 64 * tb + 8 * tq) = o;
        }
    }
    __syncthreads();
}

DI void scan_head(const Ctx& C, int l, int row0, int T, int h, const float* S0, float* Sout) {
    const int tid = C.tid, lane = C.lane, wave = C.wave;
    LAS float* STG = (LAS float*)C.lds;
    LAS float* YB = (LAS float*)(C.lds + 6 * 32 * 64 * 4);
    const float* SC = wsp<float>(C, WS_SC); constexpr size_t SS = SC_STRIDE / 4;
    const float* GG = wsp<float>(C, WS_GG); const float* BON = wsp<float>(C, WS_BON);
    bf16* MIX = wsp<bf16>(C, WS_MIX);
    const int r = 8 * wave + (lane >> 3), cg = lane & 7;
    float S[8];
    if (S0) { const f32x4 a = *(const f32x4*)(S0 + r * 64 + 8 * cg), b = *(const f32x4*)(S0 + r * 64 + 8 * cg + 4);
#pragma unroll
        for (int i = 0; i < 4; ++i) { S[i] = a[i]; S[4 + i] = b[i]; } }
    else {
#pragma unroll
        for (int i = 0; i < 8; ++i) S[i] = 0.f; }
    const int nch = (T + 31) >> 5;
    f32x4 pf[6];
#define SCAN_PREFETCH(cc) do { _Pragma("unroll") for (int k = 0; k < 6; ++k) { const int idx = tid + 512 * k, v6 = idx >> 9, rem = idx & 511, st = rem >> 4, f4 = rem & 15, step = (cc) * 32 + st; \
        pf[k] = step < T ? *(const f32x4*)(SC + v6 * SS + (size_t)(row0 + step) * 1024 + h * 64 + f4 * 4) : (f32x4){0.f, 0.f, 0.f, 0.f}; } } while (0)
    SCAN_PREFETCH(0);
    const float gng = C.inp(18)[l * 1024 + h * 64 + lane], gnb = C.inp(19)[l * 1024 + h * 64 + lane];
    for (int c = 0; c < nch; ++c) {
        __syncthreads();
#pragma unroll
        for (int k = 0; k < 6; ++k) ((LAS f32x4*)STG)[tid + 512 * k] = pf[k];
        __syncthreads();
        if (c + 1 < nch) SCAN_PREFETCH(c + 1);
        const int nst = (T - c * 32) < 32 ? (T - c * 32) : 32;
        for (int st = 0; st < nst; ++st) {
            const LAS f32x4* q = (const LAS f32x4*)STG + st * 16 + 2 * cg;
            const f32x4 k0 = q[0 * 512], k1 = q[0 * 512 + 1], d0 = q[1 * 512], d1 = q[1 * 512 + 1], b0 = q[2 * 512], b1 = q[2 * 512 + 1], m0 = q[3 * 512], m1 = q[3 * 512 + 1], r0 = q[4 * 512], r1 = q[4 * 512 + 1];
            const float vv = STG[(5 * 32 + st) * 64 + r];
            float sk = S[0] * k0[0];
#pragma unroll
            for (int i = 1; i < 4; ++i) sk += S[i] * k0[i];
#pragma unroll
            for (int i = 0; i < 4; ++i) sk += S[4 + i] * k1[i];
            sk += __shfl_xor(sk, 1); sk += __shfl_xor(sk, 2); sk += __shfl_xor(sk, 4);
#pragma unroll
            for (int i = 0; i < 4; ++i) { S[i] = S[i] * d0[i] + (vv * m0[i] - sk * b0[i]); S[4 + i] = S[4 + i] * d1[i] + (vv * m1[i] - sk * b1[i]); }
            float y = S[0] * r0[0];
#pragma unroll
            for (int i = 1; i < 4; ++i) y += S[i] * r0[i];
#pragma unroll
            for (int i = 0; i < 4; ++i) y += S[4 + i] * r1[i];
            y += __shfl_xor(y, 1); y += __shfl_xor(y, 2); y += __shfl_xor(y, 4);
            if (cg == 0) YB[st * 64 + r] = y;
        }
        __syncthreads();
#pragma unroll
        for (int qq = 0; qq < 4; ++qq) {
            const int st = wave * 4 + qq;
            if (st < nst) {
                const size_t m = (size_t)row0 + c * 32 + st;
                const float y = YB[st * 64 + lane];
                const float mean = wave_sum(y) * (1.f / 64.f);
                const float dv = y - mean;
                const float var = wave_sum(dv * dv) * (1.f / 64.f);
                const float yn = dv * (1.f / sqrtf(var + GN_EPS)) * gng + gnb;
                const float o = (yn + BON[m * 16 + h] * STG[(5 * 32 + st) * 64 + lane]) * GG[m * 1024 + h * 64 + lane];
                MIX[m * DM + h * 64 + lane] = (unsigned short)(pk2(o, 0.f) & 0xffffu);
            }
        }
    }
#undef SCAN_PREFETCH
    { f32x4 a, b;
#pragma unroll
        for (int i = 0; i < 4; ++i) { a[i] = S[i]; b[i] = S[4 + i]; }
        *(f32x4*)(Sout + r * 64 + 8 * cg) = a; *(f32x4*)(Sout + r * 64 + 8 * cg + 4) = b; }
}

#define MFMA32(a, b, c) __builtin_amdgcn_mfma_f32_32x32x16_bf16((a), (b), (c), 0, 0, 0)
DI bf16x8 pack8(const f32x16& p, int s) {
    v4u o; o.x = pk2(p[8 * s], p[8 * s + 1]); o.y = pk2(p[8 * s + 2], p[8 * s + 3]); o.z = pk2(p[8 * s + 4], p[8 * s + 5]); o.w = pk2(p[8 * s + 6], p[8 * s + 7]);
    return __builtin_bit_cast(bf16x8, o);
}
DI bf16x8 ld_vt(const bf16* p) {
    const v2u a = *(const v2u*)p, b = *(const v2u*)(p + 8);
    v4u o; o.x = a.x; o.y = a.y; o.z = b.x; o.w = b.y; return __builtin_bit_cast(bf16x8, o);
}
#define ATT_TILE(KROW_PTR, VT_PTR0, VT_PTR1, VALID_EXPR) do { \
        f32x16 a_ = zero16; \
        _Pragma("unroll") for (int s = 0; s < 4; ++s) { const bf16x8 kf = *(const bf16x8*)((KROW_PTR) + 16 * s + 8 * hi); a_ = MFMA32(kf, qf[s], a_); } \
        float tm = NEG_BIG; \
        _Pragma("unroll") for (int i = 0; i < 16; ++i) { const int key = key0 + crow(i, hi); const bool ok = (VALID_EXPR); a_[i] = ok ? a_[i] * 0.125f : NEG_BIG; tm = fmaxf(tm, a_[i]); } \
        tm = fmaxf(tm, __shfl_xor(tm, 32)); \
        const float mn = fmaxf(mrun, tm); const float sc_ = expf(mrun - mn); \
        float ps = 0.f; \
        _Pragma("unroll") for (int i = 0; i < 16; ++i) { const float p_ = a_[i] > -1e29f ? expf(a_[i] - mn) : 0.f; a_[i] = p_; ps += p_; } \
        ps += __shfl_xor(ps, 32); \
        lrun = lrun * sc_ + ps; mrun = mn; \
        _Pragma("unroll") for (int i = 0; i < 16; ++i) { oa[0][i] *= sc_; oa[1][i] *= sc_; } \
        _Pragma("unroll") for (int s = 0; s < 2; ++s) { const bf16x8 pb = pack8(a_, s); \
            oa[0] = MFMA32(ld_vt((VT_PTR0) + 16 * s + 4 * hi), pb, oa[0]); oa[1] = MFMA32(ld_vt((VT_PTR1) + 16 * s + 4 * hi), pb, oa[1]); } \
    } while (0)

DI void nsa_prompt_unit(const Ctx& C, int l, int b, int kvh, int qt) {
    const int tid = C.tid, lane = C.lane, wave = C.wave;
    const int g = wave & 3, th = wave >> 2, q = lane & 31, hi = lane >> 5;
    LAS float* IMP = (LAS float*)C.lds;
    LAS float* IMPV = (LAS float*)(C.lds + 65536);
    LAS unsigned* SELM = (LAS unsigned*)(C.lds + 65536 + 8192);
    const bf16* P = wsp<bf16>(C, WS_PROJ);
    const int tok = qt * 64 + th * 32 + q;
    const size_t m = (size_t)b * 2048 + tok;
    const int bk = b * 4 + kvh, head = kvh * 4 + g;
    f32x16 zero16;
#pragma unroll
    for (int i = 0; i < 16; ++i) zero16[i] = 0.f;
    bf16x8 qf[4];
#pragma unroll
    for (int s = 0; s < 4; ++s) qf[s] = *(const bf16x8*)(P + m * PLD + Q_OFF + head * 64 + 16 * s + 8 * hi);
    f32x16 out0 = zero16, out1 = zero16;
    const float g0 = sigmoidf_(bf2f(P[m * PLD + GL_OFF + head * 3 + 0])), g1 = sigmoidf_(bf2f(P[m * PLD + GL_OFF + head * 3 + 1])), g2 = sigmoidf_(bf2f(P[m * PLD + GL_OFF + head * 3 + 2]));
    __syncthreads();
    {
        const bf16* KCB = wsp<bf16>(C, WS_KCB) + (size_t)bk * 4096;
        const bf16* VCBT = wsp<bf16>(C, WS_VCBT) + (size_t)bk * 4096;
        f32x16 sc[2];
        const int nvalid = (tok + 1) >> 5;
        float mx = NEG_BIG;
#pragma unroll
        for (int tile = 0; tile < 2; ++tile) {
            f32x16 a_ = zero16;
#pragma unroll
            for (int s = 0; s < 4; ++s) { const bf16x8 kf = *(const bf16x8*)(KCB + (size_t)(tile * 32 + q) * 64 + 16 * s + 8 * hi); a_ = MFMA32(kf, qf[s], a_); }
#pragma unroll
            for (int i = 0; i < 16; ++i) { const int n = tile * 32 + crow(i, hi); a_[i] = n < nvalid ? a_[i] * 0.125f : NEG_BIG; mx = fmaxf(mx, a_[i]); }
            sc[tile] = a_;
        }
        mx = fmaxf(mx, __shfl_xor(mx, 32));
        float sum = 0.f;
#pragma unroll
        for (int tile = 0; tile < 2; ++tile)
#pragma unroll
            for (int i = 0; i < 16; ++i) { const float p_ = sc[tile][i] > -1e29f ? expf(sc[tile][i] - mx) : 0.f; sc[tile][i] = p_; sum += p_; }
        sum += __shfl_xor(sum, 32);
        const float inv = nvalid > 0 ? 1.f / sum : 0.f;
        f32x16 oc0 = zero16, oc1 = zero16;
#pragma unroll
        for (int tile = 0; tile < 2; ++tile) {
#pragma unroll
            for (int i = 0; i < 16; ++i) sc[tile][i] *= inv;
#pragma unroll
            for (int i4 = 0; i4 < 4; ++i4) { f32x4 v = {sc[tile][4 * i4], sc[tile][4 * i4 + 1], sc[tile][4 * i4 + 2], sc[tile][4 * i4 + 3]};
                *(LAS f32x4*)(IMP + ((size_t)(g * 64 + th * 32 + q)) * 64 + tile * 32 + 8 * i4 + 4 * hi) = v; }
#pragma unroll
            for (int s = 0; s < 2; ++s) { const bf16x8 pb = pack8(sc[tile], s);
                oc0 = MFMA32(ld_vt(VCBT + (size_t)q * 64 + tile * 32 + 16 * s + 4 * hi), pb, oc0);
                oc1 = MFMA32(ld_vt(VCBT + (size_t)(32 + q) * 64 + tile * 32 + 16 * s + 4 * hi), pb, oc1); }
        }
#pragma unroll
        for (int i = 0; i < 16; ++i) { out0[i] = g0 * oc0[i]; out1[i] = g0 * oc1[i]; }
    }
    __syncthreads();
    {
        const int tokl = tid >> 3, jq = tid & 7;
        float v[4];
#pragma unroll
        for (int e = 0; e < 4; ++e) v[e] = 0.f;
#pragma unroll
        for (int gg = 0; gg < 4; ++gg) { const f32x4 a = *(const LAS f32x4*)(IMP + (size_t)(gg * 64 + tokl) * 64 + 8 * jq), bq = *(const LAS f32x4*)(IMP + (size_t)(gg * 64 + tokl) * 64 + 8 * jq + 4);
            v[0] += a[0] + a[1]; v[1] += a[2] + a[3]; v[2] += bq[0] + bq[1]; v[3] += bq[2] + bq[3]; }
        const int cur = qt;
#pragma unroll
        for (int e = 0; e < 4; ++e) { const int j = 4 * jq + e; const bool forced = (j == 0) | (j == cur) | (j == cur - 1); v[e] = j > cur ? -1.f : (forced ? 1e4f : v[e]); }
        *(LAS f32x4*)(IMPV + tokl * 32 + 4 * jq) = (f32x4){v[0], v[1], v[2], v[3]};
        __syncthreads();
        int rank[4] = {0, 0, 0, 0};
#pragma unroll
        for (int jj4 = 0; jj4 < 8; ++jj4) { const f32x4 o = *(const LAS f32x4*)(IMPV + tokl * 32 + 4 * jj4);
#pragma unroll
            for (int u = 0; u < 4; ++u) { const int jp = 4 * jj4 + u; const float ov = o[u];
#pragma unroll
                for (int e = 0; e < 4; ++e) { const int j = 4 * jq + e; rank[e] += (ov > v[e] || (ov == v[e] && jp < j)) ? 1 : 0; } } }
        unsigned bits = 0;
#pragma unroll
        for (int e = 0; e < 4; ++e) if (rank[e] < 16 && v[e] >= 0.f) bits |= 1u << (4 * jq + e);
        bits |= __shfl_xor(bits, 1); bits |= __shfl_xor(bits, 2); bits |= __shfl_xor(bits, 4);
        if (jq == 0) SELM[tokl] = bits;
        __syncthreads();
    }
    const unsigned selm = SELM[th * 32 + q];
    {
        const bf16* VT = wsp<bf16>(C, WS_VTS) + (size_t)bk * 64 * 2048;
        f32x16 oa[2] = {zero16, zero16}; float mrun = NEG_BIG, lrun = 0.f;
        for (int j = 0; j <= qt; ++j) {
            const bool mine = (selm >> j) & 1u;
            if (!__any(mine)) continue;
#pragma unroll
            for (int tile = 0; tile < 2; ++tile) {
                const int key0 = j * 64 + tile * 32;
                ATT_TILE(P + ((size_t)b * 2048 + key0 + q) * PLD + KS_OFF + kvh * 64, VT + (size_t)q * 2048 + key0, VT + (size_t)(32 + q) * 2048 + key0, (mine && key <= tok));
            }
        }
        const float il = g1 / lrun;
#pragma unroll
        for (int i = 0; i < 16; ++i) { out0[i] += il * oa[0][i]; out1[i] += il * oa[1][i]; }
    }
    {
        const bf16* VT = wsp<bf16>(C, WS_VTW) + (size_t)bk * 64 * 2048;
        f32x16 oa[2] = {zero16, zero16}; float mrun = NEG_BIG, lrun = 0.f;
        for (int j = (qt > 8 ? qt - 8 : 0); j <= qt; ++j) {
#pragma unroll
            for (int tile = 0; tile < 2; ++tile) {
                const int key0 = j * 64 + tile * 32;
                ATT_TILE(P + ((size_t)b * 2048 + key0 + q) * PLD + KW_OFF + kvh * 64, VT + (size_t)q * 2048 + key0, VT + (size_t)(32 + q) * 2048 + key0, (key <= tok && key + 511 >= tok));
            }
        }
        const float il = g2 / lrun;
#pragma unroll
        for (int i = 0; i < 16; ++i) { out0[i] += il * oa[0][i]; out1[i] += il * oa[1][i]; }
    }
    bf16* MIX = wsp<bf16>(C, WS_MIX) + m * DM + 1024 + head * 64;
#pragma unroll
    for (int i4 = 0; i4 < 4; ++i4) {
        v2u o; o.x = pk2(out0[4 * i4], out0[4 * i4 + 1]); o.y = pk2(out0[4 * i4 + 2], out0[4 * i4 + 3]); *(v2u*)(MIX + 8 * i4 + 4 * hi) = o;
        o.x = pk2(out1[4 * i4], out1[4 * i4 + 1]); o.y = pk2(out1[4 * i4 + 2], out1[4 * i4 + 3]); *(v2u*)(MIX + 32 + 8 * i4 + 4 * hi) = o;
    }
}

template <class RowFn> DI void samp_block(const RowFn& rowptr, int nvalid, int kvh, const LAS float* QS, LAS float* PWw, int lane, float (&M)[4], float (&L)[4], float (&O)[4]) {
    float s[4] = {0.f, 0.f, 0.f, 0.f};
    const bool ok = lane < nvalid;
    if (ok) {
        const f32x4* kr = (const f32x4*)(rowptr(lane) + kvh * 64);
#pragma unroll 4
        for (int d4 = 0; d4 < 16; ++d4) { const f32x4 kq = kr[d4];
#pragma unroll
            for (int g = 0; g < 4; ++g) { const f32x4 qq = *(const LAS f32x4*)(QS + g * 64 + 4 * d4); s[g] += kq[0] * qq[0] + kq[1] * qq[1] + kq[2] * qq[2] + kq[3] * qq[3]; } }
    }
    float mb[4], lb[4];
#pragma unroll
    for (int g = 0; g < 4; ++g) { const float sv = ok ? s[g] : NEG_BIG; mb[g] = wave_max(sv); const float p = ok ? expf(sv - mb[g]) : 0.f; lb[g] = wave_sum(p); PWw[g * 64 + lane] = p; }
    LDS_WAIT(); asm volatile("" ::: "memory");
    float ob[4] = {0.f, 0.f, 0.f, 0.f};
    for (int r = 0; r < nvalid; ++r) { const float vv = rowptr(r)[256 + kvh * 64 + lane];
#pragma unroll
        for (int g = 0; g < 4; ++g) ob[g] += PWw[g * 64 + r] * vv; }
    LDS_WAIT(); asm volatile("" ::: "memory");
#pragma unroll
    for (int g = 0; g < 4; ++g) { const float mn = fmaxf(M[g], mb[g]); const float a = expf(M[g] - mn), bsc = expf(mb[g] - mn); L[g] = L[g] * a + lb[g] * bsc; O[g] = O[g] * a + ob[g] * bsc; M[g] = mn; }
}
DI float samp_combine(LAS float* WST, int tid, int lane, int wave, const float (&M)[4], const float (&L)[4], const float (&O)[4]) {
    __syncthreads();
#pragma unroll
    for (int g = 0; g < 4; ++g) { WST[wave * 264 + 8 + g * 64 + lane] = O[g]; if (lane == 0) { WST[wave * 264 + g] = M[g]; WST[wave * 264 + 4 + g] = L[g]; } }
    __syncthreads();
    float res = 0.f;
    if (tid < 256) { const int g = tid >> 6, d = tid & 63; float mm = NEG_BIG;
#pragma unroll
        for (int w = 0; w < 8; ++w) mm = fmaxf(mm, WST[w * 264 + g]);
        float ll = 0.f, oo = 0.f;
#pragma unroll
        for (int w = 0; w < 8; ++w) { const float e = expf(WST[w * 264 + g] - mm); ll += WST[w * 264 + 4 + g] * e; oo += WST[w * 264 + 8 + g * 64 + d] * e; }
        res = oo / ll; }
    return res;
}

DI void nsa_sample_item(const Ctx& C, int l, int b, int t, int kvh) {
    const int tid = C.tid, lane = C.lane, wave = C.wave;
    LAS float* F = (LAS float*)C.lds;
    LAS float *QS = F, *PC = F + 256, *IMPS = F + 2304, *RED = F + 2624, *RED2 = F + 2688, *OCP = F + 2752, *PW = F + 4800, *WST = F + 6848;
    LAS int* SELB = (LAS int*)(F + 2560);
    const bf16* P = wsp<bf16>(C, WS_PROJ);
    const size_t m = (size_t)NTP + b * 4 + t;
    __syncthreads();
    if (tid < 256) QS[tid] = bf2f(P[m * PLD + Q_OFF + kvh * 256 + tid]) * 0.125f;
    __syncthreads();
    float ocmp = 0.f;
    {
        const float* KC = wsp<float>(C, WS_KCBS) + ((size_t)((l * 8 + b) * 4 + kvh) * 512) * 64;
        const float* VC = wsp<float>(C, WS_VCBS) + ((size_t)((l * 8 + b) * 4 + kvh) * 512) * 64;
        float s[4] = {0.f, 0.f, 0.f, 0.f};
        const f32x4* kr = (const f32x4*)(KC + (size_t)tid * 64);
#pragma unroll 4
        for (int d4 = 0; d4 < 16; ++d4) { const f32x4 kq = kr[d4];
#pragma unroll
            for (int g = 0; g < 4; ++g) { const f32x4 qq = *(const LAS f32x4*)(QS + g * 64 + 4 * d4); s[g] += kq[0] * qq[0] + kq[1] * qq[1] + kq[2] * qq[2] + kq[3] * qq[3]; } }
#pragma unroll
        for (int g = 0; g < 4; ++g) { const float wm = wave_max(s[g]); if (lane == 0) RED[wave * 4 + g] = wm; }
        __syncthreads();
        float p[4];
#pragma unroll
        for (int g = 0; g < 4; ++g) { float mm = RED[g];
#pragma unroll
            for (int w = 1; w < 8; ++w) mm = fmaxf(mm, RED[w * 4 + g]);
            p[g] = expf(s[g] - mm); const float ws = wave_sum(p[g]); if (lane == 0) RED2[wave * 4 + g] = ws; }
        __syncthreads();
#pragma unroll
        for (int g = 0; g < 4; ++g) { float tot = 0.f;
#pragma unroll
            for (int w = 0; w < 8; ++w) tot += RED2[w * 4 + g];
            PC[g * 512 + tid] = p[g] / tot; }
        __syncthreads();
        if (tid < 256) IMPS[tid] = (PC[2 * tid] + PC[2 * tid + 1]) + (PC[512 + 2 * tid] + PC[512 + 2 * tid + 1]) + (PC[1024 + 2 * tid] + PC[1024 + 2 * tid + 1]) + (PC[1536 + 2 * tid] + PC[1536 + 2 * tid + 1]);
        { const int d = tid & 63, nq = tid >> 6; float acc[4] = {0.f, 0.f, 0.f, 0.f};
#pragma unroll 4
            for (int n = nq * 64; n < nq * 64 + 64; ++n) { const float vv = VC[(size_t)n * 64 + d];
#pragma unroll
                for (int g = 0; g < 4; ++g) acc[g] += PC[g * 512 + n] * vv; }
#pragma unroll
            for (int g = 0; g < 4; ++g) OCP[(nq * 4 + g) * 64 + d] = acc[g]; }
        __syncthreads();
        if (tid < 256) { const int g = tid >> 6, d = tid & 63;
#pragma unroll
            for (int nq = 0; nq < 8; ++nq) ocmp += OCP[(nq * 4 + g) * 64 + d];
            const int j = tid;
            if (j >= 1 && j <= 254) { const float v = IMPS[j]; int rank = 0;
                for (int jp = 1; jp <= 254; ++jp) { const float ov = IMPS[jp]; rank += (ov > v || (ov == v && jp < j)) ? 1 : 0; }
                if (rank < 13) SELB[rank] = j; }
            if (tid == 0) { SELB[13] = 0; SELB[14] = 255; SELB[15] = 256; }
        }
        __syncthreads();
    }
    float osel;
    {
        float M[4] = {NEG_BIG, NEG_BIG, NEG_BIG, NEG_BIG}, L[4] = {0.f, 0.f, 0.f, 0.f}, O[4] = {0.f, 0.f, 0.f, 0.f};
        const int* pt = (const int*)C.inp(4) + b * 128;
        for (int bi = 0; bi < 2; ++bi) {
            const int jb = __builtin_amdgcn_readfirstlane(SELB[2 * wave + bi]);
            if (jb < 256) { const int pid = pt[jb >> 1];
                const float* base = C.inp(3) + ((size_t)(l * NPOOL + pid) * 128 + (jb & 1) * 64) * 512;
                samp_block([&](int r) { return base + (size_t)r * 512; }, 64, kvh, QS, PW + wave * 256, lane, M, L, O);
            } else { const float* base = C.out + O_SEL_S + ((size_t)l * NTS + b * 4) * 512;
                samp_block([&](int r) { return base + (size_t)r * 512; }, t + 1, kvh, QS, PW + wave * 256, lane, M, L, O); }
        }
        osel = samp_combine(WST, tid, lane, wave, M, L, O);
    }
    float owin;
    {
        float M[4] = {NEG_BIG, NEG_BIG, NEG_BIG, NEG_BIG}, L[4] = {0.f, 0.f, 0.f, 0.f}, O[4] = {0.f, 0.f, 0.f, 0.f};
        const float* pre = C.inp(5) + (size_t)(l * 8 + b) * 262144;
        const float* nw = C.out + O_WIN_S + ((size_t)(l * 8 + b) * 512 + 508) * 512;
        samp_block([&](int r) { const int p = t + 1 + 64 * wave + r; return p <= 511 ? pre + (size_t)p * 512 : nw + (size_t)(p - 512) * 512; }, 64, kvh, QS, PW + wave * 256, lane, M, L, O);
        owin = samp_combine(WST, tid, lane, wave, M, L, O);
    }
    if (tid < 256) { const int g = tid >> 6, d = tid & 63, head = kvh * 4 + g;
        const float g0 = sigmoidf_(bf2f(P[m * PLD + GL_OFF + head * 3 + 0])), g1 = sigmoidf_(bf2f(P[m * PLD + GL_OFF + head * 3 + 1])), g2 = sigmoidf_(bf2f(P[m * PLD + GL_OFF + head * 3 + 2]));
        const float o = g0 * ocmp + g1 * osel + g2 * owin;
        wsp<bf16>(C, WS_MIX)[m * DM + 1024 + head * 64 + d] = (unsigned short)(pk2(o, 0.f) & 0xffffu); }
}

#ifndef C_MASK
#define C_MASK 7
#endif
constexpr int PC_SCAN_P = 64, PC_ATT_P = 512, PC_ATT_S = 128, PC_SCAN_S = 128, PC_ITEMS = PC_SCAN_P + PC_ATT_P + PC_ATT_S + PC_SCAN_S;
DI void phase_c(const Ctx& C0, int l) {
    LAS int* slot = (LAS int*)(C0.lds + MISC_OFF + 64);
    for (;;) {
        __syncthreads();
        if (C0.tid == 0) *slot = (int)atomicAdd(C0.ctl + CW_QUEUE + 64 * l, 1u);
        __syncthreads();
        int it = *slot;
        if (it >= PC_ITEMS) break;
        Ctx K = C0; { asm volatile("" : "+s"(K.ws), "+s"(K.out)); int t_ = K.tid; asm volatile("" : "+v"(t_)); K.tid = t_; K.lane = t_ & 63; K.wave = __builtin_amdgcn_readfirstlane(t_ >> 6); }
        const Ctx& C = K;
        if (it < PC_SCAN_P || it >= PC_SCAN_P + PC_ATT_P + PC_ATT_S) {
            int row0, T, h; const float* S0; float* So;
            if (it < PC_SCAN_P) { const int b = it >> 4; h = it & 15; row0 = b * 2048; T = 2048; S0 = nullptr; So = C.out + O_RW_P + ((size_t)(l * 4 + b) * 16 + h) * 4096; }
            else { const int u = it - (PC_SCAN_P + PC_ATT_P + PC_ATT_S), b = u >> 4; h = u & 15; row0 = NTP + b * 4; T = 4; S0 = C.inp(6) + ((size_t)(l * 8 + b) * 16 + h) * 4096; So = C.out + O_RW_S + ((size_t)(l * 8 + b) * 16 + h) * 4096; }
#if (C_MASK & 1)
            scan_head(C, l, row0, T, h, S0, So);
#endif
        } else if (it < PC_SCAN_P + PC_ATT_P) {
            const int u = it - PC_SCAN_P, qt = 31 - (u >> 4), bk = u & 15;
#if (C_MASK & 2)
            nsa_prompt_unit(C, l, bk >> 2, bk & 3, qt);
#endif
        } else {
            const int u = it - (PC_SCAN_P + PC_ATT_P);
#if (C_MASK & 4)
            nsa_sample_item(C, l, u >> 4, (u >> 2) & 3, u & 3);
#endif
        }
    }
    __syncthreads();
}

DI const float* xin_row(const Ctx& C, int l, size_t m) {
    if (l == 0) return m < (size_t)NTP ? C.inp(0) + m * DM : C.inp(1) + (m - NTP) * DM;
    return wsp<float>(C, WS_XF1) + m * DM;
}
DI void phase_e(const Ctx& C, int l) {
    const int lane = C.lane;
    const float* H = wsp<float>(C, WS_HS);
    float* X1F = wsp<float>(C, WS_X1F); bf16* X1B = wsp<bf16>(C, WS_X1B);
    const float* gw = C.inp(22) + (size_t)l * DM; const float* bw = C.inp(23) + (size_t)l * DM;
    for (int m = blockIdx.x * NWAVES + C.wave; m < NT; m += C.G * NWAVES) {
        const f32x4* xr = (const f32x4*)xin_row(C, l, m) + lane; const f32x4* hr = (const f32x4*)(H + (size_t)m * DM) + lane;
        f32x4 v[8]; float s = 0.f;
#pragma unroll
        for (int j = 0; j < 8; ++j) { v[j] = xr[64 * j] * DN_ALPHA + hr[64 * j]; s += (v[j][0] + v[j][1]) + (v[j][2] + v[j][3]); }
        const float mean = wave_sum(s) * (1.f / DM); float s2 = 0.f;
#pragma unroll
        for (int j = 0; j < 8; ++j) { v[j] = v[j] - mean; s2 += (v[j][0] * v[j][0] + v[j][1] * v[j][1]) + (v[j][2] * v[j][2] + v[j][3] * v[j][3]); }
        const float rstd = 1.f / sqrtf(wave_sum(s2) * (1.f / DM) + LN_EPS);
#pragma unroll
        for (int j = 0; j < 8; ++j) { const f32x4 gg = ((const f32x4*)gw)[lane + 64 * j], bb = ((const f32x4*)bw)[lane + 64 * j];
            const f32x4 o = v[j] * rstd * gg + bb;
            ((f32x4*)(X1F + (size_t)m * DM))[lane + 64 * j] = o;
            v2u p; p.x = pk2(o[0], o[1]); p.y = pk2(o[2], o[3]); ((v2u*)(X1B + (size_t)m * DM))[lane + 64 * j] = p; }
    }
}

DI float gelu_erf(float x) { return 0.5f * x * (1.f + erff(x * 0.70710678118654752f)); }
DI unsigned fkey(float f) { const unsigned u = __builtin_bit_cast(unsigned, f); return u ^ ((unsigned)((int)u >> 31) | 0x80000000u); }
DI int mbcnt64(unsigned long long m) { return __builtin_amdgcn_mbcnt_hi((unsigned)(m >> 32), __builtin_amdgcn_mbcnt_lo((unsigned)m, 0)); }
template <int NV, bool LANE_MAJOR> DI void top16(const unsigned (&key)[NV], bool (&sel)[NV], int (&pos)[NV]) {
    unsigned thr = 0u; bool exact = false;
    for (int bit = 31; bit >= 0; --bit) {
        const unsigned cand = thr | (1u << bit);
        int cnt = 0;
#pragma unroll
        for (int v = 0; v < NV; ++v) cnt += __builtin_popcountll(__ballot(key[v] >= cand));
        if (cnt >= 16) { thr = cand; if (cnt == 16) { exact = true; break; } }
    }
    unsigned long long sm[NV];
    if (exact) {
#pragma unroll
        for (int v = 0; v < NV; ++v) { sel[v] = key[v] >= thr; sm[v] = __ballot(sel[v]); }
    } else {
        unsigned long long eq[NV]; int ngt = 0;
#pragma unroll
        for (int v = 0; v < NV; ++v) { ngt += __builtin_popcountll(__ballot(key[v] > thr)); eq[v] = __ballot(key[v] == thr); }
        const int need = 16 - ngt;
#pragma unroll
        for (int v = 0; v < NV; ++v) { int rk;
            if (LANE_MAJOR) { rk = 0;
#pragma unroll
                for (int w = 0; w < NV; ++w) { rk += mbcnt64(eq[w]); if (w < v) rk += (int)((eq[w] >> (threadIdx.x & 63)) & 1ull); } }
            else { rk = mbcnt64(eq[v]);
#pragma unroll
                for (int w = 0; w < NV; ++w) if (w < v) rk += __builtin_popcountll(eq[w]); }
            sel[v] = key[v] > thr || (key[v] == thr && rk < need); sm[v] = __ballot(sel[v]); }
    }
    int base = 0;
#pragma unroll
    for (int v = 0; v < NV; ++v) { pos[v] = base + mbcnt64(sm[v]); base += __builtin_popcountll(sm[v]); }
}
typedef float f32x2v __attribute__((ext_vector_type(2)));
DI void phase_g(const Ctx& C, int l) {
    const int tid = C.tid, lane = C.lane, wave = C.wave;
    LAS float* FACC = (LAS float*)C.lds;
    LAS float* RED = (LAS float*)(C.lds + 65536);
    LAS float* WL = (LAS float*)(C.lds + 65536 + 256 + wave * 512);
    LAS int* WLi = (LAS int*)WL;
    const float* Sc = wsp<float>(C, WS_HS);
    const float* X1F = wsp<float>(C, WS_X1F);
    const unsigned char* UB = C.ws + WS_UB + (size_t)l * NEXP * DM; const unsigned char* VB = C.ws + WS_VB + (size_t)l * NEXP * DM;
    const float* USC = wsp<float>(C, WS_USC) + (size_t)l * NEXP; const float* VSC = USC + 2 * NEXP;
    const float* gw = C.inp(28) + (size_t)l * DM; const float* bw = C.inp(29) + (size_t)l * DM;
    for (int m = blockIdx.x; m < NT; m += C.G) {
        const float* sr = Sc + (size_t)m * DM + wave * 256;
        const float a0 = sr[lane], a1 = sr[64 + lane], b0 = sr[128 + lane], b1 = sr[192 + lane];
        { const unsigned k0[2] = {fkey(a0), fkey(a1)}; bool s0[2]; int p0[2]; top16<2, false>(k0, s0, p0);
          if (s0[0]) { WL[p0[0]] = a0; WLi[16 + p0[0]] = lane; } if (s0[1]) { WL[p0[1]] = a1; WLi[16 + p0[1]] = lane + 64; }
          const unsigned k1[2] = {fkey(b0), fkey(b1)}; bool s1[2]; int p1[2]; top16<2, false>(k1, s1, p1);
          if (s1[0]) { WL[32 + p1[0]] = b0; WLi[48 + p1[0]] = lane; } if (s1[1]) { WL[32 + p1[1]] = b1; WLi[48 + p1[1]] = lane + 64; } }
        LDS_WAIT(); asm volatile("" ::: "memory");
        float cd[4];
        { const float x0 = WL[lane >> 2]; const f32x4 x1 = *(const LAS f32x4*)(WL + 32 + (lane & 3) * 4);
          cd[0] = x0 + x1[0]; cd[1] = x0 + x1[1]; cd[2] = x0 + x1[2]; cd[3] = x0 + x1[3]; }
        { const unsigned kc[4] = {fkey(cd[0]), fkey(cd[1]), fkey(cd[2]), fkey(cd[3])}; bool sc_[4]; int pc[4]; top16<4, true>(kc, sc_, pc);
          const int ei = WLi[16 + (lane >> 2)] * 128;
#pragma unroll
          for (int jj = 0; jj < 4; ++jj) if (sc_[jj]) { WL[64 + pc[jj]] = cd[jj]; WLi[80 + pc[jj]] = ei + WLi[48 + (lane & 3) * 4 + jj]; } }
        LDS_WAIT(); asm volatile("" ::: "memory");
        const float tv = lane < 16 ? WL[64 + lane] : -INFINITY;
        const float tmax = wave_max(tv);
        const float ev = lane < 16 ? expf(tv - tmax) : 0.f;
        const float gate = ev / wave_sum(ev);
        if (lane < 16) WL[64 + lane] = gate;
        LDS_WAIT(); asm volatile("" ::: "memory");
        float x[32];
        { const f32x4* xr = (const f32x4*)(X1F + (size_t)m * DM);
#pragma unroll
          for (int k = 0; k < 2; ++k)
#pragma unroll
              for (int q = 0; q < 4; ++q) { const f32x4 a = xr[4 * lane + 256 * k + q];
#pragma unroll
                  for (int e = 0; e < 4; ++e) x[16 * k + 4 * q + e] = a[e]; } }
        f32x2v acc[16];
#pragma unroll
        for (int i = 0; i < 16; ++i) acc[i] = (f32x2v){0.f, 0.f};
        v4u ub[2][2], vb[2][2];
#define G_LOAD(bufi, r_) do { const int e_ = __builtin_amdgcn_readfirstlane(WLi[80 + (r_)]); \
            const v4u* ur_ = (const v4u*)(UB + (size_t)e_ * DM); const v4u* vr_ = (const v4u*)(VB + (size_t)e_ * DM); \
            ub[bufi][0] = ur_[lane]; ub[bufi][1] = ur_[lane + 64]; vb[bufi][0] = vr_[lane]; vb[bufi][1] = vr_[lane + 64]; } while (0)
#define G_COMP(bufi, r_) do { const int e_ = __builtin_amdgcn_readfirstlane(WLi[80 + (r_)]); const float gt_ = WL[64 + (r_)]; \
            f32x2v d2 = {0.f, 0.f}; \
            _Pragma("unroll") for (int k = 0; k < 2; ++k) _Pragma("unroll") for (int q = 0; q < 4; ++q) { const int wd = (int)ub[bufi][k][q]; \
                const f32x2v lo_ = __builtin_amdgcn_cvt_pk_f32_fp8(wd, false), hi_ = __builtin_amdgcn_cvt_pk_f32_fp8(wd, true); \
                d2 += lo_ * (f32x2v){x[16 * k + 4 * q], x[16 * k + 4 * q + 1]}; d2 += hi_ * (f32x2v){x[16 * k + 4 * q + 2], x[16 * k + 4 * q + 3]}; } \
            const float dot_ = wave_sum(d2.x + d2.y) * USC[e_]; \
            const float wg_ = gt_ * gelu_erf(dot_) * VSC[e_]; const f32x2v w2_ = {wg_, wg_}; \
            _Pragma("unroll") for (int k = 0; k < 2; ++k) _Pragma("unroll") for (int q = 0; q < 4; ++q) { const int wd = (int)vb[bufi][k][q]; \
                acc[8 * k + 2 * q] += w2_ * __builtin_amdgcn_cvt_pk_f32_fp8(wd, false); acc[8 * k + 2 * q + 1] += w2_ * __builtin_amdgcn_cvt_pk_f32_fp8(wd, true); } } while (0)
        G_LOAD(0, 0);
#pragma unroll 1
        for (int r = 0; r < 16; r += 2) {
            G_LOAD(1, r + 1);
            G_COMP(0, r);
            if (r + 2 < 16) G_LOAD(0, r + 2);
            G_COMP(1, r + 1);
        }
#undef G_LOAD
#undef G_COMP
        __syncthreads();
#pragma unroll
        for (int k = 0; k < 2; ++k)
#pragma unroll
            for (int q = 0; q < 4; ++q) *(LAS f32x4*)(FACC + wave * DM + 16 * lane + 1024 * k + 4 * q) = (f32x4){acc[8 * k + 2 * q].x, acc[8 * k + 2 * q].y, acc[8 * k + 2 * q + 1].x, acc[8 * k + 2 * q + 1].y};
        __syncthreads();
        f32x4 y = ((const f32x4*)(X1F + (size_t)m * DM))[tid] * DN_ALPHA;
#pragma unroll
        for (int w = 0; w < 8; ++w) y = y + *(const LAS f32x4*)(FACC + w * DM + 4 * tid);
        float s = wave_sum((y[0] + y[1]) + (y[2] + y[3]));
        if (lane == 0) RED[wave] = s;
        __syncthreads();
        float tot = 0.f;
#pragma unroll
        for (int w = 0; w < 8; ++w) tot += RED[w];
        const float mean = tot * (1.f / DM);
        y = y - mean;
        float s2 = wave_sum((y[0] * y[0] + y[1] * y[1]) + (y[2] * y[2] + y[3] * y[3]));
        if (lane == 0) RED[8 + wave] = s2;
        __syncthreads();
        float tot2 = 0.f;
#pragma unroll
        for (int w = 0; w < 8; ++w) tot2 += RED[8 + w];
        const float rstd = 1.f / sqrtf(tot2 * (1.f / DM) + LN_EPS);
        const f32x4 o = y * rstd * ((const f32x4*)gw)[tid] + ((const f32x4*)bw)[tid];
        if (l == 0) { ((f32x4*)(wsp<float>(C, WS_XF1) + (size_t)m * DM))[tid] = o;
            v2u p; p.x = pk2(o[0], o[1]); p.y = pk2(o[2], o[3]); ((v2u*)(wsp<bf16>(C, WS_XB) + (size_t)m * DM))[tid] = p; }
        else { float* dst = m < NTP ? C.out + O_YP + (size_t)m * DM : C.out + O_YS + (size_t)(m - NTP) * DM; ((f32x4*)dst)[tid] = o; }
    }
    __syncthreads();
}

#ifndef PH_MASK
#define PH_MASK 0xFF
#endif
#define IN(k) (lo <= (k) && (k) < hi)
#define EN(s) ((PH_MASK >> (s)) & 1)
#define FRESH(CX) Ctx CX = C; { asm volatile("" : "+s"(CX.ws), "+s"(CX.out)); int t_ = CX.tid; asm volatile("" : "+v"(t_)); CX.tid = t_; CX.lane = t_ & 63; CX.wave = __builtin_amdgcn_readfirstlane(t_ >> 6); CX.ctl = (unsigned*)(CX.ws + WS_CTL); }
#define SEAM(k) do { if (IN(k) && IN((k) + 1)) xcd_barrier(bar); } while (0)
template <int l> DI void run_layer(const Ctx& C, const XcdBarrier& bar, int lo, int hi) {
        const int pb = 1 + 7 * l;
        if (EN(0) && IN(pb + 0)) {
            FRESH(K);
            pg8::Gemm g{wsp<bf16>(K, WS_XB), wsp<bf16>(K, WS_WIN) + (size_t)l * PLD * DM, MP, PLD, DM}; pg8::StaticOrder S; S.init(MP, PLD, K.G, (int)blockIdx.x);
            EpiInProj E{wsp<bf16>(K, WS_PROJ), K.out, l};
            pg8::gemm_phase<EpiInProj, pg8::StaticOrder, true, true>(K.lds, g, S, E);
        }
        SEAM(pb + 0);
        if (EN(1) && IN(pb + 1)) { FRESH(K); phase_b(K, l); }
        SEAM(pb + 1);
        if (EN(2) && IN(pb + 2)) { FRESH(K); phase_c(K, l); }
        SEAM(pb + 2);
        if (EN(3) && IN(pb + 3)) {
            FRESH(K);
            pg8::Gemm g{wsp<bf16>(K, WS_MIX), wsp<bf16>(K, WS_WOUT) + (size_t)l * DM * DM, MP, DM, DM}; pg8::StaticOrder S; S.init(MP, DM, K.G, (int)blockIdx.x);
            pg8::EpiF32 E{wsp<float>(K, WS_HS), DM, nullptr};
            pg8::gemm_phase<pg8::EpiF32, pg8::StaticOrder, true, true>(K.lds, g, S, E);
        }
        SEAM(pb + 3);
        if (EN(4) && IN(pb + 4)) { FRESH(K); phase_e(K, l); }
        SEAM(pb + 4);
        if (EN(5) && IN(pb + 5)) {
            FRESH(K);
            pg8::Gemm g{wsp<bf16>(K, WS_X1B), wsp<bf16>(K, WS_W2) + (size_t)l * DM * DM, MP, DM, DM}; pg8::StaticOrder S; S.init(MP, DM, K.G, (int)blockIdx.x);
            pg8::EpiF32 E{wsp<float>(K, WS_HS), DM, nullptr};
            pg8::gemm_phase<pg8::EpiF32, pg8::StaticOrder, true, true>(K.lds, g, S, E);
        }
        SEAM(pb + 5);
        if (EN(6) && IN(pb + 6)) { FRESH(K); phase_g(K, l); }
        SEAM(pb + 6);
}
typedef ArgsK Args;
__global__ void __launch_bounds__(NTHREADS, 2) fwd_kernel(Args args) {
    extern __shared__ __attribute__((aligned(16))) unsigned char lds[];
    Ctx C;
    C.out = args.out; C.ws = args.ws; C.lds = (LAS unsigned char*)lds; C.ctl = (unsigned*)(args.ws + WS_CTL);
    C.tid = threadIdx.x; C.lane = C.tid & 63; C.wave = __builtin_amdgcn_readfirstlane(C.tid >> 6); C.G = gridDim.x;
    volatile LAS unsigned* MISC = (volatile LAS unsigned*)(C.lds + MISC_OFF);
    for (int u = C.tid; u < (LDS_BYTES - RING_BYTES) / 4; u += NTHREADS) ((LAS unsigned*)(C.lds + RING_BYTES))[u] = 0u;
    __syncthreads();
    XcdBarrier bar; bar.bar = C.ctl + CW_BAR; bar.x = 0; bar.st = nullptr;
    if (args.use_bar) bar = xcd_barrier_post(C.ctl + CW_BAR, MISC + 8);
    const int lo = args.ph_lo, hi = args.ph_hi;
    if (EN(7) && IN(0)) { FRESH(K); p0_prologue(K); }
    SEAM(0);
    run_layer<0>(C, bar, lo, hi);
    run_layer<1>(C, bar, lo, hi);
#undef IN
#undef SEAM
}

#ifndef MK_ONE_LAUNCH
#define MK_ONE_LAUNCH 1
#endif
extern "C" void kernel_launch(void* const* d_in, const int* in_sizes, int n_in, void* d_out, int out_size, void* d_ws, size_t ws_size, hipStream_t stream) {
    static int grid = 0;
    if (grid == 0) {
        if (n_in != 30 || out_size != (int)O_END || ws_size < WS_END) { fprintf(stderr, "kernel_launch: unexpected shapes (n_in %d, out %d, ws %zu < %zu); nothing launched\n", n_in, out_size, ws_size, (size_t)WS_END); grid = -1; return; }
        int dev = 0, cus = 0, per_cu = 0;
        if (hipGetDevice(&dev) != hipSuccess || hipDeviceGetAttribute(&cus, hipDeviceAttributeMultiprocessorCount, dev) != hipSuccess) { grid = -1; return; }
        if (hipFuncSetAttribute((const void*)fwd_kernel, hipFuncAttributeMaxDynamicSharedMemorySize, LDS_BYTES) != hipSuccess) { fprintf(stderr, "kernel_launch: hipFuncSetAttribute failed\n"); grid = -1; return; }
        if (hipOccupancyMaxActiveBlocksPerMultiprocessor(&per_cu, (const void*)fwd_kernel, NTHREADS, LDS_BYTES) != hipSuccess || per_cu < 1) { fprintf(stderr, "kernel_launch: occupancy query says %d blocks per CU\n", per_cu); }
        (void)hipGetLastError();
        grid = cus;
    }
    if (grid < 0) return;
    if (hipMemsetAsync((char*)d_ws + WS_CTL, 0, CTL_ZERO_BYTES, stream) != hipSuccess) return;
    Args a{};
    for (int i = 0; i < 30; ++i) a.in[i] = (const float*)d_in[i];
    a.out = (float*)d_out; a.ws = (unsigned char*)d_ws;
#if MK_ONE_LAUNCH
    a.ph_lo = 0; a.ph_hi = N_PHASES; a.use_bar = 1;
    hipLaunchKernelGGL(fwd_kernel, dim3(grid), dim3(NTHREADS), LDS_BYTES, stream, a);
#else
    for (int p = 0; p < N_PHASES; ++p) { a.ph_lo = p; a.ph_hi = p + 1; a.use_bar = 0; hipLaunchKernelGGL(fwd_kernel, dim3(grid), dim3(NTHREADS), LDS_BYTES, stream, a); }
#endif
}
```

```cpp
#include <hip/hip_runtime.h>
#include <cstdio>
#include <cstdint>
namespace pg8 {
#define PG8_LAS __attribute__((address_space(3)))
typedef unsigned short bf16_t;
typedef short bf16x8 __attribute__((ext_vector_type(8)));
typedef float f32x4 __attribute__((ext_vector_type(4)));
typedef unsigned u32x4 __attribute__((ext_vector_type(4)));
constexpr int BM = 256, BK = 64, HALF = 128, HTB = HALF * BK * 2  , STAGE_BYTES = 8 * HTB, NXCD = 8, WGM = 8;

__host__ __device__ __forceinline__ int lds_byte(int r, int c) { const int st = (r >> 4) * 2 + (c >> 5), rr = r & 15, cc = c & 31, ob = rr * 64 + cc * 2; return st * 1024 + (ob ^ (((ob >> 9) & 1) << 5)); }
__host__ __device__ __forceinline__ void stage_rc(int b, int& R, int& C) { const int st = b / 1024, sb = b % 1024, swz = sb ^ (((sb >> 9) & 1) << 5); R = (st >> 1) * 16 + swz / 64; C = (st & 1) * 32 + (swz % 64) / 2; }
__host__ __device__ __forceinline__ int perm32(int rho) { const int n = rho >> 4, i = rho & 15; return 8 * (i >> 2) + 4 * n + (i & 3); }

struct Unit { int pm, pn; };
struct Gemm { const bf16_t* A; const bf16_t* Bt; int M, N, K; };

struct StaticOrder {
    int nM, nN, nwg, G, c;
    __host__ __device__ void init(int M, int N, int G_, int c_) { nM = M / BM; nN = N / BM; nwg = nM * nN; G = G_; c = c_; }
    __host__ __device__ bool next(int i, Unit& u) const {
        const long L = (long)i * G + c; if (L >= nwg) return false;
        int wgid = (int)L; { const int q = nwg / NXCD, r = nwg % NXCD, xcd = wgid % NXCD, off = wgid / NXCD; wgid = (xcd < r ? xcd * (q + 1) : r * (q + 1) + (xcd - r) * q) + off; }
        const int nig = WGM * nN, gid = wgid / nig, fm = gid * WGM, gsz = (nM - fm) < WGM ? (nM - fm) : WGM;
        u.pm = fm + ((wgid % nig) % gsz); u.pn = (wgid % nig) / gsz; return true;
    }
    __device__ __forceinline__ void a_ready(const Unit&) const {}
    __device__ __forceinline__ void done(const Unit&) const {}
};

__device__ __forceinline__ unsigned cvt_pk_bf16(float lo, float hi) { unsigned r; asm volatile("v_cvt_pk_bf16_f32 %0, %1, %2" : "=v"(r) : "v"(lo), "v"(hi)); return r; }
typedef float f32x2 __attribute__((ext_vector_type(2)));
struct EpiF32 {
    static constexpr bool PERM = false, AFTER_DRAIN = false;
    float* C; int ldc; const float* bias;
    __device__ __forceinline__ void operator()(const f32x4 (&acc)[2][2][4][2], const Unit& u, int wr, int wc, int fr, int fq) const {
        const int row0 = u.pm * BM + wr * 64 + fr, col0 = u.pn * BM + wc * 32 + 4 * fq;
        f32x4 bv[2][2];
#pragma unroll
        for (int bj = 0; bj < 2; ++bj)
#pragma unroll
            for (int n = 0; n < 2; ++n) bv[bj][n] = bias ? *(const f32x4*)(bias + col0 + bj * HALF + n * 16) : (f32x4){0.f, 0.f, 0.f, 0.f};
#pragma unroll
        for (int ai = 0; ai < 2; ++ai)
#pragma unroll
            for (int m = 0; m < 4; ++m) { float* rowp = C + (size_t)(row0 + ai * HALF + m * 16) * ldc + col0;
#pragma unroll
                for (int bj = 0; bj < 2; ++bj)
#pragma unroll
                    for (int n = 0; n < 2; ++n) *(f32x4*)(rowp + bj * HALF + n * 16) = acc[ai][bj][m][n] + bv[bj][n]; }
    }
};
template <class Epi, class Sched, bool ALIGN_EPI = false, bool SP2 = false>
__device__ __forceinline__ void gemm_phase(PG8_LAS unsigned char* lds, const Gemm g, const Sched& S, const Epi& E) {
    const int tid = threadIdx.x, wid = __builtin_amdgcn_readfirstlane(tid >> 6), lane = tid & 63, wr = wid >> 2, wc = wid & 3, fr = lane & 15, fq = lane >> 4;
    const int K = g.K, nt = K / BK;
    unsigned voffA[2], voffB[2];
#pragma unroll
    for (int i = 0; i < 2; ++i) { int R, C; stage_rc(tid * 16 + i * 8192, R, C); const int Rb = Epi::PERM ? ((R & ~31) + perm32(R & 31)) : R;
        voffA[i] = (unsigned)(R * K + C) * 2u; voffB[i] = (unsigned)(Rb * K + C) * 2u; }
    const size_t kstep = (size_t)(BK * 2);
    const size_t hstep = (size_t)HALF * K * 2;
    const size_t tstep = 2 * hstep;
    const unsigned ldsw = (unsigned)wid * 1024u;
    const int aoff = lds_byte(wr * 64 + fr, fq * 8), boff = lds_byte(wc * 32 + fr, fq * 8);
#define PG8_SA(b, h) (((b) * 2 + (h)) * HTB)
#define PG8_SB(b, h) ((4 + (b) * 2 + (h)) * HTB)
#define PG8_STAGE(bufoff, gbase, voff) do { _Pragma("unroll") for (int _i = 0; _i < 2; ++_i) \
        __builtin_amdgcn_global_load_lds((const unsigned*)((const char*)(gbase) + (voff)[_i]), (PG8_LAS unsigned*)(lds + (bufoff) + ldsw + _i * 8192), 16, 0, 0); } while (0)
#define PG8_LDA(dst, b, h) do { _Pragma("unroll") for (int m = 0; m < 4; ++m) _Pragma("unroll") for (int k = 0; k < 2; ++k) dst[m][k] = *(const PG8_LAS bf16x8*)(lds + PG8_SA(b, h) + aoff + m * 2048 + k * 1024); } while (0)
#define PG8_LDB(dst, b, h) do { _Pragma("unroll") for (int n = 0; n < 2; ++n) _Pragma("unroll") for (int k = 0; k < 2; ++k) dst[n][k] = *(const PG8_LAS bf16x8*)(lds + PG8_SB(b, h) + boff + n * 2048 + k * 1024); } while (0)
#define PG8_MMA(ai, bj, At, Bt) do { __builtin_amdgcn_s_setprio(1); _Pragma("unroll") for (int m = 0; m < 4; ++m) _Pragma("unroll") for (int n = 0; n < 2; ++n) _Pragma("unroll") for (int k = 0; k < 2; ++k) \
        acc[ai][bj][m][n] = __builtin_amdgcn_mfma_f32_16x16x32_bf16(Bt[n][k], At[m][k], acc[ai][bj][m][n], 0, 0, 0); __builtin_amdgcn_s_setprio(0); } while (0)
#define PG8_WAIT_V(n) asm volatile("s_waitcnt vmcnt(" #n ")" ::: "memory")
#define PG8_WAIT_L(n) asm volatile("s_waitcnt lgkmcnt(" #n ")" ::: "memory")
#define PG8_BAR __builtin_amdgcn_s_barrier()
#define PG8_SCHED __builtin_amdgcn_sched_barrier(0)
    Unit cur, nxt; int ui = 0;
    if (!S.next(0, cur)) return;
    f32x4 acc[2][2][4][2];
#pragma unroll
    for (int a = 0; a < 2; ++a)
#pragma unroll
        for (int b = 0; b < 2; ++b)
#pragma unroll
            for (int m = 0; m < 4; ++m)
#pragma unroll
                for (int n = 0; n < 2; ++n) acc[a][b][m][n] = (f32x4){0.f, 0.f, 0.f, 0.f};
    bf16x8 At[4][2], B0[2][2], B1[2][2];
    const char* cA = (const char*)g.A + (size_t)cur.pm * tstep; const char* cB = (const char*)g.Bt + (size_t)cur.pn * tstep;
    S.a_ready(cur);
    if constexpr (SP2) {
        PG8_STAGE(PG8_SB(0, 0), cB, voffB); PG8_STAGE(PG8_SB(0, 1), cB + hstep, voffB); PG8_STAGE(PG8_SA(0, 0), cA, voffA); PG8_STAGE(PG8_SA(0, 1), cA + hstep, voffA);
        if (wr == 1) PG8_BAR;
        PG8_WAIT_V(2); PG8_BAR;
        PG8_STAGE(PG8_SB(1, 0), cB + kstep, voffB); PG8_STAGE(PG8_SA(1, 0), cA + kstep, voffA); PG8_STAGE(PG8_SB(1, 1), cB + hstep + kstep, voffB);
        PG8_WAIT_V(6); PG8_BAR;
    } else {
        PG8_STAGE(PG8_SB(0, 0), cB, voffB); PG8_STAGE(PG8_SA(0, 0), cA, voffA); PG8_STAGE(PG8_SB(0, 1), cB + hstep, voffB); PG8_STAGE(PG8_SA(0, 1), cA + hstep, voffA);
        if (wr == 1) PG8_BAR;
        PG8_WAIT_V(4); PG8_BAR;
        PG8_STAGE(PG8_SB(1, 0), cB + kstep, voffB); PG8_STAGE(PG8_SA(1, 0), cA + kstep, voffA); PG8_STAGE(PG8_SB(1, 1), cB + hstep + kstep, voffB);
        PG8_WAIT_V(6); PG8_BAR;
    }
    for (;;) {
        const bool has_next = S.next(ui + 1, nxt);
        const char* nA = has_next ? (const char*)g.A + (size_t)nxt.pm * tstep : cA; const char* nB = has_next ? (const char*)g.Bt + (size_t)nxt.pn * tstep : cB;
        for (int t = 0; t < nt; t += 2) {
            const bool last = (t == nt - 2);
            const char* a1 = cA + (size_t)(t + 1) * kstep;
            const char* a2 = last ? nA : cA + (size_t)(t + 2) * kstep; const char* b2 = last ? nB : cB + (size_t)(t + 2) * kstep;
            const char* a3 = a2 + kstep; const char* b3 = b2 + kstep;
            if (last && has_next) S.a_ready(nxt);
            if constexpr (SP2) {
            PG8_LDB(B0, 0, 0); PG8_LDB(B1, 0, 1); PG8_SCHED; PG8_LDA(At, 0, 0); PG8_STAGE(PG8_SA(1, 1), a1 + hstep, voffA);
            PG8_WAIT_V(8); PG8_WAIT_L(0); PG8_BAR; PG8_MMA(0, 0, At, B0); PG8_MMA(0, 1, At, B1); PG8_BAR; PG8_SCHED;
            PG8_LDA(At, 0, 1); PG8_STAGE(PG8_SB(0, 0), b2, voffB); PG8_STAGE(PG8_SB(0, 1), b2 + hstep, voffB); PG8_STAGE(PG8_SA(0, 0), a2, voffA);
            PG8_WAIT_V(8); PG8_WAIT_L(0); PG8_BAR; PG8_MMA(1, 0, At, B0); PG8_MMA(1, 1, At, B1); PG8_BAR; PG8_SCHED;
            PG8_LDB(B0, 1, 0); PG8_LDB(B1, 1, 1); PG8_SCHED; PG8_LDA(At, 1, 0); PG8_STAGE(PG8_SA(0, 1), a2 + hstep, voffA);
            PG8_WAIT_V(8); PG8_WAIT_L(0); PG8_BAR; PG8_MMA(0, 0, At, B0); PG8_MMA(0, 1, At, B1); PG8_BAR; PG8_SCHED;
            PG8_LDA(At, 1, 1); PG8_STAGE(PG8_SB(1, 0), b3, voffB); PG8_STAGE(PG8_SB(1, 1), b3 + hstep, voffB); PG8_STAGE(PG8_SA(1, 0), a3, voffA);
            PG8_WAIT_V(8); PG8_WAIT_L(0); PG8_BAR; PG8_MMA(1, 0, At, B0); PG8_MMA(1, 1, At, B1); PG8_BAR; PG8_SCHED;
            } else {
            PG8_LDB(B0, 0, 0); PG8_SCHED; PG8_LDA(At, 0, 0); PG8_STAGE(PG8_SA(1, 1), a1 + hstep, voffA);
            PG8_WAIT_L(8); PG8_BAR; PG8_WAIT_L(0); PG8_MMA(0, 0, At, B0); PG8_BAR; PG8_SCHED;
            PG8_LDB(B1, 0, 1); PG8_STAGE(PG8_SB(0, 0), b2, voffB);
            PG8_BAR; PG8_WAIT_L(0); PG8_MMA(0, 1, At, B1); PG8_BAR;
            PG8_LDA(At, 0, 1); PG8_STAGE(PG8_SA(0, 0), a2, voffA);
            PG8_BAR; PG8_WAIT_L(0); PG8_MMA(1, 0, At, B0); PG8_BAR; PG8_SCHED;
            PG8_STAGE(PG8_SB(0, 1), b2 + hstep, voffB);
            PG8_WAIT_V(6); PG8_BAR; PG8_MMA(1, 1, At, B1); PG8_BAR;
            PG8_LDB(B0, 1, 0); PG8_SCHED; PG8_LDA(At, 1, 0); PG8_STAGE(PG8_SA(0, 1), a2 + hstep, voffA);
            PG8_WAIT_L(8); PG8_BAR; PG8_WAIT_L(0); PG8_MMA(0, 0, At, B0); PG8_BAR; PG8_SCHED;
            PG8_LDB(B1, 1, 1); PG8_STAGE(PG8_SB(1, 0), b3, voffB);
            PG8_BAR; PG8_WAIT_L(0); PG8_MMA(0, 1, At, B1); PG8_BAR;
            PG8_LDA(At, 1, 1); PG8_STAGE(PG8_SA(1, 0), a3, voffA);
            PG8_BAR; PG8_WAIT_L(0); PG8_MMA(1, 0, At, B0); PG8_BAR; PG8_SCHED;
            PG8_STAGE(PG8_SB(1, 1), b3 + hstep, voffB);
            PG8_WAIT_V(6); PG8_BAR; PG8_MMA(1, 1, At, B1); PG8_BAR;
            }
        }
        if constexpr (ALIGN_EPI) { if (wr == 0) PG8_BAR; }
        if constexpr (!Epi::AFTER_DRAIN) { E(acc, cur, wr, wc, fr, fq); S.done(cur); }
        if (!has_next) break;
#pragma unroll
        for (int a = 0; a < 2; ++a)
#pragma unroll
            for (int b = 0; b < 2; ++b)
#pragma unroll
                for (int m = 0; m < 4; ++m)
#pragma unroll
                    for (int n = 0; n < 2; ++n) acc[a][b][m][n] = (f32x4){0.f, 0.f, 0.f, 0.f};
        cur = nxt; cA = nA; cB = nB; ++ui;
        if constexpr (ALIGN_EPI) { if (wr == 1) PG8_BAR; }
    }
    PG8_WAIT_V(0);
    if constexpr (!ALIGN_EPI) { if (wr == 0) PG8_BAR; }
    PG8_BAR;
    if constexpr (Epi::AFTER_DRAIN) { E.fused(acc, cur, wr, wc, fr, fq, lds, wid, lane); S.done(cur); }
#undef PG8_SA
#undef PG8_SB
#undef PG8_STAGE
#undef PG8_LDA
#undef PG8_LDB
#undef PG8_MMA
#undef PG8_WAIT_V
#undef PG8_WAIT_L
#undef PG8_BAR
#undef PG8_SCHED
}
}
#define LAS __attribute__((address_space(3)))
#define XB_TMO      128
#define XB_XCNT(j)  (256  + 64 * (j))
#define XB_XSUB(j)  (1280 + 64 * (j))
#define XB_XGEN(j)  (2304 + 64 * (j))
#define XB_TOP      3328
#define XB_TOPGEN   3392
#define XCD_BAR_WORDS 3456
#define XB_SPIN_CAP (1u << 18)

__device__ __forceinline__ unsigned xb_ld(unsigned* p)              { return __hip_atomic_load(p, __ATOMIC_RELAXED, __HIP_MEMORY_SCOPE_AGENT); }
__device__ __forceinline__ unsigned xb_add(unsigned* p, unsigned v) { return __hip_atomic_fetch_add(p, v, __ATOMIC_RELAXED, __HIP_MEMORY_SCOPE_AGENT); }
__device__ __forceinline__ unsigned xb_xcc_id() { return (unsigned)__builtin_amdgcn_s_getreg((3 << 11) | 20) & 0xFu; }
#define XB_SPIN(cond, bar) do { unsigned _sp = 0; while (cond) { __builtin_amdgcn_s_sleep(1); \
    if ((++_sp & 255u) == 0u) { if (xb_ld(&(bar)[XB_TMO])) break; if (_sp > XB_SPIN_CAP) { atomicAdd(&(bar)[XB_TMO], 1u); break; } } } } while (0)

struct XcdBarrier {
    unsigned* bar; unsigned x;
    volatile LAS unsigned* st;
};

__device__ __forceinline__ XcdBarrier xcd_barrier_post(unsigned* bar, volatile LAS unsigned* st) {
    XcdBarrier b; b.bar = bar; b.x = xb_xcc_id(); b.st = st;
    if (threadIdx.x == 0) (void)xb_add(&bar[XB_XCNT(b.x)], 1u);
    return b;
}
__device__ __forceinline__ void xcd_barrier_complete(unsigned* bar, unsigned x, unsigned& nloc, unsigned& nx) {
    const unsigned G = gridDim.x * gridDim.y * gridDim.z;
    unsigned sum, cnt, mine, sp = 0u;
    for (;;) {
        sum = 0u; cnt = 0u; mine = 0u;
#pragma unroll
        for (unsigned j = 0; j < 16; ++j) { const unsigned c = xb_ld(&bar[XB_XCNT(j)]); sum += c; cnt += (c > 0u) ? 1u : 0u; mine = (j == x) ? c : mine; }
        if (sum == G) break;
        __builtin_amdgcn_s_sleep(1);
        if ((++sp & 255u) == 0u) { if (xb_ld(&bar[XB_TMO])) break; if (sp > XB_SPIN_CAP) { atomicAdd(&bar[XB_TMO], 1u); break; } }
    }
    nloc = mine > 0u ? mine : 1u; nx = cnt > 0u ? cnt : 1u;
}

__device__ __forceinline__ void xcd_barrier(const XcdBarrier& b) {
    asm volatile("s_waitcnt vmcnt(0)" ::: "memory");
    __syncthreads();
    if (threadIdx.x == 0) {
        unsigned* bar = b.bar;
        __builtin_amdgcn_s_waitcnt(0);
        unsigned nloc = b.st[0], nx = b.st[1];
        if (nloc == 0u) { xcd_barrier_complete(bar, b.x, nloc, nx); b.st[0] = nloc; b.st[1] = nx; }
        const unsigned old = xb_add(&bar[XB_XSUB(b.x)], 1u);
        const unsigned gen = old / nloc;
        if (old + 1u == (gen + 1u) * nloc) {
            __builtin_amdgcn_fence(__ATOMIC_RELEASE, "agent");
            asm volatile("s_waitcnt vmcnt(0)" ::: "memory");
            const unsigned og = xb_add(&bar[XB_TOP], 1u);
            const unsigned tg = og / nx;
            if (og + 1u == (tg + 1u) * nx) xb_add(&bar[XB_TOPGEN], 1u);
            else XB_SPIN(xb_ld(&bar[XB_TOPGEN]) == tg, bar);
            __builtin_amdgcn_fence(__ATOMIC_ACQUIRE, "agent");
            xb_add(&bar[XB_XGEN(b.x)], 1u);
            asm volatile("s_waitcnt vmcnt(0)" ::: "memory");
        } else {
            XB_SPIN(xb_ld(&bar[XB_XGEN(b.x)]) == gen, bar);
            __builtin_amdgcn_fence(__ATOMIC_ACQUIRE, "agent");
            asm volatile("s_waitcnt vmcnt(0)" ::: "memory");
        }
    }
    __syncthreads();
}

constexpr int NWAVES = 8, NTHREADS = 512;
constexpr int DM = 2048, NTP = 8192, NTS = 32, NT = 8224, MP = 8448;
constexpr int RW_COLS = 3360, Q_OFF = 3360, KC_OFF = 4384, KS_OFF = 4896, VS_OFF = 5152, KW_OFF = 5408, VW_OFF = 5664, GL_OFF = 5920, IN_COLS = 5968, PLD = 6144;
constexpr int NEXP = 16384, NPOOL = 1280;
constexpr float LN_EPS = 1e-5f, GN_EPS = 64e-5f, DN_ALPHA = 1.4142135623730951f;
constexpr float NEG_BIG = -1e30f;
constexpr size_t O_YP = 0, O_YS = O_YP + (size_t)NTP * DM, O_CMP_P = O_YS + (size_t)NTS * DM, O_SEL_P = O_CMP_P + (size_t)2 * NTP * 512, O_WIN_P = O_SEL_P + (size_t)2 * NTP * 512,
                 O_RW_P = O_WIN_P + (size_t)2 * 4 * 512 * 512, O_SH_P = O_RW_P + (size_t)2 * 4 * 16 * 4096, O_CMP_S = O_SH_P + (size_t)2 * 4 * RW_COLS, O_SEL_S = O_CMP_S + (size_t)2 * NTS * 512,
                 O_WIN_S = O_SEL_S + (size_t)2 * NTS * 512, O_RW_S = O_WIN_S + (size_t)2 * 8 * 512 * 512, O_SH_S = O_RW_S + (size_t)2 * 8 * 16 * 4096, O_END = O_SH_S + (size_t)2 * 8 * RW_COLS;
static_assert(O_END == 41630464, "output size");
constexpr size_t MiB = 1ull << 20;
constexpr size_t WS_CTL = 0, CTL_ZERO_BYTES = 1 * MiB;
constexpr size_t WS_WIN = 1 * MiB;
constexpr size_t WS_WOUT = WS_WIN + 48 * MiB;
constexpr size_t WS_W2 = WS_WOUT + 16 * MiB;
constexpr size_t WS_UB = WS_W2 + 16 * MiB;
constexpr size_t WS_VB = WS_UB + 64 * MiB;
constexpr size_t WS_USC = WS_VB + 64 * MiB;
constexpr size_t WS_XB = WS_USC + 1 * MiB;
constexpr size_t WS_X1B = WS_XB + 33 * MiB;
constexpr size_t WS_XF1 = WS_X1B + 33 * MiB;
constexpr size_t WS_X1F = WS_XF1 + 65 * MiB;
constexpr size_t WS_PROJ = WS_X1F + 65 * MiB;
constexpr size_t WS_SC = WS_PROJ + 99 * MiB;
constexpr size_t SC_STRIDE = 33 * MiB;
constexpr size_t WS_GG = WS_SC + 6 * SC_STRIDE;
constexpr size_t WS_BON = WS_GG + 33 * MiB;
constexpr size_t WS_MIX = WS_BON + 1 * MiB;
constexpr size_t WS_HS = WS_MIX + 33 * MiB;
constexpr size_t WS_KCB = WS_HS + 66 * MiB;
constexpr size_t WS_VCBT = WS_KCB + 512 * 1024;
constexpr size_t WS_VTS = WS_KCB + 1 * MiB;
constexpr size_t WS_VTW = WS_VTS + 4 * MiB;
constexpr size_t WS_KCBS = WS_VTW + 4 * MiB;
constexpr size_t WS_VCBS = WS_KCBS + 17 * MiB;
constexpr size_t WS_END = WS_VCBS + 17 * MiB;
constexpr int CW_BAR = 4096, CW_QUEUE = 8192;
constexpr int RING_BYTES = 131072, MISC_OFF = RING_BYTES + 320, LDS_BYTES = 147456;
constexpr int N_PHASES = 15;

typedef unsigned short bf16;
typedef unsigned v4u __attribute__((ext_vector_type(4)));
typedef unsigned v2u __attribute__((ext_vector_type(2)));
typedef float f32x4 __attribute__((ext_vector_type(4)));
typedef float f32x16 __attribute__((ext_vector_type(16)));
typedef short bf16x8 __attribute__((ext_vector_type(8)));
typedef float f32x2_t __attribute__((ext_vector_type(2)));
typedef __bf16 bf16x2_t __attribute__((ext_vector_type(2)));
#define LDS_WAIT() asm volatile("s_waitcnt lgkmcnt(0)" ::: "memory")
#define DI __device__ __forceinline__
#define GAS __attribute__((address_space(1)))
template <class T> DI T* launder_g(T* p) { GAS T* g = (GAS T*)p; asm volatile("" : "+s"(g)); return (T*)g; }

DI unsigned pk2(float lo, float hi) { f32x2_t v = {lo, hi}; bf16x2_t b = __builtin_convertvector(v, bf16x2_t); return __builtin_bit_cast(unsigned, b); }
DI float bf2f(unsigned short u) { return __builtin_bit_cast(float, (unsigned)u << 16); }
DI float bflo(unsigned u) { return __builtin_bit_cast(float, u << 16); }
DI float bfhi(unsigned u) { return __builtin_bit_cast(float, u & 0xffff0000u); }
template <int CTRL> DI float dppf(float v) { return __builtin_bit_cast(float, __builtin_amdgcn_update_dpp(0, __builtin_bit_cast(int, v), CTRL, 0xF, 0xF, false)); }
DI float rdlane(float v, int l) { return __builtin_bit_cast(float, __builtin_amdgcn_readlane(__builtin_bit_cast(int, v), l)); }
DI float wave_sum(float v) {
    v += dppf<0xB1>(v); v += dppf<0x4E>(v); v += dppf<0x141>(v); v += dppf<0x140>(v);
    return (rdlane(v, 0) + rdlane(v, 16)) + (rdlane(v, 32) + rdlane(v, 48));
}
DI float wave_max(float v) {
    v = fmaxf(v, dppf<0xB1>(v)); v = fmaxf(v, dppf<0x4E>(v)); v = fmaxf(v, dppf<0x141>(v)); v = fmaxf(v, dppf<0x140>(v));
    return fmaxf(fmaxf(rdlane(v, 0), rdlane(v, 16)), fmaxf(rdlane(v, 32), rdlane(v, 48)));
}
DI float sigmoidf_(float x) { return 1.f / (1.f + expf(-x)); }
DI int crow(int reg, int h) { return (reg & 3) + 8 * (reg >> 2) + 4 * h; }

struct ArgsK { const float* in[30]; float* out; unsigned char* ws; int ph_lo, ph_hi, use_bar, pad; };
struct ArgsG { const GAS float* in[30]; GAS float* out; GAS unsigned char* ws; int ph_lo, ph_hi, use_bar, pad; };
typedef __attribute__((address_space(4))) const ArgsG* kargp_t;
struct Ctx {
    float* out; unsigned char* ws;
    LAS unsigned char* lds; unsigned* ctl;
    int tid, lane, wave, G;
    DI const float* inp(int k) const { kargp_t p = (kargp_t)__builtin_amdgcn_kernarg_segment_ptr(); asm volatile("" : "+s"(p)); return (const float*)p->in[k]; }
};
template <class T> DI T* wsp(const Ctx& C, size_t off) { return (T*)(C.ws + off); }

struct EpiInProj {
    static constexpr bool PERM = true, AFTER_DRAIN = false;
    bf16* P; float* out; int l;
    DI void operator()(const pg8::f32x4 (&acc)[2][2][4][2], const pg8::Unit& u, int wr, int wc, int fr, int fq) const {
        const int row0 = u.pm * 256 + wr * 64 + fr, col0 = u.pn * 256 + wc * 32 + 8 * fq;
#pragma unroll
        for (int bj = 0; bj < 2; ++bj) {
            const int colb = __builtin_amdgcn_readfirstlane(u.pn * 256 + wc * 32 + bj * 128);
            const int col = col0 + bj * 128;
            const int kind = colb < RW_COLS ? 1 : ((colb >= KC_OFF && colb < GL_OFF) ? 2 : 0);
            const int reg = (colb - KC_OFF) >> 9, cc = (col - KC_OFF) & 511;
#pragma unroll
            for (int ai = 0; ai < 2; ++ai)
#pragma unroll
                for (int m = 0; m < 4; ++m) {
                    const int row = row0 + ai * 128 + m * 16;
                    const pg8::f32x4 v0 = acc[ai][bj][m][0], v1 = acc[ai][bj][m][1];
                    v4u w; w.x = pk2(v0[0], v0[1]); w.y = pk2(v0[2], v0[3]); w.z = pk2(v1[0], v1[1]); w.w = pk2(v1[2], v1[3]);
                    *(v4u*)(P + (size_t)row * PLD + col) = w;
                    if (kind == 0 || row >= NT) continue;
                    unsigned off = 0xffffffffu;
                    if (row < NTP) { const int b = row >> 11, t = row & 2047;
                        if (kind == 1) { if (t == 2047) off = (unsigned)(O_SH_P + (size_t)(l * 4 + b) * RW_COLS + col); }
                        else if (reg == 0) off = (unsigned)(O_CMP_P + ((size_t)l * NTP + row) * 512 + cc);
                        else if (reg == 1) off = (unsigned)(O_SEL_P + ((size_t)l * NTP + row) * 512 + cc);
                        else if (t >= 1536) off = (unsigned)(O_WIN_P + ((size_t)(l * 4 + b) * 512 + (t - 1536)) * 512 + cc);
                    } else { const int j = row - NTP, b = j >> 2, t = j & 3;
                        if (kind == 1) { if (t == 3) off = (unsigned)(O_SH_S + (size_t)(l * 8 + b) * RW_COLS + col); }
                        else if (reg == 0) off = (unsigned)(O_CMP_S + ((size_t)l * NTS + j) * 512 + cc);
                        else if (reg == 1) off = (unsigned)(O_SEL_S + ((size_t)l * NTS + j) * 512 + cc);
                        else off = (unsigned)(O_WIN_S + ((size_t)(l * 8 + b) * 512 + 508 + t) * 512 + cc);
                    }
                    if (off != 0xffffffffu) { *(pg8::f32x4*)(out + off) = v0; *(pg8::f32x4*)(out + off + 4) = v1; }
                }
        }
    }
};

DI void transpose_item(const float* W, int K, int N, int Npad, bf16* WT, LAS float* scr, int item, int lane) {
    const int nblk = Npad / 32, kb = item / nblk, nb = item % nblk, k0 = 64 * kb, n0 = 32 * nb;
#pragma unroll 8
    for (int i = 0; i < 32; ++i) { const int kk = 2 * i + (lane >> 5), n = n0 + (lane & 31); scr[kk * 33 + (lane & 31)] = n < N ? W[(size_t)(k0 + kk) * N + n] : 0.f; }
    LDS_WAIT(); asm volatile("" ::: "memory");
    const int c = lane & 7;
#pragma unroll
    for (int j = 0; j < 4; ++j) { const int n = (lane >> 3) + 8 * j; const LAS float* s = scr + (8 * c) * 33 + n;
        v4u o; o.x = pk2(s[0 * 33], s[1 * 33]); o.y = pk2(s[2 * 33], s[3 * 33]); o.z = pk2(s[4 * 33], s[5 * 33]); o.w = pk2(s[6 * 33], s[7 * 33]);
        *(v4u*)(WT + (size_t)(n0 + n) * K + k0 + 8 * c) = o; }
    LDS_WAIT(); asm volatile("" ::: "memory");
}

constexpr int P0_NT = 2048, P0_NW2 = 2048, P0_NTAB = 8192, P0_NX = 2056, P0_NCC = 2048, P0_NWP = 508;
constexpr int P0_ITEMS = P0_NT + P0_NW2 + P0_NTAB + P0_NX + P0_NCC + P0_NWP;

DI void p0_prologue(const Ctx& C) {
    const int tid = C.tid, lane = C.lane, wave = C.wave;
    for (int it = blockIdx.x; it < P0_ITEMS; it += C.G) {
        int r = it;
        if (r < P0_NTAB) {
            const int row = r * 8 + wave;
            const float* src = (row < 32768 ? C.inp(26) : C.inp(27)) + (size_t)(row & 32767) * DM;
            unsigned char* dst = C.ws + (row < 32768 ? WS_UB : WS_VB) + (size_t)(row & 32767) * DM;
            f32x4 v[8]; float am = 0.f;
#pragma unroll
            for (int k = 0; k < 2; ++k)
#pragma unroll
                for (int q = 0; q < 4; ++q) { v[4 * k + q] = ((const f32x4*)src)[4 * lane + 256 * k + q];
                    am = fmaxf(am, fmaxf(fmaxf(fabsf(v[4 * k + q][0]), fabsf(v[4 * k + q][1])), fmaxf(fabsf(v[4 * k + q][2]), fabsf(v[4 * k + q][3])))); }
            am = wave_max(am);
            const float sc = am > 0.f ? am * (1.f / 256.f) : 1.f, inv = 1.f / sc;
#pragma unroll
            for (int k = 0; k < 2; ++k) { v4u o;
#pragma unroll
                for (int q = 0; q < 4; ++q) { const f32x4 x = v[4 * k + q] * inv; int p = __builtin_amdgcn_cvt_pk_fp8_f32(x[0], x[1], 0, false); p = __builtin_amdgcn_cvt_pk_fp8_f32(x[2], x[3], p, true); o[q] = (unsigned)p; }
                ((v4u*)dst)[lane + 64 * k] = o; }
            if (lane == 0) wsp<float>(C, WS_USC)[row] = sc;
            continue;
        }
        r -= P0_NTAB;
        if (r < P0_NCC) {
            const int l = r >> 10, b = (r >> 7) & 7, pi = r & 127;
            const int pid = ((const int*)C.inp(4))[b * 128 + pi];
            const float* src = C.inp(2) + ((size_t)(l * NPOOL + pid) * 128) * 512 + tid;
            const int kv = tid >> 8, kvh = (tid >> 6) & 3, d = tid & 63;
            const float* w = C.inp(20) + (l * 2 + kv) * 32;
            float acc[4] = {0.f, 0.f, 0.f, 0.f};
#pragma unroll
            for (int q = 0; q < 4; ++q)
#pragma unroll 8
                for (int rr = 0; rr < 32; ++rr) acc[q] += w[rr] * src[(size_t)(32 * q + rr) * 512];
            float* dst = wsp<float>(C, kv ? WS_VCBS : WS_KCBS) + ((size_t)((l * 8 + b) * 4 + kvh) * 512 + 4 * pi) * 64 + d;
#pragma unroll
            for (int q = 0; q < 4; ++q) dst[q * 64] = acc[q];
            continue;
        }
        r -= P0_NCC;
        if (r < P0_NT) {
            const int l = r >> 10, w8 = (r & 1023) * 8 + wave;
            LAS float* scr = (LAS float*)(C.lds + wave * 16384);
            if (w8 < 6144) transpose_item(C.inp(8) + (size_t)l * DM * IN_COLS, DM, IN_COLS, PLD, wsp<bf16>(C, WS_WIN) + (size_t)l * PLD * DM, scr, w8, lane);
            else transpose_item(C.inp(21) + (size_t)l * DM * DM, DM, DM, DM, wsp<bf16>(C, WS_WOUT) + (size_t)l * DM * DM, scr, w8 - 6144, lane);
            continue;
        }
        r -= P0_NT;
        if (r < P0_NW2) {
            const int l = r >> 10, hc = (r >> 6) & 15, kb = r & 63;
            LAS float* SK = (LAS float*)C.lds;
            LAS float* WQ = (LAS float*)(C.lds + 128 * 129 * 4);
            __syncthreads();
            const float* sk = C.inp(25) + ((size_t)l * 16 + hc) * 16384;
            for (int i = tid; i < 16384; i += NTHREADS) SK[(i >> 7) * 129 + (i & 127)] = sk[i];
            const float* wq = C.inp(24) + (size_t)l * DM * DM + (size_t)(kb * 32) * DM + hc * 128;
            for (int i = tid; i < 4096; i += NTHREADS) WQ[i] = wq[(size_t)(i >> 7) * DM + (i & 127)];
            __syncthreads();
            const int k = tid & 127, rq = tid >> 7;
            float acc[8];
#pragma unroll
            for (int j = 0; j < 8; ++j) acc[j] = 0.f;
            for (int d = 0; d < 128; d += 4) {
                const float s0 = SK[k * 129 + d], s1 = SK[k * 129 + d + 1], s2 = SK[k * 129 + d + 2], s3 = SK[k * 129 + d + 3];
#pragma unroll
                for (int j = 0; j < 8; ++j) { const f32x4 w = *(const LAS f32x4*)(WQ + (rq * 8 + j) * 128 + d); acc[j] += s0 * w[0] + s1 * w[1] + s2 * w[2] + s3 * w[3]; }
            }
            v4u o; o.x = pk2(acc[0], acc[1]); o.y = pk2(acc[2], acc[3]); o.z = pk2(acc[4], acc[5]); o.w = pk2(acc[6], acc[7]);
            *(v4u*)(wsp<bf16>(C, WS_W2) + (size_t)l * DM * DM + (size_t)(hc * 128 + k) * DM + kb * 32 + rq * 8) = o;
            continue;
        }
        r -= P0_NW2;
        if (r < P0_NX) {
            const size_t e0 = (size_t)r * 8192 + tid * 16;
            const float* src = e0 < (size_t)NTP * DM ? C.inp(0) + e0 : C.inp(1) + (e0 - (size_t)NTP * DM);
            const f32x4* s4 = (const f32x4*)src;
            const f32x4 a = s4[0], b = s4[1], c = s4[2], d = s4[3];
            v4u o0, o1; o0.x = pk2(a[0], a[1]); o0.y = pk2(a[2], a[3]); o0.z = pk2(b[0], b[1]); o0.w = pk2(b[2], b[3]);
            o1.x = pk2(c[0], c[1]); o1.y = pk2(c[2], c[3]); o1.z = pk2(d[0], d[1]); o1.w = pk2(d[2], d[3]);
            v4u* d4 = (v4u*)(wsp<bf16>(C, WS_XB) + e0); d4[0] = o0; d4[1] = o1;
            continue;
        }
        r -= P0_NX;
        {
            const size_t i0 = (size_t)r * 8192 + tid * 16;
            const size_t lb = i0 / 260096, rem = i0 % 260096;
            const f32x4* s4 = (const f32x4*)(C.inp(5) + lb * 262144 + 2048 + rem);
            f32x4* d4 = (f32x4*)(C.out + O_WIN_S + lb * 262144 + rem);
            const f32x4 a = s4[0], b = s4[1], c = s4[2], d = s4[3];
            d4[0] = a; d4[1] = b; d4[2] = c; d4[3] = d;
        }
    }
    __syncthreads();
}

constexpr int PB_NRW = 1028, PB_NPOOL = 256, PB_NVT = 1024, PB_ITEMS = PB_NRW + PB_NPOOL + PB_NVT;
DI float softplusf_(float x) { return x > 20.f ? x : log1pf(expf(x)); }

DI void rwkv_pre_item(const Ctx& C, int l, int item) {
    const int tid = C.tid, lane = C.lane, wave = C.wave;
    LAS float* XS = (LAS float*)C.lds;
    LAS float* ACT = (LAS float*)(C.lds + 8 * RW_COLS * 4);
    const bf16* P = wsp<bf16>(C, WS_PROJ);
    const int m0 = item * 8;
    __syncthreads();
    for (int idx = tid; idx < 8 * 420; idx += NTHREADS) {
        const int j = idx / 420, col = (idx % 420) * 8, m = m0 + j;
        const v4u cu = *(const v4u*)(P + (size_t)m * PLD + col);
        float cur[8] = {bflo(cu.x), bfhi(cu.x), bflo(cu.y), bfhi(cu.y), bflo(cu.z), bfhi(cu.z), bflo(cu.w), bfhi(cu.w)};
        float prev[8];
        int t; const float* sh = nullptr;
        if (m < NTP) t = m & 2047; else { const int jj = m - NTP; t = jj & 3; sh = C.inp(7) + (size_t)(l * 8 + (jj >> 2)) * RW_COLS + col; }
        if (t > 0) { const v4u pu = *(const v4u*)(P + (size_t)(m - 1) * PLD + col);
            prev[0] = bflo(pu.x); prev[1] = bfhi(pu.x); prev[2] = bflo(pu.y); prev[3] = bfhi(pu.y); prev[4] = bflo(pu.z); prev[5] = bfhi(pu.z); prev[6] = bflo(pu.w); prev[7] = bfhi(pu.w);
        } else if (sh) {
#pragma unroll
            for (int e = 0; e < 8; ++e) prev[e] = sh[e];
        } else {
#pragma unroll
            for (int e = 0; e < 8; ++e) prev[e] = 0.f;
        }
        const float* mu = C.inp(9) + (size_t)l * RW_COLS + col;
#pragma unroll
        for (int e = 0; e < 8; ++e) XS[j * RW_COLS + col + e] = cur[e] + mu[e] * (prev[e] - cur[e]);
    }
    __syncthreads();
    for (int idx = tid; idx < 8 * 288; idx += NTHREADS) {
        const int j = idx / 288, a = idx % 288; const float x = XS[j * RW_COLS + 3072 + a];
        ACT[a * 8 + j] = a < 64 ? tanhf(x) : (a < 128 ? x : sigmoidf_(x));
    }
    __syncthreads();
    float wp[2][8], ap[2][8], gp[2][8];
#pragma unroll
    for (int s = 0; s < 2; ++s)
#pragma unroll
        for (int j = 0; j < 8; ++j) { wp[s][j] = 0.f; ap[s][j] = 0.f; gp[s][j] = 0.f; }
    const float* w2 = C.inp(11) + (size_t)l * 64 * 1024 + tid;
    const float* a2 = C.inp(13) + (size_t)l * 64 * 1024 + tid;
    const float* g2 = C.inp(14) + (size_t)l * 160 * 1024 + tid;
#pragma unroll 4
    for (int kk = 0; kk < 64; ++kk) {
        const float wa = w2[kk * 1024], wb = w2[kk * 1024 + 512];
        const f32x4 t0 = *(const LAS f32x4*)(ACT + kk * 8), t1 = *(const LAS f32x4*)(ACT + kk * 8 + 4);
#pragma unroll
        for (int j = 0; j < 4; ++j) { wp[0][j] += t0[j] * wa; wp[1][j] += t0[j] * wb; wp[0][4 + j] += t1[j] * wa; wp[1][4 + j] += t1[j] * wb; }
    }
#pragma unroll 4
    for (int kk = 0; kk < 64; ++kk) {
        const float wa = a2[kk * 1024], wb = a2[kk * 1024 + 512];
        const f32x4 t0 = *(const LAS f32x4*)(ACT + (64 + kk) * 8), t1 = *(const LAS f32x4*)(ACT + (64 + kk) * 8 + 4);
#pragma unroll
        for (int j = 0; j < 4; ++j) { ap[0][j] += t0[j] * wa; ap[1][j] += t0[j] * wb; ap[0][4 + j] += t1[j] * wa; ap[1][4 + j] += t1[j] * wb; }
    }
#pragma unroll 4
    for (int kk = 0; kk < 160; ++kk) {
        const float wa = g2[kk * 1024], wb = g2[kk * 1024 + 512];
        const f32x4 t0 = *(const LAS f32x4*)(ACT + (128 + kk) * 8), t1 = *(const LAS f32x4*)(ACT + (128 + kk) * 8 + 4);
#pragma unroll
        for (int j = 0; j < 4; ++j) { gp[0][j] += t0[j] * wa; gp[1][j] += t0[j] * wb; gp[0][4 + j] += t1[j] * wa; gp[1][4 + j] += t1[j] * wb; }
    }
    float* SC = wsp<float>(C, WS_SC); constexpr size_t SS = SC_STRIDE / 4;
    float* GG = wsp<float>(C, WS_GG); float* BON = wsp<float>(C, WS_BON);
#pragma unroll
    for (int s = 0; s < 2; ++s) {
        const int c = tid + 512 * s, head = wave + 8 * s;
        const float w0v = C.inp(10)[l * 1024 + c], a0v = C.inp(12)[l * 1024 + c], kkv = C.inp(15)[l * 1024 + c], kav = C.inp(16)[l * 1024 + c], rkv = C.inp(17)[l * 1024 + c];
#pragma unroll
        for (int j = 0; j < 8; ++j) {
            const size_t m = m0 + j;
            const float z = w0v + wp[s][j];
            const float w = -softplusf_(-z) - 0.5f;
            const float dec = expf(-expf(w));
            const float a = sigmoidf_(a0v + ap[s][j]);
            const float rr = XS[j * RW_COLS + c], k = XS[j * RW_COLS + 1024 + c], v = XS[j * RW_COLS + 2048 + c];
            const float kkr = k * kkv;
            const float ss = wave_sum(kkr * kkr);
            const float kk = kkr * (1.f / sqrtf(fmaxf(ss, 1e-24f)));
            const float km = k * (1.f + (a - 1.f) * kav);
            const float bon = wave_sum(rr * km * rkv);
            ((bf16*)(SC + 0 * SS))[m * 1024 + c] = (unsigned short)(pk2(kk, 0.f) & 0xffffu); SC[1 * SS + m * 1024 + c] = dec;
            ((unsigned*)(SC + 2 * SS))[m * 1024 + (c & ~63) + (c & 15) * 4 + ((c >> 4) & 3)] = pk2(-kk * a, km);
            ((bf16*)(SC + 4 * SS))[m * 1024 + c] = (unsigned short)(pk2(rr, 0.f) & 0xffffu); SC[5 * SS + m * 1024 + c] = v;
            GG[m * 1024 + c] = gp[s][j];
            if (lane == 0) BON[m * 16 + head] = bon;
        }
    }
}

DI void phase_b(const Ctx& C, int l) {
    const int tid = C.tid;
    const bf16* P = wsp<bf16>(C, WS_PROJ);
    for (int it = blockIdx.x; it < PB_ITEMS; it += C.G) {
        int r = it;
        if (r < PB_NRW) { rwkv_pre_item(C, l, r); continue; }
        r -= PB_NRW;
        if (r < PB_NPOOL) {
            const int b = r >> 6, n = r & 63, kv = tid >> 8, kvh = (tid >> 6) & 3, d = tid & 63;
            const float* src = C.out + O_CMP_P + ((size_t)l * NTP + b * 2048 + 32 * n) * 512 + tid;
            const float* w = C.inp(20) + (l * 2 + kv) * 32;
            float acc = 0.f;
#pragma unroll 8
            for (int rr = 0; rr < 32; ++rr) acc += w[rr] * src[(size_t)rr * 512];
            const unsigned short hb = (unsigned short)(pk2(acc, 0.f) & 0xffffu);
            if (kv == 0) wsp<bf16>(C, WS_KCB)[((size_t)(b * 4 + kvh) * 64 + n) * 64 + d] = hb;
            else wsp<bf16>(C, WS_VCBT)[((size_t)(b * 4 + kvh) * 64 + d) * 64 + n] = hb;
            continue;
        }
        r -= PB_NPOOL;
        {
            const int which = r >> 9, b = (r >> 7) & 3, kvh = (r >> 5) & 3, tb = r & 31, d = tid & 63, tq = tid >> 6;
            const bf16* src = P + (size_t)(b * 2048 + 64 * tb + 8 * tq) * PLD + (which ? VW_OFF : VS_OFF) + kvh * 64 + d;
            unsigned short e[8];
#pragma unroll
            for (int i = 0; i < 8; ++i) e[i] = src[(size_t)i * PLD];
            v4u o; o.x = e[0] | ((unsigned)e[1] << 16); o.y = e[2] | ((unsigned)e[3] << 16); o.z = e[4] | ((unsigned)e[5] << 16); o.w = e[6] | ((unsigned)e[7] << 16);
            *(v4u*)(wsp<bf16>(C, which ? WS_VTW : WS_VTS) + ((size_t)(b * 4 + kvh) * 64 + d) * 2048 + 64 * tb + 8 * tq) = o;
        }
    }
    __syncthreads();
}

#define MFMA16(a, b, c) __builtin_amdgcn_mfma_f32_16x16x32_bf16((a), (b), (c), 0, 0, 0)
DI void scan_head(const Ctx& C, int l, int row0, int T, int h, const float* S0, float* Sout) {
    const int tid = C.tid, lane = C.lane, wave = C.wave;
    LAS f32x4* D4 = (LAS f32x4*)C.lds;
    LAS v4u* BK4 = (LAS v4u*)(C.lds + 8192);
    LAS f32x4* V4 = (LAS f32x4*)(C.lds + 16384);
    LAS v4u* R16 = (LAS v4u*)(C.lds + 24576);
    LAS v4u* KK16 = (LAS v4u*)(C.lds + 28672);
    LAS float* YB = (LAS float*)(C.lds + 33280);
    const unsigned char* SCb = C.ws + WS_SC;
    const bf16* SCKK = (const bf16*)SCb; const float* SCD = (const float*)(SCb + SC_STRIDE); const unsigned* SCBK = (const unsigned*)(SCb + 2 * SC_STRIDE);
    const bf16* SCR = (const bf16*)(SCb + 4 * SC_STRIDE); const float* SCV = (const float*)(SCb + 5 * SC_STRIDE);
    const float* GG = wsp<float>(C, WS_GG); const float* BON = wsp<float>(C, WS_BON);
    bf16* MIX = wsp<bf16>(C, WS_MIX);
    const int n = lane & 15, rq = lane >> 4, v0 = 16 * (wave & 3); const bool act = wave < 4;
    f32x4 acc[4];
#pragma unroll
    for (int kt = 0; kt < 4; ++kt) acc[kt] = (act && S0) ? *(const f32x4*)(S0 + (v0 + n) * 64 + 16 * kt + 4 * rq) : (f32x4){0.f, 0.f, 0.f, 0.f};
    const int nch = (T + 31) >> 5;
    f32x4 pD, pV; v4u pBK, pRK, pK2;
    const v4u z4 = {0u, 0u, 0u, 0u};
#define SCAN_PREFETCH(cc) do { { const int step = (cc) * 32 + (tid >> 4), f4 = tid & 15; const size_t o = (size_t)(row0 + step) * 1024 + h * 64 + f4 * 4; const bool ok = step < T; \
            pD = ok ? *(const f32x4*)(SCD + o) : (f32x4){0.f, 0.f, 0.f, 0.f}; pV = ok ? *(const f32x4*)(SCV + o) : (f32x4){0.f, 0.f, 0.f, 0.f}; pBK = ok ? *(const v4u*)(SCBK + o) : z4; } \
        { const int i2 = tid & 255, step = (cc) * 32 + (i2 >> 3); const size_t o = (size_t)(row0 + step) * 1024 + h * 64 + (i2 & 7) * 8; pRK = step < T ? *(const v4u*)((tid < 256 ? SCR : SCKK) + o) : z4; } \
        { const int step = (cc) * 32 + 32; const size_t o = (size_t)(row0 + step) * 1024 + h * 64 + (tid & 7) * 8; pK2 = (tid < 8 && step < T) ? *(const v4u*)(SCKK + o) : z4; } } while (0)
    SCAN_PREFETCH(0);
    const float gng = C.inp(18)[l * 1024 + h * 64 + lane], gnb = C.inp(19)[l * 1024 + h * 64 + lane];
    float sk = 0.f;
    struct StepOps { f32x4 d[4]; v4u bk; float vt; v2u a[4]; };
#define SCAN_LD(o, st_) do { _Pragma("unroll") for (int kt = 0; kt < 4; ++kt) (o).d[kt] = D4[(st_) * 16 + 4 * kt + rq]; (o).bk = BK4[(st_) * 16 + n]; (o).vt = ((const LAS float*)V4)[(st_) * 64 + v0 + n]; \
        const LAS unsigned char* src_ = (n & 3) == 1 ? (const LAS unsigned char*)KK16 + ((st_) + 1) * 128 : (const LAS unsigned char*)R16 + (st_) * 128; \
        (o).a[0] = *(const LAS v2u*)(src_ + 8 * rq); (o).a[1] = *(const LAS v2u*)(src_ + 32 + 8 * rq); (o).a[2] = *(const LAS v2u*)(src_ + 64 + 8 * rq); (o).a[3] = *(const LAS v2u*)(src_ + 96 + 8 * rq); } while (0)
#define SCAN_YSK(a0_, a1_, a2_, a3_, yv, skv) do { \
        v4u h0, h1; h0.x = pk2(acc[0][0], acc[0][1]); h0.y = pk2(acc[0][2], acc[0][3]); h0.z = pk2(acc[1][0], acc[1][1]); h0.w = pk2(acc[1][2], acc[1][3]); \
        h1.x = pk2(acc[2][0], acc[2][1]); h1.y = pk2(acc[2][2], acc[2][3]); h1.z = pk2(acc[3][0], acc[3][1]); h1.w = pk2(acc[3][2], acc[3][3]); \
        const v4u f0 = {(a0_).x, (a0_).y, (a1_).x, (a1_).y}, f1 = {(a2_).x, (a2_).y, (a3_).x, (a3_).y}; \
        f32x4 d2 = MFMA16(__builtin_bit_cast(bf16x8, f0), __builtin_bit_cast(bf16x8, h0), ((f32x4){0.f, 0.f, 0.f, 0.f})); \
        d2 = MFMA16(__builtin_bit_cast(bf16x8, f1), __builtin_bit_cast(bf16x8, h1), d2); yv = d2[0]; skv = d2[1]; } while (0)
    for (int c = 0; c < nch; ++c) {
        __syncthreads();
        D4[tid] = pD; BK4[tid] = pBK; V4[tid] = pV;
        if (tid < 256) R16[tid] = pRK; else KK16[tid - 256] = pRK;
        if (tid < 8) KK16[256 + tid] = pK2;
        __syncthreads();
        if (c + 1 < nch) SCAN_PREFETCH(c + 1);
        const int nst = (T - c * 32) < 32 ? (T - c * 32) : 32;
        float gq[4], bq[4];
#pragma unroll
        for (int qq = 0; qq < 4; ++qq) { const int st = wave * 4 + qq; const size_t m = (size_t)row0 + c * 32 + (st < nst ? st : 0);
            gq[qq] = GG[m * 1024 + h * 64 + lane]; bq[qq] = BON[m * 16 + h]; }
        if (act) {
            if (c == 0) {
                const LAS unsigned char* s0 = (const LAS unsigned char*)KK16;
                const v2u k0 = *(const LAS v2u*)(s0 + 8 * rq), k1 = *(const LAS v2u*)(s0 + 32 + 8 * rq), k2 = *(const LAS v2u*)(s0 + 64 + 8 * rq), k3 = *(const LAS v2u*)(s0 + 96 + 8 * rq);
                float yd; SCAN_YSK(k0, k1, k2, k3, sk, yd); (void)yd;
            }
            StepOps cur; SCAN_LD(cur, 0);
#pragma unroll 2
            for (int st = 0; st < nst; ++st) {
                StepOps nx; { const int sn = st + 1 < 32 ? st + 1 : 31; SCAN_LD(nx, sn); }
#pragma unroll
                for (int kt = 0; kt < 4; ++kt) acc[kt] = acc[kt] * cur.d[kt];
                v4u b2 = z4; b2.x = rq == 0 ? pk2(sk, cur.vt) : 0u;
#pragma unroll
                for (int kt = 0; kt < 4; ++kt) { v4u a2 = z4; a2.x = rq == 0 ? cur.bk[kt] : 0u; acc[kt] = MFMA16(__builtin_bit_cast(bf16x8, a2), __builtin_bit_cast(bf16x8, b2), acc[kt]); }
                float y; SCAN_YSK(cur.a[0], cur.a[1], cur.a[2], cur.a[3], y, sk);
                if (rq == 0) YB[st * 64 + v0 + n] = y;
                cur = nx;
            }
        }
        __syncthreads();
#pragma unroll
        for (int qq = 0; qq < 4; ++qq) {
            const int st = wave * 4 + qq;
            if (st < nst) {
                const size_t m = (size_t)row0 + c * 32 + st;
                const float y = YB[st * 64 + lane];
                const float mean = wave_sum(y) * (1.f / 64.f);
                const float dv = y - mean;
                const float var = wave_sum(dv * dv) * (1.f / 64.f);
                const float yn = dv * (1.f / sqrtf(var + GN_EPS)) * gng + gnb;
                const float o = (yn + bq[qq] * ((const LAS float*)V4)[st * 64 + lane]) * gq[qq];
                MIX[m * DM + h * 64 + lane] = (unsigned short)(pk2(o, 0.f) & 0xffffu);
            }
        }
    }
#undef SCAN_PREFETCH
#undef SCAN_LD
#undef SCAN_YSK
    if (act) {
#pragma unroll
        for (int kt = 0; kt < 4; ++kt) *(f32x4*)(Sout + (v0 + n) * 64 + 16 * kt + 4 * rq) = acc[kt];
    }
}

#define MFMA32(a, b, c) __builtin_amdgcn_mfma_f32_32x32x16_bf16((a), (b), (c), 0, 0, 0)
DI bf16x8 pack8(const f32x16& p, int s) {
    v4u o; o.x = pk2(p[8 * s], p[8 * s + 1]); o.y = pk2(p[8 * s + 2], p[8 * s + 3]); o.z = pk2(p[8 * s + 4], p[8 * s + 5]); o.w = pk2(p[8 * s + 6], p[8 * s + 7]);
    return __builtin_bit_cast(bf16x8, o);
}
DI bf16x8 ld_vt(const bf16* p) {
    const v2u a = *(const v2u*)p, b = *(const v2u*)(p + 8);
    v4u o; o.x = a.x; o.y = a.y; o.z = b.x; o.w = b.y; return __builtin_bit_cast(bf16x8, o);
}
constexpr int KT_STRIDE = 144, VTT_STRIDE = 136, KT_BYTES = 64 * KT_STRIDE, TILE_BYTES = KT_BYTES + 64 * VTT_STRIDE, TILE_OFF = 74752;
struct TileRegs { v4u k, v; };
DI TileRegs tile_load(const bf16* kbase, size_t kstride, const bf16* vbase, size_t vstride, int tid) {
    TileRegs r; const int row = tid >> 3, ch = tid & 7;
    r.k = *(const v4u*)(kbase + (size_t)row * kstride + ch * 8); r.v = *(const v4u*)(vbase + (size_t)row * vstride + ch * 8); return r;
}
DI void tile_store(LAS unsigned char* buf, const TileRegs& r, int tid) {
    const int row = tid >> 3, ch = tid & 7;
    *(LAS v4u*)(buf + row * KT_STRIDE + ch * 16) = r.k;
    *(LAS v2u*)(buf + KT_BYTES + row * VTT_STRIDE + ch * 16) = (v2u){r.v.x, r.v.y}; *(LAS v2u*)(buf + KT_BYTES + row * VTT_STRIDE + ch * 16 + 8) = (v2u){r.v.z, r.v.w};
}
DI bf16x8 ld_vt_lds(const LAS unsigned char* p) {
    const v2u a = *(const LAS v2u*)p, b = *(const LAS v2u*)(p + 16);
    v4u o; o.x = a.x; o.y = a.y; o.z = b.x; o.w = b.y; return __builtin_bit_cast(bf16x8, o);
}
#define ATT_BLOCK(BUF, KEYBLK0, VALID_EXPR) do { \
    _Pragma("unroll") for (int tile = 0; tile < 2; ++tile) { const int key0 = (KEYBLK0) + tile * 32; \
        f32x16 a_ = zero16; \
        _Pragma("unroll") for (int s = 0; s < 4; ++s) { const bf16x8 kf = *(const LAS bf16x8*)((BUF) + (tile * 32 + q) * KT_STRIDE + 32 * s + 16 * hi); a_ = MFMA32(kf, qf[s], a_); } \
        float tm = NEG_BIG; \
        _Pragma("unroll") for (int i = 0; i < 16; ++i) { const int key = key0 + crow(i, hi); const bool ok = (VALID_EXPR); a_[i] = ok ? a_[i] * 0.125f : NEG_BIG; tm = fmaxf(tm, a_[i]); } \
        tm = fmaxf(tm, __shfl_xor(tm, 32)); \
        const float mn = fmaxf(mrun, tm); const float sc_ = __expf(mrun - mn); \
        float ps = 0.f; \
        _Pragma("unroll") for (int i = 0; i < 16; ++i) { const float p_ = a_[i] > -1e29f ? __expf(a_[i] - mn) : 0.f; a_[i] = p_; ps += p_; } \
        ps += __shfl_xor(ps, 32); \
        lrun = lrun * sc_ + ps; mrun = mn; \
        _Pragma("unroll") for (int i = 0; i < 16; ++i) { oa[0][i] *= sc_; oa[1][i] *= sc_; } \
        _Pragma("unroll") for (int s = 0; s < 2; ++s) { const bf16x8 pb = pack8(a_, s); \
            oa[0] = MFMA32(ld_vt_lds((BUF) + KT_BYTES + q * VTT_STRIDE + (tile * 32 + 16 * s + 4 * hi) * 2), pb, oa[0]); \
            oa[1] = MFMA32(ld_vt_lds((BUF) + KT_BYTES + (32 + q) * VTT_STRIDE + (tile * 32 + 16 * s + 4 * hi) * 2), pb, oa[1]); } \
    } } while (0)

DI void nsa_prompt_unit(const Ctx& C, int l, int b, int kvh, int qt) {
    const int tid = C.tid, lane = C.lane, wave = C.wave;
    const int g = wave & 3, th = wave >> 2, q = lane & 31, hi = lane >> 5;
    LAS float* IMP = (LAS float*)C.lds;
    LAS float* IMPV = (LAS float*)(C.lds + 65536);
    LAS unsigned* SELM = (LAS unsigned*)(C.lds + 65536 + 8192);
    LAS unsigned char* TB = C.lds + TILE_OFF;
    const bf16* P = wsp<bf16>(C, WS_PROJ);
    const int tok = qt * 64 + th * 32 + q;
    const size_t m = (size_t)b * 2048 + tok;
    const int bk = b * 4 + kvh, head = kvh * 4 + g;
    f32x16 zero16;
#pragma unroll
    for (int i = 0; i < 16; ++i) zero16[i] = 0.f;
    bf16x8 qf[4];
#pragma unroll
    for (int s = 0; s < 4; ++s) qf[s] = *(const bf16x8*)(P + m * PLD + Q_OFF + head * 64 + 16 * s + 8 * hi);
    f32x16 out0 = zero16, out1 = zero16;
    const float g0 = sigmoidf_(bf2f(P[m * PLD + GL_OFF + head * 3 + 0])), g1 = sigmoidf_(bf2f(P[m * PLD + GL_OFF + head * 3 + 1])), g2 = sigmoidf_(bf2f(P[m * PLD + GL_OFF + head * 3 + 2]));
    TileRegs tr = tile_load(wsp<bf16>(C, WS_KCB) + (size_t)bk * 4096, 64, wsp<bf16>(C, WS_VCBT) + (size_t)bk * 4096, 64, tid);
    __syncthreads();
    tile_store(TB, tr, tid);
    __syncthreads();
    {
        f32x16 sc[2];
        const int nvalid = (tok + 1) >> 5;
        float mx = NEG_BIG;
#pragma unroll
        for (int tile = 0; tile < 2; ++tile) {
            f32x16 a_ = zero16;
#pragma unroll
            for (int s = 0; s < 4; ++s) { const bf16x8 kf = *(const LAS bf16x8*)(TB + (tile * 32 + q) * KT_STRIDE + 32 * s + 16 * hi); a_ = MFMA32(kf, qf[s], a_); }
#pragma unroll
            for (int i = 0; i < 16; ++i) { const int n = tile * 32 + crow(i, hi); a_[i] = n < nvalid ? a_[i] * 0.125f : NEG_BIG; mx = fmaxf(mx, a_[i]); }
            sc[tile] = a_;
        }
        mx = fmaxf(mx, __shfl_xor(mx, 32));
        float sum = 0.f;
#pragma unroll
        for (int tile = 0; tile < 2; ++tile)
#pragma unroll
            for (int i = 0; i < 16; ++i) { const float p_ = sc[tile][i] > -1e29f ? __expf(sc[tile][i] - mx) : 0.f; sc[tile][i] = p_; sum += p_; }
        sum += __shfl_xor(sum, 32);
        const float inv = nvalid > 0 ? 1.f / sum : 0.f;
        f32x16 oc0 = zero16, oc1 = zero16;
#pragma unroll
        for (int tile = 0; tile < 2; ++tile) {
#pragma unroll
            for (int i = 0; i < 16; ++i) sc[tile][i] *= inv;
#pragma unroll
            for (int i4 = 0; i4 < 4; ++i4) { f32x4 v = {sc[tile][4 * i4], sc[tile][4 * i4 + 1], sc[tile][4 * i4 + 2], sc[tile][4 * i4 + 3]};
                *(LAS f32x4*)(IMP + ((size_t)(g * 64 + th * 32 + q)) * 64 + tile * 32 + 8 * i4 + 4 * hi) = v; }
#pragma unroll
            for (int s = 0; s < 2; ++s) { const bf16x8 pb = pack8(sc[tile], s);
                oc0 = MFMA32(ld_vt_lds(TB + KT_BYTES + q * VTT_STRIDE + (tile * 32 + 16 * s + 4 * hi) * 2), pb, oc0);
                oc1 = MFMA32(ld_vt_lds(TB + KT_BYTES + (32 + q) * VTT_STRIDE + (tile * 32 + 16 * s + 4 * hi) * 2), pb, oc1); }
        }
#pragma unroll
        for (int i = 0; i < 16; ++i) { out0[i] = g0 * oc0[i]; out1[i] = g0 * oc1[i]; }
    }
    __syncthreads();
    {
        const int tokl = tid >> 3, jq = tid & 7;
        float v[4];
#pragma unroll
        for (int e = 0; e < 4; ++e) v[e] = 0.f;
#pragma unroll
        for (int gg = 0; gg < 4; ++gg) { const f32x4 a = *(const LAS f32x4*)(IMP + (size_t)(gg * 64 + tokl) * 64 + 8 * jq), bq = *(const LAS f32x4*)(IMP + (size_t)(gg * 64 + tokl) * 64 + 8 * jq + 4);
            v[0] += a[0] + a[1]; v[1] += a[2] + a[3]; v[2] += bq[0] + bq[1]; v[3] += bq[2] + bq[3]; }
        const int cur = qt;
#pragma unroll
        for (int e = 0; e < 4; ++e) { const int j = 4 * jq + e; const bool forced = (j == 0) | (j == cur) | (j == cur - 1); v[e] = j > cur ? -1.f : (forced ? 1e4f : v[e]); }
        *(LAS f32x4*)(IMPV + tokl * 32 + 4 * jq) = (f32x4){v[0], v[1], v[2], v[3]};
        __syncthreads();
        int rank[4] = {0, 0, 0, 0};
#pragma unroll
        for (int jj4 = 0; jj4 < 8; ++jj4) { const f32x4 o = *(const LAS f32x4*)(IMPV + tokl * 32 + 4 * jj4);
#pragma unroll
            for (int u = 0; u < 4; ++u) { const int jp = 4 * jj4 + u; const float ov = o[u];
#pragma unroll
                for (int e = 0; e < 4; ++e) { const int j = 4 * jq + e; rank[e] += (ov > v[e] || (ov == v[e] && jp < j)) ? 1 : 0; } } }
        unsigned bits = 0;
#pragma unroll
        for (int e = 0; e < 4; ++e) if (rank[e] < 16 && v[e] >= 0.f) bits |= 1u << (4 * jq + e);
        bits |= __shfl_xor(bits, 1); bits |= __shfl_xor(bits, 2); bits |= __shfl_xor(bits, 4);
        if (jq == 0) SELM[tokl] = bits;
        __syncthreads();
    }
    const unsigned selm = SELM[th * 32 + q];
    unsigned uni;
    { unsigned u0 = SELM[lane];
#pragma unroll
      for (int o = 1; o < 64; o <<= 1) u0 |= __shfl_xor(u0, o);
      uni = __builtin_amdgcn_readfirstlane(u0); }
    {
        const bf16* KB = P + (size_t)b * 2048 * PLD + KS_OFF + kvh * 64;
        const bf16* VT = wsp<bf16>(C, WS_VTS) + (size_t)bk * 64 * 2048;
        f32x16 oa[2] = {zero16, zero16}; float mrun = NEG_BIG, lrun = 0.f;
        unsigned rem = uni; int j = __builtin_ctz(rem); rem &= rem - 1;
        tr = tile_load(KB + (size_t)(j * 64) * PLD, PLD, VT + j * 64, 2048, tid);
        for (int k = 0;; ++k) {
            LAS unsigned char* buf = TB + (k & 1) * TILE_BYTES;
            tile_store(buf, tr, tid);
            __syncthreads();
            const int jn = rem ? __builtin_ctz(rem) : -1; rem &= rem - 1;
            if (jn >= 0) tr = tile_load(KB + (size_t)(jn * 64) * PLD, PLD, VT + jn * 64, 2048, tid);
            const bool mine = (selm >> j) & 1u;
            if (__any(mine)) ATT_BLOCK(buf, j * 64, (mine && key <= tok));
            if (jn < 0) break;
            j = jn;
        }
        const float il = g1 / lrun;
#pragma unroll
        for (int i = 0; i < 16; ++i) { out0[i] += il * oa[0][i]; out1[i] += il * oa[1][i]; }
    }
    {
        const bf16* KB = P + (size_t)b * 2048 * PLD + KW_OFF + kvh * 64;
        const bf16* VT = wsp<bf16>(C, WS_VTW) + (size_t)bk * 64 * 2048;
        f32x16 oa[2] = {zero16, zero16}; float mrun = NEG_BIG, lrun = 0.f;
        int j = qt > 8 ? qt - 8 : 0;
        tr = tile_load(KB + (size_t)(j * 64) * PLD, PLD, VT + j * 64, 2048, tid);
        __syncthreads();
        for (int k = 0;; ++k, ++j) {
            LAS unsigned char* buf = TB + (k & 1) * TILE_BYTES;
            tile_store(buf, tr, tid);
            __syncthreads();
            if (j < qt) tr = tile_load(KB + (size_t)((j + 1) * 64) * PLD, PLD, VT + (j + 1) * 64, 2048, tid);
            ATT_BLOCK(buf, j * 64, (key <= tok && key + 511 >= tok));
            if (j >= qt) break;
        }
        const float il = g2 / lrun;
#pragma unroll
        for (int i = 0; i < 16; ++i) { out0[i] += il * oa[0][i]; out1[i] += il * oa[1][i]; }
    }
    bf16* MIX = wsp<bf16>(C, WS_MIX) + m * DM + 1024 + head * 64;
#pragma unroll
    for (int i4 = 0; i4 < 4; ++i4) {
        v2u o; o.x = pk2(out0[4 * i4], out0[4 * i4 + 1]); o.y = pk2(out0[4 * i4 + 2], out0[4 * i4 + 3]); *(v2u*)(MIX + 8 * i4 + 4 * hi) = o;
        o.x = pk2(out1[4 * i4], out1[4 * i4 + 1]); o.y = pk2(out1[4 * i4 + 2], out1[4 * i4 + 3]); *(v2u*)(MIX + 32 + 8 * i4 + 4 * hi) = o;
    }
}

template <class RowFn> DI void samp_block(const RowFn& rowptr, int nvalid, int kvh, const LAS float* QS, LAS float* PWw, int lane, float (&M)[4], float (&L)[4], float (&O)[4]) {
    float s[4] = {0.f, 0.f, 0.f, 0.f};
    const bool ok = lane < nvalid;
    if (ok) {
        const f32x4* kr = (const f32x4*)(rowptr(lane) + kvh * 64);
#pragma unroll 4
        for (int d4 = 0; d4 < 16; ++d4) { const f32x4 kq = kr[d4];
#pragma unroll
            for (int g = 0; g < 4; ++g) { const f32x4 qq = *(const LAS f32x4*)(QS + g * 64 + 4 * d4); s[g] += kq[0] * qq[0] + kq[1] * qq[1] + kq[2] * qq[2] + kq[3] * qq[3]; } }
    }
    float mb[4], lb[4];
#pragma unroll
    for (int g = 0; g < 4; ++g) { const float sv = ok ? s[g] : NEG_BIG; mb[g] = wave_max(sv); const float p = ok ? expf(sv - mb[g]) : 0.f; lb[g] = wave_sum(p); PWw[g * 64 + lane] = p; }
    LDS_WAIT(); asm volatile("" ::: "memory");
    float ob[4] = {0.f, 0.f, 0.f, 0.f};
    for (int r = 0; r < nvalid; ++r) { const float vv = rowptr(r)[256 + kvh * 64 + lane];
#pragma unroll
        for (int g = 0; g < 4; ++g) ob[g] += PWw[g * 64 + r] * vv; }
    LDS_WAIT(); asm volatile("" ::: "memory");
#pragma unroll
    for (int g = 0; g < 4; ++g) { const float mn = fmaxf(M[g], mb[g]); const float a = expf(M[g] - mn), bsc = expf(mb[g] - mn); L[g] = L[g] * a + lb[g] * bsc; O[g] = O[g] * a + ob[g] * bsc; M[g] = mn; }
}
DI float samp_combine(LAS float* WST, int tid, int lane, int wave, const float (&M)[4], const float (&L)[4], const float (&O)[4]) {
    __syncthreads();
#pragma unroll
    for (int g = 0; g < 4; ++g) { WST[wave * 264 + 8 + g * 64 + lane] = O[g]; if (lane == 0) { WST[wave * 264 + g] = M[g]; WST[wave * 264 + 4 + g] = L[g]; } }
    __syncthreads();
    float res = 0.f;
    if (tid < 256) { const int g = tid >> 6, d = tid & 63; float mm = NEG_BIG;
#pragma unroll
        for (int w = 0; w < 8; ++w) mm = fmaxf(mm, WST[w * 264 + g]);
        float ll = 0.f, oo = 0.f;
#pragma unroll
        for (int w = 0; w < 8; ++w) { const float e = expf(WST[w * 264 + g] - mm); ll += WST[w * 264 + 4 + g] * e; oo += WST[w * 264 + 8 + g * 64 + d] * e; }
        res = oo / ll; }
    return res;
}

DI void nsa_sample_item(const Ctx& C, int l, int b, int t, int kvh) {
    const int tid = C.tid, lane = C.lane, wave = C.wave;
    LAS float* F = (LAS float*)C.lds;
    LAS float *QS = F, *PC = F + 256, *IMPS = F + 2304, *RED = F + 2624, *RED2 = F + 2688, *OCP = F + 2752, *PW = F + 4800, *WST = F + 6848;
    LAS int* SELB = (LAS int*)(F + 2560);
    const bf16* P = wsp<bf16>(C, WS_PROJ);
    const size_t m = (size_t)NTP + b * 4 + t;
    __syncthreads();
    if (tid < 256) QS[tid] = bf2f(P[m * PLD + Q_OFF + kvh * 256 + tid]) * 0.125f;
    __syncthreads();
    float ocmp = 0.f;
    {
        const float* KC = wsp<float>(C, WS_KCBS) + ((size_t)((l * 8 + b) * 4 + kvh) * 512) * 64;
        const float* VC = wsp<float>(C, WS_VCBS) + ((size_t)((l * 8 + b) * 4 + kvh) * 512) * 64;
        float s[4] = {0.f, 0.f, 0.f, 0.f};
        const f32x4* kr = (const f32x4*)(KC + (size_t)tid * 64);
#pragma unroll 4
        for (int d4 = 0; d4 < 16; ++d4) { const f32x4 kq = kr[d4];
#pragma unroll
            for (int g = 0; g < 4; ++g) { const f32x4 qq = *(const LAS f32x4*)(QS + g * 64 + 4 * d4); s[g] += kq[0] * qq[0] + kq[1] * qq[1] + kq[2] * qq[2] + kq[3] * qq[3]; } }
#pragma unroll
        for (int g = 0; g < 4; ++g) { const float wm = wave_max(s[g]); if (lane == 0) RED[wave * 4 + g] = wm; }
        __syncthreads();
        float p[4];
#pragma unroll
        for (int g = 0; g < 4; ++g) { float mm = RED[g];
#pragma unroll
            for (int w = 1; w < 8; ++w) mm = fmaxf(mm, RED[w * 4 + g]);
            p[g] = expf(s[g] - mm); const float ws = wave_sum(p[g]); if (lane == 0) RED2[wave * 4 + g] = ws; }
        __syncthreads();
#pragma unroll
        for (int g = 0; g < 4; ++g) { float tot = 0.f;
#pragma unroll
            for (int w = 0; w < 8; ++w) tot += RED2[w * 4 + g];
            PC[g * 512 + tid] = p[g] / tot; }
        __syncthreads();
        if (tid < 256) IMPS[tid] = (PC[2 * tid] + PC[2 * tid + 1]) + (PC[512 + 2 * tid] + PC[512 + 2 * tid + 1]) + (PC[1024 + 2 * tid] + PC[1024 + 2 * tid + 1]) + (PC[1536 + 2 * tid] + PC[1536 + 2 * tid + 1]);
        { const int d = tid & 63, nq = tid >> 6; float acc[4] = {0.f, 0.f, 0.f, 0.f};
#pragma unroll 4
            for (int n = nq * 64; n < nq * 64 + 64; ++n) { const float vv = VC[(size_t)n * 64 + d];
#pragma unroll
                for (int g = 0; g < 4; ++g) acc[g] += PC[g * 512 + n] * vv; }
#pragma unroll
            for (int g = 0; g < 4; ++g) OCP[(nq * 4 + g) * 64 + d] = acc[g]; }
        __syncthreads();
        if (tid < 256) { const int g = tid >> 6, d = tid & 63;
#pragma unroll
            for (int nq = 0; nq < 8; ++nq) ocmp += OCP[(nq * 4 + g) * 64 + d];
            const int j = tid;
            if (j >= 1 && j <= 254) { const float v = IMPS[j]; int rank = 0;
                for (int jp = 1; jp <= 254; ++jp) { const float ov = IMPS[jp]; rank += (ov > v || (ov == v && jp < j)) ? 1 : 0; }
                if (rank < 13) SELB[rank] = j; }
            if (tid == 0) { SELB[13] = 0; SELB[14] = 255; SELB[15] = 256; }
        }
        __syncthreads();
    }
    float osel;
    {
        float M[4] = {NEG_BIG, NEG_BIG, NEG_BIG, NEG_BIG}, L[4] = {0.f, 0.f, 0.f, 0.f}, O[4] = {0.f, 0.f, 0.f, 0.f};
        const int* pt = (const int*)C.inp(4) + b * 128;
        for (int bi = 0; bi < 2; ++bi) {
            const int jb = __builtin_amdgcn_readfirstlane(SELB[2 * wave + bi]);
            if (jb < 256) { const int pid = pt[jb >> 1];
                const float* base = C.inp(3) + ((size_t)(l * NPOOL + pid) * 128 + (jb & 1) * 64) * 512;
                samp_block([&](int r) { return base + (size_t)r * 512; }, 64, kvh, QS, PW + wave * 256, lane, M, L, O);
            } else { const float* base = C.out + O_SEL_S + ((size_t)l * NTS + b * 4) * 512;
                samp_block([&](int r) { return base + (size_t)r * 512; }, t + 1, kvh, QS, PW + wave * 256, lane, M, L, O); }
        }
        osel = samp_combine(WST, tid, lane, wave, M, L, O);
    }
    float owin;
    {
        float M[4] = {NEG_BIG, NEG_BIG, NEG_BIG, NEG_BIG}, L[4] = {0.f, 0.f, 0.f, 0.f}, O[4] = {0.f, 0.f, 0.f, 0.f};
        const float* pre = C.inp(5) + (size_t)(l * 8 + b) * 262144;
        const float* nw = C.out + O_WIN_S + ((size_t)(l * 8 + b) * 512 + 508) * 512;
        samp_block([&](int r) { const int p = t + 1 + 64 * wave + r; return p <= 511 ? pre + (size_t)p * 512 : nw + (size_t)(p - 512) * 512; }, 64, kvh, QS, PW + wave * 256, lane, M, L, O);
        owin = samp_combine(WST, tid, lane, wave, M, L, O);
    }
    if (tid < 256) { const int g = tid >> 6, d = tid & 63, head = kvh * 4 + g;
        const float g0 = sigmoidf_(bf2f(P[m * PLD + GL_OFF + head * 3 + 0])), g1 = sigmoidf_(bf2f(P[m * PLD + GL_OFF + head * 3 + 1])), g2 = sigmoidf_(bf2f(P[m * PLD + GL_OFF + head * 3 + 2]));
        const float o = g0 * ocmp + g1 * osel + g2 * owin;
        wsp<bf16>(C, WS_MIX)[m * DM + 1024 + head * 64 + d] = (unsigned short)(pk2(o, 0.f) & 0xffffu); }
}

#ifndef C_MASK
#define C_MASK 7
#endif
constexpr int PC_SCAN_P = 64, PC_ATT_P = 512, PC_ATT_S = 128, PC_SCAN_S = 128, PC_ITEMS = PC_SCAN_P + PC_ATT_P + PC_ATT_S + PC_SCAN_S;
DI void phase_c(const Ctx& C0, int lq, int cmask = 7) {
    const int l = lq & 1;
    LAS int* slot = (LAS int*)(C0.lds + MISC_OFF + 64);
    for (;;) {
        __syncthreads();
        if (C0.tid == 0) *slot = (int)atomicAdd(C0.ctl + CW_QUEUE + 64 * lq, 1u);
        __syncthreads();
        int it = *slot;
        if (it >= PC_ITEMS) break;
        Ctx K = C0; { K.ws = launder_g(K.ws); K.out = launder_g(K.out); int t_ = K.tid; asm volatile("" : "+v"(t_)); K.tid = t_; K.lane = t_ & 63; K.wave = __builtin_amdgcn_readfirstlane(t_ >> 6); }
        const Ctx& C = K;
        if (it < PC_SCAN_P || it >= PC_SCAN_P + PC_ATT_P + PC_ATT_S) {
            int row0, T, h; const float* S0; float* So;
            if (it < PC_SCAN_P) { const int b = it >> 4; h = it & 15; row0 = b * 2048; T = 2048; S0 = nullptr; So = C.out + O_RW_P + ((size_t)(l * 4 + b) * 16 + h) * 4096; }
            else { const int u = it - (PC_SCAN_P + PC_ATT_P + PC_ATT_S), b = u >> 4; h = u & 15; row0 = NTP + b * 4; T = 4; S0 = C.inp(6) + ((size_t)(l * 8 + b) * 16 + h) * 4096; So = C.out + O_RW_S + ((size_t)(l * 8 + b) * 16 + h) * 4096; }
            if (cmask & 1) scan_head(C, l, row0, T, h, S0, So);
        } else if (it < PC_SCAN_P + PC_ATT_P) {
            const int u = it - PC_SCAN_P, qt = 31 - (u >> 4), bk = u & 15;
            if (cmask & 2) nsa_prompt_unit(C, l, bk >> 2, bk & 3, qt);
        } else {
            const int u = it - (PC_SCAN_P + PC_ATT_P);
            if (cmask & 4) nsa_sample_item(C, l, u >> 4, (u >> 2) & 3, u & 3);
        }
    }
    __syncthreads();
}

DI const float* xin_row(const Ctx& C, int l, size_t m) {
    if (l == 0) return m < (size_t)NTP ? C.inp(0) + m * DM : C.inp(1) + (m - NTP) * DM;
    return wsp<float>(C, WS_XF1) + m * DM;
}
DI void phase_e(const Ctx& C, int l) {
    const int lane = C.lane;
    const float* H = wsp<float>(C, WS_HS);
    float* X1F = wsp<float>(C, WS_X1F); bf16* X1B = wsp<bf16>(C, WS_X1B);
    const float* gw = C.inp(22) + (size_t)l * DM; const float* bw = C.inp(23) + (size_t)l * DM;
    for (int m = blockIdx.x * NWAVES + C.wave; m < NT; m += C.G * NWAVES) {
        const f32x4* xr = (const f32x4*)xin_row(C, l, m) + lane; const f32x4* hr = (const f32x4*)(H + (size_t)m * DM) + lane;
        f32x4 v[8]; float s = 0.f;
#pragma unroll
        for (int j = 0; j < 8; ++j) { v[j] = xr[64 * j] * DN_ALPHA + hr[64 * j]; s += (v[j][0] + v[j][1]) + (v[j][2] + v[j][3]); }
        const float mean = wave_sum(s) * (1.f / DM); float s2 = 0.f;
#pragma unroll
        for (int j = 0; j < 8; ++j) { v[j] = v[j] - mean; s2 += (v[j][0] * v[j][0] + v[j][1] * v[j][1]) + (v[j][2] * v[j][2] + v[j][3] * v[j][3]); }
        const float rstd = 1.f / sqrtf(wave_sum(s2) * (1.f / DM) + LN_EPS);
#pragma unroll
        for (int j = 0; j < 8; ++j) { const f32x4 gg = ((const f32x4*)gw)[lane + 64 * j], bb = ((const f32x4*)bw)[lane + 64 * j];
            const f32x4 o = v[j] * rstd * gg + bb;
            ((f32x4*)(X1F + (size_t)m * DM))[lane + 64 * j] = o;
            v2u p; p.x = pk2(o[0], o[1]); p.y = pk2(o[2], o[3]); ((v2u*)(X1B + (size_t)m * DM))[lane + 64 * j] = p; }
    }
}

DI float gelu_erf(float x) { return 0.5f * x * (1.f + erff(x * 0.70710678118654752f)); }
DI unsigned fkey(float f) { const unsigned u = __builtin_bit_cast(unsigned, f); return u ^ ((unsigned)((int)u >> 31) | 0x80000000u); }
DI int mbcnt64(unsigned long long m) { return __builtin_amdgcn_mbcnt_hi((unsigned)(m >> 32), __builtin_amdgcn_mbcnt_lo((unsigned)m, 0)); }
template <int NV, bool LANE_MAJOR> DI void top16(const unsigned (&key)[NV], bool (&sel)[NV], int (&pos)[NV]) {
    unsigned thr = 0u; bool exact = false;
    for (int bit = 31; bit >= 0; --bit) {
        const unsigned cand = thr | (1u << bit);
        int cnt = 0;
#pragma unroll
        for (int v = 0; v < NV; ++v) cnt += __builtin_popcountll(__ballot(key[v] >= cand));
        if (cnt >= 16) { thr = cand; if (cnt == 16) { exact = true; break; } }
    }
    unsigned long long sm[NV];
    if (exact) {
#pragma unroll
        for (int v = 0; v < NV; ++v) { sel[v] = key[v] >= thr; sm[v] = __ballot(sel[v]); }
    } else {
        unsigned long long eq[NV]; int ngt = 0;
#pragma unroll
        for (int v = 0; v < NV; ++v) { ngt += __builtin_popcountll(__ballot(key[v] > thr)); eq[v] = __ballot(key[v] == thr); }
        const int need = 16 - ngt;
#pragma unroll
        for (int v = 0; v < NV; ++v) { int rk;
            if (LANE_MAJOR) { rk = 0;
#pragma unroll
                for (int w = 0; w < NV; ++w) { rk += mbcnt64(eq[w]); if (w < v) rk += (int)((eq[w] >> (threadIdx.x & 63)) & 1ull); } }
            else { rk = mbcnt64(eq[v]);
#pragma unroll
                for (int w = 0; w < NV; ++w) if (w < v) rk += __builtin_popcountll(eq[w]); }
            sel[v] = key[v] > thr || (key[v] == thr && rk < need); sm[v] = __ballot(sel[v]); }
    }
    int base = 0;
#pragma unroll
    for (int v = 0; v < NV; ++v) { pos[v] = base + mbcnt64(sm[v]); base += __builtin_popcountll(sm[v]); }
}
typedef float f32x2v __attribute__((ext_vector_type(2)));
DI void phase_g(const Ctx& C, int l) {
    const int tid = C.tid, lane = C.lane, wave = C.wave;
    LAS float* FACC = (LAS float*)C.lds;
    LAS float* RED = (LAS float*)(C.lds + 65536);
    LAS float* WL = (LAS float*)(C.lds + 65536 + 256 + wave * 512);
    LAS int* WLi = (LAS int*)WL;
    const float* Sc = wsp<float>(C, WS_HS);
    const float* X1F = wsp<float>(C, WS_X1F);
    const unsigned char* UB = C.ws + WS_UB + (size_t)l * NEXP * DM; const unsigned char* VB = C.ws + WS_VB + (size_t)l * NEXP * DM;
    const float* USC = wsp<float>(C, WS_USC) + (size_t)l * NEXP; const float* VSC = USC + 2 * NEXP;
    const float* gw = C.inp(28) + (size_t)l * DM; const float* bw = C.inp(29) + (size_t)l * DM;
    for (int m = blockIdx.x; m < NT; m += C.G) {
        const float* sr = Sc + (size_t)m * DM + wave * 256;
        const float a0 = sr[lane], a1 = sr[64 + lane], b0 = sr[128 + lane], b1 = sr[192 + lane];
        { const unsigned k0[2] = {fkey(a0), fkey(a1)}; bool s0[2]; int p0[2]; top16<2, false>(k0, s0, p0);
          if (s0[0]) { WL[p0[0]] = a0; WLi[16 + p0[0]] = lane; } if (s0[1]) { WL[p0[1]] = a1; WLi[16 + p0[1]] = lane + 64; }
          const unsigned k1[2] = {fkey(b0), fkey(b1)}; bool s1[2]; int p1[2]; top16<2, false>(k1, s1, p1);
          if (s1[0]) { WL[32 + p1[0]] = b0; WLi[48 + p1[0]] = lane; } if (s1[1]) { WL[32 + p1[1]] = b1; WLi[48 + p1[1]] = lane + 64; } }
        LDS_WAIT(); asm volatile("" ::: "memory");
        float cd[4];
        { const float x0 = WL[lane >> 2]; const f32x4 x1 = *(const LAS f32x4*)(WL + 32 + (lane & 3) * 4);
          cd[0] = x0 + x1[0]; cd[1] = x0 + x1[1]; cd[2] = x0 + x1[2]; cd[3] = x0 + x1[3]; }
        { const unsigned kc[4] = {fkey(cd[0]), fkey(cd[1]), fkey(cd[2]), fkey(cd[3])}; bool sc_[4]; int pc[4]; top16<4, true>(kc, sc_, pc);
          const int ei = WLi[16 + (lane >> 2)] * 128;
#pragma unroll
          for (int jj = 0; jj < 4; ++jj) if (sc_[jj]) { WL[64 + pc[jj]] = cd[jj]; WLi[80 + pc[jj]] = ei + WLi[48 + (lane & 3) * 4 + jj]; } }
        LDS_WAIT(); asm volatile("" ::: "memory");
        const float tv = lane < 16 ? WL[64 + lane] : -INFINITY;
        const float tmax = wave_max(tv);
        const float ev = lane < 16 ? expf(tv - tmax) : 0.f;
        const float gate = ev / wave_sum(ev);
        if (lane < 16) WL[64 + lane] = gate;
        LDS_WAIT(); asm volatile("" ::: "memory");
        float x[32];
        { const f32x4* xr = (const f32x4*)(X1F + (size_t)m * DM);
#pragma unroll
          for (int k = 0; k < 2; ++k)
#pragma unroll
              for (int q = 0; q < 4; ++q) { const f32x4 a = xr[4 * lane + 256 * k + q];
#pragma unroll
                  for (int e = 0; e < 4; ++e) x[16 * k + 4 * q + e] = a[e]; } }
        f32x2v acc[16];
#pragma unroll
        for (int i = 0; i < 16; ++i) acc[i] = (f32x2v){0.f, 0.f};
        v4u ub[2][2], vb[2][2];
#define G_LOAD(bufi, r_) do { const int e_ = __builtin_amdgcn_readfirstlane(WLi[80 + (r_)]); \
            const v4u* ur_ = (const v4u*)(UB + (size_t)e_ * DM); const v4u* vr_ = (const v4u*)(VB + (size_t)e_ * DM); \
            ub[bufi][0] = ur_[lane]; ub[bufi][1] = ur_[lane + 64]; vb[bufi][0] = vr_[lane]; vb[bufi][1] = vr_[lane + 64]; } while (0)
#define G_COMP(bufi, r_) do { const int e_ = __builtin_amdgcn_readfirstlane(WLi[80 + (r_)]); const float gt_ = WL[64 + (r_)]; \
            f32x2v d2 = {0.f, 0.f}; \
            _Pragma("unroll") for (int k = 0; k < 2; ++k) _Pragma("unroll") for (int q = 0; q < 4; ++q) { const int wd = (int)ub[bufi][k][q]; \
                const f32x2v lo_ = __builtin_amdgcn_cvt_pk_f32_fp8(wd, false), hi_ = __builtin_amdgcn_cvt_pk_f32_fp8(wd, true); \
                d2 += lo_ * (f32x2v){x[16 * k + 4 * q], x[16 * k + 4 * q + 1]}; d2 += hi_ * (f32x2v){x[16 * k + 4 * q + 2], x[16 * k + 4 * q + 3]}; } \
            const float dot_ = wave_sum(d2.x + d2.y) * USC[e_]; \
            const float wg_ = gt_ * gelu_erf(dot_) * VSC[e_]; const f32x2v w2_ = {wg_, wg_}; \
            _Pragma("unroll") for (int k = 0; k < 2; ++k) _Pragma("unroll") for (int q = 0; q < 4; ++q) { const int wd = (int)vb[bufi][k][q]; \
                acc[8 * k + 2 * q] += w2_ * __builtin_amdgcn_cvt_pk_f32_fp8(wd, false); acc[8 * k + 2 * q + 1] += w2_ * __builtin_amdgcn_cvt_pk_f32_fp8(wd, true); } } while (0)
        G_LOAD(0, 0);
#pragma unroll 1
        for (int r = 0; r < 16; r += 2) {
            G_LOAD(1, r + 1);
            G_COMP(0, r);
            if (r + 2 < 16) G_LOAD(0, r + 2);
            G_COMP(1, r + 1);
        }
#undef G_LOAD
#undef G_COMP
        __syncthreads();
#pragma unroll
        for (int k = 0; k < 2; ++k)
#pragma unroll
            for (int q = 0; q < 4; ++q) *(LAS f32x4*)(FACC + wave * DM + 16 * lane + 1024 * k + 4 * q) = (f32x4){acc[8 * k + 2 * q].x, acc[8 * k + 2 * q].y, acc[8 * k + 2 * q + 1].x, acc[8 * k + 2 * q + 1].y};
        __syncthreads();
        f32x4 y = ((const f32x4*)(X1F + (size_t)m * DM))[tid] * DN_ALPHA;
#pragma unroll
        for (int w = 0; w < 8; ++w) y = y + *(const LAS f32x4*)(FACC + w * DM + 4 * tid);
        float s = wave_sum((y[0] + y[1]) + (y[2] + y[3]));
        if (lane == 0) RED[wave] = s;
        __syncthreads();
        float tot = 0.f;
#pragma unroll
        for (int w = 0; w < 8; ++w) tot += RED[w];
        const float mean = tot * (1.f / DM);
        y = y - mean;
        float s2 = wave_sum((y[0] * y[0] + y[1] * y[1]) + (y[2] * y[2] + y[3] * y[3]));
        if (lane == 0) RED[8 + wave] = s2;
        __syncthreads();
        float tot2 = 0.f;
#pragma unroll
        for (int w = 0; w < 8; ++w) tot2 += RED[8 + w];
        const float rstd = 1.f / sqrtf(tot2 * (1.f / DM) + LN_EPS);
        const f32x4 o = y * rstd * ((const f32x4*)gw)[tid] + ((const f32x4*)bw)[tid];
        if (l == 0) { ((f32x4*)(wsp<float>(C, WS_XF1) + (size_t)m * DM))[tid] = o;
            v2u p; p.x = pk2(o[0], o[1]); p.y = pk2(o[2], o[3]); ((v2u*)(wsp<bf16>(C, WS_XB) + (size_t)m * DM))[tid] = p; }
        else { float* dst = m < NTP ? C.out + O_YP + (size_t)m * DM : C.out + O_YS + (size_t)(m - NTP) * DM; ((f32x4*)dst)[tid] = o; }
    }
    __syncthreads();
}

#ifndef PH_MASK
#define PH_MASK 0xFF
#endif
#define IN(k) (lo <= (k) && (k) < hi)
#define EN(s) ((PH_MASK >> (s)) & 1)
#define FRESH(CX) Ctx CX = C; { CX.ws = launder_g(CX.ws); CX.out = launder_g(CX.out); int t_ = CX.tid; asm volatile("" : "+v"(t_)); CX.tid = t_; CX.lane = t_ & 63; CX.wave = __builtin_amdgcn_readfirstlane(t_ >> 6); CX.ctl = (unsigned*)(CX.ws + WS_CTL); }
#ifndef PROBE_REP
#define PROBE_REP 0
#endif
#ifndef PROBE_CMASK
#define PROBE_CMASK 7
#endif
#define NREP(s) (((PROBE_REP >> (s)) & 1) ? 2 : 1)
#define REPBAR(s, rep) do { if (NREP(s) == 2 && (rep) == 0 && (hi - lo) > 1) xcd_barrier(bar); } while (0)
#define SEAM(k) do { if (IN(k) && IN((k) + 1)) xcd_barrier(bar); } while (0)
template <int l> DI void run_layer(const Ctx& C, const XcdBarrier& bar, int lo, int hi) {
        const int pb = 1 + 7 * l;
        _Pragma("unroll") for (int rep = 0; rep < NREP(0); ++rep) if (EN(0) && IN(pb + 0)) {
            FRESH(K);
            pg8::Gemm g{wsp<bf16>(K, WS_XB), wsp<bf16>(K, WS_WIN) + (size_t)l * PLD * DM, MP, PLD, DM}; pg8::StaticOrder S; S.init(MP, PLD, K.G, (int)blockIdx.x);
            EpiInProj E{wsp<bf16>(K, WS_PROJ), K.out, l};
            pg8::gemm_phase<EpiInProj, pg8::StaticOrder, true, true>(K.lds, g, S, E);
            REPBAR(0, rep);
        }
        SEAM(pb + 0);
        _Pragma("unroll") for (int rep = 0; rep < NREP(1); ++rep) if (EN(1) && IN(pb + 1)) { FRESH(K); phase_b(K, l); REPBAR(1, rep); }
        SEAM(pb + 1);
        _Pragma("unroll") for (int rep = 0; rep < NREP(2); ++rep) if (EN(2) && IN(pb + 2)) { FRESH(K); phase_c(K, l + 2 * rep, rep == 0 ? PROBE_CMASK : 7); REPBAR(2, rep); }
        SEAM(pb + 2);
        _Pragma("unroll") for (int rep = 0; rep < NREP(3); ++rep) if (EN(3) && IN(pb + 3)) {
            FRESH(K);
            pg8::Gemm g{wsp<bf16>(K, WS_MIX), wsp<bf16>(K, WS_WOUT) + (size_t)l * DM * DM, MP, DM, DM}; pg8::StaticOrder S; S.init(MP, DM, K.G, (int)blockIdx.x);
            pg8::EpiF32 E{wsp<float>(K, WS_HS), DM, nullptr};
            pg8::gemm_phase<pg8::EpiF32, pg8::StaticOrder, true, true>(K.lds, g, S, E);
            REPBAR(3, rep);
        }
        SEAM(pb + 3);
        _Pragma("unroll") for (int rep = 0; rep < NREP(4); ++rep) if (EN(4) && IN(pb + 4)) { FRESH(K); phase_e(K, l); REPBAR(4, rep); }
        SEAM(pb + 4);
        _Pragma("unroll") for (int rep = 0; rep < NREP(5); ++rep) if (EN(5) && IN(pb + 5)) {
            FRESH(K);
            pg8::Gemm g{wsp<bf16>(K, WS_X1B), wsp<bf16>(K, WS_W2) + (size_t)l * DM * DM, MP, DM, DM}; pg8::StaticOrder S; S.init(MP, DM, K.G, (int)blockIdx.x);
            pg8::EpiF32 E{wsp<float>(K, WS_HS), DM, nullptr};
            pg8::gemm_phase<pg8::EpiF32, pg8::StaticOrder, true, true>(K.lds, g, S, E);
            REPBAR(5, rep);
        }
        SEAM(pb + 5);
        _Pragma("unroll") for (int rep = 0; rep < NREP(6); ++rep) if (EN(6) && IN(pb + 6)) { FRESH(K); phase_g(K, l); REPBAR(6, rep); }
        SEAM(pb + 6);
}
typedef ArgsK Args;
__global__ void __launch_bounds__(NTHREADS, 2) fwd_kernel(Args args) {
    extern __shared__ __attribute__((aligned(16))) unsigned char lds[];
    Ctx C;
    C.out = args.out; C.ws = args.ws; C.lds = (LAS unsigned char*)lds; C.ctl = (unsigned*)(args.ws + WS_CTL);
    C.tid = threadIdx.x; C.lane = C.tid & 63; C.wave = __builtin_amdgcn_readfirstlane(C.tid >> 6); C.G = gridDim.x;
    volatile LAS unsigned* MISC = (volatile LAS unsigned*)(C.lds + MISC_OFF);
    for (int u = C.tid; u < (LDS_BYTES - RING_BYTES) / 4; u += NTHREADS) ((LAS unsigned*)(C.lds + RING_BYTES))[u] = 0u;
    __syncthreads();
    XcdBarrier bar; bar.bar = C.ctl + CW_BAR; bar.x = 0; bar.st = nullptr;
    if (args.use_bar) bar = xcd_barrier_post(C.ctl + CW_BAR, MISC + 8);
    const int lo = args.ph_lo, hi = args.ph_hi;
    _Pragma("unroll") for (int rep = 0; rep < NREP(7); ++rep) if (EN(7) && IN(0)) { FRESH(K); p0_prologue(K); REPBAR(7, rep); }
    SEAM(0);
    run_layer<0>(C, bar, lo, hi);
    run_layer<1>(C, bar, lo, hi);
#undef IN
#undef SEAM
}

#ifndef MK_ONE_LAUNCH
#define MK_ONE_LAUNCH 1
#endif
extern "C" void kernel_launch(void* const* d_in, const int* in_sizes, int n_in, void* d_out, int out_size, void* d_ws, size_t ws_size, hipStream_t stream) {
    static int grid = 0;
    if (grid == 0) {
        if (n_in != 30 || out_size != (int)O_END || ws_size < WS_END) { fprintf(stderr, "kernel_launch: unexpected shapes (n_in %d, out %d, ws %zu < %zu); nothing launched\n", n_in, out_size, ws_size, (size_t)WS_END); grid = -1; return; }
        int dev = 0, cus = 0, per_cu = 0;
        if (hipGetDevice(&dev) != hipSuccess || hipDeviceGetAttribute(&cus, hipDeviceAttributeMultiprocessorCount, dev) != hipSuccess) { grid = -1; return; }
        if (hipFuncSetAttribute((const void*)fwd_kernel, hipFuncAttributeMaxDynamicSharedMemorySize, LDS_BYTES) != hipSuccess) { fprintf(stderr, "kernel_launch: hipFuncSetAttribute failed\n"); grid = -1; return; }
        if (hipOccupancyMaxActiveBlocksPerMultiprocessor(&per_cu, (const void*)fwd_kernel, NTHREADS, LDS_BYTES) != hipSuccess || per_cu < 1) { fprintf(stderr, "kernel_launch: occupancy query says %d blocks per CU\n", per_cu); }
        (void)hipGetLastError();
        grid = cus;
    }
    if (grid < 0) return;
    if (hipMemsetAsync((char*)d_ws + WS_CTL, 0, CTL_ZERO_BYTES, stream) != hipSuccess) return;
    Args a{};
    for (int i = 0; i < 30; ++i) a.in[i] = (const float*)d_in[i];
    a.out = (float*)d_out; a.ws = (unsigned char*)d_ws;
#if MK_ONE_LAUNCH
    a.ph_lo = 0; a.ph_hi = N_PHASES; a.use_bar = 1;
    hipLaunchKernelGGL(fwd_kernel, dim3(grid), dim3(NTHREADS), LDS_BYTES, stream, a);
#else
    for (int p = 0; p < N_PHASES; ++p) { a.ph_lo = p; a.ph_hi = p + 1; a.use_bar = 0; hipLaunchKernelGGL(fwd_kernel, dim3(grid), dim3(NTHREADS), LDS_BYTES, stream, a); }
#endif
}
```

```cpp
#include <hip/hip_runtime.h>
#include <cstdio>
#include <cstdint>
namespace pg8 {
#define PG8_LAS __attribute__((address_space(3)))
typedef unsigned short bf16_t;
typedef short bf16x8 __attribute__((ext_vector_type(8)));
typedef float f32x4 __attribute__((ext_vector_type(4)));
typedef unsigned u32x4 __attribute__((ext_vector_type(4)));
constexpr int BM = 256, BK = 64, HALF = 128, HTB = HALF * BK * 2  , STAGE_BYTES = 8 * HTB, NXCD = 8, WGM = 8;

__host__ __device__ __forceinline__ int lds_byte(int r, int c) { const int st = (r >> 4) * 2 + (c >> 5), rr = r & 15, cc = c & 31, ob = rr * 64 + cc * 2; return st * 1024 + (ob ^ (((ob >> 9) & 1) << 5)); }
__host__ __device__ __forceinline__ void stage_rc(int b, int& R, int& C) { const int st = b / 1024, sb = b % 1024, swz = sb ^ (((sb >> 9) & 1) << 5); R = (st >> 1) * 16 + swz / 64; C = (st & 1) * 32 + (swz % 64) / 2; }
__host__ __device__ __forceinline__ int perm32(int rho) { const int n = rho >> 4, i = rho & 15; return 8 * (i >> 2) + 4 * n + (i & 3); }

struct Unit { int pm, pn; };
struct Gemm { const bf16_t* A; const bf16_t* Bt; int M, N, K; };

struct StaticOrder {
    int nM, nN, nwg, G, c;
    __host__ __device__ void init(int M, int N, int G_, int c_) { nM = M / BM; nN = N / BM; nwg = nM * nN; G = G_; c = c_; }
    __host__ __device__ bool next(int i, Unit& u) const {
        const long L = (long)i * G + c; if (L >= nwg) return false;
        int wgid = (int)L; { const int q = nwg / NXCD, r = nwg % NXCD, xcd = wgid % NXCD, off = wgid / NXCD; wgid = (xcd < r ? xcd * (q + 1) : r * (q + 1) + (xcd - r) * q) + off; }
        const int nig = WGM * nN, gid = wgid / nig, fm = gid * WGM, gsz = (nM - fm) < WGM ? (nM - fm) : WGM;
        u.pm = fm + ((wgid % nig) % gsz); u.pn = (wgid % nig) / gsz; return true;
    }
    __device__ __forceinline__ void a_ready(const Unit&) const {}
    __device__ __forceinline__ void done(const Unit&) const {}
};

__device__ __forceinline__ unsigned cvt_pk_bf16(float lo, float hi) { unsigned r; asm volatile("v_cvt_pk_bf16_f32 %0, %1, %2" : "=v"(r) : "v"(lo), "v"(hi)); return r; }
typedef float f32x2 __attribute__((ext_vector_type(2)));
struct EpiF32 {
    static constexpr bool PERM = false, AFTER_DRAIN = false;
    float* C; int ldc; const float* bias;
    __device__ __forceinline__ void operator()(const f32x4 (&acc)[2][2][4][2], const Unit& u, int wr, int wc, int fr, int fq) const {
        const int row0 = u.pm * BM + wr * 64 + fr, col0 = u.pn * BM + wc * 32 + 4 * fq;
        f32x4 bv[2][2];
#pragma unroll
        for (int bj = 0; bj < 2; ++bj)
#pragma unroll
            for (int n = 0; n < 2; ++n) bv[bj][n] = bias ? *(const f32x4*)(bias + col0 + bj * HALF + n * 16) : (f32x4){0.f, 0.f, 0.f, 0.f};
#pragma unroll
        for (int ai = 0; ai < 2; ++ai)
#pragma unroll
            for (int m = 0; m < 4; ++m) { float* rowp = C + (size_t)(row0 + ai * HALF + m * 16) * ldc + col0;
#pragma unroll
                for (int bj = 0; bj < 2; ++bj)
#pragma unroll
                    for (int n = 0; n < 2; ++n) *(f32x4*)(rowp + bj * HALF + n * 16) = acc[ai][bj][m][n] + bv[bj][n]; }
    }
};
template <class Epi, class Sched, bool ALIGN_EPI = false, bool SP2 = false>
__device__ __forceinline__ void gemm_phase(PG8_LAS unsigned char* lds, const Gemm g, const Sched& S, const Epi& E) {
    const int tid = threadIdx.x, wid = __builtin_amdgcn_readfirstlane(tid >> 6), lane = tid & 63, wr = wid >> 2, wc = wid & 3, fr = lane & 15, fq = lane >> 4;
    const int K = g.K, nt = K / BK;
    unsigned voffA[2], voffB[2];
#pragma unroll
    for (int i = 0; i < 2; ++i) { int R, C; stage_rc(tid * 16 + i * 8192, R, C); const int Rb = Epi::PERM ? ((R & ~31) + perm32(R & 31)) : R;
        voffA[i] = (unsigned)(R * K + C) * 2u; voffB[i] = (unsigned)(Rb * K + C) * 2u; }
    const size_t kstep = (size_t)(BK * 2);
    const size_t hstep = (size_t)HALF * K * 2;
    const size_t tstep = 2 * hstep;
    const unsigned ldsw = (unsigned)wid * 1024u;
    const int aoff = lds_byte(wr * 64 + fr, fq * 8), boff = lds_byte(wc * 32 + fr, fq * 8);
#define PG8_SA(b, h) (((b) * 2 + (h)) * HTB)
#define PG8_SB(b, h) ((4 + (b) * 2 + (h)) * HTB)
#define PG8_STAGE(bufoff, gbase, voff) do { _Pragma("unroll") for (int _i = 0; _i < 2; ++_i) \
        __builtin_amdgcn_global_load_lds((const unsigned*)((const char*)(gbase) + (voff)[_i]), (PG8_LAS unsigned*)(lds + (bufoff) + ldsw + _i * 8192), 16, 0, 0); } while (0)
#define PG8_LDA(dst, b, h) do { _Pragma("unroll") for (int m = 0; m < 4; ++m) _Pragma("unroll") for (int k = 0; k < 2; ++k) dst[m][k] = *(const PG8_LAS bf16x8*)(lds + PG8_SA(b, h) + aoff + m * 2048 + k * 1024); } while (0)
#define PG8_LDB(dst, b, h) do { _Pragma("unroll") for (int n = 0; n < 2; ++n) _Pragma("unroll") for (int k = 0; k < 2; ++k) dst[n][k] = *(const PG8_LAS bf16x8*)(lds + PG8_SB(b, h) + boff + n * 2048 + k * 1024); } while (0)
#define PG8_MMA(ai, bj, At, Bt) do { __builtin_amdgcn_s_setprio(1); _Pragma("unroll") for (int m = 0; m < 4; ++m) _Pragma("unroll") for (int n = 0; n < 2; ++n) _Pragma("unroll") for (int k = 0; k < 2; ++k) \
        acc[ai][bj][m][n] = __builtin_amdgcn_mfma_f32_16x16x32_bf16(Bt[n][k], At[m][k], acc[ai][bj][m][n], 0, 0, 0); __builtin_amdgcn_s_setprio(0); } while (0)
#define PG8_WAIT_V(n) asm volatile("s_waitcnt vmcnt(" #n ")" ::: "memory")
#define PG8_WAIT_L(n) asm volatile("s_waitcnt lgkmcnt(" #n ")" ::: "memory")
#define PG8_BAR __builtin_amdgcn_s_barrier()
#define PG8_SCHED __builtin_amdgcn_sched_barrier(0)
    Unit cur, nxt; int ui = 0;
    if (!S.next(0, cur)) return;
    f32x4 acc[2][2][4][2];
#pragma unroll
    for (int a = 0; a < 2; ++a)
#pragma unroll
        for (int b = 0; b < 2; ++b)
#pragma unroll
            for (int m = 0; m < 4; ++m)
#pragma unroll
                for (int n = 0; n < 2; ++n) acc[a][b][m][n] = (f32x4){0.f, 0.f, 0.f, 0.f};
    bf16x8 At[4][2], B0[2][2], B1[2][2];
    const char* cA = (const char*)g.A + (size_t)cur.pm * tstep; const char* cB = (const char*)g.Bt + (size_t)cur.pn * tstep;
    S.a_ready(cur);
    if constexpr (SP2) {
        PG8_STAGE(PG8_SB(0, 0), cB, voffB); PG8_STAGE(PG8_SB(0, 1), cB + hstep, voffB); PG8_STAGE(PG8_SA(0, 0), cA, voffA); PG8_STAGE(PG8_SA(0, 1), cA + hstep, voffA);
        if (wr == 1) PG8_BAR;
        PG8_WAIT_V(2); PG8_BAR;
        PG8_STAGE(PG8_SB(1, 0), cB + kstep, voffB); PG8_STAGE(PG8_SA(1, 0), cA + kstep, voffA); PG8_STAGE(PG8_SB(1, 1), cB + hstep + kstep, voffB);
        PG8_WAIT_V(6); PG8_BAR;
    } else {
        PG8_STAGE(PG8_SB(0, 0), cB, voffB); PG8_STAGE(PG8_SA(0, 0), cA, voffA); PG8_STAGE(PG8_SB(0, 1), cB + hstep, voffB); PG8_STAGE(PG8_SA(0, 1), cA + hstep, voffA);
        if (wr == 1) PG8_BAR;
        PG8_WAIT_V(4); PG8_BAR;
        PG8_STAGE(PG8_SB(1, 0), cB + kstep, voffB); PG8_STAGE(PG8_SA(1, 0), cA + kstep, voffA); PG8_STAGE(PG8_SB(1, 1), cB + hstep + kstep, voffB);
        PG8_WAIT_V(6); PG8_BAR;
    }
    for (;;) {
        const bool has_next = S.next(ui + 1, nxt);
        const char* nA = has_next ? (const char*)g.A + (size_t)nxt.pm * tstep : cA; const char* nB = has_next ? (const char*)g.Bt + (size_t)nxt.pn * tstep : cB;
        for (int t = 0; t < nt; t += 2) {
            const bool last = (t == nt - 2);
            const char* a1 = cA + (size_t)(t + 1) * kstep;
            const char* a2 = last ? nA : cA + (size_t)(t + 2) * kstep; const char* b2 = last ? nB : cB + (size_t)(t + 2) * kstep;
            const char* a3 = a2 + kstep; const char* b3 = b2 + kstep;
            if (last && has_next) S.a_ready(nxt);
            if constexpr (SP2) {
            PG8_LDB(B0, 0, 0); PG8_LDB(B1, 0, 1); PG8_SCHED; PG8_LDA(At, 0, 0); PG8_STAGE(PG8_SA(1, 1), a1 + hstep, voffA);
            PG8_WAIT_V(8); PG8_WAIT_L(0); PG8_BAR; PG8_MMA(0, 0, At, B0); PG8_MMA(0, 1, At, B1); PG8_BAR; PG8_SCHED;
            PG8_LDA(At, 0, 1); PG8_STAGE(PG8_SB(0, 0), b2, voffB); PG8_STAGE(PG8_SB(0, 1), b2 + hstep, voffB); PG8_STAGE(PG8_SA(0, 0), a2, voffA);
            PG8_WAIT_V(8); PG8_WAIT_L(0); PG8_BAR; PG8_MMA(1, 0, At, B0); PG8_MMA(1, 1, At, B1); PG8_BAR; PG8_SCHED;
            PG8_LDB(B0, 1, 0); PG8_LDB(B1, 1, 1); PG8_SCHED; PG8_LDA(At, 1, 0); PG8_STAGE(PG8_SA(0, 1), a2 + hstep, voffA);
            PG8_WAIT_V(8); PG8_WAIT_L(0); PG8_BAR; PG8_MMA(0, 0, At, B0); PG8_MMA(0, 1, At, B1); PG8_BAR; PG8_SCHED;
            PG8_LDA(At, 1, 1); PG8_STAGE(PG8_SB(1, 0), b3, voffB); PG8_STAGE(PG8_SB(1, 1), b3 + hstep, voffB); PG8_STAGE(PG8_SA(1, 0), a3, voffA);
            PG8_WAIT_V(8); PG8_WAIT_L(0); PG8_BAR; PG8_MMA(1, 0, At, B0); PG8_MMA(1, 1, At, B1); PG8_BAR; PG8_SCHED;
            } else {
            PG8_LDB(B0, 0, 0); PG8_SCHED; PG8_LDA(At, 0, 0); PG8_STAGE(PG8_SA(1, 1), a1 + hstep, voffA);
            PG8_WAIT_L(8); PG8_BAR; PG8_WAIT_L(0); PG8_MMA(0, 0, At, B0); PG8_BAR; PG8_SCHED;
            PG8_LDB(B1, 0, 1); PG8_STAGE(PG8_SB(0, 0), b2, voffB);
            PG8_BAR; PG8_WAIT_L(0); PG8_MMA(0, 1, At, B1); PG8_BAR;
            PG8_LDA(At, 0, 1); PG8_STAGE(PG8_SA(0, 0), a2, voffA);
            PG8_BAR; PG8_WAIT_L(0); PG8_MMA(1, 0, At, B0); PG8_BAR; PG8_SCHED;
            PG8_STAGE(PG8_SB(0, 1), b2 + hstep, voffB);
            PG8_WAIT_V(6); PG8_BAR; PG8_MMA(1, 1, At, B1); PG8_BAR;
            PG8_LDB(B0, 1, 0); PG8_SCHED; PG8_LDA(At, 1, 0); PG8_STAGE(PG8_SA(0, 1), a2 + hstep, voffA);
            PG8_WAIT_L(8); PG8_BAR; PG8_WAIT_L(0); PG8_MMA(0, 0, At, B0); PG8_BAR; PG8_SCHED;
            PG8_LDB(B1, 1, 1); PG8_STAGE(PG8_SB(1, 0), b3, voffB);
            PG8_BAR; PG8_WAIT_L(0); PG8_MMA(0, 1, At, B1); PG8_BAR;
            PG8_LDA(At, 1, 1); PG8_STAGE(PG8_SA(1, 0), a3, voffA);
            PG8_BAR; PG8_WAIT_L(0); PG8_MMA(1, 0, At, B0); PG8_BAR; PG8_SCHED;
            PG8_STAGE(PG8_SB(1, 1), b3 + hstep, voffB);
            PG8_WAIT_V(6); PG8_BAR; PG8_MMA(1, 1, At, B1); PG8_BAR;
            }
        }
        if constexpr (ALIGN_EPI) { if (wr == 0) PG8_BAR; }
        if constexpr (!Epi::AFTER_DRAIN) { E(acc, cur, wr, wc, fr, fq); S.done(cur); }
        if (!has_next) break;
#pragma unroll
        for (int a = 0; a < 2; ++a)
#pragma unroll
            for (int b = 0; b < 2; ++b)
#pragma unroll
                for (int m = 0; m < 4; ++m)
#pragma unroll
                    for (int n = 0; n < 2; ++n) acc[a][b][m][n] = (f32x4){0.f, 0.f, 0.f, 0.f};
        cur = nxt; cA = nA; cB = nB; ++ui;
        if constexpr (ALIGN_EPI) { if (wr == 1) PG8_BAR; }
    }
    PG8_WAIT_V(0);
    if constexpr (!ALIGN_EPI) { if (wr == 0) PG8_BAR; }
    PG8_BAR;
    if constexpr (Epi::AFTER_DRAIN) { E.fused(acc, cur, wr, wc, fr, fq, lds, wid, lane); S.done(cur); }
#undef PG8_SA
#undef PG8_SB
#undef PG8_STAGE
#undef PG8_LDA
#undef PG8_LDB
#undef PG8_MMA
#undef PG8_WAIT_V
#undef PG8_WAIT_L
#undef PG8_BAR
#undef PG8_SCHED
}
}
#define LAS __attribute__((address_space(3)))
#define XB_TMO      128
#define XB_XCNT(j)  (256  + 64 * (j))
#define XB_XSUB(j)  (1280 + 64 * (j))
#define XB_XGEN(j)  (2304 + 64 * (j))
#define XB_TOP      3328
#define XB_TOPGEN   3392
#define XCD_BAR_WORDS 3456
#define XB_SPIN_CAP (1u << 18)

__device__ __forceinline__ unsigned xb_ld(unsigned* p)              { return __hip_atomic_load(p, __ATOMIC_RELAXED, __HIP_MEMORY_SCOPE_AGENT); }
__device__ __forceinline__ unsigned xb_add(unsigned* p, unsigned v) { return __hip_atomic_fetch_add(p, v, __ATOMIC_RELAXED, __HIP_MEMORY_SCOPE_AGENT); }
__device__ __forceinline__ unsigned xb_xcc_id() { return (unsigned)__builtin_amdgcn_s_getreg((3 << 11) | 20) & 0xFu; }
#define XB_SPIN(cond, bar) do { unsigned _sp = 0; while (cond) { __builtin_amdgcn_s_sleep(1); \
    if ((++_sp & 255u) == 0u) { if (xb_ld(&(bar)[XB_TMO])) break; if (_sp > XB_SPIN_CAP) { atomicAdd(&(bar)[XB_TMO], 1u); break; } } } } while (0)

struct XcdBarrier {
    unsigned* bar; unsigned x;
    volatile LAS unsigned* st;
};

__device__ __forceinline__ XcdBarrier xcd_barrier_post(unsigned* bar, volatile LAS unsigned* st) {
    XcdBarrier b; b.bar = bar; b.x = xb_xcc_id(); b.st = st;
    if (threadIdx.x == 0) (void)xb_add(&bar[XB_XCNT(b.x)], 1u);
    return b;
}
__device__ __forceinline__ void xcd_barrier_complete(unsigned* bar, unsigned x, unsigned& nloc, unsigned& nx) {
    const unsigned G = gridDim.x * gridDim.y * gridDim.z;
    unsigned sum, cnt, mine, sp = 0u;
    for (;;) {
        sum = 0u; cnt = 0u; mine = 0u;
#pragma unroll
        for (unsigned j = 0; j < 16; ++j) { const unsigned c = xb_ld(&bar[XB_XCNT(j)]); sum += c; cnt += (c > 0u) ? 1u : 0u; mine = (j == x) ? c : mine; }
        if (sum == G) break;
        __builtin_amdgcn_s_sleep(1);
        if ((++sp & 255u) == 0u) { if (xb_ld(&bar[XB_TMO])) break; if (sp > XB_SPIN_CAP) { atomicAdd(&bar[XB_TMO], 1u); break; } }
    }
    nloc = mine > 0u ? mine : 1u; nx = cnt > 0u ? cnt : 1u;
}

__device__ __forceinline__ void xcd_barrier(const XcdBarrier& b) {
    asm volatile("s_waitcnt vmcnt(0)" ::: "memory");
    __syncthreads();
    if (threadIdx.x == 0) {
        unsigned* bar = b.bar;
        __builtin_amdgcn_s_waitcnt(0);
        unsigned nloc = b.st[0], nx = b.st[1];
        if (nloc == 0u) { xcd_barrier_complete(bar, b.x, nloc, nx); b.st[0] = nloc; b.st[1] = nx; }
        const unsigned old = xb_add(&bar[XB_XSUB(b.x)], 1u);
        const unsigned gen = old / nloc;
        if (old + 1u == (gen + 1u) * nloc) {
            __builtin_amdgcn_fence(__ATOMIC_RELEASE, "agent");
            asm volatile("s_waitcnt vmcnt(0)" ::: "memory");
            const unsigned og = xb_add(&bar[XB_TOP], 1u);
            const unsigned tg = og / nx;
            if (og + 1u == (tg + 1u) * nx) xb_add(&bar[XB_TOPGEN], 1u);
            else XB_SPIN(xb_ld(&bar[XB_TOPGEN]) == tg, bar);
            __builtin_amdgcn_fence(__ATOMIC_ACQUIRE, "agent");
            xb_add(&bar[XB_XGEN(b.x)], 1u);
            asm volatile("s_waitcnt vmcnt(0)" ::: "memory");
        } else {
            XB_SPIN(xb_ld(&bar[XB_XGEN(b.x)]) == gen, bar);
            __builtin_amdgcn_fence(__ATOMIC_ACQUIRE, "agent");
            asm volatile("s_waitcnt vmcnt(0)" ::: "memory");
        }
    }
    __syncthreads();
}

constexpr int NWAVES = 8, NTHREADS = 512;
constexpr int DM = 2048, NTP = 8192, NTS = 32, NT = 8224, MP = 8448;
constexpr int RW_COLS = 3360, Q_OFF = 3360, KC_OFF = 4384, KS_OFF = 4896, VS_OFF = 5152, KW_OFF = 5408, VW_OFF = 5664, GL_OFF = 5920, IN_COLS = 5968, PLD = 6144;
constexpr int NEXP = 16384, NPOOL = 1280;
constexpr float LN_EPS = 1e-5f, GN_EPS = 64e-5f, DN_ALPHA = 1.4142135623730951f;
constexpr float NEG_BIG = -1e30f;
constexpr size_t O_YP = 0, O_YS = O_YP + (size_t)NTP * DM, O_CMP_P = O_YS + (size_t)NTS * DM, O_SEL_P = O_CMP_P + (size_t)2 * NTP * 512, O_WIN_P = O_SEL_P + (size_t)2 * NTP * 512,
                 O_RW_P = O_WIN_P + (size_t)2 * 4 * 512 * 512, O_SH_P = O_RW_P + (size_t)2 * 4 * 16 * 4096, O_CMP_S = O_SH_P + (size_t)2 * 4 * RW_COLS, O_SEL_S = O_CMP_S + (size_t)2 * NTS * 512,
                 O_WIN_S = O_SEL_S + (size_t)2 * NTS * 512, O_RW_S = O_WIN_S + (size_t)2 * 8 * 512 * 512, O_SH_S = O_RW_S + (size_t)2 * 8 * 16 * 4096, O_END = O_SH_S + (size_t)2 * 8 * RW_COLS;
static_assert(O_END == 41630464, "output size");
constexpr size_t MiB = 1ull << 20;
constexpr size_t WS_CTL = 0, CTL_ZERO_BYTES = 1 * MiB;
constexpr size_t WS_WIN = 1 * MiB;
constexpr size_t WS_WOUT = WS_WIN + 48 * MiB;
constexpr size_t WS_W2 = WS_WOUT + 16 * MiB;
constexpr size_t WS_UB = WS_W2 + 16 * MiB;
constexpr size_t WS_VB = WS_UB + 64 * MiB;
constexpr size_t WS_USC = WS_VB + 64 * MiB;
constexpr size_t WS_XB = WS_USC + 1 * MiB;
constexpr size_t WS_X1B = WS_XB + 33 * MiB;
constexpr size_t WS_XF1 = WS_X1B + 33 * MiB;
constexpr size_t WS_X1F = WS_XF1 + 65 * MiB;
constexpr size_t WS_PROJ = WS_X1F + 65 * MiB;
constexpr size_t WS_SC = WS_PROJ + 99 * MiB;
constexpr size_t SC_STRIDE = 33 * MiB;
constexpr size_t WS_GG = WS_SC + 6 * SC_STRIDE;
constexpr size_t WS_BON = WS_GG + 33 * MiB;
constexpr size_t WS_MIX = WS_BON + 1 * MiB;
constexpr size_t WS_HS = WS_MIX + 33 * MiB;
constexpr size_t WS_KCB = WS_HS + 66 * MiB;
constexpr size_t WS_VCBT = WS_KCB + 512 * 1024;
constexpr size_t WS_VTS = WS_KCB + 1 * MiB;
constexpr size_t WS_VTW = WS_VTS + 4 * MiB;
constexpr size_t WS_KCBS = WS_VTW + 4 * MiB;
constexpr size_t WS_VCBS = WS_KCBS + 17 * MiB;
constexpr size_t WS_LT = WS_VCBS + 17 * MiB;
constexpr size_t WS_KSC = WS_LT + 2 * MiB;
constexpr size_t WS_KWC = WS_KSC + 4 * MiB;
constexpr size_t WS_OPS = WS_KWC + 4 * MiB;
constexpr size_t OPS_BYTES = 51200;
constexpr size_t WS_EL = WS_OPS + 80 * MiB;
constexpr size_t WS_GT = WS_EL + 3 * MiB;
constexpr size_t WS_PD = WS_GT + 5 * MiB;
constexpr size_t WS_WP = WS_PD + 65 * MiB;
constexpr size_t WS_FO = WS_WP + 5 * MiB;
constexpr size_t WS_X1Q = WS_FO + 65 * MiB;
constexpr size_t WS_XQS = WS_X1Q + 17 * MiB;
constexpr size_t WS_END = WS_XQS + 1 * MiB;
constexpr int CW_BAR = 4096, CW_QUEUE = 8192, CW_SQ = 65536, CW_FLAG = 16384;
constexpr int RING_BYTES = 131072, MISC_OFF = RING_BYTES + 320, LDS_BYTES = 147456;
constexpr int N_PHASES = 23;

typedef unsigned short bf16;
typedef unsigned v4u __attribute__((ext_vector_type(4)));
typedef unsigned v2u __attribute__((ext_vector_type(2)));
typedef float f32x4 __attribute__((ext_vector_type(4)));
typedef float f32x16 __attribute__((ext_vector_type(16)));
typedef short bf16x8 __attribute__((ext_vector_type(8)));
typedef float f32x2_t __attribute__((ext_vector_type(2)));
typedef __bf16 bf16x2_t __attribute__((ext_vector_type(2)));
#define LDS_WAIT() asm volatile("s_waitcnt lgkmcnt(0)" ::: "memory")
#define DI __device__ __forceinline__
#define GAS __attribute__((address_space(1)))
template <class T> DI T* launder_g(T* p) { GAS T* g = (GAS T*)p; asm volatile("" : "+s"(g)); return (T*)g; }

DI unsigned pk2(float lo, float hi) { f32x2_t v = {lo, hi}; bf16x2_t b = __builtin_convertvector(v, bf16x2_t); return __builtin_bit_cast(unsigned, b); }
DI float bf2f(unsigned short u) { return __builtin_bit_cast(float, (unsigned)u << 16); }
DI float bflo(unsigned u) { return __builtin_bit_cast(float, u << 16); }
DI float bfhi(unsigned u) { return __builtin_bit_cast(float, u & 0xffff0000u); }
template <int CTRL> DI float dppf(float v) { return __builtin_bit_cast(float, __builtin_amdgcn_update_dpp(0, __builtin_bit_cast(int, v), CTRL, 0xF, 0xF, false)); }
DI float rdlane(float v, int l) { return __builtin_bit_cast(float, __builtin_amdgcn_readlane(__builtin_bit_cast(int, v), l)); }
DI float wave_sum(float v) {
    v += dppf<0xB1>(v); v += dppf<0x4E>(v); v += dppf<0x141>(v); v += dppf<0x140>(v);
    return (rdlane(v, 0) + rdlane(v, 16)) + (rdlane(v, 32) + rdlane(v, 48));
}
DI float wave_max(float v) {
    v = fmaxf(v, dppf<0xB1>(v)); v = fmaxf(v, dppf<0x4E>(v)); v = fmaxf(v, dppf<0x141>(v)); v = fmaxf(v, dppf<0x140>(v));
    return fmaxf(fmaxf(rdlane(v, 0), rdlane(v, 16)), fmaxf(rdlane(v, 32), rdlane(v, 48)));
}
DI float sigmoidf_(float x) { return 1.f / (1.f + expf(-x)); }
DI int crow(int reg, int h) { return (reg & 3) + 8 * (reg >> 2) + 4 * h; }

struct ArgsK { const float* in[30]; float* out; unsigned char* ws; int ph_lo, ph_hi, use_bar, pad; };
struct ArgsG { const GAS float* in[30]; GAS float* out; GAS unsigned char* ws; int ph_lo, ph_hi, use_bar, pad; };
typedef __attribute__((address_space(4))) const ArgsG* kargp_t;
struct Ctx {
    float* out; unsigned char* ws;
    LAS unsigned char* lds; unsigned* ctl;
    int tid, lane, wave, G;
    DI const float* inp(int k) const { kargp_t p = (kargp_t)__builtin_amdgcn_kernarg_segment_ptr(); asm volatile("" : "+s"(p)); return (const float*)p->in[k]; }
};
template <class T> DI T* wsp(const Ctx& C, size_t off) { return (T*)(C.ws + off); }

struct EpiInProj {
    static constexpr bool PERM = true, AFTER_DRAIN = false;
    bf16* P; float* out; int l;
    DI void operator()(const pg8::f32x4 (&acc)[2][2][4][2], const pg8::Unit& u, int wr, int wc, int fr, int fq) const {
        const int row0 = u.pm * 256 + wr * 64 + fr, col0 = u.pn * 256 + wc * 32 + 8 * fq;
#pragma unroll
        for (int bj = 0; bj < 2; ++bj) {
            const int colb = __builtin_amdgcn_readfirstlane(u.pn * 256 + wc * 32 + bj * 128);
            const int col = col0 + bj * 128;
            const int kind = colb < RW_COLS ? 1 : ((colb >= KC_OFF && colb < GL_OFF) ? 2 : 0);
            const int reg = (colb - KC_OFF) >> 9, cc = (col - KC_OFF) & 511;
#pragma unroll
            for (int ai = 0; ai < 2; ++ai)
#pragma unroll
                for (int m = 0; m < 4; ++m) {
                    const int row = row0 + ai * 128 + m * 16;
                    const pg8::f32x4 v0 = acc[ai][bj][m][0], v1 = acc[ai][bj][m][1];
                    v4u w; w.x = pk2(v0[0], v0[1]); w.y = pk2(v0[2], v0[3]); w.z = pk2(v1[0], v1[1]); w.w = pk2(v1[2], v1[3]);
                    *(v4u*)(P + (size_t)row * PLD + col) = w;
                    if (kind == 0 || row >= NT) continue;
                    unsigned off = 0xffffffffu;
                    if (row < NTP) { const int b = row >> 11, t = row & 2047;
                        if (kind == 1) { if (t == 2047) off = (unsigned)(O_SH_P + (size_t)(l * 4 + b) * RW_COLS + col); }
                        else if (reg == 0) off = (unsigned)(O_CMP_P + ((size_t)l * NTP + row) * 512 + cc);
                        else if (reg == 1) off = (unsigned)(O_SEL_P + ((size_t)l * NTP + row) * 512 + cc);
                        else if (t >= 1536) off = (unsigned)(O_WIN_P + ((size_t)(l * 4 + b) * 512 + (t - 1536)) * 512 + cc);
                    } else { const int j = row - NTP, b = j >> 2, t = j & 3;
                        if (kind == 1) { if (t == 3) off = (unsigned)(O_SH_S + (size_t)(l * 8 + b) * RW_COLS + col); }
                        else if (reg == 0) off = (unsigned)(O_CMP_S + ((size_t)l * NTS + j) * 512 + cc);
                        else if (reg == 1) off = (unsigned)(O_SEL_S + ((size_t)l * NTS + j) * 512 + cc);
                        else off = (unsigned)(O_WIN_S + ((size_t)(l * 8 + b) * 512 + 508 + t) * 512 + cc);
                    }
                    if (off != 0xffffffffu) { *(pg8::f32x4*)(out + off) = v0; *(pg8::f32x4*)(out + off + 4) = v1; }
                }
        }
    }
};

struct EpiBf16Row {
    static constexpr bool PERM = true, AFTER_DRAIN = false;
    bf16* Cb; int ldc;
    DI void operator()(const pg8::f32x4 (&acc)[2][2][4][2], const pg8::Unit& u, int wr, int wc, int fr, int fq) const {
        const int row0 = u.pm * 256 + wr * 64 + fr, col0 = u.pn * 256 + wc * 32 + 8 * fq;
#pragma unroll
        for (int bj = 0; bj < 2; ++bj)
#pragma unroll
            for (int ai = 0; ai < 2; ++ai)
#pragma unroll
                for (int m = 0; m < 4; ++m) { const pg8::f32x4 v0 = acc[ai][bj][m][0], v1 = acc[ai][bj][m][1];
                    v4u w; w.x = pk2(v0[0], v0[1]); w.y = pk2(v0[2], v0[3]); w.z = pk2(v1[0], v1[1]); w.w = pk2(v1[2], v1[3]);
                    *(v4u*)(Cb + (size_t)(row0 + ai * 128 + m * 16) * ldc + col0 + bj * 128) = w; }
    }
};

template <class Sink> DI void skinny_gemm(const Ctx& C, const bf16* A, const bf16* Bt, int nslabs, const Sink& sink) {
    const int tid = C.tid, lane = C.lane, wave = C.wave, r = lane & 31, hi = lane >> 5;
    LAS float* PS = (LAS float*)C.lds;
    for (int it = blockIdx.x; it < nslabs; it += C.G) {
        const int n0 = it * 32, k0 = wave * 256;
        f32x16 acc;
#pragma unroll
        for (int i = 0; i < 16; ++i) acc[i] = 0.f;
        const bf16* ap = A + (size_t)r * DM + k0 + 8 * hi; const bf16* bp = Bt + (size_t)(n0 + r) * DM + k0 + 8 * hi;
#pragma unroll 8
        for (int s = 0; s < 16; ++s) { const bf16x8 af = *(const bf16x8*)(ap + 16 * s), bf = *(const bf16x8*)(bp + 16 * s); acc = __builtin_amdgcn_mfma_f32_32x32x16_bf16(af, bf, acc, 0, 0, 0); }
        __syncthreads();
#pragma unroll
        for (int i = 0; i < 16; ++i) PS[(wave * 32 + crow(i, hi)) * 33 + r] = acc[i];
        __syncthreads();
#pragma unroll
        for (int e = 0; e < 2; ++e) { const int o = tid * 2 + e, row = o >> 5, col = o & 31; float v = 0.f;
#pragma unroll
            for (int w = 0; w < 8; ++w) v += PS[(w * 32 + row) * 33 + col];
            sink(row, n0 + col, v); }
    }
    __syncthreads();
}

DI void transpose_item(const float* W, int K, int N, int Npad, bf16* WT, LAS float* scr, int item, int lane) {
    const int nblk = Npad / 32, kb = item / nblk, nb = item % nblk, k0 = 64 * kb, n0 = 32 * nb;
#pragma unroll 8
    for (int i = 0; i < 32; ++i) { const int kk = 2 * i + (lane >> 5), n = n0 + (lane & 31); scr[kk * 33 + (lane & 31)] = n < N ? W[(size_t)(k0 + kk) * N + n] : 0.f; }
    LDS_WAIT(); asm volatile("" ::: "memory");
    const int c = lane & 7;
#pragma unroll
    for (int j = 0; j < 4; ++j) { const int n = (lane >> 3) + 8 * j; const LAS float* s = scr + (8 * c) * 33 + n;
        v4u o; o.x = pk2(s[0 * 33], s[1 * 33]); o.y = pk2(s[2 * 33], s[3 * 33]); o.z = pk2(s[4 * 33], s[5 * 33]); o.w = pk2(s[6 * 33], s[7 * 33]);
        *(v4u*)(WT + (size_t)(n0 + n) * K + k0 + 8 * c) = o; }
    LDS_WAIT(); asm volatile("" ::: "memory");
}


DI void p0i_table(const Ctx& C, int r) {
    const int lane = C.lane, wave = C.wave;
    const int row = r * 8 + wave;
    const float* src = (row < 32768 ? C.inp(26) : C.inp(27)) + (size_t)(row & 32767) * DM;
    unsigned char* dst = C.ws + (row < 32768 ? WS_UB : WS_VB) + (size_t)((row >> 14) & 1) * NEXP * DM + (size_t)(row & 16383) * 128;
    f32x4 v[8]; float am = 0.f;
#pragma unroll
    for (int k = 0; k < 2; ++k)
#pragma unroll
        for (int q = 0; q < 4; ++q) { v[4 * k + q] = ((const f32x4*)src)[4 * lane + 256 * k + q];
            am = fmaxf(am, fmaxf(fmaxf(fabsf(v[4 * k + q][0]), fabsf(v[4 * k + q][1])), fmaxf(fabsf(v[4 * k + q][2]), fabsf(v[4 * k + q][3])))); }
    am = wave_max(am);
    const bool isu = row < 32768;
    const float sc = am > 0.f ? am * (isu ? 1.f / 127.f : 1.f / 256.f) : 1.f, inv = 1.f / sc;
#pragma unroll
    for (int k = 0; k < 2; ++k) { v4u o;
#pragma unroll
        for (int q = 0; q < 4; ++q) { const f32x4 x = v[4 * k + q] * inv;
            if (isu) o[q] = ((unsigned)(int)__builtin_rintf(x[0]) & 255u) | (((unsigned)(int)__builtin_rintf(x[1]) & 255u) << 8) | (((unsigned)(int)__builtin_rintf(x[2]) & 255u) << 16) | ((unsigned)(int)__builtin_rintf(x[3]) << 24);
            else { int p = __builtin_amdgcn_cvt_pk_fp8_f32(x[0], x[1], 0, false); p = __builtin_amdgcn_cvt_pk_fp8_f32(x[2], x[3], p, true); o[q] = (unsigned)p; } }
        *(v4u*)(dst + ((size_t)((lane >> 3) + 8 * k) * NEXP) * 128 + 16 * (lane & 7)) = o; }
    if (lane == 0) wsp<float>(C, WS_USC)[row] = sc;
}
DI void p0i_cache(const Ctx& C, int r) {
    const int tid = C.tid;
    const int l = r >> 10, b = (r >> 7) & 7, pi = r & 127;
    const int pid = ((const int*)C.inp(4))[b * 128 + pi];
    const int q = tid >> 7, c4 = tid & 127, kv = c4 >> 6, kvh = (c4 >> 4) & 3, d0 = (c4 & 15) * 4;
    const f32x4* src = (const f32x4*)(C.inp(2) + ((size_t)(l * NPOOL + pid) * 128 + 32 * q) * 512) + c4;
    const float* w = C.inp(20) + (l * 2 + kv) * 32;
    f32x4 acc = {0.f, 0.f, 0.f, 0.f};
#pragma unroll 16
    for (int rr = 0; rr < 32; ++rr) acc += src[(size_t)rr * 128] * w[rr];
    *(f32x4*)(wsp<float>(C, kv ? WS_VCBS : WS_KCBS) + ((size_t)((l * 8 + b) * 4 + kvh) * 512 + 4 * pi + q) * 64 + d0) = acc;
}
DI void p0i_transpose(const Ctx& C, int r) {
    const int lane = C.lane, wave = C.wave;
    const int l = r >> 10, w8 = (r & 1023) * 8 + wave;
    LAS float* scr = (LAS float*)(C.lds + wave * 16384);
    if (w8 < 6144) transpose_item(C.inp(8) + (size_t)l * DM * IN_COLS, DM, IN_COLS, PLD, wsp<bf16>(C, WS_WIN) + (size_t)l * PLD * DM, scr, w8, lane);
    else transpose_item(C.inp(21) + (size_t)l * DM * DM, DM, DM, DM, wsp<bf16>(C, WS_WOUT) + (size_t)l * DM * DM, scr, w8 - 6144, lane);
}
DI void p0i_w2(const Ctx& C, int r) {
    const int tid = C.tid;
    const int l = r >> 10, hc = (r >> 6) & 15, kb = r & 63;
    LAS float* SK = (LAS float*)C.lds;
    LAS float* WQ = (LAS float*)(C.lds + 128 * 129 * 4);
    __syncthreads();
    const float* sk = C.inp(25) + ((size_t)l * 16 + hc) * 16384;
    for (int i = tid; i < 16384; i += NTHREADS) SK[(i >> 7) * 129 + (i & 127)] = sk[i];
    const float* wq = C.inp(24) + (size_t)l * DM * DM + (size_t)(kb * 32) * DM + hc * 128;
    for (int i = tid; i < 4096; i += NTHREADS) WQ[i] = wq[(size_t)(i >> 7) * DM + (i & 127)];
    __syncthreads();
    const int k = tid & 127, rq = tid >> 7;
    float acc[8];
#pragma unroll
    for (int j = 0; j < 8; ++j) acc[j] = 0.f;
    for (int d = 0; d < 128; d += 4) {
        const float s0 = SK[k * 129 + d], s1 = SK[k * 129 + d + 1], s2 = SK[k * 129 + d + 2], s3 = SK[k * 129 + d + 3];
#pragma unroll
        for (int j = 0; j < 8; ++j) { const f32x4 w = *(const LAS f32x4*)(WQ + (rq * 8 + j) * 128 + d); acc[j] += s0 * w[0] + s1 * w[1] + s2 * w[2] + s3 * w[3]; }
    }
    v4u o; o.x = pk2(acc[0], acc[1]); o.y = pk2(acc[2], acc[3]); o.z = pk2(acc[4], acc[5]); o.w = pk2(acc[6], acc[7]);
    *(v4u*)(wsp<bf16>(C, WS_W2) + (size_t)l * DM * DM + (size_t)(hc * 128 + k) * DM + kb * 32 + rq * 8) = o;
}
constexpr int DEF_ITEMS = 8192 + 1024 + 1024 + 2048, DEF_GROUPS = DEF_ITEMS / 4;
DI void deferred_item(const Ctx& C, int i) {
    if (i < 8192) p0i_table(C, i);
    else if (i < 9216) p0i_cache(C, 1024 + (i - 8192));
    else if (i < 10240) p0i_transpose(C, 1024 + (i - 9216));
    else p0i_w2(C, i - 10240);
}

constexpr int P0_NX = 2056, P0_NWP = 508;
DI void p0_prologue(const Ctx& C, int pmask = 31) {
    const int tid = C.tid;
    LAS int* qslot = (LAS int*)(C.lds + MISC_OFF + 64);
#define P0_CLAIM 4
#define P0_BLOCK(n, qi) for (int base_ = 0; ; ) { __syncthreads(); if (tid == 0) *qslot = (int)atomicAdd(C.ctl + CW_QUEUE + 64 * (8 + (qi)), (unsigned)P0_CLAIM); __syncthreads(); base_ = *qslot; if (base_ >= (n)) break; \
        for (int r = base_, r_hi = (base_ + P0_CLAIM < (n) ? base_ + P0_CLAIM : (n)); r < r_hi; ++r)
#define P0_END }
    if (pmask & 4) P0_BLOCK(1024, 2) { p0i_transpose(C, r); } P0_END
    if (pmask & 16) P0_BLOCK(P0_NX, 4) {{
            const size_t e0 = (size_t)r * 8192 + tid * 16;
            const float* src = e0 < (size_t)NTP * DM ? C.inp(0) + e0 : C.inp(1) + (e0 - (size_t)NTP * DM);
            const f32x4* s4 = (const f32x4*)src;
            const f32x4 a = s4[0], b = s4[1], c = s4[2], d = s4[3];
            v4u o0, o1; o0.x = pk2(a[0], a[1]); o0.y = pk2(a[2], a[3]); o0.z = pk2(b[0], b[1]); o0.w = pk2(b[2], b[3]);
            o1.x = pk2(c[0], c[1]); o1.y = pk2(c[2], c[3]); o1.z = pk2(d[0], d[1]); o1.w = pk2(d[2], d[3]);
            v4u* d4 = (v4u*)(wsp<bf16>(C, WS_XB) + e0); d4[0] = o0; d4[1] = o1;
        }} P0_END
    if (pmask & 2) P0_BLOCK(1024, 1) { p0i_cache(C, r); } P0_END
    if (pmask & 4) P0_BLOCK(144, 6) {{
            const int g = r * 512 + tid, l = g / 36864, rem = g % 36864, c = rem / 36, kg = rem % 36;
            const float* src = kg < 8 ? C.inp(11) + ((size_t)l * 64 + kg * 8) * 1024 : (kg < 16 ? C.inp(13) + ((size_t)l * 64 + (kg - 8) * 8) * 1024 : C.inp(14) + ((size_t)l * 160 + (kg - 16) * 8) * 1024);
            float e[8];
#pragma unroll
            for (int q = 0; q < 8; ++q) e[q] = src[(size_t)q * 1024 + c];
            *(v4u*)(wsp<bf16>(C, WS_LT) + ((size_t)l * 1024 + c) * 288 + kg * 8) = (v4u){pk2(e[0], e[1]), pk2(e[2], e[3]), pk2(e[4], e[5]), pk2(e[6], e[7])};
        }} P0_END
    if (pmask & 16) P0_BLOCK(P0_NWP, 5) {{
            const size_t i0 = (size_t)r * 8192 + tid * 16;
            const size_t lb = i0 / 260096, rem = i0 % 260096;
            const f32x4* s4 = (const f32x4*)(C.inp(5) + lb * 262144 + 2048 + rem);
            f32x4* d4 = (f32x4*)(C.out + O_WIN_S + lb * 262144 + rem);
            const f32x4 a = s4[0], b = s4[1], c = s4[2], d = s4[3];
            d4[0] = a; d4[1] = b; d4[2] = c; d4[3] = d;
        }} P0_END
    __syncthreads();
}

constexpr int PB_NRW = 514, PB_NPOOL = 256, PB_NVT = 1024, PB_ITEMS = PB_NRW + PB_NPOOL + PB_NVT;
DI float softplusf_(float x) { return x > 20.f ? x : log1pf(expf(x)); }
DI float fexp_(float x) { return __expf(x); }
DI float fsoftplus_(float x) { return x > 20.f ? x : __logf(1.f + __expf(x)); }
DI float fsigmoid_(float x) { return __builtin_amdgcn_rcpf(1.f + __expf(-x)); }

constexpr int XSB_LD = 3088, ACTB_LD = 296;
DI void rwkv_pre_item(const Ctx& C, int l, int item) {
    const int tid = C.tid, lane = C.lane, wave = C.wave, n16 = lane & 15, rq = lane >> 4;
    LAS unsigned short* XSB = (LAS unsigned short*)C.lds;
    LAS unsigned short* ACTB = (LAS unsigned short*)(C.lds + 16 * XSB_LD * 2);
    const bf16* P = wsp<bf16>(C, WS_PROJ);
    const int m0 = item * 16;
    __syncthreads();
#pragma unroll 1
    for (int base = 0; base < 16 * 420; base += 4 * NTHREADS) {
        v4u cu[4], pu[4]; f32x4 mu0[4], mu1[4], sh0[4], sh1[4]; int jj_[4], col_[4], kind[4];
#pragma unroll
        for (int u = 0; u < 4; ++u) { const int idx = base + u * NTHREADS + tid; kind[u] = -1; jj_[u] = 0; col_[u] = 0;
            if (idx < 16 * 420) { const int j = idx / 420, col = (idx % 420) * 8, m = m0 + j; jj_[u] = j; col_[u] = col;
                cu[u] = *(const v4u*)(P + (size_t)m * PLD + col);
                const f32x4* mup = (const f32x4*)(C.inp(9) + (size_t)l * RW_COLS + col); mu0[u] = mup[0]; mu1[u] = mup[1];
                int t; const float* sh = nullptr;
                if (m < NTP) t = m & 2047; else { const int jq = m - NTP; t = jq & 3; sh = C.inp(7) + (size_t)(l * 8 + (jq >> 2)) * RW_COLS + col; }
                if (t > 0) { pu[u] = *(const v4u*)(P + (size_t)(m - 1) * PLD + col); kind[u] = 1; }
                else if (sh) { sh0[u] = ((const f32x4*)sh)[0]; sh1[u] = ((const f32x4*)sh)[1]; kind[u] = 2; }
                else kind[u] = 0; } }
#pragma unroll
        for (int u = 0; u < 4; ++u) if (kind[u] >= 0) {
            const int j = jj_[u], col = col_[u];
            float cur[8] = {bflo(cu[u].x), bfhi(cu[u].x), bflo(cu[u].y), bfhi(cu[u].y), bflo(cu[u].z), bfhi(cu[u].z), bflo(cu[u].w), bfhi(cu[u].w)};
            float prev[8];
            if (kind[u] == 1) { prev[0] = bflo(pu[u].x); prev[1] = bfhi(pu[u].x); prev[2] = bflo(pu[u].y); prev[3] = bfhi(pu[u].y); prev[4] = bflo(pu[u].z); prev[5] = bfhi(pu[u].z); prev[6] = bflo(pu[u].w); prev[7] = bfhi(pu[u].w); }
            else if (kind[u] == 2) {
#pragma unroll
                for (int e = 0; e < 4; ++e) { prev[e] = sh0[u][e]; prev[4 + e] = sh1[u][e]; } }
            else {
#pragma unroll
                for (int e = 0; e < 8; ++e) prev[e] = 0.f; }
            float xs[8];
#pragma unroll
            for (int e = 0; e < 4; ++e) { xs[e] = cur[e] + mu0[u][e] * (prev[e] - cur[e]); xs[4 + e] = cur[4 + e] + mu1[u][e] * (prev[4 + e] - cur[4 + e]); }
            if (col >= 3072) { const int a0 = col - 3072;
#pragma unroll
                for (int e = 0; e < 8; ++e) xs[e] = a0 < 64 ? tanhf(xs[e]) : (a0 < 128 ? xs[e] : fsigmoid_(xs[e]));
                *(LAS v4u*)(ACTB + j * ACTB_LD + a0) = (v4u){pk2(xs[0], xs[1]), pk2(xs[2], xs[3]), pk2(xs[4], xs[5]), pk2(xs[6], xs[7])};
            } else *(LAS v4u*)(XSB + j * XSB_LD + col) = (v4u){pk2(xs[0], xs[1]), pk2(xs[2], xs[3]), pk2(xs[4], xs[5]), pk2(xs[6], xs[7])};
        }
    }
    __syncthreads();
    float* SC = wsp<float>(C, WS_SC); constexpr size_t SS = SC_STRIDE / 4;
    float* GG = wsp<float>(C, WS_GG); float* BON = wsp<float>(C, WS_BON);
    const bf16* LT = wsp<bf16>(C, WS_LT) + (size_t)l * 1024 * 288;
    const f32x4 zf = {0.f, 0.f, 0.f, 0.f};
#pragma unroll 1
    for (int hh = 0; hh < 2; ++hh) {
        const int head = 2 * wave + hh;
        f32x4 aw[4], aa[4], ag[4];
#pragma unroll
        for (int t4 = 0; t4 < 4; ++t4) { aw[t4] = zf; aa[t4] = zf; ag[t4] = zf; }
#define LORA_STEPS(ACC, KS0, NKS) _Pragma("unroll 2") for (int ks = (KS0); ks < (KS0) + (NKS); ++ks) { \
            const bf16x8 af = *(const LAS bf16x8*)(ACTB + n16 * ACTB_LD + 32 * ks + 8 * rq); \
            _Pragma("unroll") for (int t4 = 0; t4 < 4; ++t4) { const bf16x8 bfr = *(const bf16x8*)(LT + (size_t)(head * 64 + 16 * t4 + n16) * 288 + 32 * ks + 8 * rq); \
                ACC[t4] = __builtin_amdgcn_mfma_f32_16x16x32_bf16(af, bfr, ACC[t4], 0, 0, 0); } }
        LORA_STEPS(aw, 0, 2) LORA_STEPS(aa, 2, 2) LORA_STEPS(ag, 4, 5)
#undef LORA_STEPS
        float w0v[4], a0v[4], kkv[4], kav[4], rkv[4];
#pragma unroll
        for (int t4 = 0; t4 < 4; ++t4) { const int c = l * 1024 + head * 64 + 16 * t4 + n16; w0v[t4] = C.inp(10)[c]; a0v[t4] = C.inp(12)[c]; kkv[t4] = C.inp(15)[c]; kav[t4] = C.inp(16)[c]; rkv[t4] = C.inp(17)[c]; }
#pragma unroll
        for (int i = 0; i < 4; ++i) {
            const int j = 4 * rq + i; const size_t m = (size_t)m0 + j;
            float kkr[4], km[4], a_[4], rr[4], vv[4], lw_[4]; float ss = 0.f, bs = 0.f;
#pragma unroll
            for (int t4 = 0; t4 < 4; ++t4) { const int cl = head * 64 + 16 * t4 + n16;
                const float z = w0v[t4] + aw[t4][i];
                const float w = -fsoftplus_(-z) - 0.5f;
                lw_[t4] = -fexp_(w);
                a_[t4] = fsigmoid_(a0v[t4] + aa[t4][i]);
                rr[t4] = bf2f(XSB[j * XSB_LD + cl]); const float k = bf2f(XSB[j * XSB_LD + 1024 + cl]); vv[t4] = bf2f(XSB[j * XSB_LD + 2048 + cl]);
                kkr[t4] = k * kkv[t4]; ss += kkr[t4] * kkr[t4];
                km[t4] = k * (1.f + (a_[t4] - 1.f) * kav[t4]); bs += rr[t4] * km[t4] * rkv[t4]; }
            ss += dppf<0xB1>(ss); ss += dppf<0x4E>(ss); ss += dppf<0x141>(ss); ss += dppf<0x140>(ss);
            bs += dppf<0xB1>(bs); bs += dppf<0x4E>(bs); bs += dppf<0x141>(bs); bs += dppf<0x140>(bs);
            const float rn = __builtin_amdgcn_rsqf(fmaxf(ss, 1e-24f));
#pragma unroll
            for (int t4 = 0; t4 < 4; ++t4) { const int c = head * 64 + 16 * t4 + n16; const float kk = kkr[t4] * rn;
                ((bf16*)(SC + 0 * SS))[m * 1024 + c] = (unsigned short)(pk2(kk, 0.f) & 0xffffu); SC[1 * SS + m * 1024 + c] = fexp_(lw_[t4]); SC[3 * SS + m * 1024 + c] = lw_[t4];
                ((unsigned*)(SC + 2 * SS))[m * 1024 + head * 64 + n16 * 4 + t4] = pk2(-kk * a_[t4], km[t4]);
                ((bf16*)(SC + 4 * SS))[m * 1024 + c] = (unsigned short)(pk2(rr[t4], 0.f) & 0xffffu); SC[5 * SS + m * 1024 + c] = vv[t4];
                GG[m * 1024 + c] = ag[t4][i]; }
            if (n16 == 0) BON[m * 16 + head] = bs;
        }
    }
}

DI void phase_b(const Ctx& C, int l, int lq) {
    const int tid = C.tid;
    const bf16* P = wsp<bf16>(C, WS_PROJ);
    LAS int* qslot = (LAS int*)(C.lds + MISC_OFF + 64);
    for (;;) {
        __syncthreads();
        if (tid == 0) *qslot = (int)atomicAdd(C.ctl + CW_QUEUE + 64 * (16 + lq), 1u);
        __syncthreads();
        const int it = *qslot;
        if (it >= PB_ITEMS) break;
        int r = it;
        if (r < PB_NRW) { rwkv_pre_item(C, l, r); continue; }
        r -= PB_NRW;
        if (r < PB_NPOOL) {
            const int b = r >> 6, n = r & 63, kv = tid >> 8, kvh = (tid >> 6) & 3, d = tid & 63;
            const float* src = C.out + O_CMP_P + ((size_t)l * NTP + b * 2048 + 32 * n) * 512 + tid;
            const float* w = C.inp(20) + (l * 2 + kv) * 32;
            float acc = 0.f;
#pragma unroll 8
            for (int rr = 0; rr < 32; ++rr) acc += w[rr] * src[(size_t)rr * 512];
            const unsigned short hb = (unsigned short)(pk2(acc, 0.f) & 0xffffu);
            if (kv == 0) wsp<bf16>(C, WS_KCB)[((size_t)(b * 4 + kvh) * 64 + n) * 64 + d] = hb;
            else wsp<bf16>(C, WS_VCBT)[((size_t)(b * 4 + kvh) * 64 + d) * 64 + n] = hb;
            continue;
        }
        r -= PB_NPOOL;
        {
            const int which = r >> 9, b = (r >> 7) & 3, kvh = (r >> 5) & 3, tb = r & 31, d = tid & 63, tq = tid >> 6;
            const bf16* src = P + (size_t)(b * 2048 + 64 * tb + 8 * tq) * PLD + (which ? VW_OFF : VS_OFF) + kvh * 64 + d;
            unsigned short e[8];
#pragma unroll
            for (int i = 0; i < 8; ++i) e[i] = src[(size_t)i * PLD];
            v4u o; o.x = e[0] | ((unsigned)e[1] << 16); o.y = e[2] | ((unsigned)e[3] << 16); o.z = e[4] | ((unsigned)e[5] << 16); o.w = e[6] | ((unsigned)e[7] << 16);
            *(v4u*)(wsp<bf16>(C, which ? WS_VTW : WS_VTS) + (((size_t)(b * 4 + kvh) * 32 + tb) * 64 + d) * 64 + 8 * tq) = o;
            { const int row = tid >> 3, ch = tid & 7;
              const v4u kv_ = *(const v4u*)(P + (size_t)(b * 2048 + 64 * tb + row) * PLD + (which ? KW_OFF : KS_OFF) + kvh * 64 + ch * 8);
              *(v4u*)(wsp<bf16>(C, which ? WS_KWC : WS_KSC) + ((size_t)(b * 4 + kvh) * 2048 + 64 * tb + row) * 64 + ch * 8) = kv_; }
        }
    }
    __syncthreads();
}

#define MFMA16(a, b, c) __builtin_amdgcn_mfma_f32_16x16x32_bf16((a), (b), (c), 0, 0, 0)
DI void scan_head(const Ctx& C, int l, int row0, int T, int h, const float* S0, float* Sout) {
    const int tid = C.tid, lane = C.lane, wave = C.wave;
    LAS f32x4* D4 = (LAS f32x4*)C.lds;
    LAS v4u* BK4 = (LAS v4u*)(C.lds + 8192);
    LAS f32x4* V4 = (LAS f32x4*)(C.lds + 16384);
    LAS v4u* R16 = (LAS v4u*)(C.lds + 24576);
    LAS v4u* KK16 = (LAS v4u*)(C.lds + 28672);
    LAS float* YB = (LAS float*)(C.lds + 33280);
    const unsigned char* SCb = C.ws + WS_SC;
    const bf16* SCKK = (const bf16*)SCb; const float* SCD = (const float*)(SCb + SC_STRIDE); const unsigned* SCBK = (const unsigned*)(SCb + 2 * SC_STRIDE);
    const bf16* SCR = (const bf16*)(SCb + 4 * SC_STRIDE); const float* SCV = (const float*)(SCb + 5 * SC_STRIDE);
    const float* GG = wsp<float>(C, WS_GG); const float* BON = wsp<float>(C, WS_BON);
    bf16* MIX = wsp<bf16>(C, WS_MIX);
    const int n = lane & 15, rq = lane >> 4, v0 = 16 * (wave & 3); const bool act = wave < 4;
    f32x4 acc[4];
#pragma unroll
    for (int kt = 0; kt < 4; ++kt) acc[kt] = (act && S0) ? *(const f32x4*)(S0 + (v0 + n) * 64 + 16 * kt + 4 * rq) : (f32x4){0.f, 0.f, 0.f, 0.f};
    const int nch = (T + 31) >> 5;
    f32x4 pD, pV; v4u pBK, pRK, pK2;
    const v4u z4 = {0u, 0u, 0u, 0u};
#define SCAN_PREFETCH(cc) do { { const int step = (cc) * 32 + (tid >> 4), f4 = tid & 15; const size_t o = (size_t)(row0 + step) * 1024 + h * 64 + f4 * 4; const bool ok = step < T; \
            pD = ok ? *(const f32x4*)(SCD + o) : (f32x4){0.f, 0.f, 0.f, 0.f}; pV = ok ? *(const f32x4*)(SCV + o) : (f32x4){0.f, 0.f, 0.f, 0.f}; pBK = ok ? *(const v4u*)(SCBK + o) : z4; } \
        { const int i2 = tid & 255, step = (cc) * 32 + (i2 >> 3); const size_t o = (size_t)(row0 + step) * 1024 + h * 64 + (i2 & 7) * 8; pRK = step < T ? *(const v4u*)((tid < 256 ? SCR : SCKK) + o) : z4; } \
        { const int step = (cc) * 32 + 32; const size_t o = (size_t)(row0 + step) * 1024 + h * 64 + (tid & 7) * 8; pK2 = (tid < 8 && step < T) ? *(const v4u*)(SCKK + o) : z4; } } while (0)
    SCAN_PREFETCH(0);
    const float gng = C.inp(18)[l * 1024 + h * 64 + lane], gnb = C.inp(19)[l * 1024 + h * 64 + lane];
    float sk = 0.f;
    struct StepOps { f32x4 d[4]; v4u bk; float vt; v2u a[4]; };
#define SCAN_LD(o, st_) do { _Pragma("unroll") for (int kt = 0; kt < 4; ++kt) (o).d[kt] = D4[(st_) * 16 + 4 * kt + rq]; (o).bk = BK4[(st_) * 16 + n]; (o).vt = ((const LAS float*)V4)[(st_) * 64 + v0 + n]; \
        const LAS unsigned char* src_ = (n & 3) == 1 ? (const LAS unsigned char*)KK16 + ((st_) + 1) * 128 : (const LAS unsigned char*)R16 + (st_) * 128; \
        (o).a[0] = *(const LAS v2u*)(src_ + 8 * rq); (o).a[1] = *(const LAS v2u*)(src_ + 32 + 8 * rq); (o).a[2] = *(const LAS v2u*)(src_ + 64 + 8 * rq); (o).a[3] = *(const LAS v2u*)(src_ + 96 + 8 * rq); } while (0)
#define SCAN_YSK(a0_, a1_, a2_, a3_, yv, skv) do { \
        v4u h0, h1; h0.x = pk2(acc[0][0], acc[0][1]); h0.y = pk2(acc[0][2], acc[0][3]); h0.z = pk2(acc[1][0], acc[1][1]); h0.w = pk2(acc[1][2], acc[1][3]); \
        h1.x = pk2(acc[2][0], acc[2][1]); h1.y = pk2(acc[2][2], acc[2][3]); h1.z = pk2(acc[3][0], acc[3][1]); h1.w = pk2(acc[3][2], acc[3][3]); \
        const v4u f0 = {(a0_).x, (a0_).y, (a1_).x, (a1_).y}, f1 = {(a2_).x, (a2_).y, (a3_).x, (a3_).y}; \
        f32x4 d2 = MFMA16(__builtin_bit_cast(bf16x8, f0), __builtin_bit_cast(bf16x8, h0), ((f32x4){0.f, 0.f, 0.f, 0.f})); \
        d2 = MFMA16(__builtin_bit_cast(bf16x8, f1), __builtin_bit_cast(bf16x8, h1), d2); yv = d2[0]; skv = d2[1]; } while (0)
    for (int c = 0; c < nch; ++c) {
        __syncthreads();
        D4[tid] = pD; BK4[tid] = pBK; V4[tid] = pV;
        if (tid < 256) R16[tid] = pRK; else KK16[tid - 256] = pRK;
        if (tid < 8) KK16[256 + tid] = pK2;
        __syncthreads();
        if (c + 1 < nch) SCAN_PREFETCH(c + 1);
        const int nst = (T - c * 32) < 32 ? (T - c * 32) : 32;
        float gq[4], bq[4];
#pragma unroll
        for (int qq = 0; qq < 4; ++qq) { const int st = wave * 4 + qq; const size_t m = (size_t)row0 + c * 32 + (st < nst ? st : 0);
            gq[qq] = GG[m * 1024 + h * 64 + lane]; bq[qq] = BON[m * 16 + h]; }
        if (act) {
            if (c == 0) {
                const LAS unsigned char* s0 = (const LAS unsigned char*)KK16;
                const v2u k0 = *(const LAS v2u*)(s0 + 8 * rq), k1 = *(const LAS v2u*)(s0 + 32 + 8 * rq), k2 = *(const LAS v2u*)(s0 + 64 + 8 * rq), k3 = *(const LAS v2u*)(s0 + 96 + 8 * rq);
                float yd; SCAN_YSK(k0, k1, k2, k3, sk, yd); (void)yd;
            }
            StepOps cur; SCAN_LD(cur, 0);
#pragma unroll 2
            for (int st = 0; st < nst; ++st) {
                StepOps nx; { const int sn = st + 1 < 32 ? st + 1 : 31; SCAN_LD(nx, sn); }
#pragma unroll
                for (int kt = 0; kt < 4; ++kt) acc[kt] = acc[kt] * cur.d[kt];
                v4u b2 = z4; b2.x = rq == 0 ? pk2(sk, cur.vt) : 0u;
#pragma unroll
                for (int kt = 0; kt < 4; ++kt) { v4u a2 = z4; a2.x = rq == 0 ? cur.bk[kt] : 0u; acc[kt] = MFMA16(__builtin_bit_cast(bf16x8, a2), __builtin_bit_cast(bf16x8, b2), acc[kt]); }
                float y; SCAN_YSK(cur.a[0], cur.a[1], cur.a[2], cur.a[3], y, sk);
                if (rq == 0) YB[st * 64 + v0 + n] = y;
                cur = nx;
            }
        }
        __syncthreads();
#pragma unroll
        for (int qq = 0; qq < 4; ++qq) {
            const int st = wave * 4 + qq;
            if (st < nst) {
                const size_t m = (size_t)row0 + c * 32 + st;
                const float y = YB[st * 64 + lane];
                const float mean = wave_sum(y) * (1.f / 64.f);
                const float dv = y - mean;
                const float var = wave_sum(dv * dv) * (1.f / 64.f);
                const float yn = dv * __builtin_amdgcn_rsqf(var + GN_EPS) * gng + gnb;
                const float o = (yn + bq[qq] * ((const LAS float*)V4)[st * 64 + lane]) * gq[qq];
                MIX[m * DM + h * 64 + lane] = (unsigned short)(pk2(o, 0.f) & 0xffffu);
            }
        }
    }
#undef SCAN_PREFETCH
#undef SCAN_LD
#undef SCAN_YSK
    if (act) {
#pragma unroll
        for (int kt = 0; kt < 4; ++kt) *(f32x4*)(Sout + (v0 + n) * 64 + 16 * kt + 4 * rq) = acc[kt];
    }
}

constexpr int CST = 144, CBUF = 64 * CST;
DI void cmm(const LAS unsigned char* L, const LAS unsigned char* Rt, f32x4 (&acc)[2], int tm, int tn0, int n16, int kq) {
#pragma unroll
    for (int ks = 0; ks < 2; ++ks) {
        const bf16x8 a = *(const LAS bf16x8*)(L + (16 * tm + n16) * CST + (32 * ks + 8 * kq) * 2);
#pragma unroll
        for (int j = 0; j < 2; ++j) { const bf16x8 bq = *(const LAS bf16x8*)(Rt + (16 * (tn0 + j) + n16) * CST + (32 * ks + 8 * kq) * 2); acc[j] = MFMA16(a, bq, acc[j]); }
    }
}
template <int MODE> DI void cst_T(LAS unsigned char* X, const f32x4 (&acc)[2], int tm, int tn0, int n16, int rq) {
#pragma unroll
    for (int j = 0; j < 2; ++j) { const int n = 16 * (tn0 + j) + n16, m0 = 16 * tm + 4 * rq; float v[4];
#pragma unroll
        for (int i = 0; i < 4; ++i) { const int col = m0 + i; const bool keep = MODE == 0 ? true : (MODE == 1 ? col < n : (MODE == 2 ? col <= n : col > n)); v[i] = keep ? acc[j][i] : 0.f; }
        *(LAS v2u*)(X + n * CST + m0 * 2) = (v2u){pk2(v[0], v[1]), pk2(v[2], v[3])}; }
}
template <int mode> DI void chunk_head(const Ctx& C, int l, int b, int h, float* Sout, int part) {
    const int tid = C.tid, lane = C.lane, wave = C.wave;
    const int n16 = lane & 15, rq = lane >> 4, tm = wave >> 1, tn0 = (wave & 1) * 2;
    LAS unsigned char* const B0 = C.lds;
#define CB(i) (B0 + (i) * CBUF)
    enum { I_BH = 0, I_BHT = 1, I_AH = 2, I_KH = 3, I_RH = 4, I_ATT = 5, I_KTT = 6, I_VT = 7, I_A1 = 8, I_A1T = 9, I_A2 = 10, I_M1 = 11, I_M2 = 12, I_H0T = 13 };
    LAS float* SEG = (LAS float*)(B0 + 14 * CBUF);
    LAS float* YB = (LAS float*)CB(8);
    const unsigned char* SCb = C.ws + WS_SC;
    const bf16* SCKK = (const bf16*)SCb; const unsigned* SCBK = (const unsigned*)(SCb + 2 * SC_STRIDE); const float* SCLW = (const float*)(SCb + 3 * SC_STRIDE);
    const bf16* SCR = (const bf16*)(SCb + 4 * SC_STRIDE); const float* SCV = (const float*)(SCb + 5 * SC_STRIDE);
    const float* GG = wsp<float>(C, WS_GG); const float* BON = wsp<float>(C, WS_BON);
    bf16* MIX = wsp<bf16>(C, WS_MIX);
    const size_t m0 = (size_t)b * 2048;
    const int pk = tid & 63, seg = tid >> 6, bkidx = (pk & 15) * 4 + (pk >> 4);
    const f32x4 zf = {0.f, 0.f, 0.f, 0.f};
    f32x4 accH[2] = {zf, zf};
    __syncthreads();
    for (int i = tid; i < CBUF / 4; i += NTHREADS) ((LAS unsigned*)CB(I_H0T))[i] = 0u;
    float plw[8], pv[8]; unsigned pbk[8]; unsigned short pkk[8], pr[8];
#define CH_LOAD(cc) do { _Pragma("unroll") for (int i = 0; i < 8; ++i) { const size_t o = (m0 + (cc) * 64 + seg * 8 + i) * 1024 + h * 64; \
        plw[i] = SCLW[o + pk]; pkk[i] = SCKK[o + pk]; pbk[i] = SCBK[o + bkidx]; pr[i] = SCR[o + pk]; pv[i] = SCV[o + pk]; } } while (0)
    unsigned char* const OPS = C.ws + WS_OPS + (size_t)((b * 16 + h) * 24) * OPS_BYTES;
    unsigned* const flag = C.ctl + CW_FLAG + 64 * ((l * 64 + b * 16 + h) * 4);
    const int c_lo = mode ? 16 * part : 0, c_hi = mode ? 16 * part + 16 : 16;
    CH_LOAD(c_lo);
    const float gng = C.inp(18)[l * 1024 + h * 64 + lane], gnb = C.inp(19)[l * 1024 + h * 64 + lane];
    for (int c = c_lo; c < c_hi; ++c) {

        float gq[8], bq[8], vq[8];
#pragma unroll
        for (int i = 0; i < 8; ++i) { const size_t m = m0 + c * 64 + 8 * wave + i; gq[i] = GG[m * 1024 + h * 64 + lane]; bq[i] = BON[m * 16 + h]; vq[i] = SCV[m * 1024 + h * 64 + lane]; }
        float cs[8];
        { float run = 0.f;
#pragma unroll
          for (int i = 0; i < 8; ++i) { run += plw[i]; cs[i] = run; } }
        __syncthreads();
        SEG[seg * 64 + pk] = cs[7];
        __syncthreads();
        float off = 0.f, tot = 0.f;
#pragma unroll
        for (int s = 0; s < 8; ++s) { const float sv = SEG[s * 64 + pk]; tot += sv; off += s < seg ? sv : 0.f; }
        { unsigned short bt[8], at[8], kt[8], vt[8];
#pragma unroll
          for (int i = 0; i < 8; ++i) { const float csv = cs[i] + off;
              const float eP = __expf(csv), eM = __expf(-csv), ePm = __expf(csv - plw[i]), eQ = __expf(tot - csv);
              const float kkf = bf2f(pkk[i]), nb = bflo(pbk[i]), kmf = bfhi(pbk[i]), rf = bf2f(pr[i]);
              const int t = seg * 8 + i;
              const unsigned short vb = (unsigned short)(pk2(kkf * ePm, 0.f) & 0xffffu);
              *(LAS unsigned short*)(CB(I_BH) + t * CST + pk * 2) = vb; bt[i] = vb;
              *(LAS unsigned short*)(CB(I_AH) + t * CST + pk * 2) = (unsigned short)(pk2(nb * eM, 0.f) & 0xffffu);
              *(LAS unsigned short*)(CB(I_KH) + t * CST + pk * 2) = (unsigned short)(pk2(kmf * eM, 0.f) & 0xffffu);
              *(LAS unsigned short*)(CB(I_RH) + t * CST + pk * 2) = (unsigned short)(pk2(rf * eP, 0.f) & 0xffffu);
              at[i] = (unsigned short)(pk2(nb * eQ, 0.f) & 0xffffu); kt[i] = (unsigned short)(pk2(kmf * eQ, 0.f) & 0xffffu); vt[i] = (unsigned short)(pk2(pv[i], 0.f) & 0xffffu); }
#define PK8(a) ((v4u){(unsigned)a[0] | ((unsigned)a[1] << 16), (unsigned)a[2] | ((unsigned)a[3] << 16), (unsigned)a[4] | ((unsigned)a[5] << 16), (unsigned)a[6] | ((unsigned)a[7] << 16)})
          *(LAS v4u*)(CB(I_BHT) + pk * CST + seg * 16) = PK8(bt); *(LAS v4u*)(CB(I_ATT) + pk * CST + seg * 16) = PK8(at);
          *(LAS v4u*)(CB(I_KTT) + pk * CST + seg * 16) = PK8(kt); *(LAS v4u*)(CB(I_VT) + pk * CST + seg * 16) = PK8(vt);
#undef PK8
        }
        if (c + 1 < c_hi) CH_LOAD(c + 1);
        __syncthreads();
        f32x4 accT[2];
        { f32x4 a_[2];
          a_[0] = zf; a_[1] = zf; cmm(CB(I_BH), CB(I_AH), a_, tm, tn0, n16, rq); cst_T<3>(CB(I_A1T), a_, tm, tn0, n16, rq);
          a_[0] = zf; a_[1] = zf; cmm(CB(I_AH), CB(I_BH), a_, tm, tn0, n16, rq); cst_T<1>(CB(I_A1), a_, tm, tn0, n16, rq);
#pragma unroll
          for (int j = 0; j < 2; ++j)
#pragma unroll
              for (int i = 0; i < 4; ++i) { const int m = 16 * tm + 4 * rq + i, n = 16 * (tn0 + j) + n16; accT[j][i] = m < n ? a_[j][i] : (m == n ? 1.f : 0.f); }
          a_[0] = zf; a_[1] = zf; cmm(CB(I_KH), CB(I_BH), a_, tm, tn0, n16, rq); cst_T<1>(CB(I_A2), a_, tm, tn0, n16, rq);
          a_[0] = zf; a_[1] = zf; cmm(CB(I_AH), CB(I_RH), a_, tm, tn0, n16, rq); cst_T<2>(CB(I_M1), a_, tm, tn0, n16, rq);
          a_[0] = zf; a_[1] = zf; cmm(CB(I_KH), CB(I_RH), a_, tm, tn0, n16, rq); cst_T<2>(CB(I_M2), a_, tm, tn0, n16, rq); }
        __syncthreads();
        { int ip = I_A1, ipt = I_A1T, in_ = I_AH, int_ = I_KH;
#pragma unroll 1
          for (int lev = 0; lev < 5; ++lev) {
              cst_T<0>(CB(I_BH), accT, tm, tn0, n16, rq);
              f32x4 a_[2];
              a_[0] = zf; a_[1] = zf; cmm(CB(ip), CB(ipt), a_, tm, tn0, n16, rq); cst_T<0>(CB(int_), a_, tm, tn0, n16, rq);
              a_[0] = zf; a_[1] = zf; cmm(CB(ipt), CB(ip), a_, tm, tn0, n16, rq); cst_T<0>(CB(in_), a_, tm, tn0, n16, rq);
              __syncthreads();
              cmm(CB(int_), CB(I_BH), accT, tm, tn0, n16, rq);
              __syncthreads();
              const int t0 = ip, t1 = ipt; ip = in_; ipt = int_; in_ = t0; int_ = t1;
          }
          cst_T<0>(CB(I_BH), accT, tm, tn0, n16, rq); }
        { f32x4 a_[2];
          a_[0] = zf; a_[1] = zf; cmm(CB(I_A2), CB(I_VT), a_, tm, tn0, n16, rq); cst_T<0>(CB(8), a_, tm, tn0, n16, rq);
          __syncthreads();
          a_[0] = zf; a_[1] = zf; cmm(CB(I_BH), CB(I_BHT), a_, tm, tn0, n16, rq); cst_T<0>(CB(9), a_, tm, tn0, n16, rq);
          a_[0] = zf; a_[1] = zf; cmm(CB(I_BH), CB(8), a_, tm, tn0, n16, rq); cst_T<0>(CB(2), a_, tm, tn0, n16, rq); }
        __syncthreads();
        f32x4 accE[2] = {zf, zf}, accY[2] = {zf, zf};
        { f32x4 a_[2];
          a_[0] = zf; a_[1] = zf; cmm(CB(9), CB(I_ATT), a_, tm, tn0, n16, rq);
#pragma unroll
          for (int j = 0; j < 2; ++j) { const int n = 16 * (tn0 + j) + n16, mm0 = 16 * tm + 4 * rq; float pc = 0.f;
#pragma unroll
              for (int s = 0; s < 8; ++s) pc += SEG[s * 64 + n];
              pc = __expf(pc); float v[4];
#pragma unroll
              for (int i = 0; i < 4; ++i) v[i] = a_[j][i] + (mm0 + i == n ? pc : 0.f);
              *(LAS v2u*)(CB(3) + n * CST + mm0 * 2) = (v2u){pk2(v[0], v[1]), pk2(v[2], v[3])}; }
          cmm(CB(I_ATT), CB(2), accE, tm, tn0, n16, rq); cmm(CB(I_KTT), CB(I_VT), accE, tm, tn0, n16, rq);
          a_[0] = zf; a_[1] = zf; cmm(CB(9), CB(I_M1), a_, tm, tn0, n16, rq);
#pragma unroll
          for (int j = 0; j < 2; ++j) { const int n = 16 * (tn0 + j) + n16, mm0 = 16 * tm + 4 * rq;
              const v2u rh = *(const LAS v2u*)(CB(I_RH) + n * CST + mm0 * 2);
              *(LAS v2u*)(CB(10) + n * CST + mm0 * 2) = (v2u){pk2(a_[j][0] + bflo(rh.x), a_[j][1] + bfhi(rh.x)), pk2(a_[j][2] + bflo(rh.y), a_[j][3] + bfhi(rh.y))}; }
          cmm(CB(I_M1), CB(2), accY, tm, tn0, n16, rq); cmm(CB(I_M2), CB(I_VT), accY, tm, tn0, n16, rq); }
        __syncthreads();
        if (mode == 1) {
            unsigned char* ob = OPS + (size_t)(c - 16) * OPS_BYTES;
            for (int i = tid; i < 2 * CBUF / 16; i += NTHREADS) ((v4u*)ob)[i] = *(const LAS v4u*)((i < CBUF / 16 ? CB(3) : CB(10)) + (i < CBUF / 16 ? i : i - CBUF / 16) * 16);
            ((f32x4*)(ob + 2 * CBUF))[tid * 2] = accE[0]; ((f32x4*)(ob + 2 * CBUF))[tid * 2 + 1] = accE[1];
            ((f32x4*)(ob + 2 * CBUF + 16384))[tid * 2] = accY[0]; ((f32x4*)(ob + 2 * CBUF + 16384))[tid * 2 + 1] = accY[1];
            continue;
        }
        cmm(CB(3), CB(I_H0T), accE, tm, tn0, n16, rq); cmm(CB(10), CB(I_H0T), accY, tm, tn0, n16, rq);
        __syncthreads();
        accH[0] = accE[0]; accH[1] = accE[1];
        cst_T<0>(CB(I_H0T), accH, tm, tn0, n16, rq);
#pragma unroll
        for (int j = 0; j < 2; ++j)
#pragma unroll
            for (int i = 0; i < 4; ++i) YB[(16 * tm + 4 * rq + i) * 64 + 16 * (tn0 + j) + n16] = accY[j][i];
        __syncthreads();
#pragma unroll
        for (int i = 0; i < 8; ++i) {
            const int t = 8 * wave + i; const size_t m = m0 + c * 64 + t;
            const float y = YB[t * 64 + lane];
            const float mean = wave_sum(y) * (1.f / 64.f);
            const float dv = y - mean;
            const float var = wave_sum(dv * dv) * (1.f / 64.f);
            const float yn = dv * __builtin_amdgcn_rsqf(var + GN_EPS) * gng + gnb;
            const float o = (yn + bq[i] * vq[i]) * gq[i];
            MIX[m * DM + h * 64 + lane] = (unsigned short)(pk2(o, 0.f) & 0xffffu);
        }
    }
    if (mode == 0) for (int c = 16; c < 32; ++c) {
            float gq[8], bq[8], vq[8];
#pragma unroll
            for (int i = 0; i < 8; ++i) { const size_t m = m0 + c * 64 + 8 * wave + i; gq[i] = GG[m * 1024 + h * 64 + lane]; bq[i] = BON[m * 16 + h]; vq[i] = SCV[m * 1024 + h * 64 + lane]; }
            if ((c & 15) == 0) {
                if (tid == 0) { unsigned sp = 0; while (__hip_atomic_load(flag + 64 * (c >> 4), __ATOMIC_RELAXED, __HIP_MEMORY_SCOPE_AGENT) == 0u) { __builtin_amdgcn_s_sleep(8); if (++sp > (1u << 22)) break; }
                    __builtin_amdgcn_fence(__ATOMIC_ACQUIRE, "agent"); asm volatile("s_waitcnt vmcnt(0)" ::: "memory"); }
            }
            __syncthreads();
            const unsigned char* ob = OPS + (size_t)(c - 16) * OPS_BYTES;
            for (int i = tid; i < 2 * CBUF / 16; i += NTHREADS) { const v4u w = ((const v4u*)ob)[i]; *(LAS v4u*)((i < CBUF / 16 ? CB(3) : CB(10)) + (i < CBUF / 16 ? i : i - CBUF / 16) * 16) = w; }
            f32x4 accE[2], accY[2];
            accE[0] = ((const f32x4*)(ob + 2 * CBUF))[tid * 2]; accE[1] = ((const f32x4*)(ob + 2 * CBUF))[tid * 2 + 1];
            accY[0] = ((const f32x4*)(ob + 2 * CBUF + 16384))[tid * 2]; accY[1] = ((const f32x4*)(ob + 2 * CBUF + 16384))[tid * 2 + 1];
            __syncthreads();
            cmm(CB(3), CB(I_H0T), accE, tm, tn0, n16, rq); cmm(CB(10), CB(I_H0T), accY, tm, tn0, n16, rq);
            __syncthreads();
            accH[0] = accE[0]; accH[1] = accE[1];
            cst_T<0>(CB(I_H0T), accH, tm, tn0, n16, rq);
#pragma unroll
            for (int j = 0; j < 2; ++j)
#pragma unroll
                for (int i = 0; i < 4; ++i) YB[(16 * tm + 4 * rq + i) * 64 + 16 * (tn0 + j) + n16] = accY[j][i];
            __syncthreads();
#pragma unroll
            for (int i = 0; i < 8; ++i) {
                const int t = 8 * wave + i; const size_t m = m0 + c * 64 + t;
                const float y = YB[t * 64 + lane];
                const float mean = wave_sum(y) * (1.f / 64.f);
                const float dv = y - mean;
                const float var = wave_sum(dv * dv) * (1.f / 64.f);
                const float yn = dv * __builtin_amdgcn_rsqf(var + GN_EPS) * gng + gnb;
                const float o = (yn + bq[i] * vq[i]) * gq[i];
                MIX[m * DM + h * 64 + lane] = (unsigned short)(pk2(o, 0.f) & 0xffffu);
            }
    }
#undef CH_LOAD
#undef CB
    if (mode == 1) {
        asm volatile("s_waitcnt vmcnt(0)" ::: "memory");
        __syncthreads();
        if (tid == 0) { __builtin_amdgcn_fence(__ATOMIC_RELEASE, "agent"); asm volatile("s_waitcnt vmcnt(0)" ::: "memory"); __hip_atomic_store(flag + 64 * part, 1u, __ATOMIC_RELAXED, __HIP_MEMORY_SCOPE_AGENT); }
        return;
    }
#pragma unroll
    for (int j = 0; j < 2; ++j) *(f32x4*)(Sout + (size_t)(16 * (tn0 + j) + n16) * 64 + 16 * tm + 4 * rq) = accH[j];
}

#define MFMA32(a, b, c) __builtin_amdgcn_mfma_f32_32x32x16_bf16((a), (b), (c), 0, 0, 0)
DI bf16x8 pack8(const f32x16& p, int s) {
    v4u o; o.x = pk2(p[8 * s], p[8 * s + 1]); o.y = pk2(p[8 * s + 2], p[8 * s + 3]); o.z = pk2(p[8 * s + 4], p[8 * s + 5]); o.w = pk2(p[8 * s + 6], p[8 * s + 7]);
    return __builtin_bit_cast(bf16x8, o);
}
DI bf16x8 ld_vt(const bf16* p) {
    const v2u a = *(const v2u*)p, b = *(const v2u*)(p + 8);
    v4u o; o.x = a.x; o.y = a.y; o.z = b.x; o.w = b.y; return __builtin_bit_cast(bf16x8, o);
}
constexpr int KT_STRIDE = 144, VTT_STRIDE = 136, KT_BYTES = 64 * KT_STRIDE, TILE_BYTES = KT_BYTES + 64 * VTT_STRIDE, TILE_OFF = 74752;
struct TileRegs { v4u k, v; };
DI TileRegs tile_load(const bf16* kbase, size_t kstride, const bf16* vbase, size_t vstride, int tid) {
    TileRegs r; const int row = tid >> 3, ch = tid & 7;
    r.k = *(const v4u*)(kbase + (size_t)row * kstride + ch * 8); r.v = *(const v4u*)(vbase + (size_t)row * vstride + ch * 8); return r;
}
DI void tile_store(LAS unsigned char* buf, const TileRegs& r, int tid) {
    const int row = tid >> 3, ch = tid & 7;
    *(LAS v4u*)(buf + row * KT_STRIDE + ch * 16) = r.k;
    *(LAS v2u*)(buf + KT_BYTES + row * VTT_STRIDE + ch * 16) = (v2u){r.v.x, r.v.y}; *(LAS v2u*)(buf + KT_BYTES + row * VTT_STRIDE + ch * 16 + 8) = (v2u){r.v.z, r.v.w};
}
DI bf16x8 ld_vt_lds(const LAS unsigned char* p) {
    const v2u a = *(const LAS v2u*)p, b = *(const LAS v2u*)(p + 16);
    v4u o; o.x = a.x; o.y = a.y; o.z = b.x; o.w = b.y; return __builtin_bit_cast(bf16x8, o);
}
#define ATT_BLOCK(EDGE, BUF, KEYBLK0, MINE, VALID_EXPR) do { \
    const float bias_ = (MINE) ? 0.f : NEG_BIG; \
    _Pragma("unroll 1") for (int tile = 0; tile < 2; ++tile) { const int key0 = (KEYBLK0) + tile * 32; (void)key0; \
        f32x16 a_ = zero16; \
        _Pragma("unroll") for (int s = 0; s < 4; ++s) { const bf16x8 kf = *(const LAS bf16x8*)((BUF) + (tile * 32 + q) * KT_STRIDE + 32 * s + 16 * hi); a_ = MFMA32(kf, qf[s], a_); } \
        float tm = NEG_BIG; \
        if (EDGE) { _Pragma("unroll") for (int i = 0; i < 16; ++i) { const int key = key0 + crow(i, hi); const bool ok = (MINE) && (VALID_EXPR); a_[i] = ok ? a_[i] * SCL2 : NEG_BIG; tm = fmaxf(tm, a_[i]); } } \
        else { _Pragma("unroll") for (int i = 0; i < 16; ++i) { a_[i] = a_[i] * SCL2 + bias_; tm = fmaxf(tm, a_[i]); } } \
        tm = fmaxf(tm, __shfl_xor(tm, 32)); \
        const float mn = fmaxf(mrun, tm); const float sc_ = __builtin_amdgcn_exp2f(mrun - mn); \
        float ps = 0.f; \
        if (EDGE) { _Pragma("unroll") for (int i = 0; i < 16; ++i) { const float p_ = a_[i] > -1e29f ? __builtin_amdgcn_exp2f(a_[i] - mn) : 0.f; a_[i] = p_; ps += p_; } } \
        else { _Pragma("unroll") for (int i = 0; i < 16; ++i) { const float p_ = __builtin_amdgcn_exp2f(a_[i] - mn); a_[i] = p_; ps += p_; } } \
        ps += __shfl_xor(ps, 32); \
        lrun = lrun * sc_ + ps; mrun = mn; \
        _Pragma("unroll") for (int i = 0; i < 16; ++i) { oa[0][i] *= sc_; oa[1][i] *= sc_; } \
        _Pragma("unroll") for (int s = 0; s < 2; ++s) { const bf16x8 pb = pack8(a_, s); \
            oa[0] = MFMA32(ld_vt_lds((BUF) + KT_BYTES + q * VTT_STRIDE + (tile * 32 + 16 * s + 4 * hi) * 2), pb, oa[0]); \
            oa[1] = MFMA32(ld_vt_lds((BUF) + KT_BYTES + (32 + q) * VTT_STRIDE + (tile * 32 + 16 * s + 4 * hi) * 2), pb, oa[1]); } \
    } } while (0)
constexpr float SCL2 = 0.125f * 1.4426950408889634f;

DI void nsa_prompt_unit(const Ctx& C, int l, int b, int kvh, int qt, bool skipblk = false, bool skipcmp = false) {
    const int tid = C.tid, lane = C.lane, wave = C.wave;
    const int g = wave & 3, th = wave >> 2, q = lane & 31, hi = lane >> 5;
    LAS float* IMP = (LAS float*)C.lds;
    LAS float* IMPV = (LAS float*)(C.lds + 65536);
    LAS unsigned* SELM = (LAS unsigned*)(C.lds + 65536 + 8192);
    LAS unsigned char* TB = C.lds + TILE_OFF;
    const bf16* P = wsp<bf16>(C, WS_PROJ);
    const int tok = qt * 64 + th * 32 + q;
    const size_t m = (size_t)b * 2048 + tok;
    const int bk = b * 4 + kvh, head = kvh * 4 + g;
    f32x16 zero16;
#pragma unroll
    for (int i = 0; i < 16; ++i) zero16[i] = 0.f;
    bf16x8 qf[4];
#pragma unroll
    for (int s = 0; s < 4; ++s) qf[s] = *(const bf16x8*)(P + m * PLD + Q_OFF + head * 64 + 16 * s + 8 * hi);
    f32x16 out0 = zero16, out1 = zero16;
    const float g0 = sigmoidf_(bf2f(P[m * PLD + GL_OFF + head * 3 + 0])), g1 = sigmoidf_(bf2f(P[m * PLD + GL_OFF + head * 3 + 1])), g2 = sigmoidf_(bf2f(P[m * PLD + GL_OFF + head * 3 + 2]));
    TileRegs tr = tile_load(wsp<bf16>(C, WS_KCB) + (size_t)bk * 4096, 64, wsp<bf16>(C, WS_VCBT) + (size_t)bk * 4096, 64, tid);
    __syncthreads();
    tile_store(TB, tr, tid);
    __syncthreads();
    if (!skipcmp) {
    {
        f32x16 sc[2];
        const int nvalid = (tok + 1) >> 5;
        float mx = NEG_BIG;
#pragma unroll
        for (int tile = 0; tile < 2; ++tile) {
            f32x16 a_ = zero16;
#pragma unroll
            for (int s = 0; s < 4; ++s) { const bf16x8 kf = *(const LAS bf16x8*)(TB + (tile * 32 + q) * KT_STRIDE + 32 * s + 16 * hi); a_ = MFMA32(kf, qf[s], a_); }
#pragma unroll
            for (int i = 0; i < 16; ++i) { const int n = tile * 32 + crow(i, hi); a_[i] = n < nvalid ? a_[i] * 0.125f : NEG_BIG; mx = fmaxf(mx, a_[i]); }
            sc[tile] = a_;
        }
        mx = fmaxf(mx, __shfl_xor(mx, 32));
        float sum = 0.f;
#pragma unroll
        for (int tile = 0; tile < 2; ++tile)
#pragma unroll
            for (int i = 0; i < 16; ++i) { const float p_ = sc[tile][i] > -1e29f ? __expf(sc[tile][i] - mx) : 0.f; sc[tile][i] = p_; sum += p_; }
        sum += __shfl_xor(sum, 32);
        const float inv = nvalid > 0 ? 1.f / sum : 0.f;
        f32x16 oc0 = zero16, oc1 = zero16;
#pragma unroll
        for (int tile = 0; tile < 2; ++tile) {
#pragma unroll
            for (int i = 0; i < 16; ++i) sc[tile][i] *= inv;
#pragma unroll
            for (int i4 = 0; i4 < 4; ++i4) { f32x4 v = {sc[tile][4 * i4], sc[tile][4 * i4 + 1], sc[tile][4 * i4 + 2], sc[tile][4 * i4 + 3]};
                *(LAS f32x4*)(IMP + ((size_t)(g * 64 + th * 32 + q)) * 64 + tile * 32 + 8 * i4 + 4 * hi) = v; }
#pragma unroll
            for (int s = 0; s < 2; ++s) { const bf16x8 pb = pack8(sc[tile], s);
                oc0 = MFMA32(ld_vt_lds(TB + KT_BYTES + q * VTT_STRIDE + (tile * 32 + 16 * s + 4 * hi) * 2), pb, oc0);
                oc1 = MFMA32(ld_vt_lds(TB + KT_BYTES + (32 + q) * VTT_STRIDE + (tile * 32 + 16 * s + 4 * hi) * 2), pb, oc1); }
        }
#pragma unroll
        for (int i = 0; i < 16; ++i) { out0[i] = g0 * oc0[i]; out1[i] = g0 * oc1[i]; }
    }
    __syncthreads();
    {
        const int tokl = tid >> 3, jq = tid & 7;
        float v[4];
#pragma unroll
        for (int e = 0; e < 4; ++e) v[e] = 0.f;
#pragma unroll
        for (int gg = 0; gg < 4; ++gg) { const f32x4 a = *(const LAS f32x4*)(IMP + (size_t)(gg * 64 + tokl) * 64 + 8 * jq), bq = *(const LAS f32x4*)(IMP + (size_t)(gg * 64 + tokl) * 64 + 8 * jq + 4);
            v[0] += a[0] + a[1]; v[1] += a[2] + a[3]; v[2] += bq[0] + bq[1]; v[3] += bq[2] + bq[3]; }
        const int cur = qt;
#pragma unroll
        for (int e = 0; e < 4; ++e) { const int j = 4 * jq + e; const bool forced = (j == 0) | (j == cur) | (j == cur - 1); v[e] = j > cur ? -1.f : (forced ? 1e4f : v[e]); }
        *(LAS f32x4*)(IMPV + tokl * 32 + 4 * jq) = (f32x4){v[0], v[1], v[2], v[3]};
        __syncthreads();
        int rank[4] = {0, 0, 0, 0};
#pragma unroll
        for (int jj4 = 0; jj4 < 8; ++jj4) { const f32x4 o = *(const LAS f32x4*)(IMPV + tokl * 32 + 4 * jj4);
#pragma unroll
            for (int u = 0; u < 4; ++u) { const int jp = 4 * jj4 + u; const float ov = o[u];
#pragma unroll
                for (int e = 0; e < 4; ++e) { const int j = 4 * jq + e; rank[e] += (ov > v[e] || (ov == v[e] && jp < j)) ? 1 : 0; } } }
        unsigned bits = 0;
#pragma unroll
        for (int e = 0; e < 4; ++e) if (rank[e] < 16 && v[e] >= 0.f) bits |= 1u << (4 * jq + e);
        bits |= __shfl_xor(bits, 1); bits |= __shfl_xor(bits, 2); bits |= __shfl_xor(bits, 4);
        if (jq == 0) SELM[tokl] = bits;
        __syncthreads();
    }
    }
    if (skipcmp && tid < 64) SELM[tid] = 0xffffffffu;
    __syncthreads();
    const unsigned selm = SELM[th * 32 + q];
    unsigned uni;
    { unsigned u0 = SELM[lane];
#pragma unroll
      for (int o = 1; o < 64; o <<= 1) u0 |= __shfl_xor(u0, o);
      uni = __builtin_amdgcn_readfirstlane(u0); }
    {
        LAS float* PARK = (LAS float*)C.lds + wave * 2048 + lane;
#pragma unroll
        for (int i = 0; i < 16; ++i) { PARK[i * 64] = out0[i]; PARK[(16 + i) * 64] = out1[i]; }
        const bf16* KBs = wsp<bf16>(C, WS_KSC) + (size_t)bk * 2048 * 64; const bf16* KBw = wsp<bf16>(C, WS_KWC) + (size_t)bk * 2048 * 64;
        const bf16* VTs = wsp<bf16>(C, WS_VTS) + (size_t)bk * 32 * 4096; const bf16* VTw = wsp<bf16>(C, WS_VTW) + (size_t)bk * 32 * 4096;
        f32x16 oa[2] = {zero16, zero16}; float mrun = NEG_BIG, lrun = 0.f;
        unsigned rem = skipblk ? 1u : uni; int wj = skipblk ? qt : (qt > 8 ? qt - 8 : 0); bool folded = false;
#define NEXT_BLK(dst) do { if (rem) { dst = __builtin_ctz(rem); rem &= rem - 1; } else if (wj <= qt) { dst = wj | 256; ++wj; } else dst = -1; } while (0)
#define LOAD_BLK(tr_, d_) do { const int j_ = (d_) & 255; tr_ = ((d_) & 256) ? tile_load(KBw + (size_t)j_ * 4096, 64, VTw + (size_t)j_ * 4096, 64, tid) : tile_load(KBs + (size_t)j_ * 4096, 64, VTs + (size_t)j_ * 4096, 64, tid); } while (0)
#define FOLD(gate_) do { const float il_ = (gate_) / lrun; _Pragma("unroll") for (int i = 0; i < 16; ++i) { PARK[i * 64] += il_ * oa[0][i]; PARK[(16 + i) * 64] += il_ * oa[1][i]; } \
            oa[0] = zero16; oa[1] = zero16; mrun = NEG_BIG; lrun = 0.f; } while (0)
#define DO_BLK(d_, buf_) do { const int j_ = (d_) & 255; const bool win_ = ((d_) & 256) != 0; \
            if (win_ && !folded) { FOLD(g1); folded = true; } \
            const bool mine = win_ ? true : (((selm >> j_) & 1u) != 0u); \
            if (__any(mine)) { const int wl_ = win_ ? 511 : (1 << 20); const bool edge_ = (j_ == qt) || (win_ && j_ + 8 <= qt); \
                if (edge_) ATT_BLOCK(1, buf_, j_ * 64, mine, (key <= tok && key + wl_ >= tok)); else ATT_BLOCK(0, buf_, j_ * 64, mine, true); } } while (0)
        int d0, d1, d2; TileRegs trA, trB;
        NEXT_BLK(d0); NEXT_BLK(d1);
        LOAD_BLK(trA, d0); if (d1 >= 0) LOAD_BLK(trB, d1);
        __syncthreads();
        for (;;) {
            tile_store(TB, trA, tid); __syncthreads();
            NEXT_BLK(d2); if (d2 >= 0) LOAD_BLK(trA, d2);
            DO_BLK(d0, TB);
            if (d1 < 0) break;
            tile_store(TB + TILE_BYTES, trB, tid); __syncthreads();
            NEXT_BLK(d0); if (d0 >= 0) LOAD_BLK(trB, d0);
            DO_BLK(d1, TB + TILE_BYTES);
            if (d2 < 0) break;
            d1 = d0; d0 = d2;
        }
        FOLD(g2);
#undef NEXT_BLK
#undef LOAD_BLK
#undef FOLD
#undef DO_BLK
#pragma unroll
        for (int i = 0; i < 16; ++i) { out0[i] = PARK[i * 64]; out1[i] = PARK[(16 + i) * 64]; }
    }
    bf16* MIX = wsp<bf16>(C, WS_MIX) + m * DM + 1024 + head * 64;
    if (!skipblk)
#pragma unroll
    for (int i4 = 0; i4 < 4; ++i4) {
        v2u o; o.x = pk2(out0[4 * i4], out0[4 * i4 + 1]); o.y = pk2(out0[4 * i4 + 2], out0[4 * i4 + 3]); *(v2u*)(MIX + 8 * i4 + 4 * hi) = o;
        o.x = pk2(out1[4 * i4], out1[4 * i4 + 1]); o.y = pk2(out1[4 * i4 + 2], out1[4 * i4 + 3]); *(v2u*)(MIX + 32 + 8 * i4 + 4 * hi) = o;
    }
}

template <class RowFn> DI void samp_block(const RowFn& rowptr, int nvalid, int kvh, const LAS float* QS, LAS float* PWw, int lane, float (&M)[4], float (&L)[4], float (&O)[4]) {
    float s[4] = {0.f, 0.f, 0.f, 0.f};
    const bool ok = lane < nvalid;
    if (ok) {
        const f32x4* kr = (const f32x4*)(rowptr(lane) + kvh * 64);
#pragma unroll 4
        for (int d4 = 0; d4 < 16; ++d4) { const f32x4 kq = kr[d4];
#pragma unroll
            for (int g = 0; g < 4; ++g) { const f32x4 qq = *(const LAS f32x4*)(QS + g * 64 + 4 * d4); s[g] += kq[0] * qq[0] + kq[1] * qq[1] + kq[2] * qq[2] + kq[3] * qq[3]; } }
    }
    float mb[4], lb[4];
#pragma unroll
    for (int g = 0; g < 4; ++g) { const float sv = ok ? s[g] : NEG_BIG; mb[g] = wave_max(sv); const float p = ok ? expf(sv - mb[g]) : 0.f; lb[g] = wave_sum(p); PWw[g * 64 + lane] = p; }
    LDS_WAIT(); asm volatile("" ::: "memory");
    float ob[4] = {0.f, 0.f, 0.f, 0.f};
    for (int r0 = 0; r0 < nvalid; r0 += 4) {
        float vv[4];
#pragma unroll
        for (int u = 0; u < 4; ++u) vv[u] = r0 + u < nvalid ? rowptr(r0 + u)[256 + kvh * 64 + lane] : 0.f;
#pragma unroll
        for (int u = 0; u < 4; ++u)
#pragma unroll
            for (int g = 0; g < 4; ++g) ob[g] += PWw[g * 64 + r0 + u] * vv[u]; }
    LDS_WAIT(); asm volatile("" ::: "memory");
#pragma unroll
    for (int g = 0; g < 4; ++g) { const float mn = fmaxf(M[g], mb[g]); const float a = expf(M[g] - mn), bsc = expf(mb[g] - mn); L[g] = L[g] * a + lb[g] * bsc; O[g] = O[g] * a + ob[g] * bsc; M[g] = mn; }
}
DI float samp_combine(LAS float* WST, int tid, int lane, int wave, const float (&M)[4], const float (&L)[4], const float (&O)[4]) {
    __syncthreads();
#pragma unroll
    for (int g = 0; g < 4; ++g) { WST[wave * 264 + 8 + g * 64 + lane] = O[g]; if (lane == 0) { WST[wave * 264 + g] = M[g]; WST[wave * 264 + 4 + g] = L[g]; } }
    __syncthreads();
    float res = 0.f;
    if (tid < 256) { const int g = tid >> 6, d = tid & 63; float mm = NEG_BIG;
#pragma unroll
        for (int w = 0; w < 8; ++w) mm = fmaxf(mm, WST[w * 264 + g]);
        float ll = 0.f, oo = 0.f;
#pragma unroll
        for (int w = 0; w < 8; ++w) { const float e = expf(WST[w * 264 + g] - mm); ll += WST[w * 264 + 4 + g] * e; oo += WST[w * 264 + 8 + g * 64 + d] * e; }
        res = oo / ll; }
    return res;
}

DI void nsa_sample_item(const Ctx& C, int l, int b, int t, int kvh) {
    const int tid = C.tid, lane = C.lane, wave = C.wave;
    LAS float* F = (LAS float*)C.lds;
    LAS float *QS = F, *PC = F + 256, *IMPS = F + 2304, *RED = F + 2624, *RED2 = F + 2688, *OCP = F + 2752, *PW = F + 4800, *WST = F + 6848;
    LAS int* SELB = (LAS int*)(F + 2560);
    const bf16* P = wsp<bf16>(C, WS_PROJ);
    const size_t m = (size_t)NTP + b * 4 + t;
    __syncthreads();
    if (tid < 256) QS[tid] = bf2f(P[m * PLD + Q_OFF + kvh * 256 + tid]) * 0.125f;
    __syncthreads();
    float ocmp = 0.f;
    {
        const float* KC = wsp<float>(C, WS_KCBS) + ((size_t)((l * 8 + b) * 4 + kvh) * 512) * 64;
        const float* VC = wsp<float>(C, WS_VCBS) + ((size_t)((l * 8 + b) * 4 + kvh) * 512) * 64;
        float s[4] = {0.f, 0.f, 0.f, 0.f};
        const f32x4* kr = (const f32x4*)(KC + (size_t)tid * 64);
#pragma unroll 4
        for (int d4 = 0; d4 < 16; ++d4) { const f32x4 kq = kr[d4];
#pragma unroll
            for (int g = 0; g < 4; ++g) { const f32x4 qq = *(const LAS f32x4*)(QS + g * 64 + 4 * d4); s[g] += kq[0] * qq[0] + kq[1] * qq[1] + kq[2] * qq[2] + kq[3] * qq[3]; } }
#pragma unroll
        for (int g = 0; g < 4; ++g) { const float wm = wave_max(s[g]); if (lane == 0) RED[wave * 4 + g] = wm; }
        __syncthreads();
        float p[4];
#pragma unroll
        for (int g = 0; g < 4; ++g) { float mm = RED[g];
#pragma unroll
            for (int w = 1; w < 8; ++w) mm = fmaxf(mm, RED[w * 4 + g]);
            p[g] = expf(s[g] - mm); const float ws = wave_sum(p[g]); if (lane == 0) RED2[wave * 4 + g] = ws; }
        __syncthreads();
#pragma unroll
        for (int g = 0; g < 4; ++g) { float tot = 0.f;
#pragma unroll
            for (int w = 0; w < 8; ++w) tot += RED2[w * 4 + g];
            PC[g * 512 + tid] = p[g] / tot; }
        __syncthreads();
        if (tid < 256) IMPS[tid] = (PC[2 * tid] + PC[2 * tid + 1]) + (PC[512 + 2 * tid] + PC[512 + 2 * tid + 1]) + (PC[1024 + 2 * tid] + PC[1024 + 2 * tid + 1]) + (PC[1536 + 2 * tid] + PC[1536 + 2 * tid + 1]);
        { const int d = tid & 63, nq = tid >> 6; float acc[4] = {0.f, 0.f, 0.f, 0.f};
#pragma unroll 4
            for (int n = nq * 64; n < nq * 64 + 64; ++n) { const float vv = VC[(size_t)n * 64 + d];
#pragma unroll
                for (int g = 0; g < 4; ++g) acc[g] += PC[g * 512 + n] * vv; }
#pragma unroll
            for (int g = 0; g < 4; ++g) OCP[(nq * 4 + g) * 64 + d] = acc[g]; }
        __syncthreads();
        if (tid < 256) { const int g = tid >> 6, d = tid & 63;
#pragma unroll
            for (int nq = 0; nq < 8; ++nq) ocmp += OCP[(nq * 4 + g) * 64 + d];
            const int j = tid;
            if (j >= 1 && j <= 254) { const float v = IMPS[j]; int rank = 0;
                for (int jp = 1; jp <= 254; ++jp) { const float ov = IMPS[jp]; rank += (ov > v || (ov == v && jp < j)) ? 1 : 0; }
                if (rank < 13) SELB[rank] = j; }
            if (tid == 0) { SELB[13] = 0; SELB[14] = 255; SELB[15] = 256; }
        }
        __syncthreads();
    }
    float osel;
    {
        float M[4] = {NEG_BIG, NEG_BIG, NEG_BIG, NEG_BIG}, L[4] = {0.f, 0.f, 0.f, 0.f}, O[4] = {0.f, 0.f, 0.f, 0.f};
        const int* pt = (const int*)C.inp(4) + b * 128;
        for (int bi = 0; bi < 2; ++bi) {
            const int jb = __builtin_amdgcn_readfirstlane(SELB[2 * wave + bi]);
            if (jb < 256) { const int pid = pt[jb >> 1];
                const float* base = C.inp(3) + ((size_t)(l * NPOOL + pid) * 128 + (jb & 1) * 64) * 512;
                samp_block([&](int r) { return base + (size_t)r * 512; }, 64, kvh, QS, PW + wave * 256, lane, M, L, O);
            } else { const float* base = C.out + O_SEL_S + ((size_t)l * NTS + b * 4) * 512;
                samp_block([&](int r) { return base + (size_t)r * 512; }, t + 1, kvh, QS, PW + wave * 256, lane, M, L, O); }
        }
        osel = samp_combine(WST, tid, lane, wave, M, L, O);
    }
    float owin;
    {
        float M[4] = {NEG_BIG, NEG_BIG, NEG_BIG, NEG_BIG}, L[4] = {0.f, 0.f, 0.f, 0.f}, O[4] = {0.f, 0.f, 0.f, 0.f};
        const float* pre = C.inp(5) + (size_t)(l * 8 + b) * 262144;
        const float* nw = C.out + O_WIN_S + ((size_t)(l * 8 + b) * 512 + 508) * 512;
        samp_block([&](int r) { const int p = t + 1 + 64 * wave + r; return p <= 511 ? pre + (size_t)p * 512 : nw + (size_t)(p - 512) * 512; }, 64, kvh, QS, PW + wave * 256, lane, M, L, O);
        owin = samp_combine(WST, tid, lane, wave, M, L, O);
    }
    if (tid < 256) { const int g = tid >> 6, d = tid & 63, head = kvh * 4 + g;
        const float g0 = sigmoidf_(bf2f(P[m * PLD + GL_OFF + head * 3 + 0])), g1 = sigmoidf_(bf2f(P[m * PLD + GL_OFF + head * 3 + 1])), g2 = sigmoidf_(bf2f(P[m * PLD + GL_OFF + head * 3 + 2]));
        const float o = g0 * ocmp + g1 * osel + g2 * owin;
        wsp<bf16>(C, WS_MIX)[m * DM + 1024 + head * 64 + d] = (unsigned short)(pk2(o, 0.f) & 0xffffu); }
}

#ifndef C_MASK
#define C_MASK 7
#endif
constexpr int PC_SCAN_P = 128, PC_ATT_P = 512, PC_ATT_S = 128, PC_SCAN_S = 128, PC_ITEMS = PC_SCAN_P + PC_ATT_P + PC_ATT_S + PC_SCAN_S;
DI void phase_c(const Ctx& C0, int lq, int cmask = 7) {
    const int l = lq & 1;
    LAS int* slot = (LAS int*)(C0.lds + MISC_OFF + 64);
    for (;;) {
        __syncthreads();
        if (C0.tid == 0) *slot = (int)atomicAdd(C0.ctl + CW_QUEUE + 64 * lq, 1u);
        __syncthreads();
        int it = *slot;
        if (it >= PC_ITEMS) {
            if (lq != 0 || it - PC_ITEMS >= DEF_GROUPS) break;
            Ctx K = C0; { K.ws = launder_g(K.ws); K.out = launder_g(K.out); int t_ = K.tid; asm volatile("" : "+v"(t_)); K.tid = t_; K.lane = t_ & 63; K.wave = __builtin_amdgcn_readfirstlane(t_ >> 6); }
            for (int e = 0; e < 4; ++e) deferred_item(K, (it - PC_ITEMS) * 4 + e);
            continue;
        }
        Ctx K = C0; { K.ws = launder_g(K.ws); K.out = launder_g(K.out); int t_ = K.tid; asm volatile("" : "+v"(t_)); K.tid = t_; K.lane = t_ & 63; K.wave = __builtin_amdgcn_readfirstlane(t_ >> 6); }
        const Ctx& C = K;
        if (it >= PC_SCAN_P && it < PC_SCAN_P + PC_ATT_S) it += PC_ATT_P; else if (it >= PC_SCAN_P + PC_ATT_S && it < PC_SCAN_P + PC_ATT_S + PC_ATT_P) it -= PC_ATT_S;
        if (it < PC_SCAN_P || it >= PC_SCAN_P + PC_ATT_P + PC_ATT_S) {
            int row0, T, h; const float* S0; float* So;
            int cmode = 0;
            if (it < PC_SCAN_P) { const int u = it & 63, b = u >> 4; cmode = it < 64 ? 1 : 0; h = u & 15; row0 = b * 2048; T = 2048; S0 = nullptr; So = C.out + O_RW_P + ((size_t)(l * 4 + b) * 16 + h) * 4096; }
            else { const int u = it - (PC_SCAN_P + PC_ATT_P + PC_ATT_S), b = u >> 4; h = u & 15; row0 = NTP + b * 4; T = 4; S0 = C.inp(6) + ((size_t)(l * 8 + b) * 16 + h) * 4096; So = C.out + O_RW_S + ((size_t)(l * 8 + b) * 16 + h) * 4096; }
            if (cmask & 1) { if (S0) scan_head(C, l, row0, T, h, S0, So); else if (cmode) chunk_head<1>(C, l, row0 >> 11, h, So, cmode); else chunk_head<0>(C, l, row0 >> 11, h, So, 0); }
        } else if (it < PC_SCAN_P + PC_ATT_P) {
            const int u = it - PC_SCAN_P, qt = 31 - (u >> 4), bk = u & 15;
            if (cmask & 2) nsa_prompt_unit(C, l, bk >> 2, bk & 3, qt, (cmask & 8) != 0, (cmask & 16) != 0);
        } else {
            const int u = it - (PC_SCAN_P + PC_ATT_P);
            if (cmask & 4) nsa_sample_item(C, l, u >> 4, (u >> 2) & 3, u & 3);
        }
    }
    __syncthreads();
}

DI const float* xin_row(const Ctx& C, int l, size_t m) {
    if (l == 0) return m < (size_t)NTP ? C.inp(0) + m * DM : C.inp(1) + (m - NTP) * DM;
    return wsp<float>(C, WS_XF1) + m * DM;
}
DI void phase_e(const Ctx& C, int l) {
    const int lane = C.lane;
    const bf16* H = wsp<bf16>(C, WS_HS);
    bf16* X1B = wsp<bf16>(C, WS_X1B); const bf16* XB = wsp<bf16>(C, WS_XB);
    const float* gw = C.inp(22) + (size_t)l * DM; const float* bw = C.inp(23) + (size_t)l * DM;
    for (int m = blockIdx.x * NWAVES + C.wave; m < NT; m += C.G * NWAVES) {
        const v2u* hr = (const v2u*)(H + (size_t)m * DM) + lane;
        f32x4 v[8]; float s = 0.f;
        if (l == 0) { const f32x4* xr = (const f32x4*)xin_row(C, l, m) + lane;
#pragma unroll
            for (int j = 0; j < 8; ++j) { const v2u hb = hr[64 * j]; v[j] = xr[64 * j] * DN_ALPHA + (f32x4){bflo(hb.x), bfhi(hb.x), bflo(hb.y), bfhi(hb.y)}; }
        } else { const v2u* xr = (const v2u*)(XB + (size_t)m * DM) + lane;
#pragma unroll
            for (int j = 0; j < 8; ++j) { const v2u hb = hr[64 * j], xb = xr[64 * j]; v[j] = (f32x4){bflo(xb.x), bfhi(xb.x), bflo(xb.y), bfhi(xb.y)} * DN_ALPHA + (f32x4){bflo(hb.x), bfhi(hb.x), bflo(hb.y), bfhi(hb.y)}; } }
#pragma unroll
        for (int j = 0; j < 8; ++j) s += (v[j][0] + v[j][1]) + (v[j][2] + v[j][3]);
        const float mean = wave_sum(s) * (1.f / DM); float s2 = 0.f;
#pragma unroll
        for (int j = 0; j < 8; ++j) { v[j] = v[j] - mean; s2 += (v[j][0] * v[j][0] + v[j][1] * v[j][1]) + (v[j][2] * v[j][2] + v[j][3] * v[j][3]); }
        const float rstd = 1.f / sqrtf(wave_sum(s2) * (1.f / DM) + LN_EPS);
        float am = 0.f;
#pragma unroll
        for (int j = 0; j < 8; ++j) { const f32x4 gg = ((const f32x4*)gw)[lane + 64 * j], bb = ((const f32x4*)bw)[lane + 64 * j];
            const f32x4 o = v[j] * rstd * gg + bb; v[j] = o;
            am = fmaxf(am, fmaxf(fmaxf(fabsf(o[0]), fabsf(o[1])), fmaxf(fabsf(o[2]), fabsf(o[3]))));
            v2u p; p.x = pk2(o[0], o[1]); p.y = pk2(o[2], o[3]); ((v2u*)(X1B + (size_t)m * DM))[lane + 64 * j] = p; }
        am = wave_max(am);
        const float qs = am > 0.f ? am * (1.f / 127.f) : 1.f, qi = 1.f / qs;
#pragma unroll
        for (int j = 0; j < 8; ++j) { const f32x4 x = v[j] * qi;
            ((unsigned*)(C.ws + WS_X1Q + (size_t)m * DM))[lane + 64 * j] = ((unsigned)(int)__builtin_rintf(x[0]) & 255u) | (((unsigned)(int)__builtin_rintf(x[1]) & 255u) << 8) | (((unsigned)(int)__builtin_rintf(x[2]) & 255u) << 16) | ((unsigned)(int)__builtin_rintf(x[3]) << 24); }
        if (lane == 0) wsp<float>(C, WS_XQS)[m] = qs;
    }
}

DI float gelu_erf(float x) { return 0.5f * x * (1.f + erff(x * 0.70710678118654752f)); }
DI unsigned fkey(float f) { const unsigned u = __builtin_bit_cast(unsigned, f); return u ^ ((unsigned)((int)u >> 31) | 0x80000000u); }
DI int mbcnt64(unsigned long long m) { return __builtin_amdgcn_mbcnt_hi((unsigned)(m >> 32), __builtin_amdgcn_mbcnt_lo((unsigned)m, 0)); }
template <int NV, bool LANE_MAJOR> DI void top16(const unsigned (&key)[NV], bool (&sel)[NV], int (&pos)[NV]) {
    unsigned thr = 0u; bool exact = false;
    for (int bit = 31; bit >= 0; --bit) {
        const unsigned cand = thr | (1u << bit);
        int cnt = 0;
#pragma unroll
        for (int v = 0; v < NV; ++v) cnt += __builtin_popcountll(__ballot(key[v] >= cand));
        if (cnt >= 16) { thr = cand; if (cnt == 16) { exact = true; break; } }
    }
    unsigned long long sm[NV];
    if (exact) {
#pragma unroll
        for (int v = 0; v < NV; ++v) { sel[v] = key[v] >= thr; sm[v] = __ballot(sel[v]); }
    } else {
        unsigned long long eq[NV]; int ngt = 0;
#pragma unroll
        for (int v = 0; v < NV; ++v) { ngt += __builtin_popcountll(__ballot(key[v] > thr)); eq[v] = __ballot(key[v] == thr); }
        const int need = 16 - ngt;
#pragma unroll
        for (int v = 0; v < NV; ++v) { int rk;
            if (LANE_MAJOR) { rk = 0;
#pragma unroll
                for (int w = 0; w < NV; ++w) { rk += mbcnt64(eq[w]); if (w < v) rk += (int)((eq[w] >> (threadIdx.x & 63)) & 1ull); } }
            else { rk = mbcnt64(eq[v]);
#pragma unroll
                for (int w = 0; w < NV; ++w) if (w < v) rk += __builtin_popcountll(eq[w]); }
            sel[v] = key[v] > thr || (key[v] == thr && rk < need); sm[v] = __ballot(sel[v]); }
    }
    int base = 0;
#pragma unroll
    for (int v = 0; v < NV; ++v) { pos[v] = base + mbcnt64(sm[v]); base += __builtin_popcountll(sm[v]); }
}
typedef float f32x2v __attribute__((ext_vector_type(2)));
typedef int v4i __attribute__((ext_vector_type(4)));
typedef int v2i __attribute__((ext_vector_type(2)));
constexpr int PS_NSL = 16, PS_TOKG = 64, PS_NGRP = (NT + PS_TOKG - 1) / PS_TOKG;
static_assert(NT % 8 == 0, "a wave's 8 tokens of a group are all valid or all invalid");
template <int NP, int NV> DI void top16_search(const unsigned (&key)[NP][NV], unsigned (&thr)[NP], bool (&ex)[NP]) {
    int c16[NP];
#pragma unroll
    for (int p = 0; p < NP; ++p) { thr[p] = 0u; c16[p] = 64 * NV; }
    for (unsigned bm = 0x80000000u; bm != 0u; bm >>= 1) {
        unsigned cand[NP]; unsigned long long bl[NP][NV]; int cnt[NP];
#pragma unroll
        for (int p = 0; p < NP; ++p) cand[p] = thr[p] | bm;
#pragma unroll
        for (int p = 0; p < NP; ++p)
#pragma unroll
            for (int v = 0; v < NV; ++v) bl[p][v] = __ballot(key[p][v] >= cand[p]);
#pragma unroll
        for (int p = 0; p < NP; ++p) { cnt[p] = 0;
#pragma unroll
            for (int v = 0; v < NV; ++v) cnt[p] += __builtin_popcountll(bl[p][v]); }
        int diff = 0;
#pragma unroll
        for (int p = 0; p < NP; ++p) { const bool ge = cnt[p] >= 16; thr[p] = ge ? cand[p] : thr[p]; c16[p] = ge ? cnt[p] : c16[p]; diff |= c16[p] ^ 16; }
        if (diff == 0) break;
    }
#pragma unroll
    for (int p = 0; p < NP; ++p) ex[p] = c16[p] == 16;
}
template <int NV, bool LANE_MAJOR> DI void top16_finish(const unsigned (&key)[NV], unsigned thr, bool exact, bool (&sel)[NV], int (&pos)[NV]) {
    unsigned long long sm[NV];
    if (exact) {
#pragma unroll
        for (int v = 0; v < NV; ++v) { sel[v] = key[v] >= thr; sm[v] = __ballot(sel[v]); }
    } else {
        unsigned long long eq[NV]; int ngt = 0;
#pragma unroll
        for (int v = 0; v < NV; ++v) { ngt += __builtin_popcountll(__ballot(key[v] > thr)); eq[v] = __ballot(key[v] == thr); }
        const int need = 16 - ngt;
#pragma unroll
        for (int v = 0; v < NV; ++v) { int rk;
            if (LANE_MAJOR) { rk = 0;
#pragma unroll
                for (int w = 0; w < NV; ++w) { rk += mbcnt64(eq[w]); if (w < v) rk += (int)((eq[w] >> (threadIdx.x & 63)) & 1ull); } }
            else { rk = mbcnt64(eq[v]);
#pragma unroll
                for (int w = 0; w < NV; ++w) if (w < v) rk += __builtin_popcountll(eq[w]); }
            sel[v] = key[v] > thr || (key[v] == thr && rk < need); sm[v] = __ballot(sel[v]); }
    }
    int base = 0;
#pragma unroll
    for (int v = 0; v < NV; ++v) { pos[v] = base + mbcnt64(sm[v]); base += __builtin_popcountll(sm[v]); }
}
DI float row_max16(float v) { v = fmaxf(v, dppf<0xB1>(v)); v = fmaxf(v, dppf<0x4E>(v)); v = fmaxf(v, dppf<0x141>(v)); return fmaxf(v, dppf<0x140>(v)); }
DI float row_sum16(float v) { v += dppf<0xB1>(v); v += dppf<0x4E>(v); v += dppf<0x141>(v); return v + dppf<0x140>(v); }
template <int CTRL, bool BC> DI int dppi(int v) { return __builtin_amdgcn_update_dpp(0, v, CTRL, 0xF, 0xF, BC); }
DI int row_sum16i(int v) { v += dppi<0xB1, false>(v); v += dppi<0x4E, false>(v); v += dppi<0x141, false>(v); v += dppi<0x140, false>(v); return v; }
DI int row_scan16i(int v) { v += dppi<0x111, true>(v); v += dppi<0x112, true>(v); v += dppi<0x114, true>(v); v += dppi<0x118, true>(v); return v; }
DI unsigned row_max16u(unsigned v) { v = max(v, (unsigned)dppi<0xB1, false>((int)v)); v = max(v, (unsigned)dppi<0x4E, false>((int)v)); v = max(v, (unsigned)dppi<0x141, false>((int)v)); return max(v, (unsigned)dppi<0x140, false>((int)v)); }
DI unsigned row_min16u(unsigned v) { v = min(v, (unsigned)dppi<0xB1, false>((int)v)); v = min(v, (unsigned)dppi<0x4E, false>((int)v)); v = min(v, (unsigned)dppi<0x141, false>((int)v)); return min(v, (unsigned)dppi<0x140, false>((int)v)); }
template <int NK> DI unsigned row_top16_search(unsigned (&key)[NK]) {
    unsigned lm = key[0];
#pragma unroll
    for (int j = 1; j < NK; ++j) lm = max(lm, key[j]);
    const unsigned kmax = row_max16u(lm), L = row_min16u(lm), sp1 = kmax - L + 1u;
    const unsigned spw = max(max((unsigned)__builtin_amdgcn_readlane((int)sp1, 0), (unsigned)__builtin_amdgcn_readlane((int)sp1, 16)), max((unsigned)__builtin_amdgcn_readlane((int)sp1, 32), (unsigned)__builtin_amdgcn_readlane((int)sp1, 48)));
    const int B = spw == 0u ? 32 : 32 - __builtin_clz(spw);
    const unsigned M = B == 32 ? 0xFFFFFFFFu : (1u << B) - 1u, off = kmax - M, lo = L - 1u;
#pragma unroll
    for (int j = 0; j < NK; ++j) key[j] = max(key[j], lo) - off;
    unsigned thr = 0u; int c16 = 16 * NK;
    for (unsigned bm = 1u << (B - 1); bm != 0u; bm >>= 1) {
        const unsigned cand = thr | bm; int cnt = 0;
#pragma unroll
        for (int j = 0; j < NK; ++j) cnt += key[j] >= cand ? 1 : 0;
        cnt = row_sum16i(cnt);
        const bool ge = cnt >= 16; thr = ge ? cand : thr; c16 = ge ? cnt : c16;
        if (__ballot(c16 != 16) == 0ull) break;
    }
    return thr;
}
template <int NK> DI void row_top16_place(const unsigned (&key)[NK], unsigned thr, int (&pos)[NK]) {
    int cg = 0, ce = 0;
#pragma unroll
    for (int j = 0; j < NK; ++j) { cg += key[j] > thr ? 1 : 0; ce += key[j] == thr ? 1 : 0; }
    const int pk = cg | (ce << 8);
    const int exc = row_scan16i(pk) - pk, tot = row_sum16i(pk);
    int pg_ = exc & 255, pe_ = (tot & 255) + (exc >> 8);
#pragma unroll
    for (int j = 0; j < NK; ++j) { const bool g = key[j] > thr, e = key[j] == thr; pos[j] = g ? pg_ : (e ? pe_ : 16); pg_ += g ? 1 : 0; pe_ += e ? 1 : 0; }
}
DI void peer_topk(const Ctx& C, int l) {
    const int lane = C.lane, wave = C.wave, n = lane & 15, r = lane >> 4;
    LAS float* WL = (LAS float*)(C.lds + 65536 + 256 + wave * 2048 + r * 384);
    LAS int* WLi = (LAS int*)WL;
    const float* Sc = wsp<float>(C, WS_HS);
    unsigned short* EL = wsp<unsigned short>(C, WS_EL); float* GT = wsp<float>(C, WS_GT);
    static_assert(NT % 4 == 0, "token quads");
    for (int m = 4 * blockIdx.x; m < NT; m += 4 * C.G) {
        const float* sr = Sc + (size_t)(m + r) * DM + wave * 256 + 8 * n;
        f32x4 sv[2][2];
#pragma unroll
        for (int c = 0; c < 2; ++c) { sv[c][0] = *(const f32x4*)(sr + 128 * c); sv[c][1] = *(const f32x4*)(sr + 128 * c + 4); }
#pragma unroll
        for (int c = 0; c < 2; ++c) {
            unsigned key[8]; int pos[8];
#pragma unroll
            for (int j = 0; j < 8; ++j) key[j] = fkey(sv[c][j >> 2][j & 3]);
            const unsigned thr = row_top16_search<8>(key);
            row_top16_place<8>(key, thr, pos);
#pragma unroll
            for (int j = 0; j < 8; ++j) if (pos[j] < 16) { WL[32 * c + pos[j]] = sv[c][j >> 2][j & 3]; WLi[32 * c + 16 + pos[j]] = 8 * n + j; }
        }
        LDS_WAIT(); asm volatile("" ::: "memory");
        {
            const float x0 = WL[n]; const int e0 = WLi[16 + n] * 128;
            float cd[16]; unsigned key[16]; int pos[16];
#pragma unroll
            for (int q = 0; q < 4; ++q) { const f32x4 x1 = *(const LAS f32x4*)(WL + 32 + 4 * q);
#pragma unroll
                for (int e = 0; e < 4; ++e) { cd[4 * q + e] = x0 + x1[e]; key[4 * q + e] = fkey(cd[4 * q + e]); } }
            const unsigned thr = row_top16_search<16>(key);
            row_top16_place<16>(key, thr, pos);
#pragma unroll
            for (int b = 0; b < 16; ++b) if (pos[b] < 16) { WL[64 + pos[b]] = cd[b]; WLi[80 + pos[b]] = e0 + WLi[48 + b]; }
        }
        LDS_WAIT(); asm volatile("" ::: "memory");
        { const float tv = WL[64 + n];
          const float ev = expf(tv - row_max16(tv));
          const float gate = ev / row_sum16(ev);
          EL[(size_t)(m + r) * 128 + wave * 16 + n] = (unsigned short)WLi[80 + n]; GT[(size_t)(m + r) * 128 + wave * 16 + n] = gate; }
        LDS_WAIT(); asm volatile("" ::: "memory");
    }
}
template <int SIDE> DI void peer_sliced(const Ctx& C, int l, int lq) {
    const int tid = C.tid, lane = C.lane, wave = C.wave, pg = lane >> 3, dq = lane & 7;
    LAS int* slot = (LAS int*)(C.lds + MISC_OFF + 64);
    const unsigned char* TAB = C.ws + (SIDE ? WS_VB : WS_UB) + (size_t)l * NEXP * DM;
    const unsigned char* X1Q = C.ws + WS_X1Q;
    const unsigned short* EL = wsp<unsigned short>(C, WS_EL); const float* WP = wsp<float>(C, WS_WP);
    float* PD = wsp<float>(C, WS_PD); float* FO = wsp<float>(C, WS_FO);
    unsigned* const Q0 = C.ctl + CW_SQ + 64 * ((lq * 2 + SIDE) * 16);
    const int s_first = (int)((2u * xb_xcc_id()) & (PS_NSL - 1));
    int k = 0, cslice = s_first;
    unsigned cpend = 0u;
    if (tid == 0) cpend = atomicAdd(Q0 + 64 * cslice, 1u);
    for (;;) {
        __syncthreads();
        if (tid == 0) { int got = -1;
            while (k < PS_NSL) { if (cpend < (unsigned)PS_NGRP) { got = (cslice << 16) | (int)cpend; break; } ++k; if (k < PS_NSL) { cslice = (s_first + k) & (PS_NSL - 1); cpend = atomicAdd(Q0 + 64 * cslice, 1u); } }
            *slot = got;
            if (got >= 0) cpend = atomicAdd(Q0 + 64 * cslice, 1u); }
        __syncthreads();
        const int d = __builtin_amdgcn_readfirstlane(*slot);
        if (d < 0) break;
        const int s = d >> 16, g = d & 0xffff;
        const int t0 = g * PS_TOKG + wave * 8;
        if (t0 >= NT) continue;
        const unsigned char* TS = TAB + (size_t)s * NEXP * 128;
        const unsigned dq16 = (unsigned)dq * 16u;
        v4u E[2][2]; v4u R[2][16]; f32x4 A[2][4]; v4u AQ[2];
        LAS unsigned char* const WB = C.lds + wave * 4352;
        const int wofs = pg * 512 + dq * 64, rofs = (lane >> 3) * 64 + 16 * (((lane & 7) >> 1) ^ ((lane >> 3) & 3)) + 8 * (lane & 1);
#define PS_LOAD_E(b, t) do { const v4u* ep_ = (const v4u*)(EL + (size_t)(t) * 128 + 16 * pg); E[b][0] = ep_[0]; E[b][1] = ep_[1]; } while (0)
#define PS_LOAD_R(b, t) do { \
            _Pragma("unroll") for (int i = 0; i < 16; ++i) { const unsigned w_ = E[b][i >> 3][(i >> 1) & 3]; const unsigned e_ = (i & 1) ? (w_ >> 16) : (w_ & 0xffffu); \
                R[b][i] = *(const v4u*)(TS + ((e_ << 7) | dq16)); } \
            if (SIDE == 0) AQ[b] = *(const v4u*)(X1Q + (size_t)(t) * DM + 128 * s + 16 * dq); \
            else { const f32x4* ap_ = (const f32x4*)(WP + (size_t)(t) * 128 + 16 * pg); _Pragma("unroll") for (int q = 0; q < 4; ++q) A[b][q] = ap_[q]; } } while (0)
        PS_LOAD_E(0, t0); PS_LOAD_E(1, t0 + 1);
        PS_LOAD_R(0, t0);
#pragma unroll
        for (int j = 0; j < 8; ++j) {
            const int b = j & 1, t = t0 + j;
            if (j + 2 < 8) PS_LOAD_E(b, t + 2);
            if (j + 1 < 8) PS_LOAD_R(b ^ 1, t + 1);
            __builtin_amdgcn_sched_barrier(0);
            if (SIDE == 0) {
                int dd[16];
#pragma unroll
                for (int i = 0; i < 16; ++i) { int a = 0;
#pragma unroll
                    for (int q = 0; q < 4; ++q) a = __builtin_amdgcn_sdot4((int)R[b][i][q], (int)AQ[b][q], a, false);
                    dd[i] = a; }
#pragma unroll
                for (int q = 0; q < 4; ++q) *(LAS v4i*)(WB + dq * 528 + pg * 64 + 16 * q) = (v4i){dd[4 * q], dd[4 * q + 1], dd[4 * q + 2], dd[4 * q + 3]};
                v2i rs = {0, 0};
#pragma unroll
                for (int d8 = 0; d8 < 8; ++d8) rs += *(const LAS v2i*)(WB + 8 * lane + 528 * d8);
                *(f32x2v*)(PD + ((size_t)t * PS_NSL + s) * 128 + 2 * lane) = (f32x2v){(float)rs.x, (float)rs.y};
            } else {
                f32x2v acc[8];
#pragma unroll
                for (int q = 0; q < 8; ++q) acc[q] = (f32x2v){0.f, 0.f};
#pragma unroll
                for (int i = 0; i < 16; ++i) { const float w = A[b][i >> 2][i & 3]; const f32x2v w2 = {w, w};
#pragma unroll
                    for (int q = 0; q < 4; ++q) { const int wd = (int)R[b][i][q]; acc[2 * q] += w2 * __builtin_amdgcn_cvt_pk_f32_fp8(wd, false); acc[2 * q + 1] += w2 * __builtin_amdgcn_cvt_pk_f32_fp8(wd, true); } }
#pragma unroll
                for (int q = 0; q < 4; ++q) *(LAS f32x4*)(WB + wofs + 16 * (q ^ (dq & 3))) = (f32x4){acc[2 * q].x, acc[2 * q].y, acc[2 * q + 1].x, acc[2 * q + 1].y};
                f32x2v rs = {0.f, 0.f};
#pragma unroll
                for (int h8 = 0; h8 < 8; ++h8) rs += *(const LAS f32x2v*)(WB + rofs + 512 * h8);
                *(f32x2v*)(FO + (size_t)t * DM + 128 * s + 2 * lane) = rs;
            }
        }
#undef PS_LOAD_E
#undef PS_LOAD_R
    }
}
DI void peer_gelu(const Ctx& C, int l) {
    const unsigned short* EL = wsp<unsigned short>(C, WS_EL); const float* GT = wsp<float>(C, WS_GT); const float* PD = wsp<float>(C, WS_PD); float* WP = wsp<float>(C, WS_WP);
    const float* USC = wsp<float>(C, WS_USC) + (size_t)l * NEXP; const float* VSC = USC + 2 * NEXP; const float* XQS = wsp<float>(C, WS_XQS);
    for (int idx = blockIdx.x * NTHREADS + C.tid; idx < NT * 128; idx += C.G * NTHREADS) {
        const int t = idx >> 7, p = idx & 127; const unsigned e = EL[idx];
        float h = 0.f;
#pragma unroll
        for (int s = 0; s < PS_NSL; ++s) h += PD[((size_t)t * PS_NSL + s) * 128 + p];
        WP[idx] = GT[idx] * gelu_erf(h * USC[e] * XQS[t]) * VSC[e];
    }
}
DI void peer_ln2(const Ctx& C, int l) {
    const int lane = C.lane;
    const bf16* X1B = wsp<bf16>(C, WS_X1B); const float* FO = wsp<float>(C, WS_FO);
    const float* gw = C.inp(28) + (size_t)l * DM; const float* bw = C.inp(29) + (size_t)l * DM;
    for (int m = blockIdx.x * NWAVES + C.wave; m < NT; m += C.G * NWAVES) {
        const v2u* xr = (const v2u*)(X1B + (size_t)m * DM) + lane; const f32x4* fr = (const f32x4*)(FO + (size_t)m * DM) + lane;
        f32x4 v[8]; float s = 0.f;
#pragma unroll
        for (int j = 0; j < 8; ++j) { const v2u xb = xr[64 * j]; v[j] = (f32x4){bflo(xb.x), bfhi(xb.x), bflo(xb.y), bfhi(xb.y)} * DN_ALPHA + fr[64 * j]; s += (v[j][0] + v[j][1]) + (v[j][2] + v[j][3]); }
        const float mean = wave_sum(s) * (1.f / DM); float s2 = 0.f;
#pragma unroll
        for (int j = 0; j < 8; ++j) { v[j] = v[j] - mean; s2 += (v[j][0] * v[j][0] + v[j][1] * v[j][1]) + (v[j][2] * v[j][2] + v[j][3] * v[j][3]); }
        const float rstd = 1.f / sqrtf(wave_sum(s2) * (1.f / DM) + LN_EPS);
#pragma unroll
        for (int j = 0; j < 8; ++j) { const f32x4 gg = ((const f32x4*)gw)[lane + 64 * j], bb = ((const f32x4*)bw)[lane + 64 * j];
            const f32x4 o = v[j] * rstd * gg + bb;
            if (l == 0) {
                v2u p; p.x = pk2(o[0], o[1]); p.y = pk2(o[2], o[3]); ((v2u*)(wsp<bf16>(C, WS_XB) + (size_t)m * DM))[lane + 64 * j] = p; }
            else { float* dst = m < NTP ? C.out + O_YP + (size_t)m * DM : C.out + O_YS + (size_t)(m - NTP) * DM; ((f32x4*)dst)[lane + 64 * j] = o; } }
    }
}

#ifndef PH_MASK
#define PH_MASK 0xFF
#endif
#define IN(k) (lo <= (k) && (k) < hi)
#define EN(s) ((PH_MASK >> (s)) & 1)
#define FRESH(CX) Ctx CX = C; { CX.ws = launder_g(CX.ws); CX.out = launder_g(CX.out); int t_ = CX.tid; asm volatile("" : "+v"(t_)); CX.tid = t_; CX.lane = t_ & 63; CX.wave = __builtin_amdgcn_readfirstlane(t_ >> 6); CX.ctl = (unsigned*)(CX.ws + WS_CTL); }
#ifndef PROBE_REP
#define PROBE_REP 0
#endif
#ifndef PROBE_PMASK
#define PROBE_PMASK 31
#endif
#ifndef PROBE_CMASK
#define PROBE_CMASK 7
#endif
#define NREP(s) (((PROBE_REP >> (s)) & 1) ? 2 : 1)
#ifndef PROBE_G
#define PROBE_G 0
#endif
#define GREP(s) (((PROBE_G >> (s)) & 1) ? 2 : 1)
#define REPBAR(s, rep) do { if (NREP(s) == 2 && (rep) == 0 && (hi - lo) > 1) xcd_barrier(bar); } while (0)
#define SEAM(k) do { if (IN(k) && IN((k) + 1)) xcd_barrier(bar); } while (0)
template <int l> DI void run_layer(const Ctx& C, const XcdBarrier& bar, int lo, int hi) {
        const int pb = 1 + 11 * l;
        _Pragma("unroll") for (int rep = 0; rep < NREP(0); ++rep) if (EN(0) && IN(pb + 0)) {
            FRESH(K);
            pg8::Gemm g{wsp<bf16>(K, WS_XB), wsp<bf16>(K, WS_WIN) + (size_t)l * PLD * DM, NTP, PLD, DM}; pg8::StaticOrder S; S.init(NTP, PLD, K.G, (int)blockIdx.x);
            EpiInProj E{wsp<bf16>(K, WS_PROJ), K.out, l};
            pg8::gemm_phase<EpiInProj, pg8::StaticOrder, true, true>(K.lds, g, S, E);
            { bf16* P = wsp<bf16>(K, WS_PROJ); float* out = K.out;
              skinny_gemm(K, wsp<bf16>(K, WS_XB) + (size_t)NTP * DM, wsp<bf16>(K, WS_WIN) + (size_t)l * PLD * DM, (IN_COLS + 31) / 32, [&](int j, int col, float v) {
                  P[(size_t)(NTP + j) * PLD + col] = (unsigned short)(pk2(v, 0.f) & 0xffffu);
                  const int b = j >> 2, t = j & 3;
                  if (col < RW_COLS) { if (t == 3) out[O_SH_S + (size_t)(l * 8 + b) * RW_COLS + col] = v; }
                  else if (col >= KC_OFF && col < GL_OFF) { const int c = col - KC_OFF, reg = c >> 9, cc = c & 511;
                      if (reg == 0) out[O_CMP_S + ((size_t)l * NTS + j) * 512 + cc] = v; else if (reg == 1) out[O_SEL_S + ((size_t)l * NTS + j) * 512 + cc] = v;
                      else out[O_WIN_S + ((size_t)(l * 8 + b) * 512 + 508 + t) * 512 + cc] = v; } }); }
            REPBAR(0, rep);
        }
        SEAM(pb + 0);
        _Pragma("unroll") for (int rep = 0; rep < NREP(1); ++rep) if (EN(1) && IN(pb + 1)) { FRESH(K); phase_b(K, l, l + 2 * rep); REPBAR(1, rep); }
        SEAM(pb + 1);
        _Pragma("unroll") for (int rep = 0; rep < NREP(2); ++rep) if (EN(2) && IN(pb + 2)) { FRESH(K); phase_c(K, l + 2 * rep, rep == 0 ? 7 : PROBE_CMASK); REPBAR(2, rep); }
        SEAM(pb + 2);
        _Pragma("unroll") for (int rep = 0; rep < NREP(3); ++rep) if (EN(3) && IN(pb + 3)) {
            FRESH(K);
            pg8::Gemm g{wsp<bf16>(K, WS_MIX), wsp<bf16>(K, WS_WOUT) + (size_t)l * DM * DM, NTP, DM, DM}; pg8::StaticOrder S; S.init(NTP, DM, K.G, (int)blockIdx.x);
            EpiBf16Row E{wsp<bf16>(K, WS_HS), DM};
            pg8::gemm_phase<EpiBf16Row, pg8::StaticOrder, true, true>(K.lds, g, S, E);
            { bf16* H = wsp<bf16>(K, WS_HS) + (size_t)NTP * DM;
              skinny_gemm(K, wsp<bf16>(K, WS_MIX) + (size_t)NTP * DM, wsp<bf16>(K, WS_WOUT) + (size_t)l * DM * DM, DM / 32, [&](int j, int col, float v) { H[(size_t)j * DM + col] = (unsigned short)(pk2(v, 0.f) & 0xffffu); }); }
            REPBAR(3, rep);
        }
        SEAM(pb + 3);
        _Pragma("unroll") for (int rep = 0; rep < NREP(4); ++rep) if (EN(4) && IN(pb + 4)) { FRESH(K); phase_e(K, l); REPBAR(4, rep); }
        SEAM(pb + 4);
        _Pragma("unroll") for (int rep = 0; rep < NREP(5); ++rep) if (EN(5) && IN(pb + 5)) {
            FRESH(K);
            pg8::Gemm g{wsp<bf16>(K, WS_X1B), wsp<bf16>(K, WS_W2) + (size_t)l * DM * DM, NTP, DM, DM}; pg8::StaticOrder S; S.init(NTP, DM, K.G, (int)blockIdx.x);
            pg8::EpiF32 E{wsp<float>(K, WS_HS), DM, nullptr};
            pg8::gemm_phase<pg8::EpiF32, pg8::StaticOrder, true, true>(K.lds, g, S, E);
            { float* H = wsp<float>(K, WS_HS) + (size_t)NTP * DM;
              skinny_gemm(K, wsp<bf16>(K, WS_X1B) + (size_t)NTP * DM, wsp<bf16>(K, WS_W2) + (size_t)l * DM * DM, DM / 32, [&](int j, int col, float v) { H[(size_t)j * DM + col] = v; }); }
            REPBAR(5, rep);
        }
        SEAM(pb + 5);
        _Pragma("unroll") for (int rep = 0; rep < GREP(0); ++rep) { if (IN(pb + 6)) { FRESH(K); peer_topk(K, l); } if (GREP(0) == 2 && rep == 0) xcd_barrier(bar); }
        SEAM(pb + 6);
        _Pragma("unroll") for (int rep = 0; rep < GREP(1); ++rep) { if (IN(pb + 7)) { FRESH(K); peer_sliced<0>(K, l, l + 2 * rep); } if (GREP(1) == 2 && rep == 0) xcd_barrier(bar); }
        SEAM(pb + 7);
        _Pragma("unroll") for (int rep = 0; rep < GREP(2); ++rep) { if (IN(pb + 8)) { FRESH(K); peer_gelu(K, l); } if (GREP(2) == 2 && rep == 0) xcd_barrier(bar); }
        SEAM(pb + 8);
        _Pragma("unroll") for (int rep = 0; rep < GREP(3); ++rep) { if (IN(pb + 9)) { FRESH(K); peer_sliced<1>(K, l, l + 2 * rep); } if (GREP(3) == 2 && rep == 0) xcd_barrier(bar); }
        SEAM(pb + 9);
        _Pragma("unroll") for (int rep = 0; rep < GREP(4); ++rep) { if (IN(pb + 10)) { FRESH(K); peer_ln2(K, l); } if (GREP(4) == 2 && rep == 0) xcd_barrier(bar); }
        SEAM(pb + 10);
}
typedef ArgsK Args;
__global__ void __launch_bounds__(NTHREADS, 2) fwd_kernel(Args args) {
    extern __shared__ __attribute__((aligned(16))) unsigned char lds[];
    Ctx C;
    C.out = args.out; C.ws = args.ws; C.lds = (LAS unsigned char*)lds; C.ctl = (unsigned*)(args.ws + WS_CTL);
    C.tid = threadIdx.x; C.lane = C.tid & 63; C.wave = __builtin_amdgcn_readfirstlane(C.tid >> 6); C.G = gridDim.x;
    volatile LAS unsigned* MISC = (volatile LAS unsigned*)(C.lds + MISC_OFF);
    for (int u = C.tid; u < (LDS_BYTES - RING_BYTES) / 4; u += NTHREADS) ((LAS unsigned*)(C.lds + RING_BYTES))[u] = 0u;
    __syncthreads();
    XcdBarrier bar; bar.bar = C.ctl + CW_BAR; bar.x = 0; bar.st = nullptr;
    if (args.use_bar) bar = xcd_barrier_post(C.ctl + CW_BAR, MISC + 8);
    const int lo = args.ph_lo, hi = args.ph_hi;
#ifdef PROBE_DELAY_TICKS
    { const unsigned long long t0 = __builtin_amdgcn_s_memrealtime(); while (__builtin_amdgcn_s_memrealtime() - t0 < (unsigned long long)PROBE_DELAY_TICKS) __builtin_amdgcn_s_sleep(32); }
#endif
#ifdef PROBE_AMPLIFY
    { const unsigned long long t0 = __builtin_amdgcn_s_memrealtime(); xcd_barrier(bar);
      if (blockIdx.x == PROBE_AMPLIFY - 1) { const unsigned long long dt = __builtin_amdgcn_s_memrealtime() - t0; while (__builtin_amdgcn_s_memrealtime() - t0 < 5ull * dt) __builtin_amdgcn_s_sleep(32); } }
#endif
    _Pragma("unroll") for (int rep = 0; rep < NREP(7); ++rep) if (EN(7) && IN(0)) { FRESH(K); p0_prologue(K, NREP(7) == 1 ? 31 : (rep == 0 ? PROBE_PMASK : (31 & ~PROBE_PMASK))); REPBAR(7, rep); }
    SEAM(0);
    run_layer<0>(C, bar, lo, hi);
    run_layer<1>(C, bar, lo, hi);
#undef IN
#undef SEAM
}

#ifndef MK_ONE_LAUNCH
#define MK_ONE_LAUNCH 1
#endif
extern "C" void kernel_launch(void* const* d_in, const int* in_sizes, int n_in, void* d_out, int out_size, void* d_ws, size_t ws_size, hipStream_t stream) {
    static int grid = 0;
    if (grid == 0) {
        if (n_in != 30 || out_size != (int)O_END || ws_size < WS_END) { fprintf(stderr, "kernel_launch: unexpected shapes (n_in %d, out %d, ws %zu < %zu); nothing launched\n", n_in, out_size, ws_size, (size_t)WS_END); grid = -1; return; }
        int dev = 0, cus = 0, per_cu = 0;
        if (hipGetDevice(&dev) != hipSuccess || hipDeviceGetAttribute(&cus, hipDeviceAttributeMultiprocessorCount, dev) != hipSuccess) { grid = -1; return; }
        if (hipFuncSetAttribute((const void*)fwd_kernel, hipFuncAttributeMaxDynamicSharedMemorySize, LDS_BYTES) != hipSuccess) { fprintf(stderr, "kernel_launch: hipFuncSetAttribute failed\n"); grid = -1; return; }
        if (hipOccupancyMaxActiveBlocksPerMultiprocessor(&per_cu, (const void*)fwd_kernel, NTHREADS, LDS_BYTES) != hipSuccess || per_cu < 1) { fprintf(stderr, "kernel_launch: occupancy query says %d blocks per CU\n", per_cu); }
        (void)hipGetLastError();
        grid = cus;
    }
    if (grid < 0) return;
    if (hipMemsetAsync((char*)d_ws + WS_CTL, 0, CTL_ZERO_BYTES, stream) != hipSuccess) return;
    Args a{};
    for (int i = 0; i < 30; ++i) a.in[i] = (const float*)d_in[i];
    a.out = (float*)d_out; a.ws = (unsigned char*)d_ws;
#if MK_ONE_LAUNCH
    a.ph_lo = 0; a.ph_hi = N_PHASES; a.use_bar = 1;
    hipLaunchKernelGGL(fwd_kernel, dim3(grid), dim3(NTHREADS), LDS_BYTES, stream, a);
#else
    for (int p = 0; p < N_PHASES; ++p) { a.ph_lo = p; a.ph_hi = p + 1; a.use_bar = 0; hipLaunchKernelGGL(fwd_kernel, dim3(grid), dim3(NTHREADS), LDS_BYTES, stream, a); }
#endif
}
```

```cpp
#include <hip/hip_runtime.h>
#include <cstdio>
#include <cstdint>
namespace pg8 {
#define PG8_LAS __attribute__((address_space(3)))
typedef unsigned short bf16_t;
typedef short bf16x8 __attribute__((ext_vector_type(8)));
typedef float f32x4 __attribute__((ext_vector_type(4)));
typedef unsigned u32x4 __attribute__((ext_vector_type(4)));
constexpr int BM = 256, BK = 64, HALF = 128, HTB = HALF * BK * 2  , STAGE_BYTES = 8 * HTB, NXCD = 8, WGM = 8;

__host__ __device__ __forceinline__ int lds_byte(int r, int c) { const int st = (r >> 4) * 2 + (c >> 5), rr = r & 15, cc = c & 31, ob = rr * 64 + cc * 2; return st * 1024 + (ob ^ (((ob >> 9) & 1) << 5)); }
__host__ __device__ __forceinline__ void stage_rc(int b, int& R, int& C) { const int st = b / 1024, sb = b % 1024, swz = sb ^ (((sb >> 9) & 1) << 5); R = (st >> 1) * 16 + swz / 64; C = (st & 1) * 32 + (swz % 64) / 2; }
__host__ __device__ __forceinline__ int perm32(int rho) { const int n = rho >> 4, i = rho & 15; return 8 * (i >> 2) + 4 * n + (i & 3); }

struct Unit { int pm, pn; };
struct Gemm { const bf16_t* A; const bf16_t* Bt; int M, N, K; };

struct StaticOrder {
    int nM, nN, nwg, G, c;
    __host__ __device__ void init(int M, int N, int G_, int c_) { nM = M / BM; nN = N / BM; nwg = nM * nN; G = G_; c = c_; }
    __host__ __device__ bool next(int i, Unit& u) const {
        const long L = (long)i * G + c; if (L >= nwg) return false;
        int wgid = (int)L; { const int q = nwg / NXCD, r = nwg % NXCD, xcd = wgid % NXCD, off = wgid / NXCD; wgid = (xcd < r ? xcd * (q + 1) : r * (q + 1) + (xcd - r) * q) + off; }
        const int nig = WGM * nN, gid = wgid / nig, fm = gid * WGM, gsz = (nM - fm) < WGM ? (nM - fm) : WGM;
        u.pm = fm + ((wgid % nig) % gsz); u.pn = (wgid % nig) / gsz; return true;
    }
    __device__ __forceinline__ void a_ready(const Unit&) const {}
    __device__ __forceinline__ void done(const Unit&) const {}
};

__device__ __forceinline__ unsigned cvt_pk_bf16(float lo, float hi) { unsigned r; asm volatile("v_cvt_pk_bf16_f32 %0, %1, %2" : "=v"(r) : "v"(lo), "v"(hi)); return r; }
typedef float f32x2 __attribute__((ext_vector_type(2)));
struct EpiF32 {
    static constexpr bool PERM = false, AFTER_DRAIN = false;
    float* C; int ldc; const float* bias;
    __device__ __forceinline__ void operator()(const f32x4 (&acc)[2][2][4][2], const Unit& u, int wr, int wc, int fr, int fq) const {
        const int row0 = u.pm * BM + wr * 64 + fr, col0 = u.pn * BM + wc * 32 + 4 * fq;
        f32x4 bv[2][2];
#pragma unroll
        for (int bj = 0; bj < 2; ++bj)
#pragma unroll
            for (int n = 0; n < 2; ++n) bv[bj][n] = bias ? *(const f32x4*)(bias + col0 + bj * HALF + n * 16) : (f32x4){0.f, 0.f, 0.f, 0.f};
#pragma unroll
        for (int ai = 0; ai < 2; ++ai)
#pragma unroll
            for (int m = 0; m < 4; ++m) { float* rowp = C + (size_t)(row0 + ai * HALF + m * 16) * ldc + col0;
#pragma unroll
                for (int bj = 0; bj < 2; ++bj)
#pragma unroll
                    for (int n = 0; n < 2; ++n) *(f32x4*)(rowp + bj * HALF + n * 16) = acc[ai][bj][m][n] + bv[bj][n]; }
    }
};
template <class Epi, class Sched, bool ALIGN_EPI = false, bool SP2 = false>
__device__ __forceinline__ void gemm_phase(PG8_LAS unsigned char* lds, const Gemm g, const Sched& S, const Epi& E) {
    const int tid = threadIdx.x, wid = __builtin_amdgcn_readfirstlane(tid >> 6), lane = tid & 63, wr = wid >> 2, wc = wid & 3, fr = lane & 15, fq = lane >> 4;
    const int K = g.K, nt = K / BK;
    unsigned voffA[2], voffB[2];
#pragma unroll
    for (int i = 0; i < 2; ++i) { int R, C; stage_rc(tid * 16 + i * 8192, R, C); const int Rb = Epi::PERM ? ((R & ~31) + perm32(R & 31)) : R;
        voffA[i] = (unsigned)(R * K + C) * 2u; voffB[i] = (unsigned)(Rb * K + C) * 2u; }
    const size_t kstep = (size_t)(BK * 2);
    const size_t hstep = (size_t)HALF * K * 2;
    const size_t tstep = 2 * hstep;
    const unsigned ldsw = (unsigned)wid * 1024u;
    const int aoff = lds_byte(wr * 64 + fr, fq * 8), boff = lds_byte(wc * 32 + fr, fq * 8);
#define PG8_SA(b, h) (((b) * 2 + (h)) * HTB)
#define PG8_SB(b, h) ((4 + (b) * 2 + (h)) * HTB)
#define PG8_STAGE(bufoff, gbase, voff) do { _Pragma("unroll") for (int _i = 0; _i < 2; ++_i) \
        __builtin_amdgcn_global_load_lds((const unsigned*)((const char*)(gbase) + (voff)[_i]), (PG8_LAS unsigned*)(lds + (bufoff) + ldsw + _i * 8192), 16, 0, 0); } while (0)
#define PG8_LDA(dst, b, h) do { _Pragma("unroll") for (int m = 0; m < 4; ++m) _Pragma("unroll") for (int k = 0; k < 2; ++k) dst[m][k] = *(const PG8_LAS bf16x8*)(lds + PG8_SA(b, h) + aoff + m * 2048 + k * 1024); } while (0)
#define PG8_LDB(dst, b, h) do { _Pragma("unroll") for (int n = 0; n < 2; ++n) _Pragma("unroll") for (int k = 0; k < 2; ++k) dst[n][k] = *(const PG8_LAS bf16x8*)(lds + PG8_SB(b, h) + boff + n * 2048 + k * 1024); } while (0)
#define PG8_MMA(ai, bj, At, Bt) do { __builtin_amdgcn_s_setprio(1); _Pragma("unroll") for (int m = 0; m < 4; ++m) _Pragma("unroll") for (int n = 0; n < 2; ++n) _Pragma("unroll") for (int k = 0; k < 2; ++k) \
        acc[ai][bj][m][n] = __builtin_amdgcn_mfma_f32_16x16x32_bf16(Bt[n][k], At[m][k], acc[ai][bj][m][n], 0, 0, 0); __builtin_amdgcn_s_setprio(0); } while (0)
#define PG8_WAIT_V(n) asm volatile("s_waitcnt vmcnt(" #n ")" ::: "memory")
#define PG8_WAIT_L(n) asm volatile("s_waitcnt lgkmcnt(" #n ")" ::: "memory")
#define PG8_BAR __builtin_amdgcn_s_barrier()
#define PG8_SCHED __builtin_amdgcn_sched_barrier(0)
    Unit cur, nxt; int ui = 0;
    if (!S.next(0, cur)) return;
    f32x4 acc[2][2][4][2];
#pragma unroll
    for (int a = 0; a < 2; ++a)
#pragma unroll
        for (int b = 0; b < 2; ++b)
#pragma unroll
            for (int m = 0; m < 4; ++m)
#pragma unroll
                for (int n = 0; n < 2; ++n) acc[a][b][m][n] = (f32x4){0.f, 0.f, 0.f, 0.f};
    bf16x8 At[4][2], B0[2][2], B1[2][2];
    const char* cA = (const char*)g.A + (size_t)cur.pm * tstep; const char* cB = (const char*)g.Bt + (size_t)cur.pn * tstep;
    S.a_ready(cur);
    if constexpr (SP2) {
        PG8_STAGE(PG8_SB(0, 0), cB, voffB); PG8_STAGE(PG8_SB(0, 1), cB + hstep, voffB); PG8_STAGE(PG8_SA(0, 0), cA, voffA); PG8_STAGE(PG8_SA(0, 1), cA + hstep, voffA);
        if (wr == 1) PG8_BAR;
        PG8_WAIT_V(2); PG8_BAR;
        PG8_STAGE(PG8_SB(1, 0), cB + kstep, voffB); PG8_STAGE(PG8_SA(1, 0), cA + kstep, voffA); PG8_STAGE(PG8_SB(1, 1), cB + hstep + kstep, voffB);
        PG8_WAIT_V(6); PG8_BAR;
    } else {
        PG8_STAGE(PG8_SB(0, 0), cB, voffB); PG8_STAGE(PG8_SA(0, 0), cA, voffA); PG8_STAGE(PG8_SB(0, 1), cB + hstep, voffB); PG8_STAGE(PG8_SA(0, 1), cA + hstep, voffA);
        if (wr == 1) PG8_BAR;
        PG8_WAIT_V(4); PG8_BAR;
        PG8_STAGE(PG8_SB(1, 0), cB + kstep, voffB); PG8_STAGE(PG8_SA(1, 0), cA + kstep, voffA); PG8_STAGE(PG8_SB(1, 1), cB + hstep + kstep, voffB);
        PG8_WAIT_V(6); PG8_BAR;
    }
    for (;;) {
        const bool has_next = S.next(ui + 1, nxt);
        const char* nA = has_next ? (const char*)g.A + (size_t)nxt.pm * tstep : cA; const char* nB = has_next ? (const char*)g.Bt + (size_t)nxt.pn * tstep : cB;
        for (int t = 0; t < nt; t += 2) {
            const bool last = (t == nt - 2);
            const char* a1 = cA + (size_t)(t + 1) * kstep;
            const char* a2 = last ? nA : cA + (size_t)(t + 2) * kstep; const char* b2 = last ? nB : cB + (size_t)(t + 2) * kstep;
            const char* a3 = a2 + kstep; const char* b3 = b2 + kstep;
            if (last && has_next) S.a_ready(nxt);
            if constexpr (SP2) {
            PG8_LDB(B0, 0, 0); PG8_LDB(B1, 0, 1); PG8_SCHED; PG8_LDA(At, 0, 0); PG8_STAGE(PG8_SA(1, 1), a1 + hstep, voffA);
            PG8_WAIT_V(8); PG8_WAIT_L(0); PG8_BAR; PG8_MMA(0, 0, At, B0); PG8_MMA(0, 1, At, B1); PG8_BAR; PG8_SCHED;
            PG8_LDA(At, 0, 1); PG8_STAGE(PG8_SB(0, 0), b2, voffB); PG8_STAGE(PG8_SB(0, 1), b2 + hstep, voffB); PG8_STAGE(PG8_SA(0, 0), a2, voffA);
            PG8_WAIT_V(8); PG8_WAIT_L(0); PG8_BAR; PG8_MMA(1, 0, At, B0); PG8_MMA(1, 1, At, B1); PG8_BAR; PG8_SCHED;
            PG8_LDB(B0, 1, 0); PG8_LDB(B1, 1, 1); PG8_SCHED; PG8_LDA(At, 1, 0); PG8_STAGE(PG8_SA(0, 1), a2 + hstep, voffA);
            PG8_WAIT_V(8); PG8_WAIT_L(0); PG8_BAR; PG8_MMA(0, 0, At, B0); PG8_MMA(0, 1, At, B1); PG8_BAR; PG8_SCHED;
            PG8_LDA(At, 1, 1); PG8_STAGE(PG8_SB(1, 0), b3, voffB); PG8_STAGE(PG8_SB(1, 1), b3 + hstep, voffB); PG8_STAGE(PG8_SA(1, 0), a3, voffA);
            PG8_WAIT_V(8); PG8_WAIT_L(0); PG8_BAR; PG8_MMA(1, 0, At, B0); PG8_MMA(1, 1, At, B1); PG8_BAR; PG8_SCHED;
            } else {
            PG8_LDB(B0, 0, 0); PG8_SCHED; PG8_LDA(At, 0, 0); PG8_STAGE(PG8_SA(1, 1), a1 + hstep, voffA);
            PG8_WAIT_L(8); PG8_BAR; PG8_WAIT_L(0); PG8_MMA(0, 0, At, B0); PG8_BAR; PG8_SCHED;
            PG8_LDB(B1, 0, 1); PG8_STAGE(PG8_SB(0, 0), b2, voffB);
            PG8_BAR; PG8_WAIT_L(0); PG8_MMA(0, 1, At, B1); PG8_BAR;
            PG8_LDA(At, 0, 1); PG8_STAGE(PG8_SA(0, 0), a2, voffA);
            PG8_BAR; PG8_WAIT_L(0); PG8_MMA(1, 0, At, B0); PG8_BAR; PG8_SCHED;
            PG8_STAGE(PG8_SB(0, 1), b2 + hstep, voffB);
            PG8_WAIT_V(6); PG8_BAR; PG8_MMA(1, 1, At, B1); PG8_BAR;
            PG8_LDB(B0, 1, 0); PG8_SCHED; PG8_LDA(At, 1, 0); PG8_STAGE(PG8_SA(0, 1), a2 + hstep, voffA);
            PG8_WAIT_L(8); PG8_BAR; PG8_WAIT_L(0); PG8_MMA(0, 0, At, B0); PG8_BAR; PG8_SCHED;
            PG8_LDB(B1, 1, 1); PG8_STAGE(PG8_SB(1, 0), b3, voffB);
            PG8_BAR; PG8_WAIT_L(0); PG8_MMA(0, 1, At, B1); PG8_BAR;
            PG8_LDA(At, 1, 1); PG8_STAGE(PG8_SA(1, 0), a3, voffA);
            PG8_BAR; PG8_WAIT_L(0); PG8_MMA(1, 0, At, B0); PG8_BAR; PG8_SCHED;
            PG8_STAGE(PG8_SB(1, 1), b3 + hstep, voffB);
            PG8_WAIT_V(6); PG8_BAR; PG8_MMA(1, 1, At, B1); PG8_BAR;
            }
        }
        if constexpr (ALIGN_EPI) { if (wr == 0) PG8_BAR; }
        if constexpr (!Epi::AFTER_DRAIN) { E(acc, cur, wr, wc, fr, fq); S.done(cur); }
        if (!has_next) break;
#pragma unroll
        for (int a = 0; a < 2; ++a)
#pragma unroll
            for (int b = 0; b < 2; ++b)
#pragma unroll
                for (int m = 0; m < 4; ++m)
#pragma unroll
                    for (int n = 0; n < 2; ++n) acc[a][b][m][n] = (f32x4){0.f, 0.f, 0.f, 0.f};
        cur = nxt; cA = nA; cB = nB; ++ui;
        if constexpr (ALIGN_EPI) { if (wr == 1) PG8_BAR; }
    }
    PG8_WAIT_V(0);
    if constexpr (!ALIGN_EPI) { if (wr == 0) PG8_BAR; }
    PG8_BAR;
    if constexpr (Epi::AFTER_DRAIN) { E.fused(acc, cur, wr, wc, fr, fq, lds, wid, lane); S.done(cur); }
#undef PG8_SA
#undef PG8_SB
#undef PG8_STAGE
#undef PG8_LDA
#undef PG8_LDB
#undef PG8_MMA
#undef PG8_WAIT_V
#undef PG8_WAIT_L
#undef PG8_BAR
#undef PG8_SCHED
}
}
#define LAS __attribute__((address_space(3)))
#define XB_TMO      128
#define XB_XCNT(j)  (256  + 64 * (j))
#define XB_XSUB(j)  (1280 + 64 * (j))
#define XB_XGEN(j)  (2304 + 64 * (j))
#define XB_TOP      3328
#define XB_TOPGEN   3392
#define XCD_BAR_WORDS 3456
#define XB_SPIN_CAP (1u << 18)

__device__ __forceinline__ unsigned xb_ld(unsigned* p)              { return __hip_atomic_load(p, __ATOMIC_RELAXED, __HIP_MEMORY_SCOPE_AGENT); }
__device__ __forceinline__ unsigned xb_add(unsigned* p, unsigned v) { return __hip_atomic_fetch_add(p, v, __ATOMIC_RELAXED, __HIP_MEMORY_SCOPE_AGENT); }
__device__ __forceinline__ unsigned xb_xcc_id() { return (unsigned)__builtin_amdgcn_s_getreg((3 << 11) | 20) & 0xFu; }
#define XB_SPIN(cond, bar) do { unsigned _sp = 0; while (cond) { __builtin_amdgcn_s_sleep(1); \
    if ((++_sp & 255u) == 0u) { if (xb_ld(&(bar)[XB_TMO])) break; if (_sp > XB_SPIN_CAP) { atomicAdd(&(bar)[XB_TMO], 1u); break; } } } } while (0)

struct XcdBarrier {
    unsigned* bar; unsigned x;
    volatile LAS unsigned* st;
};

__device__ __forceinline__ XcdBarrier xcd_barrier_post(unsigned* bar, volatile LAS unsigned* st) {
    XcdBarrier b; b.bar = bar; b.x = xb_xcc_id(); b.st = st;
    if (threadIdx.x == 0) (void)xb_add(&bar[XB_XCNT(b.x)], 1u);
    return b;
}
__device__ __forceinline__ void xcd_barrier_complete(unsigned* bar, unsigned x, unsigned& nloc, unsigned& nx) {
    const unsigned G = gridDim.x * gridDim.y * gridDim.z;
    unsigned sum, cnt, mine, sp = 0u;
    for (;;) {
        sum = 0u; cnt = 0u; mine = 0u;
#pragma unroll
        for (unsigned j = 0; j < 16; ++j) { const unsigned c = xb_ld(&bar[XB_XCNT(j)]); sum += c; cnt += (c > 0u) ? 1u : 0u; mine = (j == x) ? c : mine; }
        if (sum == G) break;
        __builtin_amdgcn_s_sleep(1);
        if ((++sp & 255u) == 0u) { if (xb_ld(&bar[XB_TMO])) break; if (sp > XB_SPIN_CAP) { atomicAdd(&bar[XB_TMO], 1u); break; } }
    }
    nloc = mine > 0u ? mine : 1u; nx = cnt > 0u ? cnt : 1u;
}

__device__ __forceinline__ void xcd_barrier(const XcdBarrier& b) {
    asm volatile("s_waitcnt vmcnt(0)" ::: "memory");
    __syncthreads();
    if (threadIdx.x == 0) {
        unsigned* bar = b.bar;
        __builtin_amdgcn_s_waitcnt(0);
        unsigned nloc = b.st[0], nx = b.st[1];
        if (nloc == 0u) { xcd_barrier_complete(bar, b.x, nloc, nx); b.st[0] = nloc; b.st[1] = nx; }
        const unsigned old = xb_add(&bar[XB_XSUB(b.x)], 1u);
        const unsigned gen = old / nloc;
        if (old + 1u == (gen + 1u) * nloc) {
            __builtin_amdgcn_fence(__ATOMIC_RELEASE, "agent");
            asm volatile("s_waitcnt vmcnt(0)" ::: "memory");
            const unsigned og = xb_add(&bar[XB_TOP], 1u);
            const unsigned tg = og / nx;
            if (og + 1u == (tg + 1u) * nx) xb_add(&bar[XB_TOPGEN], 1u);
            else XB_SPIN(xb_ld(&bar[XB_TOPGEN]) == tg, bar);
            __builtin_amdgcn_fence(__ATOMIC_ACQUIRE, "agent");
            xb_add(&bar[XB_XGEN(b.x)], 1u);
            asm volatile("s_waitcnt vmcnt(0)" ::: "memory");
        } else {
            XB_SPIN(xb_ld(&bar[XB_XGEN(b.x)]) == gen, bar);
            __builtin_amdgcn_fence(__ATOMIC_ACQUIRE, "agent");
            asm volatile("s_waitcnt vmcnt(0)" ::: "memory");
        }
    }
    __syncthreads();
}

constexpr int NWAVES = 8, NTHREADS = 512;
constexpr int DM = 2048, NTP = 8192, NTS = 32, NT = 8224, MP = 8448;
constexpr int RW_COLS = 3360, Q_OFF = 3360, KC_OFF = 4384, KS_OFF = 4896, VS_OFF = 5152, KW_OFF = 5408, VW_OFF = 5664, GL_OFF = 5920, IN_COLS = 5968, PLD = 6144;
constexpr int NEXP = 16384, NPOOL = 1280;
constexpr float LN_EPS = 1e-5f, GN_EPS = 64e-5f, DN_ALPHA = 1.4142135623730951f;
constexpr float NEG_BIG = -1e30f;
constexpr size_t O_YP = 0, O_YS = O_YP + (size_t)NTP * DM, O_CMP_P = O_YS + (size_t)NTS * DM, O_SEL_P = O_CMP_P + (size_t)2 * NTP * 512, O_WIN_P = O_SEL_P + (size_t)2 * NTP * 512,
                 O_RW_P = O_WIN_P + (size_t)2 * 4 * 512 * 512, O_SH_P = O_RW_P + (size_t)2 * 4 * 16 * 4096, O_CMP_S = O_SH_P + (size_t)2 * 4 * RW_COLS, O_SEL_S = O_CMP_S + (size_t)2 * NTS * 512,
                 O_WIN_S = O_SEL_S + (size_t)2 * NTS * 512, O_RW_S = O_WIN_S + (size_t)2 * 8 * 512 * 512, O_SH_S = O_RW_S + (size_t)2 * 8 * 16 * 4096, O_END = O_SH_S + (size_t)2 * 8 * RW_COLS;
static_assert(O_END == 41630464, "output size");
constexpr size_t MiB = 1ull << 20;
constexpr size_t WS_CTL = 0, CTL_ZERO_BYTES = 1 * MiB;
constexpr size_t WS_WIN = 1 * MiB;
constexpr size_t WS_WOUT = WS_WIN + 48 * MiB;
constexpr size_t WS_W2 = WS_WOUT + 16 * MiB;
constexpr size_t WS_UB = WS_W2 + 16 * MiB;
constexpr size_t WS_VB = WS_UB + 64 * MiB;
constexpr size_t WS_USC = WS_VB + 64 * MiB;
constexpr size_t WS_XB = WS_USC + 1 * MiB;
constexpr size_t WS_X1B = WS_XB + 33 * MiB;
constexpr size_t WS_XF1 = WS_X1B + 33 * MiB;
constexpr size_t WS_X1F = WS_XF1 + 65 * MiB;
constexpr size_t WS_PROJ = WS_X1F + 65 * MiB;
constexpr size_t WS_SC = WS_PROJ + 99 * MiB;
constexpr size_t SC_STRIDE = 33 * MiB;
constexpr size_t WS_GG = WS_SC + 6 * SC_STRIDE;
constexpr size_t WS_BON = WS_GG + 33 * MiB;
constexpr size_t WS_MIX = WS_BON + 1 * MiB;
constexpr size_t WS_HS = WS_MIX + 33 * MiB;
constexpr size_t WS_KCB = WS_HS + 66 * MiB;
constexpr size_t WS_VCBT = WS_KCB + 512 * 1024;
constexpr size_t WS_VTS = WS_KCB + 1 * MiB;
constexpr size_t WS_VTW = WS_VTS + 4 * MiB;
constexpr size_t WS_KCBS = WS_VTW + 4 * MiB;
constexpr size_t WS_VCBS = WS_KCBS + 17 * MiB;
constexpr size_t WS_LT = WS_VCBS + 17 * MiB;
constexpr size_t WS_KSC = WS_LT + 2 * MiB;
constexpr size_t WS_KWC = WS_KSC + 4 * MiB;
constexpr size_t WS_OPS = WS_KWC + 4 * MiB;
constexpr size_t OPS_BYTES = 51200;
constexpr size_t WS_EL = WS_OPS + 80 * MiB;
constexpr size_t WS_GT = WS_EL + 3 * MiB;
constexpr size_t WS_PD = WS_GT + 5 * MiB;
constexpr size_t WS_WP = WS_PD + 65 * MiB;
constexpr size_t WS_FO = WS_WP + 5 * MiB;
constexpr size_t WS_X1Q = WS_FO + 65 * MiB;
constexpr size_t WS_XQS = WS_X1Q + 17 * MiB;
constexpr size_t WS_END = WS_XQS + 1 * MiB;
constexpr int CW_BAR = 4096, CW_QUEUE = 8192, CW_SQ = 65536, CW_FLAG = 16384;
constexpr int RING_BYTES = 131072, MISC_OFF = RING_BYTES + 320, LDS_BYTES = 147456;
constexpr int N_PHASES = 23;

typedef unsigned short bf16;
typedef unsigned v4u __attribute__((ext_vector_type(4)));
typedef unsigned v2u __attribute__((ext_vector_type(2)));
typedef float f32x4 __attribute__((ext_vector_type(4)));
typedef float f32x16 __attribute__((ext_vector_type(16)));
typedef short bf16x8 __attribute__((ext_vector_type(8)));
typedef float f32x2_t __attribute__((ext_vector_type(2)));
typedef __bf16 bf16x2_t __attribute__((ext_vector_type(2)));
#define LDS_WAIT() asm volatile("s_waitcnt lgkmcnt(0)" ::: "memory")
#define DI __device__ __forceinline__
#define GAS __attribute__((address_space(1)))
template <class T> DI T* launder_g(T* p) { GAS T* g = (GAS T*)p; asm volatile("" : "+s"(g)); return (T*)g; }

DI unsigned pk2(float lo, float hi) { f32x2_t v = {lo, hi}; bf16x2_t b = __builtin_convertvector(v, bf16x2_t); return __builtin_bit_cast(unsigned, b); }
DI float bf2f(unsigned short u) { return __builtin_bit_cast(float, (unsigned)u << 16); }
DI float bflo(unsigned u) { return __builtin_bit_cast(float, u << 16); }
DI float bfhi(unsigned u) { return __builtin_bit_cast(float, u & 0xffff0000u); }
template <int CTRL> DI float dppf(float v) { return __builtin_bit_cast(float, __builtin_amdgcn_update_dpp(0, __builtin_bit_cast(int, v), CTRL, 0xF, 0xF, false)); }
DI float rdlane(float v, int l) { return __builtin_bit_cast(float, __builtin_amdgcn_readlane(__builtin_bit_cast(int, v), l)); }
DI float wave_sum(float v) {
    v += dppf<0xB1>(v); v += dppf<0x4E>(v); v += dppf<0x141>(v); v += dppf<0x140>(v);
    return (rdlane(v, 0) + rdlane(v, 16)) + (rdlane(v, 32) + rdlane(v, 48));
}
DI float wave_max(float v) {
    v = fmaxf(v, dppf<0xB1>(v)); v = fmaxf(v, dppf<0x4E>(v)); v = fmaxf(v, dppf<0x141>(v)); v = fmaxf(v, dppf<0x140>(v));
    return fmaxf(fmaxf(rdlane(v, 0), rdlane(v, 16)), fmaxf(rdlane(v, 32), rdlane(v, 48)));
}
DI float sigmoidf_(float x) { return 1.f / (1.f + expf(-x)); }
DI int crow(int reg, int h) { return (reg & 3) + 8 * (reg >> 2) + 4 * h; }

struct ArgsK { const float* in[30]; float* out; unsigned char* ws; int ph_lo, ph_hi, use_bar, pad; };
struct ArgsG { const GAS float* in[30]; GAS float* out; GAS unsigned char* ws; int ph_lo, ph_hi, use_bar, pad; };
typedef __attribute__((address_space(4))) const ArgsG* kargp_t;
struct Ctx {
    float* out; unsigned char* ws;
    LAS unsigned char* lds; unsigned* ctl;
    int tid, lane, wave, G;
    DI const float* inp(int k) const { kargp_t p = (kargp_t)__builtin_amdgcn_kernarg_segment_ptr(); asm volatile("" : "+s"(p)); return (const float*)p->in[k]; }
};
template <class T> DI T* wsp(const Ctx& C, size_t off) { return (T*)(C.ws + off); }

struct EpiInProj {
    static constexpr bool PERM = true, AFTER_DRAIN = false;
    bf16* P; float* out; int l;
    DI void operator()(const pg8::f32x4 (&acc)[2][2][4][2], const pg8::Unit& u, int wr, int wc, int fr, int fq) const {
        const int row0 = u.pm * 256 + wr * 64 + fr, col0 = u.pn * 256 + wc * 32 + 8 * fq;
#pragma unroll
        for (int bj = 0; bj < 2; ++bj) {
            const int colb = __builtin_amdgcn_readfirstlane(u.pn * 256 + wc * 32 + bj * 128);
            const int col = col0 + bj * 128;
            const int kind = colb < RW_COLS ? 1 : ((colb >= KC_OFF && colb < GL_OFF) ? 2 : 0);
            const int reg = (colb - KC_OFF) >> 9, cc = (col - KC_OFF) & 511;
#pragma unroll
            for (int ai = 0; ai < 2; ++ai)
#pragma unroll
                for (int m = 0; m < 4; ++m) {
                    const int row = row0 + ai * 128 + m * 16;
                    const pg8::f32x4 v0 = acc[ai][bj][m][0], v1 = acc[ai][bj][m][1];
                    v4u w; w.x = pk2(v0[0], v0[1]); w.y = pk2(v0[2], v0[3]); w.z = pk2(v1[0], v1[1]); w.w = pk2(v1[2], v1[3]);
                    *(v4u*)(P + (size_t)row * PLD + col) = w;
                    if (kind == 0 || row >= NT) continue;
                    unsigned off = 0xffffffffu;
                    if (row < NTP) { const int b = row >> 11, t = row & 2047;
                        if (kind == 1) { if (t == 2047) off = (unsigned)(O_SH_P + (size_t)(l * 4 + b) * RW_COLS + col); }
                        else if (reg == 0) off = (unsigned)(O_CMP_P + ((size_t)l * NTP + row) * 512 + cc);
                        else if (reg == 1) off = (unsigned)(O_SEL_P + ((size_t)l * NTP + row) * 512 + cc);
                        else if (t >= 1536) off = (unsigned)(O_WIN_P + ((size_t)(l * 4 + b) * 512 + (t - 1536)) * 512 + cc);
                    } else { const int j = row - NTP, b = j >> 2, t = j & 3;
                        if (kind == 1) { if (t == 3) off = (unsigned)(O_SH_S + (size_t)(l * 8 + b) * RW_COLS + col); }
                        else if (reg == 0) off = (unsigned)(O_CMP_S + ((size_t)l * NTS + j) * 512 + cc);
                        else if (reg == 1) off = (unsigned)(O_SEL_S + ((size_t)l * NTS + j) * 512 + cc);
                        else off = (unsigned)(O_WIN_S + ((size_t)(l * 8 + b) * 512 + 508 + t) * 512 + cc);
                    }
                    if (off != 0xffffffffu) { *(pg8::f32x4*)(out + off) = v0; *(pg8::f32x4*)(out + off + 4) = v1; }
                }
        }
    }
};

struct EpiBf16Row {
    static constexpr bool PERM = true, AFTER_DRAIN = false;
    bf16* Cb; int ldc;
    DI void operator()(const pg8::f32x4 (&acc)[2][2][4][2], const pg8::Unit& u, int wr, int wc, int fr, int fq) const {
        const int row0 = u.pm * 256 + wr * 64 + fr, col0 = u.pn * 256 + wc * 32 + 8 * fq;
#pragma unroll
        for (int bj = 0; bj < 2; ++bj)
#pragma unroll
            for (int ai = 0; ai < 2; ++ai)
#pragma unroll
                for (int m = 0; m < 4; ++m) { const pg8::f32x4 v0 = acc[ai][bj][m][0], v1 = acc[ai][bj][m][1];
                    v4u w; w.x = pk2(v0[0], v0[1]); w.y = pk2(v0[2], v0[3]); w.z = pk2(v1[0], v1[1]); w.w = pk2(v1[2], v1[3]);
                    *(v4u*)(Cb + (size_t)(row0 + ai * 128 + m * 16) * ldc + col0 + bj * 128) = w; }
    }
};

template <class Sink> DI void skinny_gemm(const Ctx& C, const bf16* A, const bf16* Bt, int nslabs, const Sink& sink) {
    const int tid = C.tid, lane = C.lane, wave = C.wave, r = lane & 31, hi = lane >> 5;
    LAS float* PS = (LAS float*)C.lds;
    for (int it = blockIdx.x; it < nslabs; it += C.G) {
        const int n0 = it * 32, k0 = wave * 256;
        f32x16 acc;
#pragma unroll
        for (int i = 0; i < 16; ++i) acc[i] = 0.f;
        const bf16* ap = A + (size_t)r * DM + k0 + 8 * hi; const bf16* bp = Bt + (size_t)(n0 + r) * DM + k0 + 8 * hi;
#pragma unroll 8
        for (int s = 0; s < 16; ++s) { const bf16x8 af = *(const bf16x8*)(ap + 16 * s), bf = *(const bf16x8*)(bp + 16 * s); acc = __builtin_amdgcn_mfma_f32_32x32x16_bf16(af, bf, acc, 0, 0, 0); }
        __syncthreads();
#pragma unroll
        for (int i = 0; i < 16; ++i) PS[(wave * 32 + crow(i, hi)) * 33 + r] = acc[i];
        __syncthreads();
#pragma unroll
        for (int e = 0; e < 2; ++e) { const int o = tid * 2 + e, row = o >> 5, col = o & 31; float v = 0.f;
#pragma unroll
            for (int w = 0; w < 8; ++w) v += PS[(w * 32 + row) * 33 + col];
            sink(row, n0 + col, v); }
    }
    __syncthreads();
}

DI void transpose_item(const float* W, int K, int N, int Npad, bf16* WT, LAS float* scr, int item, int lane) {
    const int nblk = Npad / 32, kb = item / nblk, nb = item % nblk, k0 = 64 * kb, n0 = 32 * nb;
#pragma unroll 8
    for (int i = 0; i < 32; ++i) { const int kk = 2 * i + (lane >> 5), n = n0 + (lane & 31); scr[kk * 33 + (lane & 31)] = n < N ? W[(size_t)(k0 + kk) * N + n] : 0.f; }
    LDS_WAIT(); asm volatile("" ::: "memory");
    const int c = lane & 7;
#pragma unroll
    for (int j = 0; j < 4; ++j) { const int n = (lane >> 3) + 8 * j; const LAS float* s = scr + (8 * c) * 33 + n;
        v4u o; o.x = pk2(s[0 * 33], s[1 * 33]); o.y = pk2(s[2 * 33], s[3 * 33]); o.z = pk2(s[4 * 33], s[5 * 33]); o.w = pk2(s[6 * 33], s[7 * 33]);
        *(v4u*)(WT + (size_t)(n0 + n) * K + k0 + 8 * c) = o; }
    LDS_WAIT(); asm volatile("" ::: "memory");
}


DI void p0i_table(const Ctx& C, int r) {
    const int lane = C.lane, wave = C.wave;
    const int row = r * 8 + wave;
    const float* src = (row < 32768 ? C.inp(26) : C.inp(27)) + (size_t)(row & 32767) * DM;
    unsigned char* dst = C.ws + (row < 32768 ? WS_UB : WS_VB) + (size_t)((row >> 14) & 1) * NEXP * DM + (size_t)(row & 16383) * 128;
    f32x4 v[8]; float am = 0.f;
#pragma unroll
    for (int k = 0; k < 2; ++k)
#pragma unroll
        for (int q = 0; q < 4; ++q) { v[4 * k + q] = ((const f32x4*)src)[4 * lane + 256 * k + q];
            am = fmaxf(am, fmaxf(fmaxf(fabsf(v[4 * k + q][0]), fabsf(v[4 * k + q][1])), fmaxf(fabsf(v[4 * k + q][2]), fabsf(v[4 * k + q][3])))); }
    am = wave_max(am);
    const bool isu = row < 32768;
    const float sc = am > 0.f ? am * (isu ? 1.f / 127.f : 1.f / 256.f) : 1.f, inv = 1.f / sc;
#pragma unroll
    for (int k = 0; k < 2; ++k) { v4u o;
#pragma unroll
        for (int q = 0; q < 4; ++q) { const f32x4 x = v[4 * k + q] * inv;
            if (isu) o[q] = ((unsigned)(int)__builtin_rintf(x[0]) & 255u) | (((unsigned)(int)__builtin_rintf(x[1]) & 255u) << 8) | (((unsigned)(int)__builtin_rintf(x[2]) & 255u) << 16) | ((unsigned)(int)__builtin_rintf(x[3]) << 24);
            else { int p = __builtin_amdgcn_cvt_pk_fp8_f32(x[0], x[1], 0, false); p = __builtin_amdgcn_cvt_pk_fp8_f32(x[2], x[3], p, true); o[q] = (unsigned)p; } }
        *(v4u*)(dst + ((size_t)((lane >> 3) + 8 * k) * NEXP) * 128 + 16 * (lane & 7)) = o; }
    if (lane == 0) wsp<float>(C, WS_USC)[row] = sc;
}
DI void p0i_cache(const Ctx& C, int r) {
    const int tid = C.tid;
    const int l = r >> 10, b = (r >> 7) & 7, pi = r & 127;
    const int pid = ((const int*)C.inp(4))[b * 128 + pi];
    const int q = tid >> 7, c4 = tid & 127, kv = c4 >> 6, kvh = (c4 >> 4) & 3, d0 = (c4 & 15) * 4;
    const f32x4* src = (const f32x4*)(C.inp(2) + ((size_t)(l * NPOOL + pid) * 128 + 32 * q) * 512) + c4;
    const float* w = C.inp(20) + (l * 2 + kv) * 32;
    f32x4 acc = {0.f, 0.f, 0.f, 0.f};
#pragma unroll 16
    for (int rr = 0; rr < 32; ++rr) acc += src[(size_t)rr * 128] * w[rr];
    *(f32x4*)(wsp<float>(C, kv ? WS_VCBS : WS_KCBS) + ((size_t)((l * 8 + b) * 4 + kvh) * 512 + 4 * pi + q) * 64 + d0) = acc;
}
DI void p0i_transpose(const Ctx& C, int r) {
    const int lane = C.lane, wave = C.wave;
    const int l = r >> 10, w8 = (r & 1023) * 8 + wave;
    LAS float* scr = (LAS float*)(C.lds + wave * 16384);
    if (w8 < 6144) transpose_item(C.inp(8) + (size_t)l * DM * IN_COLS, DM, IN_COLS, PLD, wsp<bf16>(C, WS_WIN) + (size_t)l * PLD * DM, scr, w8, lane);
    else transpose_item(C.inp(21) + (size_t)l * DM * DM, DM, DM, DM, wsp<bf16>(C, WS_WOUT) + (size_t)l * DM * DM, scr, w8 - 6144, lane);
}
DI void p0i_w2(const Ctx& C, int r) {
    const int tid = C.tid;
    const int l = r >> 10, hc = (r >> 6) & 15, kb = r & 63;
    LAS float* SK = (LAS float*)C.lds;
    LAS float* WQ = (LAS float*)(C.lds + 128 * 129 * 4);
    __syncthreads();
    const float* sk = C.inp(25) + ((size_t)l * 16 + hc) * 16384;
    for (int i = tid; i < 16384; i += NTHREADS) SK[(i >> 7) * 129 + (i & 127)] = sk[i];
    const float* wq = C.inp(24) + (size_t)l * DM * DM + (size_t)(kb * 32) * DM + hc * 128;
    for (int i = tid; i < 4096; i += NTHREADS) WQ[i] = wq[(size_t)(i >> 7) * DM + (i & 127)];
    __syncthreads();
    const int k = tid & 127, rq = tid >> 7;
    float acc[8];
#pragma unroll
    for (int j = 0; j < 8; ++j) acc[j] = 0.f;
    for (int d = 0; d < 128; d += 4) {
        const float s0 = SK[k * 129 + d], s1 = SK[k * 129 + d + 1], s2 = SK[k * 129 + d + 2], s3 = SK[k * 129 + d + 3];
#pragma unroll
        for (int j = 0; j < 8; ++j) { const f32x4 w = *(const LAS f32x4*)(WQ + (rq * 8 + j) * 128 + d); acc[j] += s0 * w[0] + s1 * w[1] + s2 * w[2] + s3 * w[3]; }
    }
    v4u o; o.x = pk2(acc[0], acc[1]); o.y = pk2(acc[2], acc[3]); o.z = pk2(acc[4], acc[5]); o.w = pk2(acc[6], acc[7]);
    *(v4u*)(wsp<bf16>(C, WS_W2) + (size_t)l * DM * DM + (size_t)(hc * 128 + k) * DM + kb * 32 + rq * 8) = o;
}
constexpr int DEF_ITEMS = 8192 + 1024 + 1024 + 2048, DEF_GROUPS = DEF_ITEMS / 4;
DI void deferred_item(const Ctx& C, int i) {
    if (i < 8192) p0i_table(C, i);
    else if (i < 9216) p0i_cache(C, 1024 + (i - 8192));
    else if (i < 10240) p0i_transpose(C, 1024 + (i - 9216));
    else p0i_w2(C, i - 10240);
}

constexpr int P0_NX = 2056, P0_NWP = 508;
DI void p0_prologue(const Ctx& C, int pmask = 31) {
    const int tid = C.tid;
    LAS int* qslot = (LAS int*)(C.lds + MISC_OFF + 64);
#define P0_CLAIM 4
#define P0_BLOCK(n, qi) for (int base_ = 0; ; ) { __syncthreads(); if (tid == 0) *qslot = (int)atomicAdd(C.ctl + CW_QUEUE + 64 * (8 + (qi)), (unsigned)P0_CLAIM); __syncthreads(); base_ = *qslot; if (base_ >= (n)) break; \
        for (int r = base_, r_hi = (base_ + P0_CLAIM < (n) ? base_ + P0_CLAIM : (n)); r < r_hi; ++r)
#define P0_END }
    if (pmask & 4) P0_BLOCK(1024, 2) { p0i_transpose(C, r); } P0_END
    if (pmask & 16) P0_BLOCK(P0_NX, 4) {{
            const size_t e0 = (size_t)r * 8192 + tid * 16;
            const float* src = e0 < (size_t)NTP * DM ? C.inp(0) + e0 : C.inp(1) + (e0 - (size_t)NTP * DM);
            const f32x4* s4 = (const f32x4*)src;
            const f32x4 a = s4[0], b = s4[1], c = s4[2], d = s4[3];
            v4u o0, o1; o0.x = pk2(a[0], a[1]); o0.y = pk2(a[2], a[3]); o0.z = pk2(b[0], b[1]); o0.w = pk2(b[2], b[3]);
            o1.x = pk2(c[0], c[1]); o1.y = pk2(c[2], c[3]); o1.z = pk2(d[0], d[1]); o1.w = pk2(d[2], d[3]);
            v4u* d4 = (v4u*)(wsp<bf16>(C, WS_XB) + e0); d4[0] = o0; d4[1] = o1;
        }} P0_END
    if (pmask & 2) P0_BLOCK(1024, 1) { p0i_cache(C, r); } P0_END
    if (pmask & 4) P0_BLOCK(144, 6) {{
            const int g = r * 512 + tid, l = g / 36864, rem = g % 36864, c = rem / 36, kg = rem % 36;
            const float* src = kg < 8 ? C.inp(11) + ((size_t)l * 64 + kg * 8) * 1024 : (kg < 16 ? C.inp(13) + ((size_t)l * 64 + (kg - 8) * 8) * 1024 : C.inp(14) + ((size_t)l * 160 + (kg - 16) * 8) * 1024);
            float e[8];
#pragma unroll
            for (int q = 0; q < 8; ++q) e[q] = src[(size_t)q * 1024 + c];
            *(v4u*)(wsp<bf16>(C, WS_LT) + ((size_t)l * 1024 + c) * 288 + kg * 8) = (v4u){pk2(e[0], e[1]), pk2(e[2], e[3]), pk2(e[4], e[5]), pk2(e[6], e[7])};
        }} P0_END
    if (pmask & 16) P0_BLOCK(P0_NWP, 5) {{
            const size_t i0 = (size_t)r * 8192 + tid * 16;
            const size_t lb = i0 / 260096, rem = i0 % 260096;
            const f32x4* s4 = (const f32x4*)(C.inp(5) + lb * 262144 + 2048 + rem);
            f32x4* d4 = (f32x4*)(C.out + O_WIN_S + lb * 262144 + rem);
            const f32x4 a = s4[0], b = s4[1], c = s4[2], d = s4[3];
            d4[0] = a; d4[1] = b; d4[2] = c; d4[3] = d;
        }} P0_END
    __syncthreads();
}

constexpr int PB_NRW = 514, PB_NPOOL = 256, PB_NVT = 1024, PB_ITEMS = PB_NRW + PB_NPOOL + PB_NVT;
DI float softplusf_(float x) { return x > 20.f ? x : log1pf(expf(x)); }
DI float fexp_(float x) { return __expf(x); }
DI float fsoftplus_(float x) { return x > 20.f ? x : __logf(1.f + __expf(x)); }
DI float fsigmoid_(float x) { return __builtin_amdgcn_rcpf(1.f + __expf(-x)); }

constexpr int XSB_LD = 3088, ACTB_LD = 296;
DI void rwkv_pre_item(const Ctx& C, int l, int item) {
    const int tid = C.tid, lane = C.lane, wave = C.wave, n16 = lane & 15, rq = lane >> 4;
    LAS unsigned short* XSB = (LAS unsigned short*)C.lds;
    LAS unsigned short* ACTB = (LAS unsigned short*)(C.lds + 16 * XSB_LD * 2);
    const bf16* P = wsp<bf16>(C, WS_PROJ);
    const int m0 = item * 16;
    __syncthreads();
#pragma unroll 1
    for (int base = 0; base < 16 * 420; base += 4 * NTHREADS) {
        v4u cu[4], pu[4]; f32x4 mu0[4], mu1[4], sh0[4], sh1[4]; int jj_[4], col_[4], kind[4];
#pragma unroll
        for (int u = 0; u < 4; ++u) { const int idx = base + u * NTHREADS + tid; kind[u] = -1; jj_[u] = 0; col_[u] = 0;
            if (idx < 16 * 420) { const int j = idx / 420, col = (idx % 420) * 8, m = m0 + j; jj_[u] = j; col_[u] = col;
                cu[u] = *(const v4u*)(P + (size_t)m * PLD + col);
                const f32x4* mup = (const f32x4*)(C.inp(9) + (size_t)l * RW_COLS + col); mu0[u] = mup[0]; mu1[u] = mup[1];
                int t; const float* sh = nullptr;
                if (m < NTP) t = m & 2047; else { const int jq = m - NTP; t = jq & 3; sh = C.inp(7) + (size_t)(l * 8 + (jq >> 2)) * RW_COLS + col; }
                if (t > 0) { pu[u] = *(const v4u*)(P + (size_t)(m - 1) * PLD + col); kind[u] = 1; }
                else if (sh) { sh0[u] = ((const f32x4*)sh)[0]; sh1[u] = ((const f32x4*)sh)[1]; kind[u] = 2; }
                else kind[u] = 0; } }
#pragma unroll
        for (int u = 0; u < 4; ++u) if (kind[u] >= 0) {
            const int j = jj_[u], col = col_[u];
            float cur[8] = {bflo(cu[u].x), bfhi(cu[u].x), bflo(cu[u].y), bfhi(cu[u].y), bflo(cu[u].z), bfhi(cu[u].z), bflo(cu[u].w), bfhi(cu[u].w)};
            float prev[8];
            if (kind[u] == 1) { prev[0] = bflo(pu[u].x); prev[1] = bfhi(pu[u].x); prev[2] = bflo(pu[u].y); prev[3] = bfhi(pu[u].y); prev[4] = bflo(pu[u].z); prev[5] = bfhi(pu[u].z); prev[6] = bflo(pu[u].w); prev[7] = bfhi(pu[u].w); }
            else if (kind[u] == 2) {
#pragma unroll
                for (int e = 0; e < 4; ++e) { prev[e] = sh0[u][e]; prev[4 + e] = sh1[u][e]; } }
            else {
#pragma unroll
                for (int e = 0; e < 8; ++e) prev[e] = 0.f; }
            float xs[8];
#pragma unroll
            for (int e = 0; e < 4; ++e) { xs[e] = cur[e] + mu0[u][e] * (prev[e] - cur[e]); xs[4 + e] = cur[4 + e] + mu1[u][e] * (prev[4 + e] - cur[4 + e]); }
            if (col >= 3072) { const int a0 = col - 3072;
#pragma unroll
                for (int e = 0; e < 8; ++e) xs[e] = a0 < 64 ? tanhf(xs[e]) : (a0 < 128 ? xs[e] : fsigmoid_(xs[e]));
                *(LAS v4u*)(ACTB + j * ACTB_LD + a0) = (v4u){pk2(xs[0], xs[1]), pk2(xs[2], xs[3]), pk2(xs[4], xs[5]), pk2(xs[6], xs[7])};
            } else *(LAS v4u*)(XSB + j * XSB_LD + col) = (v4u){pk2(xs[0], xs[1]), pk2(xs[2], xs[3]), pk2(xs[4], xs[5]), pk2(xs[6], xs[7])};
        }
    }
    __syncthreads();
    float* SC = wsp<float>(C, WS_SC); constexpr size_t SS = SC_STRIDE / 4;
    float* GG = wsp<float>(C, WS_GG); float* BON = wsp<float>(C, WS_BON);
    const bf16* LT = wsp<bf16>(C, WS_LT) + (size_t)l * 1024 * 288;
    const f32x4 zf = {0.f, 0.f, 0.f, 0.f};
#pragma unroll 1
    for (int hh = 0; hh < 2; ++hh) {
        const int head = 2 * wave + hh;
        f32x4 aw[4], aa[4], ag[4];
#pragma unroll
        for (int t4 = 0; t4 < 4; ++t4) { aw[t4] = zf; aa[t4] = zf; ag[t4] = zf; }
#define LORA_STEPS(ACC, KS0, NKS) _Pragma("unroll 2") for (int ks = (KS0); ks < (KS0) + (NKS); ++ks) { \
            const bf16x8 af = *(const LAS bf16x8*)(ACTB + n16 * ACTB_LD + 32 * ks + 8 * rq); \
            _Pragma("unroll") for (int t4 = 0; t4 < 4; ++t4) { const bf16x8 bfr = *(const bf16x8*)(LT + (size_t)(head * 64 + 16 * t4 + n16) * 288 + 32 * ks + 8 * rq); \
                ACC[t4] = __builtin_amdgcn_mfma_f32_16x16x32_bf16(af, bfr, ACC[t4], 0, 0, 0); } }
        LORA_STEPS(aw, 0, 2) LORA_STEPS(aa, 2, 2) LORA_STEPS(ag, 4, 5)
#undef LORA_STEPS
        float w0v[4], a0v[4], kkv[4], kav[4], rkv[4];
#pragma unroll
        for (int t4 = 0; t4 < 4; ++t4) { const int c = l * 1024 + head * 64 + 16 * t4 + n16; w0v[t4] = C.inp(10)[c]; a0v[t4] = C.inp(12)[c]; kkv[t4] = C.inp(15)[c]; kav[t4] = C.inp(16)[c]; rkv[t4] = C.inp(17)[c]; }
#pragma unroll
        for (int i = 0; i < 4; ++i) {
            const int j = 4 * rq + i; const size_t m = (size_t)m0 + j;
            float kkr[4], km[4], a_[4], rr[4], vv[4], lw_[4]; float ss = 0.f, bs = 0.f;
#pragma unroll
            for (int t4 = 0; t4 < 4; ++t4) { const int cl = head * 64 + 16 * t4 + n16;
                const float z = w0v[t4] + aw[t4][i];
                const float w = -fsoftplus_(-z) - 0.5f;
                lw_[t4] = -fexp_(w);
                a_[t4] = fsigmoid_(a0v[t4] + aa[t4][i]);
                rr[t4] = bf2f(XSB[j * XSB_LD + cl]); const float k = bf2f(XSB[j * XSB_LD + 1024 + cl]); vv[t4] = bf2f(XSB[j * XSB_LD + 2048 + cl]);
                kkr[t4] = k * kkv[t4]; ss += kkr[t4] * kkr[t4];
                km[t4] = k * (1.f + (a_[t4] - 1.f) * kav[t4]); bs += rr[t4] * km[t4] * rkv[t4]; }
            ss += dppf<0xB1>(ss); ss += dppf<0x4E>(ss); ss += dppf<0x141>(ss); ss += dppf<0x140>(ss);
            bs += dppf<0xB1>(bs); bs += dppf<0x4E>(bs); bs += dppf<0x141>(bs); bs += dppf<0x140>(bs);
            const float rn = __builtin_amdgcn_rsqf(fmaxf(ss, 1e-24f));
#pragma unroll
            for (int t4 = 0; t4 < 4; ++t4) { const int c = head * 64 + 16 * t4 + n16; const float kk = kkr[t4] * rn;
                ((bf16*)(SC + 0 * SS))[m * 1024 + c] = (unsigned short)(pk2(kk, 0.f) & 0xffffu); SC[1 * SS + m * 1024 + c] = fexp_(lw_[t4]); SC[3 * SS + m * 1024 + c] = lw_[t4];
                ((unsigned*)(SC + 2 * SS))[m * 1024 + head * 64 + n16 * 4 + t4] = pk2(-kk * a_[t4], km[t4]);
                ((bf16*)(SC + 4 * SS))[m * 1024 + c] = (unsigned short)(pk2(rr[t4], 0.f) & 0xffffu); SC[5 * SS + m * 1024 + c] = vv[t4];
                GG[m * 1024 + c] = ag[t4][i]; }
            if (n16 == 0) BON[m * 16 + head] = bs;
        }
    }
}

DI void phase_b(const Ctx& C, int l, int lq) {
    const int tid = C.tid;
    const bf16* P = wsp<bf16>(C, WS_PROJ);
    LAS int* qslot = (LAS int*)(C.lds + MISC_OFF + 64);
    for (;;) {
        __syncthreads();
        if (tid == 0) *qslot = (int)atomicAdd(C.ctl + CW_QUEUE + 64 * (16 + lq), 1u);
        __syncthreads();
        const int it = *qslot;
        if (it >= PB_ITEMS) break;
        int r = it;
        if (r < PB_NRW) { rwkv_pre_item(C, l, r); continue; }
        r -= PB_NRW;
        if (r < PB_NPOOL) {
            const int b = r >> 6, n = r & 63, kv = tid >> 8, kvh = (tid >> 6) & 3, d = tid & 63;
            const float* src = C.out + O_CMP_P + ((size_t)l * NTP + b * 2048 + 32 * n) * 512 + tid;
            const float* w = C.inp(20) + (l * 2 + kv) * 32;
            float acc = 0.f;
#pragma unroll 8
            for (int rr = 0; rr < 32; ++rr) acc += w[rr] * src[(size_t)rr * 512];
            const unsigned short hb = (unsigned short)(pk2(acc, 0.f) & 0xffffu);
            if (kv == 0) wsp<bf16>(C, WS_KCB)[((size_t)(b * 4 + kvh) * 64 + n) * 64 + d] = hb;
            else wsp<bf16>(C, WS_VCBT)[((size_t)(b * 4 + kvh) * 64 + d) * 64 + n] = hb;
            continue;
        }
        r -= PB_NPOOL;
        {
            const int which = r >> 9, b = (r >> 7) & 3, kvh = (r >> 5) & 3, tb = r & 31, d = tid & 63, tq = tid >> 6;
            const bf16* src = P + (size_t)(b * 2048 + 64 * tb + 8 * tq) * PLD + (which ? VW_OFF : VS_OFF) + kvh * 64 + d;
            unsigned short e[8];
#pragma unroll
            for (int i = 0; i < 8; ++i) e[i] = src[(size_t)i * PLD];
            v4u o; o.x = e[0] | ((unsigned)e[1] << 16); o.y = e[2] | ((unsigned)e[3] << 16); o.z = e[4] | ((unsigned)e[5] << 16); o.w = e[6] | ((unsigned)e[7] << 16);
            *(v4u*)(wsp<bf16>(C, which ? WS_VTW : WS_VTS) + (((size_t)(b * 4 + kvh) * 32 + tb) * 64 + d) * 64 + 8 * tq) = o;
            { const int row = tid >> 3, ch = tid & 7;
              const v4u kv_ = *(const v4u*)(P + (size_t)(b * 2048 + 64 * tb + row) * PLD + (which ? KW_OFF : KS_OFF) + kvh * 64 + ch * 8);
              *(v4u*)(wsp<bf16>(C, which ? WS_KWC : WS_KSC) + ((size_t)(b * 4 + kvh) * 2048 + 64 * tb + row) * 64 + ch * 8) = kv_; }
        }
    }
    __syncthreads();
}

#define MFMA16(a, b, c) __builtin_amdgcn_mfma_f32_16x16x32_bf16((a), (b), (c), 0, 0, 0)
DI void scan_head(const Ctx& C, int l, int row0, int T, int h, const float* S0, float* Sout) {
    const int tid = C.tid, lane = C.lane, wave = C.wave;
    LAS f32x4* D4 = (LAS f32x4*)C.lds;
    LAS v4u* BK4 = (LAS v4u*)(C.lds + 8192);
    LAS f32x4* V4 = (LAS f32x4*)(C.lds + 16384);
    LAS v4u* R16 = (LAS v4u*)(C.lds + 24576);
    LAS v4u* KK16 = (LAS v4u*)(C.lds + 28672);
    LAS float* YB = (LAS float*)(C.lds + 33280);
    const unsigned char* SCb = C.ws + WS_SC;
    const bf16* SCKK = (const bf16*)SCb; const float* SCD = (const float*)(SCb + SC_STRIDE); const unsigned* SCBK = (const unsigned*)(SCb + 2 * SC_STRIDE);
    const bf16* SCR = (const bf16*)(SCb + 4 * SC_STRIDE); const float* SCV = (const float*)(SCb + 5 * SC_STRIDE);
    const float* GG = wsp<float>(C, WS_GG); const float* BON = wsp<float>(C, WS_BON);
    bf16* MIX = wsp<bf16>(C, WS_MIX);
    const int n = lane & 15, rq = lane >> 4, v0 = 16 * (wave & 3); const bool act = wave < 4;
    f32x4 acc[4];
#pragma unroll
    for (int kt = 0; kt < 4; ++kt) acc[kt] = (act && S0) ? *(const f32x4*)(S0 + (v0 + n) * 64 + 16 * kt + 4 * rq) : (f32x4){0.f, 0.f, 0.f, 0.f};
    const int nch = (T + 31) >> 5;
    f32x4 pD, pV; v4u pBK, pRK, pK2;
    const v4u z4 = {0u, 0u, 0u, 0u};
#define SCAN_PREFETCH(cc) do { { const int step = (cc) * 32 + (tid >> 4), f4 = tid & 15; const size_t o = (size_t)(row0 + step) * 1024 + h * 64 + f4 * 4; const bool ok = step < T; \
            pD = ok ? *(const f32x4*)(SCD + o) : (f32x4){0.f, 0.f, 0.f, 0.f}; pV = ok ? *(const f32x4*)(SCV + o) : (f32x4){0.f, 0.f, 0.f, 0.f}; pBK = ok ? *(const v4u*)(SCBK + o) : z4; } \
        { const int i2 = tid & 255, step = (cc) * 32 + (i2 >> 3); const size_t o = (size_t)(row0 + step) * 1024 + h * 64 + (i2 & 7) * 8; pRK = step < T ? *(const v4u*)((tid < 256 ? SCR : SCKK) + o) : z4; } \
        { const int step = (cc) * 32 + 32; const size_t o = (size_t)(row0 + step) * 1024 + h * 64 + (tid & 7) * 8; pK2 = (tid < 8 && step < T) ? *(const v4u*)(SCKK + o) : z4; } } while (0)
    SCAN_PREFETCH(0);
    const float gng = C.inp(18)[l * 1024 + h * 64 + lane], gnb = C.inp(19)[l * 1024 + h * 64 + lane];
    float sk = 0.f;
    struct StepOps { f32x4 d[4]; v4u bk; float vt; v2u a[4]; };
#define SCAN_LD(o, st_) do { _Pragma("unroll") for (int kt = 0; kt < 4; ++kt) (o).d[kt] = D4[(st_) * 16 + 4 * kt + rq]; (o).bk = BK4[(st_) * 16 + n]; (o).vt = ((const LAS float*)V4)[(st_) * 64 + v0 + n]; \
        const LAS unsigned char* src_ = (n & 3) == 1 ? (const LAS unsigned char*)KK16 + ((st_) + 1) * 128 : (const LAS unsigned char*)R16 + (st_) * 128; \
        (o).a[0] = *(const LAS v2u*)(src_ + 8 * rq); (o).a[1] = *(const LAS v2u*)(src_ + 32 + 8 * rq); (o).a[2] = *(const LAS v2u*)(src_ + 64 + 8 * rq); (o).a[3] = *(const LAS v2u*)(src_ + 96 + 8 * rq); } while (0)
#define SCAN_YSK(a0_, a1_, a2_, a3_, yv, skv) do { \
        v4u h0, h1; h0.x = pk2(acc[0][0], acc[0][1]); h0.y = pk2(acc[0][2], acc[0][3]); h0.z = pk2(acc[1][0], acc[1][1]); h0.w = pk2(acc[1][2], acc[1][3]); \
        h1.x = pk2(acc[2][0], acc[2][1]); h1.y = pk2(acc[2][2], acc[2][3]); h1.z = pk2(acc[3][0], acc[3][1]); h1.w = pk2(acc[3][2], acc[3][3]); \
        const v4u f0 = {(a0_).x, (a0_).y, (a1_).x, (a1_).y}, f1 = {(a2_).x, (a2_).y, (a3_).x, (a3_).y}; \
        f32x4 d2 = MFMA16(__builtin_bit_cast(bf16x8, f0), __builtin_bit_cast(bf16x8, h0), ((f32x4){0.f, 0.f, 0.f, 0.f})); \
        d2 = MFMA16(__builtin_bit_cast(bf16x8, f1), __builtin_bit_cast(bf16x8, h1), d2); yv = d2[0]; skv = d2[1]; } while (0)
    for (int c = 0; c < nch; ++c) {
        __syncthreads();
        D4[tid] = pD; BK4[tid] = pBK; V4[tid] = pV;
        if (tid < 256) R16[tid] = pRK; else KK16[tid - 256] = pRK;
        if (tid < 8) KK16[256 + tid] = pK2;
        __syncthreads();
        if (c + 1 < nch) SCAN_PREFETCH(c + 1);
        const int nst = (T - c * 32) < 32 ? (T - c * 32) : 32;
        float gq[4], bq[4];
#pragma unroll
        for (int qq = 0; qq < 4; ++qq) { const int st = wave * 4 + qq; const size_t m = (size_t)row0 + c * 32 + (st < nst ? st : 0);
            gq[qq] = GG[m * 1024 + h * 64 + lane]; bq[qq] = BON[m * 16 + h]; }
        if (act) {
            if (c == 0) {
                const LAS unsigned char* s0 = (const LAS unsigned char*)KK16;
                const v2u k0 = *(const LAS v2u*)(s0 + 8 * rq), k1 = *(const LAS v2u*)(s0 + 32 + 8 * rq), k2 = *(const LAS v2u*)(s0 + 64 + 8 * rq), k3 = *(const LAS v2u*)(s0 + 96 + 8 * rq);
                float yd; SCAN_YSK(k0, k1, k2, k3, sk, yd); (void)yd;
            }
            StepOps cur; SCAN_LD(cur, 0);
#pragma unroll 2
            for (int st = 0; st < nst; ++st) {
                StepOps nx; { const int sn = st + 1 < 32 ? st + 1 : 31; SCAN_LD(nx, sn); }
#pragma unroll
                for (int kt = 0; kt < 4; ++kt) acc[kt] = acc[kt] * cur.d[kt];
                v4u b2 = z4; b2.x = rq == 0 ? pk2(sk, cur.vt) : 0u;
#pragma unroll
                for (int kt = 0; kt < 4; ++kt) { v4u a2 = z4; a2.x = rq == 0 ? cur.bk[kt] : 0u; acc[kt] = MFMA16(__builtin_bit_cast(bf16x8, a2), __builtin_bit_cast(bf16x8, b2), acc[kt]); }
                float y; SCAN_YSK(cur.a[0], cur.a[1], cur.a[2], cur.a[3], y, sk);
                if (rq == 0) YB[st * 64 + v0 + n] = y;
                cur = nx;
            }
        }
        __syncthreads();
#pragma unroll
        for (int qq = 0; qq < 4; ++qq) {
            const int st = wave * 4 + qq;
            if (st < nst) {
                const size_t m = (size_t)row0 + c * 32 + st;
                const float y = YB[st * 64 + lane];
                const float mean = wave_sum(y) * (1.f / 64.f);
                const float dv = y - mean;
                const float var = wave_sum(dv * dv) * (1.f / 64.f);
                const float yn = dv * __builtin_amdgcn_rsqf(var + GN_EPS) * gng + gnb;
                const float o = (yn + bq[qq] * ((const LAS float*)V4)[st * 64 + lane]) * gq[qq];
                MIX[m * DM + h * 64 + lane] = (unsigned short)(pk2(o, 0.f) & 0xffffu);
            }
        }
    }
#undef SCAN_PREFETCH
#undef SCAN_LD
#undef SCAN_YSK
    if (act) {
#pragma unroll
        for (int kt = 0; kt < 4; ++kt) *(f32x4*)(Sout + (v0 + n) * 64 + 16 * kt + 4 * rq) = acc[kt];
    }
}

constexpr int CST = 144, CBUF = 64 * CST;
DI void cmm(const LAS unsigned char* L, const LAS unsigned char* Rt, f32x4 (&acc)[2], int tm, int tn0, int n16, int kq) {
#pragma unroll
    for (int ks = 0; ks < 2; ++ks) {
        const bf16x8 a = *(const LAS bf16x8*)(L + (16 * tm + n16) * CST + (32 * ks + 8 * kq) * 2);
#pragma unroll
        for (int j = 0; j < 2; ++j) { const bf16x8 bq = *(const LAS bf16x8*)(Rt + (16 * (tn0 + j) + n16) * CST + (32 * ks + 8 * kq) * 2); acc[j] = MFMA16(a, bq, acc[j]); }
    }
}
template <int MODE> DI void cst_T(LAS unsigned char* X, const f32x4 (&acc)[2], int tm, int tn0, int n16, int rq) {
#pragma unroll
    for (int j = 0; j < 2; ++j) { const int n = 16 * (tn0 + j) + n16, m0 = 16 * tm + 4 * rq; float v[4];
#pragma unroll
        for (int i = 0; i < 4; ++i) { const int col = m0 + i; const bool keep = MODE == 0 ? true : (MODE == 1 ? col < n : (MODE == 2 ? col <= n : col > n)); v[i] = keep ? acc[j][i] : 0.f; }
        *(LAS v2u*)(X + n * CST + m0 * 2) = (v2u){pk2(v[0], v[1]), pk2(v[2], v[3])}; }
}
template <int mode> DI void chunk_head(const Ctx& C, int l, int b, int h, float* Sout, int part) {
    const int tid = C.tid, lane = C.lane, wave = C.wave;
    const int n16 = lane & 15, rq = lane >> 4, tm = wave >> 1, tn0 = (wave & 1) * 2;
    LAS unsigned char* const B0 = C.lds;
#define CB(i) (B0 + (i) * CBUF)
    enum { I_BH = 0, I_BHT = 1, I_AH = 2, I_KH = 3, I_RH = 4, I_ATT = 5, I_KTT = 6, I_VT = 7, I_A1 = 8, I_A1T = 9, I_A2 = 10, I_M1 = 11, I_M2 = 12, I_H0T = 13 };
    LAS float* SEG = (LAS float*)(B0 + 14 * CBUF);
    LAS float* YB = (LAS float*)CB(8);
    const unsigned char* SCb = C.ws + WS_SC;
    const bf16* SCKK = (const bf16*)SCb; const unsigned* SCBK = (const unsigned*)(SCb + 2 * SC_STRIDE); const float* SCLW = (const float*)(SCb + 3 * SC_STRIDE);
    const bf16* SCR = (const bf16*)(SCb + 4 * SC_STRIDE); const float* SCV = (const float*)(SCb + 5 * SC_STRIDE);
    const float* GG = wsp<float>(C, WS_GG); const float* BON = wsp<float>(C, WS_BON);
    bf16* MIX = wsp<bf16>(C, WS_MIX);
    const size_t m0 = (size_t)b * 2048;
    const int pk = tid & 63, seg = tid >> 6, bkidx = (pk & 15) * 4 + (pk >> 4);
    const f32x4 zf = {0.f, 0.f, 0.f, 0.f};
    f32x4 accH[2] = {zf, zf};
    __syncthreads();
    for (int i = tid; i < CBUF / 4; i += NTHREADS) ((LAS unsigned*)CB(I_H0T))[i] = 0u;
    float plw[8], pv[8]; unsigned pbk[8]; unsigned short pkk[8], pr[8];
#define CH_LOAD(cc) do { _Pragma("unroll") for (int i = 0; i < 8; ++i) { const size_t o = (m0 + (cc) * 64 + seg * 8 + i) * 1024 + h * 64; \
        plw[i] = SCLW[o + pk]; pkk[i] = SCKK[o + pk]; pbk[i] = SCBK[o + bkidx]; pr[i] = SCR[o + pk]; pv[i] = SCV[o + pk]; } } while (0)
    unsigned char* const OPS = C.ws + WS_OPS + (size_t)((b * 16 + h) * 24) * OPS_BYTES;
    unsigned* const flag = C.ctl + CW_FLAG + 64 * ((l * 64 + b * 16 + h) * 4);
    const int c_lo = mode ? 16 * part : 0, c_hi = mode ? 16 * part + 16 : 16;
    CH_LOAD(c_lo);
    const float gng = C.inp(18)[l * 1024 + h * 64 + lane], gnb = C.inp(19)[l * 1024 + h * 64 + lane];
    for (int c = c_lo; c < c_hi; ++c) {

        float gq[8], bq[8], vq[8];
#pragma unroll
        for (int i = 0; i < 8; ++i) { const size_t m = m0 + c * 64 + 8 * wave + i; gq[i] = GG[m * 1024 + h * 64 + lane]; bq[i] = BON[m * 16 + h]; vq[i] = SCV[m * 1024 + h * 64 + lane]; }
        float cs[8];
        { float run = 0.f;
#pragma unroll
          for (int i = 0; i < 8; ++i) { run += plw[i]; cs[i] = run; } }
        __syncthreads();
        SEG[seg * 64 + pk] = cs[7];
        __syncthreads();
        float off = 0.f, tot = 0.f;
#pragma unroll
        for (int s = 0; s < 8; ++s) { const float sv = SEG[s * 64 + pk]; tot += sv; off += s < seg ? sv : 0.f; }
        { unsigned short bt[8], at[8], kt[8], vt[8];
#pragma unroll
          for (int i = 0; i < 8; ++i) { const float csv = cs[i] + off;
              const float eP = __expf(csv), eM = __expf(-csv), ePm = __expf(csv - plw[i]), eQ = __expf(tot - csv);
              const float kkf = bf2f(pkk[i]), nb = bflo(pbk[i]), kmf = bfhi(pbk[i]), rf = bf2f(pr[i]);
              const int t = seg * 8 + i;
              const unsigned short vb = (unsigned short)(pk2(kkf * ePm, 0.f) & 0xffffu);
              *(LAS unsigned short*)(CB(I_BH) + t * CST + pk * 2) = vb; bt[i] = vb;
              *(LAS unsigned short*)(CB(I_AH) + t * CST + pk * 2) = (unsigned short)(pk2(nb * eM, 0.f) & 0xffffu);
              *(LAS unsigned short*)(CB(I_KH) + t * CST + pk * 2) = (unsigned short)(pk2(kmf * eM, 0.f) & 0xffffu);
              *(LAS unsigned short*)(CB(I_RH) + t * CST + pk * 2) = (unsigned short)(pk2(rf * eP, 0.f) & 0xffffu);
              at[i] = (unsigned short)(pk2(nb * eQ, 0.f) & 0xffffu); kt[i] = (unsigned short)(pk2(kmf * eQ, 0.f) & 0xffffu); vt[i] = (unsigned short)(pk2(pv[i], 0.f) & 0xffffu); }
#define PK8(a) ((v4u){(unsigned)a[0] | ((unsigned)a[1] << 16), (unsigned)a[2] | ((unsigned)a[3] << 16), (unsigned)a[4] | ((unsigned)a[5] << 16), (unsigned)a[6] | ((unsigned)a[7] << 16)})
          *(LAS v4u*)(CB(I_BHT) + pk * CST + seg * 16) = PK8(bt); *(LAS v4u*)(CB(I_ATT) + pk * CST + seg * 16) = PK8(at);
          *(LAS v4u*)(CB(I_KTT) + pk * CST + seg * 16) = PK8(kt); *(LAS v4u*)(CB(I_VT) + pk * CST + seg * 16) = PK8(vt);
#undef PK8
        }
        if (c + 1 < c_hi) CH_LOAD(c + 1);
        __syncthreads();
        f32x4 accT[2];
        { f32x4 a_[2];
          a_[0] = zf; a_[1] = zf; cmm(CB(I_BH), CB(I_AH), a_, tm, tn0, n16, rq); cst_T<3>(CB(I_A1T), a_, tm, tn0, n16, rq);
          a_[0] = zf; a_[1] = zf; cmm(CB(I_AH), CB(I_BH), a_, tm, tn0, n16, rq); cst_T<1>(CB(I_A1), a_, tm, tn0, n16, rq);
#pragma unroll
          for (int j = 0; j < 2; ++j)
#pragma unroll
              for (int i = 0; i < 4; ++i) { const int m = 16 * tm + 4 * rq + i, n = 16 * (tn0 + j) + n16; accT[j][i] = m < n ? a_[j][i] : (m == n ? 1.f : 0.f); }
          a_[0] = zf; a_[1] = zf; cmm(CB(I_KH), CB(I_BH), a_, tm, tn0, n16, rq); cst_T<1>(CB(I_A2), a_, tm, tn0, n16, rq);
          a_[0] = zf; a_[1] = zf; cmm(CB(I_AH), CB(I_RH), a_, tm, tn0, n16, rq); cst_T<2>(CB(I_M1), a_, tm, tn0, n16, rq);
          a_[0] = zf; a_[1] = zf; cmm(CB(I_KH), CB(I_RH), a_, tm, tn0, n16, rq); cst_T<2>(CB(I_M2), a_, tm, tn0, n16, rq); }
        __syncthreads();
        { int ip = I_A1, ipt = I_A1T, in_ = I_AH, int_ = I_KH;
#pragma unroll 1
          for (int lev = 0; lev < 5; ++lev) {
              cst_T<0>(CB(I_BH), accT, tm, tn0, n16, rq);
              f32x4 a_[2];
              a_[0] = zf; a_[1] = zf; cmm(CB(ip), CB(ipt), a_, tm, tn0, n16, rq); cst_T<0>(CB(int_), a_, tm, tn0, n16, rq);
              a_[0] = zf; a_[1] = zf; cmm(CB(ipt), CB(ip), a_, tm, tn0, n16, rq); cst_T<0>(CB(in_), a_, tm, tn0, n16, rq);
              __syncthreads();
              cmm(CB(int_), CB(I_BH), accT, tm, tn0, n16, rq);
              __syncthreads();
              const int t0 = ip, t1 = ipt; ip = in_; ipt = int_; in_ = t0; int_ = t1;
          }
          cst_T<0>(CB(I_BH), accT, tm, tn0, n16, rq); }
        { f32x4 a_[2];
          a_[0] = zf; a_[1] = zf; cmm(CB(I_A2), CB(I_VT), a_, tm, tn0, n16, rq); cst_T<0>(CB(8), a_, tm, tn0, n16, rq);
          __syncthreads();
          a_[0] = zf; a_[1] = zf; cmm(CB(I_BH), CB(I_BHT), a_, tm, tn0, n16, rq); cst_T<0>(CB(9), a_, tm, tn0, n16, rq);
          a_[0] = zf; a_[1] = zf; cmm(CB(I_BH), CB(8), a_, tm, tn0, n16, rq); cst_T<0>(CB(2), a_, tm, tn0, n16, rq); }
        __syncthreads();
        f32x4 accE[2] = {zf, zf}, accY[2] = {zf, zf};
        { f32x4 a_[2];
          a_[0] = zf; a_[1] = zf; cmm(CB(9), CB(I_ATT), a_, tm, tn0, n16, rq);
#pragma unroll
          for (int j = 0; j < 2; ++j) { const int n = 16 * (tn0 + j) + n16, mm0 = 16 * tm + 4 * rq; float pc = 0.f;
#pragma unroll
              for (int s = 0; s < 8; ++s) pc += SEG[s * 64 + n];
              pc = __expf(pc); float v[4];
#pragma unroll
              for (int i = 0; i < 4; ++i) v[i] = a_[j][i] + (mm0 + i == n ? pc : 0.f);
              *(LAS v2u*)(CB(3) + n * CST + mm0 * 2) = (v2u){pk2(v[0], v[1]), pk2(v[2], v[3])}; }
          cmm(CB(I_ATT), CB(2), accE, tm, tn0, n16, rq); cmm(CB(I_KTT), CB(I_VT), accE, tm, tn0, n16, rq);
          a_[0] = zf; a_[1] = zf; cmm(CB(9), CB(I_M1), a_, tm, tn0, n16, rq);
#pragma unroll
          for (int j = 0; j < 2; ++j) { const int n = 16 * (tn0 + j) + n16, mm0 = 16 * tm + 4 * rq;
              const v2u rh = *(const LAS v2u*)(CB(I_RH) + n * CST + mm0 * 2);
              *(LAS v2u*)(CB(10) + n * CST + mm0 * 2) = (v2u){pk2(a_[j][0] + bflo(rh.x), a_[j][1] + bfhi(rh.x)), pk2(a_[j][2] + bflo(rh.y), a_[j][3] + bfhi(rh.y))}; }
          cmm(CB(I_M1), CB(2), accY, tm, tn0, n16, rq); cmm(CB(I_M2), CB(I_VT), accY, tm, tn0, n16, rq); }
        __syncthreads();
        if (mode == 1) {
            unsigned char* ob = OPS + (size_t)(c - 16) * OPS_BYTES;
            for (int i = tid; i < 2 * CBUF / 16; i += NTHREADS) ((v4u*)ob)[i] = *(const LAS v4u*)((i < CBUF / 16 ? CB(3) : CB(10)) + (i < CBUF / 16 ? i : i - CBUF / 16) * 16);
            ((f32x4*)(ob + 2 * CBUF))[tid * 2] = accE[0]; ((f32x4*)(ob + 2 * CBUF))[tid * 2 + 1] = accE[1];
            ((f32x4*)(ob + 2 * CBUF + 16384))[tid * 2] = accY[0]; ((f32x4*)(ob + 2 * CBUF + 16384))[tid * 2 + 1] = accY[1];
            continue;
        }
        cmm(CB(3), CB(I_H0T), accE, tm, tn0, n16, rq); cmm(CB(10), CB(I_H0T), accY, tm, tn0, n16, rq);
        __syncthreads();
        accH[0] = accE[0]; accH[1] = accE[1];
        cst_T<0>(CB(I_H0T), accH, tm, tn0, n16, rq);
#pragma unroll
        for (int j = 0; j < 2; ++j)
#pragma unroll
            for (int i = 0; i < 4; ++i) YB[(16 * tm + 4 * rq + i) * 64 + 16 * (tn0 + j) + n16] = accY[j][i];
        __syncthreads();
#pragma unroll
        for (int i = 0; i < 8; ++i) {
            const int t = 8 * wave + i; const size_t m = m0 + c * 64 + t;
            const float y = YB[t * 64 + lane];
            const float mean = wave_sum(y) * (1.f / 64.f);
            const float dv = y - mean;
            const float var = wave_sum(dv * dv) * (1.f / 64.f);
            const float yn = dv * __builtin_amdgcn_rsqf(var + GN_EPS) * gng + gnb;
            const float o = (yn + bq[i] * vq[i]) * gq[i];
            MIX[m * DM + h * 64 + lane] = (unsigned short)(pk2(o, 0.f) & 0xffffu);
        }
    }
    if (mode == 0) for (int c = 16; c < 32; ++c) {
            float gq[8], bq[8], vq[8];
#pragma unroll
            for (int i = 0; i < 8; ++i) { const size_t m = m0 + c * 64 + 8 * wave + i; gq[i] = GG[m * 1024 + h * 64 + lane]; bq[i] = BON[m * 16 + h]; vq[i] = SCV[m * 1024 + h * 64 + lane]; }
            if ((c & 15) == 0) {
                if (tid == 0) { unsigned sp = 0; while (__hip_atomic_load(flag + 64 * (c >> 4), __ATOMIC_RELAXED, __HIP_MEMORY_SCOPE_AGENT) == 0u) { __builtin_amdgcn_s_sleep(8); if (++sp > (1u << 22)) break; }
                    __builtin_amdgcn_fence(__ATOMIC_ACQUIRE, "agent"); asm volatile("s_waitcnt vmcnt(0)" ::: "memory"); }
            }
            __syncthreads();
            const unsigned char* ob = OPS + (size_t)(c - 16) * OPS_BYTES;
            for (int i = tid; i < 2 * CBUF / 16; i += NTHREADS) { const v4u w = ((const v4u*)ob)[i]; *(LAS v4u*)((i < CBUF / 16 ? CB(3) : CB(10)) + (i < CBUF / 16 ? i : i - CBUF / 16) * 16) = w; }
            f32x4 accE[2], accY[2];
            accE[0] = ((const f32x4*)(ob + 2 * CBUF))[tid * 2]; accE[1] = ((const f32x4*)(ob + 2 * CBUF))[tid * 2 + 1];
            accY[0] = ((const f32x4*)(ob + 2 * CBUF + 16384))[tid * 2]; accY[1] = ((const f32x4*)(ob + 2 * CBUF + 16384))[tid * 2 + 1];
            __syncthreads();
            cmm(CB(3), CB(I_H0T), accE, tm, tn0, n16, rq); cmm(CB(10), CB(I_H0T), accY, tm, tn0, n16, rq);
            __syncthreads();
            accH[0] = accE[0]; accH[1] = accE[1];
            cst_T<0>(CB(I_H0T), accH, tm, tn0, n16, rq);
#pragma unroll
            for (int j = 0; j < 2; ++j)
#pragma unroll
                for (int i = 0; i < 4; ++i) YB[(16 * tm + 4 * rq + i) * 64 + 16 * (tn0 + j) + n16] = accY[j][i];
            __syncthreads();
#pragma unroll
            for (int i = 0; i < 8; ++i) {
                const int t = 8 * wave + i; const size_t m = m0 + c * 64 + t;
                const float y = YB[t * 64 + lane];
                const float mean = wave_sum(y) * (1.f / 64.f);
                const float dv = y - mean;
                const float var = wave_sum(dv * dv) * (1.f / 64.f);
                const float yn = dv * __builtin_amdgcn_rsqf(var + GN_EPS) * gng + gnb;
                const float o = (yn + bq[i] * vq[i]) * gq[i];
                MIX[m * DM + h * 64 + lane] = (unsigned short)(pk2(o, 0.f) & 0xffffu);
            }
    }
#undef CH_LOAD
#undef CB
    if (mode == 1) {
        asm volatile("s_waitcnt vmcnt(0)" ::: "memory");
        __syncthreads();
        if (tid == 0) { __builtin_amdgcn_fence(__ATOMIC_RELEASE, "agent"); asm volatile("s_waitcnt vmcnt(0)" ::: "memory"); __hip_atomic_store(flag + 64 * part, 1u, __ATOMIC_RELAXED, __HIP_MEMORY_SCOPE_AGENT); }
        return;
    }
#pragma unroll
    for (int j = 0; j < 2; ++j) *(f32x4*)(Sout + (size_t)(16 * (tn0 + j) + n16) * 64 + 16 * tm + 4 * rq) = accH[j];
}

#define MFMA32(a, b, c) __builtin_amdgcn_mfma_f32_32x32x16_bf16((a), (b), (c), 0, 0, 0)
DI bf16x8 pack8(const f32x16& p, int s) {
    v4u o; o.x = pk2(p[8 * s], p[8 * s + 1]); o.y = pk2(p[8 * s + 2], p[8 * s + 3]); o.z = pk2(p[8 * s + 4], p[8 * s + 5]); o.w = pk2(p[8 * s + 6], p[8 * s + 7]);
    return __builtin_bit_cast(bf16x8, o);
}
DI bf16x8 ld_vt(const bf16* p) {
    const v2u a = *(const v2u*)p, b = *(const v2u*)(p + 8);
    v4u o; o.x = a.x; o.y = a.y; o.z = b.x; o.w = b.y; return __builtin_bit_cast(bf16x8, o);
}
constexpr int KT_STRIDE = 144, VTT_STRIDE = 136, KT_BYTES = 64 * KT_STRIDE, TILE_BYTES = KT_BYTES + 64 * VTT_STRIDE, TILE_OFF = 74752;
struct TileRegs { v4u k, v; };
DI TileRegs tile_load(const bf16* kbase, size_t kstride, const bf16* vbase, size_t vstride, int tid) {
    TileRegs r; const int row = tid >> 3, ch = tid & 7;
    r.k = *(const v4u*)(kbase + (size_t)row * kstride + ch * 8); r.v = *(const v4u*)(vbase + (size_t)row * vstride + ch * 8); return r;
}
DI void tile_store(LAS unsigned char* buf, const TileRegs& r, int tid) {
    const int row = tid >> 3, ch = tid & 7;
    *(LAS v4u*)(buf + row * KT_STRIDE + ch * 16) = r.k;
    *(LAS v2u*)(buf + KT_BYTES + row * VTT_STRIDE + ch * 16) = (v2u){r.v.x, r.v.y}; *(LAS v2u*)(buf + KT_BYTES + row * VTT_STRIDE + ch * 16 + 8) = (v2u){r.v.z, r.v.w};
}
DI bf16x8 ld_vt_lds(const LAS unsigned char* p) {
    const v2u a = *(const LAS v2u*)p, b = *(const LAS v2u*)(p + 16);
    v4u o; o.x = a.x; o.y = a.y; o.z = b.x; o.w = b.y; return __builtin_bit_cast(bf16x8, o);
}
#define ATT_BLOCK(EDGE, BUF, KEYBLK0, MINE, VALID_EXPR) do { \
    const float bias_ = (MINE) ? 0.f : NEG_BIG; \
    _Pragma("unroll 1") for (int tile = 0; tile < 2; ++tile) { const int key0 = (KEYBLK0) + tile * 32; (void)key0; \
        f32x16 a_ = zero16; \
        _Pragma("unroll") for (int s = 0; s < 4; ++s) { const bf16x8 kf = *(const LAS bf16x8*)((BUF) + (tile * 32 + q) * KT_STRIDE + 32 * s + 16 * hi); a_ = MFMA32(kf, qf[s], a_); } \
        float tm = NEG_BIG; \
        if (EDGE) { _Pragma("unroll") for (int i = 0; i < 16; ++i) { const int key = key0 + crow(i, hi); const bool ok = (MINE) && (VALID_EXPR); a_[i] = ok ? a_[i] * SCL2 : NEG_BIG; tm = fmaxf(tm, a_[i]); } } \
        else { _Pragma("unroll") for (int i = 0; i < 16; ++i) { a_[i] = a_[i] * SCL2 + bias_; tm = fmaxf(tm, a_[i]); } } \
        tm = fmaxf(tm, __shfl_xor(tm, 32)); \
        const float mn = fmaxf(mrun, tm); const float sc_ = __builtin_amdgcn_exp2f(mrun - mn); \
        float ps = 0.f; \
        if (EDGE) { _Pragma("unroll") for (int i = 0; i < 16; ++i) { const float p_ = a_[i] > -1e29f ? __builtin_amdgcn_exp2f(a_[i] - mn) : 0.f; a_[i] = p_; ps += p_; } } \
        else { _Pragma("unroll") for (int i = 0; i < 16; ++i) { const float p_ = __builtin_amdgcn_exp2f(a_[i] - mn); a_[i] = p_; ps += p_; } } \
        ps += __shfl_xor(ps, 32); \
        lrun = lrun * sc_ + ps; mrun = mn; \
        _Pragma("unroll") for (int i = 0; i < 16; ++i) { oa[0][i] *= sc_; oa[1][i] *= sc_; } \
        _Pragma("unroll") for (int s = 0; s < 2; ++s) { const bf16x8 pb = pack8(a_, s); \
            oa[0] = MFMA32(ld_vt_lds((BUF) + KT_BYTES + q * VTT_STRIDE + (tile * 32 + 16 * s + 4 * hi) * 2), pb, oa[0]); \
            oa[1] = MFMA32(ld_vt_lds((BUF) + KT_BYTES + (32 + q) * VTT_STRIDE + (tile * 32 + 16 * s + 4 * hi) * 2), pb, oa[1]); } \
    } } while (0)
constexpr float SCL2 = 0.125f * 1.4426950408889634f;

DI void nsa_prompt_unit(const Ctx& C, int l, int b, int kvh, int qt, bool skipblk = false, bool skipcmp = false) {
    const int tid = C.tid, lane = C.lane, wave = C.wave;
    const int g = wave & 3, th = wave >> 2, q = lane & 31, hi = lane >> 5;
    LAS float* IMP = (LAS float*)C.lds;
    LAS float* IMPV = (LAS float*)(C.lds + 65536);
    LAS unsigned* SELM = (LAS unsigned*)(C.lds + 65536 + 8192);
    LAS unsigned char* TB = C.lds + TILE_OFF;
    const bf16* P = wsp<bf16>(C, WS_PROJ);
    const int tok = qt * 64 + th * 32 + q;
    const size_t m = (size_t)b * 2048 + tok;
    const int bk = b * 4 + kvh, head = kvh * 4 + g;
    f32x16 zero16;
#pragma unroll
    for (int i = 0; i < 16; ++i) zero16[i] = 0.f;
    bf16x8 qf[4];
#pragma unroll
    for (int s = 0; s < 4; ++s) qf[s] = *(const bf16x8*)(P + m * PLD + Q_OFF + head * 64 + 16 * s + 8 * hi);
    f32x16 out0 = zero16, out1 = zero16;
    const float g0 = sigmoidf_(bf2f(P[m * PLD + GL_OFF + head * 3 + 0])), g1 = sigmoidf_(bf2f(P[m * PLD + GL_OFF + head * 3 + 1])), g2 = sigmoidf_(bf2f(P[m * PLD + GL_OFF + head * 3 + 2]));
    TileRegs tr = tile_load(wsp<bf16>(C, WS_KCB) + (size_t)bk * 4096, 64, wsp<bf16>(C, WS_VCBT) + (size_t)bk * 4096, 64, tid);
    __syncthreads();
    tile_store(TB, tr, tid);
    __syncthreads();
    if (!skipcmp) {
    {
        f32x16 sc[2];
        const int nvalid = (tok + 1) >> 5;
        float mx = NEG_BIG;
#pragma unroll
        for (int tile = 0; tile < 2; ++tile) {
            f32x16 a_ = zero16;
#pragma unroll
            for (int s = 0; s < 4; ++s) { const bf16x8 kf = *(const LAS bf16x8*)(TB + (tile * 32 + q) * KT_STRIDE + 32 * s + 16 * hi); a_ = MFMA32(kf, qf[s], a_); }
#pragma unroll
            for (int i = 0; i < 16; ++i) { const int n = tile * 32 + crow(i, hi); a_[i] = n < nvalid ? a_[i] * 0.125f : NEG_BIG; mx = fmaxf(mx, a_[i]); }
            sc[tile] = a_;
        }
        mx = fmaxf(mx, __shfl_xor(mx, 32));
        float sum = 0.f;
#pragma unroll
        for (int tile = 0; tile < 2; ++tile)
#pragma unroll
            for (int i = 0; i < 16; ++i) { const float p_ = sc[tile][i] > -1e29f ? __expf(sc[tile][i] - mx) : 0.f; sc[tile][i] = p_; sum += p_; }
        sum += __shfl_xor(sum, 32);
        const float inv = nvalid > 0 ? 1.f / sum : 0.f;
        f32x16 oc0 = zero16, oc1 = zero16;
#pragma unroll
        for (int tile = 0; tile < 2; ++tile) {
#pragma unroll
            for (int i = 0; i < 16; ++i) sc[tile][i] *= inv;
#pragma unroll
            for (int i4 = 0; i4 < 4; ++i4) { f32x4 v = {sc[tile][4 * i4], sc[tile][4 * i4 + 1], sc[tile][4 * i4 + 2], sc[tile][4 * i4 + 3]};
                *(LAS f32x4*)(IMP + ((size_t)(g * 64 + th * 32 + q)) * 64 + tile * 32 + 8 * i4 + 4 * hi) = v; }
#pragma unroll
            for (int s = 0; s < 2; ++s) { const bf16x8 pb = pack8(sc[tile], s);
                oc0 = MFMA32(ld_vt_lds(TB + KT_BYTES + q * VTT_STRIDE + (tile * 32 + 16 * s + 4 * hi) * 2), pb, oc0);
                oc1 = MFMA32(ld_vt_lds(TB + KT_BYTES + (32 + q) * VTT_STRIDE + (tile * 32 + 16 * s + 4 * hi) * 2), pb, oc1); }
        }
#pragma unroll
        for (int i = 0; i < 16; ++i) { out0[i] = g0 * oc0[i]; out1[i] = g0 * oc1[i]; }
    }
    __syncthreads();
    {
        const int tokl = tid >> 3, jq = tid & 7;
        float v[4];
#pragma unroll
        for (int e = 0; e < 4; ++e) v[e] = 0.f;
#pragma unroll
        for (int gg = 0; gg < 4; ++gg) { const f32x4 a = *(const LAS f32x4*)(IMP + (size_t)(gg * 64 + tokl) * 64 + 8 * jq), bq = *(const LAS f32x4*)(IMP + (size_t)(gg * 64 + tokl) * 64 + 8 * jq + 4);
            v[0] += a[0] + a[1]; v[1] += a[2] + a[3]; v[2] += bq[0] + bq[1]; v[3] += bq[2] + bq[3]; }
        const int cur = qt;
#pragma unroll
        for (int e = 0; e < 4; ++e) { const int j = 4 * jq + e; const bool forced = (j == 0) | (j == cur) | (j == cur - 1); v[e] = j > cur ? -1.f : (forced ? 1e4f : v[e]); }
        *(LAS f32x4*)(IMPV + tokl * 32 + 4 * jq) = (f32x4){v[0], v[1], v[2], v[3]};
        __syncthreads();
        int rank[4] = {0, 0, 0, 0};
#pragma unroll
        for (int jj4 = 0; jj4 < 8; ++jj4) { const f32x4 o = *(const LAS f32x4*)(IMPV + tokl * 32 + 4 * jj4);
#pragma unroll
            for (int u = 0; u < 4; ++u) { const int jp = 4 * jj4 + u; const float ov = o[u];
#pragma unroll
                for (int e = 0; e < 4; ++e) { const int j = 4 * jq + e; rank[e] += (ov > v[e] || (ov == v[e] && jp < j)) ? 1 : 0; } } }
        unsigned bits = 0;
#pragma unroll
        for (int e = 0; e < 4; ++e) if (rank[e] < 16 && v[e] >= 0.f) bits |= 1u << (4 * jq + e);
        bits |= __shfl_xor(bits, 1); bits |= __shfl_xor(bits, 2); bits |= __shfl_xor(bits, 4);
        if (jq == 0) SELM[tokl] = bits;
        __syncthreads();
    }
    }
    if (skipcmp && tid < 64) SELM[tid] = 0xffffffffu;
    __syncthreads();
    const unsigned selm = SELM[th * 32 + q];
    unsigned uni;
    { unsigned u0 = SELM[lane];
#pragma unroll
      for (int o = 1; o < 64; o <<= 1) u0 |= __shfl_xor(u0, o);
      uni = __builtin_amdgcn_readfirstlane(u0); }
    {
        LAS float* PARK = (LAS float*)C.lds + wave * 2048 + lane;
#pragma unroll
        for (int i = 0; i < 16; ++i) { PARK[i * 64] = out0[i]; PARK[(16 + i) * 64] = out1[i]; }
        const bf16* KBs = wsp<bf16>(C, WS_KSC) + (size_t)bk * 2048 * 64; const bf16* KBw = wsp<bf16>(C, WS_KWC) + (size_t)bk * 2048 * 64;
        const bf16* VTs = wsp<bf16>(C, WS_VTS) + (size_t)bk * 32 * 4096; const bf16* VTw = wsp<bf16>(C, WS_VTW) + (size_t)bk * 32 * 4096;
        f32x16 oa[2] = {zero16, zero16}; float mrun = NEG_BIG, lrun = 0.f;
        unsigned rem = skipblk ? 1u : uni; int wj = skipblk ? qt : (qt > 8 ? qt - 8 : 0); bool folded = false;
#define NEXT_BLK(dst) do { if (rem) { dst = __builtin_ctz(rem); rem &= rem - 1; } else if (wj <= qt) { dst = wj | 256; ++wj; } else dst = -1; } while (0)
#define LOAD_BLK(tr_, d_) do { const int j_ = (d_) & 255; tr_ = ((d_) & 256) ? tile_load(KBw + (size_t)j_ * 4096, 64, VTw + (size_t)j_ * 4096, 64, tid) : tile_load(KBs + (size_t)j_ * 4096, 64, VTs + (size_t)j_ * 4096, 64, tid); } while (0)
#define FOLD(gate_) do { const float il_ = (gate_) / lrun; _Pragma("unroll") for (int i = 0; i < 16; ++i) { PARK[i * 64] += il_ * oa[0][i]; PARK[(16 + i) * 64] += il_ * oa[1][i]; } \
            oa[0] = zero16; oa[1] = zero16; mrun = NEG_BIG; lrun = 0.f; } while (0)
#define DO_BLK(d_, buf_) do { const int j_ = (d_) & 255; const bool win_ = ((d_) & 256) != 0; \
            if (win_ && !folded) { FOLD(g1); folded = true; } \
            const bool mine = win_ ? true : (((selm >> j_) & 1u) != 0u); \
            if (__any(mine)) { const int wl_ = win_ ? 511 : (1 << 20); const bool edge_ = (j_ == qt) || (win_ && j_ + 8 <= qt); \
                if (edge_) ATT_BLOCK(1, buf_, j_ * 64, mine, (key <= tok && key + wl_ >= tok)); else ATT_BLOCK(0, buf_, j_ * 64, mine, true); } } while (0)
        int d0, d1, d2; TileRegs trA, trB;
        NEXT_BLK(d0); NEXT_BLK(d1);
        LOAD_BLK(trA, d0); if (d1 >= 0) LOAD_BLK(trB, d1);
        __syncthreads();
        for (;;) {
            tile_store(TB, trA, tid); __syncthreads();
            NEXT_BLK(d2); if (d2 >= 0) LOAD_BLK(trA, d2);
            DO_BLK(d0, TB);
            if (d1 < 0) break;
            tile_store(TB + TILE_BYTES, trB, tid); __syncthreads();
            NEXT_BLK(d0); if (d0 >= 0) LOAD_BLK(trB, d0);
            DO_BLK(d1, TB + TILE_BYTES);
            if (d2 < 0) break;
            d1 = d0; d0 = d2;
        }
        FOLD(g2);
#undef NEXT_BLK
#undef LOAD_BLK
#undef FOLD
#undef DO_BLK
#pragma unroll
        for (int i = 0; i < 16; ++i) { out0[i] = PARK[i * 64]; out1[i] = PARK[(16 + i) * 64]; }
    }
    bf16* MIX = wsp<bf16>(C, WS_MIX) + m * DM + 1024 + head * 64;
    if (!skipblk)
#pragma unroll
    for (int i4 = 0; i4 < 4; ++i4) {
        v2u o; o.x = pk2(out0[4 * i4], out0[4 * i4 + 1]); o.y = pk2(out0[4 * i4 + 2], out0[4 * i4 + 3]); *(v2u*)(MIX + 8 * i4 + 4 * hi) = o;
        o.x = pk2(out1[4 * i4], out1[4 * i4 + 1]); o.y = pk2(out1[4 * i4 + 2], out1[4 * i4 + 3]); *(v2u*)(MIX + 32 + 8 * i4 + 4 * hi) = o;
    }
}

template <class RowFn> DI void samp_block(const RowFn& rowptr, int nvalid, int kvh, const LAS float* QS, LAS float* PWw, int lane, float (&M)[4], float (&L)[4], float (&O)[4]) {
    float s[4] = {0.f, 0.f, 0.f, 0.f};
    const bool ok = lane < nvalid;
    if (ok) {
        const f32x4* kr = (const f32x4*)(rowptr(lane) + kvh * 64);
#pragma unroll 4
        for (int d4 = 0; d4 < 16; ++d4) { const f32x4 kq = kr[d4];
#pragma unroll
            for (int g = 0; g < 4; ++g) { const f32x4 qq = *(const LAS f32x4*)(QS + g * 64 + 4 * d4); s[g] += kq[0] * qq[0] + kq[1] * qq[1] + kq[2] * qq[2] + kq[3] * qq[3]; } }
    }
    float mb[4], lb[4];
#pragma unroll
    for (int g = 0; g < 4; ++g) { const float sv = ok ? s[g] : NEG_BIG; mb[g] = wave_max(sv); const float p = ok ? expf(sv - mb[g]) : 0.f; lb[g] = wave_sum(p); PWw[g * 64 + lane] = p; }
    LDS_WAIT(); asm volatile("" ::: "memory");
    float ob[4] = {0.f, 0.f, 0.f, 0.f};
    for (int r0 = 0; r0 < nvalid; r0 += 4) {
        float vv[4];
#pragma unroll
        for (int u = 0; u < 4; ++u) vv[u] = r0 + u < nvalid ? rowptr(r0 + u)[256 + kvh * 64 + lane] : 0.f;
#pragma unroll
        for (int u = 0; u < 4; ++u)
#pragma unroll
            for (int g = 0; g < 4; ++g) ob[g] += PWw[g * 64 + r0 + u] * vv[u]; }
    LDS_WAIT(); asm volatile("" ::: "memory");
#pragma unroll
    for (int g = 0; g < 4; ++g) { const float mn = fmaxf(M[g], mb[g]); const float a = expf(M[g] - mn), bsc = expf(mb[g] - mn); L[g] = L[g] * a + lb[g] * bsc; O[g] = O[g] * a + ob[g] * bsc; M[g] = mn; }
}
DI float samp_combine(LAS float* WST, int tid, int lane, int wave, const float (&M)[4], const float (&L)[4], const float (&O)[4]) {
    __syncthreads();
#pragma unroll
    for (int g = 0; g < 4; ++g) { WST[wave * 264 + 8 + g * 64 + lane] = O[g]; if (lane == 0) { WST[wave * 264 + g] = M[g]; WST[wave * 264 + 4 + g] = L[g]; } }
    __syncthreads();
    float res = 0.f;
    if (tid < 256) { const int g = tid >> 6, d = tid & 63; float mm = NEG_BIG;
#pragma unroll
        for (int w = 0; w < 8; ++w) mm = fmaxf(mm, WST[w * 264 + g]);
        float ll = 0.f, oo = 0.f;
#pragma unroll
        for (int w = 0; w < 8; ++w) { const float e = expf(WST[w * 264 + g] - mm); ll += WST[w * 264 + 4 + g] * e; oo += WST[w * 264 + 8 + g * 64 + d] * e; }
        res = oo / ll; }
    return res;
}

DI void nsa_sample_item(const Ctx& C, int l, int b, int t, int kvh) {
    const int tid = C.tid, lane = C.lane, wave = C.wave;
    LAS float* F = (LAS float*)C.lds;
    LAS float *QS = F, *PC = F + 256, *IMPS = F + 2304, *RED = F + 2624, *RED2 = F + 2688, *OCP = F + 2752, *PW = F + 4800, *WST = F + 6848;
    LAS int* SELB = (LAS int*)(F + 2560);
    const bf16* P = wsp<bf16>(C, WS_PROJ);
    const size_t m = (size_t)NTP + b * 4 + t;
    __syncthreads();
    if (tid < 256) QS[tid] = bf2f(P[m * PLD + Q_OFF + kvh * 256 + tid]) * 0.125f;
    __syncthreads();
    float ocmp = 0.f;
    {
        const float* KC = wsp<float>(C, WS_KCBS) + ((size_t)((l * 8 + b) * 4 + kvh) * 512) * 64;
        const float* VC = wsp<float>(C, WS_VCBS) + ((size_t)((l * 8 + b) * 4 + kvh) * 512) * 64;
        float s[4] = {0.f, 0.f, 0.f, 0.f};
        const f32x4* kr = (const f32x4*)(KC + (size_t)tid * 64);
#pragma unroll 4
        for (int d4 = 0; d4 < 16; ++d4) { const f32x4 kq = kr[d4];
#pragma unroll
            for (int g = 0; g < 4; ++g) { const f32x4 qq = *(const LAS f32x4*)(QS + g * 64 + 4 * d4); s[g] += kq[0] * qq[0] + kq[1] * qq[1] + kq[2] * qq[2] + kq[3] * qq[3]; } }
#pragma unroll
        for (int g = 0; g < 4; ++g) { const float wm = wave_max(s[g]); if (lane == 0) RED[wave * 4 + g] = wm; }
        __syncthreads();
        float p[4];
#pragma unroll
        for (int g = 0; g < 4; ++g) { float mm = RED[g];
#pragma unroll
            for (int w = 1; w < 8; ++w) mm = fmaxf(mm, RED[w * 4 + g]);
            p[g] = expf(s[g] - mm); const float ws = wave_sum(p[g]); if (lane == 0) RED2[wave * 4 + g] = ws; }
        __syncthreads();
#pragma unroll
        for (int g = 0; g < 4; ++g) { float tot = 0.f;
#pragma unroll
            for (int w = 0; w < 8; ++w) tot += RED2[w * 4 + g];
            PC[g * 512 + tid] = p[g] / tot; }
        __syncthreads();
        if (tid < 256) IMPS[tid] = (PC[2 * tid] + PC[2 * tid + 1]) + (PC[512 + 2 * tid] + PC[512 + 2 * tid + 1]) + (PC[1024 + 2 * tid] + PC[1024 + 2 * tid + 1]) + (PC[1536 + 2 * tid] + PC[1536 + 2 * tid + 1]);
        { const int d = tid & 63, nq = tid >> 6; float acc[4] = {0.f, 0.f, 0.f, 0.f};
#pragma unroll 4
            for (int n = nq * 64; n < nq * 64 + 64; ++n) { const float vv = VC[(size_t)n * 64 + d];
#pragma unroll
                for (int g = 0; g < 4; ++g) acc[g] += PC[g * 512 + n] * vv; }
#pragma unroll
            for (int g = 0; g < 4; ++g) OCP[(nq * 4 + g) * 64 + d] = acc[g]; }
        __syncthreads();
        if (tid < 256) { const int g = tid >> 6, d = tid & 63;
#pragma unroll
            for (int nq = 0; nq < 8; ++nq) ocmp += OCP[(nq * 4 + g) * 64 + d];
            const int j = tid;
            if (j >= 1 && j <= 254) { const float v = IMPS[j]; int rank = 0;
                for (int jp = 1; jp <= 254; ++jp) { const float ov = IMPS[jp]; rank += (ov > v || (ov == v && jp < j)) ? 1 : 0; }
                if (rank < 13) SELB[rank] = j; }
            if (tid == 0) { SELB[13] = 0; SELB[14] = 255; SELB[15] = 256; }
        }
        __syncthreads();
    }
    float osel;
    {
        float M[4] = {NEG_BIG, NEG_BIG, NEG_BIG, NEG_BIG}, L[4] = {0.f, 0.f, 0.f, 0.f}, O[4] = {0.f, 0.f, 0.f, 0.f};
        const int* pt = (const int*)C.inp(4) + b * 128;
        for (int bi = 0; bi < 2; ++bi) {
            const int jb = __builtin_amdgcn_readfirstlane(SELB[2 * wave + bi]);
            if (jb < 256) { const int pid = pt[jb >> 1];
                const float* base = C.inp(3) + ((size_t)(l * NPOOL + pid) * 128 + (jb & 1) * 64) * 512;
                samp_block([&](int r) { return base + (size_t)r * 512; }, 64, kvh, QS, PW + wave * 256, lane, M, L, O);
            } else { const float* base = C.out + O_SEL_S + ((size_t)l * NTS + b * 4) * 512;
                samp_block([&](int r) { return base + (size_t)r * 512; }, t + 1, kvh, QS, PW + wave * 256, lane, M, L, O); }
        }
        osel = samp_combine(WST, tid, lane, wave, M, L, O);
    }
    float owin;
    {
        float M[4] = {NEG_BIG, NEG_BIG, NEG_BIG, NEG_BIG}, L[4] = {0.f, 0.f, 0.f, 0.f}, O[4] = {0.f, 0.f, 0.f, 0.f};
        const float* pre = C.inp(5) + (size_t)(l * 8 + b) * 262144;
        const float* nw = C.out + O_WIN_S + ((size_t)(l * 8 + b) * 512 + 508) * 512;
        samp_block([&](int r) { const int p = t + 1 + 64 * wave + r; return p <= 511 ? pre + (size_t)p * 512 : nw + (size_t)(p - 512) * 512; }, 64, kvh, QS, PW + wave * 256, lane, M, L, O);
        owin = samp_combine(WST, tid, lane, wave, M, L, O);
    }
    if (tid < 256) { const int g = tid >> 6, d = tid & 63, head = kvh * 4 + g;
        const float g0 = sigmoidf_(bf2f(P[m * PLD + GL_OFF + head * 3 + 0])), g1 = sigmoidf_(bf2f(P[m * PLD + GL_OFF + head * 3 + 1])), g2 = sigmoidf_(bf2f(P[m * PLD + GL_OFF + head * 3 + 2]));
        const float o = g0 * ocmp + g1 * osel + g2 * owin;
        wsp<bf16>(C, WS_MIX)[m * DM + 1024 + head * 64 + d] = (unsigned short)(pk2(o, 0.f) & 0xffffu); }
}

#ifndef C_MASK
#define C_MASK 7
#endif
constexpr int PC_SCAN_P = 128, PC_ATT_P = 512, PC_ATT_S = 128, PC_SCAN_S = 128, PC_ITEMS = PC_SCAN_P + PC_ATT_P + PC_ATT_S + PC_SCAN_S;
DI void phase_c(const Ctx& C0, int lq, int cmask = 7) {
    const int l = lq & 1;
    LAS int* slot = (LAS int*)(C0.lds + MISC_OFF + 64);
    for (;;) {
        __syncthreads();
        if (C0.tid == 0) *slot = (int)atomicAdd(C0.ctl + CW_QUEUE + 64 * lq, 1u);
        __syncthreads();
        int it = *slot;
        if (it >= PC_ITEMS) {
            if (lq != 0 || it - PC_ITEMS >= DEF_GROUPS) break;
            Ctx K = C0; { K.ws = launder_g(K.ws); K.out = launder_g(K.out); int t_ = K.tid; asm volatile("" : "+v"(t_)); K.tid = t_; K.lane = t_ & 63; K.wave = __builtin_amdgcn_readfirstlane(t_ >> 6); }
            for (int e = 0; e < 4; ++e) deferred_item(K, (it - PC_ITEMS) * 4 + e);
            continue;
        }
        Ctx K = C0; { K.ws = launder_g(K.ws); K.out = launder_g(K.out); int t_ = K.tid; asm volatile("" : "+v"(t_)); K.tid = t_; K.lane = t_ & 63; K.wave = __builtin_amdgcn_readfirstlane(t_ >> 6); }
        const Ctx& C = K;
        if (it >= PC_SCAN_P && it < PC_SCAN_P + PC_ATT_S) it += PC_ATT_P; else if (it >= PC_SCAN_P + PC_ATT_S && it < PC_SCAN_P + PC_ATT_S + PC_ATT_P) it -= PC_ATT_S;
        if (it < PC_SCAN_P || it >= PC_SCAN_P + PC_ATT_P + PC_ATT_S) {
            int row0, T, h; const float* S0; float* So;
            int cmode = 0;
            if (it < PC_SCAN_P) { const int u = it & 63, b = u >> 4; cmode = it < 64 ? 1 : 0; h = u & 15; row0 = b * 2048; T = 2048; S0 = nullptr; So = C.out + O_RW_P + ((size_t)(l * 4 + b) * 16 + h) * 4096; }
            else { const int u = it - (PC_SCAN_P + PC_ATT_P + PC_ATT_S), b = u >> 4; h = u & 15; row0 = NTP + b * 4; T = 4; S0 = C.inp(6) + ((size_t)(l * 8 + b) * 16 + h) * 4096; So = C.out + O_RW_S + ((size_t)(l * 8 + b) * 16 + h) * 4096; }
            if (cmask & 1) { if (S0) scan_head(C, l, row0, T, h, S0, So); else if (cmode) chunk_head<1>(C, l, row0 >> 11, h, So, cmode); else chunk_head<0>(C, l, row0 >> 11, h, So, 0); }
        } else if (it < PC_SCAN_P + PC_ATT_P) {
            const int u = it - PC_SCAN_P, qt = 31 - (u >> 4), bk = u & 15;
            if (cmask & 2) nsa_prompt_unit(C, l, bk >> 2, bk & 3, qt, (cmask & 8) != 0, (cmask & 16) != 0);
        } else {
            const int u = it - (PC_SCAN_P + PC_ATT_P);
            if (cmask & 4) nsa_sample_item(C, l, u >> 4, (u >> 2) & 3, u & 3);
        }
    }
    __syncthreads();
}

DI const float* xin_row(const Ctx& C, int l, size_t m) {
    if (l == 0) return m < (size_t)NTP ? C.inp(0) + m * DM : C.inp(1) + (m - NTP) * DM;
    return wsp<float>(C, WS_XF1) + m * DM;
}
DI void phase_e(const Ctx& C, int l) {
    const int lane = C.lane;
    const bf16* H = wsp<bf16>(C, WS_HS);
    bf16* X1B = wsp<bf16>(C, WS_X1B); const bf16* XB = wsp<bf16>(C, WS_XB);
    const float* gw = C.inp(22) + (size_t)l * DM; const float* bw = C.inp(23) + (size_t)l * DM;
    for (int m = blockIdx.x * NWAVES + C.wave; m < NT; m += C.G * NWAVES) {
        const v2u* hr = (const v2u*)(H + (size_t)m * DM) + lane;
        f32x4 v[8]; float s = 0.f;
        if (l == 0) { const f32x4* xr = (const f32x4*)xin_row(C, l, m) + lane;
#pragma unroll
            for (int j = 0; j < 8; ++j) { const v2u hb = hr[64 * j]; v[j] = xr[64 * j] * DN_ALPHA + (f32x4){bflo(hb.x), bfhi(hb.x), bflo(hb.y), bfhi(hb.y)}; }
        } else { const v2u* xr = (const v2u*)(XB + (size_t)m * DM) + lane;
#pragma unroll
            for (int j = 0; j < 8; ++j) { const v2u hb = hr[64 * j], xb = xr[64 * j]; v[j] = (f32x4){bflo(xb.x), bfhi(xb.x), bflo(xb.y), bfhi(xb.y)} * DN_ALPHA + (f32x4){bflo(hb.x), bfhi(hb.x), bflo(hb.y), bfhi(hb.y)}; } }
#pragma unroll
        for (int j = 0; j < 8; ++j) s += (v[j][0] + v[j][1]) + (v[j][2] + v[j][3]);
        const float mean = wave_sum(s) * (1.f / DM); float s2 = 0.f;
#pragma unroll
        for (int j = 0; j < 8; ++j) { v[j] = v[j] - mean; s2 += (v[j][0] * v[j][0] + v[j][1] * v[j][1]) + (v[j][2] * v[j][2] + v[j][3] * v[j][3]); }
        const float rstd = 1.f / sqrtf(wave_sum(s2) * (1.f / DM) + LN_EPS);
        float am = 0.f;
#pragma unroll
        for (int j = 0; j < 8; ++j) { const f32x4 gg = ((const f32x4*)gw)[lane + 64 * j], bb = ((const f32x4*)bw)[lane + 64 * j];
            const f32x4 o = v[j] * rstd * gg + bb; v[j] = o;
            am = fmaxf(am, fmaxf(fmaxf(fabsf(o[0]), fabsf(o[1])), fmaxf(fabsf(o[2]), fabsf(o[3]))));
            v2u p; p.x = pk2(o[0], o[1]); p.y = pk2(o[2], o[3]); ((v2u*)(X1B + (size_t)m * DM))[lane + 64 * j] = p; }
        am = wave_max(am);
        const float qs = am > 0.f ? am * (1.f / 127.f) : 1.f, qi = 1.f / qs;
#pragma unroll
        for (int j = 0; j < 8; ++j) { const f32x4 x = v[j] * qi;
            ((unsigned*)(C.ws + WS_X1Q + (size_t)m * DM))[lane + 64 * j] = ((unsigned)(int)__builtin_rintf(x[0]) & 255u) | (((unsigned)(int)__builtin_rintf(x[1]) & 255u) << 8) | (((unsigned)(int)__builtin_rintf(x[2]) & 255u) << 16) | ((unsigned)(int)__builtin_rintf(x[3]) << 24); }
        if (lane == 0) wsp<float>(C, WS_XQS)[m] = qs;
    }
}

DI float gelu_erf(float x) { return 0.5f * x * (1.f + erff(x * 0.70710678118654752f)); }
DI unsigned fkey(float f) { const unsigned u = __builtin_bit_cast(unsigned, f); return u ^ ((unsigned)((int)u >> 31) | 0x80000000u); }
DI int mbcnt64(unsigned long long m) { return __builtin_amdgcn_mbcnt_hi((unsigned)(m >> 32), __builtin_amdgcn_mbcnt_lo((unsigned)m, 0)); }
template <int NV, bool LANE_MAJOR> DI void top16(const unsigned (&key)[NV], bool (&sel)[NV], int (&pos)[NV]) {
    unsigned thr = 0u; bool exact = false;
    for (int bit = 31; bit >= 0; --bit) {
        const unsigned cand = thr | (1u << bit);
        int cnt = 0;
#pragma unroll
        for (int v = 0; v < NV; ++v) cnt += __builtin_popcountll(__ballot(key[v] >= cand));
        if (cnt >= 16) { thr = cand; if (cnt == 16) { exact = true; break; } }
    }
    unsigned long long sm[NV];
    if (exact) {
#pragma unroll
        for (int v = 0; v < NV; ++v) { sel[v] = key[v] >= thr; sm[v] = __ballot(sel[v]); }
    } else {
        unsigned long long eq[NV]; int ngt = 0;
#pragma unroll
        for (int v = 0; v < NV; ++v) { ngt += __builtin_popcountll(__ballot(key[v] > thr)); eq[v] = __ballot(key[v] == thr); }
        const int need = 16 - ngt;
#pragma unroll
        for (int v = 0; v < NV; ++v) { int rk;
            if (LANE_MAJOR) { rk = 0;
#pragma unroll
                for (int w = 0; w < NV; ++w) { rk += mbcnt64(eq[w]); if (w < v) rk += (int)((eq[w] >> (threadIdx.x & 63)) & 1ull); } }
            else { rk = mbcnt64(eq[v]);
#pragma unroll
                for (int w = 0; w < NV; ++w) if (w < v) rk += __builtin_popcountll(eq[w]); }
            sel[v] = key[v] > thr || (key[v] == thr && rk < need); sm[v] = __ballot(sel[v]); }
    }
    int base = 0;
#pragma unroll
    for (int v = 0; v < NV; ++v) { pos[v] = base + mbcnt64(sm[v]); base += __builtin_popcountll(sm[v]); }
}
typedef float f32x2v __attribute__((ext_vector_type(2)));
typedef int v4i __attribute__((ext_vector_type(4)));
typedef int v2i __attribute__((ext_vector_type(2)));
constexpr int PS_NSL = 16, PS_TOKG = 64, PS_NGRP = (NT + PS_TOKG - 1) / PS_TOKG;
static_assert(NT % 8 == 0, "a wave's 8 tokens of a group are all valid or all invalid");
template <int NP, int NV> DI void top16_search(const unsigned (&key)[NP][NV], unsigned (&thr)[NP], bool (&ex)[NP]) {
    int c16[NP];
#pragma unroll
    for (int p = 0; p < NP; ++p) { thr[p] = 0u; c16[p] = 64 * NV; }
    for (unsigned bm = 0x80000000u; bm != 0u; bm >>= 1) {
        unsigned cand[NP]; unsigned long long bl[NP][NV]; int cnt[NP];
#pragma unroll
        for (int p = 0; p < NP; ++p) cand[p] = thr[p] | bm;
#pragma unroll
        for (int p = 0; p < NP; ++p)
#pragma unroll
            for (int v = 0; v < NV; ++v) bl[p][v] = __ballot(key[p][v] >= cand[p]);
#pragma unroll
        for (int p = 0; p < NP; ++p) { cnt[p] = 0;
#pragma unroll
            for (int v = 0; v < NV; ++v) cnt[p] += __builtin_popcountll(bl[p][v]); }
        int diff = 0;
#pragma unroll
        for (int p = 0; p < NP; ++p) { const bool ge = cnt[p] >= 16; thr[p] = ge ? cand[p] : thr[p]; c16[p] = ge ? cnt[p] : c16[p]; diff |= c16[p] ^ 16; }
        if (diff == 0) break;
    }
#pragma unroll
    for (int p = 0; p < NP; ++p) ex[p] = c16[p] == 16;
}
template <int NV, bool LANE_MAJOR> DI void top16_finish(const unsigned (&key)[NV], unsigned thr, bool exact, bool (&sel)[NV], int (&pos)[NV]) {
    unsigned long long sm[NV];
    if (exact) {
#pragma unroll
        for (int v = 0; v < NV; ++v) { sel[v] = key[v] >= thr; sm[v] = __ballot(sel[v]); }
    } else {
        unsigned long long eq[NV]; int ngt = 0;
#pragma unroll
        for (int v = 0; v < NV; ++v) { ngt += __builtin_popcountll(__ballot(key[v] > thr)); eq[v] = __ballot(key[v] == thr); }
        const int need = 16 - ngt;
#pragma unroll
        for (int v = 0; v < NV; ++v) { int rk;
            if (LANE_MAJOR) { rk = 0;
#pragma unroll
                for (int w = 0; w < NV; ++w) { rk += mbcnt64(eq[w]); if (w < v) rk += (int)((eq[w] >> (threadIdx.x & 63)) & 1ull); } }
            else { rk = mbcnt64(eq[v]);
#pragma unroll
                for (int w = 0; w < NV; ++w) if (w < v) rk += __builtin_popcountll(eq[w]); }
            sel[v] = key[v] > thr || (key[v] == thr && rk < need); sm[v] = __ballot(sel[v]); }
    }
    int base = 0;
#pragma unroll
    for (int v = 0; v < NV; ++v) { pos[v] = base + mbcnt64(sm[v]); base += __builtin_popcountll(sm[v]); }
}
DI float row_max16(float v) { v = fmaxf(v, dppf<0xB1>(v)); v = fmaxf(v, dppf<0x4E>(v)); v = fmaxf(v, dppf<0x141>(v)); return fmaxf(v, dppf<0x140>(v)); }
DI float row_sum16(float v) { v += dppf<0xB1>(v); v += dppf<0x4E>(v); v += dppf<0x141>(v); return v + dppf<0x140>(v); }
template <int CTRL, bool BC> DI int dppi(int v) { return __builtin_amdgcn_update_dpp(0, v, CTRL, 0xF, 0xF, BC); }
DI int row_sum16i(int v) { v += dppi<0xB1, false>(v); v += dppi<0x4E, false>(v); v += dppi<0x141, false>(v); v += dppi<0x140, false>(v); return v; }
DI int row_scan16i(int v) { v += dppi<0x111, true>(v); v += dppi<0x112, true>(v); v += dppi<0x114, true>(v); v += dppi<0x118, true>(v); return v; }
DI unsigned row_max16u(unsigned v) { v = max(v, (unsigned)dppi<0xB1, false>((int)v)); v = max(v, (unsigned)dppi<0x4E, false>((int)v)); v = max(v, (unsigned)dppi<0x141, false>((int)v)); return max(v, (unsigned)dppi<0x140, false>((int)v)); }
DI unsigned row_min16u(unsigned v) { v = min(v, (unsigned)dppi<0xB1, false>((int)v)); v = min(v, (unsigned)dppi<0x4E, false>((int)v)); v = min(v, (unsigned)dppi<0x141, false>((int)v)); return min(v, (unsigned)dppi<0x140, false>((int)v)); }
template <int NK> DI unsigned row_top16_search(unsigned (&key)[NK]) {
    unsigned lm = key[0];
#pragma unroll
    for (int j = 1; j < NK; ++j) lm = max(lm, key[j]);
    const unsigned kmax = row_max16u(lm), L = row_min16u(lm), sp1 = kmax - L + 1u;
    const unsigned spw = max(max((unsigned)__builtin_amdgcn_readlane((int)sp1, 0), (unsigned)__builtin_amdgcn_readlane((int)sp1, 16)), max((unsigned)__builtin_amdgcn_readlane((int)sp1, 32), (unsigned)__builtin_amdgcn_readlane((int)sp1, 48)));
    const int B = spw == 0u ? 32 : 32 - __builtin_clz(spw);
    const unsigned M = B == 32 ? 0xFFFFFFFFu : (1u << B) - 1u, off = kmax - M, lo = L - 1u;
#pragma unroll
    for (int j = 0; j < NK; ++j) key[j] = max(key[j], lo) - off;
    unsigned thr = 0u; int c16 = 16 * NK;
    for (unsigned bm = 1u << (B - 1); bm != 0u; bm >>= 1) {
        const unsigned cand = thr | bm; int cnt = 0;
#pragma unroll
        for (int j = 0; j < NK; ++j) cnt += key[j] >= cand ? 1 : 0;
        cnt = row_sum16i(cnt);
        const bool ge = cnt >= 16; thr = ge ? cand : thr; c16 = ge ? cnt : c16;
        if (__ballot(c16 != 16) == 0ull) break;
    }
    return thr;
}
template <int NK> DI void row_top16_place(const unsigned (&key)[NK], unsigned thr, int (&pos)[NK]) {
    int cg = 0, ce = 0;
#pragma unroll
    for (int j = 0; j < NK; ++j) { cg += key[j] > thr ? 1 : 0; ce += key[j] == thr ? 1 : 0; }
    const int pk = cg | (ce << 8);
    const int exc = row_scan16i(pk) - pk, tot = row_sum16i(pk);
    int pg_ = exc & 255, pe_ = (tot & 255) + (exc >> 8);
#pragma unroll
    for (int j = 0; j < NK; ++j) { const bool g = key[j] > thr, e = key[j] == thr; pos[j] = g ? pg_ : (e ? pe_ : 16); pg_ += g ? 1 : 0; pe_ += e ? 1 : 0; }
}
DI void peer_topk(const Ctx& C, int l) {
    const int lane = C.lane, wave = C.wave, n = lane & 15, r = lane >> 4;
    LAS float* WL = (LAS float*)(C.lds + 65536 + 256 + wave * 2048 + r * 384);
    LAS int* WLi = (LAS int*)WL;
    const float* Sc = wsp<float>(C, WS_HS);
    unsigned short* EL = wsp<unsigned short>(C, WS_EL); float* GT = wsp<float>(C, WS_GT);
    static_assert(NT % 4 == 0, "token quads");
    for (int m = 4 * blockIdx.x; m < NT; m += 4 * C.G) {
        const float* sr = Sc + (size_t)(m + r) * DM + wave * 256 + 8 * n;
        f32x4 sv[2][2];
#pragma unroll
        for (int c = 0; c < 2; ++c) { sv[c][0] = *(const f32x4*)(sr + 128 * c); sv[c][1] = *(const f32x4*)(sr + 128 * c + 4); }
#pragma unroll
        for (int c = 0; c < 2; ++c) {
            unsigned key[8]; int pos[8];
#pragma unroll
            for (int j = 0; j < 8; ++j) key[j] = fkey(sv[c][j >> 2][j & 3]);
            const unsigned thr = row_top16_search<8>(key);
            row_top16_place<8>(key, thr, pos);
#pragma unroll
            for (int j = 0; j < 8; ++j) if (pos[j] < 16) { WL[32 * c + pos[j]] = sv[c][j >> 2][j & 3]; WLi[32 * c + 16 + pos[j]] = 8 * n + j; }
        }
        LDS_WAIT(); asm volatile("" ::: "memory");
        {
            const float x0 = WL[n]; const int e0 = WLi[16 + n] * 128;
            float cd[16]; unsigned key[16]; int pos[16];
#pragma unroll
            for (int q = 0; q < 4; ++q) { const f32x4 x1 = *(const LAS f32x4*)(WL + 32 + 4 * q);
#pragma unroll
                for (int e = 0; e < 4; ++e) { cd[4 * q + e] = x0 + x1[e]; key[4 * q + e] = fkey(cd[4 * q + e]); } }
            const unsigned thr = row_top16_search<16>(key);
            row_top16_place<16>(key, thr, pos);
#pragma unroll
            for (int b = 0; b < 16; ++b) if (pos[b] < 16) { WL[64 + pos[b]] = cd[b]; WLi[80 + pos[b]] = e0 + WLi[48 + b]; }
        }
        LDS_WAIT(); asm volatile("" ::: "memory");
        { const float tv = WL[64 + n];
          const float ev = expf(tv - row_max16(tv));
          const float gate = ev / row_sum16(ev);
          EL[(size_t)(m + r) * 128 + wave * 16 + n] = (unsigned short)WLi[80 + n]; GT[(size_t)(m + r) * 128 + wave * 16 + n] = gate; }
        LDS_WAIT(); asm volatile("" ::: "memory");
    }
}
template <int SIDE> DI void peer_sliced(const Ctx& C, int l, int lq) {
    const int tid = C.tid, lane = C.lane, wave = C.wave, pg = lane >> 3, dq = lane & 7;
    LAS int* slot = (LAS int*)(C.lds + MISC_OFF + 64);
    const unsigned char* TAB = C.ws + (SIDE ? WS_VB : WS_UB) + (size_t)l * NEXP * DM;
    const unsigned char* X1Q = C.ws + WS_X1Q;
    const unsigned short* EL = wsp<unsigned short>(C, WS_EL); const float* WP = wsp<float>(C, WS_WP);
    float* PD = wsp<float>(C, WS_PD); float* FO = wsp<float>(C, WS_FO);
    unsigned* const Q0 = C.ctl + CW_SQ + 64 * ((lq * 2 + SIDE) * 16);
    const int s_first = (int)((2u * xb_xcc_id()) & (PS_NSL - 1));
    int k = 0;
    for (;;) {
        __syncthreads();
        if (tid == 0) { int got = -1;
            while (k < PS_NSL) { const int s = (s_first + k) & (PS_NSL - 1); const unsigned g = atomicAdd(Q0 + 64 * s, 1u); if (g < (unsigned)PS_NGRP) { got = (s << 16) | (int)g; break; } ++k; }
            *slot = got; }
        __syncthreads();
        const int d = __builtin_amdgcn_readfirstlane(*slot);
        if (d < 0) break;
        const int s = d >> 16, g = d & 0xffff;
        const int t0 = g * PS_TOKG + wave * 8;
        if (t0 >= NT) continue;
        const unsigned char* TS = TAB + (size_t)s * NEXP * 128;
        const unsigned dq16 = (unsigned)dq * 16u;
        v4u E[2][2]; v4u R[2][16]; f32x4 A[2][4]; v4u AQ[2];
        LAS unsigned char* const WB = C.lds + wave * 4352;
        const int wofs = pg * 512 + dq * 64, rofs = (lane >> 3) * 64 + 16 * (((lane & 7) >> 1) ^ ((lane >> 3) & 3)) + 8 * (lane & 1);
#define PS_LOAD_E(b, t) do { const v4u* ep_ = (const v4u*)(EL + (size_t)(t) * 128 + 16 * pg); E[b][0] = ep_[0]; E[b][1] = ep_[1]; } while (0)
#define PS_LOAD_R(b, t) do { \
            _Pragma("unroll") for (int i = 0; i < 16; ++i) { const unsigned w_ = E[b][i >> 3][(i >> 1) & 3]; const unsigned e_ = (i & 1) ? (w_ >> 16) : (w_ & 0xffffu); \
                R[b][i] = *(const v4u*)(TS + ((e_ << 7) | dq16)); } \
            if (SIDE == 0) AQ[b] = *(const v4u*)(X1Q + (size_t)(t) * DM + 128 * s + 16 * dq); \
            else { const f32x4* ap_ = (const f32x4*)(WP + (size_t)(t) * 128 + 16 * pg); _Pragma("unroll") for (int q = 0; q < 4; ++q) A[b][q] = ap_[q]; } } while (0)
        PS_LOAD_E(0, t0); PS_LOAD_E(1, t0 + 1);
        PS_LOAD_R(0, t0);
#pragma unroll
        for (int j = 0; j < 8; ++j) {
            const int b = j & 1, t = t0 + j;
            if (j + 2 < 8) PS_LOAD_E(b, t + 2);
            if (j + 1 < 8) PS_LOAD_R(b ^ 1, t + 1);
            __builtin_amdgcn_sched_barrier(0);
            if (SIDE == 0) {
                int dd[16];
#pragma unroll
                for (int i = 0; i < 16; ++i) { int a = 0;
#pragma unroll
                    for (int q = 0; q < 4; ++q) a = __builtin_amdgcn_sdot4((int)R[b][i][q], (int)AQ[b][q], a, false);
                    dd[i] = a; }
#pragma unroll
                for (int q = 0; q < 4; ++q) *(LAS v4i*)(WB + dq * 528 + pg * 64 + 16 * q) = (v4i){dd[4 * q], dd[4 * q + 1], dd[4 * q + 2], dd[4 * q + 3]};
                v2i rs = {0, 0};
#pragma unroll
                for (int d8 = 0; d8 < 8; ++d8) rs += *(const LAS v2i*)(WB + 8 * lane + 528 * d8);
                *(f32x2v*)(PD + ((size_t)t * PS_NSL + s) * 128 + 2 * lane) = (f32x2v){(float)rs.x, (float)rs.y};
            } else {
                f32x2v acc[8];
#pragma unroll
                for (int q = 0; q < 8; ++q) acc[q] = (f32x2v){0.f, 0.f};
#pragma unroll
                for (int i = 0; i < 16; ++i) { const float w = A[b][i >> 2][i & 3]; const f32x2v w2 = {w, w};
#pragma unroll
                    for (int q = 0; q < 4; ++q) { const int wd = (int)R[b][i][q]; acc[2 * q] += w2 * __builtin_amdgcn_cvt_pk_f32_fp8(wd, false); acc[2 * q + 1] += w2 * __builtin_amdgcn_cvt_pk_f32_fp8(wd, true); } }
#pragma unroll
                for (int q = 0; q < 4; ++q) *(LAS f32x4*)(WB + wofs + 16 * (q ^ (dq & 3))) = (f32x4){acc[2 * q].x, acc[2 * q].y, acc[2 * q + 1].x, acc[2 * q + 1].y};
                f32x2v rs = {0.f, 0.f};
#pragma unroll
                for (int h8 = 0; h8 < 8; ++h8) rs += *(const LAS f32x2v*)(WB + rofs + 512 * h8);
                *(f32x2v*)(FO + (size_t)t * DM + 128 * s + 2 * lane) = rs;
            }
        }
#undef PS_LOAD_E
#undef PS_LOAD_R
    }
}
DI void peer_gelu(const Ctx& C, int l) {
    const unsigned short* EL = wsp<unsigned short>(C, WS_EL); const float* GT = wsp<float>(C, WS_GT); const float* PD = wsp<float>(C, WS_PD); float* WP = wsp<float>(C, WS_WP);
    const float* USC = wsp<float>(C, WS_USC) + (size_t)l * NEXP; const float* VSC = USC + 2 * NEXP; const float* XQS = wsp<float>(C, WS_XQS);
    for (int idx = blockIdx.x * NTHREADS + C.tid; idx < NT * 128; idx += C.G * NTHREADS) {
        const int t = idx >> 7, p = idx & 127; const unsigned e = EL[idx];
        float h = 0.f;
#pragma unroll
        for (int s = 0; s < PS_NSL; ++s) h += PD[((size_t)t * PS_NSL + s) * 128 + p];
        WP[idx] = GT[idx] * gelu_erf(h * USC[e] * XQS[t]) * VSC[e];
    }
}
DI void peer_ln2(const Ctx& C, int l) {
    const int lane = C.lane;
    const bf16* X1B = wsp<bf16>(C, WS_X1B); const float* FO = wsp<float>(C, WS_FO);
    const float* gw = C.inp(28) + (size_t)l * DM; const float* bw = C.inp(29) + (size_t)l * DM;
    for (int m = blockIdx.x * NWAVES + C.wave; m < NT; m += C.G * NWAVES) {
        const v2u* xr = (const v2u*)(X1B + (size_t)m * DM) + lane; const f32x4* fr = (const f32x4*)(FO + (size_t)m * DM) + lane;
        f32x4 v[8]; float s = 0.f;
#pragma unroll
        for (int j = 0; j < 8; ++j) { const v2u xb = xr[64 * j]; v[j] = (f32x4){bflo(xb.x), bfhi(xb.x), bflo(xb.y), bfhi(xb.y)} * DN_ALPHA + fr[64 * j]; s += (v[j][0] + v[j][1]) + (v[j][2] + v[j][3]); }
        const float mean = wave_sum(s) * (1.f / DM); float s2 = 0.f;
#pragma unroll
        for (int j = 0; j < 8; ++j) { v[j] = v[j] - mean; s2 += (v[j][0] * v[j][0] + v[j][1] * v[j][1]) + (v[j][2] * v[j][2] + v[j][3] * v[j][3]); }
        const float rstd = 1.f / sqrtf(wave_sum(s2) * (1.f / DM) + LN_EPS);
#pragma unroll
        for (int j = 0; j < 8; ++j) { const f32x4 gg = ((const f32x4*)gw)[lane + 64 * j], bb = ((const f32x4*)bw)[lane + 64 * j];
            const f32x4 o = v[j] * rstd * gg + bb;
            if (l == 0) {
                v2u p; p.x = pk2(o[0], o[1]); p.y = pk2(o[2], o[3]); ((v2u*)(wsp<bf16>(C, WS_XB) + (size_t)m * DM))[lane + 64 * j] = p; }
            else { float* dst = m < NTP ? C.out + O_YP + (size_t)m * DM : C.out + O_YS + (size_t)(m - NTP) * DM; ((f32x4*)dst)[lane + 64 * j] = o; } }
    }
}

#ifndef PH_MASK
#define PH_MASK 0xFF
#endif
#define IN(k) (lo <= (k) && (k) < hi)
#define EN(s) ((PH_MASK >> (s)) & 1)
#define FRESH(CX) Ctx CX = C; { CX.ws = launder_g(CX.ws); CX.out = launder_g(CX.out); int t_ = CX.tid; asm volatile("" : "+v"(t_)); CX.tid = t_; CX.lane = t_ & 63; CX.wave = __builtin_amdgcn_readfirstlane(t_ >> 6); CX.ctl = (unsigned*)(CX.ws + WS_CTL); }
#ifndef PROBE_REP
#define PROBE_REP 0
#endif
#ifndef PROBE_PMASK
#define PROBE_PMASK 31
#endif
#ifndef PROBE_CMASK
#define PROBE_CMASK 7
#endif
#define NREP(s) (((PROBE_REP >> (s)) & 1) ? 2 : 1)
#ifndef PROBE_G
#define PROBE_G 0
#endif
#define GREP(s) (((PROBE_G >> (s)) & 1) ? 2 : 1)
#define REPBAR(s, rep) do { if (NREP(s) == 2 && (rep) == 0 && (hi - lo) > 1) xcd_barrier(bar); } while (0)
#define SEAM(k) do { if (IN(k) && IN((k) + 1)) xcd_barrier(bar); } while (0)
template <int l> DI void run_layer(const Ctx& C, const XcdBarrier& bar, int lo, int hi) {
        const int pb = 1 + 11 * l;
        _Pragma("unroll") for (int rep = 0; rep < NREP(0); ++rep) if (EN(0) && IN(pb + 0)) {
            FRESH(K);
            pg8::Gemm g{wsp<bf16>(K, WS_XB), wsp<bf16>(K, WS_WIN) + (size_t)l * PLD * DM, NTP, PLD, DM}; pg8::StaticOrder S; S.init(NTP, PLD, K.G, (int)blockIdx.x);
            EpiInProj E{wsp<bf16>(K, WS_PROJ), K.out, l};
            pg8::gemm_phase<EpiInProj, pg8::StaticOrder, true, true>(K.lds, g, S, E);
            { bf16* P = wsp<bf16>(K, WS_PROJ); float* out = K.out;
              skinny_gemm(K, wsp<bf16>(K, WS_XB) + (size_t)NTP * DM, wsp<bf16>(K, WS_WIN) + (size_t)l * PLD * DM, (IN_COLS + 31) / 32, [&](int j, int col, float v) {
                  P[(size_t)(NTP + j) * PLD + col] = (unsigned short)(pk2(v, 0.f) & 0xffffu);
                  const int b = j >> 2, t = j & 3;
                  if (col < RW_COLS) { if (t == 3) out[O_SH_S + (size_t)(l * 8 + b) * RW_COLS + col] = v; }
                  else if (col >= KC_OFF && col < GL_OFF) { const int c = col - KC_OFF, reg = c >> 9, cc = c & 511;
                      if (reg == 0) out[O_CMP_S + ((size_t)l * NTS + j) * 512 + cc] = v; else if (reg == 1) out[O_SEL_S + ((size_t)l * NTS + j) * 512 + cc] = v;
                      else out[O_WIN_S + ((size_t)(l * 8 + b) * 512 + 508 + t) * 512 + cc] = v; } }); }
            REPBAR(0, rep);
        }
        SEAM(pb + 0);
        _Pragma("unroll") for (int rep = 0; rep < NREP(1); ++rep) if (EN(1) && IN(pb + 1)) { FRESH(K); phase_b(K, l, l + 2 * rep); REPBAR(1, rep); }
        SEAM(pb + 1);
        _Pragma("unroll") for (int rep = 0; rep < NREP(2); ++rep) if (EN(2) && IN(pb + 2)) { FRESH(K); phase_c(K, l + 2 * rep, rep == 0 ? 7 : PROBE_CMASK); REPBAR(2, rep); }
        SEAM(pb + 2);
        _Pragma("unroll") for (int rep = 0; rep < NREP(3); ++rep) if (EN(3) && IN(pb + 3)) {
            FRESH(K);
            pg8::Gemm g{wsp<bf16>(K, WS_MIX), wsp<bf16>(K, WS_WOUT) + (size_t)l * DM * DM, NTP, DM, DM}; pg8::StaticOrder S; S.init(NTP, DM, K.G, (int)blockIdx.x);
            EpiBf16Row E{wsp<bf16>(K, WS_HS), DM};
            pg8::gemm_phase<EpiBf16Row, pg8::StaticOrder, true, true>(K.lds, g, S, E);
            { bf16* H = wsp<bf16>(K, WS_HS) + (size_t)NTP * DM;
              skinny_gemm(K, wsp<bf16>(K, WS_MIX) + (size_t)NTP * DM, wsp<bf16>(K, WS_WOUT) + (size_t)l * DM * DM, DM / 32, [&](int j, int col, float v) { H[(size_t)j * DM + col] = (unsigned short)(pk2(v, 0.f) & 0xffffu); }); }
            REPBAR(3, rep);
        }
        SEAM(pb + 3);
        _Pragma("unroll") for (int rep = 0; rep < NREP(4); ++rep) if (EN(4) && IN(pb + 4)) { FRESH(K); phase_e(K, l); REPBAR(4, rep); }
        SEAM(pb + 4);
        _Pragma("unroll") for (int rep = 0; rep < NREP(5); ++rep) if (EN(5) && IN(pb + 5)) {
            FRESH(K);
            pg8::Gemm g{wsp<bf16>(K, WS_X1B), wsp<bf16>(K, WS_W2) + (size_t)l * DM * DM, NTP, DM, DM}; pg8::StaticOrder S; S.init(NTP, DM, K.G, (int)blockIdx.x);
            pg8::EpiF32 E{wsp<float>(K, WS_HS), DM, nullptr};
            pg8::gemm_phase<pg8::EpiF32, pg8::StaticOrder, true, true>(K.lds, g, S, E);
            { float* H = wsp<float>(K, WS_HS) + (size_t)NTP * DM;
              skinny_gemm(K, wsp<bf16>(K, WS_X1B) + (size_t)NTP * DM, wsp<bf16>(K, WS_W2) + (size_t)l * DM * DM, DM / 32, [&](int j, int col, float v) { H[(size_t)j * DM + col] = v; }); }
            REPBAR(5, rep);
        }
        SEAM(pb + 5);
        _Pragma("unroll") for (int rep = 0; rep < GREP(0); ++rep) { if (IN(pb + 6)) { FRESH(K); peer_topk(K, l); } if (GREP(0) == 2 && rep == 0) xcd_barrier(bar); }
        SEAM(pb + 6);
        _Pragma("unroll") for (int rep = 0; rep < GREP(1); ++rep) { if (IN(pb + 7)) { FRESH(K); peer_sliced<0>(K, l, l + 2 * rep); } if (GREP(1) == 2 && rep == 0) xcd_barrier(bar); }
        SEAM(pb + 7);
        _Pragma("unroll") for (int rep = 0; rep < GREP(2); ++rep) { if (IN(pb + 8)) { FRESH(K); peer_gelu(K, l); } if (GREP(2) == 2 && rep == 0) xcd_barrier(bar); }
        SEAM(pb + 8);
        _Pragma("unroll") for (int rep = 0; rep < GREP(3); ++rep) { if (IN(pb + 9)) { FRESH(K); peer_sliced<1>(K, l, l + 2 * rep); } if (GREP(3) == 2 && rep == 0) xcd_barrier(bar); }
        SEAM(pb + 9);
        _Pragma("unroll") for (int rep = 0; rep < GREP(4); ++rep) { if (IN(pb + 10)) { FRESH(K); peer_ln2(K, l); } if (GREP(4) == 2 && rep == 0) xcd_barrier(bar); }
        SEAM(pb + 10);
}
typedef ArgsK Args;
__global__ void __launch_bounds__(NTHREADS, 2) fwd_kernel(Args args) {
    extern __shared__ __attribute__((aligned(16))) unsigned char lds[];
    Ctx C;
    C.out = args.out; C.ws = args.ws; C.lds = (LAS unsigned char*)lds; C.ctl = (unsigned*)(args.ws + WS_CTL);
    C.tid = threadIdx.x; C.lane = C.tid & 63; C.wave = __builtin_amdgcn_readfirstlane(C.tid >> 6); C.G = gridDim.x;
    volatile LAS unsigned* MISC = (volatile LAS unsigned*)(C.lds + MISC_OFF);
    for (int u = C.tid; u < (LDS_BYTES - RING_BYTES) / 4; u += NTHREADS) ((LAS unsigned*)(C.lds + RING_BYTES))[u] = 0u;
    __syncthreads();
    XcdBarrier bar; bar.bar = C.ctl + CW_BAR; bar.x = 0; bar.st = nullptr;
    if (args.use_bar) bar = xcd_barrier_post(C.ctl + CW_BAR, MISC + 8);
    const int lo = args.ph_lo, hi = args.ph_hi;
#ifdef PROBE_DELAY_TICKS
    { const unsigned long long t0 = __builtin_amdgcn_s_memrealtime(); while (__builtin_amdgcn_s_memrealtime() - t0 < (unsigned long long)PROBE_DELAY_TICKS) __builtin_amdgcn_s_sleep(32); }
#endif
#ifdef PROBE_AMPLIFY
    { const unsigned long long t0 = __builtin_amdgcn_s_memrealtime(); xcd_barrier(bar);
      if (blockIdx.x == PROBE_AMPLIFY - 1) { const unsigned long long dt = __builtin_amdgcn_s_memrealtime() - t0; while (__builtin_amdgcn_s_memrealtime() - t0 < 5ull * dt) __builtin_amdgcn_s_sleep(32); } }
#endif
    _Pragma("unroll") for (int rep = 0; rep < NREP(7); ++rep) if (EN(7) && IN(0)) { FRESH(K); p0_prologue(K, NREP(7) == 1 ? 31 : (rep == 0 ? PROBE_PMASK : (31 & ~PROBE_PMASK))); REPBAR(7, rep); }
    SEAM(0);
    run_layer<0>(C, bar, lo, hi);
    run_layer<1>(C, bar, lo, hi);
#undef IN
#undef SEAM
}

#ifndef MK_ONE_LAUNCH
#define MK_ONE_LAUNCH 1
#endif
extern "C" void kernel_launch(void* const* d_in, const int* in_sizes, int n_in, void* d_out, int out_size, void* d_ws, size_t ws_size, hipStream_t stream) {
    static int grid = 0;
    if (grid == 0) {
        if (n_in != 30 || out_size != (int)O_END || ws_size < WS_END) { fprintf(stderr, "kernel_launch: unexpected shapes (n_in %d, out %d, ws %zu < %zu); nothing launched\n", n_in, out_size, ws_size, (size_t)WS_END); grid = -1; return; }
        int dev = 0, cus = 0, per_cu = 0;
        if (hipGetDevice(&dev) != hipSuccess || hipDeviceGetAttribute(&cus, hipDeviceAttributeMultiprocessorCount, dev) != hipSuccess) { grid = -1; return; }
        if (hipFuncSetAttribute((const void*)fwd_kernel, hipFuncAttributeMaxDynamicSharedMemorySize, LDS_BYTES) != hipSuccess) { fprintf(stderr, "kernel_launch: hipFuncSetAttribute failed\n"); grid = -1; return; }
        if (hipOccupancyMaxActiveBlocksPerMultiprocessor(&per_cu, (const void*)fwd_kernel, NTHREADS, LDS_BYTES) != hipSuccess || per_cu < 1) { fprintf(stderr, "kernel_launch: occupancy query says %d blocks per CU\n", per_cu); }
        (void)hipGetLastError();
        grid = cus;
    }
    if (grid < 0) return;
    if (hipMemsetAsync((char*)d_ws + WS_CTL, 0, CTL_ZERO_BYTES, stream) != hipSuccess) return;
    Args a{};
    for (int i = 0; i < 30; ++i) a.in[i] = (const float*)d_in[i];
    a.out = (float*)d_out; a.ws = (unsigned char*)d_ws;
#if MK_ONE_LAUNCH
    a.ph_lo = 0; a.ph_hi = N_PHASES; a.use_bar = 1;
    hipLaunchKernelGGL(fwd_kernel, dim3(grid), dim3(NTHREADS), LDS_BYTES, stream, a);
#else
    for (int p = 0; p < N_PHASES; ++p) { a.ph_lo = p; a.ph_hi = p + 1; a.use_bar = 0; hipLaunchKernelGGL(fwd_kernel, dim3(grid), dim3(NTHREADS), LDS_BYTES, stream, a); }
#endif
}
```

```cpp
#include <hip/hip_runtime.h>
#include <cstdio>
#include <cstdint>
namespace pg8 {
#define PG8_LAS __attribute__((address_space(3)))
typedef unsigned short bf16_t;
typedef short bf16x8 __attribute__((ext_vector_type(8)));
typedef float f32x4 __attribute__((ext_vector_type(4)));
typedef unsigned u32x4 __attribute__((ext_vector_type(4)));
constexpr int BM = 256, BK = 64, HALF = 128, HTB = HALF * BK * 2  , STAGE_BYTES = 8 * HTB, NXCD = 8, WGM = 8;

__host__ __device__ __forceinline__ int lds_byte(int r, int c) { const int st = (r >> 4) * 2 + (c >> 5), rr = r & 15, cc = c & 31, ob = rr * 64 + cc * 2; return st * 1024 + (ob ^ (((ob >> 9) & 1) << 5)); }
__host__ __device__ __forceinline__ void stage_rc(int b, int& R, int& C) { const int st = b / 1024, sb = b % 1024, swz = sb ^ (((sb >> 9) & 1) << 5); R = (st >> 1) * 16 + swz / 64; C = (st & 1) * 32 + (swz % 64) / 2; }
__host__ __device__ __forceinline__ int perm32(int rho) { const int n = rho >> 4, i = rho & 15; return 8 * (i >> 2) + 4 * n + (i & 3); }

struct Unit { int pm, pn; };
struct Gemm { const bf16_t* A; const bf16_t* Bt; int M, N, K; };

struct StaticOrder {
    int nM, nN, nwg, G, c;
    __host__ __device__ void init(int M, int N, int G_, int c_) { nM = M / BM; nN = N / BM; nwg = nM * nN; G = G_; c = c_; }
    __host__ __device__ bool next(int i, Unit& u) const {
        const long L = (long)i * G + c; if (L >= nwg) return false;
        int wgid = (int)L; { const int q = nwg / NXCD, r = nwg % NXCD, xcd = wgid % NXCD, off = wgid / NXCD; wgid = (xcd < r ? xcd * (q + 1) : r * (q + 1) + (xcd - r) * q) + off; }
        const int nig = WGM * nN, gid = wgid / nig, fm = gid * WGM, gsz = (nM - fm) < WGM ? (nM - fm) : WGM;
        u.pm = fm + ((wgid % nig) % gsz); u.pn = (wgid % nig) / gsz; return true;
    }
    __device__ __forceinline__ void a_ready(const Unit&) const {}
    __device__ __forceinline__ void done(const Unit&) const {}
};

__device__ __forceinline__ unsigned cvt_pk_bf16(float lo, float hi) { unsigned r; asm volatile("v_cvt_pk_bf16_f32 %0, %1, %2" : "=v"(r) : "v"(lo), "v"(hi)); return r; }
typedef float f32x2 __attribute__((ext_vector_type(2)));
struct EpiF32 {
    static constexpr bool PERM = false, AFTER_DRAIN = false;
    float* C; int ldc; const float* bias;
    __device__ __forceinline__ void operator()(const f32x4 (&acc)[2][2][4][2], const Unit& u, int wr, int wc, int fr, int fq) const {
        const int row0 = u.pm * BM + wr * 64 + fr, col0 = u.pn * BM + wc * 32 + 4 * fq;
        f32x4 bv[2][2];
#pragma unroll
        for (int bj = 0; bj < 2; ++bj)
#pragma unroll
            for (int n = 0; n < 2; ++n) bv[bj][n] = bias ? *(const f32x4*)(bias + col0 + bj * HALF + n * 16) : (f32x4){0.f, 0.f, 0.f, 0.f};
#pragma unroll
        for (int ai = 0; ai < 2; ++ai)
#pragma unroll
            for (int m = 0; m < 4; ++m) { float* rowp = C + (size_t)(row0 + ai * HALF + m * 16) * ldc + col0;
#pragma unroll
                for (int bj = 0; bj < 2; ++bj)
#pragma unroll
                    for (int n = 0; n < 2; ++n) *(f32x4*)(rowp + bj * HALF + n * 16) = acc[ai][bj][m][n] + bv[bj][n]; }
    }
};
template <class Epi, class Sched, bool ALIGN_EPI = false, bool SP2 = false>
__device__ __forceinline__ void gemm_phase(PG8_LAS unsigned char* lds, const Gemm g, const Sched& S, const Epi& E) {
    const int tid = threadIdx.x, wid = __builtin_amdgcn_readfirstlane(tid >> 6), lane = tid & 63, wr = wid >> 2, wc = wid & 3, fr = lane & 15, fq = lane >> 4;
    const int K = g.K, nt = K / BK;
    unsigned voffA[2], voffB[2];
#pragma unroll
    for (int i = 0; i < 2; ++i) { int R, C; stage_rc(tid * 16 + i * 8192, R, C); const int Rb = Epi::PERM ? ((R & ~31) + perm32(R & 31)) : R;
        voffA[i] = (unsigned)(R * K + C) * 2u; voffB[i] = (unsigned)(Rb * K + C) * 2u; }
    const size_t kstep = (size_t)(BK * 2);
    const size_t hstep = (size_t)HALF * K * 2;
    const size_t tstep = 2 * hstep;
    const unsigned ldsw = (unsigned)wid * 1024u;
    const int aoff = lds_byte(wr * 64 + fr, fq * 8), boff = lds_byte(wc * 32 + fr, fq * 8);
#define PG8_SA(b, h) (((b) * 2 + (h)) * HTB)
#define PG8_SB(b, h) ((4 + (b) * 2 + (h)) * HTB)
#define PG8_STAGE(bufoff, gbase, voff) do { _Pragma("unroll") for (int _i = 0; _i < 2; ++_i) \
        __builtin_amdgcn_global_load_lds((const unsigned*)((const char*)(gbase) + (voff)[_i]), (PG8_LAS unsigned*)(lds + (bufoff) + ldsw + _i * 8192), 16, 0, 0); } while (0)
#define PG8_LDA(dst, b, h) do { _Pragma("unroll") for (int m = 0; m < 4; ++m) _Pragma("unroll") for (int k = 0; k < 2; ++k) dst[m][k] = *(const PG8_LAS bf16x8*)(lds + PG8_SA(b, h) + aoff + m * 2048 + k * 1024); } while (0)
#define PG8_LDB(dst, b, h) do { _Pragma("unroll") for (int n = 0; n < 2; ++n) _Pragma("unroll") for (int k = 0; k < 2; ++k) dst[n][k] = *(const PG8_LAS bf16x8*)(lds + PG8_SB(b, h) + boff + n * 2048 + k * 1024); } while (0)
#define PG8_MMA(ai, bj, At, Bt) do { __builtin_amdgcn_s_setprio(1); _Pragma("unroll") for (int m = 0; m < 4; ++m) _Pragma("unroll") for (int n = 0; n < 2; ++n) _Pragma("unroll") for (int k = 0; k < 2; ++k) \
        acc[ai][bj][m][n] = __builtin_amdgcn_mfma_f32_16x16x32_bf16(Bt[n][k], At[m][k], acc[ai][bj][m][n], 0, 0, 0); __builtin_amdgcn_s_setprio(0); } while (0)
#define PG8_WAIT_V(n) asm volatile("s_waitcnt vmcnt(" #n ")" ::: "memory")
#define PG8_WAIT_L(n) asm volatile("s_waitcnt lgkmcnt(" #n ")" ::: "memory")
#define PG8_BAR __builtin_amdgcn_s_barrier()
#define PG8_SCHED __builtin_amdgcn_sched_barrier(0)
    Unit cur, nxt; int ui = 0;
    if (!S.next(0, cur)) return;
    f32x4 acc[2][2][4][2];
#pragma unroll
    for (int a = 0; a < 2; ++a)
#pragma unroll
        for (int b = 0; b < 2; ++b)
#pragma unroll
            for (int m = 0; m < 4; ++m)
#pragma unroll
                for (int n = 0; n < 2; ++n) acc[a][b][m][n] = (f32x4){0.f, 0.f, 0.f, 0.f};
    bf16x8 At[4][2], B0[2][2], B1[2][2];
    const char* cA = (const char*)g.A + (size_t)cur.pm * tstep; const char* cB = (const char*)g.Bt + (size_t)cur.pn * tstep;
    S.a_ready(cur);
    if constexpr (SP2) {
        PG8_STAGE(PG8_SB(0, 0), cB, voffB); PG8_STAGE(PG8_SB(0, 1), cB + hstep, voffB); PG8_STAGE(PG8_SA(0, 0), cA, voffA); PG8_STAGE(PG8_SA(0, 1), cA + hstep, voffA);
        if (wr == 1) PG8_BAR;
        PG8_WAIT_V(2); PG8_BAR;
        PG8_STAGE(PG8_SB(1, 0), cB + kstep, voffB); PG8_STAGE(PG8_SA(1, 0), cA + kstep, voffA); PG8_STAGE(PG8_SB(1, 1), cB + hstep + kstep, voffB);
        PG8_WAIT_V(6); PG8_BAR;
    } else {
        PG8_STAGE(PG8_SB(0, 0), cB, voffB); PG8_STAGE(PG8_SA(0, 0), cA, voffA); PG8_STAGE(PG8_SB(0, 1), cB + hstep, voffB); PG8_STAGE(PG8_SA(0, 1), cA + hstep, voffA);
        if (wr == 1) PG8_BAR;
        PG8_WAIT_V(4); PG8_BAR;
        PG8_STAGE(PG8_SB(1, 0), cB + kstep, voffB); PG8_STAGE(PG8_SA(1, 0), cA + kstep, voffA); PG8_STAGE(PG8_SB(1, 1), cB + hstep + kstep, voffB);
        PG8_WAIT_V(6); PG8_BAR;
    }
    for (;;) {
        const bool has_next = S.next(ui + 1, nxt);
        const char* nA = has_next ? (const char*)g.A + (size_t)nxt.pm * tstep : cA; const char* nB = has_next ? (const char*)g.Bt + (size_t)nxt.pn * tstep : cB;
        for (int t = 0; t < nt; t += 2) {
            const bool last = (t == nt - 2);
            const char* a1 = cA + (size_t)(t + 1) * kstep;
            const char* a2 = last ? nA : cA + (size_t)(t + 2) * kstep; const char* b2 = last ? nB : cB + (size_t)(t + 2) * kstep;
            const char* a3 = a2 + kstep; const char* b3 = b2 + kstep;
            if (last && has_next) S.a_ready(nxt);
            if constexpr (SP2) {
            PG8_LDB(B0, 0, 0); PG8_LDB(B1, 0, 1); PG8_SCHED; PG8_LDA(At, 0, 0); PG8_STAGE(PG8_SA(1, 1), a1 + hstep, voffA);
            PG8_WAIT_V(8); PG8_WAIT_L(0); PG8_BAR; PG8_MMA(0, 0, At, B0); PG8_MMA(0, 1, At, B1); PG8_BAR; PG8_SCHED;
            PG8_LDA(At, 0, 1); PG8_STAGE(PG8_SB(0, 0), b2, voffB); PG8_STAGE(PG8_SB(0, 1), b2 + hstep, voffB); PG8_STAGE(PG8_SA(0, 0), a2, voffA);
            PG8_WAIT_V(8); PG8_WAIT_L(0); PG8_BAR; PG8_MMA(1, 0, At, B0); PG8_MMA(1, 1, At, B1); PG8_BAR; PG8_SCHED;
            PG8_LDB(B0, 1, 0); PG8_LDB(B1, 1, 1); PG8_SCHED; PG8_LDA(At, 1, 0); PG8_STAGE(PG8_SA(0, 1), a2 + hstep, voffA);
            PG8_WAIT_V(8); PG8_WAIT_L(0); PG8_BAR; PG8_MMA(0, 0, At, B0); PG8_MMA(0, 1, At, B1); PG8_BAR; PG8_SCHED;
            PG8_LDA(At, 1, 1); PG8_STAGE(PG8_SB(1, 0), b3, voffB); PG8_STAGE(PG8_SB(1, 1), b3 + hstep, voffB); PG8_STAGE(PG8_SA(1, 0), a3, voffA);
            PG8_WAIT_V(8); PG8_WAIT_L(0); PG8_BAR; PG8_MMA(1, 0, At, B0); PG8_MMA(1, 1, At, B1); PG8_BAR; PG8_SCHED;
            } else {
            PG8_LDB(B0, 0, 0); PG8_SCHED; PG8_LDA(At, 0, 0); PG8_STAGE(PG8_SA(1, 1), a1 + hstep, voffA);
            PG8_WAIT_L(8); PG8_BAR; PG8_WAIT_L(0); PG8_MMA(0, 0, At, B0); PG8_BAR; PG8_SCHED;
            PG8_LDB(B1, 0, 1); PG8_STAGE(PG8_SB(0, 0), b2, voffB);
            PG8_BAR; PG8_WAIT_L(0); PG8_MMA(0, 1, At, B1); PG8_BAR;
            PG8_LDA(At, 0, 1); PG8_STAGE(PG8_SA(0, 0), a2, voffA);
            PG8_BAR; PG8_WAIT_L(0); PG8_MMA(1, 0, At, B0); PG8_BAR; PG8_SCHED;
            PG8_STAGE(PG8_SB(0, 1), b2 + hstep, voffB);
            PG8_WAIT_V(6); PG8_BAR; PG8_MMA(1, 1, At, B1); PG8_BAR;
            PG8_LDB(B0, 1, 0); PG8_SCHED; PG8_LDA(At, 1, 0); PG8_STAGE(PG8_SA(0, 1), a2 + hstep, voffA);
            PG8_WAIT_L(8); PG8_BAR; PG8_WAIT_L(0); PG8_MMA(0, 0, At, B0); PG8_BAR; PG8_SCHED;
            PG8_LDB(B1, 1, 1); PG8_STAGE(PG8_SB(1, 0), b3, voffB);
            PG8_BAR; PG8_WAIT_L(0); PG8_MMA(0, 1, At, B1); PG8_BAR;
            PG8_LDA(At, 1, 1); PG8_STAGE(PG8_SA(1, 0), a3, voffA);
            PG8_BAR; PG8_WAIT_L(0); PG8_MMA(1, 0, At, B0); PG8_BAR; PG8_SCHED;
            PG8_STAGE(PG8_SB(1, 1), b3 + hstep, voffB);
            PG8_WAIT_V(6); PG8_BAR; PG8_MMA(1, 1, At, B1); PG8_BAR;
            }
        }
        if constexpr (ALIGN_EPI) { if (wr == 0) PG8_BAR; }
        if constexpr (!Epi::AFTER_DRAIN) { E(acc, cur, wr, wc, fr, fq); S.done(cur); }
        if (!has_next) break;
#pragma unroll
        for (int a = 0; a < 2; ++a)
#pragma unroll
            for (int b = 0; b < 2; ++b)
#pragma unroll
                for (int m = 0; m < 4; ++m)
#pragma unroll
                    for (int n = 0; n < 2; ++n) acc[a][b][m][n] = (f32x4){0.f, 0.f, 0.f, 0.f};
        cur = nxt; cA = nA; cB = nB; ++ui;
        if constexpr (ALIGN_EPI) { if (wr == 1) PG8_BAR; }
    }
    PG8_WAIT_V(0);
    if constexpr (!ALIGN_EPI) { if (wr == 0) PG8_BAR; }
    PG8_BAR;
    if constexpr (Epi::AFTER_DRAIN) { E.fused(acc, cur, wr, wc, fr, fq, lds, wid, lane); S.done(cur); }
#undef PG8_SA
#undef PG8_SB
#undef PG8_STAGE
#undef PG8_LDA
#undef PG8_LDB
#undef PG8_MMA
#undef PG8_WAIT_V
#undef PG8_WAIT_L
#undef PG8_BAR
#undef PG8_SCHED
}
}
#define LAS __attribute__((address_space(3)))
#define XB_TMO      128
#define XB_XCNT(j)  (256  + 64 * (j))
#define XB_XSUB(j)  (1280 + 64 * (j))
#define XB_XGEN(j)  (2304 + 64 * (j))
#define XB_TOP      3328
#define XB_TOPGEN   3392
#define XCD_BAR_WORDS 3456
#define XB_SPIN_CAP (1u << 18)

__device__ __forceinline__ unsigned xb_ld(unsigned* p)              { return __hip_atomic_load(p, __ATOMIC_RELAXED, __HIP_MEMORY_SCOPE_AGENT); }
__device__ __forceinline__ unsigned xb_add(unsigned* p, unsigned v) { return __hip_atomic_fetch_add(p, v, __ATOMIC_RELAXED, __HIP_MEMORY_SCOPE_AGENT); }
__device__ __forceinline__ unsigned xb_xcc_id() { return (unsigned)__builtin_amdgcn_s_getreg((3 << 11) | 20) & 0xFu; }
#define XB_SPIN(cond, bar) do { unsigned _sp = 0; while (cond) { __builtin_amdgcn_s_sleep(1); \
    if ((++_sp & 255u) == 0u) { if (xb_ld(&(bar)[XB_TMO])) break; if (_sp > XB_SPIN_CAP) { atomicAdd(&(bar)[XB_TMO], 1u); break; } } } } while (0)

struct XcdBarrier {
    unsigned* bar; unsigned x;
    volatile LAS unsigned* st;
};

__device__ __forceinline__ XcdBarrier xcd_barrier_post(unsigned* bar, volatile LAS unsigned* st) {
    XcdBarrier b; b.bar = bar; b.x = xb_xcc_id(); b.st = st;
    if (threadIdx.x == 0) (void)xb_add(&bar[XB_XCNT(b.x)], 1u);
    return b;
}
__device__ __forceinline__ void xcd_barrier_complete(unsigned* bar, unsigned x, unsigned& nloc, unsigned& nx) {
    const unsigned G = gridDim.x * gridDim.y * gridDim.z;
    unsigned sum, cnt, mine, sp = 0u;
    for (;;) {
        sum = 0u; cnt = 0u; mine = 0u;
#pragma unroll
        for (unsigned j = 0; j < 16; ++j) { const unsigned c = xb_ld(&bar[XB_XCNT(j)]); sum += c; cnt += (c > 0u) ? 1u : 0u; mine = (j == x) ? c : mine; }
        if (sum == G) break;
        __builtin_amdgcn_s_sleep(1);
        if ((++sp & 255u) == 0u) { if (xb_ld(&bar[XB_TMO])) break; if (sp > XB_SPIN_CAP) { atomicAdd(&bar[XB_TMO], 1u); break; } }
    }
    nloc = mine > 0u ? mine : 1u; nx = cnt > 0u ? cnt : 1u;
}

__device__ __forceinline__ void xcd_barrier(const XcdBarrier& b) {
    asm volatile("s_waitcnt vmcnt(0)" ::: "memory");
    __syncthreads();
    if (threadIdx.x == 0) {
        unsigned* bar = b.bar;
        __builtin_amdgcn_s_waitcnt(0);
        unsigned nloc = b.st[0], nx = b.st[1];
        if (nloc == 0u) { xcd_barrier_complete(bar, b.x, nloc, nx); b.st[0] = nloc; b.st[1] = nx; }
        const unsigned old = xb_add(&bar[XB_XSUB(b.x)], 1u);
        const unsigned gen = old / nloc;
        if (old + 1u == (gen + 1u) * nloc) {
            __builtin_amdgcn_fence(__ATOMIC_RELEASE, "agent");
            asm volatile("s_waitcnt vmcnt(0)" ::: "memory");
            const unsigned og = xb_add(&bar[XB_TOP], 1u);
            const unsigned tg = og / nx;
            if (og + 1u == (tg + 1u) * nx) xb_add(&bar[XB_TOPGEN], 1u);
            else XB_SPIN(xb_ld(&bar[XB_TOPGEN]) == tg, bar);
            __builtin_amdgcn_fence(__ATOMIC_ACQUIRE, "agent");
            xb_add(&bar[XB_XGEN(b.x)], 1u);
            asm volatile("s_waitcnt vmcnt(0)" ::: "memory");
        } else {
            XB_SPIN(xb_ld(&bar[XB_XGEN(b.x)]) == gen, bar);
            __builtin_amdgcn_fence(__ATOMIC_ACQUIRE, "agent");
            asm volatile("s_waitcnt vmcnt(0)" ::: "memory");
        }
    }
    __syncthreads();
}

constexpr int NWAVES = 8, NTHREADS = 512;
constexpr int DM = 2048, NTP = 8192, NTS = 32, NT = 8224, MP = 8448;
constexpr int RW_COLS = 3360, Q_OFF = 3360, KC_OFF = 4384, KS_OFF = 4896, VS_OFF = 5152, KW_OFF = 5408, VW_OFF = 5664, GL_OFF = 5920, IN_COLS = 5968, PLD = 6144;
constexpr int NEXP = 16384, NPOOL = 1280;
constexpr float LN_EPS = 1e-5f, GN_EPS = 64e-5f, DN_ALPHA = 1.4142135623730951f;
constexpr float NEG_BIG = -1e30f;
constexpr size_t O_YP = 0, O_YS = O_YP + (size_t)NTP * DM, O_CMP_P = O_YS + (size_t)NTS * DM, O_SEL_P = O_CMP_P + (size_t)2 * NTP * 512, O_WIN_P = O_SEL_P + (size_t)2 * NTP * 512,
                 O_RW_P = O_WIN_P + (size_t)2 * 4 * 512 * 512, O_SH_P = O_RW_P + (size_t)2 * 4 * 16 * 4096, O_CMP_S = O_SH_P + (size_t)2 * 4 * RW_COLS, O_SEL_S = O_CMP_S + (size_t)2 * NTS * 512,
                 O_WIN_S = O_SEL_S + (size_t)2 * NTS * 512, O_RW_S = O_WIN_S + (size_t)2 * 8 * 512 * 512, O_SH_S = O_RW_S + (size_t)2 * 8 * 16 * 4096, O_END = O_SH_S + (size_t)2 * 8 * RW_COLS;
static_assert(O_END == 41630464, "output size");
constexpr size_t MiB = 1ull << 20;
constexpr size_t WS_CTL = 0, CTL_ZERO_BYTES = 1 * MiB;
constexpr size_t WS_WIN = 1 * MiB;
constexpr size_t WS_WOUT = WS_WIN + 48 * MiB;
constexpr size_t WS_W2 = WS_WOUT + 16 * MiB;
constexpr size_t WS_UB = WS_W2 + 16 * MiB;
constexpr size_t WS_VB = WS_UB + 64 * MiB;
constexpr size_t WS_USC = WS_VB + 64 * MiB;
constexpr size_t WS_XB = WS_USC + 1 * MiB;
constexpr size_t WS_X1B = WS_XB + 33 * MiB;
constexpr size_t WS_XF1 = WS_X1B + 33 * MiB;
constexpr size_t WS_X1F = WS_XF1 + 65 * MiB;
constexpr size_t WS_PROJ = WS_X1F + 65 * MiB;
constexpr size_t WS_SC = WS_PROJ + 99 * MiB;
constexpr size_t SC_STRIDE = 33 * MiB;
constexpr size_t WS_GG = WS_SC + 6 * SC_STRIDE;
constexpr size_t WS_BON = WS_GG + 33 * MiB;
constexpr size_t WS_MIX = WS_BON + 1 * MiB;
constexpr size_t WS_HS = WS_MIX + 33 * MiB;
constexpr size_t WS_KCB = WS_HS + 66 * MiB;
constexpr size_t WS_VCBT = WS_KCB + 512 * 1024;
constexpr size_t WS_VTS = WS_KCB + 1 * MiB;
constexpr size_t WS_VTW = WS_VTS + 4 * MiB;
constexpr size_t WS_KCBS = WS_VTW + 4 * MiB;
constexpr size_t WS_VCBS = WS_KCBS + 17 * MiB;
constexpr size_t WS_LT = WS_VCBS + 17 * MiB;
constexpr size_t WS_KSC = WS_LT + 2 * MiB;
constexpr size_t WS_KWC = WS_KSC + 4 * MiB;
constexpr size_t WS_OPS = WS_KWC + 4 * MiB;
constexpr size_t OPS_BYTES = 51200;
constexpr size_t WS_EL = WS_OPS + 80 * MiB;
constexpr size_t WS_GT = WS_EL + 3 * MiB;
constexpr size_t WS_PD = WS_GT + 5 * MiB;
constexpr size_t WS_WP = WS_PD + 65 * MiB;
constexpr size_t WS_FO = WS_WP + 5 * MiB;
constexpr size_t WS_X1Q = WS_FO + 65 * MiB;
constexpr size_t WS_XQS = WS_X1Q + 17 * MiB;
constexpr size_t WS_END = WS_XQS + 1 * MiB;
constexpr int CW_BAR = 4096, CW_QUEUE = 8192, CW_SQ = 65536, CW_FLAG = 16384;
constexpr int RING_BYTES = 131072, MISC_OFF = RING_BYTES + 320, LDS_BYTES = 147456;
constexpr int N_PHASES = 23;

typedef unsigned short bf16;
typedef unsigned v4u __attribute__((ext_vector_type(4)));
typedef unsigned v2u __attribute__((ext_vector_type(2)));
typedef float f32x4 __attribute__((ext_vector_type(4)));
typedef float f32x16 __attribute__((ext_vector_type(16)));
typedef short bf16x8 __attribute__((ext_vector_type(8)));
typedef float f32x2_t __attribute__((ext_vector_type(2)));
typedef __bf16 bf16x2_t __attribute__((ext_vector_type(2)));
#define LDS_WAIT() asm volatile("s_waitcnt lgkmcnt(0)" ::: "memory")
#define DI __device__ __forceinline__
#define GAS __attribute__((address_space(1)))
template <class T> DI T* launder_g(T* p) { GAS T* g = (GAS T*)p; asm volatile("" : "+s"(g)); return (T*)g; }

DI unsigned pk2(float lo, float hi) { f32x2_t v = {lo, hi}; bf16x2_t b = __builtin_convertvector(v, bf16x2_t); return __builtin_bit_cast(unsigned, b); }
DI float bf2f(unsigned short u) { return __builtin_bit_cast(float, (unsigned)u << 16); }
DI float bflo(unsigned u) { return __builtin_bit_cast(float, u << 16); }
DI float bfhi(unsigned u) { return __builtin_bit_cast(float, u & 0xffff0000u); }
template <int CTRL> DI float dppf(float v) { return __builtin_bit_cast(float, __builtin_amdgcn_update_dpp(0, __builtin_bit_cast(int, v), CTRL, 0xF, 0xF, false)); }
DI float rdlane(float v, int l) { return __builtin_bit_cast(float, __builtin_amdgcn_readlane(__builtin_bit_cast(int, v), l)); }
DI float wave_sum(float v) {
    v += dppf<0xB1>(v); v += dppf<0x4E>(v); v += dppf<0x141>(v); v += dppf<0x140>(v);
    return (rdlane(v, 0) + rdlane(v, 16)) + (rdlane(v, 32) + rdlane(v, 48));
}
DI float wave_max(float v) {
    v = fmaxf(v, dppf<0xB1>(v)); v = fmaxf(v, dppf<0x4E>(v)); v = fmaxf(v, dppf<0x141>(v)); v = fmaxf(v, dppf<0x140>(v));
    return fmaxf(fmaxf(rdlane(v, 0), rdlane(v, 16)), fmaxf(rdlane(v, 32), rdlane(v, 48)));
}
DI float sigmoidf_(float x) { return 1.f / (1.f + expf(-x)); }
DI int crow(int reg, int h) { return (reg & 3) + 8 * (reg >> 2) + 4 * h; }

struct ArgsK { const float* in[30]; float* out; unsigned char* ws; int ph_lo, ph_hi, use_bar, pad; };
struct ArgsG { const GAS float* in[30]; GAS float* out; GAS unsigned char* ws; int ph_lo, ph_hi, use_bar, pad; };
typedef __attribute__((address_space(4))) const ArgsG* kargp_t;
struct Ctx {
    float* out; unsigned char* ws;
    LAS unsigned char* lds; unsigned* ctl;
    int tid, lane, wave, G;
    DI const float* inp(int k) const { kargp_t p = (kargp_t)__builtin_amdgcn_kernarg_segment_ptr(); asm volatile("" : "+s"(p)); return (const float*)p->in[k]; }
};
template <class T> DI T* wsp(const Ctx& C, size_t off) { return (T*)(C.ws + off); }

struct EpiInProj {
    static constexpr bool PERM = true, AFTER_DRAIN = false;
    bf16* P; float* out; int l;
    DI void operator()(const pg8::f32x4 (&acc)[2][2][4][2], const pg8::Unit& u, int wr, int wc, int fr, int fq) const {
        const int row0 = u.pm * 256 + wr * 64 + fr, col0 = u.pn * 256 + wc * 32 + 8 * fq;
#pragma unroll
        for (int bj = 0; bj < 2; ++bj) {
            const int colb = __builtin_amdgcn_readfirstlane(u.pn * 256 + wc * 32 + bj * 128);
            const int col = col0 + bj * 128;
            const int kind = colb < RW_COLS ? 1 : ((colb >= KC_OFF && colb < GL_OFF) ? 2 : 0);
            const int reg = (colb - KC_OFF) >> 9, cc = (col - KC_OFF) & 511;
#pragma unroll
            for (int ai = 0; ai < 2; ++ai)
#pragma unroll
                for (int m = 0; m < 4; ++m) {
                    const int row = row0 + ai * 128 + m * 16;
                    const pg8::f32x4 v0 = acc[ai][bj][m][0], v1 = acc[ai][bj][m][1];
                    v4u w; w.x = pk2(v0[0], v0[1]); w.y = pk2(v0[2], v0[3]); w.z = pk2(v1[0], v1[1]); w.w = pk2(v1[2], v1[3]);
                    *(v4u*)(P + (size_t)row * PLD + col) = w;
                    if (kind == 0 || row >= NT) continue;
                    unsigned off = 0xffffffffu;
                    if (row < NTP) { const int b = row >> 11, t = row & 2047;
                        if (kind == 1) { if (t == 2047) off = (unsigned)(O_SH_P + (size_t)(l * 4 + b) * RW_COLS + col); }
                        else if (reg == 0) off = (unsigned)(O_CMP_P + ((size_t)l * NTP + row) * 512 + cc);
                        else if (reg == 1) off = (unsigned)(O_SEL_P + ((size_t)l * NTP + row) * 512 + cc);
                        else if (t >= 1536) off = (unsigned)(O_WIN_P + ((size_t)(l * 4 + b) * 512 + (t - 1536)) * 512 + cc);
                    } else { const int j = row - NTP, b = j >> 2, t = j & 3;
                        if (kind == 1) { if (t == 3) off = (unsigned)(O_SH_S + (size_t)(l * 8 + b) * RW_COLS + col); }
                        else if (reg == 0) off = (unsigned)(O_CMP_S + ((size_t)l * NTS + j) * 512 + cc);
                        else if (reg == 1) off = (unsigned)(O_SEL_S + ((size_t)l * NTS + j) * 512 + cc);
                        else off = (unsigned)(O_WIN_S + ((size_t)(l * 8 + b) * 512 + 508 + t) * 512 + cc);
                    }
                    if (off != 0xffffffffu) { *(pg8::f32x4*)(out + off) = v0; *(pg8::f32x4*)(out + off + 4) = v1; }
                }
        }
    }
};

struct EpiBf16Row {
    static constexpr bool PERM = true, AFTER_DRAIN = false;
    bf16* Cb; int ldc;
    DI void operator()(const pg8::f32x4 (&acc)[2][2][4][2], const pg8::Unit& u, int wr, int wc, int fr, int fq) const {
        const int row0 = u.pm * 256 + wr * 64 + fr, col0 = u.pn * 256 + wc * 32 + 8 * fq;
#pragma unroll
        for (int bj = 0; bj < 2; ++bj)
#pragma unroll
            for (int ai = 0; ai < 2; ++ai)
#pragma unroll
                for (int m = 0; m < 4; ++m) { const pg8::f32x4 v0 = acc[ai][bj][m][0], v1 = acc[ai][bj][m][1];
                    v4u w; w.x = pk2(v0[0], v0[1]); w.y = pk2(v0[2], v0[3]); w.z = pk2(v1[0], v1[1]); w.w = pk2(v1[2], v1[3]);
                    *(v4u*)(Cb + (size_t)(row0 + ai * 128 + m * 16) * ldc + col0 + bj * 128) = w; }
    }
};

template <class Sink> DI void skinny_gemm(const Ctx& C, const bf16* A, const bf16* Bt, int nslabs, const Sink& sink) {
    const int tid = C.tid, lane = C.lane, wave = C.wave, r = lane & 31, hi = lane >> 5;
    LAS float* PS = (LAS float*)C.lds;
    for (int it = blockIdx.x; it < nslabs; it += C.G) {
        const int n0 = it * 32, k0 = wave * 256;
        f32x16 acc;
#pragma unroll
        for (int i = 0; i < 16; ++i) acc[i] = 0.f;
        const bf16* ap = A + (size_t)r * DM + k0 + 8 * hi; const bf16* bp = Bt + (size_t)(n0 + r) * DM + k0 + 8 * hi;
#pragma unroll 8
        for (int s = 0; s < 16; ++s) { const bf16x8 af = *(const bf16x8*)(ap + 16 * s), bf = *(const bf16x8*)(bp + 16 * s); acc = __builtin_amdgcn_mfma_f32_32x32x16_bf16(af, bf, acc, 0, 0, 0); }
        __syncthreads();
#pragma unroll
        for (int i = 0; i < 16; ++i) PS[(wave * 32 + crow(i, hi)) * 33 + r] = acc[i];
        __syncthreads();
#pragma unroll
        for (int e = 0; e < 2; ++e) { const int o = tid * 2 + e, row = o >> 5, col = o & 31; float v = 0.f;
#pragma unroll
            for (int w = 0; w < 8; ++w) v += PS[(w * 32 + row) * 33 + col];
            sink(row, n0 + col, v); }
    }
    __syncthreads();
}

DI void transpose_item(const float* W, int K, int N, int Npad, bf16* WT, LAS float* scr, int item, int lane) {
    const int nblk = Npad / 32, kb = item / nblk, nb = item % nblk, k0 = 64 * kb, n0 = 32 * nb;
    float tv[32];
#pragma unroll
    for (int i = 0; i < 32; ++i) { const int kk = 2 * i + (lane >> 5), n = n0 + (lane & 31); tv[i] = n < N ? W[(size_t)(k0 + kk) * N + n] : 0.f; }
#pragma unroll
    for (int i = 0; i < 32; ++i) { const int kk = 2 * i + (lane >> 5); scr[kk * 33 + (lane & 31)] = tv[i]; }
    LDS_WAIT(); asm volatile("" ::: "memory");
    const int c = lane & 7;
#pragma unroll
    for (int j = 0; j < 4; ++j) { const int n = (lane >> 3) + 8 * j; const LAS float* s = scr + (8 * c) * 33 + n;
        v4u o; o.x = pk2(s[0 * 33], s[1 * 33]); o.y = pk2(s[2 * 33], s[3 * 33]); o.z = pk2(s[4 * 33], s[5 * 33]); o.w = pk2(s[6 * 33], s[7 * 33]);
        *(v4u*)(WT + (size_t)(n0 + n) * K + k0 + 8 * c) = o; }
    LDS_WAIT(); asm volatile("" ::: "memory");
}


DI void p0i_table(const Ctx& C, int r) {
    const int lane = C.lane, wave = C.wave;
    f32x4 v[2][8];
#pragma unroll
    for (int h = 0; h < 2; ++h) { const int row = r * 16 + 8 * h + wave;
        const float* src = (row < 32768 ? C.inp(26) : C.inp(27)) + (size_t)(row & 32767) * DM;
#pragma unroll
        for (int k = 0; k < 2; ++k)
#pragma unroll
            for (int q = 0; q < 4; ++q) v[h][4 * k + q] = ((const f32x4*)src)[4 * lane + 256 * k + q]; }
#pragma unroll
    for (int h = 0; h < 2; ++h) { const int row = r * 16 + 8 * h + wave;
        unsigned char* dst = C.ws + (row < 32768 ? WS_UB : WS_VB) + (size_t)((row >> 14) & 1) * NEXP * DM + (size_t)(row & 16383) * 128;
        float am = 0.f;
#pragma unroll
        for (int j = 0; j < 8; ++j) am = fmaxf(am, fmaxf(fmaxf(fabsf(v[h][j][0]), fabsf(v[h][j][1])), fmaxf(fabsf(v[h][j][2]), fabsf(v[h][j][3]))));
        am = wave_max(am);
        const bool isu = row < 32768;
        const float sc = am > 0.f ? am * (isu ? 1.f / 127.f : 1.f / 256.f) : 1.f, inv = 1.f / sc;
#pragma unroll
        for (int k = 0; k < 2; ++k) { v4u o;
#pragma unroll
            for (int q = 0; q < 4; ++q) { const f32x4 x = v[h][4 * k + q] * inv;
                if (isu) o[q] = ((unsigned)(int)__builtin_rintf(x[0]) & 255u) | (((unsigned)(int)__builtin_rintf(x[1]) & 255u) << 8) | (((unsigned)(int)__builtin_rintf(x[2]) & 255u) << 16) | ((unsigned)(int)__builtin_rintf(x[3]) << 24);
                else { int p = __builtin_amdgcn_cvt_pk_fp8_f32(x[0], x[1], 0, false); p = __builtin_amdgcn_cvt_pk_fp8_f32(x[2], x[3], p, true); o[q] = (unsigned)p; } }
            *(v4u*)(dst + ((size_t)((lane >> 3) + 8 * k) * NEXP) * 128 + 16 * (lane & 7)) = o; }
        if (lane == 0) wsp<float>(C, WS_USC)[row] = sc; }
}
DI void p0i_cache(const Ctx& C, int r) {
    const int tid = C.tid;
    const int l = r >> 10, b = (r >> 7) & 7, pi = r & 127;
    const int pid = ((const int*)C.inp(4))[b * 128 + pi];
    const int q = tid >> 7, c4 = tid & 127, kv = c4 >> 6, kvh = (c4 >> 4) & 3, d0 = (c4 & 15) * 4;
    const f32x4* src = (const f32x4*)(C.inp(2) + ((size_t)(l * NPOOL + pid) * 128 + 32 * q) * 512) + c4;
    const float* w = C.inp(20) + (l * 2 + kv) * 32;
    f32x4 acc = {0.f, 0.f, 0.f, 0.f};
    f32x4 cr[32];
#pragma unroll
    for (int rr = 0; rr < 32; ++rr) cr[rr] = src[(size_t)rr * 128];
#pragma unroll
    for (int rr = 0; rr < 32; ++rr) acc += cr[rr] * w[rr];
    *(f32x4*)(wsp<float>(C, kv ? WS_VCBS : WS_KCBS) + ((size_t)((l * 8 + b) * 4 + kvh) * 512 + 4 * pi + q) * 64 + d0) = acc;
}
DI void p0i_transpose(const Ctx& C, int r) {
    const int lane = C.lane, wave = C.wave;
    const int l = r >> 10, w8 = (r & 1023) * 8 + wave;
    LAS float* scr = (LAS float*)(C.lds + wave * 16384);
    if (w8 < 6144) transpose_item(C.inp(8) + (size_t)l * DM * IN_COLS, DM, IN_COLS, PLD, wsp<bf16>(C, WS_WIN) + (size_t)l * PLD * DM, scr, w8, lane);
    else transpose_item(C.inp(21) + (size_t)l * DM * DM, DM, DM, DM, wsp<bf16>(C, WS_WOUT) + (size_t)l * DM * DM, scr, w8 - 6144, lane);
}
DI bf16x8 bf8_of(const f32x4& a, const f32x4& b) { const v4u p = {pk2(a[0], a[1]), pk2(a[2], a[3]), pk2(b[0], b[1]), pk2(b[2], b[3])}; return __builtin_bit_cast(bf16x8, p); }
DI f32x4 bf_resid(const f32x4& a, unsigned p01, unsigned p23) { return (f32x4){a[0] - bflo(p01), a[1] - bfhi(p01), a[2] - bflo(p23), a[3] - bfhi(p23)}; }
DI void p0i_w2(const Ctx& C, int r) {
    const int lane = C.lane, wave = C.wave, rr = lane & 31, hi = lane >> 5;
    const int l = r >> 9, hc = (r >> 5) & 15, kb = r & 31, kt = wave & 3, nt = wave >> 2;
    const float* sk = C.inp(25) + ((size_t)l * 16 + hc) * 16384 + (size_t)(kt * 32 + rr) * 128 + 8 * hi;
    const float* wq = C.inp(24) + (size_t)l * DM * DM + (size_t)(kb * 64 + nt * 32 + rr) * DM + hc * 128 + 8 * hi;
    f32x16 acc;
#pragma unroll
    for (int i = 0; i < 16; ++i) acc[i] = 0.f;
#pragma unroll 4
    for (int s = 0; s < 8; ++s) {
        const f32x4 a0 = *(const f32x4*)(sk + 16 * s), a1 = *(const f32x4*)(sk + 16 * s + 4), b0 = *(const f32x4*)(wq + 16 * s), b1 = *(const f32x4*)(wq + 16 * s + 4);
        const v4u ahp = {pk2(a0[0], a0[1]), pk2(a0[2], a0[3]), pk2(a1[0], a1[1]), pk2(a1[2], a1[3])}, bhp = {pk2(b0[0], b0[1]), pk2(b0[2], b0[3]), pk2(b1[0], b1[1]), pk2(b1[2], b1[3])};
        const bf16x8 ah = __builtin_bit_cast(bf16x8, ahp), bh = __builtin_bit_cast(bf16x8, bhp);
        const bf16x8 al = bf8_of(bf_resid(a0, ahp.x, ahp.y), bf_resid(a1, ahp.z, ahp.w)), bl = bf8_of(bf_resid(b0, bhp.x, bhp.y), bf_resid(b1, bhp.z, bhp.w));
        acc = __builtin_amdgcn_mfma_f32_32x32x16_bf16(ah, bh, acc, 0, 0, 0);
        acc = __builtin_amdgcn_mfma_f32_32x32x16_bf16(ah, bl, acc, 0, 0, 0);
        acc = __builtin_amdgcn_mfma_f32_32x32x16_bf16(al, bh, acc, 0, 0, 0);
    }
    bf16* W2 = wsp<bf16>(C, WS_W2) + (size_t)l * DM * DM + (size_t)(hc * 128 + kt * 32) * DM + kb * 64 + nt * 32 + rr;
#pragma unroll
    for (int i = 0; i < 16; ++i) W2[(size_t)crow(i, hi) * DM] = (unsigned short)(pk2(acc[i], 0.f) & 0xffffu);
}
constexpr int DEF_ITEMS = 4096 + 1024 + 1024 + 1024, DEF_GROUPS = DEF_ITEMS / 4;
DI void deferred_item(const Ctx& C, int i) {
    if (i < 4096) p0i_table(C, i);
    else if (i < 5120) p0i_cache(C, 1024 + (i - 4096));
    else if (i < 6144) p0i_transpose(C, 1024 + (i - 5120));
    else p0i_w2(C, i - 6144);
}

constexpr int P0_NX = 2056, P0_NWP = 508;
DI void p0_prologue(const Ctx& C, int pmask = 31) {
    const int tid = C.tid;
    LAS int* qslot = (LAS int*)(C.lds + MISC_OFF + 64);
#define P0_CLAIM 4
#define P0_BLOCK(n, qi) for (int base_ = 0; ; ) { __syncthreads(); if (tid == 0) *qslot = (int)atomicAdd(C.ctl + CW_QUEUE + 64 * (8 + (qi)), (unsigned)P0_CLAIM); __syncthreads(); base_ = *qslot; if (base_ >= (n)) break; \
        for (int r = base_, r_hi = (base_ + P0_CLAIM < (n) ? base_ + P0_CLAIM : (n)); r < r_hi; ++r)
#define P0_END }
    if (pmask & 4) P0_BLOCK(1024, 2) { p0i_transpose(C, r); } P0_END
    if (pmask & 16) P0_BLOCK(P0_NX, 4) {{
            const size_t e0 = (size_t)r * 8192 + tid * 16;
            const float* src = e0 < (size_t)NTP * DM ? C.inp(0) + e0 : C.inp(1) + (e0 - (size_t)NTP * DM);
            const f32x4* s4 = (const f32x4*)src;
            const f32x4 a = s4[0], b = s4[1], c = s4[2], d = s4[3];
            v4u o0, o1; o0.x = pk2(a[0], a[1]); o0.y = pk2(a[2], a[3]); o0.z = pk2(b[0], b[1]); o0.w = pk2(b[2], b[3]);
            o1.x = pk2(c[0], c[1]); o1.y = pk2(c[2], c[3]); o1.z = pk2(d[0], d[1]); o1.w = pk2(d[2], d[3]);
            v4u* d4 = (v4u*)(wsp<bf16>(C, WS_XB) + e0); d4[0] = o0; d4[1] = o1;
        }} P0_END
    if (pmask & 2) P0_BLOCK(1024, 1) { p0i_cache(C, r); } P0_END
    if (pmask & 4) P0_BLOCK(144, 6) {{
            const int g = r * 512 + tid, l = g / 36864, rem = g % 36864, c = rem / 36, kg = rem % 36;
            const float* src = kg < 8 ? C.inp(11) + ((size_t)l * 64 + kg * 8) * 1024 : (kg < 16 ? C.inp(13) + ((size_t)l * 64 + (kg - 8) * 8) * 1024 : C.inp(14) + ((size_t)l * 160 + (kg - 16) * 8) * 1024);
            float e[8];
#pragma unroll
            for (int q = 0; q < 8; ++q) e[q] = src[(size_t)q * 1024 + c];
            *(v4u*)(wsp<bf16>(C, WS_LT) + ((size_t)l * 1024 + c) * 288 + kg * 8) = (v4u){pk2(e[0], e[1]), pk2(e[2], e[3]), pk2(e[4], e[5]), pk2(e[6], e[7])};
        }} P0_END
    if (pmask & 16) P0_BLOCK(P0_NWP, 5) {{
            const size_t i0 = (size_t)r * 8192 + tid * 16;
            const size_t lb = i0 / 260096, rem = i0 % 260096;
            const f32x4* s4 = (const f32x4*)(C.inp(5) + lb * 262144 + 2048 + rem);
            f32x4* d4 = (f32x4*)(C.out + O_WIN_S + lb * 262144 + rem);
            const f32x4 a = s4[0], b = s4[1], c = s4[2], d = s4[3];
            d4[0] = a; d4[1] = b; d4[2] = c; d4[3] = d;
        }} P0_END
    __syncthreads();
}

constexpr int PB_NRW = 514, PB_NPOOL = 256, PB_NVT = 1024, PB_ITEMS = PB_NRW + PB_NPOOL + PB_NVT;
DI float softplusf_(float x) { return x > 20.f ? x : log1pf(expf(x)); }
DI float fexp_(float x) { return __expf(x); }
DI float fsoftplus_(float x) { return x > 20.f ? x : __logf(1.f + __expf(x)); }
DI float fsigmoid_(float x) { return __builtin_amdgcn_rcpf(1.f + __expf(-x)); }

constexpr int XSB_LD = 3088, ACTB_LD = 296;
DI void rwkv_pre_item(const Ctx& C, int l, int item) {
    const int tid = C.tid, lane = C.lane, wave = C.wave, n16 = lane & 15, rq = lane >> 4;
    LAS unsigned short* XSB = (LAS unsigned short*)C.lds;
    LAS unsigned short* ACTB = (LAS unsigned short*)(C.lds + 16 * XSB_LD * 2);
    const bf16* P = wsp<bf16>(C, WS_PROJ);
    const int m0 = item * 16;
    __syncthreads();
#pragma unroll 1
    for (int base = 0; base < 16 * 420; base += 4 * NTHREADS) {
        v4u cu[4], pu[4]; f32x4 mu0[4], mu1[4], sh0[4], sh1[4]; int jj_[4], col_[4], kind[4];
#pragma unroll
        for (int u = 0; u < 4; ++u) { const int idx = base + u * NTHREADS + tid; kind[u] = -1; jj_[u] = 0; col_[u] = 0;
            if (idx < 16 * 420) { const int j = idx / 420, col = (idx % 420) * 8, m = m0 + j; jj_[u] = j; col_[u] = col;
                cu[u] = *(const v4u*)(P + (size_t)m * PLD + col);
                const f32x4* mup = (const f32x4*)(C.inp(9) + (size_t)l * RW_COLS + col); mu0[u] = mup[0]; mu1[u] = mup[1];
                int t; const float* sh = nullptr;
                if (m < NTP) t = m & 2047; else { const int jq = m - NTP; t = jq & 3; sh = C.inp(7) + (size_t)(l * 8 + (jq >> 2)) * RW_COLS + col; }
                if (t > 0) { pu[u] = *(const v4u*)(P + (size_t)(m - 1) * PLD + col); kind[u] = 1; }
                else if (sh) { sh0[u] = ((const f32x4*)sh)[0]; sh1[u] = ((const f32x4*)sh)[1]; kind[u] = 2; }
                else kind[u] = 0; } }
#pragma unroll
        for (int u = 0; u < 4; ++u) if (kind[u] >= 0) {
            const int j = jj_[u], col = col_[u];
            float cur[8] = {bflo(cu[u].x), bfhi(cu[u].x), bflo(cu[u].y), bfhi(cu[u].y), bflo(cu[u].z), bfhi(cu[u].z), bflo(cu[u].w), bfhi(cu[u].w)};
            float prev[8];
            if (kind[u] == 1) { prev[0] = bflo(pu[u].x); prev[1] = bfhi(pu[u].x); prev[2] = bflo(pu[u].y); prev[3] = bfhi(pu[u].y); prev[4] = bflo(pu[u].z); prev[5] = bfhi(pu[u].z); prev[6] = bflo(pu[u].w); prev[7] = bfhi(pu[u].w); }
            else if (kind[u] == 2) {
#pragma unroll
                for (int e = 0; e < 4; ++e) { prev[e] = sh0[u][e]; prev[4 + e] = sh1[u][e]; } }
            else {
#pragma unroll
                for (int e = 0; e < 8; ++e) prev[e] = 0.f; }
            float xs[8];
#pragma unroll
            for (int e = 0; e < 4; ++e) { xs[e] = cur[e] + mu0[u][e] * (prev[e] - cur[e]); xs[4 + e] = cur[4 + e] + mu1[u][e] * (prev[4 + e] - cur[4 + e]); }
            if (col >= 3072) { const int a0 = col - 3072;
#pragma unroll
                for (int e = 0; e < 8; ++e) xs[e] = a0 < 64 ? tanhf(xs[e]) : (a0 < 128 ? xs[e] : fsigmoid_(xs[e]));
                *(LAS v4u*)(ACTB + j * ACTB_LD + a0) = (v4u){pk2(xs[0], xs[1]), pk2(xs[2], xs[3]), pk2(xs[4], xs[5]), pk2(xs[6], xs[7])};
            } else *(LAS v4u*)(XSB + j * XSB_LD + col) = (v4u){pk2(xs[0], xs[1]), pk2(xs[2], xs[3]), pk2(xs[4], xs[5]), pk2(xs[6], xs[7])};
        }
    }
    __syncthreads();
    float* SC = wsp<float>(C, WS_SC); constexpr size_t SS = SC_STRIDE / 4;
    float* GG = wsp<float>(C, WS_GG); float* BON = wsp<float>(C, WS_BON);
    const bf16* LT = wsp<bf16>(C, WS_LT) + (size_t)l * 1024 * 288;
    const f32x4 zf = {0.f, 0.f, 0.f, 0.f};
#pragma unroll 1
    for (int hh = 0; hh < 2; ++hh) {
        const int head = 2 * wave + hh;
        f32x4 aw[4], aa[4], ag[4];
#pragma unroll
        for (int t4 = 0; t4 < 4; ++t4) { aw[t4] = zf; aa[t4] = zf; ag[t4] = zf; }
#define LORA_STEPS(ACC, KS0, NKS) _Pragma("unroll 2") for (int ks = (KS0); ks < (KS0) + (NKS); ++ks) { \
            const bf16x8 af = *(const LAS bf16x8*)(ACTB + n16 * ACTB_LD + 32 * ks + 8 * rq); \
            _Pragma("unroll") for (int t4 = 0; t4 < 4; ++t4) { const bf16x8 bfr = *(const bf16x8*)(LT + (size_t)(head * 64 + 16 * t4 + n16) * 288 + 32 * ks + 8 * rq); \
                ACC[t4] = __builtin_amdgcn_mfma_f32_16x16x32_bf16(af, bfr, ACC[t4], 0, 0, 0); } }
        LORA_STEPS(aw, 0, 2) LORA_STEPS(aa, 2, 2) LORA_STEPS(ag, 4, 5)
#undef LORA_STEPS
        float w0v[4], a0v[4], kkv[4], kav[4], rkv[4];
#pragma unroll
        for (int t4 = 0; t4 < 4; ++t4) { const int c = l * 1024 + head * 64 + 16 * t4 + n16; w0v[t4] = C.inp(10)[c]; a0v[t4] = C.inp(12)[c]; kkv[t4] = C.inp(15)[c]; kav[t4] = C.inp(16)[c]; rkv[t4] = C.inp(17)[c]; }
#pragma unroll
        for (int i = 0; i < 4; ++i) {
            const int j = 4 * rq + i; const size_t m = (size_t)m0 + j;
            float kkr[4], km[4], a_[4], rr[4], vv[4], lw_[4]; float ss = 0.f, bs = 0.f;
#pragma unroll
            for (int t4 = 0; t4 < 4; ++t4) { const int cl = head * 64 + 16 * t4 + n16;
                const float z = w0v[t4] + aw[t4][i];
                const float w = -fsoftplus_(-z) - 0.5f;
                lw_[t4] = -fexp_(w);
                a_[t4] = fsigmoid_(a0v[t4] + aa[t4][i]);
                rr[t4] = bf2f(XSB[j * XSB_LD + cl]); const float k = bf2f(XSB[j * XSB_LD + 1024 + cl]); vv[t4] = bf2f(XSB[j * XSB_LD + 2048 + cl]);
                kkr[t4] = k * kkv[t4]; ss += kkr[t4] * kkr[t4];
                km[t4] = k * (1.f + (a_[t4] - 1.f) * kav[t4]); bs += rr[t4] * km[t4] * rkv[t4]; }
            ss += dppf<0xB1>(ss); ss += dppf<0x4E>(ss); ss += dppf<0x141>(ss); ss += dppf<0x140>(ss);
            bs += dppf<0xB1>(bs); bs += dppf<0x4E>(bs); bs += dppf<0x141>(bs); bs += dppf<0x140>(bs);
            const float rn = __builtin_amdgcn_rsqf(fmaxf(ss, 1e-24f));
#pragma unroll
            for (int t4 = 0; t4 < 4; ++t4) { const int c = head * 64 + 16 * t4 + n16; const float kk = kkr[t4] * rn;
                ((bf16*)(SC + 0 * SS))[m * 1024 + c] = (unsigned short)(pk2(kk, 0.f) & 0xffffu); SC[1 * SS + m * 1024 + c] = fexp_(lw_[t4]); SC[3 * SS + m * 1024 + c] = lw_[t4];
                ((unsigned*)(SC + 2 * SS))[m * 1024 + head * 64 + n16 * 4 + t4] = pk2(-kk * a_[t4], km[t4]);
                ((bf16*)(SC + 4 * SS))[m * 1024 + c] = (unsigned short)(pk2(rr[t4], 0.f) & 0xffffu); SC[5 * SS + m * 1024 + c] = vv[t4];
                GG[m * 1024 + c] = ag[t4][i]; }
            if (n16 == 0) BON[m * 16 + head] = bs;
        }
    }
}

DI void phase_b(const Ctx& C, int l, int lq) {
    const int tid = C.tid;
    const bf16* P = wsp<bf16>(C, WS_PROJ);
    LAS int* qslot = (LAS int*)(C.lds + MISC_OFF + 64);
    for (;;) {
        __syncthreads();
        if (tid == 0) *qslot = (int)atomicAdd(C.ctl + CW_QUEUE + 64 * (16 + lq), 1u);
        __syncthreads();
        const int it = *qslot;
        if (it >= PB_ITEMS) break;
        int r = it;
        if (r < PB_NRW) { rwkv_pre_item(C, l, r); continue; }
        r -= PB_NRW;
        if (r < PB_NPOOL) {
            const int b = r >> 6, n = r & 63, kv = tid >> 8, kvh = (tid >> 6) & 3, d = tid & 63;
            const float* src = C.out + O_CMP_P + ((size_t)l * NTP + b * 2048 + 32 * n) * 512 + tid;
            const float* w = C.inp(20) + (l * 2 + kv) * 32;
            float acc = 0.f;
#pragma unroll 8
            for (int rr = 0; rr < 32; ++rr) acc += w[rr] * src[(size_t)rr * 512];
            const unsigned short hb = (unsigned short)(pk2(acc, 0.f) & 0xffffu);
            if (kv == 0) wsp<bf16>(C, WS_KCB)[((size_t)(b * 4 + kvh) * 64 + n) * 64 + d] = hb;
            else wsp<bf16>(C, WS_VCBT)[((size_t)(b * 4 + kvh) * 64 + d) * 64 + n] = hb;
            continue;
        }
        r -= PB_NPOOL;
        {
            const int which = r >> 9, b = (r >> 7) & 3, kvh = (r >> 5) & 3, tb = r & 31, d = tid & 63, tq = tid >> 6;
            const bf16* src = P + (size_t)(b * 2048 + 64 * tb + 8 * tq) * PLD + (which ? VW_OFF : VS_OFF) + kvh * 64 + d;
            unsigned short e[8];
#pragma unroll
            for (int i = 0; i < 8; ++i) e[i] = src[(size_t)i * PLD];
            v4u o; o.x = e[0] | ((unsigned)e[1] << 16); o.y = e[2] | ((unsigned)e[3] << 16); o.z = e[4] | ((unsigned)e[5] << 16); o.w = e[6] | ((unsigned)e[7] << 16);
            *(v4u*)(wsp<bf16>(C, which ? WS_VTW : WS_VTS) + (((size_t)(b * 4 + kvh) * 32 + tb) * 64 + d) * 64 + 8 * tq) = o;
            { const int row = tid >> 3, ch = tid & 7;
              const v4u kv_ = *(const v4u*)(P + (size_t)(b * 2048 + 64 * tb + row) * PLD + (which ? KW_OFF : KS_OFF) + kvh * 64 + ch * 8);
              *(v4u*)(wsp<bf16>(C, which ? WS_KWC : WS_KSC) + ((size_t)(b * 4 + kvh) * 2048 + 64 * tb + row) * 64 + ch * 8) = kv_; }
        }
    }
    __syncthreads();
}

#define MFMA16(a, b, c) __builtin_amdgcn_mfma_f32_16x16x32_bf16((a), (b), (c), 0, 0, 0)
DI void scan_head(const Ctx& C, int l, int row0, int T, int h, const float* S0, float* Sout) {
    const int tid = C.tid, lane = C.lane, wave = C.wave;
    LAS f32x4* D4 = (LAS f32x4*)C.lds;
    LAS v4u* BK4 = (LAS v4u*)(C.lds + 8192);
    LAS f32x4* V4 = (LAS f32x4*)(C.lds + 16384);
    LAS v4u* R16 = (LAS v4u*)(C.lds + 24576);
    LAS v4u* KK16 = (LAS v4u*)(C.lds + 28672);
    LAS float* YB = (LAS float*)(C.lds + 33280);
    const unsigned char* SCb = C.ws + WS_SC;
    const bf16* SCKK = (const bf16*)SCb; const float* SCD = (const float*)(SCb + SC_STRIDE); const unsigned* SCBK = (const unsigned*)(SCb + 2 * SC_STRIDE);
    const bf16* SCR = (const bf16*)(SCb + 4 * SC_STRIDE); const float* SCV = (const float*)(SCb + 5 * SC_STRIDE);
    const float* GG = wsp<float>(C, WS_GG); const float* BON = wsp<float>(C, WS_BON);
    bf16* MIX = wsp<bf16>(C, WS_MIX);
    const int n = lane & 15, rq = lane >> 4, v0 = 16 * (wave & 3); const bool act = wave < 4;
    f32x4 acc[4];
#pragma unroll
    for (int kt = 0; kt < 4; ++kt) acc[kt] = (act && S0) ? *(const f32x4*)(S0 + (v0 + n) * 64 + 16 * kt + 4 * rq) : (f32x4){0.f, 0.f, 0.f, 0.f};
    const int nch = (T + 31) >> 5;
    f32x4 pD, pV; v4u pBK, pRK, pK2;
    const v4u z4 = {0u, 0u, 0u, 0u};
#define SCAN_PREFETCH(cc) do { { const int step = (cc) * 32 + (tid >> 4), f4 = tid & 15; const size_t o = (size_t)(row0 + step) * 1024 + h * 64 + f4 * 4; const bool ok = step < T; \
            pD = ok ? *(const f32x4*)(SCD + o) : (f32x4){0.f, 0.f, 0.f, 0.f}; pV = ok ? *(const f32x4*)(SCV + o) : (f32x4){0.f, 0.f, 0.f, 0.f}; pBK = ok ? *(const v4u*)(SCBK + o) : z4; } \
        { const int i2 = tid & 255, step = (cc) * 32 + (i2 >> 3); const size_t o = (size_t)(row0 + step) * 1024 + h * 64 + (i2 & 7) * 8; pRK = step < T ? *(const v4u*)((tid < 256 ? SCR : SCKK) + o) : z4; } \
        { const int step = (cc) * 32 + 32; const size_t o = (size_t)(row0 + step) * 1024 + h * 64 + (tid & 7) * 8; pK2 = (tid < 8 && step < T) ? *(const v4u*)(SCKK + o) : z4; } } while (0)
    SCAN_PREFETCH(0);
    const float gng = C.inp(18)[l * 1024 + h * 64 + lane], gnb = C.inp(19)[l * 1024 + h * 64 + lane];
    float sk = 0.f;
    struct StepOps { f32x4 d[4]; v4u bk; float vt; v2u a[4]; };
#define SCAN_LD(o, st_) do { _Pragma("unroll") for (int kt = 0; kt < 4; ++kt) (o).d[kt] = D4[(st_) * 16 + 4 * kt + rq]; (o).bk = BK4[(st_) * 16 + n]; (o).vt = ((const LAS float*)V4)[(st_) * 64 + v0 + n]; \
        const LAS unsigned char* src_ = (n & 3) == 1 ? (const LAS unsigned char*)KK16 + ((st_) + 1) * 128 : (const LAS unsigned char*)R16 + (st_) * 128; \
        (o).a[0] = *(const LAS v2u*)(src_ + 8 * rq); (o).a[1] = *(const LAS v2u*)(src_ + 32 + 8 * rq); (o).a[2] = *(const LAS v2u*)(src_ + 64 + 8 * rq); (o).a[3] = *(const LAS v2u*)(src_ + 96 + 8 * rq); } while (0)
#define SCAN_YSK(a0_, a1_, a2_, a3_, yv, skv) do { \
        v4u h0, h1; h0.x = pk2(acc[0][0], acc[0][1]); h0.y = pk2(acc[0][2], acc[0][3]); h0.z = pk2(acc[1][0], acc[1][1]); h0.w = pk2(acc[1][2], acc[1][3]); \
        h1.x = pk2(acc[2][0], acc[2][1]); h1.y = pk2(acc[2][2], acc[2][3]); h1.z = pk2(acc[3][0], acc[3][1]); h1.w = pk2(acc[3][2], acc[3][3]); \
        const v4u f0 = {(a0_).x, (a0_).y, (a1_).x, (a1_).y}, f1 = {(a2_).x, (a2_).y, (a3_).x, (a3_).y}; \
        f32x4 d2 = MFMA16(__builtin_bit_cast(bf16x8, f0), __builtin_bit_cast(bf16x8, h0), ((f32x4){0.f, 0.f, 0.f, 0.f})); \
        d2 = MFMA16(__builtin_bit_cast(bf16x8, f1), __builtin_bit_cast(bf16x8, h1), d2); yv = d2[0]; skv = d2[1]; } while (0)
    for (int c = 0; c < nch; ++c) {
        __syncthreads();
        D4[tid] = pD; BK4[tid] = pBK; V4[tid] = pV;
        if (tid < 256) R16[tid] = pRK; else KK16[tid - 256] = pRK;
        if (tid < 8) KK16[256 + tid] = pK2;
        __syncthreads();
        if (c + 1 < nch) SCAN_PREFETCH(c + 1);
        const int nst = (T - c * 32) < 32 ? (T - c * 32) : 32;
        float gq[4], bq[4];
#pragma unroll
        for (int qq = 0; qq < 4; ++qq) { const int st = wave * 4 + qq; const size_t m = (size_t)row0 + c * 32 + (st < nst ? st : 0);
            gq[qq] = GG[m * 1024 + h * 64 + lane]; bq[qq] = BON[m * 16 + h]; }
        if (act) {
            if (c == 0) {
                const LAS unsigned char* s0 = (const LAS unsigned char*)KK16;
                const v2u k0 = *(const LAS v2u*)(s0 + 8 * rq), k1 = *(const LAS v2u*)(s0 + 32 + 8 * rq), k2 = *(const LAS v2u*)(s0 + 64 + 8 * rq), k3 = *(const LAS v2u*)(s0 + 96 + 8 * rq);
                float yd; SCAN_YSK(k0, k1, k2, k3, sk, yd); (void)yd;
            }
            StepOps cur; SCAN_LD(cur, 0);
#pragma unroll 2
            for (int st = 0; st < nst; ++st) {
                StepOps nx; { const int sn = st + 1 < 32 ? st + 1 : 31; SCAN_LD(nx, sn); }
#pragma unroll
                for (int kt = 0; kt < 4; ++kt) acc[kt] = acc[kt] * cur.d[kt];
                v4u b2 = z4; b2.x = rq == 0 ? pk2(sk, cur.vt) : 0u;
#pragma unroll
                for (int kt = 0; kt < 4; ++kt) { v4u a2 = z4; a2.x = rq == 0 ? cur.bk[kt] : 0u; acc[kt] = MFMA16(__builtin_bit_cast(bf16x8, a2), __builtin_bit_cast(bf16x8, b2), acc[kt]); }
                float y; SCAN_YSK(cur.a[0], cur.a[1], cur.a[2], cur.a[3], y, sk);
                if (rq == 0) YB[st * 64 + v0 + n] = y;
                cur = nx;
            }
        }
        __syncthreads();
#pragma unroll
        for (int qq = 0; qq < 4; ++qq) {
            const int st = wave * 4 + qq;
            if (st < nst) {
                const size_t m = (size_t)row0 + c * 32 + st;
                const float y = YB[st * 64 + lane];
                const float mean = wave_sum(y) * (1.f / 64.f);
                const float dv = y - mean;
                const float var = wave_sum(dv * dv) * (1.f / 64.f);
                const float yn = dv * __builtin_amdgcn_rsqf(var + GN_EPS) * gng + gnb;
                const float o = (yn + bq[qq] * ((const LAS float*)V4)[st * 64 + lane]) * gq[qq];
                MIX[m * DM + h * 64 + lane] = (unsigned short)(pk2(o, 0.f) & 0xffffu);
            }
        }
    }
#undef SCAN_PREFETCH
#undef SCAN_LD
#undef SCAN_YSK
    if (act) {
#pragma unroll
        for (int kt = 0; kt < 4; ++kt) *(f32x4*)(Sout + (v0 + n) * 64 + 16 * kt + 4 * rq) = acc[kt];
    }
}

constexpr int CST = 144, CBUF = 64 * CST;
DI void cmm(const LAS unsigned char* L, const LAS unsigned char* Rt, f32x4 (&acc)[2], int tm, int tn0, int n16, int kq) {
#pragma unroll
    for (int ks = 0; ks < 2; ++ks) {
        const bf16x8 a = *(const LAS bf16x8*)(L + (16 * tm + n16) * CST + (32 * ks + 8 * kq) * 2);
#pragma unroll
        for (int j = 0; j < 2; ++j) { const bf16x8 bq = *(const LAS bf16x8*)(Rt + (16 * (tn0 + j) + n16) * CST + (32 * ks + 8 * kq) * 2); acc[j] = MFMA16(a, bq, acc[j]); }
    }
}
template <int MODE> DI void cst_T(LAS unsigned char* X, const f32x4 (&acc)[2], int tm, int tn0, int n16, int rq) {
#pragma unroll
    for (int j = 0; j < 2; ++j) { const int n = 16 * (tn0 + j) + n16, m0 = 16 * tm + 4 * rq; float v[4];
#pragma unroll
        for (int i = 0; i < 4; ++i) { const int col = m0 + i; const bool keep = MODE == 0 ? true : (MODE == 1 ? col < n : (MODE == 2 ? col <= n : col > n)); v[i] = keep ? acc[j][i] : 0.f; }
        *(LAS v2u*)(X + n * CST + m0 * 2) = (v2u){pk2(v[0], v[1]), pk2(v[2], v[3])}; }
}
template <int mode> DI void chunk_head(const Ctx& C, int l, int b, int h, float* Sout, int part) {
    const int tid = C.tid, lane = C.lane, wave = C.wave;
    const int n16 = lane & 15, rq = lane >> 4, tm = wave >> 1, tn0 = (wave & 1) * 2;
    LAS unsigned char* const B0 = C.lds;
#define CB(i) (B0 + (i) * CBUF)
    enum { I_BH = 0, I_BHT = 1, I_AH = 2, I_KH = 3, I_RH = 4, I_ATT = 5, I_KTT = 6, I_VT = 7, I_A1 = 8, I_A1T = 9, I_A2 = 10, I_M1 = 11, I_M2 = 12, I_H0T = 13 };
    LAS float* SEG = (LAS float*)(B0 + 14 * CBUF);
    LAS float* YB = (LAS float*)CB(8);
    const unsigned char* SCb = C.ws + WS_SC;
    const bf16* SCKK = (const bf16*)SCb; const unsigned* SCBK = (const unsigned*)(SCb + 2 * SC_STRIDE); const float* SCLW = (const float*)(SCb + 3 * SC_STRIDE);
    const bf16* SCR = (const bf16*)(SCb + 4 * SC_STRIDE); const float* SCV = (const float*)(SCb + 5 * SC_STRIDE);
    const float* GG = wsp<float>(C, WS_GG); const float* BON = wsp<float>(C, WS_BON);
    bf16* MIX = wsp<bf16>(C, WS_MIX);
    const size_t m0 = (size_t)b * 2048;
    const int pk = tid & 63, seg = tid >> 6, bkidx = (pk & 15) * 4 + (pk >> 4);
    const f32x4 zf = {0.f, 0.f, 0.f, 0.f};
    f32x4 accH[2] = {zf, zf};
    __syncthreads();
    for (int i = tid; i < CBUF / 4; i += NTHREADS) ((LAS unsigned*)CB(I_H0T))[i] = 0u;
    float plw[8], pv[8]; unsigned pbk[8]; unsigned short pkk[8], pr[8];
#define CH_LOAD(cc) do { _Pragma("unroll") for (int i = 0; i < 8; ++i) { const size_t o = (m0 + (cc) * 64 + seg * 8 + i) * 1024 + h * 64; \
        plw[i] = SCLW[o + pk]; pkk[i] = SCKK[o + pk]; pbk[i] = SCBK[o + bkidx]; pr[i] = SCR[o + pk]; pv[i] = SCV[o + pk]; } } while (0)
    unsigned char* const OPS = C.ws + WS_OPS + (size_t)((b * 16 + h) * 24) * OPS_BYTES;
    unsigned* const flag = C.ctl + CW_FLAG + 64 * ((l * 64 + b * 16 + h) * 4);
    const int c_lo = mode ? 16 * part : 0, c_hi = mode ? 16 * part + 16 : 16;
    CH_LOAD(c_lo);
    const float gng = C.inp(18)[l * 1024 + h * 64 + lane], gnb = C.inp(19)[l * 1024 + h * 64 + lane];
    for (int c = c_lo; c < c_hi; ++c) {

        float gq[8], bq[8], vq[8];
#pragma unroll
        for (int i = 0; i < 8; ++i) { const size_t m = m0 + c * 64 + 8 * wave + i; gq[i] = GG[m * 1024 + h * 64 + lane]; bq[i] = BON[m * 16 + h]; vq[i] = SCV[m * 1024 + h * 64 + lane]; }
        float cs[8];
        { float run = 0.f;
#pragma unroll
          for (int i = 0; i < 8; ++i) { run += plw[i]; cs[i] = run; } }
        __syncthreads();
        SEG[seg * 64 + pk] = cs[7];
        __syncthreads();
        float off = 0.f, tot = 0.f;
#pragma unroll
        for (int s = 0; s < 8; ++s) { const float sv = SEG[s * 64 + pk]; tot += sv; off += s < seg ? sv : 0.f; }
        { unsigned short bt[8], at[8], kt[8], vt[8];
#pragma unroll
          for (int i = 0; i < 8; ++i) { const float csv = cs[i] + off;
              const float eP = __expf(csv), eM = __expf(-csv), ePm = __expf(csv - plw[i]), eQ = __expf(tot - csv);
              const float kkf = bf2f(pkk[i]), nb = bflo(pbk[i]), kmf = bfhi(pbk[i]), rf = bf2f(pr[i]);
              const int t = seg * 8 + i;
              const unsigned short vb = (unsigned short)(pk2(kkf * ePm, 0.f) & 0xffffu);
              *(LAS unsigned short*)(CB(I_BH) + t * CST + pk * 2) = vb; bt[i] = vb;
              *(LAS unsigned short*)(CB(I_AH) + t * CST + pk * 2) = (unsigned short)(pk2(nb * eM, 0.f) & 0xffffu);
              *(LAS unsigned short*)(CB(I_KH) + t * CST + pk * 2) = (unsigned short)(pk2(kmf * eM, 0.f) & 0xffffu);
              *(LAS unsigned short*)(CB(I_RH) + t * CST + pk * 2) = (unsigned short)(pk2(rf * eP, 0.f) & 0xffffu);
              at[i] = (unsigned short)(pk2(nb * eQ, 0.f) & 0xffffu); kt[i] = (unsigned short)(pk2(kmf * eQ, 0.f) & 0xffffu); vt[i] = (unsigned short)(pk2(pv[i], 0.f) & 0xffffu); }
#define PK8(a) ((v4u){(unsigned)a[0] | ((unsigned)a[1] << 16), (unsigned)a[2] | ((unsigned)a[3] << 16), (unsigned)a[4] | ((unsigned)a[5] << 16), (unsigned)a[6] | ((unsigned)a[7] << 16)})
          *(LAS v4u*)(CB(I_BHT) + pk * CST + seg * 16) = PK8(bt); *(LAS v4u*)(CB(I_ATT) + pk * CST + seg * 16) = PK8(at);
          *(LAS v4u*)(CB(I_KTT) + pk * CST + seg * 16) = PK8(kt); *(LAS v4u*)(CB(I_VT) + pk * CST + seg * 16) = PK8(vt);
#undef PK8
        }
        if (c + 1 < c_hi) CH_LOAD(c + 1);
        __syncthreads();
        f32x4 accT[2];
        { f32x4 a_[2];
          a_[0] = zf; a_[1] = zf; cmm(CB(I_BH), CB(I_AH), a_, tm, tn0, n16, rq); cst_T<3>(CB(I_A1T), a_, tm, tn0, n16, rq);
          a_[0] = zf; a_[1] = zf; cmm(CB(I_AH), CB(I_BH), a_, tm, tn0, n16, rq); cst_T<1>(CB(I_A1), a_, tm, tn0, n16, rq);
#pragma unroll
          for (int j = 0; j < 2; ++j)
#pragma unroll
              for (int i = 0; i < 4; ++i) { const int m = 16 * tm + 4 * rq + i, n = 16 * (tn0 + j) + n16; accT[j][i] = m < n ? a_[j][i] : (m == n ? 1.f : 0.f); }
          a_[0] = zf; a_[1] = zf; cmm(CB(I_KH), CB(I_BH), a_, tm, tn0, n16, rq); cst_T<1>(CB(I_A2), a_, tm, tn0, n16, rq);
          a_[0] = zf; a_[1] = zf; cmm(CB(I_AH), CB(I_RH), a_, tm, tn0, n16, rq); cst_T<2>(CB(I_M1), a_, tm, tn0, n16, rq);
          a_[0] = zf; a_[1] = zf; cmm(CB(I_KH), CB(I_RH), a_, tm, tn0, n16, rq); cst_T<2>(CB(I_M2), a_, tm, tn0, n16, rq); }
        __syncthreads();
        { int ip = I_A1, ipt = I_A1T, in_ = I_AH, int_ = I_KH;
#pragma unroll 1
          for (int lev = 0; lev < 5; ++lev) {
              cst_T<0>(CB(I_BH), accT, tm, tn0, n16, rq);
              f32x4 a_[2];
              a_[0] = zf; a_[1] = zf; cmm(CB(ip), CB(ipt), a_, tm, tn0, n16, rq); cst_T<0>(CB(int_), a_, tm, tn0, n16, rq);
              a_[0] = zf; a_[1] = zf; cmm(CB(ipt), CB(ip), a_, tm, tn0, n16, rq); cst_T<0>(CB(in_), a_, tm, tn0, n16, rq);
              __syncthreads();
              cmm(CB(int_), CB(I_BH), accT, tm, tn0, n16, rq);
              __syncthreads();
              const int t0 = ip, t1 = ipt; ip = in_; ipt = int_; in_ = t0; int_ = t1;
          }
          cst_T<0>(CB(I_BH), accT, tm, tn0, n16, rq); }
        { f32x4 a_[2];
          a_[0] = zf; a_[1] = zf; cmm(CB(I_A2), CB(I_VT), a_, tm, tn0, n16, rq); cst_T<0>(CB(8), a_, tm, tn0, n16, rq);
          __syncthreads();
          a_[0] = zf; a_[1] = zf; cmm(CB(I_BH), CB(I_BHT), a_, tm, tn0, n16, rq); cst_T<0>(CB(9), a_, tm, tn0, n16, rq);
          a_[0] = zf; a_[1] = zf; cmm(CB(I_BH), CB(8), a_, tm, tn0, n16, rq); cst_T<0>(CB(2), a_, tm, tn0, n16, rq); }
        __syncthreads();
        f32x4 accE[2] = {zf, zf}, accY[2] = {zf, zf};
        { f32x4 a_[2];
          a_[0] = zf; a_[1] = zf; cmm(CB(9), CB(I_ATT), a_, tm, tn0, n16, rq);
#pragma unroll
          for (int j = 0; j < 2; ++j) { const int n = 16 * (tn0 + j) + n16, mm0 = 16 * tm + 4 * rq; float pc = 0.f;
#pragma unroll
              for (int s = 0; s < 8; ++s) pc += SEG[s * 64 + n];
              pc = __expf(pc); float v[4];
#pragma unroll
              for (int i = 0; i < 4; ++i) v[i] = a_[j][i] + (mm0 + i == n ? pc : 0.f);
              *(LAS v2u*)(CB(3) + n * CST + mm0 * 2) = (v2u){pk2(v[0], v[1]), pk2(v[2], v[3])}; }
          cmm(CB(I_ATT), CB(2), accE, tm, tn0, n16, rq); cmm(CB(I_KTT), CB(I_VT), accE, tm, tn0, n16, rq);
          a_[0] = zf; a_[1] = zf; cmm(CB(9), CB(I_M1), a_, tm, tn0, n16, rq);
#pragma unroll
          for (int j = 0; j < 2; ++j) { const int n = 16 * (tn0 + j) + n16, mm0 = 16 * tm + 4 * rq;
              const v2u rh = *(const LAS v2u*)(CB(I_RH) + n * CST + mm0 * 2);
              *(LAS v2u*)(CB(10) + n * CST + mm0 * 2) = (v2u){pk2(a_[j][0] + bflo(rh.x), a_[j][1] + bfhi(rh.x)), pk2(a_[j][2] + bflo(rh.y), a_[j][3] + bfhi(rh.y))}; }
          cmm(CB(I_M1), CB(2), accY, tm, tn0, n16, rq); cmm(CB(I_M2), CB(I_VT), accY, tm, tn0, n16, rq); }
        __syncthreads();
        if (mode == 1) {
            unsigned char* ob = OPS + (size_t)(c - 16) * OPS_BYTES;
            for (int i = tid; i < 2 * CBUF / 16; i += NTHREADS) ((v4u*)ob)[i] = *(const LAS v4u*)((i < CBUF / 16 ? CB(3) : CB(10)) + (i < CBUF / 16 ? i : i - CBUF / 16) * 16);
            ((f32x4*)(ob + 2 * CBUF))[tid * 2] = accE[0]; ((f32x4*)(ob + 2 * CBUF))[tid * 2 + 1] = accE[1];
            ((f32x4*)(ob + 2 * CBUF + 16384))[tid * 2] = accY[0]; ((f32x4*)(ob + 2 * CBUF + 16384))[tid * 2 + 1] = accY[1];
            continue;
        }
        cmm(CB(3), CB(I_H0T), accE, tm, tn0, n16, rq); cmm(CB(10), CB(I_H0T), accY, tm, tn0, n16, rq);
        __syncthreads();
        accH[0] = accE[0]; accH[1] = accE[1];
        cst_T<0>(CB(I_H0T), accH, tm, tn0, n16, rq);
#pragma unroll
        for (int j = 0; j < 2; ++j)
#pragma unroll
            for (int i = 0; i < 4; ++i) YB[(16 * tm + 4 * rq + i) * 64 + 16 * (tn0 + j) + n16] = accY[j][i];
        __syncthreads();
#pragma unroll
        for (int i = 0; i < 8; ++i) {
            const int t = 8 * wave + i; const size_t m = m0 + c * 64 + t;
            const float y = YB[t * 64 + lane];
            const float mean = wave_sum(y) * (1.f / 64.f);
            const float dv = y - mean;
            const float var = wave_sum(dv * dv) * (1.f / 64.f);
            const float yn = dv * __builtin_amdgcn_rsqf(var + GN_EPS) * gng + gnb;
            const float o = (yn + bq[i] * vq[i]) * gq[i];
            MIX[m * DM + h * 64 + lane] = (unsigned short)(pk2(o, 0.f) & 0xffffu);
        }
    }
    if (mode == 0) for (int c = 16; c < 32; ++c) {
            float gq[8], bq[8], vq[8];
#pragma unroll
            for (int i = 0; i < 8; ++i) { const size_t m = m0 + c * 64 + 8 * wave + i; gq[i] = GG[m * 1024 + h * 64 + lane]; bq[i] = BON[m * 16 + h]; vq[i] = SCV[m * 1024 + h * 64 + lane]; }
            if ((c & 15) == 0) {
                if (tid == 0) { unsigned sp = 0; while (__hip_atomic_load(flag + 64 * (c >> 4), __ATOMIC_RELAXED, __HIP_MEMORY_SCOPE_AGENT) == 0u) { __builtin_amdgcn_s_sleep(8); if (++sp > (1u << 22)) break; }
                    __builtin_amdgcn_fence(__ATOMIC_ACQUIRE, "agent"); asm volatile("s_waitcnt vmcnt(0)" ::: "memory"); }
            }
            __syncthreads();
            const unsigned char* ob = OPS + (size_t)(c - 16) * OPS_BYTES;
            for (int i = tid; i < 2 * CBUF / 16; i += NTHREADS) { const v4u w = ((const v4u*)ob)[i]; *(LAS v4u*)((i < CBUF / 16 ? CB(3) : CB(10)) + (i < CBUF / 16 ? i : i - CBUF / 16) * 16) = w; }
            f32x4 accE[2], accY[2];
            accE[0] = ((const f32x4*)(ob + 2 * CBUF))[tid * 2]; accE[1] = ((const f32x4*)(ob + 2 * CBUF))[tid * 2 + 1];
            accY[0] = ((const f32x4*)(ob + 2 * CBUF + 16384))[tid * 2]; accY[1] = ((const f32x4*)(ob + 2 * CBUF + 16384))[tid * 2 + 1];
            __syncthreads();
            cmm(CB(3), CB(I_H0T), accE, tm, tn0, n16, rq); cmm(CB(10), CB(I_H0T), accY, tm, tn0, n16, rq);
            __syncthreads();
            accH[0] = accE[0]; accH[1] = accE[1];
            cst_T<0>(CB(I_H0T), accH, tm, tn0, n16, rq);
#pragma unroll
            for (int j = 0; j < 2; ++j)
#pragma unroll
                for (int i = 0; i < 4; ++i) YB[(16 * tm + 4 * rq + i) * 64 + 16 * (tn0 + j) + n16] = accY[j][i];
            __syncthreads();
#pragma unroll
            for (int i = 0; i < 8; ++i) {
                const int t = 8 * wave + i; const size_t m = m0 + c * 64 + t;
                const float y = YB[t * 64 + lane];
                const float mean = wave_sum(y) * (1.f / 64.f);
                const float dv = y - mean;
                const float var = wave_sum(dv * dv) * (1.f / 64.f);
                const float yn = dv * __builtin_amdgcn_rsqf(var + GN_EPS) * gng + gnb;
                const float o = (yn + bq[i] * vq[i]) * gq[i];
                MIX[m * DM + h * 64 + lane] = (unsigned short)(pk2(o, 0.f) & 0xffffu);
            }
    }
#undef CH_LOAD
#undef CB
    if (mode == 1) {
        asm volatile("s_waitcnt vmcnt(0)" ::: "memory");
        __syncthreads();
        if (tid == 0) { __builtin_amdgcn_fence(__ATOMIC_RELEASE, "agent"); asm volatile("s_waitcnt vmcnt(0)" ::: "memory"); __hip_atomic_store(flag + 64 * part, 1u, __ATOMIC_RELAXED, __HIP_MEMORY_SCOPE_AGENT); }
        return;
    }
#pragma unroll
    for (int j = 0; j < 2; ++j) *(f32x4*)(Sout + (size_t)(16 * (tn0 + j) + n16) * 64 + 16 * tm + 4 * rq) = accH[j];
}

#define MFMA32(a, b, c) __builtin_amdgcn_mfma_f32_32x32x16_bf16((a), (b), (c), 0, 0, 0)
DI bf16x8 pack8(const f32x16& p, int s) {
    v4u o; o.x = pk2(p[8 * s], p[8 * s + 1]); o.y = pk2(p[8 * s + 2], p[8 * s + 3]); o.z = pk2(p[8 * s + 4], p[8 * s + 5]); o.w = pk2(p[8 * s + 6], p[8 * s + 7]);
    return __builtin_bit_cast(bf16x8, o);
}
DI bf16x8 ld_vt(const bf16* p) {
    const v2u a = *(const v2u*)p, b = *(const v2u*)(p + 8);
    v4u o; o.x = a.x; o.y = a.y; o.z = b.x; o.w = b.y; return __builtin_bit_cast(bf16x8, o);
}
constexpr int KT_STRIDE = 144, VTT_STRIDE = 136, KT_BYTES = 64 * KT_STRIDE, TILE_BYTES = KT_BYTES + 64 * VTT_STRIDE, TILE_OFF = 74752;
struct TileRegs { v4u k, v; };
DI TileRegs tile_load(const bf16* kbase, size_t kstride, const bf16* vbase, size_t vstride, int tid) {
    TileRegs r; const int row = tid >> 3, ch = tid & 7;
    r.k = *(const v4u*)(kbase + (size_t)row * kstride + ch * 8); r.v = *(const v4u*)(vbase + (size_t)row * vstride + ch * 8); return r;
}
DI void tile_store(LAS unsigned char* buf, const TileRegs& r, int tid) {
    const int row = tid >> 3, ch = tid & 7;
    *(LAS v4u*)(buf + row * KT_STRIDE + ch * 16) = r.k;
    *(LAS v2u*)(buf + KT_BYTES + row * VTT_STRIDE + ch * 16) = (v2u){r.v.x, r.v.y}; *(LAS v2u*)(buf + KT_BYTES + row * VTT_STRIDE + ch * 16 + 8) = (v2u){r.v.z, r.v.w};
}
DI bf16x8 ld_vt_lds(const LAS unsigned char* p) {
    const v2u a = *(const LAS v2u*)p, b = *(const LAS v2u*)(p + 16);
    v4u o; o.x = a.x; o.y = a.y; o.z = b.x; o.w = b.y; return __builtin_bit_cast(bf16x8, o);
}
#define ATT_BLOCK(EDGE, BUF, KEYBLK0, MINE, VALID_EXPR) do { \
    const float bias_ = (MINE) ? 0.f : NEG_BIG; \
    _Pragma("unroll 1") for (int tile = 0; tile < 2; ++tile) { const int key0 = (KEYBLK0) + tile * 32; (void)key0; \
        f32x16 a_ = zero16; \
        _Pragma("unroll") for (int s = 0; s < 4; ++s) { const bf16x8 kf = *(const LAS bf16x8*)((BUF) + (tile * 32 + q) * KT_STRIDE + 32 * s + 16 * hi); a_ = MFMA32(kf, qf[s], a_); } \
        float tm = NEG_BIG; \
        if (EDGE) { _Pragma("unroll") for (int i = 0; i < 16; ++i) { const int key = key0 + crow(i, hi); const bool ok = (MINE) && (VALID_EXPR); a_[i] = ok ? a_[i] * SCL2 : NEG_BIG; tm = fmaxf(tm, a_[i]); } } \
        else { _Pragma("unroll") for (int i = 0; i < 16; ++i) { a_[i] = a_[i] * SCL2 + bias_; tm = fmaxf(tm, a_[i]); } } \
        tm = fmaxf(tm, __shfl_xor(tm, 32)); \
        const float mn = fmaxf(mrun, tm); const float sc_ = __builtin_amdgcn_exp2f(mrun - mn); \
        float ps = 0.f; \
        if (EDGE) { _Pragma("unroll") for (int i = 0; i < 16; ++i) { const float p_ = a_[i] > -1e29f ? __builtin_amdgcn_exp2f(a_[i] - mn) : 0.f; a_[i] = p_; ps += p_; } } \
        else { _Pragma("unroll") for (int i = 0; i < 16; ++i) { const float p_ = __builtin_amdgcn_exp2f(a_[i] - mn); a_[i] = p_; ps += p_; } } \
        ps += __shfl_xor(ps, 32); \
        lrun = lrun * sc_ + ps; mrun = mn; \
        _Pragma("unroll") for (int i = 0; i < 16; ++i) { oa[0][i] *= sc_; oa[1][i] *= sc_; } \
        _Pragma("unroll") for (int s = 0; s < 2; ++s) { const bf16x8 pb = pack8(a_, s); \
            oa[0] = MFMA32(ld_vt_lds((BUF) + KT_BYTES + q * VTT_STRIDE + (tile * 32 + 16 * s + 4 * hi) * 2), pb, oa[0]); \
            oa[1] = MFMA32(ld_vt_lds((BUF) + KT_BYTES + (32 + q) * VTT_STRIDE + (tile * 32 + 16 * s + 4 * hi) * 2), pb, oa[1]); } \
    } } while (0)
constexpr float SCL2 = 0.125f * 1.4426950408889634f;

DI void nsa_prompt_unit(const Ctx& C, int l, int b, int kvh, int qt, bool skipblk = false, bool skipcmp = false) {
    const int tid = C.tid, lane = C.lane, wave = C.wave;
    const int g = wave & 3, th = wave >> 2, q = lane & 31, hi = lane >> 5;
    LAS float* IMP = (LAS float*)C.lds;
    LAS float* IMPV = (LAS float*)(C.lds + 65536);
    LAS unsigned* SELM = (LAS unsigned*)(C.lds + 65536 + 8192);
    LAS unsigned char* TB = C.lds + TILE_OFF;
    const bf16* P = wsp<bf16>(C, WS_PROJ);
    const int tok = qt * 64 + th * 32 + q;
    const size_t m = (size_t)b * 2048 + tok;
    const int bk = b * 4 + kvh, head = kvh * 4 + g;
    f32x16 zero16;
#pragma unroll
    for (int i = 0; i < 16; ++i) zero16[i] = 0.f;
    bf16x8 qf[4];
#pragma unroll
    for (int s = 0; s < 4; ++s) qf[s] = *(const bf16x8*)(P + m * PLD + Q_OFF + head * 64 + 16 * s + 8 * hi);
    f32x16 out0 = zero16, out1 = zero16;
    const float g0 = sigmoidf_(bf2f(P[m * PLD + GL_OFF + head * 3 + 0])), g1 = sigmoidf_(bf2f(P[m * PLD + GL_OFF + head * 3 + 1])), g2 = sigmoidf_(bf2f(P[m * PLD + GL_OFF + head * 3 + 2]));
    TileRegs tr = tile_load(wsp<bf16>(C, WS_KCB) + (size_t)bk * 4096, 64, wsp<bf16>(C, WS_VCBT) + (size_t)bk * 4096, 64, tid);
    __syncthreads();
    tile_store(TB, tr, tid);
    __syncthreads();
    if (!skipcmp) {
    {
        f32x16 sc[2];
        const int nvalid = (tok + 1) >> 5;
        float mx = NEG_BIG;
#pragma unroll
        for (int tile = 0; tile < 2; ++tile) {
            f32x16 a_ = zero16;
#pragma unroll
            for (int s = 0; s < 4; ++s) { const bf16x8 kf = *(const LAS bf16x8*)(TB + (tile * 32 + q) * KT_STRIDE + 32 * s + 16 * hi); a_ = MFMA32(kf, qf[s], a_); }
#pragma unroll
            for (int i = 0; i < 16; ++i) { const int n = tile * 32 + crow(i, hi); a_[i] = n < nvalid ? a_[i] * 0.125f : NEG_BIG; mx = fmaxf(mx, a_[i]); }
            sc[tile] = a_;
        }
        mx = fmaxf(mx, __shfl_xor(mx, 32));
        float sum = 0.f;
#pragma unroll
        for (int tile = 0; tile < 2; ++tile)
#pragma unroll
            for (int i = 0; i < 16; ++i) { const float p_ = sc[tile][i] > -1e29f ? __expf(sc[tile][i] - mx) : 0.f; sc[tile][i] = p_; sum += p_; }
        sum += __shfl_xor(sum, 32);
        const float inv = nvalid > 0 ? 1.f / sum : 0.f;
        f32x16 oc0 = zero16, oc1 = zero16;
#pragma unroll
        for (int tile = 0; tile < 2; ++tile) {
#pragma unroll
            for (int i = 0; i < 16; ++i) sc[tile][i] *= inv;
#pragma unroll
            for (int i4 = 0; i4 < 4; ++i4) { f32x4 v = {sc[tile][4 * i4], sc[tile][4 * i4 + 1], sc[tile][4 * i4 + 2], sc[tile][4 * i4 + 3]};
                *(LAS f32x4*)(IMP + ((size_t)(g * 64 + th * 32 + q)) * 64 + tile * 32 + 8 * i4 + 4 * hi) = v; }
#pragma unroll
            for (int s = 0; s < 2; ++s) { const bf16x8 pb = pack8(sc[tile], s);
                oc0 = MFMA32(ld_vt_lds(TB + KT_BYTES + q * VTT_STRIDE + (tile * 32 + 16 * s + 4 * hi) * 2), pb, oc0);
                oc1 = MFMA32(ld_vt_lds(TB + KT_BYTES + (32 + q) * VTT_STRIDE + (tile * 32 + 16 * s + 4 * hi) * 2), pb, oc1); }
        }
#pragma unroll
        for (int i = 0; i < 16; ++i) { out0[i] = g0 * oc0[i]; out1[i] = g0 * oc1[i]; }
    }
    __syncthreads();
    {
        const int tokl = tid >> 3, jq = tid & 7;
        float v[4];
#pragma unroll
        for (int e = 0; e < 4; ++e) v[e] = 0.f;
#pragma unroll
        for (int gg = 0; gg < 4; ++gg) { const f32x4 a = *(const LAS f32x4*)(IMP + (size_t)(gg * 64 + tokl) * 64 + 8 * jq), bq = *(const LAS f32x4*)(IMP + (size_t)(gg * 64 + tokl) * 64 + 8 * jq + 4);
            v[0] += a[0] + a[1]; v[1] += a[2] + a[3]; v[2] += bq[0] + bq[1]; v[3] += bq[2] + bq[3]; }
        const int cur = qt;
#pragma unroll
        for (int e = 0; e < 4; ++e) { const int j = 4 * jq + e; const bool forced = (j == 0) | (j == cur) | (j == cur - 1); v[e] = j > cur ? -1.f : (forced ? 1e4f : v[e]); }
        *(LAS f32x4*)(IMPV + tokl * 32 + 4 * jq) = (f32x4){v[0], v[1], v[2], v[3]};
        __syncthreads();
        int rank[4] = {0, 0, 0, 0};
#pragma unroll
        for (int jj4 = 0; jj4 < 8; ++jj4) { const f32x4 o = *(const LAS f32x4*)(IMPV + tokl * 32 + 4 * jj4);
#pragma unroll
            for (int u = 0; u < 4; ++u) { const int jp = 4 * jj4 + u; const float ov = o[u];
#pragma unroll
                for (int e = 0; e < 4; ++e) { const int j = 4 * jq + e; rank[e] += (ov > v[e] || (ov == v[e] && jp < j)) ? 1 : 0; } } }
        unsigned bits = 0;
#pragma unroll
        for (int e = 0; e < 4; ++e) if (rank[e] < 16 && v[e] >= 0.f) bits |= 1u << (4 * jq + e);
        bits |= __shfl_xor(bits, 1); bits |= __shfl_xor(bits, 2); bits |= __shfl_xor(bits, 4);
        if (jq == 0) SELM[tokl] = bits;
        __syncthreads();
    }
    }
    if (skipcmp && tid < 64) SELM[tid] = 0xffffffffu;
    __syncthreads();
    const unsigned selm = SELM[th * 32 + q];
    unsigned uni;
    { unsigned u0 = SELM[lane];
#pragma unroll
      for (int o = 1; o < 64; o <<= 1) u0 |= __shfl_xor(u0, o);
      uni = __builtin_amdgcn_readfirstlane(u0); }
    {
        LAS float* PARK = (LAS float*)C.lds + wave * 2048 + lane;
#pragma unroll
        for (int i = 0; i < 16; ++i) { PARK[i * 64] = out0[i]; PARK[(16 + i) * 64] = out1[i]; }
        const bf16* KBs = wsp<bf16>(C, WS_KSC) + (size_t)bk * 2048 * 64; const bf16* KBw = wsp<bf16>(C, WS_KWC) + (size_t)bk * 2048 * 64;
        const bf16* VTs = wsp<bf16>(C, WS_VTS) + (size_t)bk * 32 * 4096; const bf16* VTw = wsp<bf16>(C, WS_VTW) + (size_t)bk * 32 * 4096;
        f32x16 oa[2] = {zero16, zero16}; float mrun = NEG_BIG, lrun = 0.f;
        unsigned rem = skipblk ? 1u : uni; int wj = skipblk ? qt : (qt > 8 ? qt - 8 : 0); bool folded = false;
#define NEXT_BLK(dst) do { if (rem) { dst = __builtin_ctz(rem); rem &= rem - 1; } else if (wj <= qt) { dst = wj | 256; ++wj; } else dst = -1; } while (0)
#define LOAD_BLK(tr_, d_) do { const int j_ = (d_) & 255; tr_ = ((d_) & 256) ? tile_load(KBw + (size_t)j_ * 4096, 64, VTw + (size_t)j_ * 4096, 64, tid) : tile_load(KBs + (size_t)j_ * 4096, 64, VTs + (size_t)j_ * 4096, 64, tid); } while (0)
#define FOLD(gate_) do { const float il_ = (gate_) / lrun; _Pragma("unroll") for (int i = 0; i < 16; ++i) { PARK[i * 64] += il_ * oa[0][i]; PARK[(16 + i) * 64] += il_ * oa[1][i]; } \
            oa[0] = zero16; oa[1] = zero16; mrun = NEG_BIG; lrun = 0.f; } while (0)
#define DO_BLK(d_, buf_) do { const int j_ = (d_) & 255; const bool win_ = ((d_) & 256) != 0; \
            if (win_ && !folded) { FOLD(g1); folded = true; } \
            const bool mine = win_ ? true : (((selm >> j_) & 1u) != 0u); \
            if (__any(mine)) { const int wl_ = win_ ? 511 : (1 << 20); const bool edge_ = (j_ == qt) || (win_ && j_ + 8 <= qt); \
                if (edge_) ATT_BLOCK(1, buf_, j_ * 64, mine, (key <= tok && key + wl_ >= tok)); else ATT_BLOCK(0, buf_, j_ * 64, mine, true); } } while (0)
        int d0, d1, d2; TileRegs trA, trB;
        NEXT_BLK(d0); NEXT_BLK(d1);
        LOAD_BLK(trA, d0); if (d1 >= 0) LOAD_BLK(trB, d1);
        __syncthreads();
        for (;;) {
            tile_store(TB, trA, tid); __syncthreads();
            NEXT_BLK(d2); if (d2 >= 0) LOAD_BLK(trA, d2);
            DO_BLK(d0, TB);
            if (d1 < 0) break;
            tile_store(TB + TILE_BYTES, trB, tid); __syncthreads();
            NEXT_BLK(d0); if (d0 >= 0) LOAD_BLK(trB, d0);
            DO_BLK(d1, TB + TILE_BYTES);
            if (d2 < 0) break;
            d1 = d0; d0 = d2;
        }
        FOLD(g2);
#undef NEXT_BLK
#undef LOAD_BLK
#undef FOLD
#undef DO_BLK
#pragma unroll
        for (int i = 0; i < 16; ++i) { out0[i] = PARK[i * 64]; out1[i] = PARK[(16 + i) * 64]; }
    }
    bf16* MIX = wsp<bf16>(C, WS_MIX) + m * DM + 1024 + head * 64;
    if (!skipblk)
#pragma unroll
    for (int i4 = 0; i4 < 4; ++i4) {
        v2u o; o.x = pk2(out0[4 * i4], out0[4 * i4 + 1]); o.y = pk2(out0[4 * i4 + 2], out0[4 * i4 + 3]); *(v2u*)(MIX + 8 * i4 + 4 * hi) = o;
        o.x = pk2(out1[4 * i4], out1[4 * i4 + 1]); o.y = pk2(out1[4 * i4 + 2], out1[4 * i4 + 3]); *(v2u*)(MIX + 32 + 8 * i4 + 4 * hi) = o;
    }
}

template <class RowFn> DI void samp_block(const RowFn& rowptr, int nvalid, int kvh, const LAS float* QS, LAS float* PWw, int lane, float (&M)[4], float (&L)[4], float (&O)[4]) {
    float s[4] = {0.f, 0.f, 0.f, 0.f};
    const bool ok = lane < nvalid;
    if (ok) {
        const f32x4* kr = (const f32x4*)(rowptr(lane) + kvh * 64);
#pragma unroll 4
        for (int d4 = 0; d4 < 16; ++d4) { const f32x4 kq = kr[d4];
#pragma unroll
            for (int g = 0; g < 4; ++g) { const f32x4 qq = *(const LAS f32x4*)(QS + g * 64 + 4 * d4); s[g] += kq[0] * qq[0] + kq[1] * qq[1] + kq[2] * qq[2] + kq[3] * qq[3]; } }
    }
    float mb[4], lb[4];
#pragma unroll
    for (int g = 0; g < 4; ++g) { const float sv = ok ? s[g] : NEG_BIG; mb[g] = wave_max(sv); const float p = ok ? expf(sv - mb[g]) : 0.f; lb[g] = wave_sum(p); PWw[g * 64 + lane] = p; }
    LDS_WAIT(); asm volatile("" ::: "memory");
    float ob[4] = {0.f, 0.f, 0.f, 0.f};
    for (int r0 = 0; r0 < nvalid; r0 += 4) {
        float vv[4];
#pragma unroll
        for (int u = 0; u < 4; ++u) vv[u] = r0 + u < nvalid ? rowptr(r0 + u)[256 + kvh * 64 + lane] : 0.f;
#pragma unroll
        for (int u = 0; u < 4; ++u)
#pragma unroll
            for (int g = 0; g < 4; ++g) ob[g] += PWw[g * 64 + r0 + u] * vv[u]; }
    LDS_WAIT(); asm volatile("" ::: "memory");
#pragma unroll
    for (int g = 0; g < 4; ++g) { const float mn = fmaxf(M[g], mb[g]); const float a = expf(M[g] - mn), bsc = expf(mb[g] - mn); L[g] = L[g] * a + lb[g] * bsc; O[g] = O[g] * a + ob[g] * bsc; M[g] = mn; }
}
DI float samp_combine(LAS float* WST, int tid, int lane, int wave, const float (&M)[4], const float (&L)[4], const float (&O)[4]) {
    __syncthreads();
#pragma unroll
    for (int g = 0; g < 4; ++g) { WST[wave * 264 + 8 + g * 64 + lane] = O[g]; if (lane == 0) { WST[wave * 264 + g] = M[g]; WST[wave * 264 + 4 + g] = L[g]; } }
    __syncthreads();
    float res = 0.f;
    if (tid < 256) { const int g = tid >> 6, d = tid & 63; float mm = NEG_BIG;
#pragma unroll
        for (int w = 0; w < 8; ++w) mm = fmaxf(mm, WST[w * 264 + g]);
        float ll = 0.f, oo = 0.f;
#pragma unroll
        for (int w = 0; w < 8; ++w) { const float e = expf(WST[w * 264 + g] - mm); ll += WST[w * 264 + 4 + g] * e; oo += WST[w * 264 + 8 + g * 64 + d] * e; }
        res = oo / ll; }
    return res;
}

DI void nsa_sample_item(const Ctx& C, int l, int b, int t, int kvh) {
    const int tid = C.tid, lane = C.lane, wave = C.wave;
    LAS float* F = (LAS float*)C.lds;
    LAS float *QS = F, *PC = F + 256, *IMPS = F + 2304, *RED = F + 2624, *RED2 = F + 2688, *OCP = F + 2752, *PW = F + 4800, *WST = F + 6848;
    LAS int* SELB = (LAS int*)(F + 2560);
    const bf16* P = wsp<bf16>(C, WS_PROJ);
    const size_t m = (size_t)NTP + b * 4 + t;
    __syncthreads();
    if (tid < 256) QS[tid] = bf2f(P[m * PLD + Q_OFF + kvh * 256 + tid]) * 0.125f;
    __syncthreads();
    float ocmp = 0.f;
    {
        const float* KC = wsp<float>(C, WS_KCBS) + ((size_t)((l * 8 + b) * 4 + kvh) * 512) * 64;
        const float* VC = wsp<float>(C, WS_VCBS) + ((size_t)((l * 8 + b) * 4 + kvh) * 512) * 64;
        float s[4] = {0.f, 0.f, 0.f, 0.f};
        const f32x4* kr = (const f32x4*)(KC + (size_t)tid * 64);
#pragma unroll 4
        for (int d4 = 0; d4 < 16; ++d4) { const f32x4 kq = kr[d4];
#pragma unroll
            for (int g = 0; g < 4; ++g) { const f32x4 qq = *(const LAS f32x4*)(QS + g * 64 + 4 * d4); s[g] += kq[0] * qq[0] + kq[1] * qq[1] + kq[2] * qq[2] + kq[3] * qq[3]; } }
#pragma unroll
        for (int g = 0; g < 4; ++g) { const float wm = wave_max(s[g]); if (lane == 0) RED[wave * 4 + g] = wm; }
        __syncthreads();
        float p[4];
#pragma unroll
        for (int g = 0; g < 4; ++g) { float mm = RED[g];
#pragma unroll
            for (int w = 1; w < 8; ++w) mm = fmaxf(mm, RED[w * 4 + g]);
            p[g] = expf(s[g] - mm); const float ws = wave_sum(p[g]); if (lane == 0) RED2[wave * 4 + g] = ws; }
        __syncthreads();
#pragma unroll
        for (int g = 0; g < 4; ++g) { float tot = 0.f;
#pragma unroll
            for (int w = 0; w < 8; ++w) tot += RED2[w * 4 + g];
            PC[g * 512 + tid] = p[g] / tot; }
        __syncthreads();
        if (tid < 256) IMPS[tid] = (PC[2 * tid] + PC[2 * tid + 1]) + (PC[512 + 2 * tid] + PC[512 + 2 * tid + 1]) + (PC[1024 + 2 * tid] + PC[1024 + 2 * tid + 1]) + (PC[1536 + 2 * tid] + PC[1536 + 2 * tid + 1]);
        { const int d = tid & 63, nq = tid >> 6; float acc[4] = {0.f, 0.f, 0.f, 0.f};
#pragma unroll 4
            for (int n = nq * 64; n < nq * 64 + 64; ++n) { const float vv = VC[(size_t)n * 64 + d];
#pragma unroll
                for (int g = 0; g < 4; ++g) acc[g] += PC[g * 512 + n] * vv; }
#pragma unroll
            for (int g = 0; g < 4; ++g) OCP[(nq * 4 + g) * 64 + d] = acc[g]; }
        __syncthreads();
        if (tid < 256) { const int g = tid >> 6, d = tid & 63;
#pragma unroll
            for (int nq = 0; nq < 8; ++nq) ocmp += OCP[(nq * 4 + g) * 64 + d];
            const int j = tid;
            if (j >= 1 && j <= 254) { const float v = IMPS[j]; int rank = 0;
                for (int jp = 1; jp <= 254; ++jp) { const float ov = IMPS[jp]; rank += (ov > v || (ov == v && jp < j)) ? 1 : 0; }
                if (rank < 13) SELB[rank] = j; }
            if (tid == 0) { SELB[13] = 0; SELB[14] = 255; SELB[15] = 256; }
        }
        __syncthreads();
    }
    float osel;
    {
        float M[4] = {NEG_BIG, NEG_BIG, NEG_BIG, NEG_BIG}, L[4] = {0.f, 0.f, 0.f, 0.f}, O[4] = {0.f, 0.f, 0.f, 0.f};
        const int* pt = (const int*)C.inp(4) + b * 128;
        for (int bi = 0; bi < 2; ++bi) {
            const int jb = __builtin_amdgcn_readfirstlane(SELB[2 * wave + bi]);
            if (jb < 256) { const int pid = pt[jb >> 1];
                const float* base = C.inp(3) + ((size_t)(l * NPOOL + pid) * 128 + (jb & 1) * 64) * 512;
                samp_block([&](int r) { return base + (size_t)r * 512; }, 64, kvh, QS, PW + wave * 256, lane, M, L, O);
            } else { const float* base = C.out + O_SEL_S + ((size_t)l * NTS + b * 4) * 512;
                samp_block([&](int r) { return base + (size_t)r * 512; }, t + 1, kvh, QS, PW + wave * 256, lane, M, L, O); }
        }
        osel = samp_combine(WST, tid, lane, wave, M, L, O);
    }
    float owin;
    {
        float M[4] = {NEG_BIG, NEG_BIG, NEG_BIG, NEG_BIG}, L[4] = {0.f, 0.f, 0.f, 0.f}, O[4] = {0.f, 0.f, 0.f, 0.f};
        const float* pre = C.inp(5) + (size_t)(l * 8 + b) * 262144;
        const float* nw = C.out + O_WIN_S + ((size_t)(l * 8 + b) * 512 + 508) * 512;
        samp_block([&](int r) { const int p = t + 1 + 64 * wave + r; return p <= 511 ? pre + (size_t)p * 512 : nw + (size_t)(p - 512) * 512; }, 64, kvh, QS, PW + wave * 256, lane, M, L, O);
        owin = samp_combine(WST, tid, lane, wave, M, L, O);
    }
    if (tid < 256) { const int g = tid >> 6, d = tid & 63, head = kvh * 4 + g;
        const float g0 = sigmoidf_(bf2f(P[m * PLD + GL_OFF + head * 3 + 0])), g1 = sigmoidf_(bf2f(P[m * PLD + GL_OFF + head * 3 + 1])), g2 = sigmoidf_(bf2f(P[m * PLD + GL_OFF + head * 3 + 2]));
        const float o = g0 * ocmp + g1 * osel + g2 * owin;
        wsp<bf16>(C, WS_MIX)[m * DM + 1024 + head * 64 + d] = (unsigned short)(pk2(o, 0.f) & 0xffffu); }
}

#ifndef C_MASK
#define C_MASK 7
#endif
constexpr int PC_SCAN_P = 128, PC_ATT_P = 512, PC_ATT_S = 128, PC_SCAN_S = 128, PC_ITEMS = PC_SCAN_P + PC_ATT_P + PC_ATT_S + PC_SCAN_S;
DI void phase_c(const Ctx& C0, int lq, int cmask = 7) {
    const int l = lq & 1;
    LAS int* slot = (LAS int*)(C0.lds + MISC_OFF + 64);
    for (;;) {
        __syncthreads();
        if (C0.tid == 0) *slot = (int)atomicAdd(C0.ctl + CW_QUEUE + 64 * lq, 1u);
        __syncthreads();
        int it = *slot;
        if (it >= PC_ITEMS) {
            if (lq != 0 || it - PC_ITEMS >= DEF_GROUPS) break;
            Ctx K = C0; { K.ws = launder_g(K.ws); K.out = launder_g(K.out); int t_ = K.tid; asm volatile("" : "+v"(t_)); K.tid = t_; K.lane = t_ & 63; K.wave = __builtin_amdgcn_readfirstlane(t_ >> 6); }
            for (int e = 0; e < 4; ++e) deferred_item(K, (it - PC_ITEMS) * 4 + e);
            continue;
        }
        Ctx K = C0; { K.ws = launder_g(K.ws); K.out = launder_g(K.out); int t_ = K.tid; asm volatile("" : "+v"(t_)); K.tid = t_; K.lane = t_ & 63; K.wave = __builtin_amdgcn_readfirstlane(t_ >> 6); }
        const Ctx& C = K;
        if (it >= PC_SCAN_P && it < PC_SCAN_P + PC_ATT_S) it += PC_ATT_P; else if (it >= PC_SCAN_P + PC_ATT_S && it < PC_SCAN_P + PC_ATT_S + PC_ATT_P) it -= PC_ATT_S;
        if (it < PC_SCAN_P || it >= PC_SCAN_P + PC_ATT_P + PC_ATT_S) {
            int row0, T, h; const float* S0; float* So;
            int cmode = 0;
            if (it < PC_SCAN_P) { const int u = it & 63, b = u >> 4; cmode = it < 64 ? 1 : 0; h = u & 15; row0 = b * 2048; T = 2048; S0 = nullptr; So = C.out + O_RW_P + ((size_t)(l * 4 + b) * 16 + h) * 4096; }
            else { const int u = it - (PC_SCAN_P + PC_ATT_P + PC_ATT_S), b = u >> 4; h = u & 15; row0 = NTP + b * 4; T = 4; S0 = C.inp(6) + ((size_t)(l * 8 + b) * 16 + h) * 4096; So = C.out + O_RW_S + ((size_t)(l * 8 + b) * 16 + h) * 4096; }
            if (cmask & 1) { if (S0) scan_head(C, l, row0, T, h, S0, So); else if (cmode) chunk_head<1>(C, l, row0 >> 11, h, So, cmode); else chunk_head<0>(C, l, row0 >> 11, h, So, 0); }
        } else if (it < PC_SCAN_P + PC_ATT_P) {
            const int u = it - PC_SCAN_P, qt = 31 - (u >> 4), bk = u & 15;
            if (cmask & 2) nsa_prompt_unit(C, l, bk >> 2, bk & 3, qt, (cmask & 8) != 0, (cmask & 16) != 0);
        } else {
            const int u = it - (PC_SCAN_P + PC_ATT_P);
            if (cmask & 4) nsa_sample_item(C, l, u >> 4, (u >> 2) & 3, u & 3);
        }
    }
    __syncthreads();
}

DI const float* xin_row(const Ctx& C, int l, size_t m) {
    if (l == 0) return m < (size_t)NTP ? C.inp(0) + m * DM : C.inp(1) + (m - NTP) * DM;
    return wsp<float>(C, WS_XF1) + m * DM;
}
DI void phase_e(const Ctx& C, int l) {
    const int lane = C.lane;
    const bf16* H = wsp<bf16>(C, WS_HS);
    bf16* X1B = wsp<bf16>(C, WS_X1B); const bf16* XB = wsp<bf16>(C, WS_XB);
    const float* gw = C.inp(22) + (size_t)l * DM; const float* bw = C.inp(23) + (size_t)l * DM;
    for (int m = blockIdx.x * NWAVES + C.wave; m < NT; m += C.G * NWAVES) {
        const v2u* hr = (const v2u*)(H + (size_t)m * DM) + lane;
        f32x4 v[8]; float s = 0.f;
        if (l == 0) { const f32x4* xr = (const f32x4*)xin_row(C, l, m) + lane;
#pragma unroll
            for (int j = 0; j < 8; ++j) { const v2u hb = hr[64 * j]; v[j] = xr[64 * j] * DN_ALPHA + (f32x4){bflo(hb.x), bfhi(hb.x), bflo(hb.y), bfhi(hb.y)}; }
        } else { const v2u* xr = (const v2u*)(XB + (size_t)m * DM) + lane;
#pragma unroll
            for (int j = 0; j < 8; ++j) { const v2u hb = hr[64 * j], xb = xr[64 * j]; v[j] = (f32x4){bflo(xb.x), bfhi(xb.x), bflo(xb.y), bfhi(xb.y)} * DN_ALPHA + (f32x4){bflo(hb.x), bfhi(hb.x), bflo(hb.y), bfhi(hb.y)}; } }
#pragma unroll
        for (int j = 0; j < 8; ++j) s += (v[j][0] + v[j][1]) + (v[j][2] + v[j][3]);
        const float mean = wave_sum(s) * (1.f / DM); float s2 = 0.f;
#pragma unroll
        for (int j = 0; j < 8; ++j) { v[j] = v[j] - mean; s2 += (v[j][0] * v[j][0] + v[j][1] * v[j][1]) + (v[j][2] * v[j][2] + v[j][3] * v[j][3]); }
        const float rstd = 1.f / sqrtf(wave_sum(s2) * (1.f / DM) + LN_EPS);
        float am = 0.f;
#pragma unroll
        for (int j = 0; j < 8; ++j) { const f32x4 gg = ((const f32x4*)gw)[lane + 64 * j], bb = ((const f32x4*)bw)[lane + 64 * j];
            const f32x4 o = v[j] * rstd * gg + bb; v[j] = o;
            am = fmaxf(am, fmaxf(fmaxf(fabsf(o[0]), fabsf(o[1])), fmaxf(fabsf(o[2]), fabsf(o[3]))));
            v2u p; p.x = pk2(o[0], o[1]); p.y = pk2(o[2], o[3]); ((v2u*)(X1B + (size_t)m * DM))[lane + 64 * j] = p; }
        am = wave_max(am);
        const float qs = am > 0.f ? am * (1.f / 127.f) : 1.f, qi = 1.f / qs;
#pragma unroll
        for (int j = 0; j < 8; ++j) { const f32x4 x = v[j] * qi;
            ((unsigned*)(C.ws + WS_X1Q + (size_t)m * DM))[lane + 64 * j] = ((unsigned)(int)__builtin_rintf(x[0]) & 255u) | (((unsigned)(int)__builtin_rintf(x[1]) & 255u) << 8) | (((unsigned)(int)__builtin_rintf(x[2]) & 255u) << 16) | ((unsigned)(int)__builtin_rintf(x[3]) << 24); }
        if (lane == 0) wsp<float>(C, WS_XQS)[m] = qs;
    }
}

DI float gelu_erf(float x) { return 0.5f * x * (1.f + erff(x * 0.70710678118654752f)); }
DI unsigned fkey(float f) { const unsigned u = __builtin_bit_cast(unsigned, f); return u ^ ((unsigned)((int)u >> 31) | 0x80000000u); }
DI int mbcnt64(unsigned long long m) { return __builtin_amdgcn_mbcnt_hi((unsigned)(m >> 32), __builtin_amdgcn_mbcnt_lo((unsigned)m, 0)); }
template <int NV, bool LANE_MAJOR> DI void top16(const unsigned (&key)[NV], bool (&sel)[NV], int (&pos)[NV]) {
    unsigned thr = 0u; bool exact = false;
    for (int bit = 31; bit >= 0; --bit) {
        const unsigned cand = thr | (1u << bit);
        int cnt = 0;
#pragma unroll
        for (int v = 0; v < NV; ++v) cnt += __builtin_popcountll(__ballot(key[v] >= cand));
        if (cnt >= 16) { thr = cand; if (cnt == 16) { exact = true; break; } }
    }
    unsigned long long sm[NV];
    if (exact) {
#pragma unroll
        for (int v = 0; v < NV; ++v) { sel[v] = key[v] >= thr; sm[v] = __ballot(sel[v]); }
    } else {
        unsigned long long eq[NV]; int ngt = 0;
#pragma unroll
        for (int v = 0; v < NV; ++v) { ngt += __builtin_popcountll(__ballot(key[v] > thr)); eq[v] = __ballot(key[v] == thr); }
        const int need = 16 - ngt;
#pragma unroll
        for (int v = 0; v < NV; ++v) { int rk;
            if (LANE_MAJOR) { rk = 0;
#pragma unroll
                for (int w = 0; w < NV; ++w) { rk += mbcnt64(eq[w]); if (w < v) rk += (int)((eq[w] >> (threadIdx.x & 63)) & 1ull); } }
            else { rk = mbcnt64(eq[v]);
#pragma unroll
                for (int w = 0; w < NV; ++w) if (w < v) rk += __builtin_popcountll(eq[w]); }
            sel[v] = key[v] > thr || (key[v] == thr && rk < need); sm[v] = __ballot(sel[v]); }
    }
    int base = 0;
#pragma unroll
    for (int v = 0; v < NV; ++v) { pos[v] = base + mbcnt64(sm[v]); base += __builtin_popcountll(sm[v]); }
}
typedef float f32x2v __attribute__((ext_vector_type(2)));
typedef int v4i __attribute__((ext_vector_type(4)));
typedef int v2i __attribute__((ext_vector_type(2)));
constexpr int PS_NSL = 16, PS_TOKG = 64, PS_NGRP = (NT + PS_TOKG - 1) / PS_TOKG;
static_assert(NT % 8 == 0, "a wave's 8 tokens of a group are all valid or all invalid");
template <int NP, int NV> DI void top16_search(const unsigned (&key)[NP][NV], unsigned (&thr)[NP], bool (&ex)[NP]) {
    int c16[NP];
#pragma unroll
    for (int p = 0; p < NP; ++p) { thr[p] = 0u; c16[p] = 64 * NV; }
    for (unsigned bm = 0x80000000u; bm != 0u; bm >>= 1) {
        unsigned cand[NP]; unsigned long long bl[NP][NV]; int cnt[NP];
#pragma unroll
        for (int p = 0; p < NP; ++p) cand[p] = thr[p] | bm;
#pragma unroll
        for (int p = 0; p < NP; ++p)
#pragma unroll
            for (int v = 0; v < NV; ++v) bl[p][v] = __ballot(key[p][v] >= cand[p]);
#pragma unroll
        for (int p = 0; p < NP; ++p) { cnt[p] = 0;
#pragma unroll
            for (int v = 0; v < NV; ++v) cnt[p] += __builtin_popcountll(bl[p][v]); }
        int diff = 0;
#pragma unroll
        for (int p = 0; p < NP; ++p) { const bool ge = cnt[p] >= 16; thr[p] = ge ? cand[p] : thr[p]; c16[p] = ge ? cnt[p] : c16[p]; diff |= c16[p] ^ 16; }
        if (diff == 0) break;
    }
#pragma unroll
    for (int p = 0; p < NP; ++p) ex[p] = c16[p] == 16;
}
template <int NV, bool LANE_MAJOR> DI void top16_finish(const unsigned (&key)[NV], unsigned thr, bool exact, bool (&sel)[NV], int (&pos)[NV]) {
    unsigned long long sm[NV];
    if (exact) {
#pragma unroll
        for (int v = 0; v < NV; ++v) { sel[v] = key[v] >= thr; sm[v] = __ballot(sel[v]); }
    } else {
        unsigned long long eq[NV]; int ngt = 0;
#pragma unroll
        for (int v = 0; v < NV; ++v) { ngt += __builtin_popcountll(__ballot(key[v] > thr)); eq[v] = __ballot(key[v] == thr); }
        const int need = 16 - ngt;
#pragma unroll
        for (int v = 0; v < NV; ++v) { int rk;
            if (LANE_MAJOR) { rk = 0;
#pragma unroll
                for (int w = 0; w < NV; ++w) { rk += mbcnt64(eq[w]); if (w < v) rk += (int)((eq[w] >> (threadIdx.x & 63)) & 1ull); } }
            else { rk = mbcnt64(eq[v]);
#pragma unroll
                for (int w = 0; w < NV; ++w) if (w < v) rk += __builtin_popcountll(eq[w]); }
            sel[v] = key[v] > thr || (key[v] == thr && rk < need); sm[v] = __ballot(sel[v]); }
    }
    int base = 0;
#pragma unroll
    for (int v = 0; v < NV; ++v) { pos[v] = base + mbcnt64(sm[v]); base += __builtin_popcountll(sm[v]); }
}
DI float row_max16(float v) { v = fmaxf(v, dppf<0xB1>(v)); v = fmaxf(v, dppf<0x4E>(v)); v = fmaxf(v, dppf<0x141>(v)); return fmaxf(v, dppf<0x140>(v)); }
DI float row_sum16(float v) { v += dppf<0xB1>(v); v += dppf<0x4E>(v); v += dppf<0x141>(v); return v + dppf<0x140>(v); }
template <int CTRL, bool BC> DI int dppi(int v) { return __builtin_amdgcn_update_dpp(0, v, CTRL, 0xF, 0xF, BC); }
DI int row_sum16i(int v) { v += dppi<0xB1, false>(v); v += dppi<0x4E, false>(v); v += dppi<0x141, false>(v); v += dppi<0x140, false>(v); return v; }
DI int row_scan16i(int v) { v += dppi<0x111, true>(v); v += dppi<0x112, true>(v); v += dppi<0x114, true>(v); v += dppi<0x118, true>(v); return v; }
DI unsigned row_max16u(unsigned v) { v = max(v, (unsigned)dppi<0xB1, false>((int)v)); v = max(v, (unsigned)dppi<0x4E, false>((int)v)); v = max(v, (unsigned)dppi<0x141, false>((int)v)); return max(v, (unsigned)dppi<0x140, false>((int)v)); }
DI unsigned row_min16u(unsigned v) { v = min(v, (unsigned)dppi<0xB1, false>((int)v)); v = min(v, (unsigned)dppi<0x4E, false>((int)v)); v = min(v, (unsigned)dppi<0x141, false>((int)v)); return min(v, (unsigned)dppi<0x140, false>((int)v)); }
template <int NK> DI unsigned row_top16_search(unsigned (&key)[NK]) {
    unsigned lm = key[0];
#pragma unroll
    for (int j = 1; j < NK; ++j) lm = max(lm, key[j]);
    const unsigned kmax = row_max16u(lm), L = row_min16u(lm), sp1 = kmax - L + 1u;
    const unsigned spw = max(max((unsigned)__builtin_amdgcn_readlane((int)sp1, 0), (unsigned)__builtin_amdgcn_readlane((int)sp1, 16)), max((unsigned)__builtin_amdgcn_readlane((int)sp1, 32), (unsigned)__builtin_amdgcn_readlane((int)sp1, 48)));
    const int B = spw == 0u ? 32 : 32 - __builtin_clz(spw);
    const unsigned M = B == 32 ? 0xFFFFFFFFu : (1u << B) - 1u, off = kmax - M, lo = L - 1u;
#pragma unroll
    for (int j = 0; j < NK; ++j) key[j] = max(key[j], lo) - off;
    unsigned thr = 0u; int c16 = 16 * NK;
    for (unsigned bm = 1u << (B - 1); bm != 0u; bm >>= 1) {
        const unsigned cand = thr | bm; int cnt = 0;
#pragma unroll
        for (int j = 0; j < NK; ++j) cnt += key[j] >= cand ? 1 : 0;
        cnt = row_sum16i(cnt);
        const bool ge = cnt >= 16; thr = ge ? cand : thr; c16 = ge ? cnt : c16;
        if (__ballot(c16 != 16) == 0ull) break;
    }
    return thr;
}
template <int NK> DI void row_top16_place(const unsigned (&key)[NK], unsigned thr, int (&pos)[NK]) {
    int cg = 0, ce = 0;
#pragma unroll
    for (int j = 0; j < NK; ++j) { cg += key[j] > thr ? 1 : 0; ce += key[j] == thr ? 1 : 0; }
    const int pk = cg | (ce << 8);
    const int exc = row_scan16i(pk) - pk, tot = row_sum16i(pk);
    int pg_ = exc & 255, pe_ = (tot & 255) + (exc >> 8);
#pragma unroll
    for (int j = 0; j < NK; ++j) { const bool g = key[j] > thr, e = key[j] == thr; pos[j] = g ? pg_ : (e ? pe_ : 16); pg_ += g ? 1 : 0; pe_ += e ? 1 : 0; }
}
DI void peer_topk(const Ctx& C, int l) {
    const int lane = C.lane, wave = C.wave, n = lane & 15, r = lane >> 4;
    LAS float* WL = (LAS float*)(C.lds + 65536 + 256 + wave * 2048 + r * 384);
    LAS int* WLi = (LAS int*)WL;
    const float* Sc = wsp<float>(C, WS_HS);
    unsigned short* EL = wsp<unsigned short>(C, WS_EL); float* GT = wsp<float>(C, WS_GT);
    static_assert(NT % 4 == 0, "token quads");
    for (int m = 4 * blockIdx.x; m < NT; m += 4 * C.G) {
        const float* sr = Sc + (size_t)(m + r) * DM + wave * 256 + 8 * n;
        f32x4 sv[2][2];
#pragma unroll
        for (int c = 0; c < 2; ++c) { sv[c][0] = *(const f32x4*)(sr + 128 * c); sv[c][1] = *(const f32x4*)(sr + 128 * c + 4); }
#pragma unroll
        for (int c = 0; c < 2; ++c) {
            unsigned key[8]; int pos[8];
#pragma unroll
            for (int j = 0; j < 8; ++j) key[j] = fkey(sv[c][j >> 2][j & 3]);
            const unsigned thr = row_top16_search<8>(key);
            row_top16_place<8>(key, thr, pos);
#pragma unroll
            for (int j = 0; j < 8; ++j) if (pos[j] < 16) { WL[32 * c + pos[j]] = sv[c][j >> 2][j & 3]; WLi[32 * c + 16 + pos[j]] = 8 * n + j; }
        }
        LDS_WAIT(); asm volatile("" ::: "memory");
        {
            const float x0 = WL[n]; const int e0 = WLi[16 + n] * 128;
            float cd[16]; unsigned key[16]; int pos[16];
#pragma unroll
            for (int q = 0; q < 4; ++q) { const f32x4 x1 = *(const LAS f32x4*)(WL + 32 + 4 * q);
#pragma unroll
                for (int e = 0; e < 4; ++e) { cd[4 * q + e] = x0 + x1[e]; key[4 * q + e] = fkey(cd[4 * q + e]); } }
            const unsigned thr = row_top16_search<16>(key);
            row_top16_place<16>(key, thr, pos);
#pragma unroll
            for (int b = 0; b < 16; ++b) if (pos[b] < 16) { WL[64 + pos[b]] = cd[b]; WLi[80 + pos[b]] = e0 + WLi[48 + b]; }
        }
        LDS_WAIT(); asm volatile("" ::: "memory");
        { const float tv = WL[64 + n];
          const float ev = expf(tv - row_max16(tv));
          const float gate = ev / row_sum16(ev);
          EL[(size_t)(m + r) * 128 + wave * 16 + n] = (unsigned short)WLi[80 + n]; GT[(size_t)(m + r) * 128 + wave * 16 + n] = gate; }
        LDS_WAIT(); asm volatile("" ::: "memory");
    }
}
template <int SIDE> DI void peer_sliced(const Ctx& C, int l, int lq) {
    const int tid = C.tid, lane = C.lane, wave = C.wave, pg = lane >> 3, dq = lane & 7;
    LAS int* slot = (LAS int*)(C.lds + MISC_OFF + 64);
    const unsigned char* TAB = C.ws + (SIDE ? WS_VB : WS_UB) + (size_t)l * NEXP * DM;
    const unsigned char* X1Q = C.ws + WS_X1Q;
    const unsigned short* EL = wsp<unsigned short>(C, WS_EL); const float* WP = wsp<float>(C, WS_WP);
    float* PD = wsp<float>(C, WS_PD); float* FO = wsp<float>(C, WS_FO);
    unsigned* const Q0 = C.ctl + CW_SQ + 64 * ((lq * 2 + SIDE) * 16);
    const int s_first = (int)((2u * xb_xcc_id()) & (PS_NSL - 1));
    int k = 0;
    for (;;) {
        __syncthreads();
        if (tid == 0) { int got = -1;
            while (k < PS_NSL) { const int s = (s_first + k) & (PS_NSL - 1); const unsigned g = atomicAdd(Q0 + 64 * s, 1u); if (g < (unsigned)PS_NGRP) { got = (s << 16) | (int)g; break; } ++k; }
            *slot = got; }
        __syncthreads();
        const int d = __builtin_amdgcn_readfirstlane(*slot);
        if (d < 0) break;
        const int s = d >> 16, g = d & 0xffff;
        const int t0 = g * PS_TOKG + wave * 8;
        if (t0 >= NT) continue;
        const unsigned char* TS = TAB + (size_t)s * NEXP * 128;
        const unsigned dq16 = (unsigned)dq * 16u;
        v4u E[2][2]; v4u R[2][16]; f32x4 A[2][4]; v4u AQ[2];
        LAS unsigned char* const WB = C.lds + wave * 4352;
        const int wofs = pg * 512 + dq * 64, rofs = (lane >> 3) * 64 + 16 * (((lane & 7) >> 1) ^ ((lane >> 3) & 3)) + 8 * (lane & 1);
#define PS_LOAD_E(b, t) do { const v4u* ep_ = (const v4u*)(EL + (size_t)(t) * 128 + 16 * pg); E[b][0] = ep_[0]; E[b][1] = ep_[1]; } while (0)
#define PS_LOAD_R(b, t) do { \
            _Pragma("unroll") for (int i = 0; i < 16; ++i) { const unsigned w_ = E[b][i >> 3][(i >> 1) & 3]; const unsigned e_ = (i & 1) ? (w_ >> 16) : (w_ & 0xffffu); \
                R[b][i] = *(const v4u*)(TS + ((e_ << 7) | dq16)); } \
            if (SIDE == 0) AQ[b] = *(const v4u*)(X1Q + (size_t)(t) * DM + 128 * s + 16 * dq); \
            else { const f32x4* ap_ = (const f32x4*)(WP + (size_t)(t) * 128 + 16 * pg); _Pragma("unroll") for (int q = 0; q < 4; ++q) A[b][q] = ap_[q]; } } while (0)
        PS_LOAD_E(0, t0); PS_LOAD_E(1, t0 + 1);
        PS_LOAD_R(0, t0);
#pragma unroll
        for (int j = 0; j < 8; ++j) {
            const int b = j & 1, t = t0 + j;
            if (j + 2 < 8) PS_LOAD_E(b, t + 2);
            if (j + 1 < 8) PS_LOAD_R(b ^ 1, t + 1);
            __builtin_amdgcn_sched_barrier(0);
            if (SIDE == 0) {
                int dd[16];
#pragma unroll
                for (int i = 0; i < 16; ++i) { int a = 0;
#pragma unroll
                    for (int q = 0; q < 4; ++q) a = __builtin_amdgcn_sdot4((int)R[b][i][q], (int)AQ[b][q], a, false);
                    dd[i] = a; }
#pragma unroll
                for (int q = 0; q < 4; ++q) *(LAS v4i*)(WB + dq * 528 + pg * 64 + 16 * q) = (v4i){dd[4 * q], dd[4 * q + 1], dd[4 * q + 2], dd[4 * q + 3]};
                v2i rs = {0, 0};
#pragma unroll
                for (int d8 = 0; d8 < 8; ++d8) rs += *(const LAS v2i*)(WB + 8 * lane + 528 * d8);
                *(f32x2v*)(PD + ((size_t)t * PS_NSL + s) * 128 + 2 * lane) = (f32x2v){(float)rs.x, (float)rs.y};
            } else {
                f32x2v acc[8];
#pragma unroll
                for (int q = 0; q < 8; ++q) acc[q] = (f32x2v){0.f, 0.f};
#pragma unroll
                for (int i = 0; i < 16; ++i) { const float w = A[b][i >> 2][i & 3]; const f32x2v w2 = {w, w};
#pragma unroll
                    for (int q = 0; q < 4; ++q) { const int wd = (int)R[b][i][q]; acc[2 * q] += w2 * __builtin_amdgcn_cvt_pk_f32_fp8(wd, false); acc[2 * q + 1] += w2 * __builtin_amdgcn_cvt_pk_f32_fp8(wd, true); } }
#pragma unroll
                for (int q = 0; q < 4; ++q) *(LAS f32x4*)(WB + wofs + 16 * (q ^ (dq & 3))) = (f32x4){acc[2 * q].x, acc[2 * q].y, acc[2 * q + 1].x, acc[2 * q + 1].y};
                f32x2v rs = {0.f, 0.f};
#pragma unroll
                for (int h8 = 0; h8 < 8; ++h8) rs += *(const LAS f32x2v*)(WB + rofs + 512 * h8);
                *(f32x2v*)(FO + (size_t)t * DM + 128 * s + 2 * lane) = rs;
            }
        }
#undef PS_LOAD_E
#undef PS_LOAD_R
    }
}
DI void peer_gelu(const Ctx& C, int l) {
    const unsigned short* EL = wsp<unsigned short>(C, WS_EL); const float* GT = wsp<float>(C, WS_GT); const float* PD = wsp<float>(C, WS_PD); float* WP = wsp<float>(C, WS_WP);
    const float* USC = wsp<float>(C, WS_USC) + (size_t)l * NEXP; const float* VSC = USC + 2 * NEXP; const float* XQS = wsp<float>(C, WS_XQS);
    for (int idx = blockIdx.x * NTHREADS + C.tid; idx < NT * 128; idx += C.G * NTHREADS) {
        const int t = idx >> 7, p = idx & 127; const unsigned e = EL[idx];
        float h = 0.f;
#pragma unroll
        for (int s = 0; s < PS_NSL; ++s) h += PD[((size_t)t * PS_NSL + s) * 128 + p];
        WP[idx] = GT[idx] * gelu_erf(h * USC[e] * XQS[t]) * VSC[e];
    }
}
DI void peer_ln2(const Ctx& C, int l) {
    const int lane = C.lane;
    const bf16* X1B = wsp<bf16>(C, WS_X1B); const float* FO = wsp<float>(C, WS_FO);
    const float* gw = C.inp(28) + (size_t)l * DM; const float* bw = C.inp(29) + (size_t)l * DM;
    for (int m = blockIdx.x * NWAVES + C.wave; m < NT; m += C.G * NWAVES) {
        const v2u* xr = (const v2u*)(X1B + (size_t)m * DM) + lane; const f32x4* fr = (const f32x4*)(FO + (size_t)m * DM) + lane;
        f32x4 v[8]; float s = 0.f;
#pragma unroll
        for (int j = 0; j < 8; ++j) { const v2u xb = xr[64 * j]; v[j] = (f32x4){bflo(xb.x), bfhi(xb.x), bflo(xb.y), bfhi(xb.y)} * DN_ALPHA + fr[64 * j]; s += (v[j][0] + v[j][1]) + (v[j][2] + v[j][3]); }
        const float mean = wave_sum(s) * (1.f / DM); float s2 = 0.f;
#pragma unroll
        for (int j = 0; j < 8; ++j) { v[j] = v[j] - mean; s2 += (v[j][0] * v[j][0] + v[j][1] * v[j][1]) + (v[j][2] * v[j][2] + v[j][3] * v[j][3]); }
        const float rstd = 1.f / sqrtf(wave_sum(s2) * (1.f / DM) + LN_EPS);
#pragma unroll
        for (int j = 0; j < 8; ++j) { const f32x4 gg = ((const f32x4*)gw)[lane + 64 * j], bb = ((const f32x4*)bw)[lane + 64 * j];
            const f32x4 o = v[j] * rstd * gg + bb;
            if (l == 0) {
                v2u p; p.x = pk2(o[0], o[1]); p.y = pk2(o[2], o[3]); ((v2u*)(wsp<bf16>(C, WS_XB) + (size_t)m * DM))[lane + 64 * j] = p; }
            else { float* dst = m < NTP ? C.out + O_YP + (size_t)m * DM : C.out + O_YS + (size_t)(m - NTP) * DM; ((f32x4*)dst)[lane + 64 * j] = o; } }
    }
}

#ifndef PH_MASK
#define PH_MASK 0xFF
#endif
#define IN(k) (lo <= (k) && (k) < hi)
#define EN(s) ((PH_MASK >> (s)) & 1)
#define FRESH(CX) Ctx CX = C; { CX.ws = launder_g(CX.ws); CX.out = launder_g(CX.out); int t_ = CX.tid; asm volatile("" : "+v"(t_)); CX.tid = t_; CX.lane = t_ & 63; CX.wave = __builtin_amdgcn_readfirstlane(t_ >> 6); CX.ctl = (unsigned*)(CX.ws + WS_CTL); }
#ifndef PROBE_REP
#define PROBE_REP 0
#endif
#ifndef PROBE_PMASK
#define PROBE_PMASK 31
#endif
#ifndef PROBE_CMASK
#define PROBE_CMASK 7
#endif
#define NREP(s) (((PROBE_REP >> (s)) & 1) ? 2 : 1)
#ifndef PROBE_G
#define PROBE_G 0
#endif
#define GREP(s) (((PROBE_G >> (s)) & 1) ? 2 : 1)
#define REPBAR(s, rep) do { if (NREP(s) == 2 && (rep) == 0 && (hi - lo) > 1) xcd_barrier(bar); } while (0)
#define SEAM(k) do { if (IN(k) && IN((k) + 1)) xcd_barrier(bar); } while (0)
template <int l> DI void run_layer(const Ctx& C, const XcdBarrier& bar, int lo, int hi) {
        const int pb = 1 + 11 * l;
        _Pragma("unroll") for (int rep = 0; rep < NREP(0); ++rep) if (EN(0) && IN(pb + 0)) {
            FRESH(K);
            pg8::Gemm g{wsp<bf16>(K, WS_XB), wsp<bf16>(K, WS_WIN) + (size_t)l * PLD * DM, NTP, PLD, DM}; pg8::StaticOrder S; S.init(NTP, PLD, K.G, (int)blockIdx.x);
            EpiInProj E{wsp<bf16>(K, WS_PROJ), K.out, l};
            pg8::gemm_phase<EpiInProj, pg8::StaticOrder, true, true>(K.lds, g, S, E);
            { bf16* P = wsp<bf16>(K, WS_PROJ); float* out = K.out;
              skinny_gemm(K, wsp<bf16>(K, WS_XB) + (size_t)NTP * DM, wsp<bf16>(K, WS_WIN) + (size_t)l * PLD * DM, (IN_COLS + 31) / 32, [&](int j, int col, float v) {
                  P[(size_t)(NTP + j) * PLD + col] = (unsigned short)(pk2(v, 0.f) & 0xffffu);
                  const int b = j >> 2, t = j & 3;
                  if (col < RW_COLS) { if (t == 3) out[O_SH_S + (size_t)(l * 8 + b) * RW_COLS + col] = v; }
                  else if (col >= KC_OFF && col < GL_OFF) { const int c = col - KC_OFF, reg = c >> 9, cc = c & 511;
                      if (reg == 0) out[O_CMP_S + ((size_t)l * NTS + j) * 512 + cc] = v; else if (reg == 1) out[O_SEL_S + ((size_t)l * NTS + j) * 512 + cc] = v;
                      else out[O_WIN_S + ((size_t)(l * 8 + b) * 512 + 508 + t) * 512 + cc] = v; } }); }
            REPBAR(0, rep);
        }
        SEAM(pb + 0);
        _Pragma("unroll") for (int rep = 0; rep < NREP(1); ++rep) if (EN(1) && IN(pb + 1)) { FRESH(K); phase_b(K, l, l + 2 * rep); REPBAR(1, rep); }
        SEAM(pb + 1);
        _Pragma("unroll") for (int rep = 0; rep < NREP(2); ++rep) if (EN(2) && IN(pb + 2)) { FRESH(K); phase_c(K, l + 2 * rep, rep == 0 ? 7 : PROBE_CMASK); REPBAR(2, rep); }
        SEAM(pb + 2);
        _Pragma("unroll") for (int rep = 0; rep < NREP(3); ++rep) if (EN(3) && IN(pb + 3)) {
            FRESH(K);
            pg8::Gemm g{wsp<bf16>(K, WS_MIX), wsp<bf16>(K, WS_WOUT) + (size_t)l * DM * DM, NTP, DM, DM}; pg8::StaticOrder S; S.init(NTP, DM, K.G, (int)blockIdx.x);
            EpiBf16Row E{wsp<bf16>(K, WS_HS), DM};
            pg8::gemm_phase<EpiBf16Row, pg8::StaticOrder, true, true>(K.lds, g, S, E);
            { bf16* H = wsp<bf16>(K, WS_HS) + (size_t)NTP * DM;
              skinny_gemm(K, wsp<bf16>(K, WS_MIX) + (size_t)NTP * DM, wsp<bf16>(K, WS_WOUT) + (size_t)l * DM * DM, DM / 32, [&](int j, int col, float v) { H[(size_t)j * DM + col] = (unsigned short)(pk2(v, 0.f) & 0xffffu); }); }
            REPBAR(3, rep);
        }
        SEAM(pb + 3);
        _Pragma("unroll") for (int rep = 0; rep < NREP(4); ++rep) if (EN(4) && IN(pb + 4)) { FRESH(K); phase_e(K, l); REPBAR(4, rep); }
        SEAM(pb + 4);
        _Pragma("unroll") for (int rep = 0; rep < NREP(5); ++rep) if (EN(5) && IN(pb + 5)) {
            FRESH(K);
            pg8::Gemm g{wsp<bf16>(K, WS_X1B), wsp<bf16>(K, WS_W2) + (size_t)l * DM * DM, NTP, DM, DM}; pg8::StaticOrder S; S.init(NTP, DM, K.G, (int)blockIdx.x);
            pg8::EpiF32 E{wsp<float>(K, WS_HS), DM, nullptr};
            pg8::gemm_phase<pg8::EpiF32, pg8::StaticOrder, true, true>(K.lds, g, S, E);
            { float* H = wsp<float>(K, WS_HS) + (size_t)NTP * DM;
              skinny_gemm(K, wsp<bf16>(K, WS_X1B) + (size_t)NTP * DM, wsp<bf16>(K, WS_W2) + (size_t)l * DM * DM, DM / 32, [&](int j, int col, float v) { H[(size_t)j * DM + col] = v; }); }
            REPBAR(5, rep);
        }
        SEAM(pb + 5);
        _Pragma("unroll") for (int rep = 0; rep < GREP(0); ++rep) { if (IN(pb + 6)) { FRESH(K); peer_topk(K, l); } if (GREP(0) == 2 && rep == 0) xcd_barrier(bar); }
        SEAM(pb + 6);
        _Pragma("unroll") for (int rep = 0; rep < GREP(1); ++rep) { if (IN(pb + 7)) { FRESH(K); peer_sliced<0>(K, l, l + 2 * rep); } if (GREP(1) == 2 && rep == 0) xcd_barrier(bar); }
        SEAM(pb + 7);
        _Pragma("unroll") for (int rep = 0; rep < GREP(2); ++rep) { if (IN(pb + 8)) { FRESH(K); peer_gelu(K, l); } if (GREP(2) == 2 && rep == 0) xcd_barrier(bar); }
        SEAM(pb + 8);
        _Pragma("unroll") for (int rep = 0; rep < GREP(3); ++rep) { if (IN(pb + 9)) { FRESH(K); peer_sliced<1>(K, l, l + 2 * rep); } if (GREP(3) == 2 && rep == 0) xcd_barrier(bar); }
        SEAM(pb + 9);
        _Pragma("unroll") for (int rep = 0; rep < GREP(4); ++rep) { if (IN(pb + 10)) { FRESH(K); peer_ln2(K, l); } if (GREP(4) == 2 && rep == 0) xcd_barrier(bar); }
        SEAM(pb + 10);
}
typedef ArgsK Args;
__global__ void __launch_bounds__(NTHREADS, 2) fwd_kernel(Args args) {
    extern __shared__ __attribute__((aligned(16))) unsigned char lds[];
    Ctx C;
    C.out = args.out; C.ws = args.ws; C.lds = (LAS unsigned char*)lds; C.ctl = (unsigned*)(args.ws + WS_CTL);
    C.tid = threadIdx.x; C.lane = C.tid & 63; C.wave = __builtin_amdgcn_readfirstlane(C.tid >> 6); C.G = gridDim.x;
    volatile LAS unsigned* MISC = (volatile LAS unsigned*)(C.lds + MISC_OFF);
    for (int u = C.tid; u < (LDS_BYTES - RING_BYTES) / 4; u += NTHREADS) ((LAS unsigned*)(C.lds + RING_BYTES))[u] = 0u;
    __syncthreads();
    XcdBarrier bar; bar.bar = C.ctl + CW_BAR; bar.x = 0; bar.st = nullptr;
    if (args.use_bar) bar = xcd_barrier_post(C.ctl + CW_BAR, MISC + 8);
    const int lo = args.ph_lo, hi = args.ph_hi;
#ifdef PROBE_DELAY_TICKS
    { const unsigned long long t0 = __builtin_amdgcn_s_memrealtime(); while (__builtin_amdgcn_s_memrealtime() - t0 < (unsigned long long)PROBE_DELAY_TICKS) __builtin_amdgcn_s_sleep(32); }
#endif
#ifdef PROBE_AMPLIFY
    { const unsigned long long t0 = __builtin_amdgcn_s_memrealtime(); xcd_barrier(bar);
      if (blockIdx.x == PROBE_AMPLIFY - 1) { const unsigned long long dt = __builtin_amdgcn_s_memrealtime() - t0; while (__builtin_amdgcn_s_memrealtime() - t0 < 5ull * dt) __builtin_amdgcn_s_sleep(32); } }
#endif
    _Pragma("unroll") for (int rep = 0; rep < NREP(7); ++rep) if (EN(7) && IN(0)) { FRESH(K); p0_prologue(K, NREP(7) == 1 ? 31 : (rep == 0 ? PROBE_PMASK : (31 & ~PROBE_PMASK))); REPBAR(7, rep); }
    SEAM(0);
    run_layer<0>(C, bar, lo, hi);
    run_layer<1>(C, bar, lo, hi);
#undef IN
#undef SEAM
}

#ifndef MK_ONE_LAUNCH
#define MK_ONE_LAUNCH 1
#endif
extern "C" void kernel_launch(void* const* d_in, const int* in_sizes, int n_in, void* d_out, int out_size, void* d_ws, size_t ws_size, hipStream_t stream) {
    static int grid = 0;
    if (grid == 0) {
        if (n_in != 30 || out_size != (int)O_END || ws_size < WS_END) { fprintf(stderr, "kernel_launch: unexpected shapes (n_in %d, out %d, ws %zu < %zu); nothing launched\n", n_in, out_size, ws_size, (size_t)WS_END); grid = -1; return; }
        int dev = 0, cus = 0, per_cu = 0;
        if (hipGetDevice(&dev) != hipSuccess || hipDeviceGetAttribute(&cus, hipDeviceAttributeMultiprocessorCount, dev) != hipSuccess) { grid = -1; return; }
        if (hipFuncSetAttribute((const void*)fwd_kernel, hipFuncAttributeMaxDynamicSharedMemorySize, LDS_BYTES) != hipSuccess) { fprintf(stderr, "kernel_launch: hipFuncSetAttribute failed\n"); grid = -1; return; }
        if (hipOccupancyMaxActiveBlocksPerMultiprocessor(&per_cu, (const void*)fwd_kernel, NTHREADS, LDS_BYTES) != hipSuccess || per_cu < 1) { fprintf(stderr, "kernel_launch: occupancy query says %d blocks per CU\n", per_cu); }
        (void)hipGetLastError();
        grid = cus;
    }
    if (grid < 0) return;
    if (hipMemsetAsync((char*)d_ws + WS_CTL, 0, CTL_ZERO_BYTES, stream) != hipSuccess) return;
    Args a{};
    for (int i = 0; i < 30; ++i) a.in[i] = (const float*)d_in[i];
    a.out = (float*)d_out; a.ws = (unsigned char*)d_ws;
#if MK_ONE_LAUNCH
    a.ph_lo = 0; a.ph_hi = N_PHASES; a.use_bar = 1;
    hipLaunchKernelGGL(fwd_kernel, dim3(grid), dim3(NTHREADS), LDS_BYTES, stream, a);
#else
    for (int p = 0; p < N_PHASES; ++p) { a.ph_lo = p; a.ph_hi = p + 1; a.use_bar = 0; hipLaunchKernelGGL(fwd_kernel, dim3(grid), dim3(NTHREADS), LDS_BYTES, stream, a); }
#endif
}
```

```cpp
#include <hip/hip_runtime.h>
#include <cstdio>
#include <cstdint>
namespace pg8 {
#define PG8_LAS __attribute__((address_space(3)))
typedef unsigned short bf16_t;
typedef short bf16x8 __attribute__((ext_vector_type(8)));
typedef float f32x4 __attribute__((ext_vector_type(4)));
typedef unsigned u32x4 __attribute__((ext_vector_type(4)));
constexpr int BM = 256, BK = 64, HALF = 128, HTB = HALF * BK * 2  , STAGE_BYTES = 8 * HTB, NXCD = 8, WGM = 8;

__host__ __device__ __forceinline__ int lds_byte(int r, int c) { const int st = (r >> 4) * 2 + (c >> 5), rr = r & 15, cc = c & 31, ob = rr * 64 + cc * 2; return st * 1024 + (ob ^ (((ob >> 9) & 1) << 5)); }
__host__ __device__ __forceinline__ void stage_rc(int b, int& R, int& C) { const int st = b / 1024, sb = b % 1024, swz = sb ^ (((sb >> 9) & 1) << 5); R = (st >> 1) * 16 + swz / 64; C = (st & 1) * 32 + (swz % 64) / 2; }
__host__ __device__ __forceinline__ int perm32(int rho) { const int n = rho >> 4, i = rho & 15; return 8 * (i >> 2) + 4 * n + (i & 3); }

struct Unit { int pm, pn; };
struct Gemm { const bf16_t* A; const bf16_t* Bt; int M, N, K; };

struct StaticOrder {
    int nM, nN, nwg, G, c;
    __host__ __device__ void init(int M, int N, int G_, int c_) { nM = M / BM; nN = N / BM; nwg = nM * nN; G = G_; c = c_; }
    __host__ __device__ bool next(int i, Unit& u) const {
        const long L = (long)i * G + c; if (L >= nwg) return false;
        int wgid = (int)L; { const int q = nwg / NXCD, r = nwg % NXCD, xcd = wgid % NXCD, off = wgid / NXCD; wgid = (xcd < r ? xcd * (q + 1) : r * (q + 1) + (xcd - r) * q) + off; }
        const int nig = WGM * nN, gid = wgid / nig, fm = gid * WGM, gsz = (nM - fm) < WGM ? (nM - fm) : WGM;
        u.pm = fm + ((wgid % nig) % gsz); u.pn = (wgid % nig) / gsz; return true;
    }
    __device__ __forceinline__ void a_ready(const Unit&) const {}
    __device__ __forceinline__ void done(const Unit&) const {}
};

__device__ __forceinline__ unsigned cvt_pk_bf16(float lo, float hi) { unsigned r; asm volatile("v_cvt_pk_bf16_f32 %0, %1, %2" : "=v"(r) : "v"(lo), "v"(hi)); return r; }
typedef float f32x2 __attribute__((ext_vector_type(2)));
struct EpiF32 {
    static constexpr bool PERM = false, AFTER_DRAIN = false;
    float* C; int ldc; const float* bias;
    __device__ __forceinline__ void operator()(const f32x4 (&acc)[2][2][4][2], const Unit& u, int wr, int wc, int fr, int fq) const {
        const int row0 = u.pm * BM + wr * 64 + fr, col0 = u.pn * BM + wc * 32 + 4 * fq;
        f32x4 bv[2][2];
#pragma unroll
        for (int bj = 0; bj < 2; ++bj)
#pragma unroll
            for (int n = 0; n < 2; ++n) bv[bj][n] = bias ? *(const f32x4*)(bias + col0 + bj * HALF + n * 16) : (f32x4){0.f, 0.f, 0.f, 0.f};
#pragma unroll
        for (int ai = 0; ai < 2; ++ai)
#pragma unroll
            for (int m = 0; m < 4; ++m) { float* rowp = C + (size_t)(row0 + ai * HALF + m * 16) * ldc + col0;
#pragma unroll
                for (int bj = 0; bj < 2; ++bj)
#pragma unroll
                    for (int n = 0; n < 2; ++n) *(f32x4*)(rowp + bj * HALF + n * 16) = acc[ai][bj][m][n] + bv[bj][n]; }
    }
};
template <class Epi, class Sched, bool ALIGN_EPI = false, bool SP2 = false>
__device__ __forceinline__ void gemm_phase(PG8_LAS unsigned char* lds, const Gemm g, const Sched& S, const Epi& E) {
    const int tid = threadIdx.x, wid = __builtin_amdgcn_readfirstlane(tid >> 6), lane = tid & 63, wr = wid >> 2, wc = wid & 3, fr = lane & 15, fq = lane >> 4;
    const int K = g.K, nt = K / BK;
    unsigned voffA[2], voffB[2];
#pragma unroll
    for (int i = 0; i < 2; ++i) { int R, C; stage_rc(tid * 16 + i * 8192, R, C); const int Rb = Epi::PERM ? ((R & ~31) + perm32(R & 31)) : R;
        voffA[i] = (unsigned)(R * K + C) * 2u; voffB[i] = (unsigned)(Rb * K + C) * 2u; }
    const size_t kstep = (size_t)(BK * 2);
    const size_t hstep = (size_t)HALF * K * 2;
    const size_t tstep = 2 * hstep;
    const unsigned ldsw = (unsigned)wid * 1024u;
    const int aoff = lds_byte(wr * 64 + fr, fq * 8), boff = lds_byte(wc * 32 + fr, fq * 8);
#define PG8_SA(b, h) (((b) * 2 + (h)) * HTB)
#define PG8_SB(b, h) ((4 + (b) * 2 + (h)) * HTB)
#define PG8_STAGE(bufoff, gbase, voff) do { _Pragma("unroll") for (int _i = 0; _i < 2; ++_i) \
        __builtin_amdgcn_global_load_lds((const unsigned*)((const char*)(gbase) + (voff)[_i]), (PG8_LAS unsigned*)(lds + (bufoff) + ldsw + _i * 8192), 16, 0, 0); } while (0)
#define PG8_LDA(dst, b, h) do { _Pragma("unroll") for (int m = 0; m < 4; ++m) _Pragma("unroll") for (int k = 0; k < 2; ++k) dst[m][k] = *(const PG8_LAS bf16x8*)(lds + PG8_SA(b, h) + aoff + m * 2048 + k * 1024); } while (0)
#define PG8_LDB(dst, b, h) do { _Pragma("unroll") for (int n = 0; n < 2; ++n) _Pragma("unroll") for (int k = 0; k < 2; ++k) dst[n][k] = *(const PG8_LAS bf16x8*)(lds + PG8_SB(b, h) + boff + n * 2048 + k * 1024); } while (0)
#define PG8_MMA(ai, bj, At, Bt) do { __builtin_amdgcn_s_setprio(1); _Pragma("unroll") for (int m = 0; m < 4; ++m) _Pragma("unroll") for (int n = 0; n < 2; ++n) _Pragma("unroll") for (int k = 0; k < 2; ++k) \
        acc[ai][bj][m][n] = __builtin_amdgcn_mfma_f32_16x16x32_bf16(Bt[n][k], At[m][k], acc[ai][bj][m][n], 0, 0, 0); __builtin_amdgcn_s_setprio(0); } while (0)
#define PG8_WAIT_V(n) asm volatile("s_waitcnt vmcnt(" #n ")" ::: "memory")
#define PG8_WAIT_L(n) asm volatile("s_waitcnt lgkmcnt(" #n ")" ::: "memory")
#define PG8_BAR __builtin_amdgcn_s_barrier()
#define PG8_SCHED __builtin_amdgcn_sched_barrier(0)
    Unit cur, nxt; int ui = 0;
    if (!S.next(0, cur)) return;
    f32x4 acc[2][2][4][2];
#pragma unroll
    for (int a = 0; a < 2; ++a)
#pragma unroll
        for (int b = 0; b < 2; ++b)
#pragma unroll
            for (int m = 0; m < 4; ++m)
#pragma unroll
                for (int n = 0; n < 2; ++n) acc[a][b][m][n] = (f32x4){0.f, 0.f, 0.f, 0.f};
    bf16x8 At[4][2], B0[2][2], B1[2][2];
    const char* cA = (const char*)g.A + (size_t)cur.pm * tstep; const char* cB = (const char*)g.Bt + (size_t)cur.pn * tstep;
    S.a_ready(cur);
    if constexpr (SP2) {
        PG8_STAGE(PG8_SB(0, 0), cB, voffB); PG8_STAGE(PG8_SB(0, 1), cB + hstep, voffB); PG8_STAGE(PG8_SA(0, 0), cA, voffA); PG8_STAGE(PG8_SA(0, 1), cA + hstep, voffA);
        if (wr == 1) PG8_BAR;
        PG8_WAIT_V(2); PG8_BAR;
        PG8_STAGE(PG8_SB(1, 0), cB + kstep, voffB); PG8_STAGE(PG8_SA(1, 0), cA + kstep, voffA); PG8_STAGE(PG8_SB(1, 1), cB + hstep + kstep, voffB);
        PG8_WAIT_V(6); PG8_BAR;
    } else {
        PG8_STAGE(PG8_SB(0, 0), cB, voffB); PG8_STAGE(PG8_SA(0, 0), cA, voffA); PG8_STAGE(PG8_SB(0, 1), cB + hstep, voffB); PG8_STAGE(PG8_SA(0, 1), cA + hstep, voffA);
        if (wr == 1) PG8_BAR;
        PG8_WAIT_V(4); PG8_BAR;
        PG8_STAGE(PG8_SB(1, 0), cB + kstep, voffB); PG8_STAGE(PG8_SA(1, 0), cA + kstep, voffA); PG8_STAGE(PG8_SB(1, 1), cB + hstep + kstep, voffB);
        PG8_WAIT_V(6); PG8_BAR;
    }
    for (;;) {
        const bool has_next = S.next(ui + 1, nxt);
        const char* nA = has_next ? (const char*)g.A + (size_t)nxt.pm * tstep : cA; const char* nB = has_next ? (const char*)g.Bt + (size_t)nxt.pn * tstep : cB;
        for (int t = 0; t < nt; t += 2) {
            const bool last = (t == nt - 2);
            const char* a1 = cA + (size_t)(t + 1) * kstep;
            const char* a2 = last ? nA : cA + (size_t)(t + 2) * kstep; const char* b2 = last ? nB : cB + (size_t)(t + 2) * kstep;
            const char* a3 = a2 + kstep; const char* b3 = b2 + kstep;
            if (last && has_next) S.a_ready(nxt);
            if constexpr (SP2) {
            PG8_LDB(B0, 0, 0); PG8_LDB(B1, 0, 1); PG8_SCHED; PG8_LDA(At, 0, 0); PG8_STAGE(PG8_SA(1, 1), a1 + hstep, voffA);
            PG8_WAIT_V(8); PG8_WAIT_L(0); PG8_BAR; PG8_MMA(0, 0, At, B0); PG8_MMA(0, 1, At, B1); PG8_BAR; PG8_SCHED;
            PG8_LDA(At, 0, 1); PG8_STAGE(PG8_SB(0, 0), b2, voffB); PG8_STAGE(PG8_SB(0, 1), b2 + hstep, voffB); PG8_STAGE(PG8_SA(0, 0), a2, voffA);
            PG8_WAIT_V(8); PG8_WAIT_L(0); PG8_BAR; PG8_MMA(1, 0, At, B0); PG8_MMA(1, 1, At, B1); PG8_BAR; PG8_SCHED;
            PG8_LDB(B0, 1, 0); PG8_LDB(B1, 1, 1); PG8_SCHED; PG8_LDA(At, 1, 0); PG8_STAGE(PG8_SA(0, 1), a2 + hstep, voffA);
            PG8_WAIT_V(8); PG8_WAIT_L(0); PG8_BAR; PG8_MMA(0, 0, At, B0); PG8_MMA(0, 1, At, B1); PG8_BAR; PG8_SCHED;
            PG8_LDA(At, 1, 1); PG8_STAGE(PG8_SB(1, 0), b3, voffB); PG8_STAGE(PG8_SB(1, 1), b3 + hstep, voffB); PG8_STAGE(PG8_SA(1, 0), a3, voffA);
            PG8_WAIT_V(8); PG8_WAIT_L(0); PG8_BAR; PG8_MMA(1, 0, At, B0); PG8_MMA(1, 1, At, B1); PG8_BAR; PG8_SCHED;
            } else {
            PG8_LDB(B0, 0, 0); PG8_SCHED; PG8_LDA(At, 0, 0); PG8_STAGE(PG8_SA(1, 1), a1 + hstep, voffA);
            PG8_WAIT_L(8); PG8_BAR; PG8_WAIT_L(0); PG8_MMA(0, 0, At, B0); PG8_BAR; PG8_SCHED;
            PG8_LDB(B1, 0, 1); PG8_STAGE(PG8_SB(0, 0), b2, voffB);
            PG8_BAR; PG8_WAIT_L(0); PG8_MMA(0, 1, At, B1); PG8_BAR;
            PG8_LDA(At, 0, 1); PG8_STAGE(PG8_SA(0, 0), a2, voffA);
            PG8_BAR; PG8_WAIT_L(0); PG8_MMA(1, 0, At, B0); PG8_BAR; PG8_SCHED;
            PG8_STAGE(PG8_SB(0, 1), b2 + hstep, voffB);
            PG8_WAIT_V(6); PG8_BAR; PG8_MMA(1, 1, At, B1); PG8_BAR;
            PG8_LDB(B0, 1, 0); PG8_SCHED; PG8_LDA(At, 1, 0); PG8_STAGE(PG8_SA(0, 1), a2 + hstep, voffA);
            PG8_WAIT_L(8); PG8_BAR; PG8_WAIT_L(0); PG8_MMA(0, 0, At, B0); PG8_BAR; PG8_SCHED;
            PG8_LDB(B1, 1, 1); PG8_STAGE(PG8_SB(1, 0), b3, voffB);
            PG8_BAR; PG8_WAIT_L(0); PG8_MMA(0, 1, At, B1); PG8_BAR;
            PG8_LDA(At, 1, 1); PG8_STAGE(PG8_SA(1, 0), a3, voffA);
            PG8_BAR; PG8_WAIT_L(0); PG8_MMA(1, 0, At, B0); PG8_BAR; PG8_SCHED;
            PG8_STAGE(PG8_SB(1, 1), b3 + hstep, voffB);
            PG8_WAIT_V(6); PG8_BAR; PG8_MMA(1, 1, At, B1); PG8_BAR;
            }
        }
        if constexpr (ALIGN_EPI) { if (wr == 0) PG8_BAR; }
        if constexpr (!Epi::AFTER_DRAIN) { E(acc, cur, wr, wc, fr, fq); S.done(cur); }
        if (!has_next) break;
#pragma unroll
        for (int a = 0; a < 2; ++a)
#pragma unroll
            for (int b = 0; b < 2; ++b)
#pragma unroll
                for (int m = 0; m < 4; ++m)
#pragma unroll
                    for (int n = 0; n < 2; ++n) acc[a][b][m][n] = (f32x4){0.f, 0.f, 0.f, 0.f};
        cur = nxt; cA = nA; cB = nB; ++ui;
        if constexpr (ALIGN_EPI) { if (wr == 1) PG8_BAR; }
    }
    PG8_WAIT_V(0);
    if constexpr (!ALIGN_EPI) { if (wr == 0) PG8_BAR; }
    PG8_BAR;
    if constexpr (Epi::AFTER_DRAIN) { E.fused(acc, cur, wr, wc, fr, fq, lds, wid, lane); S.done(cur); }
#undef PG8_SA
#undef PG8_SB
#undef PG8_STAGE
#undef PG8_LDA
#undef PG8_LDB
#undef PG8_MMA
#undef PG8_WAIT_V
#undef PG8_WAIT_L
#undef PG8_BAR
#undef PG8_SCHED
}
}
#define LAS __attribute__((address_space(3)))
#define XB_TMO      128
#define XB_XCNT(j)  (256  + 64 * (j))
#define XB_XSUB(j)  (1280 + 64 * (j))
#define XB_XGEN(j)  (2304 + 64 * (j))
#define XB_TOP      3328
#define XB_TOPGEN   3392
#define XCD_BAR_WORDS 3456
#define XB_SPIN_CAP (1u << 18)

__device__ __forceinline__ unsigned xb_ld(unsigned* p)              { return __hip_atomic_load(p, __ATOMIC_RELAXED, __HIP_MEMORY_SCOPE_AGENT); }
__device__ __forceinline__ unsigned xb_add(unsigned* p, unsigned v) { return __hip_atomic_fetch_add(p, v, __ATOMIC_RELAXED, __HIP_MEMORY_SCOPE_AGENT); }
__device__ __forceinline__ unsigned xb_xcc_id() { return (unsigned)__builtin_amdgcn_s_getreg((3 << 11) | 20) & 0xFu; }
#define XB_SPIN(cond, bar) do { unsigned _sp = 0; while (cond) { __builtin_amdgcn_s_sleep(1); \
    if ((++_sp & 255u) == 0u) { if (xb_ld(&(bar)[XB_TMO])) break; if (_sp > XB_SPIN_CAP) { atomicAdd(&(bar)[XB_TMO], 1u); break; } } } } while (0)

struct XcdBarrier {
    unsigned* bar; unsigned x;
    volatile LAS unsigned* st;
};

__device__ __forceinline__ XcdBarrier xcd_barrier_post(unsigned* bar, volatile LAS unsigned* st) {
    XcdBarrier b; b.bar = bar; b.x = xb_xcc_id(); b.st = st;
    if (threadIdx.x == 0) (void)xb_add(&bar[XB_XCNT(b.x)], 1u);
    return b;
}
__device__ __forceinline__ void xcd_barrier_complete(unsigned* bar, unsigned x, unsigned& nloc, unsigned& nx) {
    const unsigned G = gridDim.x * gridDim.y * gridDim.z;
    unsigned sum, cnt, mine, sp = 0u;
    for (;;) {
        sum = 0u; cnt = 0u; mine = 0u;
#pragma unroll
        for (unsigned j = 0; j < 16; ++j) { const unsigned c = xb_ld(&bar[XB_XCNT(j)]); sum += c; cnt += (c > 0u) ? 1u : 0u; mine = (j == x) ? c : mine; }
        if (sum == G) break;
        __builtin_amdgcn_s_sleep(1);
        if ((++sp & 255u) == 0u) { if (xb_ld(&bar[XB_TMO])) break; if (sp > XB_SPIN_CAP) { atomicAdd(&bar[XB_TMO], 1u); break; } }
    }
    nloc = mine > 0u ? mine : 1u; nx = cnt > 0u ? cnt : 1u;
}

__device__ __forceinline__ void xcd_barrier(const XcdBarrier& b) {
    asm volatile("s_waitcnt vmcnt(0)" ::: "memory");
    __syncthreads();
    if (threadIdx.x == 0) {
        unsigned* bar = b.bar;
        __builtin_amdgcn_s_waitcnt(0);
        unsigned nloc = b.st[0], nx = b.st[1];
        if (nloc == 0u) { xcd_barrier_complete(bar, b.x, nloc, nx); b.st[0] = nloc; b.st[1] = nx; }
        const unsigned old = xb_add(&bar[XB_XSUB(b.x)], 1u);
        const unsigned gen = old / nloc;
        if (old + 1u == (gen + 1u) * nloc) {
            __builtin_amdgcn_fence(__ATOMIC_RELEASE, "agent");
            asm volatile("s_waitcnt vmcnt(0)" ::: "memory");
            const unsigned og = xb_add(&bar[XB_TOP], 1u);
            const unsigned tg = og / nx;
            if (og + 1u == (tg + 1u) * nx) xb_add(&bar[XB_TOPGEN], 1u);
            else XB_SPIN(xb_ld(&bar[XB_TOPGEN]) == tg, bar);
            __builtin_amdgcn_fence(__ATOMIC_ACQUIRE, "agent");
            xb_add(&bar[XB_XGEN(b.x)], 1u);
            asm volatile("s_waitcnt vmcnt(0)" ::: "memory");
        } else {
            XB_SPIN(xb_ld(&bar[XB_XGEN(b.x)]) == gen, bar);
            __builtin_amdgcn_fence(__ATOMIC_ACQUIRE, "agent");
            asm volatile("s_waitcnt vmcnt(0)" ::: "memory");
        }
    }
    __syncthreads();
}

constexpr int NWAVES = 8, NTHREADS = 512;
constexpr int DM = 2048, NTP = 8192, NTS = 32, NT = 8224, MP = 8448;
constexpr int RW_COLS = 3360, Q_OFF = 3360, KC_OFF = 4384, KS_OFF = 4896, VS_OFF = 5152, KW_OFF = 5408, VW_OFF = 5664, GL_OFF = 5920, IN_COLS = 5968, PLD = 6144;
constexpr int NEXP = 16384, NPOOL = 1280;
constexpr float LN_EPS = 1e-5f, GN_EPS = 64e-5f, DN_ALPHA = 1.4142135623730951f;
constexpr float NEG_BIG = -1e30f;
constexpr size_t O_YP = 0, O_YS = O_YP + (size_t)NTP * DM, O_CMP_P = O_YS + (size_t)NTS * DM, O_SEL_P = O_CMP_P + (size_t)2 * NTP * 512, O_WIN_P = O_SEL_P + (size_t)2 * NTP * 512,
                 O_RW_P = O_WIN_P + (size_t)2 * 4 * 512 * 512, O_SH_P = O_RW_P + (size_t)2 * 4 * 16 * 4096, O_CMP_S = O_SH_P + (size_t)2 * 4 * RW_COLS, O_SEL_S = O_CMP_S + (size_t)2 * NTS * 512,
                 O_WIN_S = O_SEL_S + (size_t)2 * NTS * 512, O_RW_S = O_WIN_S + (size_t)2 * 8 * 512 * 512, O_SH_S = O_RW_S + (size_t)2 * 8 * 16 * 4096, O_END = O_SH_S + (size_t)2 * 8 * RW_COLS;
static_assert(O_END == 41630464, "output size");
constexpr size_t MiB = 1ull << 20;
constexpr size_t WS_CTL = 0, CTL_ZERO_BYTES = 1 * MiB;
constexpr size_t WS_WIN = 1 * MiB;
constexpr size_t WS_WOUT = WS_WIN + 48 * MiB;
constexpr size_t WS_W2 = WS_WOUT + 16 * MiB;
constexpr size_t WS_UB = WS_W2 + 16 * MiB;
constexpr size_t WS_VB = WS_UB + 64 * MiB;
constexpr size_t WS_USC = WS_VB + 64 * MiB;
constexpr size_t WS_XB = WS_USC + 1 * MiB;
constexpr size_t WS_X1B = WS_XB + 33 * MiB;
constexpr size_t WS_XF1 = WS_X1B + 33 * MiB;
constexpr size_t WS_X1F = WS_XF1 + 65 * MiB;
constexpr size_t WS_PROJ = WS_X1F + 65 * MiB;
constexpr size_t WS_SC = WS_PROJ + 99 * MiB;
constexpr size_t SC_STRIDE = 33 * MiB;
constexpr size_t WS_GG = WS_SC + 6 * SC_STRIDE;
constexpr size_t WS_BON = WS_GG + 33 * MiB;
constexpr size_t WS_MIX = WS_BON + 1 * MiB;
constexpr size_t WS_HS = WS_MIX + 33 * MiB;
constexpr size_t WS_KCB = WS_HS + 66 * MiB;
constexpr size_t WS_VCBT = WS_KCB + 512 * 1024;
constexpr size_t WS_VTS = WS_KCB + 1 * MiB;
constexpr size_t WS_VTW = WS_VTS + 4 * MiB;
constexpr size_t WS_KCBS = WS_VTW + 4 * MiB;
constexpr size_t WS_VCBS = WS_KCBS + 17 * MiB;
constexpr size_t WS_LT = WS_VCBS + 17 * MiB;
constexpr size_t WS_KSC = WS_LT + 2 * MiB;
constexpr size_t WS_KWC = WS_KSC + 4 * MiB;
constexpr size_t WS_OPS = WS_KWC + 4 * MiB;
constexpr size_t OPS_BYTES = 51200;
constexpr size_t WS_EL = WS_OPS + 80 * MiB;
constexpr size_t WS_GT = WS_EL + 3 * MiB;
constexpr size_t WS_PD = WS_GT + 5 * MiB;
constexpr size_t WS_WP = WS_PD + 65 * MiB;
constexpr size_t WS_FO = WS_WP + 5 * MiB;
constexpr size_t WS_X1Q = WS_FO + 65 * MiB;
constexpr size_t WS_XQS = WS_X1Q + 17 * MiB;
constexpr size_t WS_END = WS_XQS + 1 * MiB;
constexpr int CW_BAR = 4096, CW_QUEUE = 8192, CW_SQ = 65536, CW_FLAG = 16384;
constexpr int RING_BYTES = 131072, MISC_OFF = RING_BYTES + 320, LDS_BYTES = 147456;
constexpr int N_PHASES = 23;

typedef unsigned short bf16;
typedef unsigned v4u __attribute__((ext_vector_type(4)));
typedef unsigned v2u __attribute__((ext_vector_type(2)));
typedef float f32x4 __attribute__((ext_vector_type(4)));
typedef float f32x16 __attribute__((ext_vector_type(16)));
typedef short bf16x8 __attribute__((ext_vector_type(8)));
typedef float f32x2_t __attribute__((ext_vector_type(2)));
typedef __bf16 bf16x2_t __attribute__((ext_vector_type(2)));
#define LDS_WAIT() asm volatile("s_waitcnt lgkmcnt(0)" ::: "memory")
#define DI __device__ __forceinline__
#define GAS __attribute__((address_space(1)))
template <class T> DI T* launder_g(T* p) { GAS T* g = (GAS T*)p; asm volatile("" : "+s"(g)); return (T*)g; }

DI unsigned pk2(float lo, float hi) { f32x2_t v = {lo, hi}; bf16x2_t b = __builtin_convertvector(v, bf16x2_t); return __builtin_bit_cast(unsigned, b); }
DI float bf2f(unsigned short u) { return __builtin_bit_cast(float, (unsigned)u << 16); }
DI float bflo(unsigned u) { return __builtin_bit_cast(float, u << 16); }
DI float bfhi(unsigned u) { return __builtin_bit_cast(float, u & 0xffff0000u); }
template <int CTRL> DI float dppf(float v) { return __builtin_bit_cast(float, __builtin_amdgcn_update_dpp(0, __builtin_bit_cast(int, v), CTRL, 0xF, 0xF, false)); }
DI float rdlane(float v, int l) { return __builtin_bit_cast(float, __builtin_amdgcn_readlane(__builtin_bit_cast(int, v), l)); }
DI float wave_sum(float v) {
    v += dppf<0xB1>(v); v += dppf<0x4E>(v); v += dppf<0x141>(v); v += dppf<0x140>(v);
    return (rdlane(v, 0) + rdlane(v, 16)) + (rdlane(v, 32) + rdlane(v, 48));
}
DI float wave_max(float v) {
    v = fmaxf(v, dppf<0xB1>(v)); v = fmaxf(v, dppf<0x4E>(v)); v = fmaxf(v, dppf<0x141>(v)); v = fmaxf(v, dppf<0x140>(v));
    return fmaxf(fmaxf(rdlane(v, 0), rdlane(v, 16)), fmaxf(rdlane(v, 32), rdlane(v, 48)));
}
DI float sigmoidf_(float x) { return 1.f / (1.f + expf(-x)); }
DI int crow(int reg, int h) { return (reg & 3) + 8 * (reg >> 2) + 4 * h; }

struct ArgsK { const float* in[30]; float* out; unsigned char* ws; int ph_lo, ph_hi, use_bar, pad; };
struct ArgsG { const GAS float* in[30]; GAS float* out; GAS unsigned char* ws; int ph_lo, ph_hi, use_bar, pad; };
typedef __attribute__((address_space(4))) const ArgsG* kargp_t;
struct Ctx {
    float* out; unsigned char* ws;
    LAS unsigned char* lds; unsigned* ctl;
    int tid, lane, wave, G;
    DI const float* inp(int k) const { kargp_t p = (kargp_t)__builtin_amdgcn_kernarg_segment_ptr(); asm volatile("" : "+s"(p)); return (const float*)p->in[k]; }
};
template <class T> DI T* wsp(const Ctx& C, size_t off) { return (T*)(C.ws + off); }

struct EpiInProj {
    static constexpr bool PERM = true, AFTER_DRAIN = false;
    bf16* P; float* out; int l;
    DI void operator()(const pg8::f32x4 (&acc)[2][2][4][2], const pg8::Unit& u, int wr, int wc, int fr, int fq) const {
        const int row0 = u.pm * 256 + wr * 64 + fr, col0 = u.pn * 256 + wc * 32 + 8 * fq;
#pragma unroll
        for (int bj = 0; bj < 2; ++bj) {
            const int colb = __builtin_amdgcn_readfirstlane(u.pn * 256 + wc * 32 + bj * 128);
            const int col = col0 + bj * 128;
            const int kind = colb < RW_COLS ? 1 : ((colb >= KC_OFF && colb < GL_OFF) ? 2 : 0);
            const int reg = (colb - KC_OFF) >> 9, cc = (col - KC_OFF) & 511;
#pragma unroll
            for (int ai = 0; ai < 2; ++ai)
#pragma unroll
                for (int m = 0; m < 4; ++m) {
                    const int row = row0 + ai * 128 + m * 16;
                    const pg8::f32x4 v0 = acc[ai][bj][m][0], v1 = acc[ai][bj][m][1];
                    v4u w; w.x = pk2(v0[0], v0[1]); w.y = pk2(v0[2], v0[3]); w.z = pk2(v1[0], v1[1]); w.w = pk2(v1[2], v1[3]);
                    *(v4u*)(P + (size_t)row * PLD + col) = w;
                    if (kind == 0 || row >= NT) continue;
                    unsigned off = 0xffffffffu;
                    if (row < NTP) { const int b = row >> 11, t = row & 2047;
                        if (kind == 1) { if (t == 2047) off = (unsigned)(O_SH_P + (size_t)(l * 4 + b) * RW_COLS + col); }
                        else if (reg == 0) off = (unsigned)(O_CMP_P + ((size_t)l * NTP + row) * 512 + cc);
                        else if (reg == 1) off = (unsigned)(O_SEL_P + ((size_t)l * NTP + row) * 512 + cc);
                        else if (t >= 1536) off = (unsigned)(O_WIN_P + ((size_t)(l * 4 + b) * 512 + (t - 1536)) * 512 + cc);
                    } else { const int j = row - NTP, b = j >> 2, t = j & 3;
                        if (kind == 1) { if (t == 3) off = (unsigned)(O_SH_S + (size_t)(l * 8 + b) * RW_COLS + col); }
                        else if (reg == 0) off = (unsigned)(O_CMP_S + ((size_t)l * NTS + j) * 512 + cc);
                        else if (reg == 1) off = (unsigned)(O_SEL_S + ((size_t)l * NTS + j) * 512 + cc);
                        else off = (unsigned)(O_WIN_S + ((size_t)(l * 8 + b) * 512 + 508 + t) * 512 + cc);
                    }
                    if (off != 0xffffffffu) { *(pg8::f32x4*)(out + off) = v0; *(pg8::f32x4*)(out + off + 4) = v1; }
                }
        }
    }
};

struct EpiBf16Row {
    static constexpr bool PERM = true, AFTER_DRAIN = false;
    bf16* Cb; int ldc;
    DI void operator()(const pg8::f32x4 (&acc)[2][2][4][2], const pg8::Unit& u, int wr, int wc, int fr, int fq) const {
        const int row0 = u.pm * 256 + wr * 64 + fr, col0 = u.pn * 256 + wc * 32 + 8 * fq;
#pragma unroll
        for (int bj = 0; bj < 2; ++bj)
#pragma unroll
            for (int ai = 0; ai < 2; ++ai)
#pragma unroll
                for (int m = 0; m < 4; ++m) { const pg8::f32x4 v0 = acc[ai][bj][m][0], v1 = acc[ai][bj][m][1];
                    v4u w; w.x = pk2(v0[0], v0[1]); w.y = pk2(v0[2], v0[3]); w.z = pk2(v1[0], v1[1]); w.w = pk2(v1[2], v1[3]);
                    *(v4u*)(Cb + (size_t)(row0 + ai * 128 + m * 16) * ldc + col0 + bj * 128) = w; }
    }
};

template <class Sink> DI void skinny_gemm(const Ctx& C, const bf16* A, const bf16* Bt, int nslabs, const Sink& sink) {
    const int tid = C.tid, lane = C.lane, wave = C.wave, r = lane & 31, hi = lane >> 5;
    LAS float* PS = (LAS float*)C.lds;
    for (int it = blockIdx.x; it < nslabs; it += C.G) {
        const int n0 = it * 32, k0 = wave * 256;
        f32x16 acc;
#pragma unroll
        for (int i = 0; i < 16; ++i) acc[i] = 0.f;
        const bf16* ap = A + (size_t)r * DM + k0 + 8 * hi; const bf16* bp = Bt + (size_t)(n0 + r) * DM + k0 + 8 * hi;
#pragma unroll 8
        for (int s = 0; s < 16; ++s) { const bf16x8 af = *(const bf16x8*)(ap + 16 * s), bf = *(const bf16x8*)(bp + 16 * s); acc = __builtin_amdgcn_mfma_f32_32x32x16_bf16(af, bf, acc, 0, 0, 0); }
        __syncthreads();
#pragma unroll
        for (int i = 0; i < 16; ++i) PS[(wave * 32 + crow(i, hi)) * 33 + r] = acc[i];
        __syncthreads();
#pragma unroll
        for (int e = 0; e < 2; ++e) { const int o = tid * 2 + e, row = o >> 5, col = o & 31; float v = 0.f;
#pragma unroll
            for (int w = 0; w < 8; ++w) v += PS[(w * 32 + row) * 33 + col];
            sink(row, n0 + col, v); }
    }
    __syncthreads();
}

DI void transpose_item(const float* W, int K, int N, int Npad, bf16* WT, LAS float* scr, int item, int lane) {
    const int nblk = Npad / 32, kb = item / nblk, nb = item % nblk, k0 = 64 * kb, n0 = 32 * nb;
    float tv[32];
#pragma unroll
    for (int i = 0; i < 32; ++i) { const int kk = 2 * i + (lane >> 5), n = n0 + (lane & 31); tv[i] = n < N ? W[(size_t)(k0 + kk) * N + n] : 0.f; }
#pragma unroll
    for (int i = 0; i < 32; ++i) { const int kk = 2 * i + (lane >> 5); scr[kk * 33 + (lane & 31)] = tv[i]; }
    LDS_WAIT(); asm volatile("" ::: "memory");
    const int c = lane & 7;
#pragma unroll
    for (int j = 0; j < 4; ++j) { const int n = (lane >> 3) + 8 * j; const LAS float* s = scr + (8 * c) * 33 + n;
        v4u o; o.x = pk2(s[0 * 33], s[1 * 33]); o.y = pk2(s[2 * 33], s[3 * 33]); o.z = pk2(s[4 * 33], s[5 * 33]); o.w = pk2(s[6 * 33], s[7 * 33]);
        *(v4u*)(WT + (size_t)(n0 + n) * K + k0 + 8 * c) = o; }
    LDS_WAIT(); asm volatile("" ::: "memory");
}


DI void p0i_table(const Ctx& C, int r) {
    const int lane = C.lane, wave = C.wave;
    f32x4 v[2][8];
#pragma unroll
    for (int h = 0; h < 2; ++h) { const int row = r * 16 + 8 * h + wave;
        const float* src = (row < 32768 ? C.inp(26) : C.inp(27)) + (size_t)(row & 32767) * DM;
#pragma unroll
        for (int k = 0; k < 2; ++k)
#pragma unroll
            for (int q = 0; q < 4; ++q) v[h][4 * k + q] = ((const f32x4*)src)[4 * lane + 256 * k + q]; }
#pragma unroll
    for (int h = 0; h < 2; ++h) { const int row = r * 16 + 8 * h + wave;
        unsigned char* dst = C.ws + (row < 32768 ? WS_UB : WS_VB) + (size_t)((row >> 14) & 1) * NEXP * DM + (size_t)(row & 16383) * 128;
        float am = 0.f;
#pragma unroll
        for (int j = 0; j < 8; ++j) am = fmaxf(am, fmaxf(fmaxf(fabsf(v[h][j][0]), fabsf(v[h][j][1])), fmaxf(fabsf(v[h][j][2]), fabsf(v[h][j][3]))));
        am = wave_max(am);
        const bool isu = row < 32768;
        const float sc = am > 0.f ? am * (isu ? 1.f / 127.f : 1.f / 256.f) : 1.f, inv = 1.f / sc;
#pragma unroll
        for (int k = 0; k < 2; ++k) { v4u o;
#pragma unroll
            for (int q = 0; q < 4; ++q) { const f32x4 x = v[h][4 * k + q] * inv;
                if (isu) o[q] = ((unsigned)(int)__builtin_rintf(x[0]) & 255u) | (((unsigned)(int)__builtin_rintf(x[1]) & 255u) << 8) | (((unsigned)(int)__builtin_rintf(x[2]) & 255u) << 16) | ((unsigned)(int)__builtin_rintf(x[3]) << 24);
                else { int p = __builtin_amdgcn_cvt_pk_fp8_f32(x[0], x[1], 0, false); p = __builtin_amdgcn_cvt_pk_fp8_f32(x[2], x[3], p, true); o[q] = (unsigned)p; } }
            *(v4u*)(dst + ((size_t)((lane >> 3) + 8 * k) * NEXP) * 128 + 16 * (lane & 7)) = o; }
        if (lane == 0) wsp<float>(C, WS_USC)[row] = sc; }
}
DI void p0i_cache(const Ctx& C, int r) {
    const int tid = C.tid;
    const int l = r >> 10, b = (r >> 7) & 7, pi = r & 127;
    const int pid = ((const int*)C.inp(4))[b * 128 + pi];
    const int q = tid >> 7, c4 = tid & 127, kv = c4 >> 6, kvh = (c4 >> 4) & 3, d0 = (c4 & 15) * 4;
    const f32x4* src = (const f32x4*)(C.inp(2) + ((size_t)(l * NPOOL + pid) * 128 + 32 * q) * 512) + c4;
    const float* w = C.inp(20) + (l * 2 + kv) * 32;
    f32x4 acc = {0.f, 0.f, 0.f, 0.f};
    f32x4 cr[32];
#pragma unroll
    for (int rr = 0; rr < 32; ++rr) cr[rr] = src[(size_t)rr * 128];
#pragma unroll
    for (int rr = 0; rr < 32; ++rr) acc += cr[rr] * w[rr];
    *(f32x4*)(wsp<float>(C, kv ? WS_VCBS : WS_KCBS) + ((size_t)((l * 8 + b) * 4 + kvh) * 512 + 4 * pi + q) * 64 + d0) = acc;
}
DI void p0i_transpose(const Ctx& C, int r) {
    const int lane = C.lane, wave = C.wave;
    const int l = r >> 10, w8 = (r & 1023) * 8 + wave;
    LAS float* scr = (LAS float*)(C.lds + wave * 16384);
    if (w8 < 6144) transpose_item(C.inp(8) + (size_t)l * DM * IN_COLS, DM, IN_COLS, PLD, wsp<bf16>(C, WS_WIN) + (size_t)l * PLD * DM, scr, w8, lane);
    else transpose_item(C.inp(21) + (size_t)l * DM * DM, DM, DM, DM, wsp<bf16>(C, WS_WOUT) + (size_t)l * DM * DM, scr, w8 - 6144, lane);
}
DI bf16x8 bf8_of(const f32x4& a, const f32x4& b) { const v4u p = {pk2(a[0], a[1]), pk2(a[2], a[3]), pk2(b[0], b[1]), pk2(b[2], b[3])}; return __builtin_bit_cast(bf16x8, p); }
DI f32x4 bf_resid(const f32x4& a, unsigned p01, unsigned p23) { return (f32x4){a[0] - bflo(p01), a[1] - bfhi(p01), a[2] - bflo(p23), a[3] - bfhi(p23)}; }
DI void p0i_w2(const Ctx& C, int r) {
    const int lane = C.lane, wave = C.wave, rr = lane & 31, hi = lane >> 5;
    const int l = r >> 9, hc = (r >> 5) & 15, kb = r & 31, kt = wave & 3, nt = wave >> 2;
    const float* sk = C.inp(25) + ((size_t)l * 16 + hc) * 16384 + (size_t)(kt * 32 + rr) * 128 + 8 * hi;
    const float* wq = C.inp(24) + (size_t)l * DM * DM + (size_t)(kb * 64 + nt * 32 + rr) * DM + hc * 128 + 8 * hi;
    f32x16 acc;
#pragma unroll
    for (int i = 0; i < 16; ++i) acc[i] = 0.f;
#pragma unroll 4
    for (int s = 0; s < 8; ++s) {
        const f32x4 a0 = *(const f32x4*)(sk + 16 * s), a1 = *(const f32x4*)(sk + 16 * s + 4), b0 = *(const f32x4*)(wq + 16 * s), b1 = *(const f32x4*)(wq + 16 * s + 4);
        const v4u ahp = {pk2(a0[0], a0[1]), pk2(a0[2], a0[3]), pk2(a1[0], a1[1]), pk2(a1[2], a1[3])}, bhp = {pk2(b0[0], b0[1]), pk2(b0[2], b0[3]), pk2(b1[0], b1[1]), pk2(b1[2], b1[3])};
        const bf16x8 ah = __builtin_bit_cast(bf16x8, ahp), bh = __builtin_bit_cast(bf16x8, bhp);
        const bf16x8 al = bf8_of(bf_resid(a0, ahp.x, ahp.y), bf_resid(a1, ahp.z, ahp.w)), bl = bf8_of(bf_resid(b0, bhp.x, bhp.y), bf_resid(b1, bhp.z, bhp.w));
        acc = __builtin_amdgcn_mfma_f32_32x32x16_bf16(ah, bh, acc, 0, 0, 0);
        acc = __builtin_amdgcn_mfma_f32_32x32x16_bf16(ah, bl, acc, 0, 0, 0);
        acc = __builtin_amdgcn_mfma_f32_32x32x16_bf16(al, bh, acc, 0, 0, 0);
    }
    bf16* W2 = wsp<bf16>(C, WS_W2) + (size_t)l * DM * DM + (size_t)(hc * 128 + kt * 32) * DM + kb * 64 + nt * 32 + rr;
#pragma unroll
    for (int i = 0; i < 16; ++i) W2[(size_t)crow(i, hi) * DM] = (unsigned short)(pk2(acc[i], 0.f) & 0xffffu);
}
constexpr int DEF_ITEMS = 4096 + 1024 + 1024 + 1024, DEF_GROUPS = DEF_ITEMS / 4;
DI void deferred_item(const Ctx& C, int i) {
    if (i < 4096) p0i_table(C, i);
    else if (i < 5120) p0i_cache(C, 1024 + (i - 4096));
    else if (i < 6144) p0i_transpose(C, 1024 + (i - 5120));
    else p0i_w2(C, i - 6144);
}

constexpr int P0_NX = 2056, P0_NWP = 508;
DI void p0_prologue(const Ctx& C, int pmask = 31) {
    const int tid = C.tid;
    LAS int* qslot = (LAS int*)(C.lds + MISC_OFF + 64);
#define P0_CLAIM 4
#define P0_BLOCK(n, qi) for (int base_ = 0; ; ) { __syncthreads(); if (tid == 0) *qslot = (int)atomicAdd(C.ctl + CW_QUEUE + 64 * (8 + (qi)), (unsigned)P0_CLAIM); __syncthreads(); base_ = *qslot; if (base_ >= (n)) break; \
        for (int r = base_, r_hi = (base_ + P0_CLAIM < (n) ? base_ + P0_CLAIM : (n)); r < r_hi; ++r)
#define P0_END }
    if (pmask & 4) P0_BLOCK(1024, 2) { p0i_transpose(C, r); } P0_END
    static_assert(P0_NX % P0_CLAIM == 0 && P0_NWP % P0_CLAIM == 0, "whole claims");
#define P0_CLAIMED(n, qi) for (int base_ = 0; ; ) { __syncthreads(); if (tid == 0) *qslot = (int)atomicAdd(C.ctl + CW_QUEUE + 64 * (8 + (qi)), (unsigned)P0_CLAIM); __syncthreads(); base_ = *qslot; if (base_ >= (n)) break;
    if (pmask & 16) P0_CLAIMED(P0_NX, 4) {
            f32x4 q_[P0_CLAIM][4];
#pragma unroll
            for (int u = 0; u < P0_CLAIM; ++u) { const size_t e0 = (size_t)(base_ + u) * 8192 + tid * 16;
                const f32x4* s4 = (const f32x4*)(e0 < (size_t)NTP * DM ? C.inp(0) + e0 : C.inp(1) + (e0 - (size_t)NTP * DM));
                q_[u][0] = s4[0]; q_[u][1] = s4[1]; q_[u][2] = s4[2]; q_[u][3] = s4[3]; }
#pragma unroll
            for (int u = 0; u < P0_CLAIM; ++u) { const size_t e0 = (size_t)(base_ + u) * 8192 + tid * 16; const f32x4 a = q_[u][0], b = q_[u][1], c = q_[u][2], d = q_[u][3];
                v4u o0, o1; o0.x = pk2(a[0], a[1]); o0.y = pk2(a[2], a[3]); o0.z = pk2(b[0], b[1]); o0.w = pk2(b[2], b[3]);
                o1.x = pk2(c[0], c[1]); o1.y = pk2(c[2], c[3]); o1.z = pk2(d[0], d[1]); o1.w = pk2(d[2], d[3]);
                v4u* d4 = (v4u*)(wsp<bf16>(C, WS_XB) + e0); d4[0] = o0; d4[1] = o1; }
        } P0_END
    if (pmask & 2) P0_BLOCK(1024, 1) { p0i_cache(C, r); } P0_END
    if (pmask & 4) P0_BLOCK(144, 6) {{
            const int g = r * 512 + tid, l = g / 36864, rem = g % 36864, c = rem / 36, kg = rem % 36;
            const float* src = kg < 8 ? C.inp(11) + ((size_t)l * 64 + kg * 8) * 1024 : (kg < 16 ? C.inp(13) + ((size_t)l * 64 + (kg - 8) * 8) * 1024 : C.inp(14) + ((size_t)l * 160 + (kg - 16) * 8) * 1024);
            float e[8];
#pragma unroll
            for (int q = 0; q < 8; ++q) e[q] = src[(size_t)q * 1024 + c];
            *(v4u*)(wsp<bf16>(C, WS_LT) + ((size_t)l * 1024 + c) * 288 + kg * 8) = (v4u){pk2(e[0], e[1]), pk2(e[2], e[3]), pk2(e[4], e[5]), pk2(e[6], e[7])};
        }} P0_END
    if (pmask & 16) P0_CLAIMED(P0_NWP, 5) {
            f32x4 q_[P0_CLAIM][4];
#pragma unroll
            for (int u = 0; u < P0_CLAIM; ++u) { const size_t i0 = (size_t)(base_ + u) * 8192 + tid * 16; const size_t lb = i0 / 260096, rem = i0 % 260096;
                const f32x4* s4 = (const f32x4*)(C.inp(5) + lb * 262144 + 2048 + rem); q_[u][0] = s4[0]; q_[u][1] = s4[1]; q_[u][2] = s4[2]; q_[u][3] = s4[3]; }
#pragma unroll
            for (int u = 0; u < P0_CLAIM; ++u) { const size_t i0 = (size_t)(base_ + u) * 8192 + tid * 16; const size_t lb = i0 / 260096, rem = i0 % 260096;
                f32x4* d4 = (f32x4*)(C.out + O_WIN_S + lb * 262144 + rem); d4[0] = q_[u][0]; d4[1] = q_[u][1]; d4[2] = q_[u][2]; d4[3] = q_[u][3]; }
        } P0_END
    __syncthreads();
}

constexpr int PB_NRW = 514, PB_NPOOL = 256, PB_NVT = 1024, PB_ITEMS = PB_NRW + PB_NPOOL + PB_NVT;
DI float softplusf_(float x) { return x > 20.f ? x : log1pf(expf(x)); }
DI float fexp_(float x) { return __expf(x); }
DI float fsoftplus_(float x) { return x > 20.f ? x : __logf(1.f + __expf(x)); }
DI float fsigmoid_(float x) { return __builtin_amdgcn_rcpf(1.f + __expf(-x)); }

constexpr int XSB_LD = 3088, ACTB_LD = 296;
DI void rwkv_pre_item(const Ctx& C, int l, int item) {
    const int tid = C.tid, lane = C.lane, wave = C.wave, n16 = lane & 15, rq = lane >> 4;
    LAS unsigned short* XSB = (LAS unsigned short*)C.lds;
    LAS unsigned short* ACTB = (LAS unsigned short*)(C.lds + 16 * XSB_LD * 2);
    const bf16* P = wsp<bf16>(C, WS_PROJ);
    const int m0 = item * 16;
    __syncthreads();
#pragma unroll 1
    for (int base = 0; base < 16 * 420; base += 4 * NTHREADS) {
        v4u cu[4], pu[4]; f32x4 mu0[4], mu1[4], sh0[4], sh1[4]; int jj_[4], col_[4], kind[4];
#pragma unroll
        for (int u = 0; u < 4; ++u) { const int idx = base + u * NTHREADS + tid; kind[u] = -1; jj_[u] = 0; col_[u] = 0;
            if (idx < 16 * 420) { const int j = idx / 420, col = (idx % 420) * 8, m = m0 + j; jj_[u] = j; col_[u] = col;
                cu[u] = *(const v4u*)(P + (size_t)m * PLD + col);
                const f32x4* mup = (const f32x4*)(C.inp(9) + (size_t)l * RW_COLS + col); mu0[u] = mup[0]; mu1[u] = mup[1];
                int t; const float* sh = nullptr;
                if (m < NTP) t = m & 2047; else { const int jq = m - NTP; t = jq & 3; sh = C.inp(7) + (size_t)(l * 8 + (jq >> 2)) * RW_COLS + col; }
                if (t > 0) { pu[u] = *(const v4u*)(P + (size_t)(m - 1) * PLD + col); kind[u] = 1; }
                else if (sh) { sh0[u] = ((const f32x4*)sh)[0]; sh1[u] = ((const f32x4*)sh)[1]; kind[u] = 2; }
                else kind[u] = 0; } }
#pragma unroll
        for (int u = 0; u < 4; ++u) if (kind[u] >= 0) {
            const int j = jj_[u], col = col_[u];
            float cur[8] = {bflo(cu[u].x), bfhi(cu[u].x), bflo(cu[u].y), bfhi(cu[u].y), bflo(cu[u].z), bfhi(cu[u].z), bflo(cu[u].w), bfhi(cu[u].w)};
            float prev[8];
            if (kind[u] == 1) { prev[0] = bflo(pu[u].x); prev[1] = bfhi(pu[u].x); prev[2] = bflo(pu[u].y); prev[3] = bfhi(pu[u].y); prev[4] = bflo(pu[u].z); prev[5] = bfhi(pu[u].z); prev[6] = bflo(pu[u].w); prev[7] = bfhi(pu[u].w); }
            else if (kind[u] == 2) {
#pragma unroll
                for (int e = 0; e < 4; ++e) { prev[e] = sh0[u][e]; prev[4 + e] = sh1[u][e]; } }
            else {
#pragma unroll
                for (int e = 0; e < 8; ++e) prev[e] = 0.f; }
            float xs[8];
#pragma unroll
            for (int e = 0; e < 4; ++e) { xs[e] = cur[e] + mu0[u][e] * (prev[e] - cur[e]); xs[4 + e] = cur[4 + e] + mu1[u][e] * (prev[4 + e] - cur[4 + e]); }
            if (col >= 3072) { const int a0 = col - 3072;
#pragma unroll
                for (int e = 0; e < 8; ++e) xs[e] = a0 < 64 ? tanhf(xs[e]) : (a0 < 128 ? xs[e] : fsigmoid_(xs[e]));
                *(LAS v4u*)(ACTB + j * ACTB_LD + a0) = (v4u){pk2(xs[0], xs[1]), pk2(xs[2], xs[3]), pk2(xs[4], xs[5]), pk2(xs[6], xs[7])};
            } else *(LAS v4u*)(XSB + j * XSB_LD + col) = (v4u){pk2(xs[0], xs[1]), pk2(xs[2], xs[3]), pk2(xs[4], xs[5]), pk2(xs[6], xs[7])};
        }
    }
    __syncthreads();
    float* SC = wsp<float>(C, WS_SC); constexpr size_t SS = SC_STRIDE / 4;
    float* GG = wsp<float>(C, WS_GG); float* BON = wsp<float>(C, WS_BON);
    const bf16* LT = wsp<bf16>(C, WS_LT) + (size_t)l * 1024 * 288;
    const f32x4 zf = {0.f, 0.f, 0.f, 0.f};
#pragma unroll 1
    for (int hh = 0; hh < 2; ++hh) {
        const int head = 2 * wave + hh;
        f32x4 aw[4], aa[4], ag[4];
#pragma unroll
        for (int t4 = 0; t4 < 4; ++t4) { aw[t4] = zf; aa[t4] = zf; ag[t4] = zf; }
#define LORA_STEPS(ACC, KS0, NKS) _Pragma("unroll") for (int ks = (KS0); ks < (KS0) + (NKS); ++ks) { \
            const bf16x8 af = *(const LAS bf16x8*)(ACTB + n16 * ACTB_LD + 32 * ks + 8 * rq); \
            _Pragma("unroll") for (int t4 = 0; t4 < 4; ++t4) { const bf16x8 bfr = *(const bf16x8*)(LT + (size_t)(head * 64 + 16 * t4 + n16) * 288 + 32 * ks + 8 * rq); \
                ACC[t4] = __builtin_amdgcn_mfma_f32_16x16x32_bf16(af, bfr, ACC[t4], 0, 0, 0); } }
        LORA_STEPS(aw, 0, 2) LORA_STEPS(aa, 2, 2) LORA_STEPS(ag, 4, 5)
#undef LORA_STEPS
        float w0v[4], a0v[4], kkv[4], kav[4], rkv[4];
#pragma unroll
        for (int t4 = 0; t4 < 4; ++t4) { const int c = l * 1024 + head * 64 + 16 * t4 + n16; w0v[t4] = C.inp(10)[c]; a0v[t4] = C.inp(12)[c]; kkv[t4] = C.inp(15)[c]; kav[t4] = C.inp(16)[c]; rkv[t4] = C.inp(17)[c]; }
#pragma unroll
        for (int i = 0; i < 4; ++i) {
            const int j = 4 * rq + i; const size_t m = (size_t)m0 + j;
            float kkr[4], km[4], a_[4], rr[4], vv[4], lw_[4]; float ss = 0.f, bs = 0.f;
#pragma unroll
            for (int t4 = 0; t4 < 4; ++t4) { const int cl = head * 64 + 16 * t4 + n16;
                const float z = w0v[t4] + aw[t4][i];
                const float w = -fsoftplus_(-z) - 0.5f;
                lw_[t4] = -fexp_(w);
                a_[t4] = fsigmoid_(a0v[t4] + aa[t4][i]);
                rr[t4] = bf2f(XSB[j * XSB_LD + cl]); const float k = bf2f(XSB[j * XSB_LD + 1024 + cl]); vv[t4] = bf2f(XSB[j * XSB_LD + 2048 + cl]);
                kkr[t4] = k * kkv[t4]; ss += kkr[t4] * kkr[t4];
                km[t4] = k * (1.f + (a_[t4] - 1.f) * kav[t4]); bs += rr[t4] * km[t4] * rkv[t4]; }
            ss += dppf<0xB1>(ss); ss += dppf<0x4E>(ss); ss += dppf<0x141>(ss); ss += dppf<0x140>(ss);
            bs += dppf<0xB1>(bs); bs += dppf<0x4E>(bs); bs += dppf<0x141>(bs); bs += dppf<0x140>(bs);
            const float rn = __builtin_amdgcn_rsqf(fmaxf(ss, 1e-24f));
#pragma unroll
            for (int t4 = 0; t4 < 4; ++t4) { const int c = head * 64 + 16 * t4 + n16; const float kk = kkr[t4] * rn;
                ((bf16*)(SC + 0 * SS))[m * 1024 + c] = (unsigned short)(pk2(kk, 0.f) & 0xffffu); SC[1 * SS + m * 1024 + c] = fexp_(lw_[t4]); SC[3 * SS + m * 1024 + c] = lw_[t4];
                ((unsigned*)(SC + 2 * SS))[m * 1024 + head * 64 + n16 * 4 + t4] = pk2(-kk * a_[t4], km[t4]);
                ((bf16*)(SC + 4 * SS))[m * 1024 + c] = (unsigned short)(pk2(rr[t4], 0.f) & 0xffffu); SC[5 * SS + m * 1024 + c] = vv[t4];
                GG[m * 1024 + c] = ag[t4][i]; }
            if (n16 == 0) BON[m * 16 + head] = bs;
        }
    }
}

DI void phase_b(const Ctx& C, int l, int lq) {
    const int tid = C.tid;
    const bf16* P = wsp<bf16>(C, WS_PROJ);
    LAS int* qslot = (LAS int*)(C.lds + MISC_OFF + 64);
    for (;;) {
        __syncthreads();
        if (tid == 0) *qslot = (int)atomicAdd(C.ctl + CW_QUEUE + 64 * (16 + lq), 1u);
        __syncthreads();
        const int it = *qslot;
        if (it >= PB_ITEMS) break;
        int r = it;
        if (r < PB_NRW) { rwkv_pre_item(C, l, r); continue; }
        r -= PB_NRW;
        if (r < PB_NPOOL) {
            const int b = r >> 6, n = r & 63, kv = tid >> 8, kvh = (tid >> 6) & 3, d = tid & 63;
            const float* src = C.out + O_CMP_P + ((size_t)l * NTP + b * 2048 + 32 * n) * 512 + tid;
            const float* w = C.inp(20) + (l * 2 + kv) * 32;
            float acc = 0.f, pr_[32];
#pragma unroll
            for (int rr = 0; rr < 32; ++rr) pr_[rr] = src[(size_t)rr * 512];
#pragma unroll
            for (int rr = 0; rr < 32; ++rr) acc += w[rr] * pr_[rr];
            const unsigned short hb = (unsigned short)(pk2(acc, 0.f) & 0xffffu);
            if (kv == 0) wsp<bf16>(C, WS_KCB)[((size_t)(b * 4 + kvh) * 64 + n) * 64 + d] = hb;
            else wsp<bf16>(C, WS_VCBT)[((size_t)(b * 4 + kvh) * 64 + d) * 64 + n] = hb;
            continue;
        }
        r -= PB_NPOOL;
        {
            const int which = r >> 9, b = (r >> 7) & 3, kvh = (r >> 5) & 3, tb = r & 31, d = tid & 63, tq = tid >> 6;
            const bf16* src = P + (size_t)(b * 2048 + 64 * tb + 8 * tq) * PLD + (which ? VW_OFF : VS_OFF) + kvh * 64 + d;
            unsigned short e[8];
#pragma unroll
            for (int i = 0; i < 8; ++i) e[i] = src[(size_t)i * PLD];
            v4u o; o.x = e[0] | ((unsigned)e[1] << 16); o.y = e[2] | ((unsigned)e[3] << 16); o.z = e[4] | ((unsigned)e[5] << 16); o.w = e[6] | ((unsigned)e[7] << 16);
            *(v4u*)(wsp<bf16>(C, which ? WS_VTW : WS_VTS) + (((size_t)(b * 4 + kvh) * 32 + tb) * 64 + d) * 64 + 8 * tq) = o;
            { const int row = tid >> 3, ch = tid & 7;
              const v4u kv_ = *(const v4u*)(P + (size_t)(b * 2048 + 64 * tb + row) * PLD + (which ? KW_OFF : KS_OFF) + kvh * 64 + ch * 8);
              *(v4u*)(wsp<bf16>(C, which ? WS_KWC : WS_KSC) + ((size_t)(b * 4 + kvh) * 2048 + 64 * tb + row) * 64 + ch * 8) = kv_; }
        }
    }
    __syncthreads();
}

#define MFMA16(a, b, c) __builtin_amdgcn_mfma_f32_16x16x32_bf16((a), (b), (c), 0, 0, 0)
DI void scan_head(const Ctx& C, int l, int row0, int T, int h, const float* S0, float* Sout) {
    const int tid = C.tid, lane = C.lane, wave = C.wave;
    LAS f32x4* D4 = (LAS f32x4*)C.lds;
    LAS v4u* BK4 = (LAS v4u*)(C.lds + 8192);
    LAS f32x4* V4 = (LAS f32x4*)(C.lds + 16384);
    LAS v4u* R16 = (LAS v4u*)(C.lds + 24576);
    LAS v4u* KK16 = (LAS v4u*)(C.lds + 28672);
    LAS float* YB = (LAS float*)(C.lds + 33280);
    const unsigned char* SCb = C.ws + WS_SC;
    const bf16* SCKK = (const bf16*)SCb; const float* SCD = (const float*)(SCb + SC_STRIDE); const unsigned* SCBK = (const unsigned*)(SCb + 2 * SC_STRIDE);
    const bf16* SCR = (const bf16*)(SCb + 4 * SC_STRIDE); const float* SCV = (const float*)(SCb + 5 * SC_STRIDE);
    const float* GG = wsp<float>(C, WS_GG); const float* BON = wsp<float>(C, WS_BON);
    bf16* MIX = wsp<bf16>(C, WS_MIX);
    const int n = lane & 15, rq = lane >> 4, v0 = 16 * (wave & 3); const bool act = wave < 4;
    f32x4 acc[4];
#pragma unroll
    for (int kt = 0; kt < 4; ++kt) acc[kt] = (act && S0) ? *(const f32x4*)(S0 + (v0 + n) * 64 + 16 * kt + 4 * rq) : (f32x4){0.f, 0.f, 0.f, 0.f};
    const int nch = (T + 31) >> 5;
    f32x4 pD, pV; v4u pBK, pRK, pK2;
    const v4u z4 = {0u, 0u, 0u, 0u};
#define SCAN_PREFETCH(cc) do { { const int step = (cc) * 32 + (tid >> 4), f4 = tid & 15; const size_t o = (size_t)(row0 + step) * 1024 + h * 64 + f4 * 4; const bool ok = step < T; \
            pD = ok ? *(const f32x4*)(SCD + o) : (f32x4){0.f, 0.f, 0.f, 0.f}; pV = ok ? *(const f32x4*)(SCV + o) : (f32x4){0.f, 0.f, 0.f, 0.f}; pBK = ok ? *(const v4u*)(SCBK + o) : z4; } \
        { const int i2 = tid & 255, step = (cc) * 32 + (i2 >> 3); const size_t o = (size_t)(row0 + step) * 1024 + h * 64 + (i2 & 7) * 8; pRK = step < T ? *(const v4u*)((tid < 256 ? SCR : SCKK) + o) : z4; } \
        { const int step = (cc) * 32 + 32; const size_t o = (size_t)(row0 + step) * 1024 + h * 64 + (tid & 7) * 8; pK2 = (tid < 8 && step < T) ? *(const v4u*)(SCKK + o) : z4; } } while (0)
    SCAN_PREFETCH(0);
    const float gng = C.inp(18)[l * 1024 + h * 64 + lane], gnb = C.inp(19)[l * 1024 + h * 64 + lane];
    float sk = 0.f;
    struct StepOps { f32x4 d[4]; v4u bk; float vt; v2u a[4]; };
#define SCAN_LD(o, st_) do { _Pragma("unroll") for (int kt = 0; kt < 4; ++kt) (o).d[kt] = D4[(st_) * 16 + 4 * kt + rq]; (o).bk = BK4[(st_) * 16 + n]; (o).vt = ((const LAS float*)V4)[(st_) * 64 + v0 + n]; \
        const LAS unsigned char* src_ = (n & 3) == 1 ? (const LAS unsigned char*)KK16 + ((st_) + 1) * 128 : (const LAS unsigned char*)R16 + (st_) * 128; \
        (o).a[0] = *(const LAS v2u*)(src_ + 8 * rq); (o).a[1] = *(const LAS v2u*)(src_ + 32 + 8 * rq); (o).a[2] = *(const LAS v2u*)(src_ + 64 + 8 * rq); (o).a[3] = *(const LAS v2u*)(src_ + 96 + 8 * rq); } while (0)
#define SCAN_YSK(a0_, a1_, a2_, a3_, yv, skv) do { \
        v4u h0, h1; h0.x = pk2(acc[0][0], acc[0][1]); h0.y = pk2(acc[0][2], acc[0][3]); h0.z = pk2(acc[1][0], acc[1][1]); h0.w = pk2(acc[1][2], acc[1][3]); \
        h1.x = pk2(acc[2][0], acc[2][1]); h1.y = pk2(acc[2][2], acc[2][3]); h1.z = pk2(acc[3][0], acc[3][1]); h1.w = pk2(acc[3][2], acc[3][3]); \
        const v4u f0 = {(a0_).x, (a0_).y, (a1_).x, (a1_).y}, f1 = {(a2_).x, (a2_).y, (a3_).x, (a3_).y}; \
        f32x4 d2 = MFMA16(__builtin_bit_cast(bf16x8, f0), __builtin_bit_cast(bf16x8, h0), ((f32x4){0.f, 0.f, 0.f, 0.f})); \
        d2 = MFMA16(__builtin_bit_cast(bf16x8, f1), __builtin_bit_cast(bf16x8, h1), d2); yv = d2[0]; skv = d2[1]; } while (0)
    for (int c = 0; c < nch; ++c) {
        __syncthreads();
        D4[tid] = pD; BK4[tid] = pBK; V4[tid] = pV;
        if (tid < 256) R16[tid] = pRK; else KK16[tid - 256] = pRK;
        if (tid < 8) KK16[256 + tid] = pK2;
        __syncthreads();
        if (c + 1 < nch) SCAN_PREFETCH(c + 1);
        const int nst = (T - c * 32) < 32 ? (T - c * 32) : 32;
        float gq[4], bq[4];
#pragma unroll
        for (int qq = 0; qq < 4; ++qq) { const int st = wave * 4 + qq; const size_t m = (size_t)row0 + c * 32 + (st < nst ? st : 0);
            gq[qq] = GG[m * 1024 + h * 64 + lane]; bq[qq] = BON[m * 16 + h]; }
        if (act) {
            if (c == 0) {
                const LAS unsigned char* s0 = (const LAS unsigned char*)KK16;
                const v2u k0 = *(const LAS v2u*)(s0 + 8 * rq), k1 = *(const LAS v2u*)(s0 + 32 + 8 * rq), k2 = *(const LAS v2u*)(s0 + 64 + 8 * rq), k3 = *(const LAS v2u*)(s0 + 96 + 8 * rq);
                float yd; SCAN_YSK(k0, k1, k2, k3, sk, yd); (void)yd;
            }
            StepOps cur; SCAN_LD(cur, 0);
#pragma unroll 2
            for (int st = 0; st < nst; ++st) {
                StepOps nx; { const int sn = st + 1 < 32 ? st + 1 : 31; SCAN_LD(nx, sn); }
#pragma unroll
                for (int kt = 0; kt < 4; ++kt) acc[kt] = acc[kt] * cur.d[kt];
                v4u b2 = z4; b2.x = rq == 0 ? pk2(sk, cur.vt) : 0u;
#pragma unroll
                for (int kt = 0; kt < 4; ++kt) { v4u a2 = z4; a2.x = rq == 0 ? cur.bk[kt] : 0u; acc[kt] = MFMA16(__builtin_bit_cast(bf16x8, a2), __builtin_bit_cast(bf16x8, b2), acc[kt]); }
                float y; SCAN_YSK(cur.a[0], cur.a[1], cur.a[2], cur.a[3], y, sk);
                if (rq == 0) YB[st * 64 + v0 + n] = y;
                cur = nx;
            }
        }
        __syncthreads();
#pragma unroll
        for (int qq = 0; qq < 4; ++qq) {
            const int st = wave * 4 + qq;
            if (st < nst) {
                const size_t m = (size_t)row0 + c * 32 + st;
                const float y = YB[st * 64 + lane];
                const float mean = wave_sum(y) * (1.f / 64.f);
                const float dv = y - mean;
                const float var = wave_sum(dv * dv) * (1.f / 64.f);
                const float yn = dv * __builtin_amdgcn_rsqf(var + GN_EPS) * gng + gnb;
                const float o = (yn + bq[qq] * ((const LAS float*)V4)[st * 64 + lane]) * gq[qq];
                MIX[m * DM + h * 64 + lane] = (unsigned short)(pk2(o, 0.f) & 0xffffu);
            }
        }
    }
#undef SCAN_PREFETCH
#undef SCAN_LD
#undef SCAN_YSK
    if (act) {
#pragma unroll
        for (int kt = 0; kt < 4; ++kt) *(f32x4*)(Sout + (v0 + n) * 64 + 16 * kt + 4 * rq) = acc[kt];
    }
}

constexpr int CST = 144, CBUF = 64 * CST;
DI void cmm(const LAS unsigned char* L, const LAS unsigned char* Rt, f32x4 (&acc)[2], int tm, int tn0, int n16, int kq) {
#pragma unroll
    for (int ks = 0; ks < 2; ++ks) {
        const bf16x8 a = *(const LAS bf16x8*)(L + (16 * tm + n16) * CST + (32 * ks + 8 * kq) * 2);
#pragma unroll
        for (int j = 0; j < 2; ++j) { const bf16x8 bq = *(const LAS bf16x8*)(Rt + (16 * (tn0 + j) + n16) * CST + (32 * ks + 8 * kq) * 2); acc[j] = MFMA16(a, bq, acc[j]); }
    }
}
template <int MODE> DI void cst_T(LAS unsigned char* X, const f32x4 (&acc)[2], int tm, int tn0, int n16, int rq) {
#pragma unroll
    for (int j = 0; j < 2; ++j) { const int n = 16 * (tn0 + j) + n16, m0 = 16 * tm + 4 * rq; float v[4];
#pragma unroll
        for (int i = 0; i < 4; ++i) { const int col = m0 + i; const bool keep = MODE == 0 ? true : (MODE == 1 ? col < n : (MODE == 2 ? col <= n : col > n)); v[i] = keep ? acc[j][i] : 0.f; }
        *(LAS v2u*)(X + n * CST + m0 * 2) = (v2u){pk2(v[0], v[1]), pk2(v[2], v[3])}; }
}
template <int mode> DI void chunk_head(const Ctx& C, int l, int b, int h, float* Sout, int part) {
    const int tid = C.tid, lane = C.lane, wave = C.wave;
    const int n16 = lane & 15, rq = lane >> 4, tm = wave >> 1, tn0 = (wave & 1) * 2;
    LAS unsigned char* const B0 = C.lds;
#define CB(i) (B0 + (i) * CBUF)
    enum { I_BH = 0, I_BHT = 1, I_AH = 2, I_KH = 3, I_RH = 4, I_ATT = 5, I_KTT = 6, I_VT = 7, I_A1 = 8, I_A1T = 9, I_A2 = 10, I_M1 = 11, I_M2 = 12, I_H0T = 13 };
    LAS float* SEG = (LAS float*)(B0 + 14 * CBUF);
    LAS float* YB = (LAS float*)CB(8);
    const unsigned char* SCb = C.ws + WS_SC;
    const bf16* SCKK = (const bf16*)SCb; const unsigned* SCBK = (const unsigned*)(SCb + 2 * SC_STRIDE); const float* SCLW = (const float*)(SCb + 3 * SC_STRIDE);
    const bf16* SCR = (const bf16*)(SCb + 4 * SC_STRIDE); const float* SCV = (const float*)(SCb + 5 * SC_STRIDE);
    const float* GG = wsp<float>(C, WS_GG); const float* BON = wsp<float>(C, WS_BON);
    bf16* MIX = wsp<bf16>(C, WS_MIX);
    const size_t m0 = (size_t)b * 2048;
    const int pk = tid & 63, seg = tid >> 6, bkidx = (pk & 15) * 4 + (pk >> 4);
    const f32x4 zf = {0.f, 0.f, 0.f, 0.f};
    f32x4 accH[2] = {zf, zf};
    __syncthreads();
    for (int i = tid; i < CBUF / 4; i += NTHREADS) ((LAS unsigned*)CB(I_H0T))[i] = 0u;
    float plw[8], pv[8]; unsigned pbk[8]; unsigned short pkk[8], pr[8];
#define CH_LOAD(cc) do { _Pragma("unroll") for (int i = 0; i < 8; ++i) { const size_t o = (m0 + (cc) * 64 + seg * 8 + i) * 1024 + h * 64; \
        plw[i] = SCLW[o + pk]; pkk[i] = SCKK[o + pk]; pbk[i] = SCBK[o + bkidx]; pr[i] = SCR[o + pk]; pv[i] = SCV[o + pk]; } } while (0)
    unsigned char* const OPS = C.ws + WS_OPS + (size_t)((b * 16 + h) * 24) * OPS_BYTES;
    unsigned* const flag = C.ctl + CW_FLAG + 64 * ((l * 64 + b * 16 + h) * 4);
    const int c_lo = mode ? 16 * part : 0, c_hi = mode ? 16 * part + 16 : 16;
    CH_LOAD(c_lo);
    const float gng = C.inp(18)[l * 1024 + h * 64 + lane], gnb = C.inp(19)[l * 1024 + h * 64 + lane];
    for (int c = c_lo; c < c_hi; ++c) {

        float gq[8], bq[8], vq[8];
#pragma unroll
        for (int i = 0; i < 8; ++i) { const size_t m = m0 + c * 64 + 8 * wave + i; gq[i] = GG[m * 1024 + h * 64 + lane]; bq[i] = BON[m * 16 + h]; vq[i] = SCV[m * 1024 + h * 64 + lane]; }
        float cs[8];
        { float run = 0.f;
#pragma unroll
          for (int i = 0; i < 8; ++i) { run += plw[i]; cs[i] = run; } }
        __syncthreads();
        SEG[seg * 64 + pk] = cs[7];
        __syncthreads();
        float off = 0.f, tot = 0.f;
#pragma unroll
        for (int s = 0; s < 8; ++s) { const float sv = SEG[s * 64 + pk]; tot += sv; off += s < seg ? sv : 0.f; }
        { unsigned short bt[8], at[8], kt[8], vt[8];
#pragma unroll
          for (int i = 0; i < 8; ++i) { const float csv = cs[i] + off;
              const float eP = __expf(csv), eM = __expf(-csv), ePm = __expf(csv - plw[i]), eQ = __expf(tot - csv);
              const float kkf = bf2f(pkk[i]), nb = bflo(pbk[i]), kmf = bfhi(pbk[i]), rf = bf2f(pr[i]);
              const int t = seg * 8 + i;
              const unsigned short vb = (unsigned short)(pk2(kkf * ePm, 0.f) & 0xffffu);
              *(LAS unsigned short*)(CB(I_BH) + t * CST + pk * 2) = vb; bt[i] = vb;
              *(LAS unsigned short*)(CB(I_AH) + t * CST + pk * 2) = (unsigned short)(pk2(nb * eM, 0.f) & 0xffffu);
              *(LAS unsigned short*)(CB(I_KH) + t * CST + pk * 2) = (unsigned short)(pk2(kmf * eM, 0.f) & 0xffffu);
              *(LAS unsigned short*)(CB(I_RH) + t * CST + pk * 2) = (unsigned short)(pk2(rf * eP, 0.f) & 0xffffu);
              at[i] = (unsigned short)(pk2(nb * eQ, 0.f) & 0xffffu); kt[i] = (unsigned short)(pk2(kmf * eQ, 0.f) & 0xffffu); vt[i] = (unsigned short)(pk2(pv[i], 0.f) & 0xffffu); }
#define PK8(a) ((v4u){(unsigned)a[0] | ((unsigned)a[1] << 16), (unsigned)a[2] | ((unsigned)a[3] << 16), (unsigned)a[4] | ((unsigned)a[5] << 16), (unsigned)a[6] | ((unsigned)a[7] << 16)})
          *(LAS v4u*)(CB(I_BHT) + pk * CST + seg * 16) = PK8(bt); *(LAS v4u*)(CB(I_ATT) + pk * CST + seg * 16) = PK8(at);
          *(LAS v4u*)(CB(I_KTT) + pk * CST + seg * 16) = PK8(kt); *(LAS v4u*)(CB(I_VT) + pk * CST + seg * 16) = PK8(vt);
#undef PK8
        }
        if (c + 1 < c_hi) CH_LOAD(c + 1);
        __syncthreads();
        f32x4 accT[2];
        { f32x4 a_[2];
          a_[0] = zf; a_[1] = zf; cmm(CB(I_BH), CB(I_AH), a_, tm, tn0, n16, rq); cst_T<3>(CB(I_A1T), a_, tm, tn0, n16, rq);
          a_[0] = zf; a_[1] = zf; cmm(CB(I_AH), CB(I_BH), a_, tm, tn0, n16, rq); cst_T<1>(CB(I_A1), a_, tm, tn0, n16, rq);
#pragma unroll
          for (int j = 0; j < 2; ++j)
#pragma unroll
              for (int i = 0; i < 4; ++i) { const int m = 16 * tm + 4 * rq + i, n = 16 * (tn0 + j) + n16; accT[j][i] = m < n ? a_[j][i] : (m == n ? 1.f : 0.f); }
          a_[0] = zf; a_[1] = zf; cmm(CB(I_KH), CB(I_BH), a_, tm, tn0, n16, rq); cst_T<1>(CB(I_A2), a_, tm, tn0, n16, rq);
          a_[0] = zf; a_[1] = zf; cmm(CB(I_AH), CB(I_RH), a_, tm, tn0, n16, rq); cst_T<2>(CB(I_M1), a_, tm, tn0, n16, rq);
          a_[0] = zf; a_[1] = zf; cmm(CB(I_KH), CB(I_RH), a_, tm, tn0, n16, rq); cst_T<2>(CB(I_M2), a_, tm, tn0, n16, rq); }
        __syncthreads();
        { int ip = I_A1, ipt = I_A1T, in_ = I_AH, int_ = I_KH;
#pragma unroll 1
          for (int lev = 0; lev < 5; ++lev) {
              cst_T<0>(CB(I_BH), accT, tm, tn0, n16, rq);
              f32x4 a_[2];
              a_[0] = zf; a_[1] = zf; cmm(CB(ip), CB(ipt), a_, tm, tn0, n16, rq); cst_T<0>(CB(int_), a_, tm, tn0, n16, rq);
              a_[0] = zf; a_[1] = zf; cmm(CB(ipt), CB(ip), a_, tm, tn0, n16, rq); cst_T<0>(CB(in_), a_, tm, tn0, n16, rq);
              __syncthreads();
              cmm(CB(int_), CB(I_BH), accT, tm, tn0, n16, rq);
              __syncthreads();
              const int t0 = ip, t1 = ipt; ip = in_; ipt = int_; in_ = t0; int_ = t1;
          }
          cst_T<0>(CB(I_BH), accT, tm, tn0, n16, rq); }
        { f32x4 a_[2];
          a_[0] = zf; a_[1] = zf; cmm(CB(I_A2), CB(I_VT), a_, tm, tn0, n16, rq); cst_T<0>(CB(8), a_, tm, tn0, n16, rq);
          __syncthreads();
          a_[0] = zf; a_[1] = zf; cmm(CB(I_BH), CB(I_BHT), a_, tm, tn0, n16, rq); cst_T<0>(CB(9), a_, tm, tn0, n16, rq);
          a_[0] = zf; a_[1] = zf; cmm(CB(I_BH), CB(8), a_, tm, tn0, n16, rq); cst_T<0>(CB(2), a_, tm, tn0, n16, rq); }
        __syncthreads();
        f32x4 accE[2] = {zf, zf}, accY[2] = {zf, zf};
        { f32x4 a_[2];
          a_[0] = zf; a_[1] = zf; cmm(CB(9), CB(I_ATT), a_, tm, tn0, n16, rq);
#pragma unroll
          for (int j = 0; j < 2; ++j) { const int n = 16 * (tn0 + j) + n16, mm0 = 16 * tm + 4 * rq; float pc = 0.f;
#pragma unroll
              for (int s = 0; s < 8; ++s) pc += SEG[s * 64 + n];
              pc = __expf(pc); float v[4];
#pragma unroll
              for (int i = 0; i < 4; ++i) v[i] = a_[j][i] + (mm0 + i == n ? pc : 0.f);
              *(LAS v2u*)(CB(3) + n * CST + mm0 * 2) = (v2u){pk2(v[0], v[1]), pk2(v[2], v[3])}; }
          cmm(CB(I_ATT), CB(2), accE, tm, tn0, n16, rq); cmm(CB(I_KTT), CB(I_VT), accE, tm, tn0, n16, rq);
          a_[0] = zf; a_[1] = zf; cmm(CB(9), CB(I_M1), a_, tm, tn0, n16, rq);
#pragma unroll
          for (int j = 0; j < 2; ++j) { const int n = 16 * (tn0 + j) + n16, mm0 = 16 * tm + 4 * rq;
              const v2u rh = *(const LAS v2u*)(CB(I_RH) + n * CST + mm0 * 2);
              *(LAS v2u*)(CB(10) + n * CST + mm0 * 2) = (v2u){pk2(a_[j][0] + bflo(rh.x), a_[j][1] + bfhi(rh.x)), pk2(a_[j][2] + bflo(rh.y), a_[j][3] + bfhi(rh.y))}; }
          cmm(CB(I_M1), CB(2), accY, tm, tn0, n16, rq); cmm(CB(I_M2), CB(I_VT), accY, tm, tn0, n16, rq); }
        __syncthreads();
        if (mode == 1) {
            unsigned char* ob = OPS + (size_t)(c - 16) * OPS_BYTES;
            for (int i = tid; i < 2 * CBUF / 16; i += NTHREADS) ((v4u*)ob)[i] = *(const LAS v4u*)((i < CBUF / 16 ? CB(3) : CB(10)) + (i < CBUF / 16 ? i : i - CBUF / 16) * 16);
            ((f32x4*)(ob + 2 * CBUF))[tid * 2] = accE[0]; ((f32x4*)(ob + 2 * CBUF))[tid * 2 + 1] = accE[1];
            ((f32x4*)(ob + 2 * CBUF + 16384))[tid * 2] = accY[0]; ((f32x4*)(ob + 2 * CBUF + 16384))[tid * 2 + 1] = accY[1];
            continue;
        }
        cmm(CB(3), CB(I_H0T), accE, tm, tn0, n16, rq); cmm(CB(10), CB(I_H0T), accY, tm, tn0, n16, rq);
        __syncthreads();
        accH[0] = accE[0]; accH[1] = accE[1];
        cst_T<0>(CB(I_H0T), accH, tm, tn0, n16, rq);
#pragma unroll
        for (int j = 0; j < 2; ++j)
#pragma unroll
            for (int i = 0; i < 4; ++i) YB[(16 * tm + 4 * rq + i) * 64 + 16 * (tn0 + j) + n16] = accY[j][i];
        __syncthreads();
#pragma unroll
        for (int i = 0; i < 8; ++i) {
            const int t = 8 * wave + i; const size_t m = m0 + c * 64 + t;
            const float y = YB[t * 64 + lane];
            const float mean = wave_sum(y) * (1.f / 64.f);
            const float dv = y - mean;
            const float var = wave_sum(dv * dv) * (1.f / 64.f);
            const float yn = dv * __builtin_amdgcn_rsqf(var + GN_EPS) * gng + gnb;
            const float o = (yn + bq[i] * vq[i]) * gq[i];
            MIX[m * DM + h * 64 + lane] = (unsigned short)(pk2(o, 0.f) & 0xffffu);
        }
    }
    if (mode == 0) for (int c = 16; c < 32; ++c) {
            float gq[8], bq[8], vq[8];
#pragma unroll
            for (int i = 0; i < 8; ++i) { const size_t m = m0 + c * 64 + 8 * wave + i; gq[i] = GG[m * 1024 + h * 64 + lane]; bq[i] = BON[m * 16 + h]; vq[i] = SCV[m * 1024 + h * 64 + lane]; }
            if ((c & 15) == 0) {
                if (tid == 0) { unsigned sp = 0; while (__hip_atomic_load(flag + 64 * (c >> 4), __ATOMIC_RELAXED, __HIP_MEMORY_SCOPE_AGENT) == 0u) { __builtin_amdgcn_s_sleep(8); if (++sp > (1u << 22)) break; }
                    __builtin_amdgcn_fence(__ATOMIC_ACQUIRE, "agent"); asm volatile("s_waitcnt vmcnt(0)" ::: "memory"); }
            }
            __syncthreads();
            const unsigned char* ob = OPS + (size_t)(c - 16) * OPS_BYTES;
            for (int i = tid; i < 2 * CBUF / 16; i += NTHREADS) { const v4u w = ((const v4u*)ob)[i]; *(LAS v4u*)((i < CBUF / 16 ? CB(3) : CB(10)) + (i < CBUF / 16 ? i : i - CBUF / 16) * 16) = w; }
            f32x4 accE[2], accY[2];
            accE[0] = ((const f32x4*)(ob + 2 * CBUF))[tid * 2]; accE[1] = ((const f32x4*)(ob + 2 * CBUF))[tid * 2 + 1];
            accY[0] = ((const f32x4*)(ob + 2 * CBUF + 16384))[tid * 2]; accY[1] = ((const f32x4*)(ob + 2 * CBUF + 16384))[tid * 2 + 1];
            __syncthreads();
            cmm(CB(3), CB(I_H0T), accE, tm, tn0, n16, rq); cmm(CB(10), CB(I_H0T), accY, tm, tn0, n16, rq);
            __syncthreads();
            accH[0] = accE[0]; accH[1] = accE[1];
            cst_T<0>(CB(I_H0T), accH, tm, tn0, n16, rq);
#pragma unroll
            for (int j = 0; j < 2; ++j)
#pragma unroll
                for (int i = 0; i < 4; ++i) YB[(16 * tm + 4 * rq + i) * 64 + 16 * (tn0 + j) + n16] = accY[j][i];
            __syncthreads();
#pragma unroll
            for (int i = 0; i < 8; ++i) {
                const int t = 8 * wave + i; const size_t m = m0 + c * 64 + t;
                const float y = YB[t * 64 + lane];
                const float mean = wave_sum(y) * (1.f / 64.f);
                const float dv = y - mean;
                const float var = wave_sum(dv * dv) * (1.f / 64.f);
                const float yn = dv * __builtin_amdgcn_rsqf(var + GN_EPS) * gng + gnb;
                const float o = (yn + bq[i] * vq[i]) * gq[i];
                MIX[m * DM + h * 64 + lane] = (unsigned short)(pk2(o, 0.f) & 0xffffu);
            }
    }
#undef CH_LOAD
#undef CB
    if (mode == 1) {
        asm volatile("s_waitcnt vmcnt(0)" ::: "memory");
        __syncthreads();
        if (tid == 0) { __builtin_amdgcn_fence(__ATOMIC_RELEASE, "agent"); asm volatile("s_waitcnt vmcnt(0)" ::: "memory"); __hip_atomic_store(flag + 64 * part, 1u, __ATOMIC_RELAXED, __HIP_MEMORY_SCOPE_AGENT); }
        return;
    }
#pragma unroll
    for (int j = 0; j < 2; ++j) *(f32x4*)(Sout + (size_t)(16 * (tn0 + j) + n16) * 64 + 16 * tm + 4 * rq) = accH[j];
}

#define MFMA32(a, b, c) __builtin_amdgcn_mfma_f32_32x32x16_bf16((a), (b), (c), 0, 0, 0)
DI bf16x8 pack8(const f32x16& p, int s) {
    v4u o; o.x = pk2(p[8 * s], p[8 * s + 1]); o.y = pk2(p[8 * s + 2], p[8 * s + 3]); o.z = pk2(p[8 * s + 4], p[8 * s + 5]); o.w = pk2(p[8 * s + 6], p[8 * s + 7]);
    return __builtin_bit_cast(bf16x8, o);
}
DI bf16x8 ld_vt(const bf16* p) {
    const v2u a = *(const v2u*)p, b = *(const v2u*)(p + 8);
    v4u o; o.x = a.x; o.y = a.y; o.z = b.x; o.w = b.y; return __builtin_bit_cast(bf16x8, o);
}
constexpr int KT_STRIDE = 144, VTT_STRIDE = 136, KT_BYTES = 64 * KT_STRIDE, TILE_BYTES = KT_BYTES + 64 * VTT_STRIDE, TILE_OFF = 74752;
struct TileRegs { v4u k, v; };
DI TileRegs tile_load(const bf16* kbase, size_t kstride, const bf16* vbase, size_t vstride, int tid) {
    TileRegs r; const int row = tid >> 3, ch = tid & 7;
    r.k = *(const v4u*)(kbase + (size_t)row * kstride + ch * 8); r.v = *(const v4u*)(vbase + (size_t)row * vstride + ch * 8); return r;
}
DI void tile_store(LAS unsigned char* buf, const TileRegs& r, int tid) {
    const int row = tid >> 3, ch = tid & 7;
    *(LAS v4u*)(buf + row * KT_STRIDE + ch * 16) = r.k;
    *(LAS v2u*)(buf + KT_BYTES + row * VTT_STRIDE + ch * 16) = (v2u){r.v.x, r.v.y}; *(LAS v2u*)(buf + KT_BYTES + row * VTT_STRIDE + ch * 16 + 8) = (v2u){r.v.z, r.v.w};
}
DI bf16x8 ld_vt_lds(const LAS unsigned char* p) {
    const v2u a = *(const LAS v2u*)p, b = *(const LAS v2u*)(p + 16);
    v4u o; o.x = a.x; o.y = a.y; o.z = b.x; o.w = b.y; return __builtin_bit_cast(bf16x8, o);
}
#define ATT_BLOCK(EDGE, BUF, KEYBLK0, MINE, VALID_EXPR) do { \
    const float bias_ = (MINE) ? 0.f : NEG_BIG; \
    _Pragma("unroll 1") for (int tile = 0; tile < 2; ++tile) { const int key0 = (KEYBLK0) + tile * 32; (void)key0; \
        f32x16 a_ = zero16; \
        _Pragma("unroll") for (int s = 0; s < 4; ++s) { const bf16x8 kf = *(const LAS bf16x8*)((BUF) + (tile * 32 + q) * KT_STRIDE + 32 * s + 16 * hi); a_ = MFMA32(kf, qf[s], a_); } \
        float tm = NEG_BIG; \
        if (EDGE) { _Pragma("unroll") for (int i = 0; i < 16; ++i) { const int key = key0 + crow(i, hi); const bool ok = (MINE) && (VALID_EXPR); a_[i] = ok ? a_[i] * SCL2 : NEG_BIG; tm = fmaxf(tm, a_[i]); } } \
        else { _Pragma("unroll") for (int i = 0; i < 16; ++i) { a_[i] = a_[i] * SCL2 + bias_; tm = fmaxf(tm, a_[i]); } } \
        tm = fmaxf(tm, __shfl_xor(tm, 32)); \
        const float mn = fmaxf(mrun, tm); const float sc_ = __builtin_amdgcn_exp2f(mrun - mn); \
        float ps = 0.f; \
        if (EDGE) { _Pragma("unroll") for (int i = 0; i < 16; ++i) { const float p_ = a_[i] > -1e29f ? __builtin_amdgcn_exp2f(a_[i] - mn) : 0.f; a_[i] = p_; ps += p_; } } \
        else { _Pragma("unroll") for (int i = 0; i < 16; ++i) { const float p_ = __builtin_amdgcn_exp2f(a_[i] - mn); a_[i] = p_; ps += p_; } } \
        ps += __shfl_xor(ps, 32); \
        lrun = lrun * sc_ + ps; mrun = mn; \
        _Pragma("unroll") for (int i = 0; i < 16; ++i) { oa[0][i] *= sc_; oa[1][i] *= sc_; } \
        _Pragma("unroll") for (int s = 0; s < 2; ++s) { const bf16x8 pb = pack8(a_, s); \
            oa[0] = MFMA32(ld_vt_lds((BUF) + KT_BYTES + q * VTT_STRIDE + (tile * 32 + 16 * s + 4 * hi) * 2), pb, oa[0]); \
            oa[1] = MFMA32(ld_vt_lds((BUF) + KT_BYTES + (32 + q) * VTT_STRIDE + (tile * 32 + 16 * s + 4 * hi) * 2), pb, oa[1]); } \
    } } while (0)
constexpr float SCL2 = 0.125f * 1.4426950408889634f;

DI void nsa_prompt_unit(const Ctx& C, int l, int b, int kvh, int qt, bool skipblk = false, bool skipcmp = false) {
    const int tid = C.tid, lane = C.lane, wave = C.wave;
    const int g = wave & 3, th = wave >> 2, q = lane & 31, hi = lane >> 5;
    LAS float* IMP = (LAS float*)C.lds;
    LAS float* IMPV = (LAS float*)(C.lds + 65536);
    LAS unsigned* SELM = (LAS unsigned*)(C.lds + 65536 + 8192);
    LAS unsigned char* TB = C.lds + TILE_OFF;
    const bf16* P = wsp<bf16>(C, WS_PROJ);
    const int tok = qt * 64 + th * 32 + q;
    const size_t m = (size_t)b * 2048 + tok;
    const int bk = b * 4 + kvh, head = kvh * 4 + g;
    f32x16 zero16;
#pragma unroll
    for (int i = 0; i < 16; ++i) zero16[i] = 0.f;
    bf16x8 qf[4];
#pragma unroll
    for (int s = 0; s < 4; ++s) qf[s] = *(const bf16x8*)(P + m * PLD + Q_OFF + head * 64 + 16 * s + 8 * hi);
    f32x16 out0 = zero16, out1 = zero16;
    const float g0 = sigmoidf_(bf2f(P[m * PLD + GL_OFF + head * 3 + 0])), g1 = sigmoidf_(bf2f(P[m * PLD + GL_OFF + head * 3 + 1])), g2 = sigmoidf_(bf2f(P[m * PLD + GL_OFF + head * 3 + 2]));
    TileRegs tr = tile_load(wsp<bf16>(C, WS_KCB) + (size_t)bk * 4096, 64, wsp<bf16>(C, WS_VCBT) + (size_t)bk * 4096, 64, tid);
    __syncthreads();
    tile_store(TB, tr, tid);
    __syncthreads();
    if (!skipcmp) {
    {
        f32x16 sc[2];
        const int nvalid = (tok + 1) >> 5;
        float mx = NEG_BIG;
#pragma unroll
        for (int tile = 0; tile < 2; ++tile) {
            f32x16 a_ = zero16;
#pragma unroll
            for (int s = 0; s < 4; ++s) { const bf16x8 kf = *(const LAS bf16x8*)(TB + (tile * 32 + q) * KT_STRIDE + 32 * s + 16 * hi); a_ = MFMA32(kf, qf[s], a_); }
#pragma unroll
            for (int i = 0; i < 16; ++i) { const int n = tile * 32 + crow(i, hi); a_[i] = n < nvalid ? a_[i] * 0.125f : NEG_BIG; mx = fmaxf(mx, a_[i]); }
            sc[tile] = a_;
        }
        mx = fmaxf(mx, __shfl_xor(mx, 32));
        float sum = 0.f;
#pragma unroll
        for (int tile = 0; tile < 2; ++tile)
#pragma unroll
            for (int i = 0; i < 16; ++i) { const float p_ = sc[tile][i] > -1e29f ? __expf(sc[tile][i] - mx) : 0.f; sc[tile][i] = p_; sum += p_; }
        sum += __shfl_xor(sum, 32);
        const float inv = nvalid > 0 ? 1.f / sum : 0.f;
        f32x16 oc0 = zero16, oc1 = zero16;
#pragma unroll
        for (int tile = 0; tile < 2; ++tile) {
#pragma unroll
            for (int i = 0; i < 16; ++i) sc[tile][i] *= inv;
#pragma unroll
            for (int i4 = 0; i4 < 4; ++i4) { f32x4 v = {sc[tile][4 * i4], sc[tile][4 * i4 + 1], sc[tile][4 * i4 + 2], sc[tile][4 * i4 + 3]};
                *(LAS f32x4*)(IMP + ((size_t)(g * 64 + th * 32 + q)) * 64 + tile * 32 + 8 * i4 + 4 * hi) = v; }
#pragma unroll
            for (int s = 0; s < 2; ++s) { const bf16x8 pb = pack8(sc[tile], s);
                oc0 = MFMA32(ld_vt_lds(TB + KT_BYTES + q * VTT_STRIDE + (tile * 32 + 16 * s + 4 * hi) * 2), pb, oc0);
                oc1 = MFMA32(ld_vt_lds(TB + KT_BYTES + (32 + q) * VTT_STRIDE + (tile * 32 + 16 * s + 4 * hi) * 2), pb, oc1); }
        }
#pragma unroll
        for (int i = 0; i < 16; ++i) { out0[i] = g0 * oc0[i]; out1[i] = g0 * oc1[i]; }
    }
    __syncthreads();
    {
        const int tokl = tid >> 3, jq = tid & 7;
        float v[4];
#pragma unroll
        for (int e = 0; e < 4; ++e) v[e] = 0.f;
#pragma unroll
        for (int gg = 0; gg < 4; ++gg) { const f32x4 a = *(const LAS f32x4*)(IMP + (size_t)(gg * 64 + tokl) * 64 + 8 * jq), bq = *(const LAS f32x4*)(IMP + (size_t)(gg * 64 + tokl) * 64 + 8 * jq + 4);
            v[0] += a[0] + a[1]; v[1] += a[2] + a[3]; v[2] += bq[0] + bq[1]; v[3] += bq[2] + bq[3]; }
        const int cur = qt;
#pragma unroll
        for (int e = 0; e < 4; ++e) { const int j = 4 * jq + e; const bool forced = (j == 0) | (j == cur) | (j == cur - 1); v[e] = j > cur ? -1.f : (forced ? 1e4f : v[e]); }
        *(LAS f32x4*)(IMPV + tokl * 32 + 4 * jq) = (f32x4){v[0], v[1], v[2], v[3]};
        __syncthreads();
        int rank[4] = {0, 0, 0, 0};
#pragma unroll
        for (int jj4 = 0; jj4 < 8; ++jj4) { const f32x4 o = *(const LAS f32x4*)(IMPV + tokl * 32 + 4 * jj4);
#pragma unroll
            for (int u = 0; u < 4; ++u) { const int jp = 4 * jj4 + u; const float ov = o[u];
#pragma unroll
                for (int e = 0; e < 4; ++e) { const int j = 4 * jq + e; rank[e] += (ov > v[e] || (ov == v[e] && jp < j)) ? 1 : 0; } } }
        unsigned bits = 0;
#pragma unroll
        for (int e = 0; e < 4; ++e) if (rank[e] < 16 && v[e] >= 0.f) bits |= 1u << (4 * jq + e);
        bits |= __shfl_xor(bits, 1); bits |= __shfl_xor(bits, 2); bits |= __shfl_xor(bits, 4);
        if (jq == 0) SELM[tokl] = bits;
        __syncthreads();
    }
    }
    if (skipcmp && tid < 64) SELM[tid] = 0xffffffffu;
    __syncthreads();
    const unsigned selm = SELM[th * 32 + q];
    unsigned uni;
    { unsigned u0 = SELM[lane];
#pragma unroll
      for (int o = 1; o < 64; o <<= 1) u0 |= __shfl_xor(u0, o);
      uni = __builtin_amdgcn_readfirstlane(u0); }
    {
        LAS float* PARK = (LAS float*)C.lds + wave * 2048 + lane;
#pragma unroll
        for (int i = 0; i < 16; ++i) { PARK[i * 64] = out0[i]; PARK[(16 + i) * 64] = out1[i]; }
        const bf16* KBs = wsp<bf16>(C, WS_KSC) + (size_t)bk * 2048 * 64; const bf16* KBw = wsp<bf16>(C, WS_KWC) + (size_t)bk * 2048 * 64;
        const bf16* VTs = wsp<bf16>(C, WS_VTS) + (size_t)bk * 32 * 4096; const bf16* VTw = wsp<bf16>(C, WS_VTW) + (size_t)bk * 32 * 4096;
        f32x16 oa[2] = {zero16, zero16}; float mrun = NEG_BIG, lrun = 0.f;
        unsigned rem = skipblk ? 1u : uni; int wj = skipblk ? qt : (qt > 8 ? qt - 8 : 0); bool folded = false;
#define NEXT_BLK(dst) do { if (rem) { dst = __builtin_ctz(rem); rem &= rem - 1; } else if (wj <= qt) { dst = wj | 256; ++wj; } else dst = -1; } while (0)
#define LOAD_BLK(tr_, d_) do { const int j_ = (d_) & 255; tr_ = ((d_) & 256) ? tile_load(KBw + (size_t)j_ * 4096, 64, VTw + (size_t)j_ * 4096, 64, tid) : tile_load(KBs + (size_t)j_ * 4096, 64, VTs + (size_t)j_ * 4096, 64, tid); } while (0)
#define FOLD(gate_) do { const float il_ = (gate_) / lrun; _Pragma("unroll") for (int i = 0; i < 16; ++i) { PARK[i * 64] += il_ * oa[0][i]; PARK[(16 + i) * 64] += il_ * oa[1][i]; } \
            oa[0] = zero16; oa[1] = zero16; mrun = NEG_BIG; lrun = 0.f; } while (0)
#define DO_BLK(d_, buf_) do { const int j_ = (d_) & 255; const bool win_ = ((d_) & 256) != 0; \
            if (win_ && !folded) { FOLD(g1); folded = true; } \
            const bool mine = win_ ? true : (((selm >> j_) & 1u) != 0u); \
            if (__any(mine)) { const int wl_ = win_ ? 511 : (1 << 20); const bool edge_ = (j_ == qt) || (win_ && j_ + 8 <= qt); \
                if (edge_) ATT_BLOCK(1, buf_, j_ * 64, mine, (key <= tok && key + wl_ >= tok)); else ATT_BLOCK(0, buf_, j_ * 64, mine, true); } } while (0)
        int d0, d1, d2; TileRegs trA, trB;
        NEXT_BLK(d0); NEXT_BLK(d1);
        LOAD_BLK(trA, d0); if (d1 >= 0) LOAD_BLK(trB, d1);
        __syncthreads();
        for (;;) {
            tile_store(TB, trA, tid); __syncthreads();
            NEXT_BLK(d2); if (d2 >= 0) LOAD_BLK(trA, d2);
            DO_BLK(d0, TB);
            if (d1 < 0) break;
            tile_store(TB + TILE_BYTES, trB, tid); __syncthreads();
            NEXT_BLK(d0); if (d0 >= 0) LOAD_BLK(trB, d0);
            DO_BLK(d1, TB + TILE_BYTES);
            if (d2 < 0) break;
            d1 = d0; d0 = d2;
        }
        FOLD(g2);
#undef NEXT_BLK
#undef LOAD_BLK
#undef FOLD
#undef DO_BLK
#pragma unroll
        for (int i = 0; i < 16; ++i) { out0[i] = PARK[i * 64]; out1[i] = PARK[(16 + i) * 64]; }
    }
    bf16* MIX = wsp<bf16>(C, WS_MIX) + m * DM + 1024 + head * 64;
    if (!skipblk)
#pragma unroll
    for (int i4 = 0; i4 < 4; ++i4) {
        v2u o; o.x = pk2(out0[4 * i4], out0[4 * i4 + 1]); o.y = pk2(out0[4 * i4 + 2], out0[4 * i4 + 3]); *(v2u*)(MIX + 8 * i4 + 4 * hi) = o;
        o.x = pk2(out1[4 * i4], out1[4 * i4 + 1]); o.y = pk2(out1[4 * i4 + 2], out1[4 * i4 + 3]); *(v2u*)(MIX + 32 + 8 * i4 + 4 * hi) = o;
    }
}

template <class RowFn> DI void samp_block(const RowFn& rowptr, int nvalid, int kvh, const LAS float* QS, LAS float* PWw, int lane, float (&M)[4], float (&L)[4], float (&O)[4]) {
    float s[4] = {0.f, 0.f, 0.f, 0.f};
    const bool ok = lane < nvalid;
    if (ok) {
        const f32x4* kr = (const f32x4*)(rowptr(lane) + kvh * 64);
#pragma unroll 4
        for (int d4 = 0; d4 < 16; ++d4) { const f32x4 kq = kr[d4];
#pragma unroll
            for (int g = 0; g < 4; ++g) { const f32x4 qq = *(const LAS f32x4*)(QS + g * 64 + 4 * d4); s[g] += kq[0] * qq[0] + kq[1] * qq[1] + kq[2] * qq[2] + kq[3] * qq[3]; } }
    }
    float mb[4], lb[4];
#pragma unroll
    for (int g = 0; g < 4; ++g) { const float sv = ok ? s[g] : NEG_BIG; mb[g] = wave_max(sv); const float p = ok ? expf(sv - mb[g]) : 0.f; lb[g] = wave_sum(p); PWw[g * 64 + lane] = p; }
    LDS_WAIT(); asm volatile("" ::: "memory");
    float ob[4] = {0.f, 0.f, 0.f, 0.f};
    for (int r0 = 0; r0 < nvalid; r0 += 4) {
        float vv[4];
#pragma unroll
        for (int u = 0; u < 4; ++u) vv[u] = r0 + u < nvalid ? rowptr(r0 + u)[256 + kvh * 64 + lane] : 0.f;
#pragma unroll
        for (int u = 0; u < 4; ++u)
#pragma unroll
            for (int g = 0; g < 4; ++g) ob[g] += PWw[g * 64 + r0 + u] * vv[u]; }
    LDS_WAIT(); asm volatile("" ::: "memory");
#pragma unroll
    for (int g = 0; g < 4; ++g) { const float mn = fmaxf(M[g], mb[g]); const float a = expf(M[g] - mn), bsc = expf(mb[g] - mn); L[g] = L[g] * a + lb[g] * bsc; O[g] = O[g] * a + ob[g] * bsc; M[g] = mn; }
}
DI float samp_combine(LAS float* WST, int tid, int lane, int wave, const float (&M)[4], const float (&L)[4], const float (&O)[4]) {
    __syncthreads();
#pragma unroll
    for (int g = 0; g < 4; ++g) { WST[wave * 264 + 8 + g * 64 + lane] = O[g]; if (lane == 0) { WST[wave * 264 + g] = M[g]; WST[wave * 264 + 4 + g] = L[g]; } }
    __syncthreads();
    float res = 0.f;
    if (tid < 256) { const int g = tid >> 6, d = tid & 63; float mm = NEG_BIG;
#pragma unroll
        for (int w = 0; w < 8; ++w) mm = fmaxf(mm, WST[w * 264 + g]);
        float ll = 0.f, oo = 0.f;
#pragma unroll
        for (int w = 0; w < 8; ++w) { const float e = expf(WST[w * 264 + g] - mm); ll += WST[w * 264 + 4 + g] * e; oo += WST[w * 264 + 8 + g * 64 + d] * e; }
        res = oo / ll; }
    return res;
}

DI void nsa_sample_item(const Ctx& C, int l, int b, int t, int kvh) {
    const int tid = C.tid, lane = C.lane, wave = C.wave;
    LAS float* F = (LAS float*)C.lds;
    LAS float *QS = F, *PC = F + 256, *IMPS = F + 2304, *RED = F + 2624, *RED2 = F + 2688, *OCP = F + 2752, *PW = F + 4800, *WST = F + 6848;
    LAS int* SELB = (LAS int*)(F + 2560);
    const bf16* P = wsp<bf16>(C, WS_PROJ);
    const size_t m = (size_t)NTP + b * 4 + t;
    __syncthreads();
    if (tid < 256) QS[tid] = bf2f(P[m * PLD + Q_OFF + kvh * 256 + tid]) * 0.125f;
    __syncthreads();
    float ocmp = 0.f;
    {
        const float* KC = wsp<float>(C, WS_KCBS) + ((size_t)((l * 8 + b) * 4 + kvh) * 512) * 64;
        const float* VC = wsp<float>(C, WS_VCBS) + ((size_t)((l * 8 + b) * 4 + kvh) * 512) * 64;
        float s[4] = {0.f, 0.f, 0.f, 0.f};
        const f32x4* kr = (const f32x4*)(KC + (size_t)tid * 64);
#pragma unroll 4
        for (int d4 = 0; d4 < 16; ++d4) { const f32x4 kq = kr[d4];
#pragma unroll
            for (int g = 0; g < 4; ++g) { const f32x4 qq = *(const LAS f32x4*)(QS + g * 64 + 4 * d4); s[g] += kq[0] * qq[0] + kq[1] * qq[1] + kq[2] * qq[2] + kq[3] * qq[3]; } }
#pragma unroll
        for (int g = 0; g < 4; ++g) { const float wm = wave_max(s[g]); if (lane == 0) RED[wave * 4 + g] = wm; }
        __syncthreads();
        float p[4];
#pragma unroll
        for (int g = 0; g < 4; ++g) { float mm = RED[g];
#pragma unroll
            for (int w = 1; w < 8; ++w) mm = fmaxf(mm, RED[w * 4 + g]);
            p[g] = expf(s[g] - mm); const float ws = wave_sum(p[g]); if (lane == 0) RED2[wave * 4 + g] = ws; }
        __syncthreads();
#pragma unroll
        for (int g = 0; g < 4; ++g) { float tot = 0.f;
#pragma unroll
            for (int w = 0; w < 8; ++w) tot += RED2[w * 4 + g];
            PC[g * 512 + tid] = p[g] / tot; }
        __syncthreads();
        if (tid < 256) IMPS[tid] = (PC[2 * tid] + PC[2 * tid + 1]) + (PC[512 + 2 * tid] + PC[512 + 2 * tid + 1]) + (PC[1024 + 2 * tid] + PC[1024 + 2 * tid + 1]) + (PC[1536 + 2 * tid] + PC[1536 + 2 * tid + 1]);
        { const int d = tid & 63, nq = tid >> 6; float acc[4] = {0.f, 0.f, 0.f, 0.f};
#pragma unroll 4
            for (int n = nq * 64; n < nq * 64 + 64; ++n) { const float vv = VC[(size_t)n * 64 + d];
#pragma unroll
                for (int g = 0; g < 4; ++g) acc[g] += PC[g * 512 + n] * vv; }
#pragma unroll
            for (int g = 0; g < 4; ++g) OCP[(nq * 4 + g) * 64 + d] = acc[g]; }
        __syncthreads();
        if (tid < 256) { const int g = tid >> 6, d = tid & 63;
#pragma unroll
            for (int nq = 0; nq < 8; ++nq) ocmp += OCP[(nq * 4 + g) * 64 + d];
            const int j = tid;
            if (j >= 1 && j <= 254) { const float v = IMPS[j]; int rank = 0;
                for (int jp = 1; jp <= 254; ++jp) { const float ov = IMPS[jp]; rank += (ov > v || (ov == v && jp < j)) ? 1 : 0; }
                if (rank < 13) SELB[rank] = j; }
            if (tid == 0) { SELB[13] = 0; SELB[14] = 255; SELB[15] = 256; }
        }
        __syncthreads();
    }
    float osel;
    {
        float M[4] = {NEG_BIG, NEG_BIG, NEG_BIG, NEG_BIG}, L[4] = {0.f, 0.f, 0.f, 0.f}, O[4] = {0.f, 0.f, 0.f, 0.f};
        const int* pt = (const int*)C.inp(4) + b * 128;
        for (int bi = 0; bi < 2; ++bi) {
            const int jb = __builtin_amdgcn_readfirstlane(SELB[2 * wave + bi]);
            if (jb < 256) { const int pid = pt[jb >> 1];
                const float* base = C.inp(3) + ((size_t)(l * NPOOL + pid) * 128 + (jb & 1) * 64) * 512;
                samp_block([&](int r) { return base + (size_t)r * 512; }, 64, kvh, QS, PW + wave * 256, lane, M, L, O);
            } else { const float* base = C.out + O_SEL_S + ((size_t)l * NTS + b * 4) * 512;
                samp_block([&](int r) { return base + (size_t)r * 512; }, t + 1, kvh, QS, PW + wave * 256, lane, M, L, O); }
        }
        osel = samp_combine(WST, tid, lane, wave, M, L, O);
    }
    float owin;
    {
        float M[4] = {NEG_BIG, NEG_BIG, NEG_BIG, NEG_BIG}, L[4] = {0.f, 0.f, 0.f, 0.f}, O[4] = {0.f, 0.f, 0.f, 0.f};
        const float* pre = C.inp(5) + (size_t)(l * 8 + b) * 262144;
        const float* nw = C.out + O_WIN_S + ((size_t)(l * 8 + b) * 512 + 508) * 512;
        samp_block([&](int r) { const int p = t + 1 + 64 * wave + r; return p <= 511 ? pre + (size_t)p * 512 : nw + (size_t)(p - 512) * 512; }, 64, kvh, QS, PW + wave * 256, lane, M, L, O);
        owin = samp_combine(WST, tid, lane, wave, M, L, O);
    }
    if (tid < 256) { const int g = tid >> 6, d = tid & 63, head = kvh * 4 + g;
        const float g0 = sigmoidf_(bf2f(P[m * PLD + GL_OFF + head * 3 + 0])), g1 = sigmoidf_(bf2f(P[m * PLD + GL_OFF + head * 3 + 1])), g2 = sigmoidf_(bf2f(P[m * PLD + GL_OFF + head * 3 + 2]));
        const float o = g0 * ocmp + g1 * osel + g2 * owin;
        wsp<bf16>(C, WS_MIX)[m * DM + 1024 + head * 64 + d] = (unsigned short)(pk2(o, 0.f) & 0xffffu); }
}

#ifndef C_MASK
#define C_MASK 7
#endif
constexpr int PC_SCAN_P = 128, PC_ATT_P = 512, PC_ATT_S = 128, PC_SCAN_S = 128, PC_ITEMS = PC_SCAN_P + PC_ATT_P + PC_ATT_S + PC_SCAN_S;
DI void phase_c(const Ctx& C0, int lq, int cmask = 7) {
    const int l = lq & 1;
    LAS int* slot = (LAS int*)(C0.lds + MISC_OFF + 64);
    for (;;) {
        __syncthreads();
        if (C0.tid == 0) *slot = (int)atomicAdd(C0.ctl + CW_QUEUE + 64 * lq, 1u);
        __syncthreads();
        int it = *slot;
        if (it >= PC_ITEMS) {
            if (lq != 0 || it - PC_ITEMS >= DEF_GROUPS) break;
            Ctx K = C0; { K.ws = launder_g(K.ws); K.out = launder_g(K.out); int t_ = K.tid; asm volatile("" : "+v"(t_)); K.tid = t_; K.lane = t_ & 63; K.wave = __builtin_amdgcn_readfirstlane(t_ >> 6); }
            for (int e = 0; e < 4; ++e) deferred_item(K, (it - PC_ITEMS) * 4 + e);
            continue;
        }
        Ctx K = C0; { K.ws = launder_g(K.ws); K.out = launder_g(K.out); int t_ = K.tid; asm volatile("" : "+v"(t_)); K.tid = t_; K.lane = t_ & 63; K.wave = __builtin_amdgcn_readfirstlane(t_ >> 6); }
        const Ctx& C = K;
        if (it >= PC_SCAN_P && it < PC_SCAN_P + PC_ATT_S) it += PC_ATT_P; else if (it >= PC_SCAN_P + PC_ATT_S && it < PC_SCAN_P + PC_ATT_S + PC_ATT_P) it -= PC_ATT_S;
        if (it < PC_SCAN_P || it >= PC_SCAN_P + PC_ATT_P + PC_ATT_S) {
            int row0, T, h; const float* S0; float* So;
            int cmode = 0;
            if (it < PC_SCAN_P) { const int u = it & 63, b = u >> 4; cmode = it < 64 ? 1 : 0; h = u & 15; row0 = b * 2048; T = 2048; S0 = nullptr; So = C.out + O_RW_P + ((size_t)(l * 4 + b) * 16 + h) * 4096; }
            else { const int u = it - (PC_SCAN_P + PC_ATT_P + PC_ATT_S), b = u >> 4; h = u & 15; row0 = NTP + b * 4; T = 4; S0 = C.inp(6) + ((size_t)(l * 8 + b) * 16 + h) * 4096; So = C.out + O_RW_S + ((size_t)(l * 8 + b) * 16 + h) * 4096; }
            if (cmask & 1) { if (S0) scan_head(C, l, row0, T, h, S0, So); else if (cmode) chunk_head<1>(C, l, row0 >> 11, h, So, cmode); else chunk_head<0>(C, l, row0 >> 11, h, So, 0); }
        } else if (it < PC_SCAN_P + PC_ATT_P) {
            const int u = it - PC_SCAN_P, qt = 31 - (u >> 4), bk = u & 15;
            if (cmask & 2) nsa_prompt_unit(C, l, bk >> 2, bk & 3, qt, (cmask & 8) != 0, (cmask & 16) != 0);
        } else {
            const int u = it - (PC_SCAN_P + PC_ATT_P);
            if (cmask & 4) nsa_sample_item(C, l, u >> 4, (u >> 2) & 3, u & 3);
        }
    }
    __syncthreads();
}

DI const float* xin_row(const Ctx& C, int l, size_t m) {
    if (l == 0) return m < (size_t)NTP ? C.inp(0) + m * DM : C.inp(1) + (m - NTP) * DM;
    return wsp<float>(C, WS_XF1) + m * DM;
}
DI void phase_e(const Ctx& C, int l) {
    const int lane = C.lane;
    const bf16* H = wsp<bf16>(C, WS_HS);
    bf16* X1B = wsp<bf16>(C, WS_X1B); const bf16* XB = wsp<bf16>(C, WS_XB);
    const float* gw = C.inp(22) + (size_t)l * DM; const float* bw = C.inp(23) + (size_t)l * DM;
    for (int m = blockIdx.x * NWAVES + C.wave; m < NT; m += C.G * NWAVES) {
        const v2u* hr = (const v2u*)(H + (size_t)m * DM) + lane;
        f32x4 v[8]; float s = 0.f;
        if (l == 0) { const f32x4* xr = (const f32x4*)xin_row(C, l, m) + lane;
#pragma unroll
            for (int j = 0; j < 8; ++j) { const v2u hb = hr[64 * j]; v[j] = xr[64 * j] * DN_ALPHA + (f32x4){bflo(hb.x), bfhi(hb.x), bflo(hb.y), bfhi(hb.y)}; }
        } else { const v2u* xr = (const v2u*)(XB + (size_t)m * DM) + lane;
#pragma unroll
            for (int j = 0; j < 8; ++j) { const v2u hb = hr[64 * j], xb = xr[64 * j]; v[j] = (f32x4){bflo(xb.x), bfhi(xb.x), bflo(xb.y), bfhi(xb.y)} * DN_ALPHA + (f32x4){bflo(hb.x), bfhi(hb.x), bflo(hb.y), bfhi(hb.y)}; } }
#pragma unroll
        for (int j = 0; j < 8; ++j) s += (v[j][0] + v[j][1]) + (v[j][2] + v[j][3]);
        const float mean = wave_sum(s) * (1.f / DM); float s2 = 0.f;
#pragma unroll
        for (int j = 0; j < 8; ++j) { v[j] = v[j] - mean; s2 += (v[j][0] * v[j][0] + v[j][1] * v[j][1]) + (v[j][2] * v[j][2] + v[j][3] * v[j][3]); }
        const float rstd = 1.f / sqrtf(wave_sum(s2) * (1.f / DM) + LN_EPS);
        float am = 0.f;
#pragma unroll
        for (int j = 0; j < 8; ++j) { const f32x4 gg = ((const f32x4*)gw)[lane + 64 * j], bb = ((const f32x4*)bw)[lane + 64 * j];
            const f32x4 o = v[j] * rstd * gg + bb; v[j] = o;
            am = fmaxf(am, fmaxf(fmaxf(fabsf(o[0]), fabsf(o[1])), fmaxf(fabsf(o[2]), fabsf(o[3]))));
            v2u p; p.x = pk2(o[0], o[1]); p.y = pk2(o[2], o[3]); ((v2u*)(X1B + (size_t)m * DM))[lane + 64 * j] = p; }
        am = wave_max(am);
        const float qs = am > 0.f ? am * (1.f / 127.f) : 1.f, qi = 1.f / qs;
#pragma unroll
        for (int j = 0; j < 8; ++j) { const f32x4 x = v[j] * qi;
            ((unsigned*)(C.ws + WS_X1Q + (size_t)m * DM))[lane + 64 * j] = ((unsigned)(int)__builtin_rintf(x[0]) & 255u) | (((unsigned)(int)__builtin_rintf(x[1]) & 255u) << 8) | (((unsigned)(int)__builtin_rintf(x[2]) & 255u) << 16) | ((unsigned)(int)__builtin_rintf(x[3]) << 24); }
        if (lane == 0) wsp<float>(C, WS_XQS)[m] = qs;
    }
}

DI float gelu_erf(float x) { return 0.5f * x * (1.f + erff(x * 0.70710678118654752f)); }
DI unsigned fkey(float f) { const unsigned u = __builtin_bit_cast(unsigned, f); return u ^ ((unsigned)((int)u >> 31) | 0x80000000u); }
DI int mbcnt64(unsigned long long m) { return __builtin_amdgcn_mbcnt_hi((unsigned)(m >> 32), __builtin_amdgcn_mbcnt_lo((unsigned)m, 0)); }
template <int NV, bool LANE_MAJOR> DI void top16(const unsigned (&key)[NV], bool (&sel)[NV], int (&pos)[NV]) {
    unsigned thr = 0u; bool exact = false;
    for (int bit = 31; bit >= 0; --bit) {
        const unsigned cand = thr | (1u << bit);
        int cnt = 0;
#pragma unroll
        for (int v = 0; v < NV; ++v) cnt += __builtin_popcountll(__ballot(key[v] >= cand));
        if (cnt >= 16) { thr = cand; if (cnt == 16) { exact = true; break; } }
    }
    unsigned long long sm[NV];
    if (exact) {
#pragma unroll
        for (int v = 0; v < NV; ++v) { sel[v] = key[v] >= thr; sm[v] = __ballot(sel[v]); }
    } else {
        unsigned long long eq[NV]; int ngt = 0;
#pragma unroll
        for (int v = 0; v < NV; ++v) { ngt += __builtin_popcountll(__ballot(key[v] > thr)); eq[v] = __ballot(key[v] == thr); }
        const int need = 16 - ngt;
#pragma unroll
        for (int v = 0; v < NV; ++v) { int rk;
            if (LANE_MAJOR) { rk = 0;
#pragma unroll
                for (int w = 0; w < NV; ++w) { rk += mbcnt64(eq[w]); if (w < v) rk += (int)((eq[w] >> (threadIdx.x & 63)) & 1ull); } }
            else { rk = mbcnt64(eq[v]);
#pragma unroll
                for (int w = 0; w < NV; ++w) if (w < v) rk += __builtin_popcountll(eq[w]); }
            sel[v] = key[v] > thr || (key[v] == thr && rk < need); sm[v] = __ballot(sel[v]); }
    }
    int base = 0;
#pragma unroll
    for (int v = 0; v < NV; ++v) { pos[v] = base + mbcnt64(sm[v]); base += __builtin_popcountll(sm[v]); }
}
typedef float f32x2v __attribute__((ext_vector_type(2)));
typedef int v4i __attribute__((ext_vector_type(4)));
typedef int v2i __attribute__((ext_vector_type(2)));
constexpr int PS_NSL = 16, PS_TOKG = 64, PS_NGRP = (NT + PS_TOKG - 1) / PS_TOKG;
static_assert(NT % 8 == 0, "a wave's 8 tokens of a group are all valid or all invalid");
template <int NP, int NV> DI void top16_search(const unsigned (&key)[NP][NV], unsigned (&thr)[NP], bool (&ex)[NP]) {
    int c16[NP];
#pragma unroll
    for (int p = 0; p < NP; ++p) { thr[p] = 0u; c16[p] = 64 * NV; }
    for (unsigned bm = 0x80000000u; bm != 0u; bm >>= 1) {
        unsigned cand[NP]; unsigned long long bl[NP][NV]; int cnt[NP];
#pragma unroll
        for (int p = 0; p < NP; ++p) cand[p] = thr[p] | bm;
#pragma unroll
        for (int p = 0; p < NP; ++p)
#pragma unroll
            for (int v = 0; v < NV; ++v) bl[p][v] = __ballot(key[p][v] >= cand[p]);
#pragma unroll
        for (int p = 0; p < NP; ++p) { cnt[p] = 0;
#pragma unroll
            for (int v = 0; v < NV; ++v) cnt[p] += __builtin_popcountll(bl[p][v]); }
        int diff = 0;
#pragma unroll
        for (int p = 0; p < NP; ++p) { const bool ge = cnt[p] >= 16; thr[p] = ge ? cand[p] : thr[p]; c16[p] = ge ? cnt[p] : c16[p]; diff |= c16[p] ^ 16; }
        if (diff == 0) break;
    }
#pragma unroll
    for (int p = 0; p < NP; ++p) ex[p] = c16[p] == 16;
}
template <int NV, bool LANE_MAJOR> DI void top16_finish(const unsigned (&key)[NV], unsigned thr, bool exact, bool (&sel)[NV], int (&pos)[NV]) {
    unsigned long long sm[NV];
    if (exact) {
#pragma unroll
        for (int v = 0; v < NV; ++v) { sel[v] = key[v] >= thr; sm[v] = __ballot(sel[v]); }
    } else {
        unsigned long long eq[NV]; int ngt = 0;
#pragma unroll
        for (int v = 0; v < NV; ++v) { ngt += __builtin_popcountll(__ballot(key[v] > thr)); eq[v] = __ballot(key[v] == thr); }
        const int need = 16 - ngt;
#pragma unroll
        for (int v = 0; v < NV; ++v) { int rk;
            if (LANE_MAJOR) { rk = 0;
#pragma unroll
                for (int w = 0; w < NV; ++w) { rk += mbcnt64(eq[w]); if (w < v) rk += (int)((eq[w] >> (threadIdx.x & 63)) & 1ull); } }
            else { rk = mbcnt64(eq[v]);
#pragma unroll
                for (int w = 0; w < NV; ++w) if (w < v) rk += __builtin_popcountll(eq[w]); }
            sel[v] = key[v] > thr || (key[v] == thr && rk < need); sm[v] = __ballot(sel[v]); }
    }
    int base = 0;
#pragma unroll
    for (int v = 0; v < NV; ++v) { pos[v] = base + mbcnt64(sm[v]); base += __builtin_popcountll(sm[v]); }
}
DI float row_max16(float v) { v = fmaxf(v, dppf<0xB1>(v)); v = fmaxf(v, dppf<0x4E>(v)); v = fmaxf(v, dppf<0x141>(v)); return fmaxf(v, dppf<0x140>(v)); }
DI float row_sum16(float v) { v += dppf<0xB1>(v); v += dppf<0x4E>(v); v += dppf<0x141>(v); return v + dppf<0x140>(v); }
template <int CTRL, bool BC> DI int dppi(int v) { return __builtin_amdgcn_update_dpp(0, v, CTRL, 0xF, 0xF, BC); }
DI int row_sum16i(int v) { v += dppi<0xB1, false>(v); v += dppi<0x4E, false>(v); v += dppi<0x141, false>(v); v += dppi<0x140, false>(v); return v; }
DI int row_scan16i(int v) { v += dppi<0x111, true>(v); v += dppi<0x112, true>(v); v += dppi<0x114, true>(v); v += dppi<0x118, true>(v); return v; }
DI unsigned row_max16u(unsigned v) { v = max(v, (unsigned)dppi<0xB1, false>((int)v)); v = max(v, (unsigned)dppi<0x4E, false>((int)v)); v = max(v, (unsigned)dppi<0x141, false>((int)v)); return max(v, (unsigned)dppi<0x140, false>((int)v)); }
DI unsigned row_min16u(unsigned v) { v = min(v, (unsigned)dppi<0xB1, false>((int)v)); v = min(v, (unsigned)dppi<0x4E, false>((int)v)); v = min(v, (unsigned)dppi<0x141, false>((int)v)); return min(v, (unsigned)dppi<0x140, false>((int)v)); }
template <int NK> DI unsigned row_top16_search(unsigned (&key)[NK]) {
    unsigned lm = key[0];
#pragma unroll
    for (int j = 1; j < NK; ++j) lm = max(lm, key[j]);
    const unsigned kmax = row_max16u(lm), L = row_min16u(lm), sp1 = kmax - L + 1u;
    const unsigned spw = max(max((unsigned)__builtin_amdgcn_readlane((int)sp1, 0), (unsigned)__builtin_amdgcn_readlane((int)sp1, 16)), max((unsigned)__builtin_amdgcn_readlane((int)sp1, 32), (unsigned)__builtin_amdgcn_readlane((int)sp1, 48)));
    const int B = spw == 0u ? 32 : 32 - __builtin_clz(spw);
    const unsigned M = B == 32 ? 0xFFFFFFFFu : (1u << B) - 1u, off = kmax - M, lo = L - 1u;
#pragma unroll
    for (int j = 0; j < NK; ++j) key[j] = max(key[j], lo) - off;
    unsigned thr = 0u; int c16 = 16 * NK;
    for (unsigned bm = 1u << (B - 1); bm != 0u; bm >>= 1) {
        const unsigned cand = thr | bm; int cnt = 0;
#pragma unroll
        for (int j = 0; j < NK; ++j) cnt += key[j] >= cand ? 1 : 0;
        cnt = row_sum16i(cnt);
        const bool ge = cnt >= 16; thr = ge ? cand : thr; c16 = ge ? cnt : c16;
        if (__ballot(c16 != 16) == 0ull) break;
    }
    return thr;
}
template <int NK> DI void row_top16_place(const unsigned (&key)[NK], unsigned thr, int (&pos)[NK]) {
    int cg = 0, ce = 0;
#pragma unroll
    for (int j = 0; j < NK; ++j) { cg += key[j] > thr ? 1 : 0; ce += key[j] == thr ? 1 : 0; }
    const int pk = cg | (ce << 8);
    const int exc = row_scan16i(pk) - pk, tot = row_sum16i(pk);
    int pg_ = exc & 255, pe_ = (tot & 255) + (exc >> 8);
#pragma unroll
    for (int j = 0; j < NK; ++j) { const bool g = key[j] > thr, e = key[j] == thr; pos[j] = g ? pg_ : (e ? pe_ : 16); pg_ += g ? 1 : 0; pe_ += e ? 1 : 0; }
}
DI void peer_topk(const Ctx& C, int l) {
    const int lane = C.lane, wave = C.wave, n = lane & 15, r = lane >> 4;
    LAS float* WL = (LAS float*)(C.lds + 65536 + 256 + wave * 2048 + r * 384);
    LAS int* WLi = (LAS int*)WL;
    const float* Sc = wsp<float>(C, WS_HS);
    unsigned short* EL = wsp<unsigned short>(C, WS_EL); float* GT = wsp<float>(C, WS_GT);
    static_assert(NT % 4 == 0, "token quads");
    for (int m = 4 * blockIdx.x; m < NT; m += 4 * C.G) {
        const float* sr = Sc + (size_t)(m + r) * DM + wave * 256 + 8 * n;
        f32x4 sv[2][2];
#pragma unroll
        for (int c = 0; c < 2; ++c) { sv[c][0] = *(const f32x4*)(sr + 128 * c); sv[c][1] = *(const f32x4*)(sr + 128 * c + 4); }
#pragma unroll
        for (int c = 0; c < 2; ++c) {
            unsigned key[8]; int pos[8];
#pragma unroll
            for (int j = 0; j < 8; ++j) key[j] = fkey(sv[c][j >> 2][j & 3]);
            const unsigned thr = row_top16_search<8>(key);
            row_top16_place<8>(key, thr, pos);
#pragma unroll
            for (int j = 0; j < 8; ++j) if (pos[j] < 16) { WL[32 * c + pos[j]] = sv[c][j >> 2][j & 3]; WLi[32 * c + 16 + pos[j]] = 8 * n + j; }
        }
        LDS_WAIT(); asm volatile("" ::: "memory");
        {
            const float x0 = WL[n]; const int e0 = WLi[16 + n] * 128;
            float cd[16]; unsigned key[16]; int pos[16];
#pragma unroll
            for (int q = 0; q < 4; ++q) { const f32x4 x1 = *(const LAS f32x4*)(WL + 32 + 4 * q);
#pragma unroll
                for (int e = 0; e < 4; ++e) { cd[4 * q + e] = x0 + x1[e]; key[4 * q + e] = fkey(cd[4 * q + e]); } }
            const unsigned thr = row_top16_search<16>(key);
            row_top16_place<16>(key, thr, pos);
#pragma unroll
            for (int b = 0; b < 16; ++b) if (pos[b] < 16) { WL[64 + pos[b]] = cd[b]; WLi[80 + pos[b]] = e0 + WLi[48 + b]; }
        }
        LDS_WAIT(); asm volatile("" ::: "memory");
        { const float tv = WL[64 + n];
          const float ev = expf(tv - row_max16(tv));
          const float gate = ev / row_sum16(ev);
          EL[(size_t)(m + r) * 128 + wave * 16 + n] = (unsigned short)WLi[80 + n]; GT[(size_t)(m + r) * 128 + wave * 16 + n] = gate; }
        LDS_WAIT(); asm volatile("" ::: "memory");
    }
}
template <int SIDE> DI void peer_sliced(const Ctx& C, int l, int lq) {
    const int tid = C.tid, lane = C.lane, wave = C.wave, pg = lane >> 3, dq = lane & 7;
    LAS int* slot = (LAS int*)(C.lds + MISC_OFF + 64);
    const unsigned char* TAB = C.ws + (SIDE ? WS_VB : WS_UB) + (size_t)l * NEXP * DM;
    const unsigned char* X1Q = C.ws + WS_X1Q;
    const unsigned short* EL = wsp<unsigned short>(C, WS_EL); const float* WP = wsp<float>(C, WS_WP);
    bf16* PD = wsp<bf16>(C, WS_PD); bf16* FO = wsp<bf16>(C, WS_FO);
    unsigned* const Q0 = C.ctl + CW_SQ + 64 * ((lq * 2 + SIDE) * 16);
    const int s_first = (int)((2u * xb_xcc_id()) & (PS_NSL - 1));
    int k = 0;
    for (;;) {
        __syncthreads();
        if (tid == 0) { int got = -1;
            while (k < PS_NSL) { const int s = (s_first + k) & (PS_NSL - 1); const unsigned g = atomicAdd(Q0 + 64 * s, 1u); if (g < (unsigned)PS_NGRP) { got = (s << 16) | (int)g; break; } ++k; }
            *slot = got; }
        __syncthreads();
        const int d = __builtin_amdgcn_readfirstlane(*slot);
        if (d < 0) break;
        const int s = d >> 16, g = d & 0xffff;
        const int t0 = g * PS_TOKG + wave * 8;
        if (t0 >= NT) continue;
        const unsigned char* TS = TAB + (size_t)s * NEXP * 128;
        const unsigned dq16 = (unsigned)dq * 16u;
        v4u E[2][2]; v4u R[2][16]; f32x4 A[2][4]; v4u AQ[2];
        LAS unsigned char* const WB = C.lds + wave * 4352;
        const int wofs = pg * 512 + dq * 64, rofs = (lane >> 3) * 64 + 16 * (((lane & 7) >> 1) ^ ((lane >> 3) & 3)) + 8 * (lane & 1);
#define PS_LOAD_E(b, t) do { const v4u* ep_ = (const v4u*)(EL + (size_t)(t) * 128 + 16 * pg); E[b][0] = ep_[0]; E[b][1] = ep_[1]; } while (0)
#define PS_LOAD_R(b, t) do { \
            _Pragma("unroll") for (int i = 0; i < 16; ++i) { const unsigned w_ = E[b][i >> 3][(i >> 1) & 3]; const unsigned e_ = (i & 1) ? (w_ >> 16) : (w_ & 0xffffu); \
                R[b][i] = *(const v4u*)(TS + ((e_ << 7) | dq16)); } \
            if (SIDE == 0) AQ[b] = *(const v4u*)(X1Q + (size_t)(t) * DM + 128 * s + 16 * dq); \
            else { const f32x4* ap_ = (const f32x4*)(WP + (size_t)(t) * 128 + 16 * pg); _Pragma("unroll") for (int q = 0; q < 4; ++q) A[b][q] = ap_[q]; } } while (0)
        PS_LOAD_E(0, t0); PS_LOAD_E(1, t0 + 1);
        PS_LOAD_R(0, t0);
#pragma unroll
        for (int j = 0; j < 8; ++j) {
            const int b = j & 1, t = t0 + j;
            if (j + 2 < 8) PS_LOAD_E(b, t + 2);
            if (j + 1 < 8) PS_LOAD_R(b ^ 1, t + 1);
            __builtin_amdgcn_sched_barrier(0);
            if (SIDE == 0) {
                int dd[16];
#pragma unroll
                for (int i = 0; i < 16; ++i) { int a = 0;
#pragma unroll
                    for (int q = 0; q < 4; ++q) a = __builtin_amdgcn_sdot4((int)R[b][i][q], (int)AQ[b][q], a, false);
                    dd[i] = a; }
#pragma unroll
                for (int q = 0; q < 4; ++q) *(LAS v4i*)(WB + dq * 528 + pg * 64 + 16 * q) = (v4i){dd[4 * q], dd[4 * q + 1], dd[4 * q + 2], dd[4 * q + 3]};
                v2i rs = {0, 0};
#pragma unroll
                for (int d8 = 0; d8 < 8; ++d8) rs += *(const LAS v2i*)(WB + 8 * lane + 528 * d8);
                *(unsigned*)(PD + ((size_t)t * PS_NSL + s) * 128 + 2 * lane) = pk2((float)rs.x, (float)rs.y);
            } else {
                f32x2v acc[8];
#pragma unroll
                for (int q = 0; q < 8; ++q) acc[q] = (f32x2v){0.f, 0.f};
#pragma unroll
                for (int i = 0; i < 16; ++i) { const float w = A[b][i >> 2][i & 3]; const f32x2v w2 = {w, w};
#pragma unroll
                    for (int q = 0; q < 4; ++q) { const int wd = (int)R[b][i][q]; acc[2 * q] += w2 * __builtin_amdgcn_cvt_pk_f32_fp8(wd, false); acc[2 * q + 1] += w2 * __builtin_amdgcn_cvt_pk_f32_fp8(wd, true); } }
#pragma unroll
                for (int q = 0; q < 4; ++q) *(LAS f32x4*)(WB + wofs + 16 * (q ^ (dq & 3))) = (f32x4){acc[2 * q].x, acc[2 * q].y, acc[2 * q + 1].x, acc[2 * q + 1].y};
                f32x2v rs = {0.f, 0.f};
#pragma unroll
                for (int h8 = 0; h8 < 8; ++h8) rs += *(const LAS f32x2v*)(WB + rofs + 512 * h8);
                *(unsigned*)(FO + (size_t)t * DM + 128 * s + 2 * lane) = pk2(rs.x, rs.y);
            }
        }
#undef PS_LOAD_E
#undef PS_LOAD_R
    }
}
DI void peer_gelu(const Ctx& C, int l) {
    const unsigned short* EL = wsp<unsigned short>(C, WS_EL); const float* GT = wsp<float>(C, WS_GT); const bf16* PD = wsp<bf16>(C, WS_PD); float* WP = wsp<float>(C, WS_WP);
    const float* USC = wsp<float>(C, WS_USC) + (size_t)l * NEXP; const float* VSC = USC + 2 * NEXP; const float* XQS = wsp<float>(C, WS_XQS);
    for (int idx = blockIdx.x * NTHREADS + C.tid; idx < NT * 128; idx += C.G * NTHREADS) {
        const int t = idx >> 7, p = idx & 127; const unsigned e = EL[idx];
        float h = 0.f;
#pragma unroll
        for (int s = 0; s < PS_NSL; ++s) h += bf2f(PD[((size_t)t * PS_NSL + s) * 128 + p]);
        WP[idx] = GT[idx] * gelu_erf(h * USC[e] * XQS[t]) * VSC[e];
    }
}
DI void peer_ln2(const Ctx& C, int l) {
    const int lane = C.lane;
    const bf16* X1B = wsp<bf16>(C, WS_X1B); const bf16* FO = wsp<bf16>(C, WS_FO);
    const float* gw = C.inp(28) + (size_t)l * DM; const float* bw = C.inp(29) + (size_t)l * DM;
    for (int m = blockIdx.x * NWAVES + C.wave; m < NT; m += C.G * NWAVES) {
        const v2u* xr = (const v2u*)(X1B + (size_t)m * DM) + lane; const v2u* fr = (const v2u*)(FO + (size_t)m * DM) + lane;
        f32x4 v[8]; float s = 0.f;
#pragma unroll
        for (int j = 0; j < 8; ++j) { const v2u xb = xr[64 * j], fb = fr[64 * j]; v[j] = (f32x4){bflo(xb.x), bfhi(xb.x), bflo(xb.y), bfhi(xb.y)} * DN_ALPHA + (f32x4){bflo(fb.x), bfhi(fb.x), bflo(fb.y), bfhi(fb.y)}; s += (v[j][0] + v[j][1]) + (v[j][2] + v[j][3]); }
        const float mean = wave_sum(s) * (1.f / DM); float s2 = 0.f;
#pragma unroll
        for (int j = 0; j < 8; ++j) { v[j] = v[j] - mean; s2 += (v[j][0] * v[j][0] + v[j][1] * v[j][1]) + (v[j][2] * v[j][2] + v[j][3] * v[j][3]); }
        const float rstd = 1.f / sqrtf(wave_sum(s2) * (1.f / DM) + LN_EPS);
#pragma unroll
        for (int j = 0; j < 8; ++j) { const f32x4 gg = ((const f32x4*)gw)[lane + 64 * j], bb = ((const f32x4*)bw)[lane + 64 * j];
            const f32x4 o = v[j] * rstd * gg + bb;
            if (l == 0) {
                v2u p; p.x = pk2(o[0], o[1]); p.y = pk2(o[2], o[3]); ((v2u*)(wsp<bf16>(C, WS_XB) + (size_t)m * DM))[lane + 64 * j] = p; }
            else { float* dst = m < NTP ? C.out + O_YP + (size_t)m * DM : C.out + O_YS + (size_t)(m - NTP) * DM; ((f32x4*)dst)[lane + 64 * j] = o; } }
    }
}

#ifndef PH_MASK
#define PH_MASK 0xFF
#endif
#define IN(k) (lo <= (k) && (k) < hi)
#define EN(s) ((PH_MASK >> (s)) & 1)
#define FRESH(CX) Ctx CX = C; { CX.ws = launder_g(CX.ws); CX.out = launder_g(CX.out); int t_ = CX.tid; asm volatile("" : "+v"(t_)); CX.tid = t_; CX.lane = t_ & 63; CX.wave = __builtin_amdgcn_readfirstlane(t_ >> 6); CX.ctl = (unsigned*)(CX.ws + WS_CTL); }
#ifndef PROBE_REP
#define PROBE_REP 0
#endif
#ifndef PROBE_PMASK
#define PROBE_PMASK 31
#endif
#ifndef PROBE_CMASK
#define PROBE_CMASK 7
#endif
#define NREP(s) (((PROBE_REP >> (s)) & 1) ? 2 : 1)
#ifndef PROBE_G
#define PROBE_G 0
#endif
#define GREP(s) (((PROBE_G >> (s)) & 1) ? 2 : 1)
#define REPBAR(s, rep) do { if (NREP(s) == 2 && (rep) == 0 && (hi - lo) > 1) xcd_barrier(bar); } while (0)
#define SEAM(k) do { if (IN(k) && IN((k) + 1)) xcd_barrier(bar); } while (0)
template <int l> DI void run_layer(const Ctx& C, const XcdBarrier& bar, int lo, int hi) {
        const int pb = 1 + 11 * l;
        _Pragma("unroll") for (int rep = 0; rep < NREP(0); ++rep) if (EN(0) && IN(pb + 0)) {
            FRESH(K);
            pg8::Gemm g{wsp<bf16>(K, WS_XB), wsp<bf16>(K, WS_WIN) + (size_t)l * PLD * DM, NTP, PLD, DM}; pg8::StaticOrder S; S.init(NTP, PLD, K.G, (int)blockIdx.x);
            EpiInProj E{wsp<bf16>(K, WS_PROJ), K.out, l};
            pg8::gemm_phase<EpiInProj, pg8::StaticOrder, true, true>(K.lds, g, S, E);
            { bf16* P = wsp<bf16>(K, WS_PROJ); float* out = K.out;
              skinny_gemm(K, wsp<bf16>(K, WS_XB) + (size_t)NTP * DM, wsp<bf16>(K, WS_WIN) + (size_t)l * PLD * DM, (IN_COLS + 31) / 32, [&](int j, int col, float v) {
                  P[(size_t)(NTP + j) * PLD + col] = (unsigned short)(pk2(v, 0.f) & 0xffffu);
                  const int b = j >> 2, t = j & 3;
                  if (col < RW_COLS) { if (t == 3) out[O_SH_S + (size_t)(l * 8 + b) * RW_COLS + col] = v; }
                  else if (col >= KC_OFF && col < GL_OFF) { const int c = col - KC_OFF, reg = c >> 9, cc = c & 511;
                      if (reg == 0) out[O_CMP_S + ((size_t)l * NTS + j) * 512 + cc] = v; else if (reg == 1) out[O_SEL_S + ((size_t)l * NTS + j) * 512 + cc] = v;
                      else out[O_WIN_S + ((size_t)(l * 8 + b) * 512 + 508 + t) * 512 + cc] = v; } }); }
            REPBAR(0, rep);
        }
        SEAM(pb + 0);
        _Pragma("unroll") for (int rep = 0; rep < NREP(1); ++rep) if (EN(1) && IN(pb + 1)) { FRESH(K); phase_b(K, l, l + 2 * rep); REPBAR(1, rep); }
        SEAM(pb + 1);
        _Pragma("unroll") for (int rep = 0; rep < NREP(2); ++rep) if (EN(2) && IN(pb + 2)) { FRESH(K); phase_c(K, l + 2 * rep, rep == 0 ? 7 : PROBE_CMASK); REPBAR(2, rep); }
        SEAM(pb + 2);
        _Pragma("unroll") for (int rep = 0; rep < NREP(3); ++rep) if (EN(3) && IN(pb + 3)) {
            FRESH(K);
            pg8::Gemm g{wsp<bf16>(K, WS_MIX), wsp<bf16>(K, WS_WOUT) + (size_t)l * DM * DM, NTP, DM, DM}; pg8::StaticOrder S; S.init(NTP, DM, K.G, (int)blockIdx.x);
            EpiBf16Row E{wsp<bf16>(K, WS_HS), DM};
            pg8::gemm_phase<EpiBf16Row, pg8::StaticOrder, true, true>(K.lds, g, S, E);
            { bf16* H = wsp<bf16>(K, WS_HS) + (size_t)NTP * DM;
              skinny_gemm(K, wsp<bf16>(K, WS_MIX) + (size_t)NTP * DM, wsp<bf16>(K, WS_WOUT) + (size_t)l * DM * DM, DM / 32, [&](int j, int col, float v) { H[(size_t)j * DM + col] = (unsigned short)(pk2(v, 0.f) & 0xffffu); }); }
            REPBAR(3, rep);
        }
        SEAM(pb + 3);
        _Pragma("unroll") for (int rep = 0; rep < NREP(4); ++rep) if (EN(4) && IN(pb + 4)) { FRESH(K); phase_e(K, l); REPBAR(4, rep); }
        SEAM(pb + 4);
        _Pragma("unroll") for (int rep = 0; rep < NREP(5); ++rep) if (EN(5) && IN(pb + 5)) {
            FRESH(K);
            pg8::Gemm g{wsp<bf16>(K, WS_X1B), wsp<bf16>(K, WS_W2) + (size_t)l * DM * DM, NTP, DM, DM}; pg8::StaticOrder S; S.init(NTP, DM, K.G, (int)blockIdx.x);
            pg8::EpiF32 E{wsp<float>(K, WS_HS), DM, nullptr};
            pg8::gemm_phase<pg8::EpiF32, pg8::StaticOrder, true, true>(K.lds, g, S, E);
            { float* H = wsp<float>(K, WS_HS) + (size_t)NTP * DM;
              skinny_gemm(K, wsp<bf16>(K, WS_X1B) + (size_t)NTP * DM, wsp<bf16>(K, WS_W2) + (size_t)l * DM * DM, DM / 32, [&](int j, int col, float v) { H[(size_t)j * DM + col] = v; }); }
            REPBAR(5, rep);
        }
        SEAM(pb + 5);
        _Pragma("unroll") for (int rep = 0; rep < GREP(0); ++rep) { if (IN(pb + 6)) { FRESH(K); peer_topk(K, l); } if (GREP(0) == 2 && rep == 0) xcd_barrier(bar); }
        SEAM(pb + 6);
        _Pragma("unroll") for (int rep = 0; rep < GREP(1); ++rep) { if (IN(pb + 7)) { FRESH(K); peer_sliced<0>(K, l, l + 2 * rep); } if (GREP(1) == 2 && rep == 0) xcd_barrier(bar); }
        SEAM(pb + 7);
        _Pragma("unroll") for (int rep = 0; rep < GREP(2); ++rep) { if (IN(pb + 8)) { FRESH(K); peer_gelu(K, l); } if (GREP(2) == 2 && rep == 0) xcd_barrier(bar); }
        SEAM(pb + 8);
        _Pragma("unroll") for (int rep = 0; rep < GREP(3); ++rep) { if (IN(pb + 9)) { FRESH(K); peer_sliced<1>(K, l, l + 2 * rep); } if (GREP(3) == 2 && rep == 0) xcd_barrier(bar); }
        SEAM(pb + 9);
        _Pragma("unroll") for (int rep = 0; rep < GREP(4); ++rep) { if (IN(pb + 10)) { FRESH(K); peer_ln2(K, l); } if (GREP(4) == 2 && rep == 0) xcd_barrier(bar); }
        SEAM(pb + 10);
}
typedef ArgsK Args;
__global__ void __launch_bounds__(NTHREADS, 2) fwd_kernel(Args args) {
    extern __shared__ __attribute__((aligned(16))) unsigned char lds[];
    Ctx C;
    C.out = args.out; C.ws = args.ws; C.lds = (LAS unsigned char*)lds; C.ctl = (unsigned*)(args.ws + WS_CTL);
    C.tid = threadIdx.x; C.lane = C.tid & 63; C.wave = __builtin_amdgcn_readfirstlane(C.tid >> 6); C.G = gridDim.x;
    volatile LAS unsigned* MISC = (volatile LAS unsigned*)(C.lds + MISC_OFF);
    for (int u = C.tid; u < (LDS_BYTES - RING_BYTES) / 4; u += NTHREADS) ((LAS unsigned*)(C.lds + RING_BYTES))[u] = 0u;
    __syncthreads();
    XcdBarrier bar; bar.bar = C.ctl + CW_BAR; bar.x = 0; bar.st = nullptr;
    if (args.use_bar) bar = xcd_barrier_post(C.ctl + CW_BAR, MISC + 8);
    const int lo = args.ph_lo, hi = args.ph_hi;
#ifdef PROBE_DELAY_TICKS
    { const unsigned long long t0 = __builtin_amdgcn_s_memrealtime(); while (__builtin_amdgcn_s_memrealtime() - t0 < (unsigned long long)PROBE_DELAY_TICKS) __builtin_amdgcn_s_sleep(32); }
#endif
#ifdef PROBE_AMPLIFY
    { const unsigned long long t0 = __builtin_amdgcn_s_memrealtime(); xcd_barrier(bar);
      if (blockIdx.x == PROBE_AMPLIFY - 1) { const unsigned long long dt = __builtin_amdgcn_s_memrealtime() - t0; while (__builtin_amdgcn_s_memrealtime() - t0 < 5ull * dt) __builtin_amdgcn_s_sleep(32); } }
#endif
    _Pragma("unroll") for (int rep = 0; rep < NREP(7); ++rep) if (EN(7) && IN(0)) { FRESH(K); p0_prologue(K, NREP(7) == 1 ? 31 : (rep == 0 ? PROBE_PMASK : (31 & ~PROBE_PMASK))); REPBAR(7, rep); }
    SEAM(0);
    run_layer<0>(C, bar, lo, hi);
    run_layer<1>(C, bar, lo, hi);
#undef IN
#undef SEAM
}

#ifndef MK_ONE_LAUNCH
#define MK_ONE_LAUNCH 1
#endif
extern "C" void kernel_launch(void* const* d_in, const int* in_sizes, int n_in, void* d_out, int out_size, void* d_ws, size_t ws_size, hipStream_t stream) {
    static int grid = 0;
    if (grid == 0) {
        if (n_in != 30 || out_size != (int)O_END || ws_size < WS_END) { fprintf(stderr, "kernel_launch: unexpected shapes (n_in %d, out %d, ws %zu < %zu); nothing launched\n", n_in, out_size, ws_size, (size_t)WS_END); grid = -1; return; }
        int dev = 0, cus = 0, per_cu = 0;
        if (hipGetDevice(&dev) != hipSuccess || hipDeviceGetAttribute(&cus, hipDeviceAttributeMultiprocessorCount, dev) != hipSuccess) { grid = -1; return; }
        if (hipFuncSetAttribute((const void*)fwd_kernel, hipFuncAttributeMaxDynamicSharedMemorySize, LDS_BYTES) != hipSuccess) { fprintf(stderr, "kernel_launch: hipFuncSetAttribute failed\n"); grid = -1; return; }
        if (hipOccupancyMaxActiveBlocksPerMultiprocessor(&per_cu, (const void*)fwd_kernel, NTHREADS, LDS_BYTES) != hipSuccess || per_cu < 1) { fprintf(stderr, "kernel_launch: occupancy query says %d blocks per CU\n", per_cu); }
        (void)hipGetLastError();
        grid = cus;
    }
    if (grid < 0) return;
    if (hipMemsetAsync((char*)d_ws + WS_CTL, 0, CTL_ZERO_BYTES, stream) != hipSuccess) return;
    Args a{};
    for (int i = 0; i < 30; ++i) a.in[i] = (const float*)d_in[i];
    a.out = (float*)d_out; a.ws = (unsigned char*)d_ws;
#if MK_ONE_LAUNCH
    a.ph_lo = 0; a.ph_hi = N_PHASES; a.use_bar = 1;
    hipLaunchKernelGGL(fwd_kernel, dim3(grid), dim3(NTHREADS), LDS_BYTES, stream, a);
#else
    for (int p = 0; p < N_PHASES; ++p) { a.ph_lo = p; a.ph_hi = p + 1; a.use_bar = 0; hipLaunchKernelGGL(fwd_kernel, dim3(grid), dim3(NTHREADS), LDS_BYTES, stream, a); }
#endif
}
```

```cpp
#include <hip/hip_runtime.h>
#include <cstdio>
#include <cstdint>
namespace pg8 {
#define PG8_LAS __attribute__((address_space(3)))
typedef unsigned short bf16_t;
typedef short bf16x8 __attribute__((ext_vector_type(8)));
typedef float f32x4 __attribute__((ext_vector_type(4)));
typedef unsigned u32x4 __attribute__((ext_vector_type(4)));
constexpr int BM = 256, BK = 64, HALF = 128, HTB = HALF * BK * 2  , STAGE_BYTES = 8 * HTB, NXCD = 8, WGM = 8;

__host__ __device__ __forceinline__ int lds_byte(int r, int c) { const int st = (r >> 4) * 2 + (c >> 5), rr = r & 15, cc = c & 31, ob = rr * 64 + cc * 2; return st * 1024 + (ob ^ (((ob >> 9) & 1) << 5)); }
__host__ __device__ __forceinline__ void stage_rc(int b, int& R, int& C) { const int st = b / 1024, sb = b % 1024, swz = sb ^ (((sb >> 9) & 1) << 5); R = (st >> 1) * 16 + swz / 64; C = (st & 1) * 32 + (swz % 64) / 2; }
__host__ __device__ __forceinline__ int perm32(int rho) { const int n = rho >> 4, i = rho & 15; return 8 * (i >> 2) + 4 * n + (i & 3); }

struct Unit { int pm, pn; };
struct Gemm { const bf16_t* A; const bf16_t* Bt; int M, N, K; };

struct StaticOrder {
    int nM, nN, nwg, G, c;
    __host__ __device__ void init(int M, int N, int G_, int c_) { nM = M / BM; nN = N / BM; nwg = nM * nN; G = G_; c = c_; }
    __host__ __device__ bool next(int i, Unit& u) const {
        const long L = (long)i * G + c; if (L >= nwg) return false;
        int wgid = (int)L; { const int q = nwg / NXCD, r = nwg % NXCD, xcd = wgid % NXCD, off = wgid / NXCD; wgid = (xcd < r ? xcd * (q + 1) : r * (q + 1) + (xcd - r) * q) + off; }
        const int nig = WGM * nN, gid = wgid / nig, fm = gid * WGM, gsz = (nM - fm) < WGM ? (nM - fm) : WGM;
        u.pm = fm + ((wgid % nig) % gsz); u.pn = (wgid % nig) / gsz; return true;
    }
    __device__ __forceinline__ void a_ready(const Unit&) const {}
    __device__ __forceinline__ void done(const Unit&) const {}
};

__device__ __forceinline__ unsigned cvt_pk_bf16(float lo, float hi) { unsigned r; asm volatile("v_cvt_pk_bf16_f32 %0, %1, %2" : "=v"(r) : "v"(lo), "v"(hi)); return r; }
typedef float f32x2 __attribute__((ext_vector_type(2)));
struct EpiF32 {
    static constexpr bool PERM = false, AFTER_DRAIN = false;
    float* C; int ldc; const float* bias;
    __device__ __forceinline__ void operator()(const f32x4 (&acc)[2][2][4][2], const Unit& u, int wr, int wc, int fr, int fq) const {
        const int row0 = u.pm * BM + wr * 64 + fr, col0 = u.pn * BM + wc * 32 + 4 * fq;
        f32x4 bv[2][2];
#pragma unroll
        for (int bj = 0; bj < 2; ++bj)
#pragma unroll
            for (int n = 0; n < 2; ++n) bv[bj][n] = bias ? *(const f32x4*)(bias + col0 + bj * HALF + n * 16) : (f32x4){0.f, 0.f, 0.f, 0.f};
#pragma unroll
        for (int ai = 0; ai < 2; ++ai)
#pragma unroll
            for (int m = 0; m < 4; ++m) { float* rowp = C + (size_t)(row0 + ai * HALF + m * 16) * ldc + col0;
#pragma unroll
                for (int bj = 0; bj < 2; ++bj)
#pragma unroll
                    for (int n = 0; n < 2; ++n) *(f32x4*)(rowp + bj * HALF + n * 16) = acc[ai][bj][m][n] + bv[bj][n]; }
    }
};
template <class Epi, class Sched, bool ALIGN_EPI = false, bool SP2 = false>
__device__ __forceinline__ void gemm_phase(PG8_LAS unsigned char* lds, const Gemm g, const Sched& S, const Epi& E) {
    const int tid = threadIdx.x, wid = __builtin_amdgcn_readfirstlane(tid >> 6), lane = tid & 63, wr = wid >> 2, wc = wid & 3, fr = lane & 15, fq = lane >> 4;
    const int K = g.K, nt = K / BK;
    unsigned voffA[2], voffB[2];
#pragma unroll
    for (int i = 0; i < 2; ++i) { int R, C; stage_rc(tid * 16 + i * 8192, R, C); const int Rb = Epi::PERM ? ((R & ~31) + perm32(R & 31)) : R;
        voffA[i] = (unsigned)(R * K + C) * 2u; voffB[i] = (unsigned)(Rb * K + C) * 2u; }
    const size_t kstep = (size_t)(BK * 2);
    const size_t hstep = (size_t)HALF * K * 2;
    const size_t tstep = 2 * hstep;
    const unsigned ldsw = (unsigned)wid * 1024u;
    const int aoff = lds_byte(wr * 64 + fr, fq * 8), boff = lds_byte(wc * 32 + fr, fq * 8);
#define PG8_SA(b, h) (((b) * 2 + (h)) * HTB)
#define PG8_SB(b, h) ((4 + (b) * 2 + (h)) * HTB)
#define PG8_STAGE(bufoff, gbase, voff) do { _Pragma("unroll") for (int _i = 0; _i < 2; ++_i) \
        __builtin_amdgcn_global_load_lds((const unsigned*)((const char*)(gbase) + (voff)[_i]), (PG8_LAS unsigned*)(lds + (bufoff) + ldsw + _i * 8192), 16, 0, 0); } while (0)
#define PG8_LDA(dst, b, h) do { _Pragma("unroll") for (int m = 0; m < 4; ++m) _Pragma("unroll") for (int k = 0; k < 2; ++k) dst[m][k] = *(const PG8_LAS bf16x8*)(lds + PG8_SA(b, h) + aoff + m * 2048 + k * 1024); } while (0)
#define PG8_LDB(dst, b, h) do { _Pragma("unroll") for (int n = 0; n < 2; ++n) _Pragma("unroll") for (int k = 0; k < 2; ++k) dst[n][k] = *(const PG8_LAS bf16x8*)(lds + PG8_SB(b, h) + boff + n * 2048 + k * 1024); } while (0)
#define PG8_MMA(ai, bj, At, Bt) do { __builtin_amdgcn_s_setprio(1); _Pragma("unroll") for (int m = 0; m < 4; ++m) _Pragma("unroll") for (int n = 0; n < 2; ++n) _Pragma("unroll") for (int k = 0; k < 2; ++k) \
        acc[ai][bj][m][n] = __builtin_amdgcn_mfma_f32_16x16x32_bf16(Bt[n][k], At[m][k], acc[ai][bj][m][n], 0, 0, 0); __builtin_amdgcn_s_setprio(0); } while (0)
#define PG8_WAIT_V(n) asm volatile("s_waitcnt vmcnt(" #n ")" ::: "memory")
#define PG8_WAIT_L(n) asm volatile("s_waitcnt lgkmcnt(" #n ")" ::: "memory")
#define PG8_BAR __builtin_amdgcn_s_barrier()
#define PG8_SCHED __builtin_amdgcn_sched_barrier(0)
    Unit cur, nxt; int ui = 0;
    if (!S.next(0, cur)) return;
    f32x4 acc[2][2][4][2];
#pragma unroll
    for (int a = 0; a < 2; ++a)
#pragma unroll
        for (int b = 0; b < 2; ++b)
#pragma unroll
            for (int m = 0; m < 4; ++m)
#pragma unroll
                for (int n = 0; n < 2; ++n) acc[a][b][m][n] = (f32x4){0.f, 0.f, 0.f, 0.f};
    bf16x8 At[4][2], B0[2][2], B1[2][2];
    const char* cA = (const char*)g.A + (size_t)cur.pm * tstep; const char* cB = (const char*)g.Bt + (size_t)cur.pn * tstep;
    S.a_ready(cur);
    if constexpr (SP2) {
        PG8_STAGE(PG8_SB(0, 0), cB, voffB); PG8_STAGE(PG8_SB(0, 1), cB + hstep, voffB); PG8_STAGE(PG8_SA(0, 0), cA, voffA); PG8_STAGE(PG8_SA(0, 1), cA + hstep, voffA);
        if (wr == 1) PG8_BAR;
        PG8_WAIT_V(2); PG8_BAR;
        PG8_STAGE(PG8_SB(1, 0), cB + kstep, voffB); PG8_STAGE(PG8_SA(1, 0), cA + kstep, voffA); PG8_STAGE(PG8_SB(1, 1), cB + hstep + kstep, voffB);
        PG8_WAIT_V(6); PG8_BAR;
    } else {
        PG8_STAGE(PG8_SB(0, 0), cB, voffB); PG8_STAGE(PG8_SA(0, 0), cA, voffA); PG8_STAGE(PG8_SB(0, 1), cB + hstep, voffB); PG8_STAGE(PG8_SA(0, 1), cA + hstep, voffA);
        if (wr == 1) PG8_BAR;
        PG8_WAIT_V(4); PG8_BAR;
        PG8_STAGE(PG8_SB(1, 0), cB + kstep, voffB); PG8_STAGE(PG8_SA(1, 0), cA + kstep, voffA); PG8_STAGE(PG8_SB(1, 1), cB + hstep + kstep, voffB);
        PG8_WAIT_V(6); PG8_BAR;
    }
    for (;;) {
        const bool has_next = S.next(ui + 1, nxt);
        const char* nA = has_next ? (const char*)g.A + (size_t)nxt.pm * tstep : cA; const char* nB = has_next ? (const char*)g.Bt + (size_t)nxt.pn * tstep : cB;
        for (int t = 0; t < nt; t += 2) {
            const bool last = (t == nt - 2);
            const char* a1 = cA + (size_t)(t + 1) * kstep;
            const char* a2 = last ? nA : cA + (size_t)(t + 2) * kstep; const char* b2 = last ? nB : cB + (size_t)(t + 2) * kstep;
            const char* a3 = a2 + kstep; const char* b3 = b2 + kstep;
            if (last && has_next) S.a_ready(nxt);
            if constexpr (SP2) {
            PG8_LDB(B0, 0, 0); PG8_LDB(B1, 0, 1); PG8_SCHED; PG8_LDA(At, 0, 0); PG8_STAGE(PG8_SA(1, 1), a1 + hstep, voffA);
            PG8_WAIT_V(8); PG8_WAIT_L(0); PG8_BAR; PG8_MMA(0, 0, At, B0); PG8_MMA(0, 1, At, B1); PG8_BAR; PG8_SCHED;
            PG8_LDA(At, 0, 1); PG8_STAGE(PG8_SB(0, 0), b2, voffB); PG8_STAGE(PG8_SB(0, 1), b2 + hstep, voffB); PG8_STAGE(PG8_SA(0, 0), a2, voffA);
            PG8_WAIT_V(8); PG8_WAIT_L(0); PG8_BAR; PG8_MMA(1, 0, At, B0); PG8_MMA(1, 1, At, B1); PG8_BAR; PG8_SCHED;
            PG8_LDB(B0, 1, 0); PG8_LDB(B1, 1, 1); PG8_SCHED; PG8_LDA(At, 1, 0); PG8_STAGE(PG8_SA(0, 1), a2 + hstep, voffA);
            PG8_WAIT_V(8); PG8_WAIT_L(0); PG8_BAR; PG8_MMA(0, 0, At, B0); PG8_MMA(0, 1, At, B1); PG8_BAR; PG8_SCHED;
            PG8_LDA(At, 1, 1); PG8_STAGE(PG8_SB(1, 0), b3, voffB); PG8_STAGE(PG8_SB(1, 1), b3 + hstep, voffB); PG8_STAGE(PG8_SA(1, 0), a3, voffA);
            PG8_WAIT_V(8); PG8_WAIT_L(0); PG8_BAR; PG8_MMA(1, 0, At, B0); PG8_MMA(1, 1, At, B1); PG8_BAR; PG8_SCHED;
            } else {
            PG8_LDB(B0, 0, 0); PG8_SCHED; PG8_LDA(At, 0, 0); PG8_STAGE(PG8_SA(1, 1), a1 + hstep, voffA);
            PG8_WAIT_L(8); PG8_BAR; PG8_WAIT_L(0); PG8_MMA(0, 0, At, B0); PG8_BAR; PG8_SCHED;
            PG8_LDB(B1, 0, 1); PG8_STAGE(PG8_SB(0, 0), b2, voffB);
            PG8_BAR; PG8_WAIT_L(0); PG8_MMA(0, 1, At, B1); PG8_BAR;
            PG8_LDA(At, 0, 1); PG8_STAGE(PG8_SA(0, 0), a2, voffA);
            PG8_BAR; PG8_WAIT_L(0); PG8_MMA(1, 0, At, B0); PG8_BAR; PG8_SCHED;
            PG8_STAGE(PG8_SB(0, 1), b2 + hstep, voffB);
            PG8_WAIT_V(6); PG8_BAR; PG8_MMA(1, 1, At, B1); PG8_BAR;
            PG8_LDB(B0, 1, 0); PG8_SCHED; PG8_LDA(At, 1, 0); PG8_STAGE(PG8_SA(0, 1), a2 + hstep, voffA);
            PG8_WAIT_L(8); PG8_BAR; PG8_WAIT_L(0); PG8_MMA(0, 0, At, B0); PG8_BAR; PG8_SCHED;
            PG8_LDB(B1, 1, 1); PG8_STAGE(PG8_SB(1, 0), b3, voffB);
            PG8_BAR; PG8_WAIT_L(0); PG8_MMA(0, 1, At, B1); PG8_BAR;
            PG8_LDA(At, 1, 1); PG8_STAGE(PG8_SA(1, 0), a3, voffA);
            PG8_BAR; PG8_WAIT_L(0); PG8_MMA(1, 0, At, B0); PG8_BAR; PG8_SCHED;
            PG8_STAGE(PG8_SB(1, 1), b3 + hstep, voffB);
            PG8_WAIT_V(6); PG8_BAR; PG8_MMA(1, 1, At, B1); PG8_BAR;
            }
        }
        if constexpr (ALIGN_EPI) { if (wr == 0) PG8_BAR; }
        if constexpr (!Epi::AFTER_DRAIN) { E(acc, cur, wr, wc, fr, fq); S.done(cur); }
        if (!has_next) break;
#pragma unroll
        for (int a = 0; a < 2; ++a)
#pragma unroll
            for (int b = 0; b < 2; ++b)
#pragma unroll
                for (int m = 0; m < 4; ++m)
#pragma unroll
                    for (int n = 0; n < 2; ++n) acc[a][b][m][n] = (f32x4){0.f, 0.f, 0.f, 0.f};
        cur = nxt; cA = nA; cB = nB; ++ui;
        if constexpr (ALIGN_EPI) { if (wr == 1) PG8_BAR; }
    }
    PG8_WAIT_V(0);
    if constexpr (!ALIGN_EPI) { if (wr == 0) PG8_BAR; }
    PG8_BAR;
    if constexpr (Epi::AFTER_DRAIN) { E.fused(acc, cur, wr, wc, fr, fq, lds, wid, lane); S.done(cur); }
#undef PG8_SA
#undef PG8_SB
#undef PG8_STAGE
#undef PG8_LDA
#undef PG8_LDB
#undef PG8_MMA
#undef PG8_WAIT_V
#undef PG8_WAIT_L
#undef PG8_BAR
#undef PG8_SCHED
}
}
#define LAS __attribute__((address_space(3)))
#define XB_TMO      128
#define XB_XCNT(j)  (256  + 64 * (j))
#define XB_XSUB(j)  (1280 + 64 * (j))
#define XB_XGEN(j)  (2304 + 64 * (j))
#define XB_TOP      3328
#define XB_TOPGEN   3392
#define XCD_BAR_WORDS 3456
#define XB_SPIN_CAP (1u << 18)

__device__ __forceinline__ unsigned xb_ld(unsigned* p)              { return __hip_atomic_load(p, __ATOMIC_RELAXED, __HIP_MEMORY_SCOPE_AGENT); }
__device__ __forceinline__ unsigned xb_add(unsigned* p, unsigned v) { return __hip_atomic_fetch_add(p, v, __ATOMIC_RELAXED, __HIP_MEMORY_SCOPE_AGENT); }
__device__ __forceinline__ unsigned xb_xcc_id() { return (unsigned)__builtin_amdgcn_s_getreg((3 << 11) | 20) & 0xFu; }
#define XB_SPIN(cond, bar) do { unsigned _sp = 0; while (cond) { __builtin_amdgcn_s_sleep(1); \
    if ((++_sp & 255u) == 0u) { if (xb_ld(&(bar)[XB_TMO])) break; if (_sp > XB_SPIN_CAP) { atomicAdd(&(bar)[XB_TMO], 1u); break; } } } } while (0)

struct XcdBarrier {
    unsigned* bar; unsigned x;
    volatile LAS unsigned* st;
};

__device__ __forceinline__ XcdBarrier xcd_barrier_post(unsigned* bar, volatile LAS unsigned* st) {
    XcdBarrier b; b.bar = bar; b.x = xb_xcc_id(); b.st = st;
    if (threadIdx.x == 0) (void)xb_add(&bar[XB_XCNT(b.x)], 1u);
    return b;
}
__device__ __forceinline__ void xcd_barrier_complete(unsigned* bar, unsigned x, unsigned& nloc, unsigned& nx) {
    const unsigned G = gridDim.x * gridDim.y * gridDim.z;
    unsigned sum, cnt, mine, sp = 0u;
    for (;;) {
        sum = 0u; cnt = 0u; mine = 0u;
#pragma unroll
        for (unsigned j = 0; j < 16; ++j) { const unsigned c = xb_ld(&bar[XB_XCNT(j)]); sum += c; cnt += (c > 0u) ? 1u : 0u; mine = (j == x) ? c : mine; }
        if (sum == G) break;
        __builtin_amdgcn_s_sleep(1);
        if ((++sp & 255u) == 0u) { if (xb_ld(&bar[XB_TMO])) break; if (sp > XB_SPIN_CAP) { atomicAdd(&bar[XB_TMO], 1u); break; } }
    }
    nloc = mine > 0u ? mine : 1u; nx = cnt > 0u ? cnt : 1u;
}

__device__ __forceinline__ void xcd_barrier(const XcdBarrier& b) {
    asm volatile("s_waitcnt vmcnt(0)" ::: "memory");
    __syncthreads();
    if (threadIdx.x == 0) {
        unsigned* bar = b.bar;
        __builtin_amdgcn_s_waitcnt(0);
        unsigned nloc = b.st[0], nx = b.st[1];
        if (nloc == 0u) { xcd_barrier_complete(bar, b.x, nloc, nx); b.st[0] = nloc; b.st[1] = nx; }
        const unsigned old = xb_add(&bar[XB_XSUB(b.x)], 1u);
        const unsigned gen = old / nloc;
        if (old + 1u == (gen + 1u) * nloc) {
            __builtin_amdgcn_fence(__ATOMIC_RELEASE, "agent");
            asm volatile("s_waitcnt vmcnt(0)" ::: "memory");
            const unsigned og = xb_add(&bar[XB_TOP], 1u);
            const unsigned tg = og / nx;
            if (og + 1u == (tg + 1u) * nx) xb_add(&bar[XB_TOPGEN], 1u);
            else XB_SPIN(xb_ld(&bar[XB_TOPGEN]) == tg, bar);
            __builtin_amdgcn_fence(__ATOMIC_ACQUIRE, "agent");
            xb_add(&bar[XB_XGEN(b.x)], 1u);
            asm volatile("s_waitcnt vmcnt(0)" ::: "memory");
        } else {
            XB_SPIN(xb_ld(&bar[XB_XGEN(b.x)]) == gen, bar);
            __builtin_amdgcn_fence(__ATOMIC_ACQUIRE, "agent");
            asm volatile("s_waitcnt vmcnt(0)" ::: "memory");
        }
    }
    __syncthreads();
}

constexpr int NWAVES = 8, NTHREADS = 512;
constexpr int DM = 2048, NTP = 8192, NTS = 32, NT = 8224, MP = 8448;
constexpr int RW_COLS = 3360, Q_OFF = 3360, KC_OFF = 4384, KS_OFF = 4896, VS_OFF = 5152, KW_OFF = 5408, VW_OFF = 5664, GL_OFF = 5920, IN_COLS = 5968, PLD = 6144;
constexpr int NEXP = 16384, NPOOL = 1280;
constexpr float LN_EPS = 1e-5f, GN_EPS = 64e-5f, DN_ALPHA = 1.4142135623730951f;
constexpr float NEG_BIG = -1e30f;
constexpr size_t O_YP = 0, O_YS = O_YP + (size_t)NTP * DM, O_CMP_P = O_YS + (size_t)NTS * DM, O_SEL_P = O_CMP_P + (size_t)2 * NTP * 512, O_WIN_P = O_SEL_P + (size_t)2 * NTP * 512,
                 O_RW_P = O_WIN_P + (size_t)2 * 4 * 512 * 512, O_SH_P = O_RW_P + (size_t)2 * 4 * 16 * 4096, O_CMP_S = O_SH_P + (size_t)2 * 4 * RW_COLS, O_SEL_S = O_CMP_S + (size_t)2 * NTS * 512,
                 O_WIN_S = O_SEL_S + (size_t)2 * NTS * 512, O_RW_S = O_WIN_S + (size_t)2 * 8 * 512 * 512, O_SH_S = O_RW_S + (size_t)2 * 8 * 16 * 4096, O_END = O_SH_S + (size_t)2 * 8 * RW_COLS;
static_assert(O_END == 41630464, "output size");
constexpr size_t MiB = 1ull << 20;
constexpr size_t WS_CTL = 0, CTL_ZERO_BYTES = 1 * MiB;
constexpr size_t WS_WIN = 1 * MiB;
constexpr size_t WS_WOUT = WS_WIN + 48 * MiB;
constexpr size_t WS_W2 = WS_WOUT + 16 * MiB;
constexpr size_t WS_UB = WS_W2 + 16 * MiB;
constexpr size_t WS_VB = WS_UB + 64 * MiB;
constexpr size_t WS_USC = WS_VB + 64 * MiB;
constexpr size_t WS_XB = WS_USC + 1 * MiB;
constexpr size_t WS_X1B = WS_XB + 33 * MiB;
constexpr size_t WS_XF1 = WS_X1B + 33 * MiB;
constexpr size_t WS_X1F = WS_XF1 + 65 * MiB;
constexpr size_t WS_PROJ = WS_X1F + 65 * MiB;
constexpr size_t WS_SC = WS_PROJ + 99 * MiB;
constexpr size_t SC_STRIDE = 33 * MiB;
constexpr size_t WS_GG = WS_SC + 6 * SC_STRIDE;
constexpr size_t WS_BON = WS_GG + 33 * MiB;
constexpr size_t WS_MIX = WS_BON + 1 * MiB;
constexpr size_t WS_HS = WS_MIX + 33 * MiB;
constexpr size_t WS_KCB = WS_HS + 66 * MiB;
constexpr size_t WS_VCBT = WS_KCB + 512 * 1024;
constexpr size_t WS_VTS = WS_KCB + 1 * MiB;
constexpr size_t WS_VTW = WS_VTS + 4 * MiB;
constexpr size_t WS_KCBS = WS_VTW + 4 * MiB;
constexpr size_t WS_VCBS = WS_KCBS + 17 * MiB;
constexpr size_t WS_LT = WS_VCBS + 17 * MiB;
constexpr size_t WS_KSC = WS_LT + 2 * MiB;
constexpr size_t WS_KWC = WS_KSC + 4 * MiB;
constexpr size_t WS_OPS = WS_KWC + 4 * MiB;
constexpr size_t OPS_BYTES = 51200;
constexpr size_t WS_EL = WS_OPS + 80 * MiB;
constexpr size_t WS_GT = WS_EL + 3 * MiB;
constexpr size_t WS_PD = WS_GT + 5 * MiB;
constexpr size_t WS_WP = WS_PD + 65 * MiB;
constexpr size_t WS_FO = WS_WP + 5 * MiB;
constexpr size_t WS_X1Q = WS_FO + 65 * MiB;
constexpr size_t WS_XQS = WS_X1Q + 17 * MiB;
constexpr size_t WS_END = WS_XQS + 1 * MiB;
constexpr int CW_BAR = 4096, CW_QUEUE = 8192, CW_SQ = 65536, CW_FLAG = 16384;
constexpr int RING_BYTES = 131072, MISC_OFF = RING_BYTES + 320, LDS_BYTES = 147456;
constexpr int N_PHASES = 23;

typedef unsigned short bf16;
typedef unsigned v4u __attribute__((ext_vector_type(4)));
typedef unsigned v2u __attribute__((ext_vector_type(2)));
typedef float f32x4 __attribute__((ext_vector_type(4)));
typedef float f32x16 __attribute__((ext_vector_type(16)));
typedef short bf16x8 __attribute__((ext_vector_type(8)));
typedef float f32x2_t __attribute__((ext_vector_type(2)));
typedef __bf16 bf16x2_t __attribute__((ext_vector_type(2)));
#define LDS_WAIT() asm volatile("s_waitcnt lgkmcnt(0)" ::: "memory")
#define DI __device__ __forceinline__
#define GAS __attribute__((address_space(1)))
template <class T> DI T* launder_g(T* p) { GAS T* g = (GAS T*)p; asm volatile("" : "+s"(g)); return (T*)g; }

DI unsigned pk2(float lo, float hi) { f32x2_t v = {lo, hi}; bf16x2_t b = __builtin_convertvector(v, bf16x2_t); return __builtin_bit_cast(unsigned, b); }
DI float bf2f(unsigned short u) { return __builtin_bit_cast(float, (unsigned)u << 16); }
DI float bflo(unsigned u) { return __builtin_bit_cast(float, u << 16); }
DI float bfhi(unsigned u) { return __builtin_bit_cast(float, u & 0xffff0000u); }
template <int CTRL> DI float dppf(float v) { return __builtin_bit_cast(float, __builtin_amdgcn_update_dpp(0, __builtin_bit_cast(int, v), CTRL, 0xF, 0xF, false)); }
DI float rdlane(float v, int l) { return __builtin_bit_cast(float, __builtin_amdgcn_readlane(__builtin_bit_cast(int, v), l)); }
DI float wave_sum(float v) {
    v += dppf<0xB1>(v); v += dppf<0x4E>(v); v += dppf<0x141>(v); v += dppf<0x140>(v);
    return (rdlane(v, 0) + rdlane(v, 16)) + (rdlane(v, 32) + rdlane(v, 48));
}
DI float wave_max(float v) {
    v = fmaxf(v, dppf<0xB1>(v)); v = fmaxf(v, dppf<0x4E>(v)); v = fmaxf(v, dppf<0x141>(v)); v = fmaxf(v, dppf<0x140>(v));
    return fmaxf(fmaxf(rdlane(v, 0), rdlane(v, 16)), fmaxf(rdlane(v, 32), rdlane(v, 48)));
}
DI float sigmoidf_(float x) { return 1.f / (1.f + expf(-x)); }
DI int crow(int reg, int h) { return (reg & 3) + 8 * (reg >> 2) + 4 * h; }

struct ArgsK { const float* in[30]; float* out; unsigned char* ws; int ph_lo, ph_hi, use_bar, pad; };
struct ArgsG { const GAS float* in[30]; GAS float* out; GAS unsigned char* ws; int ph_lo, ph_hi, use_bar, pad; };
typedef __attribute__((address_space(4))) const ArgsG* kargp_t;
struct Ctx {
    float* out; unsigned char* ws;
    LAS unsigned char* lds; unsigned* ctl;
    int tid, lane, wave, G;
    DI const float* inp(int k) const { kargp_t p = (kargp_t)__builtin_amdgcn_kernarg_segment_ptr(); asm volatile("" : "+s"(p)); return (const float*)p->in[k]; }
};
template <class T> DI T* wsp(const Ctx& C, size_t off) { return (T*)(C.ws + off); }

struct EpiInProj {
    static constexpr bool PERM = true, AFTER_DRAIN = false;
    bf16* P; float* out; int l;
    DI void operator()(const pg8::f32x4 (&acc)[2][2][4][2], const pg8::Unit& u, int wr, int wc, int fr, int fq) const {
        const int row0 = u.pm * 256 + wr * 64 + fr, col0 = u.pn * 256 + wc * 32 + 8 * fq;
#pragma unroll
        for (int bj = 0; bj < 2; ++bj) {
            const int colb = __builtin_amdgcn_readfirstlane(u.pn * 256 + wc * 32 + bj * 128);
            const int col = col0 + bj * 128;
            const int kind = colb < RW_COLS ? 1 : ((colb >= KC_OFF && colb < GL_OFF) ? 2 : 0);
            const int reg = (colb - KC_OFF) >> 9, cc = (col - KC_OFF) & 511;
#pragma unroll
            for (int ai = 0; ai < 2; ++ai)
#pragma unroll
                for (int m = 0; m < 4; ++m) {
                    const int row = row0 + ai * 128 + m * 16;
                    const pg8::f32x4 v0 = acc[ai][bj][m][0], v1 = acc[ai][bj][m][1];
                    v4u w; w.x = pk2(v0[0], v0[1]); w.y = pk2(v0[2], v0[3]); w.z = pk2(v1[0], v1[1]); w.w = pk2(v1[2], v1[3]);
                    *(v4u*)(P + (size_t)row * PLD + col) = w;
                    if (kind == 0 || row >= NT) continue;
                    unsigned off = 0xffffffffu;
                    if (row < NTP) { const int b = row >> 11, t = row & 2047;
                        if (kind == 1) { if (t == 2047) off = (unsigned)(O_SH_P + (size_t)(l * 4 + b) * RW_COLS + col); }
                        else if (reg == 0) off = (unsigned)(O_CMP_P + ((size_t)l * NTP + row) * 512 + cc);
                        else if (reg == 1) off = (unsigned)(O_SEL_P + ((size_t)l * NTP + row) * 512 + cc);
                        else if (t >= 1536) off = (unsigned)(O_WIN_P + ((size_t)(l * 4 + b) * 512 + (t - 1536)) * 512 + cc);
                    } else { const int j = row - NTP, b = j >> 2, t = j & 3;
                        if (kind == 1) { if (t == 3) off = (unsigned)(O_SH_S + (size_t)(l * 8 + b) * RW_COLS + col); }
                        else if (reg == 0) off = (unsigned)(O_CMP_S + ((size_t)l * NTS + j) * 512 + cc);
                        else if (reg == 1) off = (unsigned)(O_SEL_S + ((size_t)l * NTS + j) * 512 + cc);
                        else off = (unsigned)(O_WIN_S + ((size_t)(l * 8 + b) * 512 + 508 + t) * 512 + cc);
                    }
                    if (off != 0xffffffffu) { *(pg8::f32x4*)(out + off) = v0; *(pg8::f32x4*)(out + off + 4) = v1; }
                }
        }
    }
};

struct EpiBf16Row {
    static constexpr bool PERM = true, AFTER_DRAIN = false;
    bf16* Cb; int ldc;
    DI void operator()(const pg8::f32x4 (&acc)[2][2][4][2], const pg8::Unit& u, int wr, int wc, int fr, int fq) const {
        const int row0 = u.pm * 256 + wr * 64 + fr, col0 = u.pn * 256 + wc * 32 + 8 * fq;
#pragma unroll
        for (int bj = 0; bj < 2; ++bj)
#pragma unroll
            for (int ai = 0; ai < 2; ++ai)
#pragma unroll
                for (int m = 0; m < 4; ++m) { const pg8::f32x4 v0 = acc[ai][bj][m][0], v1 = acc[ai][bj][m][1];
                    v4u w; w.x = pk2(v0[0], v0[1]); w.y = pk2(v0[2], v0[3]); w.z = pk2(v1[0], v1[1]); w.w = pk2(v1[2], v1[3]);
                    *(v4u*)(Cb + (size_t)(row0 + ai * 128 + m * 16) * ldc + col0 + bj * 128) = w; }
    }
};

template <class Sink> DI void skinny_gemm(const Ctx& C, const bf16* A, const bf16* Bt, int nslabs, const Sink& sink) {
    const int tid = C.tid, lane = C.lane, wave = C.wave, r = lane & 31, hi = lane >> 5;
    LAS float* PS = (LAS float*)C.lds;
    for (int it = blockIdx.x; it < nslabs; it += C.G) {
        const int n0 = it * 32, k0 = wave * 256;
        f32x16 acc;
#pragma unroll
        for (int i = 0; i < 16; ++i) acc[i] = 0.f;
        const bf16* ap = A + (size_t)r * DM + k0 + 8 * hi; const bf16* bp = Bt + (size_t)(n0 + r) * DM + k0 + 8 * hi;
#pragma unroll 8
        for (int s = 0; s < 16; ++s) { const bf16x8 af = *(const bf16x8*)(ap + 16 * s), bf = *(const bf16x8*)(bp + 16 * s); acc = __builtin_amdgcn_mfma_f32_32x32x16_bf16(af, bf, acc, 0, 0, 0); }
        __syncthreads();
#pragma unroll
        for (int i = 0; i < 16; ++i) PS[(wave * 32 + crow(i, hi)) * 33 + r] = acc[i];
        __syncthreads();
#pragma unroll
        for (int e = 0; e < 2; ++e) { const int o = tid * 2 + e, row = o >> 5, col = o & 31; float v = 0.f;
#pragma unroll
            for (int w = 0; w < 8; ++w) v += PS[(w * 32 + row) * 33 + col];
            sink(row, n0 + col, v); }
    }
    __syncthreads();
}

DI void transpose_item(const float* W, int K, int N, int Npad, bf16* WT, LAS float* scr, int item, int lane) {
    const int nblk = Npad / 32, kb = item / nblk, nb = item % nblk, k0 = 64 * kb, n0 = 32 * nb;
    float tv[32];
#pragma unroll
    for (int i = 0; i < 32; ++i) { const int kk = 2 * i + (lane >> 5), n = n0 + (lane & 31); tv[i] = n < N ? W[(size_t)(k0 + kk) * N + n] : 0.f; }
#pragma unroll
    for (int i = 0; i < 32; ++i) { const int kk = 2 * i + (lane >> 5); scr[kk * 33 + (lane & 31)] = tv[i]; }
    LDS_WAIT(); asm volatile("" ::: "memory");
    const int c = lane & 7;
#pragma unroll
    for (int j = 0; j < 4; ++j) { const int n = (lane >> 3) + 8 * j; const LAS float* s = scr + (8 * c) * 33 + n;
        v4u o; o.x = pk2(s[0 * 33], s[1 * 33]); o.y = pk2(s[2 * 33], s[3 * 33]); o.z = pk2(s[4 * 33], s[5 * 33]); o.w = pk2(s[6 * 33], s[7 * 33]);
        *(v4u*)(WT + (size_t)(n0 + n) * K + k0 + 8 * c) = o; }
    LDS_WAIT(); asm volatile("" ::: "memory");
}


DI void p0i_table(const Ctx& C, int r) {
    const int lane = C.lane, wave = C.wave;
    f32x4 v[2][8];
#pragma unroll
    for (int h = 0; h < 2; ++h) { const int row = r * 16 + 8 * h + wave;
        const float* src = (row < 32768 ? C.inp(26) : C.inp(27)) + (size_t)(row & 32767) * DM;
#pragma unroll
        for (int k = 0; k < 2; ++k)
#pragma unroll
            for (int q = 0; q < 4; ++q) v[h][4 * k + q] = ((const f32x4*)src)[4 * lane + 256 * k + q]; }
#pragma unroll
    for (int h = 0; h < 2; ++h) { const int row = r * 16 + 8 * h + wave;
        unsigned char* dst = C.ws + (row < 32768 ? WS_UB : WS_VB) + (size_t)((row >> 14) & 1) * NEXP * DM + (size_t)(row & 16383) * 128;
        float am = 0.f;
#pragma unroll
        for (int j = 0; j < 8; ++j) am = fmaxf(am, fmaxf(fmaxf(fabsf(v[h][j][0]), fabsf(v[h][j][1])), fmaxf(fabsf(v[h][j][2]), fabsf(v[h][j][3]))));
        am = wave_max(am);
        const bool isu = row < 32768;
        const float sc = am > 0.f ? am * (isu ? 1.f / 127.f : 1.f / 256.f) : 1.f, inv = 1.f / sc;
#pragma unroll
        for (int k = 0; k < 2; ++k) { v4u o;
#pragma unroll
            for (int q = 0; q < 4; ++q) { const f32x4 x = v[h][4 * k + q] * inv;
                if (isu) o[q] = ((unsigned)(int)__builtin_rintf(x[0]) & 255u) | (((unsigned)(int)__builtin_rintf(x[1]) & 255u) << 8) | (((unsigned)(int)__builtin_rintf(x[2]) & 255u) << 16) | ((unsigned)(int)__builtin_rintf(x[3]) << 24);
                else { int p = __builtin_amdgcn_cvt_pk_fp8_f32(x[0], x[1], 0, false); p = __builtin_amdgcn_cvt_pk_fp8_f32(x[2], x[3], p, true); o[q] = (unsigned)p; } }
            *(v4u*)(dst + ((size_t)((lane >> 3) + 8 * k) * NEXP) * 128 + 16 * (lane & 7)) = o; }
        if (lane == 0) wsp<float>(C, WS_USC)[row] = sc; }
}
DI void p0i_cache(const Ctx& C, int r) {
    const int tid = C.tid;
    const int l = r >> 10, b = (r >> 7) & 7, pi = r & 127;
    const int pid = ((const int*)C.inp(4))[b * 128 + pi];
    const int q = tid >> 7, c4 = tid & 127, kv = c4 >> 6, kvh = (c4 >> 4) & 3, d0 = (c4 & 15) * 4;
    const f32x4* src = (const f32x4*)(C.inp(2) + ((size_t)(l * NPOOL + pid) * 128 + 32 * q) * 512) + c4;
    const float* w = C.inp(20) + (l * 2 + kv) * 32;
    f32x4 acc = {0.f, 0.f, 0.f, 0.f};
    f32x4 cr[32];
#pragma unroll
    for (int rr = 0; rr < 32; ++rr) cr[rr] = src[(size_t)rr * 128];
#pragma unroll
    for (int rr = 0; rr < 32; ++rr) acc += cr[rr] * w[rr];
    *(f32x4*)(wsp<float>(C, kv ? WS_VCBS : WS_KCBS) + ((size_t)((l * 8 + b) * 4 + kvh) * 512 + 4 * pi + q) * 64 + d0) = acc;
}
DI void p0i_transpose(const Ctx& C, int r) {
    const int lane = C.lane, wave = C.wave;
    const int l = r >> 10, w8 = (r & 1023) * 8 + wave;
    LAS float* scr = (LAS float*)(C.lds + wave * 16384);
    if (w8 < 6144) transpose_item(C.inp(8) + (size_t)l * DM * IN_COLS, DM, IN_COLS, PLD, wsp<bf16>(C, WS_WIN) + (size_t)l * PLD * DM, scr, w8, lane);
    else transpose_item(C.inp(21) + (size_t)l * DM * DM, DM, DM, DM, wsp<bf16>(C, WS_WOUT) + (size_t)l * DM * DM, scr, w8 - 6144, lane);
}
DI bf16x8 bf8_of(const f32x4& a, const f32x4& b) { const v4u p = {pk2(a[0], a[1]), pk2(a[2], a[3]), pk2(b[0], b[1]), pk2(b[2], b[3])}; return __builtin_bit_cast(bf16x8, p); }
DI f32x4 bf_resid(const f32x4& a, unsigned p01, unsigned p23) { return (f32x4){a[0] - bflo(p01), a[1] - bfhi(p01), a[2] - bflo(p23), a[3] - bfhi(p23)}; }
DI void p0i_w2(const Ctx& C, int r) {
    const int lane = C.lane, wave = C.wave, rr = lane & 31, hi = lane >> 5;
    const int l = r >> 9, hc = (r >> 5) & 15, kb = r & 31, kt = wave & 3, nt = wave >> 2;
    const float* sk = C.inp(25) + ((size_t)l * 16 + hc) * 16384 + (size_t)(kt * 32 + rr) * 128 + 8 * hi;
    const float* wq = C.inp(24) + (size_t)l * DM * DM + (size_t)(kb * 64 + nt * 32 + rr) * DM + hc * 128 + 8 * hi;
    f32x16 acc;
#pragma unroll
    for (int i = 0; i < 16; ++i) acc[i] = 0.f;
#pragma unroll 4
    for (int s = 0; s < 8; ++s) {
        const f32x4 a0 = *(const f32x4*)(sk + 16 * s), a1 = *(const f32x4*)(sk + 16 * s + 4), b0 = *(const f32x4*)(wq + 16 * s), b1 = *(const f32x4*)(wq + 16 * s + 4);
        const v4u ahp = {pk2(a0[0], a0[1]), pk2(a0[2], a0[3]), pk2(a1[0], a1[1]), pk2(a1[2], a1[3])}, bhp = {pk2(b0[0], b0[1]), pk2(b0[2], b0[3]), pk2(b1[0], b1[1]), pk2(b1[2], b1[3])};
        const bf16x8 ah = __builtin_bit_cast(bf16x8, ahp), bh = __builtin_bit_cast(bf16x8, bhp);
        const bf16x8 al = bf8_of(bf_resid(a0, ahp.x, ahp.y), bf_resid(a1, ahp.z, ahp.w)), bl = bf8_of(bf_resid(b0, bhp.x, bhp.y), bf_resid(b1, bhp.z, bhp.w));
        acc = __builtin_amdgcn_mfma_f32_32x32x16_bf16(ah, bh, acc, 0, 0, 0);
        acc = __builtin_amdgcn_mfma_f32_32x32x16_bf16(ah, bl, acc, 0, 0, 0);
        acc = __builtin_amdgcn_mfma_f32_32x32x16_bf16(al, bh, acc, 0, 0, 0);
    }
    bf16* W2 = wsp<bf16>(C, WS_W2) + (size_t)l * DM * DM + (size_t)(hc * 128 + kt * 32) * DM + kb * 64 + nt * 32 + rr;
#pragma unroll
    for (int i = 0; i < 16; ++i) W2[(size_t)crow(i, hi) * DM] = (unsigned short)(pk2(acc[i], 0.f) & 0xffffu);
}
constexpr int DEF_ITEMS = 4096 + 1024 + 1024 + 1024, DEF_GROUPS = DEF_ITEMS / 4;
DI void deferred_item(const Ctx& C, int i) {
    if (i < 4096) p0i_table(C, i);
    else if (i < 5120) p0i_cache(C, 1024 + (i - 4096));
    else if (i < 6144) p0i_transpose(C, 1024 + (i - 5120));
    else p0i_w2(C, i - 6144);
}

constexpr int P0_NX = 2056, P0_NWP = 508;
DI void p0_prologue(const Ctx& C, int pmask = 31) {
    const int tid = C.tid;
    LAS int* qslot = (LAS int*)(C.lds + MISC_OFF + 64);
#define P0_CLAIM 4
#define P0_BLOCK(n, qi) for (int base_ = 0; ; ) { __syncthreads(); if (tid == 0) *qslot = (int)atomicAdd(C.ctl + CW_QUEUE + 64 * (8 + (qi)), (unsigned)P0_CLAIM); __syncthreads(); base_ = *qslot; if (base_ >= (n)) break; \
        for (int r = base_, r_hi = (base_ + P0_CLAIM < (n) ? base_ + P0_CLAIM : (n)); r < r_hi; ++r)
#define P0_END }
    if (pmask & 4) P0_BLOCK(1024, 2) { p0i_transpose(C, r); } P0_END
    static_assert(P0_NX % P0_CLAIM == 0 && P0_NWP % P0_CLAIM == 0, "whole claims");
#define P0_CLAIMED(n, qi) for (int base_ = 0; ; ) { __syncthreads(); if (tid == 0) *qslot = (int)atomicAdd(C.ctl + CW_QUEUE + 64 * (8 + (qi)), (unsigned)P0_CLAIM); __syncthreads(); base_ = *qslot; if (base_ >= (n)) break;
    if (pmask & 16) P0_CLAIMED(P0_NX, 4) {
            f32x4 q_[P0_CLAIM][4];
#pragma unroll
            for (int u = 0; u < P0_CLAIM; ++u) { const size_t e0 = (size_t)(base_ + u) * 8192 + tid * 16;
                const f32x4* s4 = (const f32x4*)(e0 < (size_t)NTP * DM ? C.inp(0) + e0 : C.inp(1) + (e0 - (size_t)NTP * DM));
                q_[u][0] = s4[0]; q_[u][1] = s4[1]; q_[u][2] = s4[2]; q_[u][3] = s4[3]; }
#pragma unroll
            for (int u = 0; u < P0_CLAIM; ++u) { const size_t e0 = (size_t)(base_ + u) * 8192 + tid * 16; const f32x4 a = q_[u][0], b = q_[u][1], c = q_[u][2], d = q_[u][3];
                v4u o0, o1; o0.x = pk2(a[0], a[1]); o0.y = pk2(a[2], a[3]); o0.z = pk2(b[0], b[1]); o0.w = pk2(b[2], b[3]);
                o1.x = pk2(c[0], c[1]); o1.y = pk2(c[2], c[3]); o1.z = pk2(d[0], d[1]); o1.w = pk2(d[2], d[3]);
                v4u* d4 = (v4u*)(wsp<bf16>(C, WS_XB) + e0); d4[0] = o0; d4[1] = o1; }
        } P0_END
    if (pmask & 2) P0_BLOCK(1024, 1) { p0i_cache(C, r); } P0_END
    if (pmask & 4) P0_BLOCK(144, 6) {{
            const int g = r * 512 + tid, l = g / 36864, rem = g % 36864, c = rem / 36, kg = rem % 36;
            const float* src = kg < 8 ? C.inp(11) + ((size_t)l * 64 + kg * 8) * 1024 : (kg < 16 ? C.inp(13) + ((size_t)l * 64 + (kg - 8) * 8) * 1024 : C.inp(14) + ((size_t)l * 160 + (kg - 16) * 8) * 1024);
            float e[8];
#pragma unroll
            for (int q = 0; q < 8; ++q) e[q] = src[(size_t)q * 1024 + c];
            *(v4u*)(wsp<bf16>(C, WS_LT) + ((size_t)l * 1024 + c) * 288 + kg * 8) = (v4u){pk2(e[0], e[1]), pk2(e[2], e[3]), pk2(e[4], e[5]), pk2(e[6], e[7])};
        }} P0_END
    if (pmask & 16) P0_CLAIMED(P0_NWP, 5) {
            f32x4 q_[P0_CLAIM][4];
#pragma unroll
            for (int u = 0; u < P0_CLAIM; ++u) { const size_t i0 = (size_t)(base_ + u) * 8192 + tid * 16; const size_t lb = i0 / 260096, rem = i0 % 260096;
                const f32x4* s4 = (const f32x4*)(C.inp(5) + lb * 262144 + 2048 + rem); q_[u][0] = s4[0]; q_[u][1] = s4[1]; q_[u][2] = s4[2]; q_[u][3] = s4[3]; }
#pragma unroll
            for (int u = 0; u < P0_CLAIM; ++u) { const size_t i0 = (size_t)(base_ + u) * 8192 + tid * 16; const size_t lb = i0 / 260096, rem = i0 % 260096;
                f32x4* d4 = (f32x4*)(C.out + O_WIN_S + lb * 262144 + rem); d4[0] = q_[u][0]; d4[1] = q_[u][1]; d4[2] = q_[u][2]; d4[3] = q_[u][3]; }
        } P0_END
    __syncthreads();
}

constexpr int PB_NRW = 514, PB_NPOOL = 256, PB_NVT = 1024, PB_ITEMS = PB_NRW + PB_NPOOL + PB_NVT;
DI float softplusf_(float x) { return x > 20.f ? x : log1pf(expf(x)); }
DI float fexp_(float x) { return __expf(x); }
DI float fsoftplus_(float x) { return x > 20.f ? x : __logf(1.f + __expf(x)); }
DI float fsigmoid_(float x) { return __builtin_amdgcn_rcpf(1.f + __expf(-x)); }

constexpr int XSB_LD = 3088, ACTB_LD = 296;
DI void rwkv_pre_item(const Ctx& C, int l, int item) {
    const int tid = C.tid, lane = C.lane, wave = C.wave, n16 = lane & 15, rq = lane >> 4;
    LAS unsigned short* XSB = (LAS unsigned short*)C.lds;
    LAS unsigned short* ACTB = (LAS unsigned short*)(C.lds + 16 * XSB_LD * 2);
    const bf16* P = wsp<bf16>(C, WS_PROJ);
    const int m0 = item * 16;
    __syncthreads();
#pragma unroll 1
    for (int base = 0; base < 16 * 420; base += 4 * NTHREADS) {
        v4u cu[4], pu[4]; f32x4 mu0[4], mu1[4], sh0[4], sh1[4]; int jj_[4], col_[4], kind[4];
#pragma unroll
        for (int u = 0; u < 4; ++u) { const int idx = base + u * NTHREADS + tid; kind[u] = -1; jj_[u] = 0; col_[u] = 0;
            if (idx < 16 * 420) { const int j = idx / 420, col = (idx % 420) * 8, m = m0 + j; jj_[u] = j; col_[u] = col;
                cu[u] = *(const v4u*)(P + (size_t)m * PLD + col);
                const f32x4* mup = (const f32x4*)(C.inp(9) + (size_t)l * RW_COLS + col); mu0[u] = mup[0]; mu1[u] = mup[1];
                int t; const float* sh = nullptr;
                if (m < NTP) t = m & 2047; else { const int jq = m - NTP; t = jq & 3; sh = C.inp(7) + (size_t)(l * 8 + (jq >> 2)) * RW_COLS + col; }
                if (t > 0) { pu[u] = *(const v4u*)(P + (size_t)(m - 1) * PLD + col); kind[u] = 1; }
                else if (sh) { sh0[u] = ((const f32x4*)sh)[0]; sh1[u] = ((const f32x4*)sh)[1]; kind[u] = 2; }
                else kind[u] = 0; } }
#pragma unroll
        for (int u = 0; u < 4; ++u) if (kind[u] >= 0) {
            const int j = jj_[u], col = col_[u];
            float cur[8] = {bflo(cu[u].x), bfhi(cu[u].x), bflo(cu[u].y), bfhi(cu[u].y), bflo(cu[u].z), bfhi(cu[u].z), bflo(cu[u].w), bfhi(cu[u].w)};
            float prev[8];
            if (kind[u] == 1) { prev[0] = bflo(pu[u].x); prev[1] = bfhi(pu[u].x); prev[2] = bflo(pu[u].y); prev[3] = bfhi(pu[u].y); prev[4] = bflo(pu[u].z); prev[5] = bfhi(pu[u].z); prev[6] = bflo(pu[u].w); prev[7] = bfhi(pu[u].w); }
            else if (kind[u] == 2) {
#pragma unroll
                for (int e = 0; e < 4; ++e) { prev[e] = sh0[u][e]; prev[4 + e] = sh1[u][e]; } }
            else {
#pragma unroll
                for (int e = 0; e < 8; ++e) prev[e] = 0.f; }
            float xs[8];
#pragma unroll
            for (int e = 0; e < 4; ++e) { xs[e] = cur[e] + mu0[u][e] * (prev[e] - cur[e]); xs[4 + e] = cur[4 + e] + mu1[u][e] * (prev[4 + e] - cur[4 + e]); }
            if (col >= 3072) { const int a0 = col - 3072;
#pragma unroll
                for (int e = 0; e < 8; ++e) xs[e] = a0 < 64 ? tanhf(xs[e]) : (a0 < 128 ? xs[e] : fsigmoid_(xs[e]));
                *(LAS v4u*)(ACTB + j * ACTB_LD + a0) = (v4u){pk2(xs[0], xs[1]), pk2(xs[2], xs[3]), pk2(xs[4], xs[5]), pk2(xs[6], xs[7])};
            } else *(LAS v4u*)(XSB + j * XSB_LD + col) = (v4u){pk2(xs[0], xs[1]), pk2(xs[2], xs[3]), pk2(xs[4], xs[5]), pk2(xs[6], xs[7])};
        }
    }
    __syncthreads();
    float* SC = wsp<float>(C, WS_SC); constexpr size_t SS = SC_STRIDE / 4;
    float* GG = wsp<float>(C, WS_GG); float* BON = wsp<float>(C, WS_BON);
    const bf16* LT = wsp<bf16>(C, WS_LT) + (size_t)l * 1024 * 288;
    const f32x4 zf = {0.f, 0.f, 0.f, 0.f};
#pragma unroll 1
    for (int hh = 0; hh < 2; ++hh) {
        const int head = 2 * wave + hh;
        f32x4 aw[4], aa[4], ag[4];
#pragma unroll
        for (int t4 = 0; t4 < 4; ++t4) { aw[t4] = zf; aa[t4] = zf; ag[t4] = zf; }
#define LORA_STEPS(ACC, KS0, NKS) _Pragma("unroll") for (int ks = (KS0); ks < (KS0) + (NKS); ++ks) { \
            const bf16x8 af = *(const LAS bf16x8*)(ACTB + n16 * ACTB_LD + 32 * ks + 8 * rq); \
            _Pragma("unroll") for (int t4 = 0; t4 < 4; ++t4) { const bf16x8 bfr = *(const bf16x8*)(LT + (size_t)(head * 64 + 16 * t4 + n16) * 288 + 32 * ks + 8 * rq); \
                ACC[t4] = __builtin_amdgcn_mfma_f32_16x16x32_bf16(af, bfr, ACC[t4], 0, 0, 0); } }
        LORA_STEPS(aw, 0, 2) LORA_STEPS(aa, 2, 2) LORA_STEPS(ag, 4, 5)
#undef LORA_STEPS
        float w0v[4], a0v[4], kkv[4], kav[4], rkv[4];
#pragma unroll
        for (int t4 = 0; t4 < 4; ++t4) { const int c = l * 1024 + head * 64 + 16 * t4 + n16; w0v[t4] = C.inp(10)[c]; a0v[t4] = C.inp(12)[c]; kkv[t4] = C.inp(15)[c]; kav[t4] = C.inp(16)[c]; rkv[t4] = C.inp(17)[c]; }
#pragma unroll
        for (int i = 0; i < 4; ++i) {
            const int j = 4 * rq + i; const size_t m = (size_t)m0 + j;
            float kkr[4], km[4], a_[4], rr[4], vv[4], lw_[4]; float ss = 0.f, bs = 0.f;
#pragma unroll
            for (int t4 = 0; t4 < 4; ++t4) { const int cl = head * 64 + 16 * t4 + n16;
                const float z = w0v[t4] + aw[t4][i];
                const float w = -fsoftplus_(-z) - 0.5f;
                lw_[t4] = -fexp_(w);
                a_[t4] = fsigmoid_(a0v[t4] + aa[t4][i]);
                rr[t4] = bf2f(XSB[j * XSB_LD + cl]); const float k = bf2f(XSB[j * XSB_LD + 1024 + cl]); vv[t4] = bf2f(XSB[j * XSB_LD + 2048 + cl]);
                kkr[t4] = k * kkv[t4]; ss += kkr[t4] * kkr[t4];
                km[t4] = k * (1.f + (a_[t4] - 1.f) * kav[t4]); bs += rr[t4] * km[t4] * rkv[t4]; }
            ss += dppf<0xB1>(ss); ss += dppf<0x4E>(ss); ss += dppf<0x141>(ss); ss += dppf<0x140>(ss);
            bs += dppf<0xB1>(bs); bs += dppf<0x4E>(bs); bs += dppf<0x141>(bs); bs += dppf<0x140>(bs);
            const float rn = __builtin_amdgcn_rsqf(fmaxf(ss, 1e-24f));
#pragma unroll
            for (int t4 = 0; t4 < 4; ++t4) { const int c = head * 64 + 16 * t4 + n16; const float kk = kkr[t4] * rn;
                ((bf16*)(SC + 0 * SS))[m * 1024 + c] = (unsigned short)(pk2(kk, 0.f) & 0xffffu); SC[1 * SS + m * 1024 + c] = fexp_(lw_[t4]); SC[3 * SS + m * 1024 + c] = lw_[t4];
                ((unsigned*)(SC + 2 * SS))[m * 1024 + head * 64 + n16 * 4 + t4] = pk2(-kk * a_[t4], km[t4]);
                ((bf16*)(SC + 4 * SS))[m * 1024 + c] = (unsigned short)(pk2(rr[t4], 0.f) & 0xffffu); SC[5 * SS + m * 1024 + c] = vv[t4];
                GG[m * 1024 + c] = ag[t4][i]; }
            if (n16 == 0) BON[m * 16 + head] = bs;
        }
    }
}

DI void phase_b(const Ctx& C, int l, int lq) {
    const int tid = C.tid;
    const bf16* P = wsp<bf16>(C, WS_PROJ);
    LAS int* qslot = (LAS int*)(C.lds + MISC_OFF + 64);
    for (;;) {
        __syncthreads();
        if (tid == 0) *qslot = (int)atomicAdd(C.ctl + CW_QUEUE + 64 * (16 + lq), 1u);
        __syncthreads();
        const int it = *qslot;
        if (it >= PB_ITEMS) break;
        int r = it;
        if (r < PB_NRW) { rwkv_pre_item(C, l, r); continue; }
        r -= PB_NRW;
        if (r < PB_NPOOL) {
            const int b = r >> 6, n = r & 63, kv = tid >> 8, kvh = (tid >> 6) & 3, d = tid & 63;
            const float* src = C.out + O_CMP_P + ((size_t)l * NTP + b * 2048 + 32 * n) * 512 + tid;
            const float* w = C.inp(20) + (l * 2 + kv) * 32;
            float acc = 0.f, pr_[32];
#pragma unroll
            for (int rr = 0; rr < 32; ++rr) pr_[rr] = src[(size_t)rr * 512];
#pragma unroll
            for (int rr = 0; rr < 32; ++rr) acc += w[rr] * pr_[rr];
            const unsigned short hb = (unsigned short)(pk2(acc, 0.f) & 0xffffu);
            if (kv == 0) wsp<bf16>(C, WS_KCB)[((size_t)(b * 4 + kvh) * 64 + n) * 64 + d] = hb;
            else wsp<bf16>(C, WS_VCBT)[((size_t)(b * 4 + kvh) * 64 + d) * 64 + n] = hb;
            continue;
        }
        r -= PB_NPOOL;
        {
            const int which = r >> 9, b = (r >> 7) & 3, kvh = (r >> 5) & 3, tb = r & 31, d = tid & 63, tq = tid >> 6;
            const bf16* src = P + (size_t)(b * 2048 + 64 * tb + 8 * tq) * PLD + (which ? VW_OFF : VS_OFF) + kvh * 64 + d;
            unsigned short e[8];
#pragma unroll
            for (int i = 0; i < 8; ++i) e[i] = src[(size_t)i * PLD];
            v4u o; o.x = e[0] | ((unsigned)e[1] << 16); o.y = e[2] | ((unsigned)e[3] << 16); o.z = e[4] | ((unsigned)e[5] << 16); o.w = e[6] | ((unsigned)e[7] << 16);
            *(v4u*)(wsp<bf16>(C, which ? WS_VTW : WS_VTS) + (((size_t)(b * 4 + kvh) * 32 + tb) * 64 + d) * 64 + 8 * tq) = o;
            { const int row = tid >> 3, ch = tid & 7;
              const v4u kv_ = *(const v4u*)(P + (size_t)(b * 2048 + 64 * tb + row) * PLD + (which ? KW_OFF : KS_OFF) + kvh * 64 + ch * 8);
              *(v4u*)(wsp<bf16>(C, which ? WS_KWC : WS_KSC) + ((size_t)(b * 4 + kvh) * 2048 + 64 * tb + row) * 64 + ch * 8) = kv_; }
        }
    }
    __syncthreads();
}

#define MFMA16(a, b, c) __builtin_amdgcn_mfma_f32_16x16x32_bf16((a), (b), (c), 0, 0, 0)
DI void scan_head(const Ctx& C, int l, int row0, int T, int h, const float* S0, float* Sout) {
    const int tid = C.tid, lane = C.lane, wave = C.wave;
    LAS f32x4* D4 = (LAS f32x4*)C.lds;
    LAS v4u* BK4 = (LAS v4u*)(C.lds + 8192);
    LAS f32x4* V4 = (LAS f32x4*)(C.lds + 16384);
    LAS v4u* R16 = (LAS v4u*)(C.lds + 24576);
    LAS v4u* KK16 = (LAS v4u*)(C.lds + 28672);
    LAS float* YB = (LAS float*)(C.lds + 33280);
    const unsigned char* SCb = C.ws + WS_SC;
    const bf16* SCKK = (const bf16*)SCb; const float* SCD = (const float*)(SCb + SC_STRIDE); const unsigned* SCBK = (const unsigned*)(SCb + 2 * SC_STRIDE);
    const bf16* SCR = (const bf16*)(SCb + 4 * SC_STRIDE); const float* SCV = (const float*)(SCb + 5 * SC_STRIDE);
    const float* GG = wsp<float>(C, WS_GG); const float* BON = wsp<float>(C, WS_BON);
    bf16* MIX = wsp<bf16>(C, WS_MIX);
    const int n = lane & 15, rq = lane >> 4, v0 = 16 * (wave & 3); const bool act = wave < 4;
    f32x4 acc[4];
#pragma unroll
    for (int kt = 0; kt < 4; ++kt) acc[kt] = (act && S0) ? *(const f32x4*)(S0 + (v0 + n) * 64 + 16 * kt + 4 * rq) : (f32x4){0.f, 0.f, 0.f, 0.f};
    const int nch = (T + 31) >> 5;
    f32x4 pD, pV; v4u pBK, pRK, pK2;
    const v4u z4 = {0u, 0u, 0u, 0u};
#define SCAN_PREFETCH(cc) do { { const int step = (cc) * 32 + (tid >> 4), f4 = tid & 15; const size_t o = (size_t)(row0 + step) * 1024 + h * 64 + f4 * 4; const bool ok = step < T; \
            pD = ok ? *(const f32x4*)(SCD + o) : (f32x4){0.f, 0.f, 0.f, 0.f}; pV = ok ? *(const f32x4*)(SCV + o) : (f32x4){0.f, 0.f, 0.f, 0.f}; pBK = ok ? *(const v4u*)(SCBK + o) : z4; } \
        { const int i2 = tid & 255, step = (cc) * 32 + (i2 >> 3); const size_t o = (size_t)(row0 + step) * 1024 + h * 64 + (i2 & 7) * 8; pRK = step < T ? *(const v4u*)((tid < 256 ? SCR : SCKK) + o) : z4; } \
        { const int step = (cc) * 32 + 32; const size_t o = (size_t)(row0 + step) * 1024 + h * 64 + (tid & 7) * 8; pK2 = (tid < 8 && step < T) ? *(const v4u*)(SCKK + o) : z4; } } while (0)
    SCAN_PREFETCH(0);
    const float gng = C.inp(18)[l * 1024 + h * 64 + lane], gnb = C.inp(19)[l * 1024 + h * 64 + lane];
    float sk = 0.f;
    struct StepOps { f32x4 d[4]; v4u bk; float vt; v2u a[4]; };
#define SCAN_LD(o, st_) do { _Pragma("unroll") for (int kt = 0; kt < 4; ++kt) (o).d[kt] = D4[(st_) * 16 + 4 * kt + rq]; (o).bk = BK4[(st_) * 16 + n]; (o).vt = ((const LAS float*)V4)[(st_) * 64 + v0 + n]; \
        const LAS unsigned char* src_ = (n & 3) == 1 ? (const LAS unsigned char*)KK16 + ((st_) + 1) * 128 : (const LAS unsigned char*)R16 + (st_) * 128; \
        (o).a[0] = *(const LAS v2u*)(src_ + 8 * rq); (o).a[1] = *(const LAS v2u*)(src_ + 32 + 8 * rq); (o).a[2] = *(const LAS v2u*)(src_ + 64 + 8 * rq); (o).a[3] = *(const LAS v2u*)(src_ + 96 + 8 * rq); } while (0)
#define SCAN_YSK(a0_, a1_, a2_, a3_, yv, skv) do { \
        v4u h0, h1; h0.x = pk2(acc[0][0], acc[0][1]); h0.y = pk2(acc[0][2], acc[0][3]); h0.z = pk2(acc[1][0], acc[1][1]); h0.w = pk2(acc[1][2], acc[1][3]); \
        h1.x = pk2(acc[2][0], acc[2][1]); h1.y = pk2(acc[2][2], acc[2][3]); h1.z = pk2(acc[3][0], acc[3][1]); h1.w = pk2(acc[3][2], acc[3][3]); \
        const v4u f0 = {(a0_).x, (a0_).y, (a1_).x, (a1_).y}, f1 = {(a2_).x, (a2_).y, (a3_).x, (a3_).y}; \
        f32x4 d2 = MFMA16(__builtin_bit_cast(bf16x8, f0), __builtin_bit_cast(bf16x8, h0), ((f32x4){0.f, 0.f, 0.f, 0.f})); \
        d2 = MFMA16(__builtin_bit_cast(bf16x8, f1), __builtin_bit_cast(bf16x8, h1), d2); yv = d2[0]; skv = d2[1]; } while (0)
    for (int c = 0; c < nch; ++c) {
        __syncthreads();
        D4[tid] = pD; BK4[tid] = pBK; V4[tid] = pV;
        if (tid < 256) R16[tid] = pRK; else KK16[tid - 256] = pRK;
        if (tid < 8) KK16[256 + tid] = pK2;
        __syncthreads();
        if (c + 1 < nch) SCAN_PREFETCH(c + 1);
        const int nst = (T - c * 32) < 32 ? (T - c * 32) : 32;
        float gq[4], bq[4];
#pragma unroll
        for (int qq = 0; qq < 4; ++qq) { const int st = wave * 4 + qq; const size_t m = (size_t)row0 + c * 32 + (st < nst ? st : 0);
            gq[qq] = GG[m * 1024 + h * 64 + lane]; bq[qq] = BON[m * 16 + h]; }
        if (act) {
            if (c == 0) {
                const LAS unsigned char* s0 = (const LAS unsigned char*)KK16;
                const v2u k0 = *(const LAS v2u*)(s0 + 8 * rq), k1 = *(const LAS v2u*)(s0 + 32 + 8 * rq), k2 = *(const LAS v2u*)(s0 + 64 + 8 * rq), k3 = *(const LAS v2u*)(s0 + 96 + 8 * rq);
                float yd; SCAN_YSK(k0, k1, k2, k3, sk, yd); (void)yd;
            }
            StepOps cur; SCAN_LD(cur, 0);
#pragma unroll 2
            for (int st = 0; st < nst; ++st) {
                StepOps nx; { const int sn = st + 1 < 32 ? st + 1 : 31; SCAN_LD(nx, sn); }
#pragma unroll
                for (int kt = 0; kt < 4; ++kt) acc[kt] = acc[kt] * cur.d[kt];
                v4u b2 = z4; b2.x = rq == 0 ? pk2(sk, cur.vt) : 0u;
#pragma unroll
                for (int kt = 0; kt < 4; ++kt) { v4u a2 = z4; a2.x = rq == 0 ? cur.bk[kt] : 0u; acc[kt] = MFMA16(__builtin_bit_cast(bf16x8, a2), __builtin_bit_cast(bf16x8, b2), acc[kt]); }
                float y; SCAN_YSK(cur.a[0], cur.a[1], cur.a[2], cur.a[3], y, sk);
                if (rq == 0) YB[st * 64 + v0 + n] = y;
                cur = nx;
            }
        }
        __syncthreads();
#pragma unroll
        for (int qq = 0; qq < 4; ++qq) {
            const int st = wave * 4 + qq;
            if (st < nst) {
                const size_t m = (size_t)row0 + c * 32 + st;
                const float y = YB[st * 64 + lane];
                const float mean = wave_sum(y) * (1.f / 64.f);
                const float dv = y - mean;
                const float var = wave_sum(dv * dv) * (1.f / 64.f);
                const float yn = dv * __builtin_amdgcn_rsqf(var + GN_EPS) * gng + gnb;
                const float o = (yn + bq[qq] * ((const LAS float*)V4)[st * 64 + lane]) * gq[qq];
                MIX[m * DM + h * 64 + lane] = (unsigned short)(pk2(o, 0.f) & 0xffffu);
            }
        }
    }
#undef SCAN_PREFETCH
#undef SCAN_LD
#undef SCAN_YSK
    if (act) {
#pragma unroll
        for (int kt = 0; kt < 4; ++kt) *(f32x4*)(Sout + (v0 + n) * 64 + 16 * kt + 4 * rq) = acc[kt];
    }
}

constexpr int CST = 144, CBUF = 64 * CST;
DI void cmm(const LAS unsigned char* L, const LAS unsigned char* Rt, f32x4 (&acc)[2], int tm, int tn0, int n16, int kq) {
#pragma unroll
    for (int ks = 0; ks < 2; ++ks) {
        const bf16x8 a = *(const LAS bf16x8*)(L + (16 * tm + n16) * CST + (32 * ks + 8 * kq) * 2);
#pragma unroll
        for (int j = 0; j < 2; ++j) { const bf16x8 bq = *(const LAS bf16x8*)(Rt + (16 * (tn0 + j) + n16) * CST + (32 * ks + 8 * kq) * 2); acc[j] = MFMA16(a, bq, acc[j]); }
    }
}
template <int MODE> DI void cst_T(LAS unsigned char* X, const f32x4 (&acc)[2], int tm, int tn0, int n16, int rq) {
#pragma unroll
    for (int j = 0; j < 2; ++j) { const int n = 16 * (tn0 + j) + n16, m0 = 16 * tm + 4 * rq; float v[4];
#pragma unroll
        for (int i = 0; i < 4; ++i) { const int col = m0 + i; const bool keep = MODE == 0 ? true : (MODE == 1 ? col < n : (MODE == 2 ? col <= n : col > n)); v[i] = keep ? acc[j][i] : 0.f; }
        *(LAS v2u*)(X + n * CST + m0 * 2) = (v2u){pk2(v[0], v[1]), pk2(v[2], v[3])}; }
}
template <int mode> DI void chunk_head(const Ctx& C, int l, int b, int h, float* Sout, int part) {
    const int tid = C.tid, lane = C.lane, wave = C.wave;
    const int n16 = lane & 15, rq = lane >> 4, tm = wave >> 1, tn0 = (wave & 1) * 2;
    LAS unsigned char* const B0 = C.lds;
#define CB(i) (B0 + (i) * CBUF)
    enum { I_BH = 0, I_BHT = 1, I_AH = 2, I_KH = 3, I_RH = 4, I_ATT = 5, I_KTT = 6, I_VT = 7, I_A1 = 8, I_A1T = 9, I_A2 = 10, I_M1 = 11, I_M2 = 12, I_H0T = 13 };
    LAS float* SEG = (LAS float*)(B0 + 14 * CBUF);
    LAS float* YB = (LAS float*)CB(8);
    const unsigned char* SCb = C.ws + WS_SC;
    const bf16* SCKK = (const bf16*)SCb; const unsigned* SCBK = (const unsigned*)(SCb + 2 * SC_STRIDE); const float* SCLW = (const float*)(SCb + 3 * SC_STRIDE);
    const bf16* SCR = (const bf16*)(SCb + 4 * SC_STRIDE); const float* SCV = (const float*)(SCb + 5 * SC_STRIDE);
    const float* GG = wsp<float>(C, WS_GG); const float* BON = wsp<float>(C, WS_BON);
    bf16* MIX = wsp<bf16>(C, WS_MIX);
    const size_t m0 = (size_t)b * 2048;
    const int pk = tid & 63, seg = tid >> 6, bkidx = (pk & 15) * 4 + (pk >> 4);
    const f32x4 zf = {0.f, 0.f, 0.f, 0.f};
    f32x4 accH[2] = {zf, zf};
    __syncthreads();
    for (int i = tid; i < CBUF / 4; i += NTHREADS) ((LAS unsigned*)CB(I_H0T))[i] = 0u;
    float plw[8], pv[8]; unsigned pbk[8]; unsigned short pkk[8], pr[8];
#define CH_LOAD(cc) do { _Pragma("unroll") for (int i = 0; i < 8; ++i) { const size_t o = (m0 + (cc) * 64 + seg * 8 + i) * 1024 + h * 64; \
        plw[i] = SCLW[o + pk]; pkk[i] = SCKK[o + pk]; pbk[i] = SCBK[o + bkidx]; pr[i] = SCR[o + pk]; pv[i] = SCV[o + pk]; } } while (0)
    unsigned char* const OPS = C.ws + WS_OPS + (size_t)((b * 16 + h) * 24) * OPS_BYTES;
    unsigned* const flag = C.ctl + CW_FLAG + 64 * ((l * 64 + b * 16 + h) * 4);
    const int c_lo = mode ? 16 * part : 0, c_hi = mode ? 16 * part + 16 : 16;
    CH_LOAD(c_lo);
    const float gng = C.inp(18)[l * 1024 + h * 64 + lane], gnb = C.inp(19)[l * 1024 + h * 64 + lane];
    for (int c = c_lo; c < c_hi; ++c) {

        float gq[8], bq[8], vq[8];
#pragma unroll
        for (int i = 0; i < 8; ++i) { const size_t m = m0 + c * 64 + 8 * wave + i; gq[i] = GG[m * 1024 + h * 64 + lane]; bq[i] = BON[m * 16 + h]; vq[i] = SCV[m * 1024 + h * 64 + lane]; }
        float cs[8];
        { float run = 0.f;
#pragma unroll
          for (int i = 0; i < 8; ++i) { run += plw[i]; cs[i] = run; } }
        __syncthreads();
        SEG[seg * 64 + pk] = cs[7];
        __syncthreads();
        float off = 0.f, tot = 0.f;
#pragma unroll
        for (int s = 0; s < 8; ++s) { const float sv = SEG[s * 64 + pk]; tot += sv; off += s < seg ? sv : 0.f; }
        { unsigned short bt[8], at[8], kt[8], vt[8];
#pragma unroll
          for (int i = 0; i < 8; ++i) { const float csv = cs[i] + off;
              const float eP = __expf(csv), eM = __expf(-csv), ePm = __expf(csv - plw[i]), eQ = __expf(tot - csv);
              const float kkf = bf2f(pkk[i]), nb = bflo(pbk[i]), kmf = bfhi(pbk[i]), rf = bf2f(pr[i]);
              const int t = seg * 8 + i;
              const unsigned short vb = (unsigned short)(pk2(kkf * ePm, 0.f) & 0xffffu);
              *(LAS unsigned short*)(CB(I_BH) + t * CST + pk * 2) = vb; bt[i] = vb;
              *(LAS unsigned short*)(CB(I_AH) + t * CST + pk * 2) = (unsigned short)(pk2(nb * eM, 0.f) & 0xffffu);
              *(LAS unsigned short*)(CB(I_KH) + t * CST + pk * 2) = (unsigned short)(pk2(kmf * eM, 0.f) & 0xffffu);
              *(LAS unsigned short*)(CB(I_RH) + t * CST + pk * 2) = (unsigned short)(pk2(rf * eP, 0.f) & 0xffffu);
              at[i] = (unsigned short)(pk2(nb * eQ, 0.f) & 0xffffu); kt[i] = (unsigned short)(pk2(kmf * eQ, 0.f) & 0xffffu); vt[i] = (unsigned short)(pk2(pv[i], 0.f) & 0xffffu); }
#define PK8(a) ((v4u){(unsigned)a[0] | ((unsigned)a[1] << 16), (unsigned)a[2] | ((unsigned)a[3] << 16), (unsigned)a[4] | ((unsigned)a[5] << 16), (unsigned)a[6] | ((unsigned)a[7] << 16)})
          *(LAS v4u*)(CB(I_BHT) + pk * CST + seg * 16) = PK8(bt); *(LAS v4u*)(CB(I_ATT) + pk * CST + seg * 16) = PK8(at);
          *(LAS v4u*)(CB(I_KTT) + pk * CST + seg * 16) = PK8(kt); *(LAS v4u*)(CB(I_VT) + pk * CST + seg * 16) = PK8(vt);
#undef PK8
        }
        if (c + 1 < c_hi) CH_LOAD(c + 1);
        __syncthreads();
        f32x4 accT[2];
        { f32x4 a_[2];
          a_[0] = zf; a_[1] = zf; cmm(CB(I_BH), CB(I_AH), a_, tm, tn0, n16, rq); cst_T<3>(CB(I_A1T), a_, tm, tn0, n16, rq);
          a_[0] = zf; a_[1] = zf; cmm(CB(I_AH), CB(I_BH), a_, tm, tn0, n16, rq); cst_T<1>(CB(I_A1), a_, tm, tn0, n16, rq);
#pragma unroll
          for (int j = 0; j < 2; ++j)
#pragma unroll
              for (int i = 0; i < 4; ++i) { const int m = 16 * tm + 4 * rq + i, n = 16 * (tn0 + j) + n16; accT[j][i] = m < n ? a_[j][i] : (m == n ? 1.f : 0.f); }
          a_[0] = zf; a_[1] = zf; cmm(CB(I_KH), CB(I_BH), a_, tm, tn0, n16, rq); cst_T<1>(CB(I_A2), a_, tm, tn0, n16, rq);
          a_[0] = zf; a_[1] = zf; cmm(CB(I_AH), CB(I_RH), a_, tm, tn0, n16, rq); cst_T<2>(CB(I_M1), a_, tm, tn0, n16, rq);
          a_[0] = zf; a_[1] = zf; cmm(CB(I_KH), CB(I_RH), a_, tm, tn0, n16, rq); cst_T<2>(CB(I_M2), a_, tm, tn0, n16, rq); }
        __syncthreads();
        { int ip = I_A1, ipt = I_A1T, in_ = I_AH, int_ = I_KH;
#pragma unroll 1
          for (int lev = 0; lev < 5; ++lev) {
              cst_T<0>(CB(I_BH), accT, tm, tn0, n16, rq);
              f32x4 a_[2];
              a_[0] = zf; a_[1] = zf; cmm(CB(ip), CB(ipt), a_, tm, tn0, n16, rq); cst_T<0>(CB(int_), a_, tm, tn0, n16, rq);
              a_[0] = zf; a_[1] = zf; cmm(CB(ipt), CB(ip), a_, tm, tn0, n16, rq); cst_T<0>(CB(in_), a_, tm, tn0, n16, rq);
              __syncthreads();
              cmm(CB(int_), CB(I_BH), accT, tm, tn0, n16, rq);
              __syncthreads();
              const int t0 = ip, t1 = ipt; ip = in_; ipt = int_; in_ = t0; int_ = t1;
          }
          cst_T<0>(CB(I_BH), accT, tm, tn0, n16, rq); }
        { f32x4 a_[2];
          a_[0] = zf; a_[1] = zf; cmm(CB(I_A2), CB(I_VT), a_, tm, tn0, n16, rq); cst_T<0>(CB(8), a_, tm, tn0, n16, rq);
          __syncthreads();
          a_[0] = zf; a_[1] = zf; cmm(CB(I_BH), CB(I_BHT), a_, tm, tn0, n16, rq); cst_T<0>(CB(9), a_, tm, tn0, n16, rq);
          a_[0] = zf; a_[1] = zf; cmm(CB(I_BH), CB(8), a_, tm, tn0, n16, rq); cst_T<0>(CB(2), a_, tm, tn0, n16, rq); }
        __syncthreads();
        f32x4 accE[2] = {zf, zf}, accY[2] = {zf, zf};
        { f32x4 a_[2];
          a_[0] = zf; a_[1] = zf; cmm(CB(9), CB(I_ATT), a_, tm, tn0, n16, rq);
#pragma unroll
          for (int j = 0; j < 2; ++j) { const int n = 16 * (tn0 + j) + n16, mm0 = 16 * tm + 4 * rq; float pc = 0.f;
#pragma unroll
              for (int s = 0; s < 8; ++s) pc += SEG[s * 64 + n];
              pc = __expf(pc); float v[4];
#pragma unroll
              for (int i = 0; i < 4; ++i) v[i] = a_[j][i] + (mm0 + i == n ? pc : 0.f);
              *(LAS v2u*)(CB(3) + n * CST + mm0 * 2) = (v2u){pk2(v[0], v[1]), pk2(v[2], v[3])}; }
          cmm(CB(I_ATT), CB(2), accE, tm, tn0, n16, rq); cmm(CB(I_KTT), CB(I_VT), accE, tm, tn0, n16, rq);
          a_[0] = zf; a_[1] = zf; cmm(CB(9), CB(I_M1), a_, tm, tn0, n16, rq);
#pragma unroll
          for (int j = 0; j < 2; ++j) { const int n = 16 * (tn0 + j) + n16, mm0 = 16 * tm + 4 * rq;
              const v2u rh = *(const LAS v2u*)(CB(I_RH) + n * CST + mm0 * 2);
              *(LAS v2u*)(CB(10) + n * CST + mm0 * 2) = (v2u){pk2(a_[j][0] + bflo(rh.x), a_[j][1] + bfhi(rh.x)), pk2(a_[j][2] + bflo(rh.y), a_[j][3] + bfhi(rh.y))}; }
          cmm(CB(I_M1), CB(2), accY, tm, tn0, n16, rq); cmm(CB(I_M2), CB(I_VT), accY, tm, tn0, n16, rq); }
        __syncthreads();
        if (mode == 1) {
            unsigned char* ob = OPS + (size_t)(c - 16) * OPS_BYTES;
            for (int i = tid; i < 2 * CBUF / 16; i += NTHREADS) ((v4u*)ob)[i] = *(const LAS v4u*)((i < CBUF / 16 ? CB(3) : CB(10)) + (i < CBUF / 16 ? i : i - CBUF / 16) * 16);
            ((f32x4*)(ob + 2 * CBUF))[tid * 2] = accE[0]; ((f32x4*)(ob + 2 * CBUF))[tid * 2 + 1] = accE[1];
            ((f32x4*)(ob + 2 * CBUF + 16384))[tid * 2] = accY[0]; ((f32x4*)(ob + 2 * CBUF + 16384))[tid * 2 + 1] = accY[1];
            continue;
        }
        cmm(CB(3), CB(I_H0T), accE, tm, tn0, n16, rq); cmm(CB(10), CB(I_H0T), accY, tm, tn0, n16, rq);
        __syncthreads();
        accH[0] = accE[0]; accH[1] = accE[1];
        cst_T<0>(CB(I_H0T), accH, tm, tn0, n16, rq);
#pragma unroll
        for (int j = 0; j < 2; ++j)
#pragma unroll
            for (int i = 0; i < 4; ++i) YB[(16 * tm + 4 * rq + i) * 64 + 16 * (tn0 + j) + n16] = accY[j][i];
        __syncthreads();
#pragma unroll
        for (int i = 0; i < 8; ++i) {
            const int t = 8 * wave + i; const size_t m = m0 + c * 64 + t;
            const float y = YB[t * 64 + lane];
            const float mean = wave_sum(y) * (1.f / 64.f);
            const float dv = y - mean;
            const float var = wave_sum(dv * dv) * (1.f / 64.f);
            const float yn = dv * __builtin_amdgcn_rsqf(var + GN_EPS) * gng + gnb;
            const float o = (yn + bq[i] * vq[i]) * gq[i];
            MIX[m * DM + h * 64 + lane] = (unsigned short)(pk2(o, 0.f) & 0xffffu);
        }
    }
    if (mode == 0) for (int c = 16; c < 32; ++c) {
            float gq[8], bq[8], vq[8];
#pragma unroll
            for (int i = 0; i < 8; ++i) { const size_t m = m0 + c * 64 + 8 * wave + i; gq[i] = GG[m * 1024 + h * 64 + lane]; bq[i] = BON[m * 16 + h]; vq[i] = SCV[m * 1024 + h * 64 + lane]; }
            if ((c & 15) == 0) {
                if (tid == 0) { unsigned sp = 0; while (__hip_atomic_load(flag + 64 * (c >> 4), __ATOMIC_RELAXED, __HIP_MEMORY_SCOPE_AGENT) == 0u) { __builtin_amdgcn_s_sleep(8); if (++sp > (1u << 22)) break; }
                    __builtin_amdgcn_fence(__ATOMIC_ACQUIRE, "agent"); asm volatile("s_waitcnt vmcnt(0)" ::: "memory"); }
            }
            __syncthreads();
            const unsigned char* ob = OPS + (size_t)(c - 16) * OPS_BYTES;
            for (int i = tid; i < 2 * CBUF / 16; i += NTHREADS) { const v4u w = ((const v4u*)ob)[i]; *(LAS v4u*)((i < CBUF / 16 ? CB(3) : CB(10)) + (i < CBUF / 16 ? i : i - CBUF / 16) * 16) = w; }
            f32x4 accE[2], accY[2];
            accE[0] = ((const f32x4*)(ob + 2 * CBUF))[tid * 2]; accE[1] = ((const f32x4*)(ob + 2 * CBUF))[tid * 2 + 1];
            accY[0] = ((const f32x4*)(ob + 2 * CBUF + 16384))[tid * 2]; accY[1] = ((const f32x4*)(ob + 2 * CBUF + 16384))[tid * 2 + 1];
            __syncthreads();
            cmm(CB(3), CB(I_H0T), accE, tm, tn0, n16, rq); cmm(CB(10), CB(I_H0T), accY, tm, tn0, n16, rq);
            __syncthreads();
            accH[0] = accE[0]; accH[1] = accE[1];
            cst_T<0>(CB(I_H0T), accH, tm, tn0, n16, rq);
#pragma unroll
            for (int j = 0; j < 2; ++j)
#pragma unroll
                for (int i = 0; i < 4; ++i) YB[(16 * tm + 4 * rq + i) * 64 + 16 * (tn0 + j) + n16] = accY[j][i];
            __syncthreads();
#pragma unroll
            for (int i = 0; i < 8; ++i) {
                const int t = 8 * wave + i; const size_t m = m0 + c * 64 + t;
                const float y = YB[t * 64 + lane];
                const float mean = wave_sum(y) * (1.f / 64.f);
                const float dv = y - mean;
                const float var = wave_sum(dv * dv) * (1.f / 64.f);
                const float yn = dv * __builtin_amdgcn_rsqf(var + GN_EPS) * gng + gnb;
                const float o = (yn + bq[i] * vq[i]) * gq[i];
                MIX[m * DM + h * 64 + lane] = (unsigned short)(pk2(o, 0.f) & 0xffffu);
            }
    }
#undef CH_LOAD
#undef CB
    if (mode == 1) {
        asm volatile("s_waitcnt vmcnt(0)" ::: "memory");
        __syncthreads();
        if (tid == 0) { __builtin_amdgcn_fence(__ATOMIC_RELEASE, "agent"); asm volatile("s_waitcnt vmcnt(0)" ::: "memory"); __hip_atomic_store(flag + 64 * part, 1u, __ATOMIC_RELAXED, __HIP_MEMORY_SCOPE_AGENT); }
        return;
    }
#pragma unroll
    for (int j = 0; j < 2; ++j) *(f32x4*)(Sout + (size_t)(16 * (tn0 + j) + n16) * 64 + 16 * tm + 4 * rq) = accH[j];
}

#define MFMA32(a, b, c) __builtin_amdgcn_mfma_f32_32x32x16_bf16((a), (b), (c), 0, 0, 0)
DI bf16x8 pack8(const f32x16& p, int s) {
    v4u o; o.x = pk2(p[8 * s], p[8 * s + 1]); o.y = pk2(p[8 * s + 2], p[8 * s + 3]); o.z = pk2(p[8 * s + 4], p[8 * s + 5]); o.w = pk2(p[8 * s + 6], p[8 * s + 7]);
    return __builtin_bit_cast(bf16x8, o);
}
DI bf16x8 ld_vt(const bf16* p) {
    const v2u a = *(const v2u*)p, b = *(const v2u*)(p + 8);
    v4u o; o.x = a.x; o.y = a.y; o.z = b.x; o.w = b.y; return __builtin_bit_cast(bf16x8, o);
}
constexpr int KT_STRIDE = 144, VTT_STRIDE = 136, KT_BYTES = 64 * KT_STRIDE, TILE_BYTES = KT_BYTES + 64 * VTT_STRIDE, TILE_OFF = 74752;
struct TileRegs { v4u k, v; };
DI TileRegs tile_load(const bf16* kbase, size_t kstride, const bf16* vbase, size_t vstride, int tid) {
    TileRegs r; const int row = tid >> 3, ch = tid & 7;
    r.k = *(const v4u*)(kbase + (size_t)row * kstride + ch * 8); r.v = *(const v4u*)(vbase + (size_t)row * vstride + ch * 8); return r;
}
DI void tile_store(LAS unsigned char* buf, const TileRegs& r, int tid) {
    const int row = tid >> 3, ch = tid & 7;
    *(LAS v4u*)(buf + row * KT_STRIDE + ch * 16) = r.k;
    *(LAS v2u*)(buf + KT_BYTES + row * VTT_STRIDE + ch * 16) = (v2u){r.v.x, r.v.y}; *(LAS v2u*)(buf + KT_BYTES + row * VTT_STRIDE + ch * 16 + 8) = (v2u){r.v.z, r.v.w};
}
DI bf16x8 ld_vt_lds(const LAS unsigned char* p) {
    const v2u a = *(const LAS v2u*)p, b = *(const LAS v2u*)(p + 16);
    v4u o; o.x = a.x; o.y = a.y; o.z = b.x; o.w = b.y; return __builtin_bit_cast(bf16x8, o);
}
#define ATT_BLOCK(EDGE, BUF, KEYBLK0, MINE, VALID_EXPR) do { \
    const float bias_ = (MINE) ? 0.f : NEG_BIG; \
    _Pragma("unroll 1") for (int tile = 0; tile < 2; ++tile) { const int key0 = (KEYBLK0) + tile * 32; (void)key0; \
        f32x16 a_ = zero16; \
        _Pragma("unroll") for (int s = 0; s < 4; ++s) { const bf16x8 kf = *(const LAS bf16x8*)((BUF) + (tile * 32 + q) * KT_STRIDE + 32 * s + 16 * hi); a_ = MFMA32(kf, qf[s], a_); } \
        float tm = NEG_BIG; \
        if (EDGE) { _Pragma("unroll") for (int i = 0; i < 16; ++i) { const int key = key0 + crow(i, hi); const bool ok = (MINE) && (VALID_EXPR); a_[i] = ok ? a_[i] * SCL2 : NEG_BIG; tm = fmaxf(tm, a_[i]); } } \
        else { _Pragma("unroll") for (int i = 0; i < 16; ++i) { a_[i] = a_[i] * SCL2 + bias_; tm = fmaxf(tm, a_[i]); } } \
        tm = fmaxf(tm, __shfl_xor(tm, 32)); \
        const float mn = fmaxf(mrun, tm); const float sc_ = __builtin_amdgcn_exp2f(mrun - mn); \
        float ps = 0.f; \
        if (EDGE) { _Pragma("unroll") for (int i = 0; i < 16; ++i) { const float p_ = a_[i] > -1e29f ? __builtin_amdgcn_exp2f(a_[i] - mn) : 0.f; a_[i] = p_; ps += p_; } } \
        else { _Pragma("unroll") for (int i = 0; i < 16; ++i) { const float p_ = __builtin_amdgcn_exp2f(a_[i] - mn); a_[i] = p_; ps += p_; } } \
        ps += __shfl_xor(ps, 32); \
        lrun = lrun * sc_ + ps; mrun = mn; \
        _Pragma("unroll") for (int i = 0; i < 16; ++i) { oa[0][i] *= sc_; oa[1][i] *= sc_; } \
        _Pragma("unroll") for (int s = 0; s < 2; ++s) { const bf16x8 pb = pack8(a_, s); \
            oa[0] = MFMA32(ld_vt_lds((BUF) + KT_BYTES + q * VTT_STRIDE + (tile * 32 + 16 * s + 4 * hi) * 2), pb, oa[0]); \
            oa[1] = MFMA32(ld_vt_lds((BUF) + KT_BYTES + (32 + q) * VTT_STRIDE + (tile * 32 + 16 * s + 4 * hi) * 2), pb, oa[1]); } \
    } } while (0)
constexpr float SCL2 = 0.125f * 1.4426950408889634f;

DI void nsa_prompt_unit(const Ctx& C, int l, int b, int kvh, int qt, bool skipblk = false, bool skipcmp = false) {
    const int tid = C.tid, lane = C.lane, wave = C.wave;
    const int g = wave & 3, th = wave >> 2, q = lane & 31, hi = lane >> 5;
    LAS float* IMP = (LAS float*)C.lds;
    LAS float* IMPV = (LAS float*)(C.lds + 65536);
    LAS unsigned* SELM = (LAS unsigned*)(C.lds + 65536 + 8192);
    LAS unsigned char* TB = C.lds + TILE_OFF;
    const bf16* P = wsp<bf16>(C, WS_PROJ);
    const int tok = qt * 64 + th * 32 + q;
    const size_t m = (size_t)b * 2048 + tok;
    const int bk = b * 4 + kvh, head = kvh * 4 + g;
    f32x16 zero16;
#pragma unroll
    for (int i = 0; i < 16; ++i) zero16[i] = 0.f;
    bf16x8 qf[4];
#pragma unroll
    for (int s = 0; s < 4; ++s) qf[s] = *(const bf16x8*)(P + m * PLD + Q_OFF + head * 64 + 16 * s + 8 * hi);
    f32x16 out0 = zero16, out1 = zero16;
    const float g0 = sigmoidf_(bf2f(P[m * PLD + GL_OFF + head * 3 + 0])), g1 = sigmoidf_(bf2f(P[m * PLD + GL_OFF + head * 3 + 1])), g2 = sigmoidf_(bf2f(P[m * PLD + GL_OFF + head * 3 + 2]));
    TileRegs tr = tile_load(wsp<bf16>(C, WS_KCB) + (size_t)bk * 4096, 64, wsp<bf16>(C, WS_VCBT) + (size_t)bk * 4096, 64, tid);
    __syncthreads();
    tile_store(TB, tr, tid);
    __syncthreads();
    if (!skipcmp) {
    {
        f32x16 sc[2];
        const int nvalid = (tok + 1) >> 5;
        float mx = NEG_BIG;
#pragma unroll
        for (int tile = 0; tile < 2; ++tile) {
            f32x16 a_ = zero16;
#pragma unroll
            for (int s = 0; s < 4; ++s) { const bf16x8 kf = *(const LAS bf16x8*)(TB + (tile * 32 + q) * KT_STRIDE + 32 * s + 16 * hi); a_ = MFMA32(kf, qf[s], a_); }
#pragma unroll
            for (int i = 0; i < 16; ++i) { const int n = tile * 32 + crow(i, hi); a_[i] = n < nvalid ? a_[i] * 0.125f : NEG_BIG; mx = fmaxf(mx, a_[i]); }
            sc[tile] = a_;
        }
        mx = fmaxf(mx, __shfl_xor(mx, 32));
        float sum = 0.f;
#pragma unroll
        for (int tile = 0; tile < 2; ++tile)
#pragma unroll
            for (int i = 0; i < 16; ++i) { const float p_ = sc[tile][i] > -1e29f ? __expf(sc[tile][i] - mx) : 0.f; sc[tile][i] = p_; sum += p_; }
        sum += __shfl_xor(sum, 32);
        const float inv = nvalid > 0 ? 1.f / sum : 0.f;
        f32x16 oc0 = zero16, oc1 = zero16;
#pragma unroll
        for (int tile = 0; tile < 2; ++tile) {
#pragma unroll
            for (int i = 0; i < 16; ++i) sc[tile][i] *= inv;
#pragma unroll
            for (int i4 = 0; i4 < 4; ++i4) { f32x4 v = {sc[tile][4 * i4], sc[tile][4 * i4 + 1], sc[tile][4 * i4 + 2], sc[tile][4 * i4 + 3]};
                *(LAS f32x4*)(IMP + ((size_t)(g * 64 + th * 32 + q)) * 64 + tile * 32 + 8 * i4 + 4 * hi) = v; }
#pragma unroll
            for (int s = 0; s < 2; ++s) { const bf16x8 pb = pack8(sc[tile], s);
                oc0 = MFMA32(ld_vt_lds(TB + KT_BYTES + q * VTT_STRIDE + (tile * 32 + 16 * s + 4 * hi) * 2), pb, oc0);
                oc1 = MFMA32(ld_vt_lds(TB + KT_BYTES + (32 + q) * VTT_STRIDE + (tile * 32 + 16 * s + 4 * hi) * 2), pb, oc1); }
        }
#pragma unroll
        for (int i = 0; i < 16; ++i) { out0[i] = g0 * oc0[i]; out1[i] = g0 * oc1[i]; }
    }
    __syncthreads();
    {
        const int tokl = tid >> 3, jq = tid & 7;
        float v[4];
#pragma unroll
        for (int e = 0; e < 4; ++e) v[e] = 0.f;
#pragma unroll
        for (int gg = 0; gg < 4; ++gg) { const f32x4 a = *(const LAS f32x4*)(IMP + (size_t)(gg * 64 + tokl) * 64 + 8 * jq), bq = *(const LAS f32x4*)(IMP + (size_t)(gg * 64 + tokl) * 64 + 8 * jq + 4);
            v[0] += a[0] + a[1]; v[1] += a[2] + a[3]; v[2] += bq[0] + bq[1]; v[3] += bq[2] + bq[3]; }
        const int cur = qt;
#pragma unroll
        for (int e = 0; e < 4; ++e) { const int j = 4 * jq + e; const bool forced = (j == 0) | (j == cur) | (j == cur - 1); v[e] = j > cur ? -1.f : (forced ? 1e4f : v[e]); }
        *(LAS f32x4*)(IMPV + tokl * 32 + 4 * jq) = (f32x4){v[0], v[1], v[2], v[3]};
        __syncthreads();
        int rank[4] = {0, 0, 0, 0};
#pragma unroll
        for (int jj4 = 0; jj4 < 8; ++jj4) { const f32x4 o = *(const LAS f32x4*)(IMPV + tokl * 32 + 4 * jj4);
#pragma unroll
            for (int u = 0; u < 4; ++u) { const int jp = 4 * jj4 + u; const float ov = o[u];
#pragma unroll
                for (int e = 0; e < 4; ++e) { const int j = 4 * jq + e; rank[e] += (ov > v[e] || (ov == v[e] && jp < j)) ? 1 : 0; } } }
        unsigned bits = 0;
#pragma unroll
        for (int e = 0; e < 4; ++e) if (rank[e] < 16 && v[e] >= 0.f) bits |= 1u << (4 * jq + e);
        bits |= __shfl_xor(bits, 1); bits |= __shfl_xor(bits, 2); bits |= __shfl_xor(bits, 4);
        if (jq == 0) SELM[tokl] = bits;
        __syncthreads();
    }
    }
    if (skipcmp && tid < 64) SELM[tid] = 0xffffffffu;
    __syncthreads();
    const unsigned selm = SELM[th * 32 + q];
    unsigned uni;
    { unsigned u0 = SELM[lane];
#pragma unroll
      for (int o = 1; o < 64; o <<= 1) u0 |= __shfl_xor(u0, o);
      uni = __builtin_amdgcn_readfirstlane(u0); }
    {
        LAS float* PARK = (LAS float*)C.lds + wave * 2048 + lane;
#pragma unroll
        for (int i = 0; i < 16; ++i) { PARK[i * 64] = out0[i]; PARK[(16 + i) * 64] = out1[i]; }
        const bf16* KBs = wsp<bf16>(C, WS_KSC) + (size_t)bk * 2048 * 64; const bf16* KBw = wsp<bf16>(C, WS_KWC) + (size_t)bk * 2048 * 64;
        const bf16* VTs = wsp<bf16>(C, WS_VTS) + (size_t)bk * 32 * 4096; const bf16* VTw = wsp<bf16>(C, WS_VTW) + (size_t)bk * 32 * 4096;
        f32x16 oa[2] = {zero16, zero16}; float mrun = NEG_BIG, lrun = 0.f;
        unsigned rem = skipblk ? 1u : uni; int wj = skipblk ? qt : (qt > 8 ? qt - 8 : 0); bool folded = false;
#define NEXT_BLK(dst) do { if (rem) { dst = __builtin_ctz(rem); rem &= rem - 1; } else if (wj <= qt) { dst = wj | 256; ++wj; } else dst = -1; } while (0)
#define LOAD_BLK(tr_, d_) do { const int j_ = (d_) & 255; tr_ = ((d_) & 256) ? tile_load(KBw + (size_t)j_ * 4096, 64, VTw + (size_t)j_ * 4096, 64, tid) : tile_load(KBs + (size_t)j_ * 4096, 64, VTs + (size_t)j_ * 4096, 64, tid); } while (0)
#define FOLD(gate_) do { const float il_ = (gate_) / lrun; _Pragma("unroll") for (int i = 0; i < 16; ++i) { PARK[i * 64] += il_ * oa[0][i]; PARK[(16 + i) * 64] += il_ * oa[1][i]; } \
            oa[0] = zero16; oa[1] = zero16; mrun = NEG_BIG; lrun = 0.f; } while (0)
#define DO_BLK(d_, buf_) do { const int j_ = (d_) & 255; const bool win_ = ((d_) & 256) != 0; \
            if (win_ && !folded) { FOLD(g1); folded = true; } \
            const bool mine = win_ ? true : (((selm >> j_) & 1u) != 0u); \
            if (__any(mine)) { const int wl_ = win_ ? 511 : (1 << 20); const bool edge_ = (j_ == qt) || (win_ && j_ + 8 <= qt); \
                if (edge_) ATT_BLOCK(1, buf_, j_ * 64, mine, (key <= tok && key + wl_ >= tok)); else ATT_BLOCK(0, buf_, j_ * 64, mine, true); } } while (0)
        int d0, d1, d2; TileRegs trA, trB;
        NEXT_BLK(d0); NEXT_BLK(d1);
        LOAD_BLK(trA, d0); if (d1 >= 0) LOAD_BLK(trB, d1);
        __syncthreads();
        for (;;) {
            tile_store(TB, trA, tid); __syncthreads();
            NEXT_BLK(d2); if (d2 >= 0) LOAD_BLK(trA, d2);
            DO_BLK(d0, TB);
            if (d1 < 0) break;
            tile_store(TB + TILE_BYTES, trB, tid); __syncthreads();
            NEXT_BLK(d0); if (d0 >= 0) LOAD_BLK(trB, d0);
            DO_BLK(d1, TB + TILE_BYTES);
            if (d2 < 0) break;
            d1 = d0; d0 = d2;
        }
        FOLD(g2);
#undef NEXT_BLK
#undef LOAD_BLK
#undef FOLD
#undef DO_BLK
#pragma unroll
        for (int i = 0; i < 16; ++i) { out0[i] = PARK[i * 64]; out1[i] = PARK[(16 + i) * 64]; }
    }
    bf16* MIX = wsp<bf16>(C, WS_MIX) + m * DM + 1024 + head * 64;
    if (!skipblk)
#pragma unroll
    for (int i4 = 0; i4 < 4; ++i4) {
        v2u o; o.x = pk2(out0[4 * i4], out0[4 * i4 + 1]); o.y = pk2(out0[4 * i4 + 2], out0[4 * i4 + 3]); *(v2u*)(MIX + 8 * i4 + 4 * hi) = o;
        o.x = pk2(out1[4 * i4], out1[4 * i4 + 1]); o.y = pk2(out1[4 * i4 + 2], out1[4 * i4 + 3]); *(v2u*)(MIX + 32 + 8 * i4 + 4 * hi) = o;
    }
}

template <class RowFn> DI void samp_block(const RowFn& rowptr, int nvalid, int kvh, const LAS float* QS, LAS float* PWw, int lane, float (&M)[4], float (&L)[4], float (&O)[4]) {
    float s[4] = {0.f, 0.f, 0.f, 0.f};
    const bool ok = lane < nvalid;
    if (ok) {
        const f32x4* kr = (const f32x4*)(rowptr(lane) + kvh * 64);
#pragma unroll 4
        for (int d4 = 0; d4 < 16; ++d4) { const f32x4 kq = kr[d4];
#pragma unroll
            for (int g = 0; g < 4; ++g) { const f32x4 qq = *(const LAS f32x4*)(QS + g * 64 + 4 * d4); s[g] += kq[0] * qq[0] + kq[1] * qq[1] + kq[2] * qq[2] + kq[3] * qq[3]; } }
    }
    float mb[4], lb[4];
#pragma unroll
    for (int g = 0; g < 4; ++g) { const float sv = ok ? s[g] : NEG_BIG; mb[g] = wave_max(sv); const float p = ok ? expf(sv - mb[g]) : 0.f; lb[g] = wave_sum(p); PWw[g * 64 + lane] = p; }
    LDS_WAIT(); asm volatile("" ::: "memory");
    float ob[4] = {0.f, 0.f, 0.f, 0.f};
    for (int r0 = 0; r0 < nvalid; r0 += 4) {
        float vv[4];
#pragma unroll
        for (int u = 0; u < 4; ++u) vv[u] = r0 + u < nvalid ? rowptr(r0 + u)[256 + kvh * 64 + lane] : 0.f;
#pragma unroll
        for (int u = 0; u < 4; ++u)
#pragma unroll
            for (int g = 0; g < 4; ++g) ob[g] += PWw[g * 64 + r0 + u] * vv[u]; }
    LDS_WAIT(); asm volatile("" ::: "memory");
#pragma unroll
    for (int g = 0; g < 4; ++g) { const float mn = fmaxf(M[g], mb[g]); const float a = expf(M[g] - mn), bsc = expf(mb[g] - mn); L[g] = L[g] * a + lb[g] * bsc; O[g] = O[g] * a + ob[g] * bsc; M[g] = mn; }
}
DI float samp_combine(LAS float* WST, int tid, int lane, int wave, const float (&M)[4], const float (&L)[4], const float (&O)[4]) {
    __syncthreads();
#pragma unroll
    for (int g = 0; g < 4; ++g) { WST[wave * 264 + 8 + g * 64 + lane] = O[g]; if (lane == 0) { WST[wave * 264 + g] = M[g]; WST[wave * 264 + 4 + g] = L[g]; } }
    __syncthreads();
    float res = 0.f;
    if (tid < 256) { const int g = tid >> 6, d = tid & 63; float mm = NEG_BIG;
#pragma unroll
        for (int w = 0; w < 8; ++w) mm = fmaxf(mm, WST[w * 264 + g]);
        float ll = 0.f, oo = 0.f;
#pragma unroll
        for (int w = 0; w < 8; ++w) { const float e = expf(WST[w * 264 + g] - mm); ll += WST[w * 264 + 4 + g] * e; oo += WST[w * 264 + 8 + g * 64 + d] * e; }
        res = oo / ll; }
    return res;
}

DI void nsa_sample_item(const Ctx& C, int l, int b, int t, int kvh) {
    const int tid = C.tid, lane = C.lane, wave = C.wave;
    LAS float* F = (LAS float*)C.lds;
    LAS float *QS = F, *PC = F + 256, *IMPS = F + 2304, *RED = F + 2624, *RED2 = F + 2688, *OCP = F + 2752, *PW = F + 4800, *WST = F + 6848;
    LAS int* SELB = (LAS int*)(F + 2560);
    const bf16* P = wsp<bf16>(C, WS_PROJ);
    const size_t m = (size_t)NTP + b * 4 + t;
    __syncthreads();
    if (tid < 256) QS[tid] = bf2f(P[m * PLD + Q_OFF + kvh * 256 + tid]) * 0.125f;
    __syncthreads();
    float ocmp = 0.f;
    {
        const float* KC = wsp<float>(C, WS_KCBS) + ((size_t)((l * 8 + b) * 4 + kvh) * 512) * 64;
        const float* VC = wsp<float>(C, WS_VCBS) + ((size_t)((l * 8 + b) * 4 + kvh) * 512) * 64;
        float s[4] = {0.f, 0.f, 0.f, 0.f};
        const f32x4* kr = (const f32x4*)(KC + (size_t)tid * 64);
#pragma unroll 4
        for (int d4 = 0; d4 < 16; ++d4) { const f32x4 kq = kr[d4];
#pragma unroll
            for (int g = 0; g < 4; ++g) { const f32x4 qq = *(const LAS f32x4*)(QS + g * 64 + 4 * d4); s[g] += kq[0] * qq[0] + kq[1] * qq[1] + kq[2] * qq[2] + kq[3] * qq[3]; } }
#pragma unroll
        for (int g = 0; g < 4; ++g) { const float wm = wave_max(s[g]); if (lane == 0) RED[wave * 4 + g] = wm; }
        __syncthreads();
        float p[4];
#pragma unroll
        for (int g = 0; g < 4; ++g) { float mm = RED[g];
#pragma unroll
            for (int w = 1; w < 8; ++w) mm = fmaxf(mm, RED[w * 4 + g]);
            p[g] = expf(s[g] - mm); const float ws = wave_sum(p[g]); if (lane == 0) RED2[wave * 4 + g] = ws; }
        __syncthreads();
#pragma unroll
        for (int g = 0; g < 4; ++g) { float tot = 0.f;
#pragma unroll
            for (int w = 0; w < 8; ++w) tot += RED2[w * 4 + g];
            PC[g * 512 + tid] = p[g] / tot; }
        __syncthreads();
        if (tid < 256) IMPS[tid] = (PC[2 * tid] + PC[2 * tid + 1]) + (PC[512 + 2 * tid] + PC[512 + 2 * tid + 1]) + (PC[1024 + 2 * tid] + PC[1024 + 2 * tid + 1]) + (PC[1536 + 2 * tid] + PC[1536 + 2 * tid + 1]);
        { const int d = tid & 63, nq = tid >> 6; float acc[4] = {0.f, 0.f, 0.f, 0.f};
#pragma unroll 4
            for (int n = nq * 64; n < nq * 64 + 64; ++n) { const float vv = VC[(size_t)n * 64 + d];
#pragma unroll
                for (int g = 0; g < 4; ++g) acc[g] += PC[g * 512 + n] * vv; }
#pragma unroll
            for (int g = 0; g < 4; ++g) OCP[(nq * 4 + g) * 64 + d] = acc[g]; }
        __syncthreads();
        if (tid < 256) { const int g = tid >> 6, d = tid & 63;
#pragma unroll
            for (int nq = 0; nq < 8; ++nq) ocmp += OCP[(nq * 4 + g) * 64 + d];
            const int j = tid;
            if (j >= 1 && j <= 254) { const float v = IMPS[j]; int rank = 0;
                for (int jp = 1; jp <= 254; ++jp) { const float ov = IMPS[jp]; rank += (ov > v || (ov == v && jp < j)) ? 1 : 0; }
                if (rank < 13) SELB[rank] = j; }
            if (tid == 0) { SELB[13] = 0; SELB[14] = 255; SELB[15] = 256; }
        }
        __syncthreads();
    }
    float osel;
    {
        float M[4] = {NEG_BIG, NEG_BIG, NEG_BIG, NEG_BIG}, L[4] = {0.f, 0.f, 0.f, 0.f}, O[4] = {0.f, 0.f, 0.f, 0.f};
        const int* pt = (const int*)C.inp(4) + b * 128;
        for (int bi = 0; bi < 2; ++bi) {
            const int jb = __builtin_amdgcn_readfirstlane(SELB[2 * wave + bi]);
            if (jb < 256) { const int pid = pt[jb >> 1];
                const float* base = C.inp(3) + ((size_t)(l * NPOOL + pid) * 128 + (jb & 1) * 64) * 512;
                samp_block([&](int r) { return base + (size_t)r * 512; }, 64, kvh, QS, PW + wave * 256, lane, M, L, O);
            } else { const float* base = C.out + O_SEL_S + ((size_t)l * NTS + b * 4) * 512;
                samp_block([&](int r) { return base + (size_t)r * 512; }, t + 1, kvh, QS, PW + wave * 256, lane, M, L, O); }
        }
        osel = samp_combine(WST, tid, lane, wave, M, L, O);
    }
    float owin;
    {
        float M[4] = {NEG_BIG, NEG_BIG, NEG_BIG, NEG_BIG}, L[4] = {0.f, 0.f, 0.f, 0.f}, O[4] = {0.f, 0.f, 0.f, 0.f};
        const float* pre = C.inp(5) + (size_t)(l * 8 + b) * 262144;
        const float* nw = C.out + O_WIN_S + ((size_t)(l * 8 + b) * 512 + 508) * 512;
        samp_block([&](int r) { const int p = t + 1 + 64 * wave + r; return p <= 511 ? pre + (size_t)p * 512 : nw + (size_t)(p - 512) * 512; }, 64, kvh, QS, PW + wave * 256, lane, M, L, O);
        owin = samp_combine(WST, tid, lane, wave, M, L, O);
    }
    if (tid < 256) { const int g = tid >> 6, d = tid & 63, head = kvh * 4 + g;
        const float g0 = sigmoidf_(bf2f(P[m * PLD + GL_OFF + head * 3 + 0])), g1 = sigmoidf_(bf2f(P[m * PLD + GL_OFF + head * 3 + 1])), g2 = sigmoidf_(bf2f(P[m * PLD + GL_OFF + head * 3 + 2]));
        const float o = g0 * ocmp + g1 * osel + g2 * owin;
        wsp<bf16>(C, WS_MIX)[m * DM + 1024 + head * 64 + d] = (unsigned short)(pk2(o, 0.f) & 0xffffu); }
}

#ifndef C_MASK
#define C_MASK 7
#endif
constexpr int PC_SCAN_P = 128, PC_ATT_P = 512, PC_ATT_S = 128, PC_SCAN_S = 128, PC_ITEMS = PC_SCAN_P + PC_ATT_P + PC_ATT_S + PC_SCAN_S;
DI void phase_c(const Ctx& C0, int lq, int cmask = 7) {
    const int l = lq & 1;
    LAS int* slot = (LAS int*)(C0.lds + MISC_OFF + 64);
    for (;;) {
        __syncthreads();
        if (C0.tid == 0) *slot = (int)atomicAdd(C0.ctl + CW_QUEUE + 64 * lq, 1u);
        __syncthreads();
        int it = *slot;
        if (it >= PC_ITEMS) {
            if (lq != 0 || it - PC_ITEMS >= DEF_GROUPS) break;
            Ctx K = C0; { K.ws = launder_g(K.ws); K.out = launder_g(K.out); int t_ = K.tid; asm volatile("" : "+v"(t_)); K.tid = t_; K.lane = t_ & 63; K.wave = __builtin_amdgcn_readfirstlane(t_ >> 6); }
            for (int e = 0; e < 4; ++e) deferred_item(K, (it - PC_ITEMS) * 4 + e);
            continue;
        }
        Ctx K = C0; { K.ws = launder_g(K.ws); K.out = launder_g(K.out); int t_ = K.tid; asm volatile("" : "+v"(t_)); K.tid = t_; K.lane = t_ & 63; K.wave = __builtin_amdgcn_readfirstlane(t_ >> 6); }
        const Ctx& C = K;
        if (it >= PC_SCAN_P && it < PC_SCAN_P + PC_ATT_S) it += PC_ATT_P; else if (it >= PC_SCAN_P + PC_ATT_S && it < PC_SCAN_P + PC_ATT_S + PC_ATT_P) it -= PC_ATT_S;
        if (it < PC_SCAN_P || it >= PC_SCAN_P + PC_ATT_P + PC_ATT_S) {
            int row0, T, h; const float* S0; float* So;
            int cmode = 0;
            if (it < PC_SCAN_P) { const int u = it & 63, b = u >> 4; cmode = it < 64 ? 1 : 0; h = u & 15; row0 = b * 2048; T = 2048; S0 = nullptr; So = C.out + O_RW_P + ((size_t)(l * 4 + b) * 16 + h) * 4096; }
            else { const int u = it - (PC_SCAN_P + PC_ATT_P + PC_ATT_S), b = u >> 4; h = u & 15; row0 = NTP + b * 4; T = 4; S0 = C.inp(6) + ((size_t)(l * 8 + b) * 16 + h) * 4096; So = C.out + O_RW_S + ((size_t)(l * 8 + b) * 16 + h) * 4096; }
            if (cmask & 1) { if (S0) scan_head(C, l, row0, T, h, S0, So); else if (cmode) chunk_head<1>(C, l, row0 >> 11, h, So, cmode); else chunk_head<0>(C, l, row0 >> 11, h, So, 0); }
        } else if (it < PC_SCAN_P + PC_ATT_P) {
            const int u = it - PC_SCAN_P, qt = 31 - (u >> 4), bk = u & 15;
            if (cmask & 2) nsa_prompt_unit(C, l, bk >> 2, bk & 3, qt, (cmask & 8) != 0, (cmask & 16) != 0);
        } else {
            const int u = it - (PC_SCAN_P + PC_ATT_P);
            if (cmask & 4) nsa_sample_item(C, l, u >> 4, (u >> 2) & 3, u & 3);
        }
    }
    __syncthreads();
}

DI const float* xin_row(const Ctx& C, int l, size_t m) {
    if (l == 0) return m < (size_t)NTP ? C.inp(0) + m * DM : C.inp(1) + (m - NTP) * DM;
    return wsp<float>(C, WS_XF1) + m * DM;
}
DI void ln_stage_gb(const Ctx& C, const float* gw, const float* bw) {
    __syncthreads();
    { const f32x4 g4 = ((const f32x4*)gw)[C.tid], b4 = ((const f32x4*)bw)[C.tid]; ((LAS f32x4*)C.lds)[C.tid] = g4; ((LAS f32x4*)(C.lds + 8192))[C.tid] = b4; }
    __syncthreads();
}
DI void phase_e(const Ctx& C, int l) {
    const int lane = C.lane;
    const bf16* H = wsp<bf16>(C, WS_HS);
    bf16* X1B = wsp<bf16>(C, WS_X1B); const bf16* XB = wsp<bf16>(C, WS_XB);
    ln_stage_gb(C, C.inp(22) + (size_t)l * DM, C.inp(23) + (size_t)l * DM);
    const LAS f32x4* GL = (const LAS f32x4*)C.lds; const LAS f32x4* BL = (const LAS f32x4*)(C.lds + 8192);
    const int stride = C.G * NWAVES;
    f32x4 xf[8]; v2u xh[8], hh[8];
#define E_LOAD(mm) do { const v2u* hr_ = (const v2u*)(H + (size_t)(mm) * DM) + lane; \
        if (l == 0) { const f32x4* xr_ = (const f32x4*)xin_row(C, l, (mm)) + lane; _Pragma("unroll") for (int j = 0; j < 8; ++j) { xf[j] = xr_[64 * j]; hh[j] = hr_[64 * j]; } } \
        else { const v2u* xr_ = (const v2u*)(XB + (size_t)(mm) * DM) + lane; _Pragma("unroll") for (int j = 0; j < 8; ++j) { xh[j] = xr_[64 * j]; hh[j] = hr_[64 * j]; } } } while (0)
    int m = blockIdx.x * NWAVES + C.wave;
    if (m < NT) E_LOAD(m);
    for (; m < NT; m += stride) {
        f32x4 v[8]; float s = 0.f;
#pragma unroll
        for (int j = 0; j < 8; ++j) { const f32x4 hv = {bflo(hh[j].x), bfhi(hh[j].x), bflo(hh[j].y), bfhi(hh[j].y)};
            v[j] = (l == 0 ? xf[j] : (f32x4){bflo(xh[j].x), bfhi(xh[j].x), bflo(xh[j].y), bfhi(xh[j].y)}) * DN_ALPHA + hv; }
        if (m + stride < NT) E_LOAD(m + stride);
#pragma unroll
        for (int j = 0; j < 8; ++j) s += (v[j][0] + v[j][1]) + (v[j][2] + v[j][3]);
        const float mean = wave_sum(s) * (1.f / DM); float s2 = 0.f;
#pragma unroll
        for (int j = 0; j < 8; ++j) { v[j] = v[j] - mean; s2 += (v[j][0] * v[j][0] + v[j][1] * v[j][1]) + (v[j][2] * v[j][2] + v[j][3] * v[j][3]); }
        const float rstd = __builtin_amdgcn_rsqf(wave_sum(s2) * (1.f / DM) + LN_EPS);
        float am = 0.f;
#pragma unroll
        for (int j = 0; j < 8; ++j) { const f32x4 gg = GL[lane + 64 * j], bb = BL[lane + 64 * j];
            const f32x4 o = v[j] * rstd * gg + bb; v[j] = o;
            am = fmaxf(am, fmaxf(fmaxf(fabsf(o[0]), fabsf(o[1])), fmaxf(fabsf(o[2]), fabsf(o[3]))));
            v2u p; p.x = pk2(o[0], o[1]); p.y = pk2(o[2], o[3]); ((v2u*)(X1B + (size_t)m * DM))[lane + 64 * j] = p; }
        am = wave_max(am);
        const float qs = am > 0.f ? am * (1.f / 127.f) : 1.f, qi = 1.f / qs;
#pragma unroll
        for (int j = 0; j < 8; ++j) { const f32x4 x = v[j] * qi;
            ((unsigned*)(C.ws + WS_X1Q + (size_t)m * DM))[lane + 64 * j] = ((unsigned)(int)__builtin_rintf(x[0]) & 255u) | (((unsigned)(int)__builtin_rintf(x[1]) & 255u) << 8) | (((unsigned)(int)__builtin_rintf(x[2]) & 255u) << 16) | ((unsigned)(int)__builtin_rintf(x[3]) << 24); }
        if (lane == 0) wsp<float>(C, WS_XQS)[m] = qs;
    }
#undef E_LOAD
    __syncthreads();
}

DI float gelu_erf(float x) { return 0.5f * x * (1.f + erff(x * 0.70710678118654752f)); }
DI unsigned fkey(float f) { const unsigned u = __builtin_bit_cast(unsigned, f); return u ^ ((unsigned)((int)u >> 31) | 0x80000000u); }
DI int mbcnt64(unsigned long long m) { return __builtin_amdgcn_mbcnt_hi((unsigned)(m >> 32), __builtin_amdgcn_mbcnt_lo((unsigned)m, 0)); }
template <int NV, bool LANE_MAJOR> DI void top16(const unsigned (&key)[NV], bool (&sel)[NV], int (&pos)[NV]) {
    unsigned thr = 0u; bool exact = false;
    for (int bit = 31; bit >= 0; --bit) {
        const unsigned cand = thr | (1u << bit);
        int cnt = 0;
#pragma unroll
        for (int v = 0; v < NV; ++v) cnt += __builtin_popcountll(__ballot(key[v] >= cand));
        if (cnt >= 16) { thr = cand; if (cnt == 16) { exact = true; break; } }
    }
    unsigned long long sm[NV];
    if (exact) {
#pragma unroll
        for (int v = 0; v < NV; ++v) { sel[v] = key[v] >= thr; sm[v] = __ballot(sel[v]); }
    } else {
        unsigned long long eq[NV]; int ngt = 0;
#pragma unroll
        for (int v = 0; v < NV; ++v) { ngt += __builtin_popcountll(__ballot(key[v] > thr)); eq[v] = __ballot(key[v] == thr); }
        const int need = 16 - ngt;
#pragma unroll
        for (int v = 0; v < NV; ++v) { int rk;
            if (LANE_MAJOR) { rk = 0;
#pragma unroll
                for (int w = 0; w < NV; ++w) { rk += mbcnt64(eq[w]); if (w < v) rk += (int)((eq[w] >> (threadIdx.x & 63)) & 1ull); } }
            else { rk = mbcnt64(eq[v]);
#pragma unroll
                for (int w = 0; w < NV; ++w) if (w < v) rk += __builtin_popcountll(eq[w]); }
            sel[v] = key[v] > thr || (key[v] == thr && rk < need); sm[v] = __ballot(sel[v]); }
    }
    int base = 0;
#pragma unroll
    for (int v = 0; v < NV; ++v) { pos[v] = base + mbcnt64(sm[v]); base += __builtin_popcountll(sm[v]); }
}
typedef float f32x2v __attribute__((ext_vector_type(2)));
typedef int v4i __attribute__((ext_vector_type(4)));
typedef int v2i __attribute__((ext_vector_type(2)));
constexpr int PS_NSL = 16, PS_TOKG = 64, PS_NGRP = (NT + PS_TOKG - 1) / PS_TOKG;
static_assert(NT % 8 == 0, "a wave's 8 tokens of a group are all valid or all invalid");
template <int NP, int NV> DI void top16_search(const unsigned (&key)[NP][NV], unsigned (&thr)[NP], bool (&ex)[NP]) {
    int c16[NP];
#pragma unroll
    for (int p = 0; p < NP; ++p) { thr[p] = 0u; c16[p] = 64 * NV; }
    for (unsigned bm = 0x80000000u; bm != 0u; bm >>= 1) {
        unsigned cand[NP]; unsigned long long bl[NP][NV]; int cnt[NP];
#pragma unroll
        for (int p = 0; p < NP; ++p) cand[p] = thr[p] | bm;
#pragma unroll
        for (int p = 0; p < NP; ++p)
#pragma unroll
            for (int v = 0; v < NV; ++v) bl[p][v] = __ballot(key[p][v] >= cand[p]);
#pragma unroll
        for (int p = 0; p < NP; ++p) { cnt[p] = 0;
#pragma unroll
            for (int v = 0; v < NV; ++v) cnt[p] += __builtin_popcountll(bl[p][v]); }
        int diff = 0;
#pragma unroll
        for (int p = 0; p < NP; ++p) { const bool ge = cnt[p] >= 16; thr[p] = ge ? cand[p] : thr[p]; c16[p] = ge ? cnt[p] : c16[p]; diff |= c16[p] ^ 16; }
        if (diff == 0) break;
    }
#pragma unroll
    for (int p = 0; p < NP; ++p) ex[p] = c16[p] == 16;
}
template <int NV, bool LANE_MAJOR> DI void top16_finish(const unsigned (&key)[NV], unsigned thr, bool exact, bool (&sel)[NV], int (&pos)[NV]) {
    unsigned long long sm[NV];
    if (exact) {
#pragma unroll
        for (int v = 0; v < NV; ++v) { sel[v] = key[v] >= thr; sm[v] = __ballot(sel[v]); }
    } else {
        unsigned long long eq[NV]; int ngt = 0;
#pragma unroll
        for (int v = 0; v < NV; ++v) { ngt += __builtin_popcountll(__ballot(key[v] > thr)); eq[v] = __ballot(key[v] == thr); }
        const int need = 16 - ngt;
#pragma unroll
        for (int v = 0; v < NV; ++v) { int rk;
            if (LANE_MAJOR) { rk = 0;
#pragma unroll
                for (int w = 0; w < NV; ++w) { rk += mbcnt64(eq[w]); if (w < v) rk += (int)((eq[w] >> (threadIdx.x & 63)) & 1ull); } }
            else { rk = mbcnt64(eq[v]);
#pragma unroll
                for (int w = 0; w < NV; ++w) if (w < v) rk += __builtin_popcountll(eq[w]); }
            sel[v] = key[v] > thr || (key[v] == thr && rk < need); sm[v] = __ballot(sel[v]); }
    }
    int base = 0;
#pragma unroll
    for (int v = 0; v < NV; ++v) { pos[v] = base + mbcnt64(sm[v]); base += __builtin_popcountll(sm[v]); }
}
DI float row_max16(float v) { v = fmaxf(v, dppf<0xB1>(v)); v = fmaxf(v, dppf<0x4E>(v)); v = fmaxf(v, dppf<0x141>(v)); return fmaxf(v, dppf<0x140>(v)); }
DI float row_sum16(float v) { v += dppf<0xB1>(v); v += dppf<0x4E>(v); v += dppf<0x141>(v); return v + dppf<0x140>(v); }
template <int CTRL, bool BC> DI int dppi(int v) { return __builtin_amdgcn_update_dpp(0, v, CTRL, 0xF, 0xF, BC); }
DI int row_sum16i(int v) { v += dppi<0xB1, false>(v); v += dppi<0x4E, false>(v); v += dppi<0x141, false>(v); v += dppi<0x140, false>(v); return v; }
DI int row_scan16i(int v) { v += dppi<0x111, true>(v); v += dppi<0x112, true>(v); v += dppi<0x114, true>(v); v += dppi<0x118, true>(v); return v; }
DI unsigned row_max16u(unsigned v) { v = max(v, (unsigned)dppi<0xB1, false>((int)v)); v = max(v, (unsigned)dppi<0x4E, false>((int)v)); v = max(v, (unsigned)dppi<0x141, false>((int)v)); return max(v, (unsigned)dppi<0x140, false>((int)v)); }
DI unsigned row_min16u(unsigned v) { v = min(v, (unsigned)dppi<0xB1, false>((int)v)); v = min(v, (unsigned)dppi<0x4E, false>((int)v)); v = min(v, (unsigned)dppi<0x141, false>((int)v)); return min(v, (unsigned)dppi<0x140, false>((int)v)); }
template <int NK> DI unsigned row_top16_search(unsigned (&key)[NK]) {
    unsigned lm = key[0];
#pragma unroll
    for (int j = 1; j < NK; ++j) lm = max(lm, key[j]);
    const unsigned kmax = row_max16u(lm), L = row_min16u(lm), sp1 = kmax - L + 1u;
    const unsigned spw = max(max((unsigned)__builtin_amdgcn_readlane((int)sp1, 0), (unsigned)__builtin_amdgcn_readlane((int)sp1, 16)), max((unsigned)__builtin_amdgcn_readlane((int)sp1, 32), (unsigned)__builtin_amdgcn_readlane((int)sp1, 48)));
    const int B = spw == 0u ? 32 : 32 - __builtin_clz(spw);
    const unsigned M = B == 32 ? 0xFFFFFFFFu : (1u << B) - 1u, off = kmax - M, lo = L - 1u;
#pragma unroll
    for (int j = 0; j < NK; ++j) key[j] = max(key[j], lo) - off;
    unsigned thr = 0u; int c16 = 16 * NK;
    for (unsigned bm = 1u << (B - 1); bm != 0u; bm >>= 1) {
        const unsigned cand = thr | bm; int cnt = 0;
#pragma unroll
        for (int j = 0; j < NK; ++j) cnt += key[j] >= cand ? 1 : 0;
        cnt = row_sum16i(cnt);
        const bool ge = cnt >= 16; thr = ge ? cand : thr; c16 = ge ? cnt : c16;
        if (__ballot(c16 != 16) == 0ull) break;
    }
    return thr;
}
template <int NK> DI void row_top16_place(const unsigned (&key)[NK], unsigned thr, int (&pos)[NK]) {
    int cg = 0, ce = 0;
#pragma unroll
    for (int j = 0; j < NK; ++j) { cg += key[j] > thr ? 1 : 0; ce += key[j] == thr ? 1 : 0; }
    const int pk = cg | (ce << 8);
    const int exc = row_scan16i(pk) - pk, tot = row_sum16i(pk);
    int pg_ = exc & 255, pe_ = (tot & 255) + (exc >> 8);
#pragma unroll
    for (int j = 0; j < NK; ++j) { const bool g = key[j] > thr, e = key[j] == thr; pos[j] = g ? pg_ : (e ? pe_ : 16); pg_ += g ? 1 : 0; pe_ += e ? 1 : 0; }
}
DI void peer_topk(const Ctx& C, int l) {
    const int lane = C.lane, wave = C.wave, n = lane & 15, r = lane >> 4;
    LAS float* WL = (LAS float*)(C.lds + 65536 + 256 + wave * 2048 + r * 384);
    LAS int* WLi = (LAS int*)WL;
    const float* Sc = wsp<float>(C, WS_HS);
    unsigned short* EL = wsp<unsigned short>(C, WS_EL); float* GT = wsp<float>(C, WS_GT);
    static_assert(NT % 4 == 0, "token quads");
    for (int m = 4 * blockIdx.x; m < NT; m += 4 * C.G) {
        const float* sr = Sc + (size_t)(m + r) * DM + wave * 256 + 8 * n;
        f32x4 sv[2][2];
#pragma unroll
        for (int c = 0; c < 2; ++c) { sv[c][0] = *(const f32x4*)(sr + 128 * c); sv[c][1] = *(const f32x4*)(sr + 128 * c + 4); }
#pragma unroll
        for (int c = 0; c < 2; ++c) {
            unsigned key[8]; int pos[8];
#pragma unroll
            for (int j = 0; j < 8; ++j) key[j] = fkey(sv[c][j >> 2][j & 3]);
            const unsigned thr = row_top16_search<8>(key);
            row_top16_place<8>(key, thr, pos);
#pragma unroll
            for (int j = 0; j < 8; ++j) if (pos[j] < 16) { WL[32 * c + pos[j]] = sv[c][j >> 2][j & 3]; WLi[32 * c + 16 + pos[j]] = 8 * n + j; }
        }
        LDS_WAIT(); asm volatile("" ::: "memory");
        {
            const float x0 = WL[n]; const int e0 = WLi[16 + n] * 128;
            float cd[16]; unsigned key[16]; int pos[16];
#pragma unroll
            for (int q = 0; q < 4; ++q) { const f32x4 x1 = *(const LAS f32x4*)(WL + 32 + 4 * q);
#pragma unroll
                for (int e = 0; e < 4; ++e) { cd[4 * q + e] = x0 + x1[e]; key[4 * q + e] = fkey(cd[4 * q + e]); } }
            const unsigned thr = row_top16_search<16>(key);
            row_top16_place<16>(key, thr, pos);
#pragma unroll
            for (int b = 0; b < 16; ++b) if (pos[b] < 16) { WL[64 + pos[b]] = cd[b]; WLi[80 + pos[b]] = e0 + WLi[48 + b]; }
        }
        LDS_WAIT(); asm volatile("" ::: "memory");
        { const float tv = WL[64 + n];
          const float ev = expf(tv - row_max16(tv));
          const float gate = ev / row_sum16(ev);
          EL[(size_t)(m + r) * 128 + wave * 16 + n] = (unsigned short)WLi[80 + n]; GT[(size_t)(m + r) * 128 + wave * 16 + n] = gate; }
        LDS_WAIT(); asm volatile("" ::: "memory");
    }
}
template <int SIDE> DI void peer_sliced(const Ctx& C, int l, int lq) {
    const int tid = C.tid, lane = C.lane, wave = C.wave, pg = lane >> 3, dq = lane & 7;
    LAS int* slot = (LAS int*)(C.lds + MISC_OFF + 64);
    const unsigned char* TAB = C.ws + (SIDE ? WS_VB : WS_UB) + (size_t)l * NEXP * DM;
    const unsigned char* X1Q = C.ws + WS_X1Q;
    const unsigned short* EL = wsp<unsigned short>(C, WS_EL); const float* WP = wsp<float>(C, WS_WP);
    bf16* PD = wsp<bf16>(C, WS_PD); bf16* FO = wsp<bf16>(C, WS_FO);
    unsigned* const Q0 = C.ctl + CW_SQ + 64 * ((lq * 2 + SIDE) * 16);
    const int s_first = (int)((2u * xb_xcc_id()) & (PS_NSL - 1));
    int k = 0;
    for (;;) {
        __syncthreads();
        if (tid == 0) { int got = -1;
            while (k < PS_NSL) { const int s = (s_first + k) & (PS_NSL - 1); const unsigned g = atomicAdd(Q0 + 64 * s, 1u); if (g < (unsigned)PS_NGRP) { got = (s << 16) | (int)g; break; } ++k; }
            *slot = got; }
        __syncthreads();
        const int d = __builtin_amdgcn_readfirstlane(*slot);
        if (d < 0) break;
        const int s = d >> 16, g = d & 0xffff;
        const int t0 = g * PS_TOKG + wave * 8;
        if (t0 >= NT) continue;
        const unsigned char* TS = TAB + (size_t)s * NEXP * 128;
        const unsigned dq16 = (unsigned)dq * 16u;
        v4u E[2][2]; v4u R[2][16]; f32x4 A[2][4]; v4u AQ[2];
        LAS unsigned char* const WB = C.lds + wave * 4352;
        const int wofs = pg * 512 + dq * 64, rofs = (lane >> 3) * 64 + 16 * (((lane & 7) >> 1) ^ ((lane >> 3) & 3)) + 8 * (lane & 1);
#define PS_LOAD_E(b, t) do { const v4u* ep_ = (const v4u*)(EL + (size_t)(t) * 128 + 16 * pg); E[b][0] = ep_[0]; E[b][1] = ep_[1]; } while (0)
#define PS_LOAD_R(b, t) do { \
            _Pragma("unroll") for (int i = 0; i < 16; ++i) { const unsigned w_ = E[b][i >> 3][(i >> 1) & 3]; const unsigned e_ = (i & 1) ? (w_ >> 16) : (w_ & 0xffffu); \
                R[b][i] = *(const v4u*)(TS + ((e_ << 7) | dq16)); } \
            if (SIDE == 0) AQ[b] = *(const v4u*)(X1Q + (size_t)(t) * DM + 128 * s + 16 * dq); \
            else { const f32x4* ap_ = (const f32x4*)(WP + (size_t)(t) * 128 + 16 * pg); _Pragma("unroll") for (int q = 0; q < 4; ++q) A[b][q] = ap_[q]; } } while (0)
        PS_LOAD_E(0, t0); PS_LOAD_E(1, t0 + 1);
        PS_LOAD_R(0, t0);
#pragma unroll
        for (int j = 0; j < 8; ++j) {
            const int b = j & 1, t = t0 + j;
            if (j + 2 < 8) PS_LOAD_E(b, t + 2);
            if (j + 1 < 8) PS_LOAD_R(b ^ 1, t + 1);
            __builtin_amdgcn_sched_barrier(0);
            if (SIDE == 0) {
                int dd[16];
#pragma unroll
                for (int i = 0; i < 16; ++i) { int a = 0;
#pragma unroll
                    for (int q = 0; q < 4; ++q) a = __builtin_amdgcn_sdot4((int)R[b][i][q], (int)AQ[b][q], a, false);
                    dd[i] = a; }
#pragma unroll
                for (int q = 0; q < 4; ++q) *(LAS v4i*)(WB + dq * 528 + pg * 64 + 16 * q) = (v4i){dd[4 * q], dd[4 * q + 1], dd[4 * q + 2], dd[4 * q + 3]};
                v2i rs = {0, 0};
#pragma unroll
                for (int d8 = 0; d8 < 8; ++d8) rs += *(const LAS v2i*)(WB + 8 * lane + 528 * d8);
                *(unsigned*)(PD + ((size_t)t * PS_NSL + s) * 128 + 2 * lane) = pk2((float)rs.x, (float)rs.y);
            } else {
                f32x2v acc[8];
#pragma unroll
                for (int q = 0; q < 8; ++q) acc[q] = (f32x2v){0.f, 0.f};
#pragma unroll
                for (int i = 0; i < 16; ++i) { const float w = A[b][i >> 2][i & 3]; const f32x2v w2 = {w, w};
#pragma unroll
                    for (int q = 0; q < 4; ++q) { const int wd = (int)R[b][i][q]; acc[2 * q] += w2 * __builtin_amdgcn_cvt_pk_f32_fp8(wd, false); acc[2 * q + 1] += w2 * __builtin_amdgcn_cvt_pk_f32_fp8(wd, true); } }
#pragma unroll
                for (int q = 0; q < 4; ++q) *(LAS f32x4*)(WB + wofs + 16 * (q ^ (dq & 3))) = (f32x4){acc[2 * q].x, acc[2 * q].y, acc[2 * q + 1].x, acc[2 * q + 1].y};
                f32x2v rs = {0.f, 0.f};
#pragma unroll
                for (int h8 = 0; h8 < 8; ++h8) rs += *(const LAS f32x2v*)(WB + rofs + 512 * h8);
                *(unsigned*)(FO + (size_t)t * DM + 128 * s + 2 * lane) = pk2(rs.x, rs.y);
            }
        }
#undef PS_LOAD_E
#undef PS_LOAD_R
    }
}
DI void peer_gelu(const Ctx& C, int l) {
    const unsigned short* EL = wsp<unsigned short>(C, WS_EL); const float* GT = wsp<float>(C, WS_GT); const bf16* PD = wsp<bf16>(C, WS_PD); float* WP = wsp<float>(C, WS_WP);
    const float* USC = wsp<float>(C, WS_USC) + (size_t)l * NEXP; const float* VSC = USC + 2 * NEXP; const float* XQS = wsp<float>(C, WS_XQS);
    for (int idx = blockIdx.x * NTHREADS + C.tid; idx < NT * 128; idx += C.G * NTHREADS) {
        const int t = idx >> 7, p = idx & 127; const unsigned e = EL[idx];
        float h = 0.f;
#pragma unroll
        for (int s = 0; s < PS_NSL; ++s) h += bf2f(PD[((size_t)t * PS_NSL + s) * 128 + p]);
        WP[idx] = GT[idx] * gelu_erf(h * USC[e] * XQS[t]) * VSC[e];
    }
}
DI void peer_ln2(const Ctx& C, int l) {
    const int lane = C.lane;
    const bf16* X1B = wsp<bf16>(C, WS_X1B); const bf16* FO = wsp<bf16>(C, WS_FO);
    ln_stage_gb(C, C.inp(28) + (size_t)l * DM, C.inp(29) + (size_t)l * DM);
    const LAS f32x4* GL = (const LAS f32x4*)C.lds; const LAS f32x4* BL = (const LAS f32x4*)(C.lds + 8192);
    const int stride = C.G * NWAVES;
    v2u xh[8], fh[8];
#define G5_LOAD(mm) do { const v2u* xr_ = (const v2u*)(X1B + (size_t)(mm) * DM) + lane; const v2u* fr_ = (const v2u*)(FO + (size_t)(mm) * DM) + lane; \
        _Pragma("unroll") for (int j = 0; j < 8; ++j) { xh[j] = xr_[64 * j]; fh[j] = fr_[64 * j]; } } while (0)
    int m = blockIdx.x * NWAVES + C.wave;
    if (m < NT) G5_LOAD(m);
    for (; m < NT; m += stride) {
        f32x4 v[8]; float s = 0.f;
#pragma unroll
        for (int j = 0; j < 8; ++j) { v[j] = (f32x4){bflo(xh[j].x), bfhi(xh[j].x), bflo(xh[j].y), bfhi(xh[j].y)} * DN_ALPHA + (f32x4){bflo(fh[j].x), bfhi(fh[j].x), bflo(fh[j].y), bfhi(fh[j].y)}; s += (v[j][0] + v[j][1]) + (v[j][2] + v[j][3]); }
        if (m + stride < NT) G5_LOAD(m + stride);
        const float mean = wave_sum(s) * (1.f / DM); float s2 = 0.f;
#pragma unroll
        for (int j = 0; j < 8; ++j) { v[j] = v[j] - mean; s2 += (v[j][0] * v[j][0] + v[j][1] * v[j][1]) + (v[j][2] * v[j][2] + v[j][3] * v[j][3]); }
        const float rstd = __builtin_amdgcn_rsqf(wave_sum(s2) * (1.f / DM) + LN_EPS);
#pragma unroll
        for (int j = 0; j < 8; ++j) { const f32x4 gg = GL[lane + 64 * j], bb = BL[lane + 64 * j];
            const f32x4 o = v[j] * rstd * gg + bb;
            if (l == 0) {
                v2u p; p.x = pk2(o[0], o[1]); p.y = pk2(o[2], o[3]); ((v2u*)(wsp<bf16>(C, WS_XB) + (size_t)m * DM))[lane + 64 * j] = p; }
            else { float* dst = m < NTP ? C.out + O_YP + (size_t)m * DM : C.out + O_YS + (size_t)(m - NTP) * DM; ((f32x4*)dst)[lane + 64 * j] = o; } }
    }
#undef G5_LOAD
    __syncthreads();
}

#ifndef PH_MASK
#define PH_MASK 0xFF
#endif
#define IN(k) (lo <= (k) && (k) < hi)
#define EN(s) ((PH_MASK >> (s)) & 1)
#define FRESH(CX) Ctx CX = C; { CX.ws = launder_g(CX.ws); CX.out = launder_g(CX.out); int t_ = CX.tid; asm volatile("" : "+v"(t_)); CX.tid = t_; CX.lane = t_ & 63; CX.wave = __builtin_amdgcn_readfirstlane(t_ >> 6); CX.ctl = (unsigned*)(CX.ws + WS_CTL); }
#ifndef PROBE_REP
#define PROBE_REP 0
#endif
#ifndef PROBE_PMASK
#define PROBE_PMASK 31
#endif
#ifndef PROBE_CMASK
#define PROBE_CMASK 7
#endif
#define NREP(s) (((PROBE_REP >> (s)) & 1) ? 2 : 1)
#ifndef PROBE_G
#define PROBE_G 0
#endif
#define GREP(s) (((PROBE_G >> (s)) & 1) ? 2 : 1)
#define REPBAR(s, rep) do { if (NREP(s) == 2 && (rep) == 0 && (hi - lo) > 1) xcd_barrier(bar); } while (0)
#define SEAM(k) do { if (IN(k) && IN((k) + 1)) xcd_barrier(bar); } while (0)
template <int l> DI void run_layer(const Ctx& C, const XcdBarrier& bar, int lo, int hi) {
        const int pb = 1 + 11 * l;
        _Pragma("unroll") for (int rep = 0; rep < NREP(0); ++rep) if (EN(0) && IN(pb + 0)) {
            FRESH(K);
            pg8::Gemm g{wsp<bf16>(K, WS_XB), wsp<bf16>(K, WS_WIN) + (size_t)l * PLD * DM, NTP, PLD, DM}; pg8::StaticOrder S; S.init(NTP, PLD, K.G, (int)blockIdx.x);
            EpiInProj E{wsp<bf16>(K, WS_PROJ), K.out, l};
            pg8::gemm_phase<EpiInProj, pg8::StaticOrder, true, true>(K.lds, g, S, E);
            { bf16* P = wsp<bf16>(K, WS_PROJ); float* out = K.out;
              skinny_gemm(K, wsp<bf16>(K, WS_XB) + (size_t)NTP * DM, wsp<bf16>(K, WS_WIN) + (size_t)l * PLD * DM, (IN_COLS + 31) / 32, [&](int j, int col, float v) {
                  P[(size_t)(NTP + j) * PLD + col] = (unsigned short)(pk2(v, 0.f) & 0xffffu);
                  const int b = j >> 2, t = j & 3;
                  if (col < RW_COLS) { if (t == 3) out[O_SH_S + (size_t)(l * 8 + b) * RW_COLS + col] = v; }
                  else if (col >= KC_OFF && col < GL_OFF) { const int c = col - KC_OFF, reg = c >> 9, cc = c & 511;
                      if (reg == 0) out[O_CMP_S + ((size_t)l * NTS + j) * 512 + cc] = v; else if (reg == 1) out[O_SEL_S + ((size_t)l * NTS + j) * 512 + cc] = v;
                      else out[O_WIN_S + ((size_t)(l * 8 + b) * 512 + 508 + t) * 512 + cc] = v; } }); }
            REPBAR(0, rep);
        }
        SEAM(pb + 0);
        _Pragma("unroll") for (int rep = 0; rep < NREP(1); ++rep) if (EN(1) && IN(pb + 1)) { FRESH(K); phase_b(K, l, l + 2 * rep); REPBAR(1, rep); }
        SEAM(pb + 1);
        _Pragma("unroll") for (int rep = 0; rep < NREP(2); ++rep) if (EN(2) && IN(pb + 2)) { FRESH(K); phase_c(K, l + 2 * rep, rep == 0 ? 7 : PROBE_CMASK); REPBAR(2, rep); }
        SEAM(pb + 2);
        _Pragma("unroll") for (int rep = 0; rep < NREP(3); ++rep) if (EN(3) && IN(pb + 3)) {
            FRESH(K);
            pg8::Gemm g{wsp<bf16>(K, WS_MIX), wsp<bf16>(K, WS_WOUT) + (size_t)l * DM * DM, NTP, DM, DM}; pg8::StaticOrder S; S.init(NTP, DM, K.G, (int)blockIdx.x);
            EpiBf16Row E{wsp<bf16>(K, WS_HS), DM};
            pg8::gemm_phase<EpiBf16Row, pg8::StaticOrder, true, true>(K.lds, g, S, E);
            { bf16* H = wsp<bf16>(K, WS_HS) + (size_t)NTP * DM;
              skinny_gemm(K, wsp<bf16>(K, WS_MIX) + (size_t)NTP * DM, wsp<bf16>(K, WS_WOUT) + (size_t)l * DM * DM, DM / 32, [&](int j, int col, float v) { H[(size_t)j * DM + col] = (unsigned short)(pk2(v, 0.f) & 0xffffu); }); }
            REPBAR(3, rep);
        }
        SEAM(pb + 3);
        _Pragma("unroll") for (int rep = 0; rep < NREP(4); ++rep) if (EN(4) && IN(pb + 4)) { FRESH(K); phase_e(K, l); REPBAR(4, rep); }
        SEAM(pb + 4);
        _Pragma("unroll") for (int rep = 0; rep < NREP(5); ++rep) if (EN(5) && IN(pb + 5)) {
            FRESH(K);
            pg8::Gemm g{wsp<bf16>(K, WS_X1B), wsp<bf16>(K, WS_W2) + (size_t)l * DM * DM, NTP, DM, DM}; pg8::StaticOrder S; S.init(NTP, DM, K.G, (int)blockIdx.x);
            pg8::EpiF32 E{wsp<float>(K, WS_HS), DM, nullptr};
            pg8::gemm_phase<pg8::EpiF32, pg8::StaticOrder, true, true>(K.lds, g, S, E);
            { float* H = wsp<float>(K, WS_HS) + (size_t)NTP * DM;
              skinny_gemm(K, wsp<bf16>(K, WS_X1B) + (size_t)NTP * DM, wsp<bf16>(K, WS_W2) + (size_t)l * DM * DM, DM / 32, [&](int j, int col, float v) { H[(size_t)j * DM + col] = v; }); }
            REPBAR(5, rep);
        }
        SEAM(pb + 5);
        _Pragma("unroll") for (int rep = 0; rep < GREP(0); ++rep) { if (IN(pb + 6)) { FRESH(K); peer_topk(K, l); } if (GREP(0) == 2 && rep == 0) xcd_barrier(bar); }
        SEAM(pb + 6);
        _Pragma("unroll") for (int rep = 0; rep < GREP(1); ++rep) { if (IN(pb + 7)) { FRESH(K); peer_sliced<0>(K, l, l + 2 * rep); } if (GREP(1) == 2 && rep == 0) xcd_barrier(bar); }
        SEAM(pb + 7);
        _Pragma("unroll") for (int rep = 0; rep < GREP(2); ++rep) { if (IN(pb + 8)) { FRESH(K); peer_gelu(K, l); } if (GREP(2) == 2 && rep == 0) xcd_barrier(bar); }
        SEAM(pb + 8);
        _Pragma("unroll") for (int rep = 0; rep < GREP(3); ++rep) { if (IN(pb + 9)) { FRESH(K); peer_sliced<1>(K, l, l + 2 * rep); } if (GREP(3) == 2 && rep == 0) xcd_barrier(bar); }
        SEAM(pb + 9);
        _Pragma("unroll") for (int rep = 0; rep < GREP(4); ++rep) { if (IN(pb + 10)) { FRESH(K); peer_ln2(K, l); } if (GREP(4) == 2 && rep == 0) xcd_barrier(bar); }
        SEAM(pb + 10);
}
typedef ArgsK Args;
__global__ void __launch_bounds__(NTHREADS, 2) fwd_kernel(Args args) {
    extern __shared__ __attribute__((aligned(16))) unsigned char lds[];
    Ctx C;
    C.out = args.out; C.ws = args.ws; C.lds = (LAS unsigned char*)lds; C.ctl = (unsigned*)(args.ws + WS_CTL);
    C.tid = threadIdx.x; C.lane = C.tid & 63; C.wave = __builtin_amdgcn_readfirstlane(C.tid >> 6); C.G = gridDim.x;
    volatile LAS unsigned* MISC = (volatile LAS unsigned*)(C.lds + MISC_OFF);
    for (int u = C.tid; u < (LDS_BYTES - RING_BYTES) / 4; u += NTHREADS) ((LAS unsigned*)(C.lds + RING_BYTES))[u] = 0u;
    __syncthreads();
    XcdBarrier bar; bar.bar = C.ctl + CW_BAR; bar.x = 0; bar.st = nullptr;
    if (args.use_bar) bar = xcd_barrier_post(C.ctl + CW_BAR, MISC + 8);
    const int lo = args.ph_lo, hi = args.ph_hi;
#ifdef PROBE_DELAY_TICKS
    { const unsigned long long t0 = __builtin_amdgcn_s_memrealtime(); while (__builtin_amdgcn_s_memrealtime() - t0 < (unsigned long long)PROBE_DELAY_TICKS) __builtin_amdgcn_s_sleep(32); }
#endif
#ifdef PROBE_AMPLIFY
    { const unsigned long long t0 = __builtin_amdgcn_s_memrealtime(); xcd_barrier(bar);
      if (blockIdx.x == PROBE_AMPLIFY - 1) { const unsigned long long dt = __builtin_amdgcn_s_memrealtime() - t0; while (__builtin_amdgcn_s_memrealtime() - t0 < 5ull * dt) __builtin_amdgcn_s_sleep(32); } }
#endif
    _Pragma("unroll") for (int rep = 0; rep < NREP(7); ++rep) if (EN(7) && IN(0)) { FRESH(K); p0_prologue(K, NREP(7) == 1 ? 31 : (rep == 0 ? PROBE_PMASK : (31 & ~PROBE_PMASK))); REPBAR(7, rep); }
    SEAM(0);
    run_layer<0>(C, bar, lo, hi);
    run_layer<1>(C, bar, lo, hi);
#undef IN
#undef SEAM
}

#ifndef MK_ONE_LAUNCH
#define MK_ONE_LAUNCH 1
#endif
extern "C" void kernel_launch(void* const* d_in, const int* in_sizes, int n_in, void* d_out, int out_size, void* d_ws, size_t ws_size, hipStream_t stream) {
    static int grid = 0;
    if (grid == 0) {
        if (n_in != 30 || out_size != (int)O_END || ws_size < WS_END) { fprintf(stderr, "kernel_launch: unexpected shapes (n_in %d, out %d, ws %zu < %zu); nothing launched\n", n_in, out_size, ws_size, (size_t)WS_END); grid = -1; return; }
        int dev = 0, cus = 0, per_cu = 0;
        if (hipGetDevice(&dev) != hipSuccess || hipDeviceGetAttribute(&cus, hipDeviceAttributeMultiprocessorCount, dev) != hipSuccess) { grid = -1; return; }
        if (hipFuncSetAttribute((const void*)fwd_kernel, hipFuncAttributeMaxDynamicSharedMemorySize, LDS_BYTES) != hipSuccess) { fprintf(stderr, "kernel_launch: hipFuncSetAttribute failed\n"); grid = -1; return; }
        if (hipOccupancyMaxActiveBlocksPerMultiprocessor(&per_cu, (const void*)fwd_kernel, NTHREADS, LDS_BYTES) != hipSuccess || per_cu < 1) { fprintf(stderr, "kernel_launch: occupancy query says %d blocks per CU\n", per_cu); }
        (void)hipGetLastError();
        grid = cus;
    }
    if (grid < 0) return;
    if (hipMemsetAsync((char*)d_ws + WS_CTL, 0, CTL_ZERO_BYTES, stream) != hipSuccess) return;
    Args a{};
    for (int i = 0; i < 30; ++i) a.in[i] = (const float*)d_in[i];
    a.out = (float*)d_out; a.ws = (unsigned char*)d_ws;
#if MK_ONE_LAUNCH
    a.ph_lo = 0; a.ph_hi = N_PHASES; a.use_bar = 1;
    hipLaunchKernelGGL(fwd_kernel, dim3(grid), dim3(NTHREADS), LDS_BYTES, stream, a);
#else
    for (int p = 0; p < N_PHASES; ++p) { a.ph_lo = p; a.ph_hi = p + 1; a.use_bar = 0; hipLaunchKernelGGL(fwd_kernel, dim3(grid), dim3(NTHREADS), LDS_BYTES, stream, a); }
#endif
}
```

```cpp
#include <hip/hip_runtime.h>
#include <cstdio>
#include <cstdint>
namespace pg8 {
#define PG8_LAS __attribute__((address_space(3)))
typedef unsigned short bf16_t;
typedef short bf16x8 __attribute__((ext_vector_type(8)));
typedef float f32x4 __attribute__((ext_vector_type(4)));
typedef unsigned u32x4 __attribute__((ext_vector_type(4)));
constexpr int BM = 256, BK = 64, HALF = 128, HTB = HALF * BK * 2  , STAGE_BYTES = 8 * HTB, NXCD = 8, WGM = 8;

__host__ __device__ __forceinline__ int lds_byte(int r, int c) { const int st = (r >> 4) * 2 + (c >> 5), rr = r & 15, cc = c & 31, ob = rr * 64 + cc * 2; return st * 1024 + (ob ^ (((ob >> 9) & 1) << 5)); }
__host__ __device__ __forceinline__ void stage_rc(int b, int& R, int& C) { const int st = b / 1024, sb = b % 1024, swz = sb ^ (((sb >> 9) & 1) << 5); R = (st >> 1) * 16 + swz / 64; C = (st & 1) * 32 + (swz % 64) / 2; }
__host__ __device__ __forceinline__ int perm32(int rho) { const int n = rho >> 4, i = rho & 15; return 8 * (i >> 2) + 4 * n + (i & 3); }

struct Unit { int pm, pn; };
struct Gemm { const bf16_t* A; const bf16_t* Bt; int M, N, K; };

struct StaticOrder {
    int nM, nN, nwg, G, c;
    __host__ __device__ void init(int M, int N, int G_, int c_) { nM = M / BM; nN = N / BM; nwg = nM * nN; G = G_; c = c_; }
    __host__ __device__ bool next(int i, Unit& u) const {
        const long L = (long)i * G + c; if (L >= nwg) return false;
        int wgid = (int)L; { const int q = nwg / NXCD, r = nwg % NXCD, xcd = wgid % NXCD, off = wgid / NXCD; wgid = (xcd < r ? xcd * (q + 1) : r * (q + 1) + (xcd - r) * q) + off; }
        const int nig = WGM * nN, gid = wgid / nig, fm = gid * WGM, gsz = (nM - fm) < WGM ? (nM - fm) : WGM;
        u.pm = fm + ((wgid % nig) % gsz); u.pn = (wgid % nig) / gsz; return true;
    }
    __device__ __forceinline__ void a_ready(const Unit&) const {}
    __device__ __forceinline__ void done(const Unit&) const {}
};

__device__ __forceinline__ unsigned cvt_pk_bf16(float lo, float hi) { unsigned r; asm volatile("v_cvt_pk_bf16_f32 %0, %1, %2" : "=v"(r) : "v"(lo), "v"(hi)); return r; }
typedef float f32x2 __attribute__((ext_vector_type(2)));
struct EpiF32 {
    static constexpr bool PERM = false, AFTER_DRAIN = false;
    float* C; int ldc; const float* bias;
    __device__ __forceinline__ void operator()(const f32x4 (&acc)[2][2][4][2], const Unit& u, int wr, int wc, int fr, int fq) const {
        const int row0 = u.pm * BM + wr * 64 + fr, col0 = u.pn * BM + wc * 32 + 4 * fq;
        f32x4 bv[2][2];
#pragma unroll
        for (int bj = 0; bj < 2; ++bj)
#pragma unroll
            for (int n = 0; n < 2; ++n) bv[bj][n] = bias ? *(const f32x4*)(bias + col0 + bj * HALF + n * 16) : (f32x4){0.f, 0.f, 0.f, 0.f};
#pragma unroll
        for (int ai = 0; ai < 2; ++ai)
#pragma unroll
            for (int m = 0; m < 4; ++m) { float* rowp = C + (size_t)(row0 + ai * HALF + m * 16) * ldc + col0;
#pragma unroll
                for (int bj = 0; bj < 2; ++bj)
#pragma unroll
                    for (int n = 0; n < 2; ++n) *(f32x4*)(rowp + bj * HALF + n * 16) = acc[ai][bj][m][n] + bv[bj][n]; }
    }
};
template <class Epi, class Sched, bool ALIGN_EPI = false, bool SP2 = false>
__device__ __forceinline__ void gemm_phase(PG8_LAS unsigned char* lds, const Gemm g, const Sched& S, const Epi& E) {
    const int tid = threadIdx.x, wid = __builtin_amdgcn_readfirstlane(tid >> 6), lane = tid & 63, wr = wid >> 2, wc = wid & 3, fr = lane & 15, fq = lane >> 4;
    const int K = g.K, nt = K / BK;
    unsigned voffA[2], voffB[2];
#pragma unroll
    for (int i = 0; i < 2; ++i) { int R, C; stage_rc(tid * 16 + i * 8192, R, C); const int Rb = Epi::PERM ? ((R & ~31) + perm32(R & 31)) : R;
        voffA[i] = (unsigned)(R * K + C) * 2u; voffB[i] = (unsigned)(Rb * K + C) * 2u; }
    const size_t kstep = (size_t)(BK * 2);
    const size_t hstep = (size_t)HALF * K * 2;
    const size_t tstep = 2 * hstep;
    const unsigned ldsw = (unsigned)wid * 1024u;
    const int aoff = lds_byte(wr * 64 + fr, fq * 8), boff = lds_byte(wc * 32 + fr, fq * 8);
#define PG8_SA(b, h) (((b) * 2 + (h)) * HTB)
#define PG8_SB(b, h) ((4 + (b) * 2 + (h)) * HTB)
#define PG8_STAGE(bufoff, gbase, voff) do { _Pragma("unroll") for (int _i = 0; _i < 2; ++_i) \
        __builtin_amdgcn_global_load_lds((const unsigned*)((const char*)(gbase) + (voff)[_i]), (PG8_LAS unsigned*)(lds + (bufoff) + ldsw + _i * 8192), 16, 0, 0); } while (0)
#define PG8_LDA(dst, b, h) do { _Pragma("unroll") for (int m = 0; m < 4; ++m) _Pragma("unroll") for (int k = 0; k < 2; ++k) dst[m][k] = *(const PG8_LAS bf16x8*)(lds + PG8_SA(b, h) + aoff + m * 2048 + k * 1024); } while (0)
#define PG8_LDB(dst, b, h) do { _Pragma("unroll") for (int n = 0; n < 2; ++n) _Pragma("unroll") for (int k = 0; k < 2; ++k) dst[n][k] = *(const PG8_LAS bf16x8*)(lds + PG8_SB(b, h) + boff + n * 2048 + k * 1024); } while (0)
#define PG8_MMA(ai, bj, At, Bt) do { __builtin_amdgcn_s_setprio(1); _Pragma("unroll") for (int m = 0; m < 4; ++m) _Pragma("unroll") for (int n = 0; n < 2; ++n) _Pragma("unroll") for (int k = 0; k < 2; ++k) \
        acc[ai][bj][m][n] = __builtin_amdgcn_mfma_f32_16x16x32_bf16(Bt[n][k], At[m][k], acc[ai][bj][m][n], 0, 0, 0); __builtin_amdgcn_s_setprio(0); } while (0)
#define PG8_WAIT_V(n) asm volatile("s_waitcnt vmcnt(" #n ")" ::: "memory")
#define PG8_WAIT_L(n) asm volatile("s_waitcnt lgkmcnt(" #n ")" ::: "memory")
#define PG8_BAR __builtin_amdgcn_s_barrier()
#define PG8_SCHED __builtin_amdgcn_sched_barrier(0)
    Unit cur, nxt; int ui = 0;
    if (!S.next(0, cur)) return;
    f32x4 acc[2][2][4][2];
#pragma unroll
    for (int a = 0; a < 2; ++a)
#pragma unroll
        for (int b = 0; b < 2; ++b)
#pragma unroll
            for (int m = 0; m < 4; ++m)
#pragma unroll
                for (int n = 0; n < 2; ++n) acc[a][b][m][n] = (f32x4){0.f, 0.f, 0.f, 0.f};
    bf16x8 At[4][2], B0[2][2], B1[2][2];
    const char* cA = (const char*)g.A + (size_t)cur.pm * tstep; const char* cB = (const char*)g.Bt + (size_t)cur.pn * tstep;
    S.a_ready(cur);
    if constexpr (SP2) {
        PG8_STAGE(PG8_SB(0, 0), cB, voffB); PG8_STAGE(PG8_SB(0, 1), cB + hstep, voffB); PG8_STAGE(PG8_SA(0, 0), cA, voffA); PG8_STAGE(PG8_SA(0, 1), cA + hstep, voffA);
        if (wr == 1) PG8_BAR;
        PG8_WAIT_V(2); PG8_BAR;
        PG8_STAGE(PG8_SB(1, 0), cB + kstep, voffB); PG8_STAGE(PG8_SA(1, 0), cA + kstep, voffA); PG8_STAGE(PG8_SB(1, 1), cB + hstep + kstep, voffB);
        PG8_WAIT_V(6); PG8_BAR;
    } else {
        PG8_STAGE(PG8_SB(0, 0), cB, voffB); PG8_STAGE(PG8_SA(0, 0), cA, voffA); PG8_STAGE(PG8_SB(0, 1), cB + hstep, voffB); PG8_STAGE(PG8_SA(0, 1), cA + hstep, voffA);
        if (wr == 1) PG8_BAR;
        PG8_WAIT_V(4); PG8_BAR;
        PG8_STAGE(PG8_SB(1, 0), cB + kstep, voffB); PG8_STAGE(PG8_SA(1, 0), cA + kstep, voffA); PG8_STAGE(PG8_SB(1, 1), cB + hstep + kstep, voffB);
        PG8_WAIT_V(6); PG8_BAR;
    }
    for (;;) {
        const bool has_next = S.next(ui + 1, nxt);
        const char* nA = has_next ? (const char*)g.A + (size_t)nxt.pm * tstep : cA; const char* nB = has_next ? (const char*)g.Bt + (size_t)nxt.pn * tstep : cB;
        for (int t = 0; t < nt; t += 2) {
            const bool last = (t == nt - 2);
            const char* a1 = cA + (size_t)(t + 1) * kstep;
            const char* a2 = last ? nA : cA + (size_t)(t + 2) * kstep; const char* b2 = last ? nB : cB + (size_t)(t + 2) * kstep;
            const char* a3 = a2 + kstep; const char* b3 = b2 + kstep;
            if (last && has_next) S.a_ready(nxt);
            if constexpr (SP2) {
            PG8_LDB(B0, 0, 0); PG8_LDB(B1, 0, 1); PG8_SCHED; PG8_LDA(At, 0, 0); PG8_STAGE(PG8_SA(1, 1), a1 + hstep, voffA);
            PG8_WAIT_V(8); PG8_WAIT_L(0); PG8_BAR; PG8_MMA(0, 0, At, B0); PG8_MMA(0, 1, At, B1); PG8_BAR; PG8_SCHED;
            PG8_LDA(At, 0, 1); PG8_STAGE(PG8_SB(0, 0), b2, voffB); PG8_STAGE(PG8_SB(0, 1), b2 + hstep, voffB); PG8_STAGE(PG8_SA(0, 0), a2, voffA);
            PG8_WAIT_V(8); PG8_WAIT_L(0); PG8_BAR; PG8_MMA(1, 0, At, B0); PG8_MMA(1, 1, At, B1); PG8_BAR; PG8_SCHED;
            PG8_LDB(B0, 1, 0); PG8_LDB(B1, 1, 1); PG8_SCHED; PG8_LDA(At, 1, 0); PG8_STAGE(PG8_SA(0, 1), a2 + hstep, voffA);
            PG8_WAIT_V(8); PG8_WAIT_L(0); PG8_BAR; PG8_MMA(0, 0, At, B0); PG8_MMA(0, 1, At, B1); PG8_BAR; PG8_SCHED;
            PG8_LDA(At, 1, 1); PG8_STAGE(PG8_SB(1, 0), b3, voffB); PG8_STAGE(PG8_SB(1, 1), b3 + hstep, voffB); PG8_STAGE(PG8_SA(1, 0), a3, voffA);
            PG8_WAIT_V(8); PG8_WAIT_L(0); PG8_BAR; PG8_MMA(1, 0, At, B0); PG8_MMA(1, 1, At, B1); PG8_BAR; PG8_SCHED;
            } else {
            PG8_LDB(B0, 0, 0); PG8_SCHED; PG8_LDA(At, 0, 0); PG8_STAGE(PG8_SA(1, 1), a1 + hstep, voffA);
            PG8_WAIT_L(8); PG8_BAR; PG8_WAIT_L(0); PG8_MMA(0, 0, At, B0); PG8_BAR; PG8_SCHED;
            PG8_LDB(B1, 0, 1); PG8_STAGE(PG8_SB(0, 0), b2, voffB);
            PG8_BAR; PG8_WAIT_L(0); PG8_MMA(0, 1, At, B1); PG8_BAR;
            PG8_LDA(At, 0, 1); PG8_STAGE(PG8_SA(0, 0), a2, voffA);
            PG8_BAR; PG8_WAIT_L(0); PG8_MMA(1, 0, At, B0); PG8_BAR; PG8_SCHED;
            PG8_STAGE(PG8_SB(0, 1), b2 + hstep, voffB);
            PG8_WAIT_V(6); PG8_BAR; PG8_MMA(1, 1, At, B1); PG8_BAR;
            PG8_LDB(B0, 1, 0); PG8_SCHED; PG8_LDA(At, 1, 0); PG8_STAGE(PG8_SA(0, 1), a2 + hstep, voffA);
            PG8_WAIT_L(8); PG8_BAR; PG8_WAIT_L(0); PG8_MMA(0, 0, At, B0); PG8_BAR; PG8_SCHED;
            PG8_LDB(B1, 1, 1); PG8_STAGE(PG8_SB(1, 0), b3, voffB);
            PG8_BAR; PG8_WAIT_L(0); PG8_MMA(0, 1, At, B1); PG8_BAR;
            PG8_LDA(At, 1, 1); PG8_STAGE(PG8_SA(1, 0), a3, voffA);
            PG8_BAR; PG8_WAIT_L(0); PG8_MMA(1, 0, At, B0); PG8_BAR; PG8_SCHED;
            PG8_STAGE(PG8_SB(1, 1), b3 + hstep, voffB);
            PG8_WAIT_V(6); PG8_BAR; PG8_MMA(1, 1, At, B1); PG8_BAR;
            }
        }
        if constexpr (ALIGN_EPI) { if (wr == 0) PG8_BAR; }
        if constexpr (!Epi::AFTER_DRAIN) { E(acc, cur, wr, wc, fr, fq); S.done(cur); }
        if (!has_next) break;
#pragma unroll
        for (int a = 0; a < 2; ++a)
#pragma unroll
            for (int b = 0; b < 2; ++b)
#pragma unroll
                for (int m = 0; m < 4; ++m)
#pragma unroll
                    for (int n = 0; n < 2; ++n) acc[a][b][m][n] = (f32x4){0.f, 0.f, 0.f, 0.f};
        cur = nxt; cA = nA; cB = nB; ++ui;
        if constexpr (ALIGN_EPI) { if (wr == 1) PG8_BAR; }
    }
    PG8_WAIT_V(0);
    if constexpr (!ALIGN_EPI) { if (wr == 0) PG8_BAR; }
    PG8_BAR;
    if constexpr (Epi::AFTER_DRAIN) { E.fused(acc, cur, wr, wc, fr, fq, lds, wid, lane); S.done(cur); }
#undef PG8_SA
#undef PG8_SB
#undef PG8_STAGE
#undef PG8_LDA
#undef PG8_LDB
#undef PG8_MMA
#undef PG8_WAIT_V
#undef PG8_WAIT_L
#undef PG8_BAR
#undef PG8_SCHED
}
}
#define LAS __attribute__((address_space(3)))
#define XB_TMO      128
#define XB_XCNT(j)  (256  + 64 * (j))
#define XB_XSUB(j)  (1280 + 64 * (j))
#define XB_XGEN(j)  (2304 + 64 * (j))
#define XB_TOP      3328
#define XB_TOPGEN   3392
#define XCD_BAR_WORDS 3456
#define XB_SPIN_CAP (1u << 18)

__device__ __forceinline__ unsigned xb_ld(unsigned* p)              { return __hip_atomic_load(p, __ATOMIC_RELAXED, __HIP_MEMORY_SCOPE_AGENT); }
__device__ __forceinline__ unsigned xb_add(unsigned* p, unsigned v) { return __hip_atomic_fetch_add(p, v, __ATOMIC_RELAXED, __HIP_MEMORY_SCOPE_AGENT); }
__device__ __forceinline__ unsigned xb_xcc_id() { return (unsigned)__builtin_amdgcn_s_getreg((3 << 11) | 20) & 0xFu; }
#define XB_SPIN(cond, bar) do { unsigned _sp = 0; while (cond) { __builtin_amdgcn_s_sleep(1); \
    if ((++_sp & 255u) == 0u) { if (xb_ld(&(bar)[XB_TMO])) break; if (_sp > XB_SPIN_CAP) { atomicAdd(&(bar)[XB_TMO], 1u); break; } } } } while (0)

struct XcdBarrier {
    unsigned* bar; unsigned x;
    volatile LAS unsigned* st;
};

__device__ __forceinline__ XcdBarrier xcd_barrier_post(unsigned* bar, volatile LAS unsigned* st) {
    XcdBarrier b; b.bar = bar; b.x = xb_xcc_id(); b.st = st;
    if (threadIdx.x == 0) (void)xb_add(&bar[XB_XCNT(b.x)], 1u);
    return b;
}
__device__ __forceinline__ void xcd_barrier_complete(unsigned* bar, unsigned x, unsigned& nloc, unsigned& nx) {
    const unsigned G = gridDim.x * gridDim.y * gridDim.z;
    unsigned sum, cnt, mine, sp = 0u;
    for (;;) {
        sum = 0u; cnt = 0u; mine = 0u;
#pragma unroll
        for (unsigned j = 0; j < 16; ++j) { const unsigned c = xb_ld(&bar[XB_XCNT(j)]); sum += c; cnt += (c > 0u) ? 1u : 0u; mine = (j == x) ? c : mine; }
        if (sum == G) break;
        __builtin_amdgcn_s_sleep(1);
        if ((++sp & 255u) == 0u) { if (xb_ld(&bar[XB_TMO])) break; if (sp > XB_SPIN_CAP) { atomicAdd(&bar[XB_TMO], 1u); break; } }
    }
    nloc = mine > 0u ? mine : 1u; nx = cnt > 0u ? cnt : 1u;
}

__device__ __forceinline__ void xcd_barrier(const XcdBarrier& b) {
    asm volatile("s_waitcnt vmcnt(0)" ::: "memory");
    __syncthreads();
    if (threadIdx.x == 0) {
        unsigned* bar = b.bar;
        __builtin_amdgcn_s_waitcnt(0);
        unsigned nloc = b.st[0], nx = b.st[1];
        if (nloc == 0u) { xcd_barrier_complete(bar, b.x, nloc, nx); b.st[0] = nloc; b.st[1] = nx; }
        const unsigned old = xb_add(&bar[XB_XSUB(b.x)], 1u);
        const unsigned gen = old / nloc;
        if (old + 1u == (gen + 1u) * nloc) {
            __builtin_amdgcn_fence(__ATOMIC_RELEASE, "agent");
            asm volatile("s_waitcnt vmcnt(0)" ::: "memory");
            const unsigned og = xb_add(&bar[XB_TOP], 1u);
            const unsigned tg = og / nx;
            if (og + 1u == (tg + 1u) * nx) xb_add(&bar[XB_TOPGEN], 1u);
            else XB_SPIN(xb_ld(&bar[XB_TOPGEN]) == tg, bar);
            __builtin_amdgcn_fence(__ATOMIC_ACQUIRE, "agent");
            xb_add(&bar[XB_XGEN(b.x)], 1u);
            asm volatile("s_waitcnt vmcnt(0)" ::: "memory");
        } else {
            XB_SPIN(xb_ld(&bar[XB_XGEN(b.x)]) == gen, bar);
            __builtin_amdgcn_fence(__ATOMIC_ACQUIRE, "agent");
            asm volatile("s_waitcnt vmcnt(0)" ::: "memory");
        }
    }
    __syncthreads();
}

constexpr int NWAVES = 8, NTHREADS = 512;
constexpr int DM = 2048, NTP = 8192, NTS = 32, NT = 8224, MP = 8448;
constexpr int RW_COLS = 3360, Q_OFF = 3360, KC_OFF = 4384, KS_OFF = 4896, VS_OFF = 5152, KW_OFF = 5408, VW_OFF = 5664, GL_OFF = 5920, IN_COLS = 5968, PLD = 6144;
constexpr int NEXP = 16384, NPOOL = 1280;
constexpr float LN_EPS = 1e-5f, GN_EPS = 64e-5f, DN_ALPHA = 1.4142135623730951f;
constexpr float NEG_BIG = -1e30f;
constexpr size_t O_YP = 0, O_YS = O_YP + (size_t)NTP * DM, O_CMP_P = O_YS + (size_t)NTS * DM, O_SEL_P = O_CMP_P + (size_t)2 * NTP * 512, O_WIN_P = O_SEL_P + (size_t)2 * NTP * 512,
                 O_RW_P = O_WIN_P + (size_t)2 * 4 * 512 * 512, O_SH_P = O_RW_P + (size_t)2 * 4 * 16 * 4096, O_CMP_S = O_SH_P + (size_t)2 * 4 * RW_COLS, O_SEL_S = O_CMP_S + (size_t)2 * NTS * 512,
                 O_WIN_S = O_SEL_S + (size_t)2 * NTS * 512, O_RW_S = O_WIN_S + (size_t)2 * 8 * 512 * 512, O_SH_S = O_RW_S + (size_t)2 * 8 * 16 * 4096, O_END = O_SH_S + (size_t)2 * 8 * RW_COLS;
static_assert(O_END == 41630464, "output size");
constexpr size_t MiB = 1ull << 20;
constexpr size_t WS_CTL = 0, CTL_ZERO_BYTES = 1 * MiB;
constexpr size_t WS_WIN = 1 * MiB;
constexpr size_t WS_WOUT = WS_WIN + 48 * MiB;
constexpr size_t WS_W2 = WS_WOUT + 16 * MiB;
constexpr size_t WS_UB = WS_W2 + 16 * MiB;
constexpr size_t WS_VB = WS_UB + 64 * MiB;
constexpr size_t WS_USC = WS_VB + 64 * MiB;
constexpr size_t WS_XB = WS_USC + 1 * MiB;
constexpr size_t WS_X1B = WS_XB + 33 * MiB;
constexpr size_t WS_XF1 = WS_X1B + 33 * MiB;
constexpr size_t WS_X1F = WS_XF1 + 65 * MiB;
constexpr size_t WS_PROJ = WS_X1F + 65 * MiB;
constexpr size_t WS_SC = WS_PROJ + 99 * MiB;
constexpr size_t SC_STRIDE = 33 * MiB;
constexpr size_t WS_GG = WS_SC + 6 * SC_STRIDE;
constexpr size_t WS_BON = WS_GG + 33 * MiB;
constexpr size_t WS_MIX = WS_BON + 1 * MiB;
constexpr size_t WS_HS = WS_MIX + 33 * MiB;
constexpr size_t WS_KCB = WS_HS + 66 * MiB;
constexpr size_t WS_VCBT = WS_KCB + 512 * 1024;
constexpr size_t WS_VTS = WS_KCB + 1 * MiB;
constexpr size_t WS_VTW = WS_VTS + 4 * MiB;
constexpr size_t WS_KCBS = WS_VTW + 4 * MiB;
constexpr size_t WS_VCBS = WS_KCBS + 17 * MiB;
constexpr size_t WS_LT = WS_VCBS + 17 * MiB;
constexpr size_t WS_KSC = WS_LT + 2 * MiB;
constexpr size_t WS_KWC = WS_KSC + 4 * MiB;
constexpr size_t WS_OPS = WS_KWC + 4 * MiB;
constexpr size_t OPS_BYTES = 51200;
constexpr size_t WS_EL = WS_OPS + 80 * MiB;
constexpr size_t WS_GT = WS_EL + 3 * MiB;
constexpr size_t WS_PD = WS_GT + 5 * MiB;
constexpr size_t WS_WP = WS_PD + 65 * MiB;
constexpr size_t WS_FO = WS_WP + 5 * MiB;
constexpr size_t WS_X1Q = WS_FO + 65 * MiB;
constexpr size_t WS_XQS = WS_X1Q + 17 * MiB;
constexpr size_t WS_END = WS_XQS + 1 * MiB;
constexpr int CW_BAR = 4096, CW_QUEUE = 8192, CW_SQ = 65536, CW_FLAG = 16384;
constexpr int RING_BYTES = 131072, MISC_OFF = RING_BYTES + 320, LDS_BYTES = 147456;
constexpr int N_PHASES = 23;

typedef unsigned short bf16;
typedef unsigned v4u __attribute__((ext_vector_type(4)));
typedef unsigned v2u __attribute__((ext_vector_type(2)));
typedef float f32x4 __attribute__((ext_vector_type(4)));
typedef float f32x16 __attribute__((ext_vector_type(16)));
typedef short bf16x8 __attribute__((ext_vector_type(8)));
typedef float f32x2_t __attribute__((ext_vector_type(2)));
typedef __bf16 bf16x2_t __attribute__((ext_vector_type(2)));
#define LDS_WAIT() asm volatile("s_waitcnt lgkmcnt(0)" ::: "memory")
#define DI __device__ __forceinline__
#define GAS __attribute__((address_space(1)))
template <class T> DI T* launder_g(T* p) { GAS T* g = (GAS T*)p; asm volatile("" : "+s"(g)); return (T*)g; }

DI unsigned pk2(float lo, float hi) { f32x2_t v = {lo, hi}; bf16x2_t b = __builtin_convertvector(v, bf16x2_t); return __builtin_bit_cast(unsigned, b); }
DI float bf2f(unsigned short u) { return __builtin_bit_cast(float, (unsigned)u << 16); }
DI float bflo(unsigned u) { return __builtin_bit_cast(float, u << 16); }
DI float bfhi(unsigned u) { return __builtin_bit_cast(float, u & 0xffff0000u); }
template <int CTRL> DI float dppf(float v) { return __builtin_bit_cast(float, __builtin_amdgcn_update_dpp(0, __builtin_bit_cast(int, v), CTRL, 0xF, 0xF, false)); }
DI float rdlane(float v, int l) { return __builtin_bit_cast(float, __builtin_amdgcn_readlane(__builtin_bit_cast(int, v), l)); }
DI float wave_sum(float v) {
    v += dppf<0xB1>(v); v += dppf<0x4E>(v); v += dppf<0x141>(v); v += dppf<0x140>(v);
    return (rdlane(v, 0) + rdlane(v, 16)) + (rdlane(v, 32) + rdlane(v, 48));
}
DI float wave_max(float v) {
    v = fmaxf(v, dppf<0xB1>(v)); v = fmaxf(v, dppf<0x4E>(v)); v = fmaxf(v, dppf<0x141>(v)); v = fmaxf(v, dppf<0x140>(v));
    return fmaxf(fmaxf(rdlane(v, 0), rdlane(v, 16)), fmaxf(rdlane(v, 32), rdlane(v, 48)));
}
DI float sigmoidf_(float x) { return 1.f / (1.f + expf(-x)); }
DI int crow(int reg, int h) { return (reg & 3) + 8 * (reg >> 2) + 4 * h; }

struct ArgsK { const float* in[30]; float* out; unsigned char* ws; int ph_lo, ph_hi, use_bar, pad; };
struct ArgsG { const GAS float* in[30]; GAS float* out; GAS unsigned char* ws; int ph_lo, ph_hi, use_bar, pad; };
typedef __attribute__((address_space(4))) const ArgsG* kargp_t;
struct Ctx {
    float* out; unsigned char* ws;
    LAS unsigned char* lds; unsigned* ctl;
    int tid, lane, wave, G;
    DI const float* inp(int k) const { kargp_t p = (kargp_t)__builtin_amdgcn_kernarg_segment_ptr(); asm volatile("" : "+s"(p)); return (const float*)p->in[k]; }
};
template <class T> DI T* wsp(const Ctx& C, size_t off) { return (T*)(C.ws + off); }

struct EpiInProj {
    static constexpr bool PERM = true, AFTER_DRAIN = false;
    bf16* P; float* out; int l;
    DI void operator()(const pg8::f32x4 (&acc)[2][2][4][2], const pg8::Unit& u, int wr, int wc, int fr, int fq) const {
        const int row0 = u.pm * 256 + wr * 64 + fr, col0 = u.pn * 256 + wc * 32 + 8 * fq;
#pragma unroll
        for (int bj = 0; bj < 2; ++bj) {
            const int colb = __builtin_amdgcn_readfirstlane(u.pn * 256 + wc * 32 + bj * 128);
            const int col = col0 + bj * 128;
            const int kind = colb < RW_COLS ? 1 : ((colb >= KC_OFF && colb < GL_OFF) ? 2 : 0);
            const int reg = (colb - KC_OFF) >> 9, cc = (col - KC_OFF) & 511;
#pragma unroll
            for (int ai = 0; ai < 2; ++ai)
#pragma unroll
                for (int m = 0; m < 4; ++m) {
                    const int row = row0 + ai * 128 + m * 16;
                    const pg8::f32x4 v0 = acc[ai][bj][m][0], v1 = acc[ai][bj][m][1];
                    v4u w; w.x = pk2(v0[0], v0[1]); w.y = pk2(v0[2], v0[3]); w.z = pk2(v1[0], v1[1]); w.w = pk2(v1[2], v1[3]);
                    *(v4u*)(P + (size_t)row * PLD + col) = w;
                    if (kind == 0 || row >= NT) continue;
                    unsigned off = 0xffffffffu;
                    if (row < NTP) { const int b = row >> 11, t = row & 2047;
                        if (kind == 1) { if (t == 2047) off = (unsigned)(O_SH_P + (size_t)(l * 4 + b) * RW_COLS + col); }
                        else if (reg == 0) off = (unsigned)(O_CMP_P + ((size_t)l * NTP + row) * 512 + cc);
                        else if (reg == 1) off = (unsigned)(O_SEL_P + ((size_t)l * NTP + row) * 512 + cc);
                        else if (t >= 1536) off = (unsigned)(O_WIN_P + ((size_t)(l * 4 + b) * 512 + (t - 1536)) * 512 + cc);
                    } else { const int j = row - NTP, b = j >> 2, t = j & 3;
                        if (kind == 1) { if (t == 3) off = (unsigned)(O_SH_S + (size_t)(l * 8 + b) * RW_COLS + col); }
                        else if (reg == 0) off = (unsigned)(O_CMP_S + ((size_t)l * NTS + j) * 512 + cc);
                        else if (reg == 1) off = (unsigned)(O_SEL_S + ((size_t)l * NTS + j) * 512 + cc);
                        else off = (unsigned)(O_WIN_S + ((size_t)(l * 8 + b) * 512 + 508 + t) * 512 + cc);
                    }
                    if (off != 0xffffffffu) { *(pg8::f32x4*)(out + off) = v0; *(pg8::f32x4*)(out + off + 4) = v1; }
                }
        }
    }
};

struct EpiBf16Row {
    static constexpr bool PERM = true, AFTER_DRAIN = false;
    bf16* Cb; int ldc;
    DI void operator()(const pg8::f32x4 (&acc)[2][2][4][2], const pg8::Unit& u, int wr, int wc, int fr, int fq) const {
        const int row0 = u.pm * 256 + wr * 64 + fr, col0 = u.pn * 256 + wc * 32 + 8 * fq;
#pragma unroll
        for (int bj = 0; bj < 2; ++bj)
#pragma unroll
            for (int ai = 0; ai < 2; ++ai)
#pragma unroll
                for (int m = 0; m < 4; ++m) { const pg8::f32x4 v0 = acc[ai][bj][m][0], v1 = acc[ai][bj][m][1];
                    v4u w; w.x = pk2(v0[0], v0[1]); w.y = pk2(v0[2], v0[3]); w.z = pk2(v1[0], v1[1]); w.w = pk2(v1[2], v1[3]);
                    *(v4u*)(Cb + (size_t)(row0 + ai * 128 + m * 16) * ldc + col0 + bj * 128) = w; }
    }
};

template <class Sink> DI void skinny_gemm(const Ctx& C, const bf16* A, const bf16* Bt, int nslabs, const Sink& sink) {
    const int tid = C.tid, lane = C.lane, wave = C.wave, r = lane & 31, hi = lane >> 5;
    LAS float* PS = (LAS float*)C.lds;
    for (int it = blockIdx.x; it < nslabs; it += C.G) {
        const int n0 = it * 32, k0 = wave * 256;
        f32x16 acc;
#pragma unroll
        for (int i = 0; i < 16; ++i) acc[i] = 0.f;
        const bf16* ap = A + (size_t)r * DM + k0 + 8 * hi; const bf16* bp = Bt + (size_t)(n0 + r) * DM + k0 + 8 * hi;
#pragma unroll 8
        for (int s = 0; s < 16; ++s) { const bf16x8 af = *(const bf16x8*)(ap + 16 * s), bf = *(const bf16x8*)(bp + 16 * s); acc = __builtin_amdgcn_mfma_f32_32x32x16_bf16(af, bf, acc, 0, 0, 0); }
        __syncthreads();
#pragma unroll
        for (int i = 0; i < 16; ++i) PS[(wave * 32 + crow(i, hi)) * 33 + r] = acc[i];
        __syncthreads();
#pragma unroll
        for (int e = 0; e < 2; ++e) { const int o = tid * 2 + e, row = o >> 5, col = o & 31; float v = 0.f;
#pragma unroll
            for (int w = 0; w < 8; ++w) v += PS[(w * 32 + row) * 33 + col];
            sink(row, n0 + col, v); }
    }
    __syncthreads();
}

DI void transpose_item(const float* W, int K, int N, int Npad, bf16* WT, LAS float* scr, int item, int lane) {
    const int nblk = Npad / 32, kb = item / nblk, nb = item % nblk, k0 = 64 * kb, n0 = 32 * nb;
    float tv[32];
#pragma unroll
    for (int i = 0; i < 32; ++i) { const int kk = 2 * i + (lane >> 5), n = n0 + (lane & 31); tv[i] = n < N ? W[(size_t)(k0 + kk) * N + n] : 0.f; }
#pragma unroll
    for (int i = 0; i < 32; ++i) { const int kk = 2 * i + (lane >> 5); scr[kk * 33 + (lane & 31)] = tv[i]; }
    LDS_WAIT(); asm volatile("" ::: "memory");
    const int c = lane & 7;
#pragma unroll
    for (int j = 0; j < 4; ++j) { const int n = (lane >> 3) + 8 * j; const LAS float* s = scr + (8 * c) * 33 + n;
        v4u o; o.x = pk2(s[0 * 33], s[1 * 33]); o.y = pk2(s[2 * 33], s[3 * 33]); o.z = pk2(s[4 * 33], s[5 * 33]); o.w = pk2(s[6 * 33], s[7 * 33]);
        *(v4u*)(WT + (size_t)(n0 + n) * K + k0 + 8 * c) = o; }
    LDS_WAIT(); asm volatile("" ::: "memory");
}


DI void p0i_table(const Ctx& C, int r) {
    const int lane = C.lane, wave = C.wave;
    f32x4 v[2][8];
#pragma unroll
    for (int h = 0; h < 2; ++h) { const int row = r * 16 + 8 * h + wave;
        const float* src = (row < 32768 ? C.inp(26) : C.inp(27)) + (size_t)(row & 32767) * DM;
#pragma unroll
        for (int k = 0; k < 2; ++k)
#pragma unroll
            for (int q = 0; q < 4; ++q) v[h][4 * k + q] = ((const f32x4*)src)[4 * lane + 256 * k + q]; }
#pragma unroll
    for (int h = 0; h < 2; ++h) { const int row = r * 16 + 8 * h + wave;
        unsigned char* dst = C.ws + (row < 32768 ? WS_UB : WS_VB) + (size_t)((row >> 14) & 1) * NEXP * DM + (size_t)(row & 16383) * 128;
        float am = 0.f;
#pragma unroll
        for (int j = 0; j < 8; ++j) am = fmaxf(am, fmaxf(fmaxf(fabsf(v[h][j][0]), fabsf(v[h][j][1])), fmaxf(fabsf(v[h][j][2]), fabsf(v[h][j][3]))));
        am = wave_max(am);
        const bool isu = row < 32768;
        const float sc = am > 0.f ? am * (isu ? 1.f / 127.f : 1.f / 256.f) : 1.f, inv = 1.f / sc;
#pragma unroll
        for (int k = 0; k < 2; ++k) { v4u o;
#pragma unroll
            for (int q = 0; q < 4; ++q) { const f32x4 x = v[h][4 * k + q] * inv;
                if (isu) o[q] = ((unsigned)(int)__builtin_rintf(x[0]) & 255u) | (((unsigned)(int)__builtin_rintf(x[1]) & 255u) << 8) | (((unsigned)(int)__builtin_rintf(x[2]) & 255u) << 16) | ((unsigned)(int)__builtin_rintf(x[3]) << 24);
                else { int p = __builtin_amdgcn_cvt_pk_fp8_f32(x[0], x[1], 0, false); p = __builtin_amdgcn_cvt_pk_fp8_f32(x[2], x[3], p, true); o[q] = (unsigned)p; } }
            *(v4u*)(dst + ((size_t)((lane >> 3) + 8 * k) * NEXP) * 128 + 16 * (lane & 7)) = o; }
        if (lane == 0) wsp<float>(C, WS_USC)[row] = sc; }
}
DI void p0i_cache(const Ctx& C, int r) {
    const int tid = C.tid;
    const int l = r >> 10, b = (r >> 7) & 7, pi = r & 127;
    const int pid = ((const int*)C.inp(4))[b * 128 + pi];
    const int q = tid >> 7, c4 = tid & 127, kv = c4 >> 6, kvh = (c4 >> 4) & 3, d0 = (c4 & 15) * 4;
    const f32x4* src = (const f32x4*)(C.inp(2) + ((size_t)(l * NPOOL + pid) * 128 + 32 * q) * 512) + c4;
    const float* w = C.inp(20) + (l * 2 + kv) * 32;
    f32x4 acc = {0.f, 0.f, 0.f, 0.f};
    f32x4 cr[32];
#pragma unroll
    for (int rr = 0; rr < 32; ++rr) cr[rr] = src[(size_t)rr * 128];
#pragma unroll
    for (int rr = 0; rr < 32; ++rr) acc += cr[rr] * w[rr];
    *(f32x4*)(wsp<float>(C, kv ? WS_VCBS : WS_KCBS) + ((size_t)((l * 8 + b) * 4 + kvh) * 512 + 4 * pi + q) * 64 + d0) = acc;
}
DI void p0i_transpose(const Ctx& C, int r) {
    const int lane = C.lane, wave = C.wave;
    const int l = r >> 10, w8 = (r & 1023) * 8 + wave;
    LAS float* scr = (LAS float*)(C.lds + wave * 16384);
    if (w8 < 6144) transpose_item(C.inp(8) + (size_t)l * DM * IN_COLS, DM, IN_COLS, PLD, wsp<bf16>(C, WS_WIN) + (size_t)l * PLD * DM, scr, w8, lane);
    else transpose_item(C.inp(21) + (size_t)l * DM * DM, DM, DM, DM, wsp<bf16>(C, WS_WOUT) + (size_t)l * DM * DM, scr, w8 - 6144, lane);
}
DI bf16x8 bf8_of(const f32x4& a, const f32x4& b) { const v4u p = {pk2(a[0], a[1]), pk2(a[2], a[3]), pk2(b[0], b[1]), pk2(b[2], b[3])}; return __builtin_bit_cast(bf16x8, p); }
DI f32x4 bf_resid(const f32x4& a, unsigned p01, unsigned p23) { return (f32x4){a[0] - bflo(p01), a[1] - bfhi(p01), a[2] - bflo(p23), a[3] - bfhi(p23)}; }
DI void p0i_w2(const Ctx& C, int r) {
    const int lane = C.lane, wave = C.wave, rr = lane & 31, hi = lane >> 5;
    const int l = r >> 9, hc = (r >> 5) & 15, kb = r & 31, kt = wave & 3, nt = wave >> 2;
    const float* sk = C.inp(25) + ((size_t)l * 16 + hc) * 16384 + (size_t)(kt * 32 + rr) * 128 + 8 * hi;
    const float* wq = C.inp(24) + (size_t)l * DM * DM + (size_t)(kb * 64 + nt * 32 + rr) * DM + hc * 128 + 8 * hi;
    f32x16 acc;
#pragma unroll
    for (int i = 0; i < 16; ++i) acc[i] = 0.f;
#pragma unroll 4
    for (int s = 0; s < 8; ++s) {
        const f32x4 a0 = *(const f32x4*)(sk + 16 * s), a1 = *(const f32x4*)(sk + 16 * s + 4), b0 = *(const f32x4*)(wq + 16 * s), b1 = *(const f32x4*)(wq + 16 * s + 4);
        const v4u ahp = {pk2(a0[0], a0[1]), pk2(a0[2], a0[3]), pk2(a1[0], a1[1]), pk2(a1[2], a1[3])}, bhp = {pk2(b0[0], b0[1]), pk2(b0[2], b0[3]), pk2(b1[0], b1[1]), pk2(b1[2], b1[3])};
        const bf16x8 ah = __builtin_bit_cast(bf16x8, ahp), bh = __builtin_bit_cast(bf16x8, bhp);
        const bf16x8 al = bf8_of(bf_resid(a0, ahp.x, ahp.y), bf_resid(a1, ahp.z, ahp.w)), bl = bf8_of(bf_resid(b0, bhp.x, bhp.y), bf_resid(b1, bhp.z, bhp.w));
        acc = __builtin_amdgcn_mfma_f32_32x32x16_bf16(ah, bh, acc, 0, 0, 0);
        acc = __builtin_amdgcn_mfma_f32_32x32x16_bf16(ah, bl, acc, 0, 0, 0);
        acc = __builtin_amdgcn_mfma_f32_32x32x16_bf16(al, bh, acc, 0, 0, 0);
    }
    bf16* W2 = wsp<bf16>(C, WS_W2) + (size_t)l * DM * DM + (size_t)(hc * 128 + kt * 32) * DM + kb * 64 + nt * 32 + rr;
#pragma unroll
    for (int i = 0; i < 16; ++i) W2[(size_t)crow(i, hi) * DM] = (unsigned short)(pk2(acc[i], 0.f) & 0xffffu);
}
constexpr int DEF_ITEMS = 4096 + 1024 + 1024 + 1024, DEF_GROUPS = DEF_ITEMS / 4;
DI void deferred_item(const Ctx& C, int i) {
    if (i < 4096) p0i_table(C, i);
    else if (i < 5120) p0i_cache(C, 1024 + (i - 4096));
    else if (i < 6144) p0i_transpose(C, 1024 + (i - 5120));
    else p0i_w2(C, i - 6144);
}

constexpr int P0_NX = 2056, P0_NWP = 508;
DI void p0_prologue(const Ctx& C, int pmask = 31) {
    const int tid = C.tid;
    LAS int* qslot = (LAS int*)(C.lds + MISC_OFF + 64);
#define P0_CLAIM 4
#define P0_BLOCK(n, qi) for (int base_ = 0; ; ) { __syncthreads(); if (tid == 0) *qslot = (int)atomicAdd(C.ctl + CW_QUEUE + 64 * (8 + (qi)), (unsigned)P0_CLAIM); __syncthreads(); base_ = *qslot; if (base_ >= (n)) break; \
        for (int r = base_, r_hi = (base_ + P0_CLAIM < (n) ? base_ + P0_CLAIM : (n)); r < r_hi; ++r)
#define P0_END }
    if (pmask & 4) P0_BLOCK(1024, 2) { p0i_transpose(C, r); } P0_END
    static_assert(P0_NX % P0_CLAIM == 0 && P0_NWP % P0_CLAIM == 0, "whole claims");
#define P0_CLAIMED(n, qi) for (int base_ = 0; ; ) { __syncthreads(); if (tid == 0) *qslot = (int)atomicAdd(C.ctl + CW_QUEUE + 64 * (8 + (qi)), (unsigned)P0_CLAIM); __syncthreads(); base_ = *qslot; if (base_ >= (n)) break;
    if (pmask & 16) P0_CLAIMED(P0_NX, 4) {
            f32x4 q_[P0_CLAIM][4];
#pragma unroll
            for (int u = 0; u < P0_CLAIM; ++u) { const size_t e0 = (size_t)(base_ + u) * 8192 + tid * 16;
                const f32x4* s4 = (const f32x4*)(e0 < (size_t)NTP * DM ? C.inp(0) + e0 : C.inp(1) + (e0 - (size_t)NTP * DM));
                q_[u][0] = s4[0]; q_[u][1] = s4[1]; q_[u][2] = s4[2]; q_[u][3] = s4[3]; }
#pragma unroll
            for (int u = 0; u < P0_CLAIM; ++u) { const size_t e0 = (size_t)(base_ + u) * 8192 + tid * 16; const f32x4 a = q_[u][0], b = q_[u][1], c = q_[u][2], d = q_[u][3];
                v4u o0, o1; o0.x = pk2(a[0], a[1]); o0.y = pk2(a[2], a[3]); o0.z = pk2(b[0], b[1]); o0.w = pk2(b[2], b[3]);
                o1.x = pk2(c[0], c[1]); o1.y = pk2(c[2], c[3]); o1.z = pk2(d[0], d[1]); o1.w = pk2(d[2], d[3]);
                v4u* d4 = (v4u*)(wsp<bf16>(C, WS_XB) + e0); d4[0] = o0; d4[1] = o1; }
        } P0_END
    if (pmask & 2) P0_BLOCK(1024, 1) { p0i_cache(C, r); } P0_END
    if (pmask & 4) P0_BLOCK(144, 6) {{
            const int g = r * 512 + tid, l = g / 36864, rem = g % 36864, c = rem / 36, kg = rem % 36;
            const float* src = kg < 8 ? C.inp(11) + ((size_t)l * 64 + kg * 8) * 1024 : (kg < 16 ? C.inp(13) + ((size_t)l * 64 + (kg - 8) * 8) * 1024 : C.inp(14) + ((size_t)l * 160 + (kg - 16) * 8) * 1024);
            float e[8];
#pragma unroll
            for (int q = 0; q < 8; ++q) e[q] = src[(size_t)q * 1024 + c];
            *(v4u*)(wsp<bf16>(C, WS_LT) + ((size_t)l * 1024 + c) * 288 + kg * 8) = (v4u){pk2(e[0], e[1]), pk2(e[2], e[3]), pk2(e[4], e[5]), pk2(e[6], e[7])};
        }} P0_END
    if (pmask & 16) P0_CLAIMED(P0_NWP, 5) {
            f32x4 q_[P0_CLAIM][4];
#pragma unroll
            for (int u = 0; u < P0_CLAIM; ++u) { const size_t i0 = (size_t)(base_ + u) * 8192 + tid * 16; const size_t lb = i0 / 260096, rem = i0 % 260096;
                const f32x4* s4 = (const f32x4*)(C.inp(5) + lb * 262144 + 2048 + rem); q_[u][0] = s4[0]; q_[u][1] = s4[1]; q_[u][2] = s4[2]; q_[u][3] = s4[3]; }
#pragma unroll
            for (int u = 0; u < P0_CLAIM; ++u) { const size_t i0 = (size_t)(base_ + u) * 8192 + tid * 16; const size_t lb = i0 / 260096, rem = i0 % 260096;
                f32x4* d4 = (f32x4*)(C.out + O_WIN_S + lb * 262144 + rem); d4[0] = q_[u][0]; d4[1] = q_[u][1]; d4[2] = q_[u][2]; d4[3] = q_[u][3]; }
        } P0_END
    __syncthreads();
}

constexpr int PB_NRW = 514, PB_NPOOL = 256, PB_NVT = 1024, PB_ITEMS = PB_NRW + PB_NPOOL + PB_NVT;
DI float softplusf_(float x) { return x > 20.f ? x : log1pf(expf(x)); }
DI float fexp_(float x) { return __expf(x); }
DI float fsoftplus_(float x) { return x > 20.f ? x : __logf(1.f + __expf(x)); }
DI float fsigmoid_(float x) { return __builtin_amdgcn_rcpf(1.f + __expf(-x)); }

constexpr int XSB_LD = 3088, ACTB_LD = 296, MU_OFF = 110592;
DI void rwkv_pre_item(const Ctx& C, int l, int item) {
    const int tid = C.tid, lane = C.lane, wave = C.wave, n16 = lane & 15, rq = lane >> 4;
    LAS unsigned short* XSB = (LAS unsigned short*)C.lds;
    LAS unsigned short* ACTB = (LAS unsigned short*)(C.lds + 16 * XSB_LD * 2);
    const bf16* P = wsp<bf16>(C, WS_PROJ);
    const int m0 = item * 16;
    __syncthreads();
#pragma unroll 1
    for (int base = 0; base < 16 * 420; base += 4 * NTHREADS) {
        v4u cu[4], pu[4]; f32x4 mu0[4], mu1[4], sh0[4], sh1[4]; int jj_[4], col_[4], kind[4];
#pragma unroll
        for (int u = 0; u < 4; ++u) { const int idx = base + u * NTHREADS + tid; kind[u] = -1; jj_[u] = 0; col_[u] = 0;
            if (idx < 16 * 420) { const int j = idx / 420, col = (idx % 420) * 8, m = m0 + j; jj_[u] = j; col_[u] = col;
                cu[u] = *(const v4u*)(P + (size_t)m * PLD + col);
                const LAS f32x4* mup = (const LAS f32x4*)(C.lds + MU_OFF) + (col >> 2); mu0[u] = mup[0]; mu1[u] = mup[1];
                int t; const float* sh = nullptr;
                if (m < NTP) t = m & 2047; else { const int jq = m - NTP; t = jq & 3; sh = C.inp(7) + (size_t)(l * 8 + (jq >> 2)) * RW_COLS + col; }
                if (t > 0) { pu[u] = *(const v4u*)(P + (size_t)(m - 1) * PLD + col); kind[u] = 1; }
                else if (sh) { sh0[u] = ((const f32x4*)sh)[0]; sh1[u] = ((const f32x4*)sh)[1]; kind[u] = 2; }
                else kind[u] = 0; } }
#pragma unroll
        for (int u = 0; u < 4; ++u) if (kind[u] >= 0) {
            const int j = jj_[u], col = col_[u];
            float cur[8] = {bflo(cu[u].x), bfhi(cu[u].x), bflo(cu[u].y), bfhi(cu[u].y), bflo(cu[u].z), bfhi(cu[u].z), bflo(cu[u].w), bfhi(cu[u].w)};
            float prev[8];
            if (kind[u] == 1) { prev[0] = bflo(pu[u].x); prev[1] = bfhi(pu[u].x); prev[2] = bflo(pu[u].y); prev[3] = bfhi(pu[u].y); prev[4] = bflo(pu[u].z); prev[5] = bfhi(pu[u].z); prev[6] = bflo(pu[u].w); prev[7] = bfhi(pu[u].w); }
            else if (kind[u] == 2) {
#pragma unroll
                for (int e = 0; e < 4; ++e) { prev[e] = sh0[u][e]; prev[4 + e] = sh1[u][e]; } }
            else {
#pragma unroll
                for (int e = 0; e < 8; ++e) prev[e] = 0.f; }
            float xs[8];
#pragma unroll
            for (int e = 0; e < 4; ++e) { xs[e] = cur[e] + mu0[u][e] * (prev[e] - cur[e]); xs[4 + e] = cur[4 + e] + mu1[u][e] * (prev[4 + e] - cur[4 + e]); }
            if (col >= 3072) { const int a0 = col - 3072;
#pragma unroll
                for (int e = 0; e < 8; ++e) xs[e] = a0 < 64 ? tanhf(xs[e]) : (a0 < 128 ? xs[e] : fsigmoid_(xs[e]));
                *(LAS v4u*)(ACTB + j * ACTB_LD + a0) = (v4u){pk2(xs[0], xs[1]), pk2(xs[2], xs[3]), pk2(xs[4], xs[5]), pk2(xs[6], xs[7])};
            } else *(LAS v4u*)(XSB + j * XSB_LD + col) = (v4u){pk2(xs[0], xs[1]), pk2(xs[2], xs[3]), pk2(xs[4], xs[5]), pk2(xs[6], xs[7])};
        }
    }
    __syncthreads();
    float* SC = wsp<float>(C, WS_SC); constexpr size_t SS = SC_STRIDE / 4;
    float* GG = wsp<float>(C, WS_GG); float* BON = wsp<float>(C, WS_BON);
    const bf16* LT = wsp<bf16>(C, WS_LT) + (size_t)l * 1024 * 288;
    const f32x4 zf = {0.f, 0.f, 0.f, 0.f};
#pragma unroll 1
    for (int hh = 0; hh < 2; ++hh) {
        const int head = 2 * wave + hh;
        f32x4 aw[4], aa[4], ag[4];
#pragma unroll
        for (int t4 = 0; t4 < 4; ++t4) { aw[t4] = zf; aa[t4] = zf; ag[t4] = zf; }
#define LORA_STEPS(ACC, KS0, NKS) _Pragma("unroll") for (int ks = (KS0); ks < (KS0) + (NKS); ++ks) { \
            const bf16x8 af = *(const LAS bf16x8*)(ACTB + n16 * ACTB_LD + 32 * ks + 8 * rq); \
            _Pragma("unroll") for (int t4 = 0; t4 < 4; ++t4) { const bf16x8 bfr = *(const bf16x8*)(LT + (size_t)(head * 64 + 16 * t4 + n16) * 288 + 32 * ks + 8 * rq); \
                ACC[t4] = __builtin_amdgcn_mfma_f32_16x16x32_bf16(af, bfr, ACC[t4], 0, 0, 0); } }
        LORA_STEPS(aw, 0, 2) LORA_STEPS(aa, 2, 2) LORA_STEPS(ag, 4, 5)
#undef LORA_STEPS
        float w0v[4], a0v[4], kkv[4], kav[4], rkv[4];
#pragma unroll
        for (int t4 = 0; t4 < 4; ++t4) { const int c = l * 1024 + head * 64 + 16 * t4 + n16; w0v[t4] = C.inp(10)[c]; a0v[t4] = C.inp(12)[c]; kkv[t4] = C.inp(15)[c]; kav[t4] = C.inp(16)[c]; rkv[t4] = C.inp(17)[c]; }
#pragma unroll
        for (int i = 0; i < 4; ++i) {
            const int j = 4 * rq + i; const size_t m = (size_t)m0 + j;
            float kkr[4], km[4], a_[4], rr[4], vv[4], lw_[4]; float ss = 0.f, bs = 0.f;
#pragma unroll
            for (int t4 = 0; t4 < 4; ++t4) { const int cl = head * 64 + 16 * t4 + n16;
                const float z = w0v[t4] + aw[t4][i];
                const float w = -fsoftplus_(-z) - 0.5f;
                lw_[t4] = -fexp_(w);
                a_[t4] = fsigmoid_(a0v[t4] + aa[t4][i]);
                rr[t4] = bf2f(XSB[j * XSB_LD + cl]); const float k = bf2f(XSB[j * XSB_LD + 1024 + cl]); vv[t4] = bf2f(XSB[j * XSB_LD + 2048 + cl]);
                kkr[t4] = k * kkv[t4]; ss += kkr[t4] * kkr[t4];
                km[t4] = k * (1.f + (a_[t4] - 1.f) * kav[t4]); bs += rr[t4] * km[t4] * rkv[t4]; }
            ss += dppf<0xB1>(ss); ss += dppf<0x4E>(ss); ss += dppf<0x141>(ss); ss += dppf<0x140>(ss);
            bs += dppf<0xB1>(bs); bs += dppf<0x4E>(bs); bs += dppf<0x141>(bs); bs += dppf<0x140>(bs);
            const float rn = __builtin_amdgcn_rsqf(fmaxf(ss, 1e-24f));
#pragma unroll
            for (int t4 = 0; t4 < 4; ++t4) { const int c = head * 64 + 16 * t4 + n16; const float kk = kkr[t4] * rn;
                ((bf16*)(SC + 0 * SS))[m * 1024 + c] = (unsigned short)(pk2(kk, 0.f) & 0xffffu); SC[1 * SS + m * 1024 + c] = fexp_(lw_[t4]); SC[3 * SS + m * 1024 + c] = lw_[t4];
                ((unsigned*)(SC + 2 * SS))[m * 1024 + head * 64 + n16 * 4 + t4] = pk2(-kk * a_[t4], km[t4]);
                ((bf16*)(SC + 4 * SS))[m * 1024 + c] = (unsigned short)(pk2(rr[t4], 0.f) & 0xffffu); SC[5 * SS + m * 1024 + c] = vv[t4];
                GG[m * 1024 + c] = ag[t4][i]; }
            if (n16 == 0) BON[m * 16 + head] = bs;
        }
    }
}

DI void phase_b(const Ctx& C, int l, int lq) {
    const int tid = C.tid;
    const bf16* P = wsp<bf16>(C, WS_PROJ);
    LAS int* qslot = (LAS int*)(C.lds + MISC_OFF + 64);
    __syncthreads();
    for (int i = tid; i < RW_COLS / 4; i += NTHREADS) ((LAS f32x4*)(C.lds + MU_OFF))[i] = ((const f32x4*)(C.inp(9) + (size_t)l * RW_COLS))[i];
    for (;;) {
        __syncthreads();
        if (tid == 0) *qslot = (int)atomicAdd(C.ctl + CW_QUEUE + 64 * (16 + lq), 1u);
        __syncthreads();
        const int it = *qslot;
        if (it >= PB_ITEMS) break;
        int r = it;
        if (r < PB_NRW) { rwkv_pre_item(C, l, r); continue; }
        r -= PB_NRW;
        if (r < PB_NPOOL) {
            const int b = r >> 6, n = r & 63, kv = tid >> 8, kvh = (tid >> 6) & 3, d = tid & 63;
            const float* src = C.out + O_CMP_P + ((size_t)l * NTP + b * 2048 + 32 * n) * 512 + tid;
            const float* w = C.inp(20) + (l * 2 + kv) * 32;
            float acc = 0.f, pr_[32];
#pragma unroll
            for (int rr = 0; rr < 32; ++rr) pr_[rr] = src[(size_t)rr * 512];
#pragma unroll
            for (int rr = 0; rr < 32; ++rr) acc += w[rr] * pr_[rr];
            const unsigned short hb = (unsigned short)(pk2(acc, 0.f) & 0xffffu);
            if (kv == 0) wsp<bf16>(C, WS_KCB)[((size_t)(b * 4 + kvh) * 64 + n) * 64 + d] = hb;
            else wsp<bf16>(C, WS_VCBT)[((size_t)(b * 4 + kvh) * 64 + d) * 64 + n] = hb;
            continue;
        }
        r -= PB_NPOOL;
        {
            const int which = r >> 9, b = (r >> 7) & 3, kvh = (r >> 5) & 3, tb = r & 31, d = tid & 63, tq = tid >> 6;
            const bf16* src = P + (size_t)(b * 2048 + 64 * tb + 8 * tq) * PLD + (which ? VW_OFF : VS_OFF) + kvh * 64 + d;
            unsigned short e[8];
#pragma unroll
            for (int i = 0; i < 8; ++i) e[i] = src[(size_t)i * PLD];
            v4u o; o.x = e[0] | ((unsigned)e[1] << 16); o.y = e[2] | ((unsigned)e[3] << 16); o.z = e[4] | ((unsigned)e[5] << 16); o.w = e[6] | ((unsigned)e[7] << 16);
            *(v4u*)(wsp<bf16>(C, which ? WS_VTW : WS_VTS) + (((size_t)(b * 4 + kvh) * 32 + tb) * 64 + d) * 64 + 8 * tq) = o;
            { const int row = tid >> 3, ch = tid & 7;
              const v4u kv_ = *(const v4u*)(P + (size_t)(b * 2048 + 64 * tb + row) * PLD + (which ? KW_OFF : KS_OFF) + kvh * 64 + ch * 8);
              *(v4u*)(wsp<bf16>(C, which ? WS_KWC : WS_KSC) + ((size_t)(b * 4 + kvh) * 2048 + 64 * tb + row) * 64 + ch * 8) = kv_; }
        }
    }
    __syncthreads();
}

#define MFMA16(a, b, c) __builtin_amdgcn_mfma_f32_16x16x32_bf16((a), (b), (c), 0, 0, 0)
DI void scan_head(const Ctx& C, int l, int row0, int T, int h, const float* S0, float* Sout) {
    const int tid = C.tid, lane = C.lane, wave = C.wave;
    LAS f32x4* D4 = (LAS f32x4*)C.lds;
    LAS v4u* BK4 = (LAS v4u*)(C.lds + 8192);
    LAS f32x4* V4 = (LAS f32x4*)(C.lds + 16384);
    LAS v4u* R16 = (LAS v4u*)(C.lds + 24576);
    LAS v4u* KK16 = (LAS v4u*)(C.lds + 28672);
    LAS float* YB = (LAS float*)(C.lds + 33280);
    const unsigned char* SCb = C.ws + WS_SC;
    const bf16* SCKK = (const bf16*)SCb; const float* SCD = (const float*)(SCb + SC_STRIDE); const unsigned* SCBK = (const unsigned*)(SCb + 2 * SC_STRIDE);
    const bf16* SCR = (const bf16*)(SCb + 4 * SC_STRIDE); const float* SCV = (const float*)(SCb + 5 * SC_STRIDE);
    const float* GG = wsp<float>(C, WS_GG); const float* BON = wsp<float>(C, WS_BON);
    bf16* MIX = wsp<bf16>(C, WS_MIX);
    const int n = lane & 15, rq = lane >> 4, v0 = 16 * (wave & 3); const bool act = wave < 4;
    f32x4 acc[4];
#pragma unroll
    for (int kt = 0; kt < 4; ++kt) acc[kt] = (act && S0) ? *(const f32x4*)(S0 + (v0 + n) * 64 + 16 * kt + 4 * rq) : (f32x4){0.f, 0.f, 0.f, 0.f};
    const int nch = (T + 31) >> 5;
    f32x4 pD, pV; v4u pBK, pRK, pK2;
    const v4u z4 = {0u, 0u, 0u, 0u};
#define SCAN_PREFETCH(cc) do { { const int step = (cc) * 32 + (tid >> 4), f4 = tid & 15; const size_t o = (size_t)(row0 + step) * 1024 + h * 64 + f4 * 4; const bool ok = step < T; \
            pD = ok ? *(const f32x4*)(SCD + o) : (f32x4){0.f, 0.f, 0.f, 0.f}; pV = ok ? *(const f32x4*)(SCV + o) : (f32x4){0.f, 0.f, 0.f, 0.f}; pBK = ok ? *(const v4u*)(SCBK + o) : z4; } \
        { const int i2 = tid & 255, step = (cc) * 32 + (i2 >> 3); const size_t o = (size_t)(row0 + step) * 1024 + h * 64 + (i2 & 7) * 8; pRK = step < T ? *(const v4u*)((tid < 256 ? SCR : SCKK) + o) : z4; } \
        { const int step = (cc) * 32 + 32; const size_t o = (size_t)(row0 + step) * 1024 + h * 64 + (tid & 7) * 8; pK2 = (tid < 8 && step < T) ? *(const v4u*)(SCKK + o) : z4; } } while (0)
    SCAN_PREFETCH(0);
    const float gng = C.inp(18)[l * 1024 + h * 64 + lane], gnb = C.inp(19)[l * 1024 + h * 64 + lane];
    float sk = 0.f;
    struct StepOps { f32x4 d[4]; v4u bk; float vt; v2u a[4]; };
#define SCAN_LD(o, st_) do { _Pragma("unroll") for (int kt = 0; kt < 4; ++kt) (o).d[kt] = D4[(st_) * 16 + 4 * kt + rq]; (o).bk = BK4[(st_) * 16 + n]; (o).vt = ((const LAS float*)V4)[(st_) * 64 + v0 + n]; \
        const LAS unsigned char* src_ = (n & 3) == 1 ? (const LAS unsigned char*)KK16 + ((st_) + 1) * 128 : (const LAS unsigned char*)R16 + (st_) * 128; \
        (o).a[0] = *(const LAS v2u*)(src_ + 8 * rq); (o).a[1] = *(const LAS v2u*)(src_ + 32 + 8 * rq); (o).a[2] = *(const LAS v2u*)(src_ + 64 + 8 * rq); (o).a[3] = *(const LAS v2u*)(src_ + 96 + 8 * rq); } while (0)
#define SCAN_YSK(a0_, a1_, a2_, a3_, yv, skv) do { \
        v4u h0, h1; h0.x = pk2(acc[0][0], acc[0][1]); h0.y = pk2(acc[0][2], acc[0][3]); h0.z = pk2(acc[1][0], acc[1][1]); h0.w = pk2(acc[1][2], acc[1][3]); \
        h1.x = pk2(acc[2][0], acc[2][1]); h1.y = pk2(acc[2][2], acc[2][3]); h1.z = pk2(acc[3][0], acc[3][1]); h1.w = pk2(acc[3][2], acc[3][3]); \
        const v4u f0 = {(a0_).x, (a0_).y, (a1_).x, (a1_).y}, f1 = {(a2_).x, (a2_).y, (a3_).x, (a3_).y}; \
        f32x4 d2 = MFMA16(__builtin_bit_cast(bf16x8, f0), __builtin_bit_cast(bf16x8, h0), ((f32x4){0.f, 0.f, 0.f, 0.f})); \
        d2 = MFMA16(__builtin_bit_cast(bf16x8, f1), __builtin_bit_cast(bf16x8, h1), d2); yv = d2[0]; skv = d2[1]; } while (0)
    for (int c = 0; c < nch; ++c) {
        __syncthreads();
        D4[tid] = pD; BK4[tid] = pBK; V4[tid] = pV;
        if (tid < 256) R16[tid] = pRK; else KK16[tid - 256] = pRK;
        if (tid < 8) KK16[256 + tid] = pK2;
        __syncthreads();
        if (c + 1 < nch) SCAN_PREFETCH(c + 1);
        const int nst = (T - c * 32) < 32 ? (T - c * 32) : 32;
        float gq[4], bq[4];
#pragma unroll
        for (int qq = 0; qq < 4; ++qq) { const int st = wave * 4 + qq; const size_t m = (size_t)row0 + c * 32 + (st < nst ? st : 0);
            gq[qq] = GG[m * 1024 + h * 64 + lane]; bq[qq] = BON[m * 16 + h]; }
        if (act) {
            if (c == 0) {
                const LAS unsigned char* s0 = (const LAS unsigned char*)KK16;
                const v2u k0 = *(const LAS v2u*)(s0 + 8 * rq), k1 = *(const LAS v2u*)(s0 + 32 + 8 * rq), k2 = *(const LAS v2u*)(s0 + 64 + 8 * rq), k3 = *(const LAS v2u*)(s0 + 96 + 8 * rq);
                float yd; SCAN_YSK(k0, k1, k2, k3, sk, yd); (void)yd;
            }
            StepOps cur; SCAN_LD(cur, 0);
#pragma unroll 2
            for (int st = 0; st < nst; ++st) {
                StepOps nx; { const int sn = st + 1 < 32 ? st + 1 : 31; SCAN_LD(nx, sn); }
#pragma unroll
                for (int kt = 0; kt < 4; ++kt) acc[kt] = acc[kt] * cur.d[kt];
                v4u b2 = z4; b2.x = rq == 0 ? pk2(sk, cur.vt) : 0u;
#pragma unroll
                for (int kt = 0; kt < 4; ++kt) { v4u a2 = z4; a2.x = rq == 0 ? cur.bk[kt] : 0u; acc[kt] = MFMA16(__builtin_bit_cast(bf16x8, a2), __builtin_bit_cast(bf16x8, b2), acc[kt]); }
                float y; SCAN_YSK(cur.a[0], cur.a[1], cur.a[2], cur.a[3], y, sk);
                if (rq == 0) YB[st * 64 + v0 + n] = y;
                cur = nx;
            }
        }
        __syncthreads();
#pragma unroll
        for (int qq = 0; qq < 4; ++qq) {
            const int st = wave * 4 + qq;
            if (st < nst) {
                const size_t m = (size_t)row0 + c * 32 + st;
                const float y = YB[st * 64 + lane];
                const float mean = wave_sum(y) * (1.f / 64.f);
                const float dv = y - mean;
                const float var = wave_sum(dv * dv) * (1.f / 64.f);
                const float yn = dv * __builtin_amdgcn_rsqf(var + GN_EPS) * gng + gnb;
                const float o = (yn + bq[qq] * ((const LAS float*)V4)[st * 64 + lane]) * gq[qq];
                MIX[m * DM + h * 64 + lane] = (unsigned short)(pk2(o, 0.f) & 0xffffu);
            }
        }
    }
#undef SCAN_PREFETCH
#undef SCAN_LD
#undef SCAN_YSK
    if (act) {
#pragma unroll
        for (int kt = 0; kt < 4; ++kt) *(f32x4*)(Sout + (v0 + n) * 64 + 16 * kt + 4 * rq) = acc[kt];
    }
}

constexpr int CST = 144, CBUF = 64 * CST;
DI void cmm(const LAS unsigned char* L, const LAS unsigned char* Rt, f32x4 (&acc)[2], int tm, int tn0, int n16, int kq) {
#pragma unroll
    for (int ks = 0; ks < 2; ++ks) {
        const bf16x8 a = *(const LAS bf16x8*)(L + (16 * tm + n16) * CST + (32 * ks + 8 * kq) * 2);
#pragma unroll
        for (int j = 0; j < 2; ++j) { const bf16x8 bq = *(const LAS bf16x8*)(Rt + (16 * (tn0 + j) + n16) * CST + (32 * ks + 8 * kq) * 2); acc[j] = MFMA16(a, bq, acc[j]); }
    }
}
template <int MODE> DI void cst_T(LAS unsigned char* X, const f32x4 (&acc)[2], int tm, int tn0, int n16, int rq) {
#pragma unroll
    for (int j = 0; j < 2; ++j) { const int n = 16 * (tn0 + j) + n16, m0 = 16 * tm + 4 * rq; float v[4];
#pragma unroll
        for (int i = 0; i < 4; ++i) { const int col = m0 + i; const bool keep = MODE == 0 ? true : (MODE == 1 ? col < n : (MODE == 2 ? col <= n : col > n)); v[i] = keep ? acc[j][i] : 0.f; }
        *(LAS v2u*)(X + n * CST + m0 * 2) = (v2u){pk2(v[0], v[1]), pk2(v[2], v[3])}; }
}
template <int mode> DI void chunk_head(const Ctx& C, int l, int b, int h, float* Sout, int part) {
    const int tid = C.tid, lane = C.lane, wave = C.wave;
    const int n16 = lane & 15, rq = lane >> 4, tm = wave >> 1, tn0 = (wave & 1) * 2;
    LAS unsigned char* const B0 = C.lds;
#define CB(i) (B0 + (i) * CBUF)
    enum { I_BH = 0, I_BHT = 1, I_AH = 2, I_KH = 3, I_RH = 4, I_ATT = 5, I_KTT = 6, I_VT = 7, I_A1 = 8, I_A1T = 9, I_A2 = 10, I_M1 = 11, I_M2 = 12, I_H0T = 13 };
    LAS float* SEG = (LAS float*)(B0 + 14 * CBUF);
    LAS float* YB = (LAS float*)CB(8);
    const unsigned char* SCb = C.ws + WS_SC;
    const bf16* SCKK = (const bf16*)SCb; const unsigned* SCBK = (const unsigned*)(SCb + 2 * SC_STRIDE); const float* SCLW = (const float*)(SCb + 3 * SC_STRIDE);
    const bf16* SCR = (const bf16*)(SCb + 4 * SC_STRIDE); const float* SCV = (const float*)(SCb + 5 * SC_STRIDE);
    const float* GG = wsp<float>(C, WS_GG); const float* BON = wsp<float>(C, WS_BON);
    bf16* MIX = wsp<bf16>(C, WS_MIX);
    const size_t m0 = (size_t)b * 2048;
    const int pk = tid & 63, seg = tid >> 6, bkidx = (pk & 15) * 4 + (pk >> 4);
    const f32x4 zf = {0.f, 0.f, 0.f, 0.f};
    f32x4 accH[2] = {zf, zf};
    __syncthreads();
    for (int i = tid; i < CBUF / 4; i += NTHREADS) ((LAS unsigned*)CB(I_H0T))[i] = 0u;
    float plw[8], pv[8]; unsigned pbk[8]; unsigned short pkk[8], pr[8];
#define CH_LOAD(cc) do { _Pragma("unroll") for (int i = 0; i < 8; ++i) { const size_t o = (m0 + (cc) * 64 + seg * 8 + i) * 1024 + h * 64; \
        plw[i] = SCLW[o + pk]; pkk[i] = SCKK[o + pk]; pbk[i] = SCBK[o + bkidx]; pr[i] = SCR[o + pk]; pv[i] = SCV[o + pk]; } } while (0)
    unsigned char* const OPS = C.ws + WS_OPS + (size_t)((b * 16 + h) * 24) * OPS_BYTES;
    unsigned* const flag = C.ctl + CW_FLAG + 64 * ((l * 64 + b * 16 + h) * 4);
    const int c_lo = mode ? 16 * part : 0, c_hi = mode ? 16 * part + 16 : 16;
    CH_LOAD(c_lo);
    const float gng = C.inp(18)[l * 1024 + h * 64 + lane], gnb = C.inp(19)[l * 1024 + h * 64 + lane];
    for (int c = c_lo; c < c_hi; ++c) {

        float gq[8], bq[8], vq[8];
#pragma unroll
        for (int i = 0; i < 8; ++i) { const size_t m = m0 + c * 64 + 8 * wave + i; gq[i] = GG[m * 1024 + h * 64 + lane]; bq[i] = BON[m * 16 + h]; vq[i] = SCV[m * 1024 + h * 64 + lane]; }
        float cs[8];
        { float run = 0.f;
#pragma unroll
          for (int i = 0; i < 8; ++i) { run += plw[i]; cs[i] = run; } }
        __syncthreads();
        SEG[seg * 64 + pk] = cs[7];
        __syncthreads();
        float off = 0.f, tot = 0.f;
#pragma unroll
        for (int s = 0; s < 8; ++s) { const float sv = SEG[s * 64 + pk]; tot += sv; off += s < seg ? sv : 0.f; }
        { unsigned short bt[8], at[8], kt[8], vt[8];
#pragma unroll
          for (int i = 0; i < 8; ++i) { const float csv = cs[i] + off;
              const float eP = __expf(csv), eM = __expf(-csv), ePm = __expf(csv - plw[i]), eQ = __expf(tot - csv);
              const float kkf = bf2f(pkk[i]), nb = bflo(pbk[i]), kmf = bfhi(pbk[i]), rf = bf2f(pr[i]);
              const int t = seg * 8 + i;
              const unsigned short vb = (unsigned short)(pk2(kkf * ePm, 0.f) & 0xffffu);
              *(LAS unsigned short*)(CB(I_BH) + t * CST + pk * 2) = vb; bt[i] = vb;
              *(LAS unsigned short*)(CB(I_AH) + t * CST + pk * 2) = (unsigned short)(pk2(nb * eM, 0.f) & 0xffffu);
              *(LAS unsigned short*)(CB(I_KH) + t * CST + pk * 2) = (unsigned short)(pk2(kmf * eM, 0.f) & 0xffffu);
              *(LAS unsigned short*)(CB(I_RH) + t * CST + pk * 2) = (unsigned short)(pk2(rf * eP, 0.f) & 0xffffu);
              at[i] = (unsigned short)(pk2(nb * eQ, 0.f) & 0xffffu); kt[i] = (unsigned short)(pk2(kmf * eQ, 0.f) & 0xffffu); vt[i] = (unsigned short)(pk2(pv[i], 0.f) & 0xffffu); }
#define PK8(a) ((v4u){(unsigned)a[0] | ((unsigned)a[1] << 16), (unsigned)a[2] | ((unsigned)a[3] << 16), (unsigned)a[4] | ((unsigned)a[5] << 16), (unsigned)a[6] | ((unsigned)a[7] << 16)})
          *(LAS v4u*)(CB(I_BHT) + pk * CST + seg * 16) = PK8(bt); *(LAS v4u*)(CB(I_ATT) + pk * CST + seg * 16) = PK8(at);
          *(LAS v4u*)(CB(I_KTT) + pk * CST + seg * 16) = PK8(kt); *(LAS v4u*)(CB(I_VT) + pk * CST + seg * 16) = PK8(vt);
#undef PK8
        }
        if (c + 1 < c_hi) CH_LOAD(c + 1);
        __syncthreads();
        f32x4 accT[2];
        { f32x4 a_[2];
          a_[0] = zf; a_[1] = zf; cmm(CB(I_BH), CB(I_AH), a_, tm, tn0, n16, rq); cst_T<3>(CB(I_A1T), a_, tm, tn0, n16, rq);
          a_[0] = zf; a_[1] = zf; cmm(CB(I_AH), CB(I_BH), a_, tm, tn0, n16, rq); cst_T<1>(CB(I_A1), a_, tm, tn0, n16, rq);
#pragma unroll
          for (int j = 0; j < 2; ++j)
#pragma unroll
              for (int i = 0; i < 4; ++i) { const int m = 16 * tm + 4 * rq + i, n = 16 * (tn0 + j) + n16; accT[j][i] = m < n ? a_[j][i] : (m == n ? 1.f : 0.f); }
          a_[0] = zf; a_[1] = zf; cmm(CB(I_KH), CB(I_BH), a_, tm, tn0, n16, rq); cst_T<1>(CB(I_A2), a_, tm, tn0, n16, rq);
          a_[0] = zf; a_[1] = zf; cmm(CB(I_AH), CB(I_RH), a_, tm, tn0, n16, rq); cst_T<2>(CB(I_M1), a_, tm, tn0, n16, rq);
          a_[0] = zf; a_[1] = zf; cmm(CB(I_KH), CB(I_RH), a_, tm, tn0, n16, rq); cst_T<2>(CB(I_M2), a_, tm, tn0, n16, rq); }
        __syncthreads();
        { int ip = I_A1, ipt = I_A1T, in_ = I_AH, int_ = I_KH;
#pragma unroll 1
          for (int lev = 0; lev < 5; ++lev) {
              cst_T<0>(CB(I_BH), accT, tm, tn0, n16, rq);
              f32x4 a_[2];
              a_[0] = zf; a_[1] = zf; cmm(CB(ip), CB(ipt), a_, tm, tn0, n16, rq); cst_T<0>(CB(int_), a_, tm, tn0, n16, rq);
              a_[0] = zf; a_[1] = zf; cmm(CB(ipt), CB(ip), a_, tm, tn0, n16, rq); cst_T<0>(CB(in_), a_, tm, tn0, n16, rq);
              __syncthreads();
              cmm(CB(int_), CB(I_BH), accT, tm, tn0, n16, rq);
              __syncthreads();
              const int t0 = ip, t1 = ipt; ip = in_; ipt = int_; in_ = t0; int_ = t1;
          }
          cst_T<0>(CB(I_BH), accT, tm, tn0, n16, rq); }
        { f32x4 a_[2];
          a_[0] = zf; a_[1] = zf; cmm(CB(I_A2), CB(I_VT), a_, tm, tn0, n16, rq); cst_T<0>(CB(8), a_, tm, tn0, n16, rq);
          __syncthreads();
          a_[0] = zf; a_[1] = zf; cmm(CB(I_BH), CB(I_BHT), a_, tm, tn0, n16, rq); cst_T<0>(CB(9), a_, tm, tn0, n16, rq);
          a_[0] = zf; a_[1] = zf; cmm(CB(I_BH), CB(8), a_, tm, tn0, n16, rq); cst_T<0>(CB(2), a_, tm, tn0, n16, rq); }
        __syncthreads();
        f32x4 accE[2] = {zf, zf}, accY[2] = {zf, zf};
        { f32x4 a_[2];
          a_[0] = zf; a_[1] = zf; cmm(CB(9), CB(I_ATT), a_, tm, tn0, n16, rq);
#pragma unroll
          for (int j = 0; j < 2; ++j) { const int n = 16 * (tn0 + j) + n16, mm0 = 16 * tm + 4 * rq; float pc = 0.f;
#pragma unroll
              for (int s = 0; s < 8; ++s) pc += SEG[s * 64 + n];
              pc = __expf(pc); float v[4];
#pragma unroll
              for (int i = 0; i < 4; ++i) v[i] = a_[j][i] + (mm0 + i == n ? pc : 0.f);
              *(LAS v2u*)(CB(3) + n * CST + mm0 * 2) = (v2u){pk2(v[0], v[1]), pk2(v[2], v[3])}; }
          cmm(CB(I_ATT), CB(2), accE, tm, tn0, n16, rq); cmm(CB(I_KTT), CB(I_VT), accE, tm, tn0, n16, rq);
          a_[0] = zf; a_[1] = zf; cmm(CB(9), CB(I_M1), a_, tm, tn0, n16, rq);
#pragma unroll
          for (int j = 0; j < 2; ++j) { const int n = 16 * (tn0 + j) + n16, mm0 = 16 * tm + 4 * rq;
              const v2u rh = *(const LAS v2u*)(CB(I_RH) + n * CST + mm0 * 2);
              *(LAS v2u*)(CB(10) + n * CST + mm0 * 2) = (v2u){pk2(a_[j][0] + bflo(rh.x), a_[j][1] + bfhi(rh.x)), pk2(a_[j][2] + bflo(rh.y), a_[j][3] + bfhi(rh.y))}; }
          cmm(CB(I_M1), CB(2), accY, tm, tn0, n16, rq); cmm(CB(I_M2), CB(I_VT), accY, tm, tn0, n16, rq); }
        __syncthreads();
        if (mode == 1) {
            unsigned char* ob = OPS + (size_t)(c - 16) * OPS_BYTES;
            for (int i = tid; i < 2 * CBUF / 16; i += NTHREADS) ((v4u*)ob)[i] = *(const LAS v4u*)((i < CBUF / 16 ? CB(3) : CB(10)) + (i < CBUF / 16 ? i : i - CBUF / 16) * 16);
            ((f32x4*)(ob + 2 * CBUF))[tid * 2] = accE[0]; ((f32x4*)(ob + 2 * CBUF))[tid * 2 + 1] = accE[1];
            ((f32x4*)(ob + 2 * CBUF + 16384))[tid * 2] = accY[0]; ((f32x4*)(ob + 2 * CBUF + 16384))[tid * 2 + 1] = accY[1];
            continue;
        }
        cmm(CB(3), CB(I_H0T), accE, tm, tn0, n16, rq); cmm(CB(10), CB(I_H0T), accY, tm, tn0, n16, rq);
        __syncthreads();
        accH[0] = accE[0]; accH[1] = accE[1];
        cst_T<0>(CB(I_H0T), accH, tm, tn0, n16, rq);
#pragma unroll
        for (int j = 0; j < 2; ++j)
#pragma unroll
            for (int i = 0; i < 4; ++i) YB[(16 * tm + 4 * rq + i) * 64 + 16 * (tn0 + j) + n16] = accY[j][i];
        __syncthreads();
#pragma unroll
        for (int i = 0; i < 8; ++i) {
            const int t = 8 * wave + i; const size_t m = m0 + c * 64 + t;
            const float y = YB[t * 64 + lane];
            const float mean = wave_sum(y) * (1.f / 64.f);
            const float dv = y - mean;
            const float var = wave_sum(dv * dv) * (1.f / 64.f);
            const float yn = dv * __builtin_amdgcn_rsqf(var + GN_EPS) * gng + gnb;
            const float o = (yn + bq[i] * vq[i]) * gq[i];
            MIX[m * DM + h * 64 + lane] = (unsigned short)(pk2(o, 0.f) & 0xffffu);
        }
    }
    if (mode == 0) for (int c = 16; c < 32; ++c) {
            float gq[8], bq[8], vq[8];
#pragma unroll
            for (int i = 0; i < 8; ++i) { const size_t m = m0 + c * 64 + 8 * wave + i; gq[i] = GG[m * 1024 + h * 64 + lane]; bq[i] = BON[m * 16 + h]; vq[i] = SCV[m * 1024 + h * 64 + lane]; }
            if ((c & 15) == 0) {
                if (tid == 0) { unsigned sp = 0; while (__hip_atomic_load(flag + 64 * (c >> 4), __ATOMIC_RELAXED, __HIP_MEMORY_SCOPE_AGENT) == 0u) { __builtin_amdgcn_s_sleep(8); if (++sp > (1u << 22)) break; }
                    __builtin_amdgcn_fence(__ATOMIC_ACQUIRE, "agent"); asm volatile("s_waitcnt vmcnt(0)" ::: "memory"); }
            }
            __syncthreads();
            const unsigned char* ob = OPS + (size_t)(c - 16) * OPS_BYTES;
            for (int i = tid; i < 2 * CBUF / 16; i += NTHREADS) { const v4u w = ((const v4u*)ob)[i]; *(LAS v4u*)((i < CBUF / 16 ? CB(3) : CB(10)) + (i < CBUF / 16 ? i : i - CBUF / 16) * 16) = w; }
            f32x4 accE[2], accY[2];
            accE[0] = ((const f32x4*)(ob + 2 * CBUF))[tid * 2]; accE[1] = ((const f32x4*)(ob + 2 * CBUF))[tid * 2 + 1];
            accY[0] = ((const f32x4*)(ob + 2 * CBUF + 16384))[tid * 2]; accY[1] = ((const f32x4*)(ob + 2 * CBUF + 16384))[tid * 2 + 1];
            __syncthreads();
            cmm(CB(3), CB(I_H0T), accE, tm, tn0, n16, rq); cmm(CB(10), CB(I_H0T), accY, tm, tn0, n16, rq);
            __syncthreads();
            accH[0] = accE[0]; accH[1] = accE[1];
            cst_T<0>(CB(I_H0T), accH, tm, tn0, n16, rq);
#pragma unroll
            for (int j = 0; j < 2; ++j)
#pragma unroll
                for (int i = 0; i < 4; ++i) YB[(16 * tm + 4 * rq + i) * 64 + 16 * (tn0 + j) + n16] = accY[j][i];
            __syncthreads();
#pragma unroll
            for (int i = 0; i < 8; ++i) {
                const int t = 8 * wave + i; const size_t m = m0 + c * 64 + t;
                const float y = YB[t * 64 + lane];
                const float mean = wave_sum(y) * (1.f / 64.f);
                const float dv = y - mean;
                const float var = wave_sum(dv * dv) * (1.f / 64.f);
                const float yn = dv * __builtin_amdgcn_rsqf(var + GN_EPS) * gng + gnb;
                const float o = (yn + bq[i] * vq[i]) * gq[i];
                MIX[m * DM + h * 64 + lane] = (unsigned short)(pk2(o, 0.f) & 0xffffu);
            }
    }
#undef CH_LOAD
#undef CB
    if (mode == 1) {
        asm volatile("s_waitcnt vmcnt(0)" ::: "memory");
        __syncthreads();
        if (tid == 0) { __builtin_amdgcn_fence(__ATOMIC_RELEASE, "agent"); asm volatile("s_waitcnt vmcnt(0)" ::: "memory"); __hip_atomic_store(flag + 64 * part, 1u, __ATOMIC_RELAXED, __HIP_MEMORY_SCOPE_AGENT); }
        return;
    }
#pragma unroll
    for (int j = 0; j < 2; ++j) *(f32x4*)(Sout + (size_t)(16 * (tn0 + j) + n16) * 64 + 16 * tm + 4 * rq) = accH[j];
}

#define MFMA32(a, b, c) __builtin_amdgcn_mfma_f32_32x32x16_bf16((a), (b), (c), 0, 0, 0)
DI bf16x8 pack8(const f32x16& p, int s) {
    v4u o; o.x = pk2(p[8 * s], p[8 * s + 1]); o.y = pk2(p[8 * s + 2], p[8 * s + 3]); o.z = pk2(p[8 * s + 4], p[8 * s + 5]); o.w = pk2(p[8 * s + 6], p[8 * s + 7]);
    return __builtin_bit_cast(bf16x8, o);
}
DI bf16x8 ld_vt(const bf16* p) {
    const v2u a = *(const v2u*)p, b = *(const v2u*)(p + 8);
    v4u o; o.x = a.x; o.y = a.y; o.z = b.x; o.w = b.y; return __builtin_bit_cast(bf16x8, o);
}
constexpr int KT_STRIDE = 144, VTT_STRIDE = 136, KT_BYTES = 64 * KT_STRIDE, TILE_BYTES = KT_BYTES + 64 * VTT_STRIDE, TILE_OFF = 74752;
struct TileRegs { v4u k, v; };
DI TileRegs tile_load(const bf16* kbase, size_t kstride, const bf16* vbase, size_t vstride, int tid) {
    TileRegs r; const int row = tid >> 3, ch = tid & 7;
    r.k = *(const v4u*)(kbase + (size_t)row * kstride + ch * 8); r.v = *(const v4u*)(vbase + (size_t)row * vstride + ch * 8); return r;
}
DI void tile_store(LAS unsigned char* buf, const TileRegs& r, int tid) {
    const int row = tid >> 3, ch = tid & 7;
    *(LAS v4u*)(buf + row * KT_STRIDE + ch * 16) = r.k;
    *(LAS v2u*)(buf + KT_BYTES + row * VTT_STRIDE + ch * 16) = (v2u){r.v.x, r.v.y}; *(LAS v2u*)(buf + KT_BYTES + row * VTT_STRIDE + ch * 16 + 8) = (v2u){r.v.z, r.v.w};
}
DI bf16x8 ld_vt_lds(const LAS unsigned char* p) {
    const v2u a = *(const LAS v2u*)p, b = *(const LAS v2u*)(p + 16);
    v4u o; o.x = a.x; o.y = a.y; o.z = b.x; o.w = b.y; return __builtin_bit_cast(bf16x8, o);
}
#define ATT_BLOCK(EDGE, BUF, KEYBLK0, MINE, VALID_EXPR) do { \
    const float bias_ = (MINE) ? 0.f : NEG_BIG; \
    _Pragma("unroll 1") for (int tile = 0; tile < 2; ++tile) { const int key0 = (KEYBLK0) + tile * 32; (void)key0; \
        f32x16 a_ = zero16; \
        _Pragma("unroll") for (int s = 0; s < 4; ++s) { const bf16x8 kf = *(const LAS bf16x8*)((BUF) + (tile * 32 + q) * KT_STRIDE + 32 * s + 16 * hi); a_ = MFMA32(kf, qf[s], a_); } \
        float tm = NEG_BIG; \
        if (EDGE) { _Pragma("unroll") for (int i = 0; i < 16; ++i) { const int key = key0 + crow(i, hi); const bool ok = (MINE) && (VALID_EXPR); a_[i] = ok ? a_[i] * SCL2 : NEG_BIG; tm = fmaxf(tm, a_[i]); } } \
        else { _Pragma("unroll") for (int i = 0; i < 16; ++i) { a_[i] = a_[i] * SCL2 + bias_; tm = fmaxf(tm, a_[i]); } } \
        tm = fmaxf(tm, __shfl_xor(tm, 32)); \
        const float mn = fmaxf(mrun, tm); const float sc_ = __builtin_amdgcn_exp2f(mrun - mn); \
        float ps = 0.f; \
        if (EDGE) { _Pragma("unroll") for (int i = 0; i < 16; ++i) { const float p_ = a_[i] > -1e29f ? __builtin_amdgcn_exp2f(a_[i] - mn) : 0.f; a_[i] = p_; ps += p_; } } \
        else { _Pragma("unroll") for (int i = 0; i < 16; ++i) { const float p_ = __builtin_amdgcn_exp2f(a_[i] - mn); a_[i] = p_; ps += p_; } } \
        ps += __shfl_xor(ps, 32); \
        lrun = lrun * sc_ + ps; mrun = mn; \
        _Pragma("unroll") for (int i = 0; i < 16; ++i) { oa[0][i] *= sc_; oa[1][i] *= sc_; } \
        _Pragma("unroll") for (int s = 0; s < 2; ++s) { const bf16x8 pb = pack8(a_, s); \
            oa[0] = MFMA32(ld_vt_lds((BUF) + KT_BYTES + q * VTT_STRIDE + (tile * 32 + 16 * s + 4 * hi) * 2), pb, oa[0]); \
            oa[1] = MFMA32(ld_vt_lds((BUF) + KT_BYTES + (32 + q) * VTT_STRIDE + (tile * 32 + 16 * s + 4 * hi) * 2), pb, oa[1]); } \
    } } while (0)
constexpr float SCL2 = 0.125f * 1.4426950408889634f;

DI void nsa_prompt_unit(const Ctx& C, int l, int b, int kvh, int qt, bool skipblk = false, bool skipcmp = false) {
    const int tid = C.tid, lane = C.lane, wave = C.wave;
    const int g = wave & 3, th = wave >> 2, q = lane & 31, hi = lane >> 5;
    LAS float* IMP = (LAS float*)C.lds;
    LAS float* IMPV = (LAS float*)(C.lds + 65536);
    LAS unsigned* SELM = (LAS unsigned*)(C.lds + 65536 + 8192);
    LAS unsigned char* TB = C.lds + TILE_OFF;
    const bf16* P = wsp<bf16>(C, WS_PROJ);
    const int tok = qt * 64 + th * 32 + q;
    const size_t m = (size_t)b * 2048 + tok;
    const int bk = b * 4 + kvh, head = kvh * 4 + g;
    f32x16 zero16;
#pragma unroll
    for (int i = 0; i < 16; ++i) zero16[i] = 0.f;
    bf16x8 qf[4];
#pragma unroll
    for (int s = 0; s < 4; ++s) qf[s] = *(const bf16x8*)(P + m * PLD + Q_OFF + head * 64 + 16 * s + 8 * hi);
    f32x16 out0 = zero16, out1 = zero16;
    const float g0 = sigmoidf_(bf2f(P[m * PLD + GL_OFF + head * 3 + 0])), g1 = sigmoidf_(bf2f(P[m * PLD + GL_OFF + head * 3 + 1])), g2 = sigmoidf_(bf2f(P[m * PLD + GL_OFF + head * 3 + 2]));
    TileRegs tr = tile_load(wsp<bf16>(C, WS_KCB) + (size_t)bk * 4096, 64, wsp<bf16>(C, WS_VCBT) + (size_t)bk * 4096, 64, tid);
    __syncthreads();
    tile_store(TB, tr, tid);
    __syncthreads();
    if (!skipcmp) {
    {
        f32x16 sc[2];
        const int nvalid = (tok + 1) >> 5;
        float mx = NEG_BIG;
#pragma unroll
        for (int tile = 0; tile < 2; ++tile) {
            f32x16 a_ = zero16;
#pragma unroll
            for (int s = 0; s < 4; ++s) { const bf16x8 kf = *(const LAS bf16x8*)(TB + (tile * 32 + q) * KT_STRIDE + 32 * s + 16 * hi); a_ = MFMA32(kf, qf[s], a_); }
#pragma unroll
            for (int i = 0; i < 16; ++i) { const int n = tile * 32 + crow(i, hi); a_[i] = n < nvalid ? a_[i] * 0.125f : NEG_BIG; mx = fmaxf(mx, a_[i]); }
            sc[tile] = a_;
        }
        mx = fmaxf(mx, __shfl_xor(mx, 32));
        float sum = 0.f;
#pragma unroll
        for (int tile = 0; tile < 2; ++tile)
#pragma unroll
            for (int i = 0; i < 16; ++i) { const float p_ = sc[tile][i] > -1e29f ? __expf(sc[tile][i] - mx) : 0.f; sc[tile][i] = p_; sum += p_; }
        sum += __shfl_xor(sum, 32);
        const float inv = nvalid > 0 ? 1.f / sum : 0.f;
        f32x16 oc0 = zero16, oc1 = zero16;
#pragma unroll
        for (int tile = 0; tile < 2; ++tile) {
#pragma unroll
            for (int i = 0; i < 16; ++i) sc[tile][i] *= inv;
#pragma unroll
            for (int i4 = 0; i4 < 4; ++i4) { f32x4 v = {sc[tile][4 * i4], sc[tile][4 * i4 + 1], sc[tile][4 * i4 + 2], sc[tile][4 * i4 + 3]};
                *(LAS f32x4*)(IMP + ((size_t)(g * 64 + th * 32 + q)) * 64 + tile * 32 + 8 * i4 + 4 * hi) = v; }
#pragma unroll
            for (int s = 0; s < 2; ++s) { const bf16x8 pb = pack8(sc[tile], s);
                oc0 = MFMA32(ld_vt_lds(TB + KT_BYTES + q * VTT_STRIDE + (tile * 32 + 16 * s + 4 * hi) * 2), pb, oc0);
                oc1 = MFMA32(ld_vt_lds(TB + KT_BYTES + (32 + q) * VTT_STRIDE + (tile * 32 + 16 * s + 4 * hi) * 2), pb, oc1); }
        }
#pragma unroll
        for (int i = 0; i < 16; ++i) { out0[i] = g0 * oc0[i]; out1[i] = g0 * oc1[i]; }
    }
    __syncthreads();
    {
        const int tokl = tid >> 3, jq = tid & 7;
        float v[4];
#pragma unroll
        for (int e = 0; e < 4; ++e) v[e] = 0.f;
#pragma unroll
        for (int gg = 0; gg < 4; ++gg) { const f32x4 a = *(const LAS f32x4*)(IMP + (size_t)(gg * 64 + tokl) * 64 + 8 * jq), bq = *(const LAS f32x4*)(IMP + (size_t)(gg * 64 + tokl) * 64 + 8 * jq + 4);
            v[0] += a[0] + a[1]; v[1] += a[2] + a[3]; v[2] += bq[0] + bq[1]; v[3] += bq[2] + bq[3]; }
        const int cur = qt;
#pragma unroll
        for (int e = 0; e < 4; ++e) { const int j = 4 * jq + e; const bool forced = (j == 0) | (j == cur) | (j == cur - 1); v[e] = j > cur ? -1.f : (forced ? 1e4f : v[e]); }
        *(LAS f32x4*)(IMPV + tokl * 32 + 4 * jq) = (f32x4){v[0], v[1], v[2], v[3]};
        __syncthreads();
        int rank[4] = {0, 0, 0, 0};
#pragma unroll
        for (int jj4 = 0; jj4 < 8; ++jj4) { const f32x4 o = *(const LAS f32x4*)(IMPV + tokl * 32 + 4 * jj4);
#pragma unroll
            for (int u = 0; u < 4; ++u) { const int jp = 4 * jj4 + u; const float ov = o[u];
#pragma unroll
                for (int e = 0; e < 4; ++e) { const int j = 4 * jq + e; rank[e] += (ov > v[e] || (ov == v[e] && jp < j)) ? 1 : 0; } } }
        unsigned bits = 0;
#pragma unroll
        for (int e = 0; e < 4; ++e) if (rank[e] < 16 && v[e] >= 0.f) bits |= 1u << (4 * jq + e);
        bits |= __shfl_xor(bits, 1); bits |= __shfl_xor(bits, 2); bits |= __shfl_xor(bits, 4);
        if (jq == 0) SELM[tokl] = bits;
        __syncthreads();
    }
    }
    if (skipcmp && tid < 64) SELM[tid] = 0xffffffffu;
    __syncthreads();
    const unsigned selm = SELM[th * 32 + q];
    unsigned uni;
    { unsigned u0 = SELM[lane];
#pragma unroll
      for (int o = 1; o < 64; o <<= 1) u0 |= __shfl_xor(u0, o);
      uni = __builtin_amdgcn_readfirstlane(u0); }
    {
        LAS float* PARK = (LAS float*)C.lds + wave * 2048 + lane;
#pragma unroll
        for (int i = 0; i < 16; ++i) { PARK[i * 64] = out0[i]; PARK[(16 + i) * 64] = out1[i]; }
        const bf16* KBs = wsp<bf16>(C, WS_KSC) + (size_t)bk * 2048 * 64; const bf16* KBw = wsp<bf16>(C, WS_KWC) + (size_t)bk * 2048 * 64;
        const bf16* VTs = wsp<bf16>(C, WS_VTS) + (size_t)bk * 32 * 4096; const bf16* VTw = wsp<bf16>(C, WS_VTW) + (size_t)bk * 32 * 4096;
        f32x16 oa[2] = {zero16, zero16}; float mrun = NEG_BIG, lrun = 0.f;
        unsigned rem = skipblk ? 1u : uni; int wj = skipblk ? qt : (qt > 8 ? qt - 8 : 0); bool folded = false;
#define NEXT_BLK(dst) do { if (rem) { dst = __builtin_ctz(rem); rem &= rem - 1; } else if (wj <= qt) { dst = wj | 256; ++wj; } else dst = -1; } while (0)
#define LOAD_BLK(tr_, d_) do { const int j_ = (d_) & 255; tr_ = ((d_) & 256) ? tile_load(KBw + (size_t)j_ * 4096, 64, VTw + (size_t)j_ * 4096, 64, tid) : tile_load(KBs + (size_t)j_ * 4096, 64, VTs + (size_t)j_ * 4096, 64, tid); } while (0)
#define FOLD(gate_) do { const float il_ = (gate_) / lrun; _Pragma("unroll") for (int i = 0; i < 16; ++i) { PARK[i * 64] += il_ * oa[0][i]; PARK[(16 + i) * 64] += il_ * oa[1][i]; } \
            oa[0] = zero16; oa[1] = zero16; mrun = NEG_BIG; lrun = 0.f; } while (0)
#define DO_BLK(d_, buf_) do { const int j_ = (d_) & 255; const bool win_ = ((d_) & 256) != 0; \
            if (win_ && !folded) { FOLD(g1); folded = true; } \
            const bool mine = win_ ? true : (((selm >> j_) & 1u) != 0u); \
            if (__any(mine)) { const int wl_ = win_ ? 511 : (1 << 20); const bool edge_ = (j_ == qt) || (win_ && j_ + 8 <= qt); \
                if (edge_) ATT_BLOCK(1, buf_, j_ * 64, mine, (key <= tok && key + wl_ >= tok)); else ATT_BLOCK(0, buf_, j_ * 64, mine, true); } } while (0)
        int d0, d1, d2; TileRegs trA, trB;
        NEXT_BLK(d0); NEXT_BLK(d1);
        LOAD_BLK(trA, d0); if (d1 >= 0) LOAD_BLK(trB, d1);
        __syncthreads();
        for (;;) {
            tile_store(TB, trA, tid); __syncthreads();
            NEXT_BLK(d2); if (d2 >= 0) LOAD_BLK(trA, d2);
            DO_BLK(d0, TB);
            if (d1 < 0) break;
            tile_store(TB + TILE_BYTES, trB, tid); __syncthreads();
            NEXT_BLK(d0); if (d0 >= 0) LOAD_BLK(trB, d0);
            DO_BLK(d1, TB + TILE_BYTES);
            if (d2 < 0) break;
            d1 = d0; d0 = d2;
        }
        FOLD(g2);
#undef NEXT_BLK
#undef LOAD_BLK
#undef FOLD
#undef DO_BLK
#pragma unroll
        for (int i = 0; i < 16; ++i) { out0[i] = PARK[i * 64]; out1[i] = PARK[(16 + i) * 64]; }
    }
    bf16* MIX = wsp<bf16>(C, WS_MIX) + m * DM + 1024 + head * 64;
    if (!skipblk)
#pragma unroll
    for (int i4 = 0; i4 < 4; ++i4) {
        v2u o; o.x = pk2(out0[4 * i4], out0[4 * i4 + 1]); o.y = pk2(out0[4 * i4 + 2], out0[4 * i4 + 3]); *(v2u*)(MIX + 8 * i4 + 4 * hi) = o;
        o.x = pk2(out1[4 * i4], out1[4 * i4 + 1]); o.y = pk2(out1[4 * i4 + 2], out1[4 * i4 + 3]); *(v2u*)(MIX + 32 + 8 * i4 + 4 * hi) = o;
    }
}

template <class RowFn> DI void samp_block(const RowFn& rowptr, int nvalid, int kvh, const LAS float* QS, LAS float* PWw, int lane, float (&M)[4], float (&L)[4], float (&O)[4]) {
    float s[4] = {0.f, 0.f, 0.f, 0.f};
    const bool ok = lane < nvalid;
    if (ok) {
        const f32x4* kr = (const f32x4*)(rowptr(lane) + kvh * 64);
#pragma unroll 4
        for (int d4 = 0; d4 < 16; ++d4) { const f32x4 kq = kr[d4];
#pragma unroll
            for (int g = 0; g < 4; ++g) { const f32x4 qq = *(const LAS f32x4*)(QS + g * 64 + 4 * d4); s[g] += kq[0] * qq[0] + kq[1] * qq[1] + kq[2] * qq[2] + kq[3] * qq[3]; } }
    }
    float mb[4], lb[4];
#pragma unroll
    for (int g = 0; g < 4; ++g) { const float sv = ok ? s[g] : NEG_BIG; mb[g] = wave_max(sv); const float p = ok ? expf(sv - mb[g]) : 0.f; lb[g] = wave_sum(p); PWw[g * 64 + lane] = p; }
    LDS_WAIT(); asm volatile("" ::: "memory");
    float ob[4] = {0.f, 0.f, 0.f, 0.f};
    for (int r0 = 0; r0 < nvalid; r0 += 4) {
        float vv[4];
#pragma unroll
        for (int u = 0; u < 4; ++u) vv[u] = r0 + u < nvalid ? rowptr(r0 + u)[256 + kvh * 64 + lane] : 0.f;
#pragma unroll
        for (int u = 0; u < 4; ++u)
#pragma unroll
            for (int g = 0; g < 4; ++g) ob[g] += PWw[g * 64 + r0 + u] * vv[u]; }
    LDS_WAIT(); asm volatile("" ::: "memory");
#pragma unroll
    for (int g = 0; g < 4; ++g) { const float mn = fmaxf(M[g], mb[g]); const float a = expf(M[g] - mn), bsc = expf(mb[g] - mn); L[g] = L[g] * a + lb[g] * bsc; O[g] = O[g] * a + ob[g] * bsc; M[g] = mn; }
}
DI float samp_combine(LAS float* WST, int tid, int lane, int wave, const float (&M)[4], const float (&L)[4], const float (&O)[4]) {
    __syncthreads();
#pragma unroll
    for (int g = 0; g < 4; ++g) { WST[wave * 264 + 8 + g * 64 + lane] = O[g]; if (lane == 0) { WST[wave * 264 + g] = M[g]; WST[wave * 264 + 4 + g] = L[g]; } }
    __syncthreads();
    float res = 0.f;
    if (tid < 256) { const int g = tid >> 6, d = tid & 63; float mm = NEG_BIG;
#pragma unroll
        for (int w = 0; w < 8; ++w) mm = fmaxf(mm, WST[w * 264 + g]);
        float ll = 0.f, oo = 0.f;
#pragma unroll
        for (int w = 0; w < 8; ++w) { const float e = expf(WST[w * 264 + g] - mm); ll += WST[w * 264 + 4 + g] * e; oo += WST[w * 264 + 8 + g * 64 + d] * e; }
        res = oo / ll; }
    return res;
}

DI void nsa_sample_item(const Ctx& C, int l, int b, int t, int kvh) {
    const int tid = C.tid, lane = C.lane, wave = C.wave;
    LAS float* F = (LAS float*)C.lds;
    LAS float *QS = F, *PC = F + 256, *IMPS = F + 2304, *RED = F + 2624, *RED2 = F + 2688, *OCP = F + 2752, *PW = F + 4800, *WST = F + 6848;
    LAS int* SELB = (LAS int*)(F + 2560);
    const bf16* P = wsp<bf16>(C, WS_PROJ);
    const size_t m = (size_t)NTP + b * 4 + t;
    __syncthreads();
    if (tid < 256) QS[tid] = bf2f(P[m * PLD + Q_OFF + kvh * 256 + tid]) * 0.125f;
    __syncthreads();
    float ocmp = 0.f;
    {
        const float* KC = wsp<float>(C, WS_KCBS) + ((size_t)((l * 8 + b) * 4 + kvh) * 512) * 64;
        const float* VC = wsp<float>(C, WS_VCBS) + ((size_t)((l * 8 + b) * 4 + kvh) * 512) * 64;
        float s[4] = {0.f, 0.f, 0.f, 0.f};
        const f32x4* kr = (const f32x4*)(KC + (size_t)tid * 64);
#pragma unroll 4
        for (int d4 = 0; d4 < 16; ++d4) { const f32x4 kq = kr[d4];
#pragma unroll
            for (int g = 0; g < 4; ++g) { const f32x4 qq = *(const LAS f32x4*)(QS + g * 64 + 4 * d4); s[g] += kq[0] * qq[0] + kq[1] * qq[1] + kq[2] * qq[2] + kq[3] * qq[3]; } }
#pragma unroll
        for (int g = 0; g < 4; ++g) { const float wm = wave_max(s[g]); if (lane == 0) RED[wave * 4 + g] = wm; }
        __syncthreads();
        float p[4];
#pragma unroll
        for (int g = 0; g < 4; ++g) { float mm = RED[g];
#pragma unroll
            for (int w = 1; w < 8; ++w) mm = fmaxf(mm, RED[w * 4 + g]);
            p[g] = expf(s[g] - mm); const float ws = wave_sum(p[g]); if (lane == 0) RED2[wave * 4 + g] = ws; }
        __syncthreads();
#pragma unroll
        for (int g = 0; g < 4; ++g) { float tot = 0.f;
#pragma unroll
            for (int w = 0; w < 8; ++w) tot += RED2[w * 4 + g];
            PC[g * 512 + tid] = p[g] / tot; }
        __syncthreads();
        if (tid < 256) IMPS[tid] = (PC[2 * tid] + PC[2 * tid + 1]) + (PC[512 + 2 * tid] + PC[512 + 2 * tid + 1]) + (PC[1024 + 2 * tid] + PC[1024 + 2 * tid + 1]) + (PC[1536 + 2 * tid] + PC[1536 + 2 * tid + 1]);
        { const int d = tid & 63, nq = tid >> 6; float acc[4] = {0.f, 0.f, 0.f, 0.f};
#pragma unroll 4
            for (int n = nq * 64; n < nq * 64 + 64; ++n) { const float vv = VC[(size_t)n * 64 + d];
#pragma unroll
                for (int g = 0; g < 4; ++g) acc[g] += PC[g * 512 + n] * vv; }
#pragma unroll
            for (int g = 0; g < 4; ++g) OCP[(nq * 4 + g) * 64 + d] = acc[g]; }
        __syncthreads();
        if (tid < 256) { const int g = tid >> 6, d = tid & 63;
#pragma unroll
            for (int nq = 0; nq < 8; ++nq) ocmp += OCP[(nq * 4 + g) * 64 + d];
            const int j = tid;
            if (j >= 1 && j <= 254) { const float v = IMPS[j]; int rank = 0;
                for (int jp = 1; jp <= 254; ++jp) { const float ov = IMPS[jp]; rank += (ov > v || (ov == v && jp < j)) ? 1 : 0; }
                if (rank < 13) SELB[rank] = j; }
            if (tid == 0) { SELB[13] = 0; SELB[14] = 255; SELB[15] = 256; }
        }
        __syncthreads();
    }
    float osel;
    {
        float M[4] = {NEG_BIG, NEG_BIG, NEG_BIG, NEG_BIG}, L[4] = {0.f, 0.f, 0.f, 0.f}, O[4] = {0.f, 0.f, 0.f, 0.f};
        const int* pt = (const int*)C.inp(4) + b * 128;
        for (int bi = 0; bi < 2; ++bi) {
            const int jb = __builtin_amdgcn_readfirstlane(SELB[2 * wave + bi]);
            if (jb < 256) { const int pid = pt[jb >> 1];
                const float* base = C.inp(3) + ((size_t)(l * NPOOL + pid) * 128 + (jb & 1) * 64) * 512;
                samp_block([&](int r) { return base + (size_t)r * 512; }, 64, kvh, QS, PW + wave * 256, lane, M, L, O);
            } else { const float* base = C.out + O_SEL_S + ((size_t)l * NTS + b * 4) * 512;
                samp_block([&](int r) { return base + (size_t)r * 512; }, t + 1, kvh, QS, PW + wave * 256, lane, M, L, O); }
        }
        osel = samp_combine(WST, tid, lane, wave, M, L, O);
    }
    float owin;
    {
        float M[4] = {NEG_BIG, NEG_BIG, NEG_BIG, NEG_BIG}, L[4] = {0.f, 0.f, 0.f, 0.f}, O[4] = {0.f, 0.f, 0.f, 0.f};
        const float* pre = C.inp(5) + (size_t)(l * 8 + b) * 262144;
        const float* nw = C.out + O_WIN_S + ((size_t)(l * 8 + b) * 512 + 508) * 512;
        samp_block([&](int r) { const int p = t + 1 + 64 * wave + r; return p <= 511 ? pre + (size_t)p * 512 : nw + (size_t)(p - 512) * 512; }, 64, kvh, QS, PW + wave * 256, lane, M, L, O);
        owin = samp_combine(WST, tid, lane, wave, M, L, O);
    }
    if (tid < 256) { const int g = tid >> 6, d = tid & 63, head = kvh * 4 + g;
        const float g0 = sigmoidf_(bf2f(P[m * PLD + GL_OFF + head * 3 + 0])), g1 = sigmoidf_(bf2f(P[m * PLD + GL_OFF + head * 3 + 1])), g2 = sigmoidf_(bf2f(P[m * PLD + GL_OFF + head * 3 + 2]));
        const float o = g0 * ocmp + g1 * osel + g2 * owin;
        wsp<bf16>(C, WS_MIX)[m * DM + 1024 + head * 64 + d] = (unsigned short)(pk2(o, 0.f) & 0xffffu); }
}

#ifndef C_MASK
#define C_MASK 7
#endif
constexpr int PC_SCAN_P = 128, PC_ATT_P = 512, PC_ATT_S = 128, PC_SCAN_S = 128, PC_ITEMS = PC_SCAN_P + PC_ATT_P + PC_ATT_S + PC_SCAN_S;
DI void phase_c(const Ctx& C0, int lq, int cmask = 7) {
    const int l = lq & 1;
    LAS int* slot = (LAS int*)(C0.lds + MISC_OFF + 64);
    for (;;) {
        __syncthreads();
        if (C0.tid == 0) *slot = (int)atomicAdd(C0.ctl + CW_QUEUE + 64 * lq, 1u);
        __syncthreads();
        int it = *slot;
        if (it >= PC_ITEMS) {
            if (lq != 0 || it - PC_ITEMS >= DEF_GROUPS) break;
            Ctx K = C0; { K.ws = launder_g(K.ws); K.out = launder_g(K.out); int t_ = K.tid; asm volatile("" : "+v"(t_)); K.tid = t_; K.lane = t_ & 63; K.wave = __builtin_amdgcn_readfirstlane(t_ >> 6); }
            for (int e = 0; e < 4; ++e) deferred_item(K, (it - PC_ITEMS) * 4 + e);
            continue;
        }
        Ctx K = C0; { K.ws = launder_g(K.ws); K.out = launder_g(K.out); int t_ = K.tid; asm volatile("" : "+v"(t_)); K.tid = t_; K.lane = t_ & 63; K.wave = __builtin_amdgcn_readfirstlane(t_ >> 6); }
        const Ctx& C = K;
        if (it >= PC_SCAN_P && it < PC_SCAN_P + PC_ATT_S) it += PC_ATT_P; else if (it >= PC_SCAN_P + PC_ATT_S && it < PC_SCAN_P + PC_ATT_S + PC_ATT_P) it -= PC_ATT_S;
        if (it < PC_SCAN_P || it >= PC_SCAN_P + PC_ATT_P + PC_ATT_S) {
            int row0, T, h; const float* S0; float* So;
            int cmode = 0;
            if (it < PC_SCAN_P) { const int u = it & 63, b = u >> 4; cmode = it < 64 ? 1 : 0; h = u & 15; row0 = b * 2048; T = 2048; S0 = nullptr; So = C.out + O_RW_P + ((size_t)(l * 4 + b) * 16 + h) * 4096; }
            else { const int u = it - (PC_SCAN_P + PC_ATT_P + PC_ATT_S), b = u >> 4; h = u & 15; row0 = NTP + b * 4; T = 4; S0 = C.inp(6) + ((size_t)(l * 8 + b) * 16 + h) * 4096; So = C.out + O_RW_S + ((size_t)(l * 8 + b) * 16 + h) * 4096; }
            if (cmask & 1) { if (S0) scan_head(C, l, row0, T, h, S0, So); else if (cmode) chunk_head<1>(C, l, row0 >> 11, h, So, cmode); else chunk_head<0>(C, l, row0 >> 11, h, So, 0); }
        } else if (it < PC_SCAN_P + PC_ATT_P) {
            const int u = it - PC_SCAN_P, qt = 31 - (u >> 4), bk = u & 15;
            if (cmask & 2) nsa_prompt_unit(C, l, bk >> 2, bk & 3, qt, (cmask & 8) != 0, (cmask & 16) != 0);
        } else {
            const int u = it - (PC_SCAN_P + PC_ATT_P);
            if (cmask & 4) nsa_sample_item(C, l, u >> 4, (u >> 2) & 3, u & 3);
        }
    }
    __syncthreads();
}

DI const float* xin_row(const Ctx& C, int l, size_t m) {
    if (l == 0) return m < (size_t)NTP ? C.inp(0) + m * DM : C.inp(1) + (m - NTP) * DM;
    return wsp<float>(C, WS_XF1) + m * DM;
}
DI void ln_stage_gb(const Ctx& C, const float* gw, const float* bw) {
    __syncthreads();
    { const f32x4 g4 = ((const f32x4*)gw)[C.tid], b4 = ((const f32x4*)bw)[C.tid]; ((LAS f32x4*)C.lds)[C.tid] = g4; ((LAS f32x4*)(C.lds + 8192))[C.tid] = b4; }
    __syncthreads();
}
DI void phase_e(const Ctx& C, int l) {
    const int lane = C.lane;
    const bf16* H = wsp<bf16>(C, WS_HS);
    bf16* X1B = wsp<bf16>(C, WS_X1B); const bf16* XB = wsp<bf16>(C, WS_XB);
    ln_stage_gb(C, C.inp(22) + (size_t)l * DM, C.inp(23) + (size_t)l * DM);
    const LAS f32x4* GL = (const LAS f32x4*)C.lds; const LAS f32x4* BL = (const LAS f32x4*)(C.lds + 8192);
    const int stride = C.G * NWAVES;
    f32x4 xf[8]; v2u xh[8], hh[8];
#define E_LOAD(mm) do { const v2u* hr_ = (const v2u*)(H + (size_t)(mm) * DM) + lane; \
        if (l == 0) { const f32x4* xr_ = (const f32x4*)xin_row(C, l, (mm)) + lane; _Pragma("unroll") for (int j = 0; j < 8; ++j) { xf[j] = xr_[64 * j]; hh[j] = hr_[64 * j]; } } \
        else { const v2u* xr_ = (const v2u*)(XB + (size_t)(mm) * DM) + lane; _Pragma("unroll") for (int j = 0; j < 8; ++j) { xh[j] = xr_[64 * j]; hh[j] = hr_[64 * j]; } } } while (0)
    int m = blockIdx.x * NWAVES + C.wave;
    if (m < NT) E_LOAD(m);
    for (; m < NT; m += stride) {
        f32x4 v[8]; float s = 0.f;
#pragma unroll
        for (int j = 0; j < 8; ++j) { const f32x4 hv = {bflo(hh[j].x), bfhi(hh[j].x), bflo(hh[j].y), bfhi(hh[j].y)};
            v[j] = (l == 0 ? xf[j] : (f32x4){bflo(xh[j].x), bfhi(xh[j].x), bflo(xh[j].y), bfhi(xh[j].y)}) * DN_ALPHA + hv; }
        if (m + stride < NT) E_LOAD(m + stride);
#pragma unroll
        for (int j = 0; j < 8; ++j) s += (v[j][0] + v[j][1]) + (v[j][2] + v[j][3]);
        const float mean = wave_sum(s) * (1.f / DM); float s2 = 0.f;
#pragma unroll
        for (int j = 0; j < 8; ++j) { v[j] = v[j] - mean; s2 += (v[j][0] * v[j][0] + v[j][1] * v[j][1]) + (v[j][2] * v[j][2] + v[j][3] * v[j][3]); }
        const float rstd = __builtin_amdgcn_rsqf(wave_sum(s2) * (1.f / DM) + LN_EPS);
        float am = 0.f;
#pragma unroll
        for (int j = 0; j < 8; ++j) { const f32x4 gg = GL[lane + 64 * j], bb = BL[lane + 64 * j];
            const f32x4 o = v[j] * rstd * gg + bb; v[j] = o;
            am = fmaxf(am, fmaxf(fmaxf(fabsf(o[0]), fabsf(o[1])), fmaxf(fabsf(o[2]), fabsf(o[3]))));
            v2u p; p.x = pk2(o[0], o[1]); p.y = pk2(o[2], o[3]); ((v2u*)(X1B + (size_t)m * DM))[lane + 64 * j] = p; }
        am = wave_max(am);
        const float qs = am > 0.f ? am * (1.f / 127.f) : 1.f, qi = 1.f / qs;
#pragma unroll
        for (int j = 0; j < 8; ++j) { const f32x4 x = v[j] * qi;
            ((unsigned*)(C.ws + WS_X1Q + (size_t)m * DM))[lane + 64 * j] = ((unsigned)(int)__builtin_rintf(x[0]) & 255u) | (((unsigned)(int)__builtin_rintf(x[1]) & 255u) << 8) | (((unsigned)(int)__builtin_rintf(x[2]) & 255u) << 16) | ((unsigned)(int)__builtin_rintf(x[3]) << 24); }
        if (lane == 0) wsp<float>(C, WS_XQS)[m] = qs;
    }
#undef E_LOAD
    __syncthreads();
}

DI float gelu_erf(float x) { return 0.5f * x * (1.f + erff(x * 0.70710678118654752f)); }
DI unsigned fkey(float f) { const unsigned u = __builtin_bit_cast(unsigned, f); return u ^ ((unsigned)((int)u >> 31) | 0x80000000u); }
DI int mbcnt64(unsigned long long m) { return __builtin_amdgcn_mbcnt_hi((unsigned)(m >> 32), __builtin_amdgcn_mbcnt_lo((unsigned)m, 0)); }
template <int NV, bool LANE_MAJOR> DI void top16(const unsigned (&key)[NV], bool (&sel)[NV], int (&pos)[NV]) {
    unsigned thr = 0u; bool exact = false;
    for (int bit = 31; bit >= 0; --bit) {
        const unsigned cand = thr | (1u << bit);
        int cnt = 0;
#pragma unroll
        for (int v = 0; v < NV; ++v) cnt += __builtin_popcountll(__ballot(key[v] >= cand));
        if (cnt >= 16) { thr = cand; if (cnt == 16) { exact = true; break; } }
    }
    unsigned long long sm[NV];
    if (exact) {
#pragma unroll
        for (int v = 0; v < NV; ++v) { sel[v] = key[v] >= thr; sm[v] = __ballot(sel[v]); }
    } else {
        unsigned long long eq[NV]; int ngt = 0;
#pragma unroll
        for (int v = 0; v < NV; ++v) { ngt += __builtin_popcountll(__ballot(key[v] > thr)); eq[v] = __ballot(key[v] == thr); }
        const int need = 16 - ngt;
#pragma unroll
        for (int v = 0; v < NV; ++v) { int rk;
            if (LANE_MAJOR) { rk = 0;
#pragma unroll
                for (int w = 0; w < NV; ++w) { rk += mbcnt64(eq[w]); if (w < v) rk += (int)((eq[w] >> (threadIdx.x & 63)) & 1ull); } }
            else { rk = mbcnt64(eq[v]);
#pragma unroll
                for (int w = 0; w < NV; ++w) if (w < v) rk += __builtin_popcountll(eq[w]); }
            sel[v] = key[v] > thr || (key[v] == thr && rk < need); sm[v] = __ballot(sel[v]); }
    }
    int base = 0;
#pragma unroll
    for (int v = 0; v < NV; ++v) { pos[v] = base + mbcnt64(sm[v]); base += __builtin_popcountll(sm[v]); }
}
typedef float f32x2v __attribute__((ext_vector_type(2)));
typedef int v4i __attribute__((ext_vector_type(4)));
typedef int v2i __attribute__((ext_vector_type(2)));
constexpr int PS_NSL = 16, PS_TOKG = 64, PS_NGRP = (NT + PS_TOKG - 1) / PS_TOKG;
static_assert(NT % 8 == 0, "a wave's 8 tokens of a group are all valid or all invalid");
template <int NP, int NV> DI void top16_search(const unsigned (&key)[NP][NV], unsigned (&thr)[NP], bool (&ex)[NP]) {
    int c16[NP];
#pragma unroll
    for (int p = 0; p < NP; ++p) { thr[p] = 0u; c16[p] = 64 * NV; }
    for (unsigned bm = 0x80000000u; bm != 0u; bm >>= 1) {
        unsigned cand[NP]; unsigned long long bl[NP][NV]; int cnt[NP];
#pragma unroll
        for (int p = 0; p < NP; ++p) cand[p] = thr[p] | bm;
#pragma unroll
        for (int p = 0; p < NP; ++p)
#pragma unroll
            for (int v = 0; v < NV; ++v) bl[p][v] = __ballot(key[p][v] >= cand[p]);
#pragma unroll
        for (int p = 0; p < NP; ++p) { cnt[p] = 0;
#pragma unroll
            for (int v = 0; v < NV; ++v) cnt[p] += __builtin_popcountll(bl[p][v]); }
        int diff = 0;
#pragma unroll
        for (int p = 0; p < NP; ++p) { const bool ge = cnt[p] >= 16; thr[p] = ge ? cand[p] : thr[p]; c16[p] = ge ? cnt[p] : c16[p]; diff |= c16[p] ^ 16; }
        if (diff == 0) break;
    }
#pragma unroll
    for (int p = 0; p < NP; ++p) ex[p] = c16[p] == 16;
}
template <int NV, bool LANE_MAJOR> DI void top16_finish(const unsigned (&key)[NV], unsigned thr, bool exact, bool (&sel)[NV], int (&pos)[NV]) {
    unsigned long long sm[NV];
    if (exact) {
#pragma unroll
        for (int v = 0; v < NV; ++v) { sel[v] = key[v] >= thr; sm[v] = __ballot(sel[v]); }
    } else {
        unsigned long long eq[NV]; int ngt = 0;
#pragma unroll
        for (int v = 0; v < NV; ++v) { ngt += __builtin_popcountll(__ballot(key[v] > thr)); eq[v] = __ballot(key[v] == thr); }
        const int need = 16 - ngt;
#pragma unroll
        for (int v = 0; v < NV; ++v) { int rk;
            if (LANE_MAJOR) { rk = 0;
#pragma unroll
                for (int w = 0; w < NV; ++w) { rk += mbcnt64(eq[w]); if (w < v) rk += (int)((eq[w] >> (threadIdx.x & 63)) & 1ull); } }
            else { rk = mbcnt64(eq[v]);
#pragma unroll
                for (int w = 0; w < NV; ++w) if (w < v) rk += __builtin_popcountll(eq[w]); }
            sel[v] = key[v] > thr || (key[v] == thr && rk < need); sm[v] = __ballot(sel[v]); }
    }
    int base = 0;
#pragma unroll
    for (int v = 0; v < NV; ++v) { pos[v] = base + mbcnt64(sm[v]); base += __builtin_popcountll(sm[v]); }
}
DI float row_max16(float v) { v = fmaxf(v, dppf<0xB1>(v)); v = fmaxf(v, dppf<0x4E>(v)); v = fmaxf(v, dppf<0x141>(v)); return fmaxf(v, dppf<0x140>(v)); }
DI float row_sum16(float v) { v += dppf<0xB1>(v); v += dppf<0x4E>(v); v += dppf<0x141>(v); return v + dppf<0x140>(v); }
template <int CTRL, bool BC> DI int dppi(int v) { return __builtin_amdgcn_update_dpp(0, v, CTRL, 0xF, 0xF, BC); }
DI int row_sum16i(int v) { v += dppi<0xB1, false>(v); v += dppi<0x4E, false>(v); v += dppi<0x141, false>(v); v += dppi<0x140, false>(v); return v; }
DI int row_scan16i(int v) { v += dppi<0x111, true>(v); v += dppi<0x112, true>(v); v += dppi<0x114, true>(v); v += dppi<0x118, true>(v); return v; }
DI unsigned row_max16u(unsigned v) { v = max(v, (unsigned)dppi<0xB1, false>((int)v)); v = max(v, (unsigned)dppi<0x4E, false>((int)v)); v = max(v, (unsigned)dppi<0x141, false>((int)v)); return max(v, (unsigned)dppi<0x140, false>((int)v)); }
DI unsigned row_min16u(unsigned v) { v = min(v, (unsigned)dppi<0xB1, false>((int)v)); v = min(v, (unsigned)dppi<0x4E, false>((int)v)); v = min(v, (unsigned)dppi<0x141, false>((int)v)); return min(v, (unsigned)dppi<0x140, false>((int)v)); }
template <int NK> DI unsigned row_top16_search(unsigned (&key)[NK]) {
    unsigned lm = key[0];
#pragma unroll
    for (int j = 1; j < NK; ++j) lm = max(lm, key[j]);
    const unsigned kmax = row_max16u(lm), L = row_min16u(lm), sp1 = kmax - L + 1u;
    const unsigned spw = max(max((unsigned)__builtin_amdgcn_readlane((int)sp1, 0), (unsigned)__builtin_amdgcn_readlane((int)sp1, 16)), max((unsigned)__builtin_amdgcn_readlane((int)sp1, 32), (unsigned)__builtin_amdgcn_readlane((int)sp1, 48)));
    const int B = spw == 0u ? 32 : 32 - __builtin_clz(spw);
    const unsigned M = B == 32 ? 0xFFFFFFFFu : (1u << B) - 1u, off = kmax - M, lo = L - 1u;
#pragma unroll
    for (int j = 0; j < NK; ++j) key[j] = max(key[j], lo) - off;
    unsigned thr = 0u; int c16 = 16 * NK;
    for (unsigned bm = 1u << (B - 1); bm != 0u; bm >>= 1) {
        const unsigned cand = thr | bm; int cnt = 0;
#pragma unroll
        for (int j = 0; j < NK; ++j) cnt += key[j] >= cand ? 1 : 0;
        cnt = row_sum16i(cnt);
        const bool ge = cnt >= 16; thr = ge ? cand : thr; c16 = ge ? cnt : c16;
        if (__ballot(c16 != 16) == 0ull) break;
    }
    return thr;
}
template <int NK> DI void row_top16_place(const unsigned (&key)[NK], unsigned thr, int (&pos)[NK]) {
    int cg = 0, ce = 0;
#pragma unroll
    for (int j = 0; j < NK; ++j) { cg += key[j] > thr ? 1 : 0; ce += key[j] == thr ? 1 : 0; }
    const int pk = cg | (ce << 8);
    const int exc = row_scan16i(pk) - pk, tot = row_sum16i(pk);
    int pg_ = exc & 255, pe_ = (tot & 255) + (exc >> 8);
#pragma unroll
    for (int j = 0; j < NK; ++j) { const bool g = key[j] > thr, e = key[j] == thr; pos[j] = g ? pg_ : (e ? pe_ : 16); pg_ += g ? 1 : 0; pe_ += e ? 1 : 0; }
}
DI void peer_topk(const Ctx& C, int l) {
    const int lane = C.lane, wave = C.wave, n = lane & 15, r = lane >> 4;
    LAS float* WL = (LAS float*)(C.lds + 65536 + 256 + wave * 2048 + r * 384);
    LAS int* WLi = (LAS int*)WL;
    const float* Sc = wsp<float>(C, WS_HS);
    unsigned short* EL = wsp<unsigned short>(C, WS_EL); float* GT = wsp<float>(C, WS_GT);
    static_assert(NT % 4 == 0, "token quads");
    for (int m = 4 * blockIdx.x; m < NT; m += 4 * C.G) {
        const float* sr = Sc + (size_t)(m + r) * DM + wave * 256 + 8 * n;
        f32x4 sv[2][2];
#pragma unroll
        for (int c = 0; c < 2; ++c) { sv[c][0] = *(const f32x4*)(sr + 128 * c); sv[c][1] = *(const f32x4*)(sr + 128 * c + 4); }
#pragma unroll
        for (int c = 0; c < 2; ++c) {
            unsigned key[8]; int pos[8];
#pragma unroll
            for (int j = 0; j < 8; ++j) key[j] = fkey(sv[c][j >> 2][j & 3]);
            const unsigned thr = row_top16_search<8>(key);
            row_top16_place<8>(key, thr, pos);
#pragma unroll
            for (int j = 0; j < 8; ++j) if (pos[j] < 16) { WL[32 * c + pos[j]] = sv[c][j >> 2][j & 3]; WLi[32 * c + 16 + pos[j]] = 8 * n + j; }
        }
        LDS_WAIT(); asm volatile("" ::: "memory");
        {
            const float x0 = WL[n]; const int e0 = WLi[16 + n] * 128;
            float cd[16]; unsigned key[16]; int pos[16];
#pragma unroll
            for (int q = 0; q < 4; ++q) { const f32x4 x1 = *(const LAS f32x4*)(WL + 32 + 4 * q);
#pragma unroll
                for (int e = 0; e < 4; ++e) { cd[4 * q + e] = x0 + x1[e]; key[4 * q + e] = fkey(cd[4 * q + e]); } }
            const unsigned thr = row_top16_search<16>(key);
            row_top16_place<16>(key, thr, pos);
#pragma unroll
            for (int b = 0; b < 16; ++b) if (pos[b] < 16) { WL[64 + pos[b]] = cd[b]; WLi[80 + pos[b]] = e0 + WLi[48 + b]; }
        }
        LDS_WAIT(); asm volatile("" ::: "memory");
        { const float tv = WL[64 + n];
          const float ev = expf(tv - row_max16(tv));
          const float gate = ev / row_sum16(ev);
          EL[(size_t)(m + r) * 128 + wave * 16 + n] = (unsigned short)WLi[80 + n]; GT[(size_t)(m + r) * 128 + wave * 16 + n] = gate; }
        LDS_WAIT(); asm volatile("" ::: "memory");
    }
}
template <int SIDE> DI void peer_sliced(const Ctx& C, int l, int lq) {
    const int tid = C.tid, lane = C.lane, wave = C.wave, pg = lane >> 3, dq = lane & 7;
    LAS int* slot = (LAS int*)(C.lds + MISC_OFF + 64);
    const unsigned char* TAB = C.ws + (SIDE ? WS_VB : WS_UB) + (size_t)l * NEXP * DM;
    const unsigned char* X1Q = C.ws + WS_X1Q;
    const unsigned short* EL = wsp<unsigned short>(C, WS_EL); const float* WP = wsp<float>(C, WS_WP);
    bf16* PD = wsp<bf16>(C, WS_PD); bf16* FO = wsp<bf16>(C, WS_FO);
    unsigned* const Q0 = C.ctl + CW_SQ + 64 * ((lq * 2 + SIDE) * 16);
    const int s_first = (int)((2u * xb_xcc_id()) & (PS_NSL - 1));
    int k = 0;
    for (;;) {
        __syncthreads();
        if (tid == 0) { int got = -1;
            while (k < PS_NSL) { const int s = (s_first + k) & (PS_NSL - 1); const unsigned g = atomicAdd(Q0 + 64 * s, 1u); if (g < (unsigned)PS_NGRP) { got = (s << 16) | (int)g; break; } ++k; }
            *slot = got; }
        __syncthreads();
        const int d = __builtin_amdgcn_readfirstlane(*slot);
        if (d < 0) break;
        const int s = d >> 16, g = d & 0xffff;
        const int t0 = g * PS_TOKG + wave * 8;
        if (t0 >= NT) continue;
        const unsigned char* TS = TAB + (size_t)s * NEXP * 128;
        const unsigned dq16 = (unsigned)dq * 16u;
        v4u E[2][2]; v4u R[2][16]; f32x4 A[2][4]; v4u AQ[2];
        LAS unsigned char* const WB = C.lds + wave * 4352;
        const int wofs = pg * 512 + dq * 64, rofs = (lane >> 3) * 64 + 16 * (((lane & 7) >> 1) ^ ((lane >> 3) & 3)) + 8 * (lane & 1);
#define PS_LOAD_E(b, t) do { const v4u* ep_ = (const v4u*)(EL + (size_t)(t) * 128 + 16 * pg); E[b][0] = ep_[0]; E[b][1] = ep_[1]; } while (0)
#define PS_LOAD_R(b, t) do { \
            _Pragma("unroll") for (int i = 0; i < 16; ++i) { const unsigned w_ = E[b][i >> 3][(i >> 1) & 3]; const unsigned e_ = (i & 1) ? (w_ >> 16) : (w_ & 0xffffu); \
                R[b][i] = *(const v4u*)(TS + ((e_ << 7) | dq16)); } \
            if (SIDE == 0) AQ[b] = *(const v4u*)(X1Q + (size_t)(t) * DM + 128 * s + 16 * dq); \
            else { const f32x4* ap_ = (const f32x4*)(WP + (size_t)(t) * 128 + 16 * pg); _Pragma("unroll") for (int q = 0; q < 4; ++q) A[b][q] = ap_[q]; } } while (0)
        PS_LOAD_E(0, t0); PS_LOAD_E(1, t0 + 1);
        PS_LOAD_R(0, t0);
#pragma unroll
        for (int j = 0; j < 8; ++j) {
            const int b = j & 1, t = t0 + j;
            if (j + 2 < 8) PS_LOAD_E(b, t + 2);
            if (j + 1 < 8) PS_LOAD_R(b ^ 1, t + 1);
            __builtin_amdgcn_sched_barrier(0);
            if (SIDE == 0) {
                int dd[16];
#pragma unroll
                for (int i = 0; i < 16; ++i) { int a = 0;
#pragma unroll
                    for (int q = 0; q < 4; ++q) a = __builtin_amdgcn_sdot4((int)R[b][i][q], (int)AQ[b][q], a, false);
                    dd[i] = a; }
#pragma unroll
                for (int q = 0; q < 4; ++q) *(LAS v4i*)(WB + dq * 528 + pg * 64 + 16 * q) = (v4i){dd[4 * q], dd[4 * q + 1], dd[4 * q + 2], dd[4 * q + 3]};
                v2i rs = {0, 0};
#pragma unroll
                for (int d8 = 0; d8 < 8; ++d8) rs += *(const LAS v2i*)(WB + 8 * lane + 528 * d8);
                *(unsigned*)(PD + ((size_t)t * PS_NSL + s) * 128 + 2 * lane) = pk2((float)rs.x, (float)rs.y);
            } else {
                f32x2v acc[8];
#pragma unroll
                for (int q = 0; q < 8; ++q) acc[q] = (f32x2v){0.f, 0.f};
#pragma unroll
                for (int i = 0; i < 16; ++i) { const float w = A[b][i >> 2][i & 3]; const f32x2v w2 = {w, w};
#pragma unroll
                    for (int q = 0; q < 4; ++q) { const int wd = (int)R[b][i][q]; acc[2 * q] += w2 * __builtin_amdgcn_cvt_pk_f32_fp8(wd, false); acc[2 * q + 1] += w2 * __builtin_amdgcn_cvt_pk_f32_fp8(wd, true); } }
#pragma unroll
                for (int q = 0; q < 4; ++q) *(LAS f32x4*)(WB + wofs + 16 * (q ^ (dq & 3))) = (f32x4){acc[2 * q].x, acc[2 * q].y, acc[2 * q + 1].x, acc[2 * q + 1].y};
                f32x2v rs = {0.f, 0.f};
#pragma unroll
                for (int h8 = 0; h8 < 8; ++h8) rs += *(const LAS f32x2v*)(WB + rofs + 512 * h8);
                *(unsigned*)(FO + (size_t)t * DM + 128 * s + 2 * lane) = pk2(rs.x, rs.y);
            }
        }
#undef PS_LOAD_E
#undef PS_LOAD_R
    }
}
DI void peer_gelu(const Ctx& C, int l) {
    const unsigned short* EL = wsp<unsigned short>(C, WS_EL); const float* GT = wsp<float>(C, WS_GT); const bf16* PD = wsp<bf16>(C, WS_PD); float* WP = wsp<float>(C, WS_WP);
    const float* USC = wsp<float>(C, WS_USC) + (size_t)l * NEXP; const float* VSC = USC + 2 * NEXP; const float* XQS = wsp<float>(C, WS_XQS);
    for (int idx = blockIdx.x * NTHREADS + C.tid; idx < NT * 128; idx += C.G * NTHREADS) {
        const int t = idx >> 7, p = idx & 127; const unsigned e = EL[idx];
        float h = 0.f;
#pragma unroll
        for (int s = 0; s < PS_NSL; ++s) h += bf2f(PD[((size_t)t * PS_NSL + s) * 128 + p]);
        WP[idx] = GT[idx] * gelu_erf(h * USC[e] * XQS[t]) * VSC[e];
    }
}
DI void peer_ln2(const Ctx& C, int l) {
    const int lane = C.lane;
    const bf16* X1B = wsp<bf16>(C, WS_X1B); const bf16* FO = wsp<bf16>(C, WS_FO);
    ln_stage_gb(C, C.inp(28) + (size_t)l * DM, C.inp(29) + (size_t)l * DM);
    const LAS f32x4* GL = (const LAS f32x4*)C.lds; const LAS f32x4* BL = (const LAS f32x4*)(C.lds + 8192);
    const int stride = C.G * NWAVES;
    v2u xh[8], fh[8];
#define G5_LOAD(mm) do { const v2u* xr_ = (const v2u*)(X1B + (size_t)(mm) * DM) + lane; const v2u* fr_ = (const v2u*)(FO + (size_t)(mm) * DM) + lane; \
        _Pragma("unroll") for (int j = 0; j < 8; ++j) { xh[j] = xr_[64 * j]; fh[j] = fr_[64 * j]; } } while (0)
    int m = blockIdx.x * NWAVES + C.wave;
    if (m < NT) G5_LOAD(m);
    for (; m < NT; m += stride) {
        f32x4 v[8]; float s = 0.f;
#pragma unroll
        for (int j = 0; j < 8; ++j) { v[j] = (f32x4){bflo(xh[j].x), bfhi(xh[j].x), bflo(xh[j].y), bfhi(xh[j].y)} * DN_ALPHA + (f32x4){bflo(fh[j].x), bfhi(fh[j].x), bflo(fh[j].y), bfhi(fh[j].y)}; s += (v[j][0] + v[j][1]) + (v[j][2] + v[j][3]); }
        if (m + stride < NT) G5_LOAD(m + stride);
        const float mean = wave_sum(s) * (1.f / DM); float s2 = 0.f;
#pragma unroll
        for (int j = 0; j < 8; ++j) { v[j] = v[j] - mean; s2 += (v[j][0] * v[j][0] + v[j][1] * v[j][1]) + (v[j][2] * v[j][2] + v[j][3] * v[j][3]); }
        const float rstd = __builtin_amdgcn_rsqf(wave_sum(s2) * (1.f / DM) + LN_EPS);
#pragma unroll
        for (int j = 0; j < 8; ++j) { const f32x4 gg = GL[lane + 64 * j], bb = BL[lane + 64 * j];
            const f32x4 o = v[j] * rstd * gg + bb;
            if (l == 0) {
                v2u p; p.x = pk2(o[0], o[1]); p.y = pk2(o[2], o[3]); ((v2u*)(wsp<bf16>(C, WS_XB) + (size_t)m * DM))[lane + 64 * j] = p; }
            else { float* dst = m < NTP ? C.out + O_YP + (size_t)m * DM : C.out + O_YS + (size_t)(m - NTP) * DM; ((f32x4*)dst)[lane + 64 * j] = o; } }
    }
#undef G5_LOAD
    __syncthreads();
}

#ifndef PH_MASK
#define PH_MASK 0xFF
#endif
#define IN(k) (lo <= (k) && (k) < hi)
#define EN(s) ((PH_MASK >> (s)) & 1)
#define FRESH(CX) Ctx CX = C; { CX.ws = launder_g(CX.ws); CX.out = launder_g(CX.out); int t_ = CX.tid; asm volatile("" : "+v"(t_)); CX.tid = t_; CX.lane = t_ & 63; CX.wave = __builtin_amdgcn_readfirstlane(t_ >> 6); CX.ctl = (unsigned*)(CX.ws + WS_CTL); }
#ifndef PROBE_REP
#define PROBE_REP 0
#endif
#ifndef PROBE_PMASK
#define PROBE_PMASK 31
#endif
#ifndef PROBE_CMASK
#define PROBE_CMASK 7
#endif
#define NREP(s) (((PROBE_REP >> (s)) & 1) ? 2 : 1)
#ifndef PROBE_G
#define PROBE_G 0
#endif
#define GREP(s) (((PROBE_G >> (s)) & 1) ? 2 : 1)
#define REPBAR(s, rep) do { if (NREP(s) == 2 && (rep) == 0 && (hi - lo) > 1) xcd_barrier(bar); } while (0)
#define SEAM(k) do { if (IN(k) && IN((k) + 1)) xcd_barrier(bar); } while (0)
template <int l> DI void run_layer(const Ctx& C, const XcdBarrier& bar, int lo, int hi) {
        const int pb = 1 + 11 * l;
        _Pragma("unroll") for (int rep = 0; rep < NREP(0); ++rep) if (EN(0) && IN(pb + 0)) {
            FRESH(K);
            pg8::Gemm g{wsp<bf16>(K, WS_XB), wsp<bf16>(K, WS_WIN) + (size_t)l * PLD * DM, NTP, PLD, DM}; pg8::StaticOrder S; S.init(NTP, PLD, K.G, (int)blockIdx.x);
            EpiInProj E{wsp<bf16>(K, WS_PROJ), K.out, l};
            pg8::gemm_phase<EpiInProj, pg8::StaticOrder, true, true>(K.lds, g, S, E);
            { bf16* P = wsp<bf16>(K, WS_PROJ); float* out = K.out;
              skinny_gemm(K, wsp<bf16>(K, WS_XB) + (size_t)NTP * DM, wsp<bf16>(K, WS_WIN) + (size_t)l * PLD * DM, (IN_COLS + 31) / 32, [&](int j, int col, float v) {
                  P[(size_t)(NTP + j) * PLD + col] = (unsigned short)(pk2(v, 0.f) & 0xffffu);
                  const int b = j >> 2, t = j & 3;
                  if (col < RW_COLS) { if (t == 3) out[O_SH_S + (size_t)(l * 8 + b) * RW_COLS + col] = v; }
                  else if (col >= KC_OFF && col < GL_OFF) { const int c = col - KC_OFF, reg = c >> 9, cc = c & 511;
                      if (reg == 0) out[O_CMP_S + ((size_t)l * NTS + j) * 512 + cc] = v; else if (reg == 1) out[O_SEL_S + ((size_t)l * NTS + j) * 512 + cc] = v;
                      else out[O_WIN_S + ((size_t)(l * 8 + b) * 512 + 508 + t) * 512 + cc] = v; } }); }
            REPBAR(0, rep);
        }
        SEAM(pb + 0);
        _Pragma("unroll") for (int rep = 0; rep < NREP(1); ++rep) if (EN(1) && IN(pb + 1)) { FRESH(K); phase_b(K, l, l + 2 * rep); REPBAR(1, rep); }
        SEAM(pb + 1);
        _Pragma("unroll") for (int rep = 0; rep < NREP(2); ++rep) if (EN(2) && IN(pb + 2)) { FRESH(K); phase_c(K, l + 2 * rep, rep == 0 ? 7 : PROBE_CMASK); REPBAR(2, rep); }
        SEAM(pb + 2);
        _Pragma("unroll") for (int rep = 0; rep < NREP(3); ++rep) if (EN(3) && IN(pb + 3)) {
            FRESH(K);
            pg8::Gemm g{wsp<bf16>(K, WS_MIX), wsp<bf16>(K, WS_WOUT) + (size_t)l * DM * DM, NTP, DM, DM}; pg8::StaticOrder S; S.init(NTP, DM, K.G, (int)blockIdx.x);
            EpiBf16Row E{wsp<bf16>(K, WS_HS), DM};
            pg8::gemm_phase<EpiBf16Row, pg8::StaticOrder, true, true>(K.lds, g, S, E);
            { bf16* H = wsp<bf16>(K, WS_HS) + (size_t)NTP * DM;
              skinny_gemm(K, wsp<bf16>(K, WS_MIX) + (size_t)NTP * DM, wsp<bf16>(K, WS_WOUT) + (size_t)l * DM * DM, DM / 32, [&](int j, int col, float v) { H[(size_t)j * DM + col] = (unsigned short)(pk2(v, 0.f) & 0xffffu); }); }
            REPBAR(3, rep);
        }
        SEAM(pb + 3);
        _Pragma("unroll") for (int rep = 0; rep < NREP(4); ++rep) if (EN(4) && IN(pb + 4)) { FRESH(K); phase_e(K, l); REPBAR(4, rep); }
        SEAM(pb + 4);
        _Pragma("unroll") for (int rep = 0; rep < NREP(5); ++rep) if (EN(5) && IN(pb + 5)) {
            FRESH(K);
            pg8::Gemm g{wsp<bf16>(K, WS_X1B), wsp<bf16>(K, WS_W2) + (size_t)l * DM * DM, NTP, DM, DM}; pg8::StaticOrder S; S.init(NTP, DM, K.G, (int)blockIdx.x);
            pg8::EpiF32 E{wsp<float>(K, WS_HS), DM, nullptr};
            pg8::gemm_phase<pg8::EpiF32, pg8::StaticOrder, true, true>(K.lds, g, S, E);
            { float* H = wsp<float>(K, WS_HS) + (size_t)NTP * DM;
              skinny_gemm(K, wsp<bf16>(K, WS_X1B) + (size_t)NTP * DM, wsp<bf16>(K, WS_W2) + (size_t)l * DM * DM, DM / 32, [&](int j, int col, float v) { H[(size_t)j * DM + col] = v; }); }
            REPBAR(5, rep);
        }
        SEAM(pb + 5);
        _Pragma("unroll") for (int rep = 0; rep < GREP(0); ++rep) { if (IN(pb + 6)) { FRESH(K); peer_topk(K, l); } if (GREP(0) == 2 && rep == 0) xcd_barrier(bar); }
        SEAM(pb + 6);
        _Pragma("unroll") for (int rep = 0; rep < GREP(1); ++rep) { if (IN(pb + 7)) { FRESH(K); peer_sliced<0>(K, l, l + 2 * rep); } if (GREP(1) == 2 && rep == 0) xcd_barrier(bar); }
        SEAM(pb + 7);
        _Pragma("unroll") for (int rep = 0; rep < GREP(2); ++rep) { if (IN(pb + 8)) { FRESH(K); peer_gelu(K, l); } if (GREP(2) == 2 && rep == 0) xcd_barrier(bar); }
        SEAM(pb + 8);
        _Pragma("unroll") for (int rep = 0; rep < GREP(3); ++rep) { if (IN(pb + 9)) { FRESH(K); peer_sliced<1>(K, l, l + 2 * rep); } if (GREP(3) == 2 && rep == 0) xcd_barrier(bar); }
        SEAM(pb + 9);
        _Pragma("unroll") for (int rep = 0; rep < GREP(4); ++rep) { if (IN(pb + 10)) { FRESH(K); peer_ln2(K, l); } if (GREP(4) == 2 && rep == 0) xcd_barrier(bar); }
        SEAM(pb + 10);
}
typedef ArgsK Args;
__global__ void __launch_bounds__(NTHREADS, 2) fwd_kernel(Args args) {
    extern __shared__ __attribute__((aligned(16))) unsigned char lds[];
    Ctx C;
    C.out = args.out; C.ws = args.ws; C.lds = (LAS unsigned char*)lds; C.ctl = (unsigned*)(args.ws + WS_CTL);
    C.tid = threadIdx.x; C.lane = C.tid & 63; C.wave = __builtin_amdgcn_readfirstlane(C.tid >> 6); C.G = gridDim.x;
    volatile LAS unsigned* MISC = (volatile LAS unsigned*)(C.lds + MISC_OFF);
    for (int u = C.tid; u < (LDS_BYTES - RING_BYTES) / 4; u += NTHREADS) ((LAS unsigned*)(C.lds + RING_BYTES))[u] = 0u;
    __syncthreads();
    XcdBarrier bar; bar.bar = C.ctl + CW_BAR; bar.x = 0; bar.st = nullptr;
    if (args.use_bar) bar = xcd_barrier_post(C.ctl + CW_BAR, MISC + 8);
    const int lo = args.ph_lo, hi = args.ph_hi;
#ifdef PROBE_DELAY_TICKS
    { const unsigned long long t0 = __builtin_amdgcn_s_memrealtime(); while (__builtin_amdgcn_s_memrealtime() - t0 < (unsigned long long)PROBE_DELAY_TICKS) __builtin_amdgcn_s_sleep(32); }
#endif
#ifdef PROBE_AMPLIFY
    { const unsigned long long t0 = __builtin_amdgcn_s_memrealtime(); xcd_barrier(bar);
      if (blockIdx.x == PROBE_AMPLIFY - 1) { const unsigned long long dt = __builtin_amdgcn_s_memrealtime() - t0; while (__builtin_amdgcn_s_memrealtime() - t0 < 5ull * dt) __builtin_amdgcn_s_sleep(32); } }
#endif
    _Pragma("unroll") for (int rep = 0; rep < NREP(7); ++rep) if (EN(7) && IN(0)) { FRESH(K); p0_prologue(K, NREP(7) == 1 ? 31 : (rep == 0 ? PROBE_PMASK : (31 & ~PROBE_PMASK))); REPBAR(7, rep); }
    SEAM(0);
    run_layer<0>(C, bar, lo, hi);
    run_layer<1>(C, bar, lo, hi);
#undef IN
#undef SEAM
}

#ifndef MK_ONE_LAUNCH
#define MK_ONE_LAUNCH 1
#endif
extern "C" void kernel_launch(void* const* d_in, const int* in_sizes, int n_in, void* d_out, int out_size, void* d_ws, size_t ws_size, hipStream_t stream) {
    static int grid = 0;
    if (grid == 0) {
        if (n_in != 30 || out_size != (int)O_END || ws_size < WS_END) { fprintf(stderr, "kernel_launch: unexpected shapes (n_in %d, out %d, ws %zu < %zu); nothing launched\n", n_in, out_size, ws_size, (size_t)WS_END); grid = -1; return; }
        int dev = 0, cus = 0, per_cu = 0;
        if (hipGetDevice(&dev) != hipSuccess || hipDeviceGetAttribute(&cus, hipDeviceAttributeMultiprocessorCount, dev) != hipSuccess) { grid = -1; return; }
        if (hipFuncSetAttribute((const void*)fwd_kernel, hipFuncAttributeMaxDynamicSharedMemorySize, LDS_BYTES) != hipSuccess) { fprintf(stderr, "kernel_launch: hipFuncSetAttribute failed\n"); grid = -1; return; }
        if (hipOccupancyMaxActiveBlocksPerMultiprocessor(&per_cu, (const void*)fwd_kernel, NTHREADS, LDS_BYTES) != hipSuccess || per_cu < 1) { fprintf(stderr, "kernel_launch: occupancy query says %d blocks per CU\n", per_cu); }
        (void)hipGetLastError();
        grid = cus;
    }
    if (grid < 0) return;
    if (hipMemsetAsync((char*)d_ws + WS_CTL, 0, CTL_ZERO_BYTES, stream) != hipSuccess) return;
    Args a{};
    for (int i = 0; i < 30; ++i) a.in[i] = (const float*)d_in[i];
    a.out = (float*)d_out; a.ws = (unsigned char*)d_ws;
#if MK_ONE_LAUNCH
    a.ph_lo = 0; a.ph_hi = N_PHASES; a.use_bar = 1;
    hipLaunchKernelGGL(fwd_kernel, dim3(grid), dim3(NTHREADS), LDS_BYTES, stream, a);
#else
    for (int p = 0; p < N_PHASES; ++p) { a.ph_lo = p; a.ph_hi = p + 1; a.use_bar = 0; hipLaunchKernelGGL(fwd_kernel, dim3(grid), dim3(NTHREADS), LDS_BYTES, stream, a); }
#endif
}
```

```cpp
#include <hip/hip_runtime.h>
#include <cstdio>
#include <cstdint>
namespace pg8 {
#define PG8_LAS __attribute__((address_space(3)))
typedef unsigned short bf16_t;
typedef short bf16x8 __attribute__((ext_vector_type(8)));
typedef float f32x4 __attribute__((ext_vector_type(4)));
typedef unsigned u32x4 __attribute__((ext_vector_type(4)));
constexpr int BM = 256, BK = 64, HALF = 128, HTB = HALF * BK * 2  , STAGE_BYTES = 8 * HTB, NXCD = 8, WGM = 8;

__host__ __device__ __forceinline__ int lds_byte(int r, int c) { const int st = (r >> 4) * 2 + (c >> 5), rr = r & 15, cc = c & 31, ob = rr * 64 + cc * 2; return st * 1024 + (ob ^ (((ob >> 9) & 1) << 5)); }
__host__ __device__ __forceinline__ void stage_rc(int b, int& R, int& C) { const int st = b / 1024, sb = b % 1024, swz = sb ^ (((sb >> 9) & 1) << 5); R = (st >> 1) * 16 + swz / 64; C = (st & 1) * 32 + (swz % 64) / 2; }
__host__ __device__ __forceinline__ int perm32(int rho) { const int n = rho >> 4, i = rho & 15; return 8 * (i >> 2) + 4 * n + (i & 3); }

struct Unit { int pm, pn; };
struct Gemm { const bf16_t* A; const bf16_t* Bt; int M, N, K; };

struct StaticOrder {
    int nM, nN, nwg, G, c;
    __host__ __device__ void init(int M, int N, int G_, int c_) { nM = M / BM; nN = N / BM; nwg = nM * nN; G = G_; c = c_; }
    __host__ __device__ bool next(int i, Unit& u) const {
        const long L = (long)i * G + c; if (L >= nwg) return false;
        int wgid = (int)L; { const int q = nwg / NXCD, r = nwg % NXCD, xcd = wgid % NXCD, off = wgid / NXCD; wgid = (xcd < r ? xcd * (q + 1) : r * (q + 1) + (xcd - r) * q) + off; }
        const int nig = WGM * nN, gid = wgid / nig, fm = gid * WGM, gsz = (nM - fm) < WGM ? (nM - fm) : WGM;
        u.pm = fm + ((wgid % nig) % gsz); u.pn = (wgid % nig) / gsz; return true;
    }
    __device__ __forceinline__ void a_ready(const Unit&) const {}
    __device__ __forceinline__ void done(const Unit&) const {}
};

__device__ __forceinline__ unsigned cvt_pk_bf16(float lo, float hi) { unsigned r; asm volatile("v_cvt_pk_bf16_f32 %0, %1, %2" : "=v"(r) : "v"(lo), "v"(hi)); return r; }
typedef float f32x2 __attribute__((ext_vector_type(2)));
struct EpiF32 {
    static constexpr bool PERM = false, AFTER_DRAIN = false;
    float* C; int ldc; const float* bias;
    __device__ __forceinline__ void operator()(const f32x4 (&acc)[2][2][4][2], const Unit& u, int wr, int wc, int fr, int fq) const {
        const int row0 = u.pm * BM + wr * 64 + fr, col0 = u.pn * BM + wc * 32 + 4 * fq;
        f32x4 bv[2][2];
#pragma unroll
        for (int bj = 0; bj < 2; ++bj)
#pragma unroll
            for (int n = 0; n < 2; ++n) bv[bj][n] = bias ? *(const f32x4*)(bias + col0 + bj * HALF + n * 16) : (f32x4){0.f, 0.f, 0.f, 0.f};
#pragma unroll
        for (int ai = 0; ai < 2; ++ai)
#pragma unroll
            for (int m = 0; m < 4; ++m) { float* rowp = C + (size_t)(row0 + ai * HALF + m * 16) * ldc + col0;
#pragma unroll
                for (int bj = 0; bj < 2; ++bj)
#pragma unroll
                    for (int n = 0; n < 2; ++n) *(f32x4*)(rowp + bj * HALF + n * 16) = acc[ai][bj][m][n] + bv[bj][n]; }
    }
};
template <class Epi, class Sched, bool ALIGN_EPI = false, bool SP2 = false>
__device__ __forceinline__ void gemm_phase(PG8_LAS unsigned char* lds, const Gemm g, const Sched& S, const Epi& E) {
    const int tid = threadIdx.x, wid = __builtin_amdgcn_readfirstlane(tid >> 6), lane = tid & 63, wr = wid >> 2, wc = wid & 3, fr = lane & 15, fq = lane >> 4;
    const int K = g.K, nt = K / BK;
    unsigned voffA[2], voffB[2];
#pragma unroll
    for (int i = 0; i < 2; ++i) { int R, C; stage_rc(tid * 16 + i * 8192, R, C); const int Rb = Epi::PERM ? ((R & ~31) + perm32(R & 31)) : R;
        voffA[i] = (unsigned)(R * K + C) * 2u; voffB[i] = (unsigned)(Rb * K + C) * 2u; }
    const size_t kstep = (size_t)(BK * 2);
    const size_t hstep = (size_t)HALF * K * 2;
    const size_t tstep = 2 * hstep;
    const unsigned ldsw = (unsigned)wid * 1024u;
    const int aoff = lds_byte(wr * 64 + fr, fq * 8), boff = lds_byte(wc * 32 + fr, fq * 8);
#define PG8_SA(b, h) (((b) * 2 + (h)) * HTB)
#define PG8_SB(b, h) ((4 + (b) * 2 + (h)) * HTB)
#define PG8_STAGE(bufoff, gbase, voff) do { _Pragma("unroll") for (int _i = 0; _i < 2; ++_i) \
        __builtin_amdgcn_global_load_lds((const unsigned*)((const char*)(gbase) + (voff)[_i]), (PG8_LAS unsigned*)(lds + (bufoff) + ldsw + _i * 8192), 16, 0, 0); } while (0)
#define PG8_LDA(dst, b, h) do { _Pragma("unroll") for (int m = 0; m < 4; ++m) _Pragma("unroll") for (int k = 0; k < 2; ++k) dst[m][k] = *(const PG8_LAS bf16x8*)(lds + PG8_SA(b, h) + aoff + m * 2048 + k * 1024); } while (0)
#define PG8_LDB(dst, b, h) do { _Pragma("unroll") for (int n = 0; n < 2; ++n) _Pragma("unroll") for (int k = 0; k < 2; ++k) dst[n][k] = *(const PG8_LAS bf16x8*)(lds + PG8_SB(b, h) + boff + n * 2048 + k * 1024); } while (0)
#define PG8_MMA(ai, bj, At, Bt) do { __builtin_amdgcn_s_setprio(1); _Pragma("unroll") for (int m = 0; m < 4; ++m) _Pragma("unroll") for (int n = 0; n < 2; ++n) _Pragma("unroll") for (int k = 0; k < 2; ++k) \
        acc[ai][bj][m][n] = __builtin_amdgcn_mfma_f32_16x16x32_bf16(Bt[n][k], At[m][k], acc[ai][bj][m][n], 0, 0, 0); __builtin_amdgcn_s_setprio(0); } while (0)
#define PG8_WAIT_V(n) asm volatile("s_waitcnt vmcnt(" #n ")" ::: "memory")
#define PG8_WAIT_L(n) asm volatile("s_waitcnt lgkmcnt(" #n ")" ::: "memory")
#define PG8_BAR __builtin_amdgcn_s_barrier()
#define PG8_SCHED __builtin_amdgcn_sched_barrier(0)
    Unit cur, nxt; int ui = 0;
    if (!S.next(0, cur)) return;
    f32x4 acc[2][2][4][2];
#pragma unroll
    for (int a = 0; a < 2; ++a)
#pragma unroll
        for (int b = 0; b < 2; ++b)
#pragma unroll
            for (int m = 0; m < 4; ++m)
#pragma unroll
                for (int n = 0; n < 2; ++n) acc[a][b][m][n] = (f32x4){0.f, 0.f, 0.f, 0.f};
    bf16x8 At[4][2], B0[2][2], B1[2][2];
    const char* cA = (const char*)g.A + (size_t)cur.pm * tstep; const char* cB = (const char*)g.Bt + (size_t)cur.pn * tstep;
    S.a_ready(cur);
    if constexpr (SP2) {
        PG8_STAGE(PG8_SB(0, 0), cB, voffB); PG8_STAGE(PG8_SB(0, 1), cB + hstep, voffB); PG8_STAGE(PG8_SA(0, 0), cA, voffA); PG8_STAGE(PG8_SA(0, 1), cA + hstep, voffA);
        if (wr == 1) PG8_BAR;
        PG8_WAIT_V(2); PG8_BAR;
        PG8_STAGE(PG8_SB(1, 0), cB + kstep, voffB); PG8_STAGE(PG8_SA(1, 0), cA + kstep, voffA); PG8_STAGE(PG8_SB(1, 1), cB + hstep + kstep, voffB);
        PG8_WAIT_V(6); PG8_BAR;
    } else {
        PG8_STAGE(PG8_SB(0, 0), cB, voffB); PG8_STAGE(PG8_SA(0, 0), cA, voffA); PG8_STAGE(PG8_SB(0, 1), cB + hstep, voffB); PG8_STAGE(PG8_SA(0, 1), cA + hstep, voffA);
        if (wr == 1) PG8_BAR;
        PG8_WAIT_V(4); PG8_BAR;
        PG8_STAGE(PG8_SB(1, 0), cB + kstep, voffB); PG8_STAGE(PG8_SA(1, 0), cA + kstep, voffA); PG8_STAGE(PG8_SB(1, 1), cB + hstep + kstep, voffB);
        PG8_WAIT_V(6); PG8_BAR;
    }
    for (;;) {
        const bool has_next = S.next(ui + 1, nxt);
        const char* nA = has_next ? (const char*)g.A + (size_t)nxt.pm * tstep : cA; const char* nB = has_next ? (const char*)g.Bt + (size_t)nxt.pn * tstep : cB;
        for (int t = 0; t < nt; t += 2) {
            const bool last = (t == nt - 2);
            const char* a1 = cA + (size_t)(t + 1) * kstep;
            const char* a2 = last ? nA : cA + (size_t)(t + 2) * kstep; const char* b2 = last ? nB : cB + (size_t)(t + 2) * kstep;
            const char* a3 = a2 + kstep; const char* b3 = b2 + kstep;
            if (last && has_next) S.a_ready(nxt);
            if constexpr (SP2) {
            PG8_LDB(B0, 0, 0); PG8_LDB(B1, 0, 1); PG8_SCHED; PG8_LDA(At, 0, 0); PG8_STAGE(PG8_SA(1, 1), a1 + hstep, voffA);
            PG8_WAIT_V(8); PG8_WAIT_L(0); PG8_BAR; PG8_MMA(0, 0, At, B0); PG8_MMA(0, 1, At, B1); PG8_BAR; PG8_SCHED;
            PG8_LDA(At, 0, 1); PG8_STAGE(PG8_SB(0, 0), b2, voffB); PG8_STAGE(PG8_SB(0, 1), b2 + hstep, voffB); PG8_STAGE(PG8_SA(0, 0), a2, voffA);
            PG8_WAIT_V(8); PG8_WAIT_L(0); PG8_BAR; PG8_MMA(1, 0, At, B0); PG8_MMA(1, 1, At, B1); PG8_BAR; PG8_SCHED;
            PG8_LDB(B0, 1, 0); PG8_LDB(B1, 1, 1); PG8_SCHED; PG8_LDA(At, 1, 0); PG8_STAGE(PG8_SA(0, 1), a2 + hstep, voffA);
            PG8_WAIT_V(8); PG8_WAIT_L(0); PG8_BAR; PG8_MMA(0, 0, At, B0); PG8_MMA(0, 1, At, B1); PG8_BAR; PG8_SCHED;
            PG8_LDA(At, 1, 1); PG8_STAGE(PG8_SB(1, 0), b3, voffB); PG8_STAGE(PG8_SB(1, 1), b3 + hstep, voffB); PG8_STAGE(PG8_SA(1, 0), a3, voffA);
            PG8_WAIT_V(8); PG8_WAIT_L(0); PG8_BAR; PG8_MMA(1, 0, At, B0); PG8_MMA(1, 1, At, B1); PG8_BAR; PG8_SCHED;
            } else {
            PG8_LDB(B0, 0, 0); PG8_SCHED; PG8_LDA(At, 0, 0); PG8_STAGE(PG8_SA(1, 1), a1 + hstep, voffA);
            PG8_WAIT_L(8); PG8_BAR; PG8_WAIT_L(0); PG8_MMA(0, 0, At, B0); PG8_BAR; PG8_SCHED;
            PG8_LDB(B1, 0, 1); PG8_STAGE(PG8_SB(0, 0), b2, voffB);
            PG8_BAR; PG8_WAIT_L(0); PG8_MMA(0, 1, At, B1); PG8_BAR;
            PG8_LDA(At, 0, 1); PG8_STAGE(PG8_SA(0, 0), a2, voffA);
            PG8_BAR; PG8_WAIT_L(0); PG8_MMA(1, 0, At, B0); PG8_BAR; PG8_SCHED;
            PG8_STAGE(PG8_SB(0, 1), b2 + hstep, voffB);
            PG8_WAIT_V(6); PG8_BAR; PG8_MMA(1, 1, At, B1); PG8_BAR;
            PG8_LDB(B0, 1, 0); PG8_SCHED; PG8_LDA(At, 1, 0); PG8_STAGE(PG8_SA(0, 1), a2 + hstep, voffA);
            PG8_WAIT_L(8); PG8_BAR; PG8_WAIT_L(0); PG8_MMA(0, 0, At, B0); PG8_BAR; PG8_SCHED;
            PG8_LDB(B1, 1, 1); PG8_STAGE(PG8_SB(1, 0), b3, voffB);
            PG8_BAR; PG8_WAIT_L(0); PG8_MMA(0, 1, At, B1); PG8_BAR;
            PG8_LDA(At, 1, 1); PG8_STAGE(PG8_SA(1, 0), a3, voffA);
            PG8_BAR; PG8_WAIT_L(0); PG8_MMA(1, 0, At, B0); PG8_BAR; PG8_SCHED;
            PG8_STAGE(PG8_SB(1, 1), b3 + hstep, voffB);
            PG8_WAIT_V(6); PG8_BAR; PG8_MMA(1, 1, At, B1); PG8_BAR;
            }
        }
        if constexpr (ALIGN_EPI) { if (wr == 0) PG8_BAR; }
        if constexpr (!Epi::AFTER_DRAIN) { E(acc, cur, wr, wc, fr, fq); S.done(cur); }
        if (!has_next) break;
#pragma unroll
        for (int a = 0; a < 2; ++a)
#pragma unroll
            for (int b = 0; b < 2; ++b)
#pragma unroll
                for (int m = 0; m < 4; ++m)
#pragma unroll
                    for (int n = 0; n < 2; ++n) acc[a][b][m][n] = (f32x4){0.f, 0.f, 0.f, 0.f};
        cur = nxt; cA = nA; cB = nB; ++ui;
        if constexpr (ALIGN_EPI) { if (wr == 1) PG8_BAR; }
    }
    PG8_WAIT_V(0);
    if constexpr (!ALIGN_EPI) { if (wr == 0) PG8_BAR; }
    PG8_BAR;
    if constexpr (Epi::AFTER_DRAIN) { E.fused(acc, cur, wr, wc, fr, fq, lds, wid, lane); S.done(cur); }
#undef PG8_SA
#undef PG8_SB
#undef PG8_STAGE
#undef PG8_LDA
#undef PG8_LDB
#undef PG8_MMA
#undef PG8_WAIT_V
#undef PG8_WAIT_L
#undef PG8_BAR
#undef PG8_SCHED
}
}
#define LAS __attribute__((address_space(3)))
#define XB_TMO      128
#define XB_XCNT(j)  (256  + 64 * (j))
#define XB_XSUB(j)  (1280 + 64 * (j))
#define XB_XGEN(j)  (2304 + 64 * (j))
#define XB_TOP      3328
#define XB_TOPGEN   3392
#define XCD_BAR_WORDS 3456
#define XB_SPIN_CAP (1u << 18)

__device__ __forceinline__ unsigned xb_ld(unsigned* p)              { return __hip_atomic_load(p, __ATOMIC_RELAXED, __HIP_MEMORY_SCOPE_AGENT); }
__device__ __forceinline__ unsigned xb_add(unsigned* p, unsigned v) { return __hip_atomic_fetch_add(p, v, __ATOMIC_RELAXED, __HIP_MEMORY_SCOPE_AGENT); }
__device__ __forceinline__ unsigned xb_xcc_id() { return (unsigned)__builtin_amdgcn_s_getreg((3 << 11) | 20) & 0xFu; }
#define XB_SPIN(cond, bar) do { unsigned _sp = 0; while (cond) { __builtin_amdgcn_s_sleep(1); \
    if ((++_sp & 255u) == 0u) { if (xb_ld(&(bar)[XB_TMO])) break; if (_sp > XB_SPIN_CAP) { atomicAdd(&(bar)[XB_TMO], 1u); break; } } } } while (0)

struct XcdBarrier {
    unsigned* bar; unsigned x;
    volatile LAS unsigned* st;
};

__device__ __forceinline__ XcdBarrier xcd_barrier_post(unsigned* bar, volatile LAS unsigned* st) {
    XcdBarrier b; b.bar = bar; b.x = xb_xcc_id(); b.st = st;
    if (threadIdx.x == 0) (void)xb_add(&bar[XB_XCNT(b.x)], 1u);
    return b;
}
__device__ __forceinline__ void xcd_barrier_complete(unsigned* bar, unsigned x, unsigned& nloc, unsigned& nx) {
    const unsigned G = gridDim.x * gridDim.y * gridDim.z;
    unsigned sum, cnt, mine, sp = 0u;
    for (;;) {
        sum = 0u; cnt = 0u; mine = 0u;
#pragma unroll
        for (unsigned j = 0; j < 16; ++j) { const unsigned c = xb_ld(&bar[XB_XCNT(j)]); sum += c; cnt += (c > 0u) ? 1u : 0u; mine = (j == x) ? c : mine; }
        if (sum == G) break;
        __builtin_amdgcn_s_sleep(1);
        if ((++sp & 255u) == 0u) { if (xb_ld(&bar[XB_TMO])) break; if (sp > XB_SPIN_CAP) { atomicAdd(&bar[XB_TMO], 1u); break; } }
    }
    nloc = mine > 0u ? mine : 1u; nx = cnt > 0u ? cnt : 1u;
}

__device__ __forceinline__ void xcd_barrier(const XcdBarrier& b) {
    asm volatile("s_waitcnt vmcnt(0)" ::: "memory");
    __syncthreads();
    if (threadIdx.x == 0) {
        unsigned* bar = b.bar;
        __builtin_amdgcn_s_waitcnt(0);
        unsigned nloc = b.st[0], nx = b.st[1];
        if (nloc == 0u) { xcd_barrier_complete(bar, b.x, nloc, nx); b.st[0] = nloc; b.st[1] = nx; }
        const unsigned old = xb_add(&bar[XB_XSUB(b.x)], 1u);
        const unsigned gen = old / nloc;
        if (old + 1u == (gen + 1u) * nloc) {
            __builtin_amdgcn_fence(__ATOMIC_RELEASE, "agent");
            asm volatile("s_waitcnt vmcnt(0)" ::: "memory");
            const unsigned og = xb_add(&bar[XB_TOP], 1u);
            const unsigned tg = og / nx;
            if (og + 1u == (tg + 1u) * nx) xb_add(&bar[XB_TOPGEN], 1u);
            else XB_SPIN(xb_ld(&bar[XB_TOPGEN]) == tg, bar);
            __builtin_amdgcn_fence(__ATOMIC_ACQUIRE, "agent");
            xb_add(&bar[XB_XGEN(b.x)], 1u);
            asm volatile("s_waitcnt vmcnt(0)" ::: "memory");
        } else {
            XB_SPIN(xb_ld(&bar[XB_XGEN(b.x)]) == gen, bar);
            __builtin_amdgcn_fence(__ATOMIC_ACQUIRE, "agent");
            asm volatile("s_waitcnt vmcnt(0)" ::: "memory");
        }
    }
    __syncthreads();
}

constexpr int NWAVES = 8, NTHREADS = 512;
constexpr int DM = 2048, NTP = 8192, NTS = 32, NT = 8224, MP = 8448;
constexpr int RW_COLS = 3360, Q_OFF = 3360, KC_OFF = 4384, KS_OFF = 4896, VS_OFF = 5152, KW_OFF = 5408, VW_OFF = 5664, GL_OFF = 5920, IN_COLS = 5968, PLD = 6144;
constexpr int NEXP = 16384, NPOOL = 1280;
constexpr float LN_EPS = 1e-5f, GN_EPS = 64e-5f, DN_ALPHA = 1.4142135623730951f;
constexpr float NEG_BIG = -1e30f;
constexpr size_t O_YP = 0, O_YS = O_YP + (size_t)NTP * DM, O_CMP_P = O_YS + (size_t)NTS * DM, O_SEL_P = O_CMP_P + (size_t)2 * NTP * 512, O_WIN_P = O_SEL_P + (size_t)2 * NTP * 512,
                 O_RW_P = O_WIN_P + (size_t)2 * 4 * 512 * 512, O_SH_P = O_RW_P + (size_t)2 * 4 * 16 * 4096, O_CMP_S = O_SH_P + (size_t)2 * 4 * RW_COLS, O_SEL_S = O_CMP_S + (size_t)2 * NTS * 512,
                 O_WIN_S = O_SEL_S + (size_t)2 * NTS * 512, O_RW_S = O_WIN_S + (size_t)2 * 8 * 512 * 512, O_SH_S = O_RW_S + (size_t)2 * 8 * 16 * 4096, O_END = O_SH_S + (size_t)2 * 8 * RW_COLS;
static_assert(O_END == 41630464, "output size");
constexpr size_t MiB = 1ull << 20;
constexpr size_t WS_CTL = 0, CTL_ZERO_BYTES = 1 * MiB;
constexpr size_t WS_WIN = 1 * MiB;
constexpr size_t WS_WOUT = WS_WIN + 48 * MiB;
constexpr size_t WS_W2 = WS_WOUT + 16 * MiB;
constexpr size_t WS_UB = WS_W2 + 16 * MiB;
constexpr size_t WS_VB = WS_UB + 64 * MiB;
constexpr size_t WS_USC = WS_VB + 64 * MiB;
constexpr size_t WS_XB = WS_USC + 1 * MiB;
constexpr size_t WS_X1B = WS_XB + 33 * MiB;
constexpr size_t WS_XF1 = WS_X1B + 33 * MiB;
constexpr size_t WS_X1F = WS_XF1 + 65 * MiB;
constexpr size_t WS_PROJ = WS_X1F + 65 * MiB;
constexpr size_t WS_SC = WS_PROJ + 99 * MiB;
constexpr size_t SC_STRIDE = 33 * MiB;
constexpr size_t WS_GG = WS_SC + 6 * SC_STRIDE;
constexpr size_t WS_BON = WS_GG + 33 * MiB;
constexpr size_t WS_MIX = WS_BON + 1 * MiB;
constexpr size_t WS_HS = WS_MIX + 33 * MiB;
constexpr size_t WS_KCB = WS_HS + 66 * MiB;
constexpr size_t WS_VCBT = WS_KCB + 512 * 1024;
constexpr size_t WS_VTS = WS_KCB + 1 * MiB;
constexpr size_t WS_VTW = WS_VTS + 4 * MiB;
constexpr size_t WS_KCBS = WS_VTW + 4 * MiB;
constexpr size_t WS_VCBS = WS_KCBS + 17 * MiB;
constexpr size_t WS_LT = WS_VCBS + 17 * MiB;
constexpr size_t WS_KSC = WS_LT + 2 * MiB;
constexpr size_t WS_KWC = WS_KSC + 4 * MiB;
constexpr size_t WS_OPS = WS_KWC + 4 * MiB;
constexpr size_t OPS_BYTES = 51200;
constexpr size_t WS_EL = WS_OPS + 80 * MiB;
constexpr size_t WS_GT = WS_EL + 3 * MiB;
constexpr size_t WS_PD = WS_GT + 5 * MiB;
constexpr size_t WS_WP = WS_PD + 65 * MiB;
constexpr size_t WS_FO = WS_WP + 5 * MiB;
constexpr size_t WS_X1Q = WS_FO + 65 * MiB;
constexpr size_t WS_XQS = WS_X1Q + 17 * MiB;
constexpr size_t WS_END = WS_XQS + 1 * MiB;
constexpr int CW_BAR = 4096, CW_QUEUE = 8192, CW_SQ = 65536, CW_FLAG = 16384;
constexpr int RING_BYTES = 131072, MISC_OFF = RING_BYTES + 320, LDS_BYTES = 147456;
constexpr int N_PHASES = 23;

typedef unsigned short bf16;
typedef unsigned v4u __attribute__((ext_vector_type(4)));
typedef unsigned v2u __attribute__((ext_vector_type(2)));
typedef float f32x4 __attribute__((ext_vector_type(4)));
typedef float f32x16 __attribute__((ext_vector_type(16)));
typedef short bf16x8 __attribute__((ext_vector_type(8)));
typedef float f32x2_t __attribute__((ext_vector_type(2)));
typedef __bf16 bf16x2_t __attribute__((ext_vector_type(2)));
#define LDS_WAIT() asm volatile("s_waitcnt lgkmcnt(0)" ::: "memory")
#define DI __device__ __forceinline__
#define GAS __attribute__((address_space(1)))
template <class T> DI T* launder_g(T* p) { GAS T* g = (GAS T*)p; asm volatile("" : "+s"(g)); return (T*)g; }

DI unsigned pk2(float lo, float hi) { f32x2_t v = {lo, hi}; bf16x2_t b = __builtin_convertvector(v, bf16x2_t); return __builtin_bit_cast(unsigned, b); }
DI float bf2f(unsigned short u) { return __builtin_bit_cast(float, (unsigned)u << 16); }
DI float bflo(unsigned u) { return __builtin_bit_cast(float, u << 16); }
DI float bfhi(unsigned u) { return __builtin_bit_cast(float, u & 0xffff0000u); }
template <int CTRL> DI float dppf(float v) { return __builtin_bit_cast(float, __builtin_amdgcn_update_dpp(0, __builtin_bit_cast(int, v), CTRL, 0xF, 0xF, false)); }
DI float rdlane(float v, int l) { return __builtin_bit_cast(float, __builtin_amdgcn_readlane(__builtin_bit_cast(int, v), l)); }
DI float wave_sum(float v) {
    v += dppf<0xB1>(v); v += dppf<0x4E>(v); v += dppf<0x141>(v); v += dppf<0x140>(v);
    return (rdlane(v, 0) + rdlane(v, 16)) + (rdlane(v, 32) + rdlane(v, 48));
}
DI float wave_max(float v) {
    v = fmaxf(v, dppf<0xB1>(v)); v = fmaxf(v, dppf<0x4E>(v)); v = fmaxf(v, dppf<0x141>(v)); v = fmaxf(v, dppf<0x140>(v));
    return fmaxf(fmaxf(rdlane(v, 0), rdlane(v, 16)), fmaxf(rdlane(v, 32), rdlane(v, 48)));
}
DI float sigmoidf_(float x) { return 1.f / (1.f + expf(-x)); }
DI int crow(int reg, int h) { return (reg & 3) + 8 * (reg >> 2) + 4 * h; }

struct ArgsK { const float* in[30]; float* out; unsigned char* ws; int ph_lo, ph_hi, use_bar, pad; };
struct ArgsG { const GAS float* in[30]; GAS float* out; GAS unsigned char* ws; int ph_lo, ph_hi, use_bar, pad; };
typedef __attribute__((address_space(4))) const ArgsG* kargp_t;
struct Ctx {
    float* out; unsigned char* ws;
    LAS unsigned char* lds; unsigned* ctl;
    int tid, lane, wave, G;
    DI const float* inp(int k) const { kargp_t p = (kargp_t)__builtin_amdgcn_kernarg_segment_ptr(); asm volatile("" : "+s"(p)); return (const float*)p->in[k]; }
};
template <class T> DI T* wsp(const Ctx& C, size_t off) { return (T*)(C.ws + off); }

struct EpiInProj {
    static constexpr bool PERM = true, AFTER_DRAIN = false;
    bf16* P; float* out; int l;
    DI void operator()(const pg8::f32x4 (&acc)[2][2][4][2], const pg8::Unit& u, int wr, int wc, int fr, int fq) const {
        const int row0 = u.pm * 256 + wr * 64 + fr, col0 = u.pn * 256 + wc * 32 + 8 * fq;
#pragma unroll
        for (int bj = 0; bj < 2; ++bj) {
            const int colb = __builtin_amdgcn_readfirstlane(u.pn * 256 + wc * 32 + bj * 128);
            const int col = col0 + bj * 128;
            const int kind = colb < RW_COLS ? 1 : ((colb >= KC_OFF && colb < GL_OFF) ? 2 : 0);
            const int reg = (colb - KC_OFF) >> 9, cc = (col - KC_OFF) & 511;
#pragma unroll
            for (int ai = 0; ai < 2; ++ai)
#pragma unroll
                for (int m = 0; m < 4; ++m) {
                    const int row = row0 + ai * 128 + m * 16;
                    const pg8::f32x4 v0 = acc[ai][bj][m][0], v1 = acc[ai][bj][m][1];
                    v4u w; w.x = pk2(v0[0], v0[1]); w.y = pk2(v0[2], v0[3]); w.z = pk2(v1[0], v1[1]); w.w = pk2(v1[2], v1[3]);
                    *(v4u*)(P + (size_t)row * PLD + col) = w;
                    if (kind == 0 || row >= NT) continue;
                    unsigned off = 0xffffffffu;
                    if (row < NTP) { const int b = row >> 11, t = row & 2047;
                        if (kind == 1) { if (t == 2047) off = (unsigned)(O_SH_P + (size_t)(l * 4 + b) * RW_COLS + col); }
                        else if (reg == 0) off = (unsigned)(O_CMP_P + ((size_t)l * NTP + row) * 512 + cc);
                        else if (reg == 1) off = (unsigned)(O_SEL_P + ((size_t)l * NTP + row) * 512 + cc);
                        else if (t >= 1536) off = (unsigned)(O_WIN_P + ((size_t)(l * 4 + b) * 512 + (t - 1536)) * 512 + cc);
                    } else { const int j = row - NTP, b = j >> 2, t = j & 3;
                        if (kind == 1) { if (t == 3) off = (unsigned)(O_SH_S + (size_t)(l * 8 + b) * RW_COLS + col); }
                        else if (reg == 0) off = (unsigned)(O_CMP_S + ((size_t)l * NTS + j) * 512 + cc);
                        else if (reg == 1) off = (unsigned)(O_SEL_S + ((size_t)l * NTS + j) * 512 + cc);
                        else off = (unsigned)(O_WIN_S + ((size_t)(l * 8 + b) * 512 + 508 + t) * 512 + cc);
                    }
                    if (off != 0xffffffffu) { *(pg8::f32x4*)(out + off) = v0; *(pg8::f32x4*)(out + off + 4) = v1; }
                }
        }
    }
};

struct EpiBf16Row {
    static constexpr bool PERM = true, AFTER_DRAIN = false;
    bf16* Cb; int ldc;
    DI void operator()(const pg8::f32x4 (&acc)[2][2][4][2], const pg8::Unit& u, int wr, int wc, int fr, int fq) const {
        const int row0 = u.pm * 256 + wr * 64 + fr, col0 = u.pn * 256 + wc * 32 + 8 * fq;
#pragma unroll
        for (int bj = 0; bj < 2; ++bj)
#pragma unroll
            for (int ai = 0; ai < 2; ++ai)
#pragma unroll
                for (int m = 0; m < 4; ++m) { const pg8::f32x4 v0 = acc[ai][bj][m][0], v1 = acc[ai][bj][m][1];
                    v4u w; w.x = pk2(v0[0], v0[1]); w.y = pk2(v0[2], v0[3]); w.z = pk2(v1[0], v1[1]); w.w = pk2(v1[2], v1[3]);
                    *(v4u*)(Cb + (size_t)(row0 + ai * 128 + m * 16) * ldc + col0 + bj * 128) = w; }
    }
};

template <class Sink> DI void skinny_gemm(const Ctx& C, const bf16* A, const bf16* Bt, int nslabs, const Sink& sink) {
    const int tid = C.tid, lane = C.lane, wave = C.wave, r = lane & 31, hi = lane >> 5;
    LAS float* PS = (LAS float*)C.lds;
    for (int it = blockIdx.x; it < nslabs; it += C.G) {
        const int n0 = it * 32, k0 = wave * 256;
        f32x16 acc;
#pragma unroll
        for (int i = 0; i < 16; ++i) acc[i] = 0.f;
        const bf16* ap = A + (size_t)r * DM + k0 + 8 * hi; const bf16* bp = Bt + (size_t)(n0 + r) * DM + k0 + 8 * hi;
#pragma unroll 8
        for (int s = 0; s < 16; ++s) { const bf16x8 af = *(const bf16x8*)(ap + 16 * s), bf = *(const bf16x8*)(bp + 16 * s); acc = __builtin_amdgcn_mfma_f32_32x32x16_bf16(af, bf, acc, 0, 0, 0); }
        __syncthreads();
#pragma unroll
        for (int i = 0; i < 16; ++i) PS[(wave * 32 + crow(i, hi)) * 33 + r] = acc[i];
        __syncthreads();
#pragma unroll
        for (int e = 0; e < 2; ++e) { const int o = tid * 2 + e, row = o >> 5, col = o & 31; float v = 0.f;
#pragma unroll
            for (int w = 0; w < 8; ++w) v += PS[(w * 32 + row) * 33 + col];
            sink(row, n0 + col, v); }
    }
    __syncthreads();
}

DI void transpose_item(const float* W, int K, int N, int Npad, bf16* WT, LAS float* scr, int item, int lane) {
    const int nblk = Npad / 32, kb = item / nblk, nb = item % nblk, k0 = 64 * kb, n0 = 32 * nb;
    float tv[32];
#pragma unroll
    for (int i = 0; i < 32; ++i) { const int kk = 2 * i + (lane >> 5), n = n0 + (lane & 31); tv[i] = n < N ? W[(size_t)(k0 + kk) * N + n] : 0.f; }
#pragma unroll
    for (int i = 0; i < 32; ++i) { const int kk = 2 * i + (lane >> 5); scr[kk * 33 + (lane & 31)] = tv[i]; }
    LDS_WAIT(); asm volatile("" ::: "memory");
    const int c = lane & 7;
#pragma unroll
    for (int j = 0; j < 4; ++j) { const int n = (lane >> 3) + 8 * j; const LAS float* s = scr + (8 * c) * 33 + n;
        v4u o; o.x = pk2(s[0 * 33], s[1 * 33]); o.y = pk2(s[2 * 33], s[3 * 33]); o.z = pk2(s[4 * 33], s[5 * 33]); o.w = pk2(s[6 * 33], s[7 * 33]);
        *(v4u*)(WT + (size_t)(n0 + n) * K + k0 + 8 * c) = o; }
    LDS_WAIT(); asm volatile("" ::: "memory");
}


DI void p0i_table(const Ctx& C, int r) {
    const int lane = C.lane, wave = C.wave;
    f32x4 v[2][8];
#pragma unroll
    for (int h = 0; h < 2; ++h) { const int row = r * 16 + 8 * h + wave;
        const float* src = (row < 32768 ? C.inp(26) : C.inp(27)) + (size_t)(row & 32767) * DM;
#pragma unroll
        for (int k = 0; k < 2; ++k)
#pragma unroll
            for (int q = 0; q < 4; ++q) v[h][4 * k + q] = ((const f32x4*)src)[4 * lane + 256 * k + q]; }
#pragma unroll
    for (int h = 0; h < 2; ++h) { const int row = r * 16 + 8 * h + wave;
        unsigned char* dst = C.ws + (row < 32768 ? WS_UB : WS_VB) + (size_t)((row >> 14) & 1) * NEXP * DM + (size_t)(row & 16383) * 128;
        float am = 0.f;
#pragma unroll
        for (int j = 0; j < 8; ++j) am = fmaxf(am, fmaxf(fmaxf(fabsf(v[h][j][0]), fabsf(v[h][j][1])), fmaxf(fabsf(v[h][j][2]), fabsf(v[h][j][3]))));
        am = wave_max(am);
        const bool isu = row < 32768;
        const float sc = am > 0.f ? am * (isu ? 1.f / 127.f : 1.f / 256.f) : 1.f, inv = 1.f / sc;
#pragma unroll
        for (int k = 0; k < 2; ++k) { v4u o;
#pragma unroll
            for (int q = 0; q < 4; ++q) { const f32x4 x = v[h][4 * k + q] * inv;
                if (isu) o[q] = ((unsigned)(int)__builtin_rintf(x[0]) & 255u) | (((unsigned)(int)__builtin_rintf(x[1]) & 255u) << 8) | (((unsigned)(int)__builtin_rintf(x[2]) & 255u) << 16) | ((unsigned)(int)__builtin_rintf(x[3]) << 24);
                else { int p = __builtin_amdgcn_cvt_pk_fp8_f32(x[0], x[1], 0, false); p = __builtin_amdgcn_cvt_pk_fp8_f32(x[2], x[3], p, true); o[q] = (unsigned)p; } }
            *(v4u*)(dst + ((size_t)((lane >> 3) + 8 * k) * NEXP) * 128 + 16 * (lane & 7)) = o; }
        if (lane == 0) wsp<float>(C, WS_USC)[row] = sc; }
}
DI void p0i_cache(const Ctx& C, int r) {
    const int tid = C.tid;
    const int l = r >> 10, b = (r >> 7) & 7, pi = r & 127;
    const int pid = ((const int*)C.inp(4))[b * 128 + pi];
    const int q = tid >> 7, c4 = tid & 127, kv = c4 >> 6, kvh = (c4 >> 4) & 3, d0 = (c4 & 15) * 4;
    const f32x4* src = (const f32x4*)(C.inp(2) + ((size_t)(l * NPOOL + pid) * 128 + 32 * q) * 512) + c4;
    const float* w = C.inp(20) + (l * 2 + kv) * 32;
    f32x4 acc = {0.f, 0.f, 0.f, 0.f};
    f32x4 cr[32];
#pragma unroll
    for (int rr = 0; rr < 32; ++rr) cr[rr] = src[(size_t)rr * 128];
#pragma unroll
    for (int rr = 0; rr < 32; ++rr) acc += cr[rr] * w[rr];
    *(f32x4*)(wsp<float>(C, kv ? WS_VCBS : WS_KCBS) + ((size_t)((l * 8 + b) * 4 + kvh) * 512 + 4 * pi + q) * 64 + d0) = acc;
}
DI void p0i_transpose(const Ctx& C, int r) {
    const int lane = C.lane, wave = C.wave;
    const int l = r >> 10, w8 = (r & 1023) * 8 + wave;
    LAS float* scr = (LAS float*)(C.lds + wave * 16384);
    if (w8 < 6144) transpose_item(C.inp(8) + (size_t)l * DM * IN_COLS, DM, IN_COLS, PLD, wsp<bf16>(C, WS_WIN) + (size_t)l * PLD * DM, scr, w8, lane);
    else transpose_item(C.inp(21) + (size_t)l * DM * DM, DM, DM, DM, wsp<bf16>(C, WS_WOUT) + (size_t)l * DM * DM, scr, w8 - 6144, lane);
}
DI bf16x8 bf8_of(const f32x4& a, const f32x4& b) { const v4u p = {pk2(a[0], a[1]), pk2(a[2], a[3]), pk2(b[0], b[1]), pk2(b[2], b[3])}; return __builtin_bit_cast(bf16x8, p); }
DI f32x4 bf_resid(const f32x4& a, unsigned p01, unsigned p23) { return (f32x4){a[0] - bflo(p01), a[1] - bfhi(p01), a[2] - bflo(p23), a[3] - bfhi(p23)}; }
DI void p0i_w2(const Ctx& C, int r) {
    const int lane = C.lane, wave = C.wave, rr = lane & 31, hi = lane >> 5;
    const int l = r >> 9, hc = (r >> 5) & 15, kb = r & 31, kt = wave & 3, nt = wave >> 2;
    const float* sk = C.inp(25) + ((size_t)l * 16 + hc) * 16384 + (size_t)(kt * 32 + rr) * 128 + 8 * hi;
    const float* wq = C.inp(24) + (size_t)l * DM * DM + (size_t)(kb * 64 + nt * 32 + rr) * DM + hc * 128 + 8 * hi;
    f32x16 acc;
#pragma unroll
    for (int i = 0; i < 16; ++i) acc[i] = 0.f;
#pragma unroll 4
    for (int s = 0; s < 8; ++s) {
        const f32x4 a0 = *(const f32x4*)(sk + 16 * s), a1 = *(const f32x4*)(sk + 16 * s + 4), b0 = *(const f32x4*)(wq + 16 * s), b1 = *(const f32x4*)(wq + 16 * s + 4);
        const v4u ahp = {pk2(a0[0], a0[1]), pk2(a0[2], a0[3]), pk2(a1[0], a1[1]), pk2(a1[2], a1[3])}, bhp = {pk2(b0[0], b0[1]), pk2(b0[2], b0[3]), pk2(b1[0], b1[1]), pk2(b1[2], b1[3])};
        const bf16x8 ah = __builtin_bit_cast(bf16x8, ahp), bh = __builtin_bit_cast(bf16x8, bhp);
        const bf16x8 al = bf8_of(bf_resid(a0, ahp.x, ahp.y), bf_resid(a1, ahp.z, ahp.w)), bl = bf8_of(bf_resid(b0, bhp.x, bhp.y), bf_resid(b1, bhp.z, bhp.w));
        acc = __builtin_amdgcn_mfma_f32_32x32x16_bf16(ah, bh, acc, 0, 0, 0);
        acc = __builtin_amdgcn_mfma_f32_32x32x16_bf16(ah, bl, acc, 0, 0, 0);
        acc = __builtin_amdgcn_mfma_f32_32x32x16_bf16(al, bh, acc, 0, 0, 0);
    }
    bf16* W2 = wsp<bf16>(C, WS_W2) + (size_t)l * DM * DM + (size_t)(hc * 128 + kt * 32) * DM + kb * 64 + nt * 32 + rr;
#pragma unroll
    for (int i = 0; i < 16; ++i) W2[(size_t)crow(i, hi) * DM] = (unsigned short)(pk2(acc[i], 0.f) & 0xffffu);
}
constexpr int DEF_ITEMS = 4096 + 1024 + 1024 + 1024, DEF_GROUPS = DEF_ITEMS / 4;
DI void deferred_item(const Ctx& C, int i) {
    if (i < 4096) p0i_table(C, i);
    else if (i < 5120) p0i_cache(C, 1024 + (i - 4096));
    else if (i < 6144) p0i_transpose(C, 1024 + (i - 5120));
    else p0i_w2(C, i - 6144);
}

constexpr int P0_NX = 2056, P0_NWP = 508;
DI void p0_prologue(const Ctx& C, int pmask = 31) {
    const int tid = C.tid;
    LAS int* qslot = (LAS int*)(C.lds + MISC_OFF + 64);
#define P0_CLAIM 4
#define P0_BLOCK(n, qi) for (int base_ = 0; ; ) { __syncthreads(); if (tid == 0) *qslot = (int)atomicAdd(C.ctl + CW_QUEUE + 64 * (8 + (qi)), (unsigned)P0_CLAIM); __syncthreads(); base_ = *qslot; if (base_ >= (n)) break; \
        for (int r = base_, r_hi = (base_ + P0_CLAIM < (n) ? base_ + P0_CLAIM : (n)); r < r_hi; ++r)
#define P0_END }
    if (pmask & 4) P0_BLOCK(1024, 2) { p0i_transpose(C, r); } P0_END
    static_assert(P0_NX % P0_CLAIM == 0 && P0_NWP % P0_CLAIM == 0, "whole claims");
#define P0_CLAIMED(n, qi) for (int base_ = 0; ; ) { __syncthreads(); if (tid == 0) *qslot = (int)atomicAdd(C.ctl + CW_QUEUE + 64 * (8 + (qi)), (unsigned)P0_CLAIM); __syncthreads(); base_ = *qslot; if (base_ >= (n)) break;
    if (pmask & 16) P0_CLAIMED(P0_NX, 4) {
            f32x4 q_[P0_CLAIM][4];
#pragma unroll
            for (int u = 0; u < P0_CLAIM; ++u) { const size_t e0 = (size_t)(base_ + u) * 8192 + tid * 16;
                const f32x4* s4 = (const f32x4*)(e0 < (size_t)NTP * DM ? C.inp(0) + e0 : C.inp(1) + (e0 - (size_t)NTP * DM));
                q_[u][0] = s4[0]; q_[u][1] = s4[1]; q_[u][2] = s4[2]; q_[u][3] = s4[3]; }
#pragma unroll
            for (int u = 0; u < P0_CLAIM; ++u) { const size_t e0 = (size_t)(base_ + u) * 8192 + tid * 16; const f32x4 a = q_[u][0], b = q_[u][1], c = q_[u][2], d = q_[u][3];
                v4u o0, o1; o0.x = pk2(a[0], a[1]); o0.y = pk2(a[2], a[3]); o0.z = pk2(b[0], b[1]); o0.w = pk2(b[2], b[3]);
                o1.x = pk2(c[0], c[1]); o1.y = pk2(c[2], c[3]); o1.z = pk2(d[0], d[1]); o1.w = pk2(d[2], d[3]);
                v4u* d4 = (v4u*)(wsp<bf16>(C, WS_XB) + e0); d4[0] = o0; d4[1] = o1; }
        } P0_END
    if (pmask & 2) P0_BLOCK(1024, 1) { p0i_cache(C, r); } P0_END
    if (pmask & 4) P0_BLOCK(144, 6) {{
            const int g = r * 512 + tid, l = g / 36864, rem = g % 36864, c = rem / 36, kg = rem % 36;
            const float* src = kg < 8 ? C.inp(11) + ((size_t)l * 64 + kg * 8) * 1024 : (kg < 16 ? C.inp(13) + ((size_t)l * 64 + (kg - 8) * 8) * 1024 : C.inp(14) + ((size_t)l * 160 + (kg - 16) * 8) * 1024);
            float e[8];
#pragma unroll
            for (int q = 0; q < 8; ++q) e[q] = src[(size_t)q * 1024 + c];
            *(v4u*)(wsp<bf16>(C, WS_LT) + ((size_t)l * 1024 + c) * 288 + kg * 8) = (v4u){pk2(e[0], e[1]), pk2(e[2], e[3]), pk2(e[4], e[5]), pk2(e[6], e[7])};
        }} P0_END
    if (pmask & 16) P0_CLAIMED(P0_NWP, 5) {
            f32x4 q_[P0_CLAIM][4];
#pragma unroll
            for (int u = 0; u < P0_CLAIM; ++u) { const size_t i0 = (size_t)(base_ + u) * 8192 + tid * 16; const size_t lb = i0 / 260096, rem = i0 % 260096;
                const f32x4* s4 = (const f32x4*)(C.inp(5) + lb * 262144 + 2048 + rem); q_[u][0] = s4[0]; q_[u][1] = s4[1]; q_[u][2] = s4[2]; q_[u][3] = s4[3]; }
#pragma unroll
            for (int u = 0; u < P0_CLAIM; ++u) { const size_t i0 = (size_t)(base_ + u) * 8192 + tid * 16; const size_t lb = i0 / 260096, rem = i0 % 260096;
                f32x4* d4 = (f32x4*)(C.out + O_WIN_S + lb * 262144 + rem); d4[0] = q_[u][0]; d4[1] = q_[u][1]; d4[2] = q_[u][2]; d4[3] = q_[u][3]; }
        } P0_END
    __syncthreads();
}

constexpr int PB_NFULL = 484, PB_NRW = PB_NFULL + 2 * (514 - PB_NFULL), PB_NPOOL = 256, PB_NVT = 1024;
constexpr int PB_ITEMS = PB_NRW + PB_NPOOL + PB_NVT;
DI float softplusf_(float x) { return x > 20.f ? x : log1pf(expf(x)); }
DI float fexp_(float x) { return __expf(x); }
DI float fsoftplus_(float x) { return x > 20.f ? x : __logf(1.f + __expf(x)); }
DI float fsigmoid_(float x) { return __builtin_amdgcn_rcpf(1.f + __expf(-x)); }

constexpr int XSB_LD = 3088, ACTB_LD = 296, MU_OFF = 110592;
DI void rwkv_pre_item(const Ctx& C, int l, int item, int hsel) {
    const int tid = C.tid, lane = C.lane, wave = C.wave, n16 = lane & 15, rq = lane >> 4;
    LAS unsigned short* XSB = (LAS unsigned short*)C.lds;
    LAS unsigned short* ACTB = (LAS unsigned short*)(C.lds + 16 * XSB_LD * 2);
    const bf16* P = wsp<bf16>(C, WS_PROJ);
    const int m0 = item * 16;
    __syncthreads();
#pragma unroll 1
    for (int base = 0; base < 16 * 420; base += 4 * NTHREADS) {
        v4u cu[4], pu[4]; f32x4 mu0[4], mu1[4], sh0[4], sh1[4]; int jj_[4], col_[4], kind[4];
#pragma unroll
        for (int u = 0; u < 4; ++u) { const int idx = base + u * NTHREADS + tid; kind[u] = -1; jj_[u] = 0; col_[u] = 0;
            if (idx < 16 * 420) { const int j = idx / 420, col = (idx % 420) * 8, m = m0 + j; jj_[u] = j; col_[u] = col;
                cu[u] = *(const v4u*)(P + (size_t)m * PLD + col);
                const LAS f32x4* mup = (const LAS f32x4*)(C.lds + MU_OFF) + (col >> 2); mu0[u] = mup[0]; mu1[u] = mup[1];
                int t; const float* sh = nullptr;
                if (m < NTP) t = m & 2047; else { const int jq = m - NTP; t = jq & 3; sh = C.inp(7) + (size_t)(l * 8 + (jq >> 2)) * RW_COLS + col; }
                if (t > 0) { pu[u] = *(const v4u*)(P + (size_t)(m - 1) * PLD + col); kind[u] = 1; }
                else if (sh) { sh0[u] = ((const f32x4*)sh)[0]; sh1[u] = ((const f32x4*)sh)[1]; kind[u] = 2; }
                else kind[u] = 0; } }
#pragma unroll
        for (int u = 0; u < 4; ++u) if (kind[u] >= 0) {
            const int j = jj_[u], col = col_[u];
            float cur[8] = {bflo(cu[u].x), bfhi(cu[u].x), bflo(cu[u].y), bfhi(cu[u].y), bflo(cu[u].z), bfhi(cu[u].z), bflo(cu[u].w), bfhi(cu[u].w)};
            float prev[8];
            if (kind[u] == 1) { prev[0] = bflo(pu[u].x); prev[1] = bfhi(pu[u].x); prev[2] = bflo(pu[u].y); prev[3] = bfhi(pu[u].y); prev[4] = bflo(pu[u].z); prev[5] = bfhi(pu[u].z); prev[6] = bflo(pu[u].w); prev[7] = bfhi(pu[u].w); }
            else if (kind[u] == 2) {
#pragma unroll
                for (int e = 0; e < 4; ++e) { prev[e] = sh0[u][e]; prev[4 + e] = sh1[u][e]; } }
            else {
#pragma unroll
                for (int e = 0; e < 8; ++e) prev[e] = 0.f; }
            float xs[8];
#pragma unroll
            for (int e = 0; e < 4; ++e) { xs[e] = cur[e] + mu0[u][e] * (prev[e] - cur[e]); xs[4 + e] = cur[4 + e] + mu1[u][e] * (prev[4 + e] - cur[4 + e]); }
            if (col >= 3072) { const int a0 = col - 3072;
#pragma unroll
                for (int e = 0; e < 8; ++e) xs[e] = a0 < 64 ? tanhf(xs[e]) : (a0 < 128 ? xs[e] : fsigmoid_(xs[e]));
                *(LAS v4u*)(ACTB + j * ACTB_LD + a0) = (v4u){pk2(xs[0], xs[1]), pk2(xs[2], xs[3]), pk2(xs[4], xs[5]), pk2(xs[6], xs[7])};
            } else *(LAS v4u*)(XSB + j * XSB_LD + col) = (v4u){pk2(xs[0], xs[1]), pk2(xs[2], xs[3]), pk2(xs[4], xs[5]), pk2(xs[6], xs[7])};
        }
    }
    __syncthreads();
    float* SC = wsp<float>(C, WS_SC); constexpr size_t SS = SC_STRIDE / 4;
    float* GG = wsp<float>(C, WS_GG); float* BON = wsp<float>(C, WS_BON);
    const bf16* LT = wsp<bf16>(C, WS_LT) + (size_t)l * 1024 * 288;
    const f32x4 zf = {0.f, 0.f, 0.f, 0.f};
#pragma unroll 1
    for (int hh = 0; hh < 2; ++hh) {
        if (hsel >= 0 && hh != hsel) continue;
        const int head = 2 * wave + hh;
        f32x4 aw[4], aa[4], ag[4];
#pragma unroll
        for (int t4 = 0; t4 < 4; ++t4) { aw[t4] = zf; aa[t4] = zf; ag[t4] = zf; }
#define LORA_STEPS(ACC, KS0, NKS) _Pragma("unroll") for (int ks = (KS0); ks < (KS0) + (NKS); ++ks) { \
            const bf16x8 af = *(const LAS bf16x8*)(ACTB + n16 * ACTB_LD + 32 * ks + 8 * rq); \
            _Pragma("unroll") for (int t4 = 0; t4 < 4; ++t4) { const bf16x8 bfr = *(const bf16x8*)(LT + (size_t)(head * 64 + 16 * t4 + n16) * 288 + 32 * ks + 8 * rq); \
                ACC[t4] = __builtin_amdgcn_mfma_f32_16x16x32_bf16(af, bfr, ACC[t4], 0, 0, 0); } }
        LORA_STEPS(aw, 0, 2) LORA_STEPS(aa, 2, 2) LORA_STEPS(ag, 4, 5)
#undef LORA_STEPS
        float w0v[4], a0v[4], kkv[4], kav[4], rkv[4];
#pragma unroll
        for (int t4 = 0; t4 < 4; ++t4) { const int c = l * 1024 + head * 64 + 16 * t4 + n16; w0v[t4] = C.inp(10)[c]; a0v[t4] = C.inp(12)[c]; kkv[t4] = C.inp(15)[c]; kav[t4] = C.inp(16)[c]; rkv[t4] = C.inp(17)[c]; }
#pragma unroll
        for (int i = 0; i < 4; ++i) {
            const int j = 4 * rq + i; const size_t m = (size_t)m0 + j;
            float kkr[4], km[4], a_[4], rr[4], vv[4], lw_[4]; float ss = 0.f, bs = 0.f;
#pragma unroll
            for (int t4 = 0; t4 < 4; ++t4) { const int cl = head * 64 + 16 * t4 + n16;
                const float z = w0v[t4] + aw[t4][i];
                const float w = -fsoftplus_(-z) - 0.5f;
                lw_[t4] = -fexp_(w);
                a_[t4] = fsigmoid_(a0v[t4] + aa[t4][i]);
                rr[t4] = bf2f(XSB[j * XSB_LD + cl]); const float k = bf2f(XSB[j * XSB_LD + 1024 + cl]); vv[t4] = bf2f(XSB[j * XSB_LD + 2048 + cl]);
                kkr[t4] = k * kkv[t4]; ss += kkr[t4] * kkr[t4];
                km[t4] = k * (1.f + (a_[t4] - 1.f) * kav[t4]); bs += rr[t4] * km[t4] * rkv[t4]; }
            ss += dppf<0xB1>(ss); ss += dppf<0x4E>(ss); ss += dppf<0x141>(ss); ss += dppf<0x140>(ss);
            bs += dppf<0xB1>(bs); bs += dppf<0x4E>(bs); bs += dppf<0x141>(bs); bs += dppf<0x140>(bs);
            const float rn = __builtin_amdgcn_rsqf(fmaxf(ss, 1e-24f));
#pragma unroll
            for (int t4 = 0; t4 < 4; ++t4) { const int c = head * 64 + 16 * t4 + n16; const float kk = kkr[t4] * rn;
                ((bf16*)(SC + 0 * SS))[m * 1024 + c] = (unsigned short)(pk2(kk, 0.f) & 0xffffu); SC[1 * SS + m * 1024 + c] = fexp_(lw_[t4]); SC[3 * SS + m * 1024 + c] = lw_[t4];
                ((unsigned*)(SC + 2 * SS))[m * 1024 + head * 64 + n16 * 4 + t4] = pk2(-kk * a_[t4], km[t4]);
                ((bf16*)(SC + 4 * SS))[m * 1024 + c] = (unsigned short)(pk2(rr[t4], 0.f) & 0xffffu); SC[5 * SS + m * 1024 + c] = vv[t4];
                GG[m * 1024 + c] = ag[t4][i]; }
            if (n16 == 0) BON[m * 16 + head] = bs;
        }
    }
}

DI void phase_b(const Ctx& C, int l, int lq) {
    const int tid = C.tid;
    const bf16* P = wsp<bf16>(C, WS_PROJ);
    LAS int* qslot = (LAS int*)(C.lds + MISC_OFF + 64);
    __syncthreads();
    for (int i = tid; i < RW_COLS / 4; i += NTHREADS) ((LAS f32x4*)(C.lds + MU_OFF))[i] = ((const f32x4*)(C.inp(9) + (size_t)l * RW_COLS))[i];
    for (;;) {
        __syncthreads();
        if (tid == 0) *qslot = (int)atomicAdd(C.ctl + CW_QUEUE + 64 * (16 + lq), 1u);
        __syncthreads();
        const int it = *qslot;
        if (it >= PB_ITEMS) break;
        int r = it;
        if (r < PB_NRW) { const bool full_ = r < PB_NFULL; rwkv_pre_item(C, l, full_ ? r : PB_NFULL + ((r - PB_NFULL) >> 1), full_ ? -1 : ((r - PB_NFULL) & 1)); continue; }
        r -= PB_NRW;
        if (r < PB_NPOOL) {
            const int b = r >> 6, n = r & 63, kv = tid >> 8, kvh = (tid >> 6) & 3, d = tid & 63;
            const float* src = C.out + O_CMP_P + ((size_t)l * NTP + b * 2048 + 32 * n) * 512 + tid;
            const float* w = C.inp(20) + (l * 2 + kv) * 32;
            float acc = 0.f, pr_[32];
#pragma unroll
            for (int rr = 0; rr < 32; ++rr) pr_[rr] = src[(size_t)rr * 512];
#pragma unroll
            for (int rr = 0; rr < 32; ++rr) acc += w[rr] * pr_[rr];
            const unsigned short hb = (unsigned short)(pk2(acc, 0.f) & 0xffffu);
            if (kv == 0) wsp<bf16>(C, WS_KCB)[((size_t)(b * 4 + kvh) * 64 + n) * 64 + d] = hb;
            else wsp<bf16>(C, WS_VCBT)[((size_t)(b * 4 + kvh) * 64 + d) * 64 + n] = hb;
            continue;
        }
        r -= PB_NPOOL;
        {
            const int which = r >> 9, b = (r >> 7) & 3, kvh = (r >> 5) & 3, tb = r & 31, d = tid & 63, tq = tid >> 6;
            const bf16* src = P + (size_t)(b * 2048 + 64 * tb + 8 * tq) * PLD + (which ? VW_OFF : VS_OFF) + kvh * 64 + d;
            unsigned short e[8];
#pragma unroll
            for (int i = 0; i < 8; ++i) e[i] = src[(size_t)i * PLD];
            v4u o; o.x = e[0] | ((unsigned)e[1] << 16); o.y = e[2] | ((unsigned)e[3] << 16); o.z = e[4] | ((unsigned)e[5] << 16); o.w = e[6] | ((unsigned)e[7] << 16);
            *(v4u*)(wsp<bf16>(C, which ? WS_VTW : WS_VTS) + (((size_t)(b * 4 + kvh) * 32 + tb) * 64 + d) * 64 + 8 * tq) = o;
            { const int row = tid >> 3, ch = tid & 7;
              const v4u kv_ = *(const v4u*)(P + (size_t)(b * 2048 + 64 * tb + row) * PLD + (which ? KW_OFF : KS_OFF) + kvh * 64 + ch * 8);
              *(v4u*)(wsp<bf16>(C, which ? WS_KWC : WS_KSC) + ((size_t)(b * 4 + kvh) * 2048 + 64 * tb + row) * 64 + ch * 8) = kv_; }
        }
    }
    __syncthreads();
}

#define MFMA16(a, b, c) __builtin_amdgcn_mfma_f32_16x16x32_bf16((a), (b), (c), 0, 0, 0)
DI void scan_head(const Ctx& C, int l, int row0, int T, int h, const float* S0, float* Sout) {
    const int tid = C.tid, lane = C.lane, wave = C.wave;
    LAS f32x4* D4 = (LAS f32x4*)C.lds;
    LAS v4u* BK4 = (LAS v4u*)(C.lds + 8192);
    LAS f32x4* V4 = (LAS f32x4*)(C.lds + 16384);
    LAS v4u* R16 = (LAS v4u*)(C.lds + 24576);
    LAS v4u* KK16 = (LAS v4u*)(C.lds + 28672);
    LAS float* YB = (LAS float*)(C.lds + 33280);
    const unsigned char* SCb = C.ws + WS_SC;
    const bf16* SCKK = (const bf16*)SCb; const float* SCD = (const float*)(SCb + SC_STRIDE); const unsigned* SCBK = (const unsigned*)(SCb + 2 * SC_STRIDE);
    const bf16* SCR = (const bf16*)(SCb + 4 * SC_STRIDE); const float* SCV = (const float*)(SCb + 5 * SC_STRIDE);
    const float* GG = wsp<float>(C, WS_GG); const float* BON = wsp<float>(C, WS_BON);
    bf16* MIX = wsp<bf16>(C, WS_MIX);
    const int n = lane & 15, rq = lane >> 4, v0 = 16 * (wave & 3); const bool act = wave < 4;
    f32x4 acc[4];
#pragma unroll
    for (int kt = 0; kt < 4; ++kt) acc[kt] = (act && S0) ? *(const f32x4*)(S0 + (v0 + n) * 64 + 16 * kt + 4 * rq) : (f32x4){0.f, 0.f, 0.f, 0.f};
    const int nch = (T + 31) >> 5;
    f32x4 pD, pV; v4u pBK, pRK, pK2;
    const v4u z4 = {0u, 0u, 0u, 0u};
#define SCAN_PREFETCH(cc) do { { const int step = (cc) * 32 + (tid >> 4), f4 = tid & 15; const size_t o = (size_t)(row0 + step) * 1024 + h * 64 + f4 * 4; const bool ok = step < T; \
            pD = ok ? *(const f32x4*)(SCD + o) : (f32x4){0.f, 0.f, 0.f, 0.f}; pV = ok ? *(const f32x4*)(SCV + o) : (f32x4){0.f, 0.f, 0.f, 0.f}; pBK = ok ? *(const v4u*)(SCBK + o) : z4; } \
        { const int i2 = tid & 255, step = (cc) * 32 + (i2 >> 3); const size_t o = (size_t)(row0 + step) * 1024 + h * 64 + (i2 & 7) * 8; pRK = step < T ? *(const v4u*)((tid < 256 ? SCR : SCKK) + o) : z4; } \
        { const int step = (cc) * 32 + 32; const size_t o = (size_t)(row0 + step) * 1024 + h * 64 + (tid & 7) * 8; pK2 = (tid < 8 && step < T) ? *(const v4u*)(SCKK + o) : z4; } } while (0)
    SCAN_PREFETCH(0);
    const float gng = C.inp(18)[l * 1024 + h * 64 + lane], gnb = C.inp(19)[l * 1024 + h * 64 + lane];
    float sk = 0.f;
    struct StepOps { f32x4 d[4]; v4u bk; float vt; v2u a[4]; };
#define SCAN_LD(o, st_) do { _Pragma("unroll") for (int kt = 0; kt < 4; ++kt) (o).d[kt] = D4[(st_) * 16 + 4 * kt + rq]; (o).bk = BK4[(st_) * 16 + n]; (o).vt = ((const LAS float*)V4)[(st_) * 64 + v0 + n]; \
        const LAS unsigned char* src_ = (n & 3) == 1 ? (const LAS unsigned char*)KK16 + ((st_) + 1) * 128 : (const LAS unsigned char*)R16 + (st_) * 128; \
        (o).a[0] = *(const LAS v2u*)(src_ + 8 * rq); (o).a[1] = *(const LAS v2u*)(src_ + 32 + 8 * rq); (o).a[2] = *(const LAS v2u*)(src_ + 64 + 8 * rq); (o).a[3] = *(const LAS v2u*)(src_ + 96 + 8 * rq); } while (0)
#define SCAN_YSK(a0_, a1_, a2_, a3_, yv, skv) do { \
        v4u h0, h1; h0.x = pk2(acc[0][0], acc[0][1]); h0.y = pk2(acc[0][2], acc[0][3]); h0.z = pk2(acc[1][0], acc[1][1]); h0.w = pk2(acc[1][2], acc[1][3]); \
        h1.x = pk2(acc[2][0], acc[2][1]); h1.y = pk2(acc[2][2], acc[2][3]); h1.z = pk2(acc[3][0], acc[3][1]); h1.w = pk2(acc[3][2], acc[3][3]); \
        const v4u f0 = {(a0_).x, (a0_).y, (a1_).x, (a1_).y}, f1 = {(a2_).x, (a2_).y, (a3_).x, (a3_).y}; \
        f32x4 d2 = MFMA16(__builtin_bit_cast(bf16x8, f0), __builtin_bit_cast(bf16x8, h0), ((f32x4){0.f, 0.f, 0.f, 0.f})); \
        d2 = MFMA16(__builtin_bit_cast(bf16x8, f1), __builtin_bit_cast(bf16x8, h1), d2); yv = d2[0]; skv = d2[1]; } while (0)
    for (int c = 0; c < nch; ++c) {
        __syncthreads();
        D4[tid] = pD; BK4[tid] = pBK; V4[tid] = pV;
        if (tid < 256) R16[tid] = pRK; else KK16[tid - 256] = pRK;
        if (tid < 8) KK16[256 + tid] = pK2;
        __syncthreads();
        if (c + 1 < nch) SCAN_PREFETCH(c + 1);
        const int nst = (T - c * 32) < 32 ? (T - c * 32) : 32;
        float gq[4], bq[4];
#pragma unroll
        for (int qq = 0; qq < 4; ++qq) { const int st = wave * 4 + qq; const size_t m = (size_t)row0 + c * 32 + (st < nst ? st : 0);
            gq[qq] = GG[m * 1024 + h * 64 + lane]; bq[qq] = BON[m * 16 + h]; }
        if (act) {
            if (c == 0) {
                const LAS unsigned char* s0 = (const LAS unsigned char*)KK16;
                const v2u k0 = *(const LAS v2u*)(s0 + 8 * rq), k1 = *(const LAS v2u*)(s0 + 32 + 8 * rq), k2 = *(const LAS v2u*)(s0 + 64 + 8 * rq), k3 = *(const LAS v2u*)(s0 + 96 + 8 * rq);
                float yd; SCAN_YSK(k0, k1, k2, k3, sk, yd); (void)yd;
            }
            StepOps cur; SCAN_LD(cur, 0);
#pragma unroll 2
            for (int st = 0; st < nst; ++st) {
                StepOps nx; { const int sn = st + 1 < 32 ? st + 1 : 31; SCAN_LD(nx, sn); }
#pragma unroll
                for (int kt = 0; kt < 4; ++kt) acc[kt] = acc[kt] * cur.d[kt];
                v4u b2 = z4; b2.x = rq == 0 ? pk2(sk, cur.vt) : 0u;
#pragma unroll
                for (int kt = 0; kt < 4; ++kt) { v4u a2 = z4; a2.x = rq == 0 ? cur.bk[kt] : 0u; acc[kt] = MFMA16(__builtin_bit_cast(bf16x8, a2), __builtin_bit_cast(bf16x8, b2), acc[kt]); }
                float y; SCAN_YSK(cur.a[0], cur.a[1], cur.a[2], cur.a[3], y, sk);
                if (rq == 0) YB[st * 64 + v0 + n] = y;
                cur = nx;
            }
        }
        __syncthreads();
#pragma unroll
        for (int qq = 0; qq < 4; ++qq) {
            const int st = wave * 4 + qq;
            if (st < nst) {
                const size_t m = (size_t)row0 + c * 32 + st;
                const float y = YB[st * 64 + lane];
                const float mean = wave_sum(y) * (1.f / 64.f);
                const float dv = y - mean;
                const float var = wave_sum(dv * dv) * (1.f / 64.f);
                const float yn = dv * __builtin_amdgcn_rsqf(var + GN_EPS) * gng + gnb;
                const float o = (yn + bq[qq] * ((const LAS float*)V4)[st * 64 + lane]) * gq[qq];
                MIX[m * DM + h * 64 + lane] = (unsigned short)(pk2(o, 0.f) & 0xffffu);
            }
        }
    }
#undef SCAN_PREFETCH
#undef SCAN_LD
#undef SCAN_YSK
    if (act) {
#pragma unroll
        for (int kt = 0; kt < 4; ++kt) *(f32x4*)(Sout + (v0 + n) * 64 + 16 * kt + 4 * rq) = acc[kt];
    }
}

constexpr int CST = 144, CBUF = 64 * CST;
DI void cmm(const LAS unsigned char* L, const LAS unsigned char* Rt, f32x4 (&acc)[2], int tm, int tn0, int n16, int kq) {
#pragma unroll
    for (int ks = 0; ks < 2; ++ks) {
        const bf16x8 a = *(const LAS bf16x8*)(L + (16 * tm + n16) * CST + (32 * ks + 8 * kq) * 2);
#pragma unroll
        for (int j = 0; j < 2; ++j) { const bf16x8 bq = *(const LAS bf16x8*)(Rt + (16 * (tn0 + j) + n16) * CST + (32 * ks + 8 * kq) * 2); acc[j] = MFMA16(a, bq, acc[j]); }
    }
}
template <int MODE> DI void cst_T(LAS unsigned char* X, const f32x4 (&acc)[2], int tm, int tn0, int n16, int rq) {
#pragma unroll
    for (int j = 0; j < 2; ++j) { const int n = 16 * (tn0 + j) + n16, m0 = 16 * tm + 4 * rq; float v[4];
#pragma unroll
        for (int i = 0; i < 4; ++i) { const int col = m0 + i; const bool keep = MODE == 0 ? true : (MODE == 1 ? col < n : (MODE == 2 ? col <= n : col > n)); v[i] = keep ? acc[j][i] : 0.f; }
        *(LAS v2u*)(X + n * CST + m0 * 2) = (v2u){pk2(v[0], v[1]), pk2(v[2], v[3])}; }
}
template <int mode> DI void chunk_head(const Ctx& C, int l, int b, int h, float* Sout, int part) {
    const int tid = C.tid, lane = C.lane, wave = C.wave;
    const int n16 = lane & 15, rq = lane >> 4, tm = wave >> 1, tn0 = (wave & 1) * 2;
    LAS unsigned char* const B0 = C.lds;
#define CB(i) (B0 + (i) * CBUF)
    enum { I_BH = 0, I_BHT = 1, I_AH = 2, I_KH = 3, I_RH = 4, I_ATT = 5, I_KTT = 6, I_VT = 7, I_A1 = 8, I_A1T = 9, I_A2 = 10, I_M1 = 11, I_M2 = 12, I_H0T = 13 };
    LAS float* SEG = (LAS float*)(B0 + 14 * CBUF);
    LAS float* YB = (LAS float*)CB(8);
    const unsigned char* SCb = C.ws + WS_SC;
    const bf16* SCKK = (const bf16*)SCb; const unsigned* SCBK = (const unsigned*)(SCb + 2 * SC_STRIDE); const float* SCLW = (const float*)(SCb + 3 * SC_STRIDE);
    const bf16* SCR = (const bf16*)(SCb + 4 * SC_STRIDE); const float* SCV = (const float*)(SCb + 5 * SC_STRIDE);
    const float* GG = wsp<float>(C, WS_GG); const float* BON = wsp<float>(C, WS_BON);
    bf16* MIX = wsp<bf16>(C, WS_MIX);
    const size_t m0 = (size_t)b * 2048;
    const int pk = tid & 63, seg = tid >> 6, bkidx = (pk & 15) * 4 + (pk >> 4);
    const f32x4 zf = {0.f, 0.f, 0.f, 0.f};
    f32x4 accH[2] = {zf, zf};
    __syncthreads();
    for (int i = tid; i < CBUF / 4; i += NTHREADS) ((LAS unsigned*)CB(I_H0T))[i] = 0u;
    float plw[8], pv[8]; unsigned pbk[8]; unsigned short pkk[8], pr[8];
#define CH_LOAD(cc) do { _Pragma("unroll") for (int i = 0; i < 8; ++i) { const size_t o = (m0 + (cc) * 64 + seg * 8 + i) * 1024 + h * 64; \
        plw[i] = SCLW[o + pk]; pkk[i] = SCKK[o + pk]; pbk[i] = SCBK[o + bkidx]; pr[i] = SCR[o + pk]; pv[i] = SCV[o + pk]; } } while (0)
    unsigned char* const OPS = C.ws + WS_OPS + (size_t)((b * 16 + h) * 24) * OPS_BYTES;
    unsigned* const flag = C.ctl + CW_FLAG + 64 * ((l * 64 + b * 16 + h) * 4);
    const int c_lo = mode ? 16 * part : 0, c_hi = mode ? 16 * part + 16 : 16;
    CH_LOAD(c_lo);
    const float gng = C.inp(18)[l * 1024 + h * 64 + lane], gnb = C.inp(19)[l * 1024 + h * 64 + lane];
    for (int c = c_lo; c < c_hi; ++c) {

        float gq[8], bq[8], vq[8];
#pragma unroll
        for (int i = 0; i < 8; ++i) { const size_t m = m0 + c * 64 + 8 * wave + i; gq[i] = GG[m * 1024 + h * 64 + lane]; bq[i] = BON[m * 16 + h]; vq[i] = SCV[m * 1024 + h * 64 + lane]; }
        float cs[8];
        { float run = 0.f;
#pragma unroll
          for (int i = 0; i < 8; ++i) { run += plw[i]; cs[i] = run; } }
        __syncthreads();
        SEG[seg * 64 + pk] = cs[7];
        __syncthreads();
        float off = 0.f, tot = 0.f;
#pragma unroll
        for (int s = 0; s < 8; ++s) { const float sv = SEG[s * 64 + pk]; tot += sv; off += s < seg ? sv : 0.f; }
        { unsigned short bt[8], at[8], kt[8], vt[8];
#pragma unroll
          for (int i = 0; i < 8; ++i) { const float csv = cs[i] + off;
              const float eP = __expf(csv), eM = __expf(-csv), ePm = __expf(csv - plw[i]), eQ = __expf(tot - csv);
              const float kkf = bf2f(pkk[i]), nb = bflo(pbk[i]), kmf = bfhi(pbk[i]), rf = bf2f(pr[i]);
              const int t = seg * 8 + i;
              const unsigned short vb = (unsigned short)(pk2(kkf * ePm, 0.f) & 0xffffu);
              *(LAS unsigned short*)(CB(I_BH) + t * CST + pk * 2) = vb; bt[i] = vb;
              *(LAS unsigned short*)(CB(I_AH) + t * CST + pk * 2) = (unsigned short)(pk2(nb * eM, 0.f) & 0xffffu);
              *(LAS unsigned short*)(CB(I_KH) + t * CST + pk * 2) = (unsigned short)(pk2(kmf * eM, 0.f) & 0xffffu);
              *(LAS unsigned short*)(CB(I_RH) + t * CST + pk * 2) = (unsigned short)(pk2(rf * eP, 0.f) & 0xffffu);
              at[i] = (unsigned short)(pk2(nb * eQ, 0.f) & 0xffffu); kt[i] = (unsigned short)(pk2(kmf * eQ, 0.f) & 0xffffu); vt[i] = (unsigned short)(pk2(pv[i], 0.f) & 0xffffu); }
#define PK8(a) ((v4u){(unsigned)a[0] | ((unsigned)a[1] << 16), (unsigned)a[2] | ((unsigned)a[3] << 16), (unsigned)a[4] | ((unsigned)a[5] << 16), (unsigned)a[6] | ((unsigned)a[7] << 16)})
          *(LAS v4u*)(CB(I_BHT) + pk * CST + seg * 16) = PK8(bt); *(LAS v4u*)(CB(I_ATT) + pk * CST + seg * 16) = PK8(at);
          *(LAS v4u*)(CB(I_KTT) + pk * CST + seg * 16) = PK8(kt); *(LAS v4u*)(CB(I_VT) + pk * CST + seg * 16) = PK8(vt);
#undef PK8
        }
        if (c + 1 < c_hi) CH_LOAD(c + 1);
        __syncthreads();
        f32x4 accT[2];
        { f32x4 a_[2];
          a_[0] = zf; a_[1] = zf; cmm(CB(I_BH), CB(I_AH), a_, tm, tn0, n16, rq); cst_T<3>(CB(I_A1T), a_, tm, tn0, n16, rq);
          a_[0] = zf; a_[1] = zf; cmm(CB(I_AH), CB(I_BH), a_, tm, tn0, n16, rq); cst_T<1>(CB(I_A1), a_, tm, tn0, n16, rq);
#pragma unroll
          for (int j = 0; j < 2; ++j)
#pragma unroll
              for (int i = 0; i < 4; ++i) { const int m = 16 * tm + 4 * rq + i, n = 16 * (tn0 + j) + n16; accT[j][i] = m < n ? a_[j][i] : (m == n ? 1.f : 0.f); }
          a_[0] = zf; a_[1] = zf; cmm(CB(I_KH), CB(I_BH), a_, tm, tn0, n16, rq); cst_T<1>(CB(I_A2), a_, tm, tn0, n16, rq);
          a_[0] = zf; a_[1] = zf; cmm(CB(I_AH), CB(I_RH), a_, tm, tn0, n16, rq); cst_T<2>(CB(I_M1), a_, tm, tn0, n16, rq);
          a_[0] = zf; a_[1] = zf; cmm(CB(I_KH), CB(I_RH), a_, tm, tn0, n16, rq); cst_T<2>(CB(I_M2), a_, tm, tn0, n16, rq); }
        __syncthreads();
        { int ip = I_A1, ipt = I_A1T, in_ = I_AH, int_ = I_KH;
#pragma unroll 1
          for (int lev = 0; lev < 5; ++lev) {
              cst_T<0>(CB(I_BH), accT, tm, tn0, n16, rq);
              f32x4 a_[2];
              a_[0] = zf; a_[1] = zf; cmm(CB(ip), CB(ipt), a_, tm, tn0, n16, rq); cst_T<0>(CB(int_), a_, tm, tn0, n16, rq);
              a_[0] = zf; a_[1] = zf; cmm(CB(ipt), CB(ip), a_, tm, tn0, n16, rq); cst_T<0>(CB(in_), a_, tm, tn0, n16, rq);
              __syncthreads();
              cmm(CB(int_), CB(I_BH), accT, tm, tn0, n16, rq);
              __syncthreads();
              const int t0 = ip, t1 = ipt; ip = in_; ipt = int_; in_ = t0; int_ = t1;
          }
          cst_T<0>(CB(I_BH), accT, tm, tn0, n16, rq); }
        { f32x4 a_[2];
          a_[0] = zf; a_[1] = zf; cmm(CB(I_A2), CB(I_VT), a_, tm, tn0, n16, rq); cst_T<0>(CB(8), a_, tm, tn0, n16, rq);
          __syncthreads();
          a_[0] = zf; a_[1] = zf; cmm(CB(I_BH), CB(I_BHT), a_, tm, tn0, n16, rq); cst_T<0>(CB(9), a_, tm, tn0, n16, rq);
          a_[0] = zf; a_[1] = zf; cmm(CB(I_BH), CB(8), a_, tm, tn0, n16, rq); cst_T<0>(CB(2), a_, tm, tn0, n16, rq); }
        __syncthreads();
        f32x4 accE[2] = {zf, zf}, accY[2] = {zf, zf};
        { f32x4 a_[2];
          a_[0] = zf; a_[1] = zf; cmm(CB(9), CB(I_ATT), a_, tm, tn0, n16, rq);
#pragma unroll
          for (int j = 0; j < 2; ++j) { const int n = 16 * (tn0 + j) + n16, mm0 = 16 * tm + 4 * rq; float pc = 0.f;
#pragma unroll
              for (int s = 0; s < 8; ++s) pc += SEG[s * 64 + n];
              pc = __expf(pc); float v[4];
#pragma unroll
              for (int i = 0; i < 4; ++i) v[i] = a_[j][i] + (mm0 + i == n ? pc : 0.f);
              *(LAS v2u*)(CB(3) + n * CST + mm0 * 2) = (v2u){pk2(v[0], v[1]), pk2(v[2], v[3])}; }
          cmm(CB(I_ATT), CB(2), accE, tm, tn0, n16, rq); cmm(CB(I_KTT), CB(I_VT), accE, tm, tn0, n16, rq);
          a_[0] = zf; a_[1] = zf; cmm(CB(9), CB(I_M1), a_, tm, tn0, n16, rq);
#pragma unroll
          for (int j = 0; j < 2; ++j) { const int n = 16 * (tn0 + j) + n16, mm0 = 16 * tm + 4 * rq;
              const v2u rh = *(const LAS v2u*)(CB(I_RH) + n * CST + mm0 * 2);
              *(LAS v2u*)(CB(10) + n * CST + mm0 * 2) = (v2u){pk2(a_[j][0] + bflo(rh.x), a_[j][1] + bfhi(rh.x)), pk2(a_[j][2] + bflo(rh.y), a_[j][3] + bfhi(rh.y))}; }
          cmm(CB(I_M1), CB(2), accY, tm, tn0, n16, rq); cmm(CB(I_M2), CB(I_VT), accY, tm, tn0, n16, rq); }
        __syncthreads();
        if (mode == 1) {
            unsigned char* ob = OPS + (size_t)(c - 16) * OPS_BYTES;
            for (int i = tid; i < 2 * CBUF / 16; i += NTHREADS) ((v4u*)ob)[i] = *(const LAS v4u*)((i < CBUF / 16 ? CB(3) : CB(10)) + (i < CBUF / 16 ? i : i - CBUF / 16) * 16);
            ((f32x4*)(ob + 2 * CBUF))[tid * 2] = accE[0]; ((f32x4*)(ob + 2 * CBUF))[tid * 2 + 1] = accE[1];
            ((f32x4*)(ob + 2 * CBUF + 16384))[tid * 2] = accY[0]; ((f32x4*)(ob + 2 * CBUF + 16384))[tid * 2 + 1] = accY[1];
            continue;
        }
        cmm(CB(3), CB(I_H0T), accE, tm, tn0, n16, rq); cmm(CB(10), CB(I_H0T), accY, tm, tn0, n16, rq);
        __syncthreads();
        accH[0] = accE[0]; accH[1] = accE[1];
        cst_T<0>(CB(I_H0T), accH, tm, tn0, n16, rq);
#pragma unroll
        for (int j = 0; j < 2; ++j)
#pragma unroll
            for (int i = 0; i < 4; ++i) YB[(16 * tm + 4 * rq + i) * 64 + 16 * (tn0 + j) + n16] = accY[j][i];
        __syncthreads();
#pragma unroll
        for (int i = 0; i < 8; ++i) {
            const int t = 8 * wave + i; const size_t m = m0 + c * 64 + t;
            const float y = YB[t * 64 + lane];
            const float mean = wave_sum(y) * (1.f / 64.f);
            const float dv = y - mean;
            const float var = wave_sum(dv * dv) * (1.f / 64.f);
            const float yn = dv * __builtin_amdgcn_rsqf(var + GN_EPS) * gng + gnb;
            const float o = (yn + bq[i] * vq[i]) * gq[i];
            MIX[m * DM + h * 64 + lane] = (unsigned short)(pk2(o, 0.f) & 0xffffu);
        }
    }
    if (mode == 0) for (int c = 16; c < 32; ++c) {
            float gq[8], bq[8], vq[8];
#pragma unroll
            for (int i = 0; i < 8; ++i) { const size_t m = m0 + c * 64 + 8 * wave + i; gq[i] = GG[m * 1024 + h * 64 + lane]; bq[i] = BON[m * 16 + h]; vq[i] = SCV[m * 1024 + h * 64 + lane]; }
            if ((c & 15) == 0) {
                if (tid == 0) { unsigned sp = 0; while (__hip_atomic_load(flag + 64 * (c >> 4), __ATOMIC_RELAXED, __HIP_MEMORY_SCOPE_AGENT) == 0u) { __builtin_amdgcn_s_sleep(8); if (++sp > (1u << 22)) break; }
                    __builtin_amdgcn_fence(__ATOMIC_ACQUIRE, "agent"); asm volatile("s_waitcnt vmcnt(0)" ::: "memory"); }
            }
            __syncthreads();
            const unsigned char* ob = OPS + (size_t)(c - 16) * OPS_BYTES;
            for (int i = tid; i < 2 * CBUF / 16; i += NTHREADS) { const v4u w = ((const v4u*)ob)[i]; *(LAS v4u*)((i < CBUF / 16 ? CB(3) : CB(10)) + (i < CBUF / 16 ? i : i - CBUF / 16) * 16) = w; }
            f32x4 accE[2], accY[2];
            accE[0] = ((const f32x4*)(ob + 2 * CBUF))[tid * 2]; accE[1] = ((const f32x4*)(ob + 2 * CBUF))[tid * 2 + 1];
            accY[0] = ((const f32x4*)(ob + 2 * CBUF + 16384))[tid * 2]; accY[1] = ((const f32x4*)(ob + 2 * CBUF + 16384))[tid * 2 + 1];
            __syncthreads();
            cmm(CB(3), CB(I_H0T), accE, tm, tn0, n16, rq); cmm(CB(10), CB(I_H0T), accY, tm, tn0, n16, rq);
            __syncthreads();
            accH[0] = accE[0]; accH[1] = accE[1];
            cst_T<0>(CB(I_H0T), accH, tm, tn0, n16, rq);
#pragma unroll
            for (int j = 0; j < 2; ++j)
#pragma unroll
                for (int i = 0; i < 4; ++i) YB[(16 * tm + 4 * rq + i) * 64 + 16 * (tn0 + j) + n16] = accY[j][i];
            __syncthreads();
#pragma unroll
            for (int i = 0; i < 8; ++i) {
                const int t = 8 * wave + i; const size_t m = m0 + c * 64 + t;
                const float y = YB[t * 64 + lane];
                const float mean = wave_sum(y) * (1.f / 64.f);
                const float dv = y - mean;
                const float var = wave_sum(dv * dv) * (1.f / 64.f);
                const float yn = dv * __builtin_amdgcn_rsqf(var + GN_EPS) * gng + gnb;
                const float o = (yn + bq[i] * vq[i]) * gq[i];
                MIX[m * DM + h * 64 + lane] = (unsigned short)(pk2(o, 0.f) & 0xffffu);
            }
    }
#undef CH_LOAD
#undef CB
    if (mode == 1) {
        asm volatile("s_waitcnt vmcnt(0)" ::: "memory");
        __syncthreads();
        if (tid == 0) { __builtin_amdgcn_fence(__ATOMIC_RELEASE, "agent"); asm volatile("s_waitcnt vmcnt(0)" ::: "memory"); __hip_atomic_store(flag + 64 * part, 1u, __ATOMIC_RELAXED, __HIP_MEMORY_SCOPE_AGENT); }
        return;
    }
#pragma unroll
    for (int j = 0; j < 2; ++j) *(f32x4*)(Sout + (size_t)(16 * (tn0 + j) + n16) * 64 + 16 * tm + 4 * rq) = accH[j];
}

#define MFMA32(a, b, c) __builtin_amdgcn_mfma_f32_32x32x16_bf16((a), (b), (c), 0, 0, 0)
DI bf16x8 pack8(const f32x16& p, int s) {
    v4u o; o.x = pk2(p[8 * s], p[8 * s + 1]); o.y = pk2(p[8 * s + 2], p[8 * s + 3]); o.z = pk2(p[8 * s + 4], p[8 * s + 5]); o.w = pk2(p[8 * s + 6], p[8 * s + 7]);
    return __builtin_bit_cast(bf16x8, o);
}
DI bf16x8 ld_vt(const bf16* p) {
    const v2u a = *(const v2u*)p, b = *(const v2u*)(p + 8);
    v4u o; o.x = a.x; o.y = a.y; o.z = b.x; o.w = b.y; return __builtin_bit_cast(bf16x8, o);
}
constexpr int KT_STRIDE = 144, VTT_STRIDE = 136, KT_BYTES = 64 * KT_STRIDE, TILE_BYTES = KT_BYTES + 64 * VTT_STRIDE, TILE_OFF = 74752;
struct TileRegs { v4u k, v; };
DI TileRegs tile_load(const bf16* kbase, size_t kstride, const bf16* vbase, size_t vstride, int tid) {
    TileRegs r; const int row = tid >> 3, ch = tid & 7;
    r.k = *(const v4u*)(kbase + (size_t)row * kstride + ch * 8); r.v = *(const v4u*)(vbase + (size_t)row * vstride + ch * 8); return r;
}
DI void tile_store(LAS unsigned char* buf, const TileRegs& r, int tid) {
    const int row = tid >> 3, ch = tid & 7;
    *(LAS v4u*)(buf + row * KT_STRIDE + ch * 16) = r.k;
    *(LAS v2u*)(buf + KT_BYTES + row * VTT_STRIDE + ch * 16) = (v2u){r.v.x, r.v.y}; *(LAS v2u*)(buf + KT_BYTES + row * VTT_STRIDE + ch * 16 + 8) = (v2u){r.v.z, r.v.w};
}
DI bf16x8 ld_vt_lds(const LAS unsigned char* p) {
    const v2u a = *(const LAS v2u*)p, b = *(const LAS v2u*)(p + 16);
    v4u o; o.x = a.x; o.y = a.y; o.z = b.x; o.w = b.y; return __builtin_bit_cast(bf16x8, o);
}
#define ATT_BLOCK(EDGE, BUF, KEYBLK0, MINE, VALID_EXPR) do { \
    const float bias_ = (MINE) ? 0.f : NEG_BIG; \
    _Pragma("unroll 1") for (int tile = 0; tile < 2; ++tile) { const int key0 = (KEYBLK0) + tile * 32; (void)key0; \
        f32x16 a_ = zero16; \
        _Pragma("unroll") for (int s = 0; s < 4; ++s) { const bf16x8 kf = *(const LAS bf16x8*)((BUF) + (tile * 32 + q) * KT_STRIDE + 32 * s + 16 * hi); a_ = MFMA32(kf, qf[s], a_); } \
        float tm = NEG_BIG; \
        if (EDGE) { _Pragma("unroll") for (int i = 0; i < 16; ++i) { const int key = key0 + crow(i, hi); const bool ok = (MINE) && (VALID_EXPR); a_[i] = ok ? a_[i] * SCL2 : NEG_BIG; tm = fmaxf(tm, a_[i]); } } \
        else { _Pragma("unroll") for (int i = 0; i < 16; ++i) { a_[i] = a_[i] * SCL2 + bias_; tm = fmaxf(tm, a_[i]); } } \
        tm = fmaxf(tm, __shfl_xor(tm, 32)); \
        const float mn = fmaxf(mrun, tm); const float sc_ = __builtin_amdgcn_exp2f(mrun - mn); \
        float ps = 0.f; \
        if (EDGE) { _Pragma("unroll") for (int i = 0; i < 16; ++i) { const float p_ = a_[i] > -1e29f ? __builtin_amdgcn_exp2f(a_[i] - mn) : 0.f; a_[i] = p_; ps += p_; } } \
        else { _Pragma("unroll") for (int i = 0; i < 16; ++i) { const float p_ = __builtin_amdgcn_exp2f(a_[i] - mn); a_[i] = p_; ps += p_; } } \
        ps += __shfl_xor(ps, 32); \
        lrun = lrun * sc_ + ps; mrun = mn; \
        _Pragma("unroll") for (int i = 0; i < 16; ++i) { oa[0][i] *= sc_; oa[1][i] *= sc_; } \
        _Pragma("unroll") for (int s = 0; s < 2; ++s) { const bf16x8 pb = pack8(a_, s); \
            oa[0] = MFMA32(ld_vt_lds((BUF) + KT_BYTES + q * VTT_STRIDE + (tile * 32 + 16 * s + 4 * hi) * 2), pb, oa[0]); \
            oa[1] = MFMA32(ld_vt_lds((BUF) + KT_BYTES + (32 + q) * VTT_STRIDE + (tile * 32 + 16 * s + 4 * hi) * 2), pb, oa[1]); } \
    } } while (0)
constexpr float SCL2 = 0.125f * 1.4426950408889634f;

DI void nsa_prompt_unit(const Ctx& C, int l, int b, int kvh, int qt, bool skipblk = false, bool skipcmp = false) {
    const int tid = C.tid, lane = C.lane, wave = C.wave;
    const int g = wave & 3, th = wave >> 2, q = lane & 31, hi = lane >> 5;
    LAS float* IMP = (LAS float*)C.lds;
    LAS float* IMPV = (LAS float*)(C.lds + 65536);
    LAS unsigned* SELM = (LAS unsigned*)(C.lds + 65536 + 8192);
    LAS unsigned char* TB = C.lds + TILE_OFF;
    const bf16* P = wsp<bf16>(C, WS_PROJ);
    const int tok = qt * 64 + th * 32 + q;
    const size_t m = (size_t)b * 2048 + tok;
    const int bk = b * 4 + kvh, head = kvh * 4 + g;
    f32x16 zero16;
#pragma unroll
    for (int i = 0; i < 16; ++i) zero16[i] = 0.f;
    bf16x8 qf[4];
#pragma unroll
    for (int s = 0; s < 4; ++s) qf[s] = *(const bf16x8*)(P + m * PLD + Q_OFF + head * 64 + 16 * s + 8 * hi);
    f32x16 out0 = zero16, out1 = zero16;
    const float g0 = sigmoidf_(bf2f(P[m * PLD + GL_OFF + head * 3 + 0])), g1 = sigmoidf_(bf2f(P[m * PLD + GL_OFF + head * 3 + 1])), g2 = sigmoidf_(bf2f(P[m * PLD + GL_OFF + head * 3 + 2]));
    TileRegs tr = tile_load(wsp<bf16>(C, WS_KCB) + (size_t)bk * 4096, 64, wsp<bf16>(C, WS_VCBT) + (size_t)bk * 4096, 64, tid);
    __syncthreads();
    tile_store(TB, tr, tid);
    __syncthreads();
    if (!skipcmp) {
    {
        f32x16 sc[2];
        const int nvalid = (tok + 1) >> 5;
        float mx = NEG_BIG;
#pragma unroll
        for (int tile = 0; tile < 2; ++tile) {
            f32x16 a_ = zero16;
#pragma unroll
            for (int s = 0; s < 4; ++s) { const bf16x8 kf = *(const LAS bf16x8*)(TB + (tile * 32 + q) * KT_STRIDE + 32 * s + 16 * hi); a_ = MFMA32(kf, qf[s], a_); }
#pragma unroll
            for (int i = 0; i < 16; ++i) { const int n = tile * 32 + crow(i, hi); a_[i] = n < nvalid ? a_[i] * 0.125f : NEG_BIG; mx = fmaxf(mx, a_[i]); }
            sc[tile] = a_;
        }
        mx = fmaxf(mx, __shfl_xor(mx, 32));
        float sum = 0.f;
#pragma unroll
        for (int tile = 0; tile < 2; ++tile)
#pragma unroll
            for (int i = 0; i < 16; ++i) { const float p_ = sc[tile][i] > -1e29f ? __expf(sc[tile][i] - mx) : 0.f; sc[tile][i] = p_; sum += p_; }
        sum += __shfl_xor(sum, 32);
        const float inv = nvalid > 0 ? 1.f / sum : 0.f;
        f32x16 oc0 = zero16, oc1 = zero16;
#pragma unroll
        for (int tile = 0; tile < 2; ++tile) {
#pragma unroll
            for (int i = 0; i < 16; ++i) sc[tile][i] *= inv;
#pragma unroll
            for (int i4 = 0; i4 < 4; ++i4) { f32x4 v = {sc[tile][4 * i4], sc[tile][4 * i4 + 1], sc[tile][4 * i4 + 2], sc[tile][4 * i4 + 3]};
                *(LAS f32x4*)(IMP + ((size_t)(g * 64 + th * 32 + q)) * 64 + tile * 32 + 8 * i4 + 4 * hi) = v; }
#pragma unroll
            for (int s = 0; s < 2; ++s) { const bf16x8 pb = pack8(sc[tile], s);
                oc0 = MFMA32(ld_vt_lds(TB + KT_BYTES + q * VTT_STRIDE + (tile * 32 + 16 * s + 4 * hi) * 2), pb, oc0);
                oc1 = MFMA32(ld_vt_lds(TB + KT_BYTES + (32 + q) * VTT_STRIDE + (tile * 32 + 16 * s + 4 * hi) * 2), pb, oc1); }
        }
#pragma unroll
        for (int i = 0; i < 16; ++i) { out0[i] = g0 * oc0[i]; out1[i] = g0 * oc1[i]; }
    }
    __syncthreads();
    {
        const int tokl = tid >> 3, jq = tid & 7;
        float v[4];
#pragma unroll
        for (int e = 0; e < 4; ++e) v[e] = 0.f;
#pragma unroll
        for (int gg = 0; gg < 4; ++gg) { const f32x4 a = *(const LAS f32x4*)(IMP + (size_t)(gg * 64 + tokl) * 64 + 8 * jq), bq = *(const LAS f32x4*)(IMP + (size_t)(gg * 64 + tokl) * 64 + 8 * jq + 4);
            v[0] += a[0] + a[1]; v[1] += a[2] + a[3]; v[2] += bq[0] + bq[1]; v[3] += bq[2] + bq[3]; }
        const int cur = qt;
#pragma unroll
        for (int e = 0; e < 4; ++e) { const int j = 4 * jq + e; const bool forced = (j == 0) | (j == cur) | (j == cur - 1); v[e] = j > cur ? -1.f : (forced ? 1e4f : v[e]); }
        *(LAS f32x4*)(IMPV + tokl * 32 + 4 * jq) = (f32x4){v[0], v[1], v[2], v[3]};
        __syncthreads();
        int rank[4] = {0, 0, 0, 0};
#pragma unroll
        for (int jj4 = 0; jj4 < 8; ++jj4) { const f32x4 o = *(const LAS f32x4*)(IMPV + tokl * 32 + 4 * jj4);
#pragma unroll
            for (int u = 0; u < 4; ++u) { const int jp = 4 * jj4 + u; const float ov = o[u];
#pragma unroll
                for (int e = 0; e < 4; ++e) { const int j = 4 * jq + e; rank[e] += (ov > v[e] || (ov == v[e] && jp < j)) ? 1 : 0; } } }
        unsigned bits = 0;
#pragma unroll
        for (int e = 0; e < 4; ++e) if (rank[e] < 16 && v[e] >= 0.f) bits |= 1u << (4 * jq + e);
        bits |= __shfl_xor(bits, 1); bits |= __shfl_xor(bits, 2); bits |= __shfl_xor(bits, 4);
        if (jq == 0) SELM[tokl] = bits;
        __syncthreads();
    }
    }
    if (skipcmp && tid < 64) SELM[tid] = 0xffffffffu;
    __syncthreads();
    const unsigned selm = SELM[th * 32 + q];
    unsigned uni;
    { unsigned u0 = SELM[lane];
#pragma unroll
      for (int o = 1; o < 64; o <<= 1) u0 |= __shfl_xor(u0, o);
      uni = __builtin_amdgcn_readfirstlane(u0); }
    {
        LAS float* PARK = (LAS float*)C.lds + wave * 2048 + lane;
#pragma unroll
        for (int i = 0; i < 16; ++i) { PARK[i * 64] = out0[i]; PARK[(16 + i) * 64] = out1[i]; }
        const bf16* KBs = wsp<bf16>(C, WS_KSC) + (size_t)bk * 2048 * 64; const bf16* KBw = wsp<bf16>(C, WS_KWC) + (size_t)bk * 2048 * 64;
        const bf16* VTs = wsp<bf16>(C, WS_VTS) + (size_t)bk * 32 * 4096; const bf16* VTw = wsp<bf16>(C, WS_VTW) + (size_t)bk * 32 * 4096;
        f32x16 oa[2] = {zero16, zero16}; float mrun = NEG_BIG, lrun = 0.f;
        unsigned rem = skipblk ? 1u : uni; int wj = skipblk ? qt : (qt > 8 ? qt - 8 : 0); bool folded = false;
#define NEXT_BLK(dst) do { if (rem) { dst = __builtin_ctz(rem); rem &= rem - 1; } else if (wj <= qt) { dst = wj | 256; ++wj; } else dst = -1; } while (0)
#define LOAD_BLK(tr_, d_) do { const int j_ = (d_) & 255; tr_ = ((d_) & 256) ? tile_load(KBw + (size_t)j_ * 4096, 64, VTw + (size_t)j_ * 4096, 64, tid) : tile_load(KBs + (size_t)j_ * 4096, 64, VTs + (size_t)j_ * 4096, 64, tid); } while (0)
#define FOLD(gate_) do { const float il_ = (gate_) / lrun; _Pragma("unroll") for (int i = 0; i < 16; ++i) { PARK[i * 64] += il_ * oa[0][i]; PARK[(16 + i) * 64] += il_ * oa[1][i]; } \
            oa[0] = zero16; oa[1] = zero16; mrun = NEG_BIG; lrun = 0.f; } while (0)
#define DO_BLK(d_, buf_) do { const int j_ = (d_) & 255; const bool win_ = ((d_) & 256) != 0; \
            if (win_ && !folded) { FOLD(g1); folded = true; } \
            const bool mine = win_ ? true : (((selm >> j_) & 1u) != 0u); \
            if (__any(mine)) { const int wl_ = win_ ? 511 : (1 << 20); const bool edge_ = (j_ == qt) || (win_ && j_ + 8 <= qt); \
                if (edge_) ATT_BLOCK(1, buf_, j_ * 64, mine, (key <= tok && key + wl_ >= tok)); else ATT_BLOCK(0, buf_, j_ * 64, mine, true); } } while (0)
        int d0, d1, d2; TileRegs trA, trB;
        NEXT_BLK(d0); NEXT_BLK(d1);
        LOAD_BLK(trA, d0); if (d1 >= 0) LOAD_BLK(trB, d1);
        __syncthreads();
        for (;;) {
            tile_store(TB, trA, tid); __syncthreads();
            NEXT_BLK(d2); if (d2 >= 0) LOAD_BLK(trA, d2);
            DO_BLK(d0, TB);
            if (d1 < 0) break;
            tile_store(TB + TILE_BYTES, trB, tid); __syncthreads();
            NEXT_BLK(d0); if (d0 >= 0) LOAD_BLK(trB, d0);
            DO_BLK(d1, TB + TILE_BYTES);
            if (d2 < 0) break;
            d1 = d0; d0 = d2;
        }
        FOLD(g2);
#undef NEXT_BLK
#undef LOAD_BLK
#undef FOLD
#undef DO_BLK
#pragma unroll
        for (int i = 0; i < 16; ++i) { out0[i] = PARK[i * 64]; out1[i] = PARK[(16 + i) * 64]; }
    }
    bf16* MIX = wsp<bf16>(C, WS_MIX) + m * DM + 1024 + head * 64;
    if (!skipblk)
#pragma unroll
    for (int i4 = 0; i4 < 4; ++i4) {
        v2u o; o.x = pk2(out0[4 * i4], out0[4 * i4 + 1]); o.y = pk2(out0[4 * i4 + 2], out0[4 * i4 + 3]); *(v2u*)(MIX + 8 * i4 + 4 * hi) = o;
        o.x = pk2(out1[4 * i4], out1[4 * i4 + 1]); o.y = pk2(out1[4 * i4 + 2], out1[4 * i4 + 3]); *(v2u*)(MIX + 32 + 8 * i4 + 4 * hi) = o;
    }
}

template <class RowFn> DI void samp_block(const RowFn& rowptr, int nvalid, int kvh, const LAS float* QS, LAS float* PWw, int lane, float (&M)[4], float (&L)[4], float (&O)[4]) {
    float s[4] = {0.f, 0.f, 0.f, 0.f};
    const bool ok = lane < nvalid;
    if (ok) {
        const f32x4* kr = (const f32x4*)(rowptr(lane) + kvh * 64);
#pragma unroll 4
        for (int d4 = 0; d4 < 16; ++d4) { const f32x4 kq = kr[d4];
#pragma unroll
            for (int g = 0; g < 4; ++g) { const f32x4 qq = *(const LAS f32x4*)(QS + g * 64 + 4 * d4); s[g] += kq[0] * qq[0] + kq[1] * qq[1] + kq[2] * qq[2] + kq[3] * qq[3]; } }
    }
    float mb[4], lb[4];
#pragma unroll
    for (int g = 0; g < 4; ++g) { const float sv = ok ? s[g] : NEG_BIG; mb[g] = wave_max(sv); const float p = ok ? expf(sv - mb[g]) : 0.f; lb[g] = wave_sum(p); PWw[g * 64 + lane] = p; }
    LDS_WAIT(); asm volatile("" ::: "memory");
    float ob[4] = {0.f, 0.f, 0.f, 0.f};
    for (int r0 = 0; r0 < nvalid; r0 += 4) {
        float vv[4];
#pragma unroll
        for (int u = 0; u < 4; ++u) vv[u] = r0 + u < nvalid ? rowptr(r0 + u)[256 + kvh * 64 + lane] : 0.f;
#pragma unroll
        for (int u = 0; u < 4; ++u)
#pragma unroll
            for (int g = 0; g < 4; ++g) ob[g] += PWw[g * 64 + r0 + u] * vv[u]; }
    LDS_WAIT(); asm volatile("" ::: "memory");
#pragma unroll
    for (int g = 0; g < 4; ++g) { const float mn = fmaxf(M[g], mb[g]); const float a = expf(M[g] - mn), bsc = expf(mb[g] - mn); L[g] = L[g] * a + lb[g] * bsc; O[g] = O[g] * a + ob[g] * bsc; M[g] = mn; }
}
DI float samp_combine(LAS float* WST, int tid, int lane, int wave, const float (&M)[4], const float (&L)[4], const float (&O)[4]) {
    __syncthreads();
#pragma unroll
    for (int g = 0; g < 4; ++g) { WST[wave * 264 + 8 + g * 64 + lane] = O[g]; if (lane == 0) { WST[wave * 264 + g] = M[g]; WST[wave * 264 + 4 + g] = L[g]; } }
    __syncthreads();
    float res = 0.f;
    if (tid < 256) { const int g = tid >> 6, d = tid & 63; float mm = NEG_BIG;
#pragma unroll
        for (int w = 0; w < 8; ++w) mm = fmaxf(mm, WST[w * 264 + g]);
        float ll = 0.f, oo = 0.f;
#pragma unroll
        for (int w = 0; w < 8; ++w) { const float e = expf(WST[w * 264 + g] - mm); ll += WST[w * 264 + 4 + g] * e; oo += WST[w * 264 + 8 + g * 64 + d] * e; }
        res = oo / ll; }
    return res;
}

DI void nsa_sample_item(const Ctx& C, int l, int b, int t, int kvh) {
    const int tid = C.tid, lane = C.lane, wave = C.wave;
    LAS float* F = (LAS float*)C.lds;
    LAS float *QS = F, *PC = F + 256, *IMPS = F + 2304, *RED = F + 2624, *RED2 = F + 2688, *OCP = F + 2752, *PW = F + 4800, *WST = F + 6848;
    LAS int* SELB = (LAS int*)(F + 2560);
    const bf16* P = wsp<bf16>(C, WS_PROJ);
    const size_t m = (size_t)NTP + b * 4 + t;
    __syncthreads();
    if (tid < 256) QS[tid] = bf2f(P[m * PLD + Q_OFF + kvh * 256 + tid]) * 0.125f;
    __syncthreads();
    float ocmp = 0.f;
    {
        const float* KC = wsp<float>(C, WS_KCBS) + ((size_t)((l * 8 + b) * 4 + kvh) * 512) * 64;
        const float* VC = wsp<float>(C, WS_VCBS) + ((size_t)((l * 8 + b) * 4 + kvh) * 512) * 64;
        float s[4] = {0.f, 0.f, 0.f, 0.f};
        const f32x4* kr = (const f32x4*)(KC + (size_t)tid * 64);
#pragma unroll 4
        for (int d4 = 0; d4 < 16; ++d4) { const f32x4 kq = kr[d4];
#pragma unroll
            for (int g = 0; g < 4; ++g) { const f32x4 qq = *(const LAS f32x4*)(QS + g * 64 + 4 * d4); s[g] += kq[0] * qq[0] + kq[1] * qq[1] + kq[2] * qq[2] + kq[3] * qq[3]; } }
#pragma unroll
        for (int g = 0; g < 4; ++g) { const float wm = wave_max(s[g]); if (lane == 0) RED[wave * 4 + g] = wm; }
        __syncthreads();
        float p[4];
#pragma unroll
        for (int g = 0; g < 4; ++g) { float mm = RED[g];
#pragma unroll
            for (int w = 1; w < 8; ++w) mm = fmaxf(mm, RED[w * 4 + g]);
            p[g] = expf(s[g] - mm); const float ws = wave_sum(p[g]); if (lane == 0) RED2[wave * 4 + g] = ws; }
        __syncthreads();
#pragma unroll
        for (int g = 0; g < 4; ++g) { float tot = 0.f;
#pragma unroll
            for (int w = 0; w < 8; ++w) tot += RED2[w * 4 + g];
            PC[g * 512 + tid] = p[g] / tot; }
        __syncthreads();
        if (tid < 256) IMPS[tid] = (PC[2 * tid] + PC[2 * tid + 1]) + (PC[512 + 2 * tid] + PC[512 + 2 * tid + 1]) + (PC[1024 + 2 * tid] + PC[1024 + 2 * tid + 1]) + (PC[1536 + 2 * tid] + PC[1536 + 2 * tid + 1]);
        { const int d = tid & 63, nq = tid >> 6; float acc[4] = {0.f, 0.f, 0.f, 0.f};
#pragma unroll 4
            for (int n = nq * 64; n < nq * 64 + 64; ++n) { const float vv = VC[(size_t)n * 64 + d];
#pragma unroll
                for (int g = 0; g < 4; ++g) acc[g] += PC[g * 512 + n] * vv; }
#pragma unroll
            for (int g = 0; g < 4; ++g) OCP[(nq * 4 + g) * 64 + d] = acc[g]; }
        __syncthreads();
        if (tid < 256) { const int g = tid >> 6, d = tid & 63;
#pragma unroll
            for (int nq = 0; nq < 8; ++nq) ocmp += OCP[(nq * 4 + g) * 64 + d];
            const int j = tid;
            if (j >= 1 && j <= 254) { const float v = IMPS[j]; int rank = 0;
                for (int jp = 1; jp <= 254; ++jp) { const float ov = IMPS[jp]; rank += (ov > v || (ov == v && jp < j)) ? 1 : 0; }
                if (rank < 13) SELB[rank] = j; }
            if (tid == 0) { SELB[13] = 0; SELB[14] = 255; SELB[15] = 256; }
        }
        __syncthreads();
    }
    float osel;
    {
        float M[4] = {NEG_BIG, NEG_BIG, NEG_BIG, NEG_BIG}, L[4] = {0.f, 0.f, 0.f, 0.f}, O[4] = {0.f, 0.f, 0.f, 0.f};
        const int* pt = (const int*)C.inp(4) + b * 128;
        for (int bi = 0; bi < 2; ++bi) {
            const int jb = __builtin_amdgcn_readfirstlane(SELB[2 * wave + bi]);
            if (jb < 256) { const int pid = pt[jb >> 1];
                const float* base = C.inp(3) + ((size_t)(l * NPOOL + pid) * 128 + (jb & 1) * 64) * 512;
                samp_block([&](int r) { return base + (size_t)r * 512; }, 64, kvh, QS, PW + wave * 256, lane, M, L, O);
            } else { const float* base = C.out + O_SEL_S + ((size_t)l * NTS + b * 4) * 512;
                samp_block([&](int r) { return base + (size_t)r * 512; }, t + 1, kvh, QS, PW + wave * 256, lane, M, L, O); }
        }
        osel = samp_combine(WST, tid, lane, wave, M, L, O);
    }
    float owin;
    {
        float M[4] = {NEG_BIG, NEG_BIG, NEG_BIG, NEG_BIG}, L[4] = {0.f, 0.f, 0.f, 0.f}, O[4] = {0.f, 0.f, 0.f, 0.f};
        const float* pre = C.inp(5) + (size_t)(l * 8 + b) * 262144;
        const float* nw = C.out + O_WIN_S + ((size_t)(l * 8 + b) * 512 + 508) * 512;
        samp_block([&](int r) { const int p = t + 1 + 64 * wave + r; return p <= 511 ? pre + (size_t)p * 512 : nw + (size_t)(p - 512) * 512; }, 64, kvh, QS, PW + wave * 256, lane, M, L, O);
        owin = samp_combine(WST, tid, lane, wave, M, L, O);
    }
    if (tid < 256) { const int g = tid >> 6, d = tid & 63, head = kvh * 4 + g;
        const float g0 = sigmoidf_(bf2f(P[m * PLD + GL_OFF + head * 3 + 0])), g1 = sigmoidf_(bf2f(P[m * PLD + GL_OFF + head * 3 + 1])), g2 = sigmoidf_(bf2f(P[m * PLD + GL_OFF + head * 3 + 2]));
        const float o = g0 * ocmp + g1 * osel + g2 * owin;
        wsp<bf16>(C, WS_MIX)[m * DM + 1024 + head * 64 + d] = (unsigned short)(pk2(o, 0.f) & 0xffffu); }
}

#ifndef C_MASK
#define C_MASK 7
#endif
constexpr int PC_SCAN_P = 128, PC_ATT_P = 512, PC_ATT_S = 128, PC_SCAN_S = 128, PC_ITEMS = PC_SCAN_P + PC_ATT_P + PC_ATT_S + PC_SCAN_S;
DI void phase_c(const Ctx& C0, int lq, int cmask = 7) {
    const int l = lq & 1;
    LAS int* slot = (LAS int*)(C0.lds + MISC_OFF + 64);
    for (;;) {
        __syncthreads();
        if (C0.tid == 0) *slot = (int)atomicAdd(C0.ctl + CW_QUEUE + 64 * lq, 1u);
        __syncthreads();
        int it = *slot;
        if (it >= PC_ITEMS) {
            if (lq != 0 || it - PC_ITEMS >= DEF_GROUPS) break;
            Ctx K = C0; { K.ws = launder_g(K.ws); K.out = launder_g(K.out); int t_ = K.tid; asm volatile("" : "+v"(t_)); K.tid = t_; K.lane = t_ & 63; K.wave = __builtin_amdgcn_readfirstlane(t_ >> 6); }
            for (int e = 0; e < 4; ++e) deferred_item(K, (it - PC_ITEMS) * 4 + e);
            continue;
        }
        Ctx K = C0; { K.ws = launder_g(K.ws); K.out = launder_g(K.out); int t_ = K.tid; asm volatile("" : "+v"(t_)); K.tid = t_; K.lane = t_ & 63; K.wave = __builtin_amdgcn_readfirstlane(t_ >> 6); }
        const Ctx& C = K;
        if (it >= PC_SCAN_P && it < PC_SCAN_P + PC_ATT_S) it += PC_ATT_P; else if (it >= PC_SCAN_P + PC_ATT_S && it < PC_SCAN_P + PC_ATT_S + PC_ATT_P) it -= PC_ATT_S;
        if (it < PC_SCAN_P || it >= PC_SCAN_P + PC_ATT_P + PC_ATT_S) {
            int row0, T, h; const float* S0; float* So;
            int cmode = 0;
            if (it < PC_SCAN_P) { const int u = it & 63, b = u >> 4; cmode = it < 64 ? 1 : 0; h = u & 15; row0 = b * 2048; T = 2048; S0 = nullptr; So = C.out + O_RW_P + ((size_t)(l * 4 + b) * 16 + h) * 4096; }
            else { const int u = it - (PC_SCAN_P + PC_ATT_P + PC_ATT_S), b = u >> 4; h = u & 15; row0 = NTP + b * 4; T = 4; S0 = C.inp(6) + ((size_t)(l * 8 + b) * 16 + h) * 4096; So = C.out + O_RW_S + ((size_t)(l * 8 + b) * 16 + h) * 4096; }
            if (cmask & 1) { if (S0) scan_head(C, l, row0, T, h, S0, So); else if (cmode) chunk_head<1>(C, l, row0 >> 11, h, So, cmode); else chunk_head<0>(C, l, row0 >> 11, h, So, 0); }
        } else if (it < PC_SCAN_P + PC_ATT_P) {
            const int u = it - PC_SCAN_P, qt = 31 - (u >> 4), bk = u & 15;
            if (cmask & 2) nsa_prompt_unit(C, l, bk >> 2, bk & 3, qt, (cmask & 8) != 0, (cmask & 16) != 0);
        } else {
            const int u = it - (PC_SCAN_P + PC_ATT_P);
            if (cmask & 4) nsa_sample_item(C, l, u >> 4, (u >> 2) & 3, u & 3);
        }
    }
    __syncthreads();
}

DI const float* xin_row(const Ctx& C, int l, size_t m) {
    if (l == 0) return m < (size_t)NTP ? C.inp(0) + m * DM : C.inp(1) + (m - NTP) * DM;
    return wsp<float>(C, WS_XF1) + m * DM;
}
DI void ln_stage_gb(const Ctx& C, const float* gw, const float* bw) {
    __syncthreads();
    { const f32x4 g4 = ((const f32x4*)gw)[C.tid], b4 = ((const f32x4*)bw)[C.tid]; ((LAS f32x4*)C.lds)[C.tid] = g4; ((LAS f32x4*)(C.lds + 8192))[C.tid] = b4; }
    __syncthreads();
}
DI void phase_e(const Ctx& C, int l) {
    const int lane = C.lane;
    const bf16* H = wsp<bf16>(C, WS_HS);
    bf16* X1B = wsp<bf16>(C, WS_X1B); const bf16* XB = wsp<bf16>(C, WS_XB);
    ln_stage_gb(C, C.inp(22) + (size_t)l * DM, C.inp(23) + (size_t)l * DM);
    const LAS f32x4* GL = (const LAS f32x4*)C.lds; const LAS f32x4* BL = (const LAS f32x4*)(C.lds + 8192);
    const int stride = C.G * NWAVES;
    f32x4 xf[8]; v2u xh[8], hh[8];
#define E_LOAD(mm) do { const v2u* hr_ = (const v2u*)(H + (size_t)(mm) * DM) + lane; \
        if (l == 0) { const f32x4* xr_ = (const f32x4*)xin_row(C, l, (mm)) + lane; _Pragma("unroll") for (int j = 0; j < 8; ++j) { xf[j] = xr_[64 * j]; hh[j] = hr_[64 * j]; } } \
        else { const v2u* xr_ = (const v2u*)(XB + (size_t)(mm) * DM) + lane; _Pragma("unroll") for (int j = 0; j < 8; ++j) { xh[j] = xr_[64 * j]; hh[j] = hr_[64 * j]; } } } while (0)
    int m = blockIdx.x * NWAVES + C.wave;
    if (m < NT) E_LOAD(m);
    for (; m < NT; m += stride) {
        f32x4 v[8]; float s = 0.f;
#pragma unroll
        for (int j = 0; j < 8; ++j) { const f32x4 hv = {bflo(hh[j].x), bfhi(hh[j].x), bflo(hh[j].y), bfhi(hh[j].y)};
            v[j] = (l == 0 ? xf[j] : (f32x4){bflo(xh[j].x), bfhi(xh[j].x), bflo(xh[j].y), bfhi(xh[j].y)}) * DN_ALPHA + hv; }
        if (m + stride < NT) E_LOAD(m + stride);
#pragma unroll
        for (int j = 0; j < 8; ++j) s += (v[j][0] + v[j][1]) + (v[j][2] + v[j][3]);
        const float mean = wave_sum(s) * (1.f / DM); float s2 = 0.f;
#pragma unroll
        for (int j = 0; j < 8; ++j) { v[j] = v[j] - mean; s2 += (v[j][0] * v[j][0] + v[j][1] * v[j][1]) + (v[j][2] * v[j][2] + v[j][3] * v[j][3]); }
        const float rstd = __builtin_amdgcn_rsqf(wave_sum(s2) * (1.f / DM) + LN_EPS);
        float am = 0.f;
#pragma unroll
        for (int j = 0; j < 8; ++j) { const f32x4 gg = GL[lane + 64 * j], bb = BL[lane + 64 * j];
            const f32x4 o = v[j] * rstd * gg + bb; v[j] = o;
            am = fmaxf(am, fmaxf(fmaxf(fabsf(o[0]), fabsf(o[1])), fmaxf(fabsf(o[2]), fabsf(o[3]))));
            v2u p; p.x = pk2(o[0], o[1]); p.y = pk2(o[2], o[3]); ((v2u*)(X1B + (size_t)m * DM))[lane + 64 * j] = p; }
        am = wave_max(am);
        const float qs = am > 0.f ? am * (1.f / 127.f) : 1.f, qi = 1.f / qs;
#pragma unroll
        for (int j = 0; j < 8; ++j) { const f32x4 x = v[j] * qi;
            ((unsigned*)(C.ws + WS_X1Q + (size_t)m * DM))[lane + 64 * j] = ((unsigned)(int)__builtin_rintf(x[0]) & 255u) | (((unsigned)(int)__builtin_rintf(x[1]) & 255u) << 8) | (((unsigned)(int)__builtin_rintf(x[2]) & 255u) << 16) | ((unsigned)(int)__builtin_rintf(x[3]) << 24); }
        if (lane == 0) wsp<float>(C, WS_XQS)[m] = qs;
    }
#undef E_LOAD
    __syncthreads();
}

DI float gelu_erf(float x) { return 0.5f * x * (1.f + erff(x * 0.70710678118654752f)); }
DI unsigned fkey(float f) { const unsigned u = __builtin_bit_cast(unsigned, f); return u ^ ((unsigned)((int)u >> 31) | 0x80000000u); }
DI int mbcnt64(unsigned long long m) { return __builtin_amdgcn_mbcnt_hi((unsigned)(m >> 32), __builtin_amdgcn_mbcnt_lo((unsigned)m, 0)); }
template <int NV, bool LANE_MAJOR> DI void top16(const unsigned (&key)[NV], bool (&sel)[NV], int (&pos)[NV]) {
    unsigned thr = 0u; bool exact = false;
    for (int bit = 31; bit >= 0; --bit) {
        const unsigned cand = thr | (1u << bit);
        int cnt = 0;
#pragma unroll
        for (int v = 0; v < NV; ++v) cnt += __builtin_popcountll(__ballot(key[v] >= cand));
        if (cnt >= 16) { thr = cand; if (cnt == 16) { exact = true; break; } }
    }
    unsigned long long sm[NV];
    if (exact) {
#pragma unroll
        for (int v = 0; v < NV; ++v) { sel[v] = key[v] >= thr; sm[v] = __ballot(sel[v]); }
    } else {
        unsigned long long eq[NV]; int ngt = 0;
#pragma unroll
        for (int v = 0; v < NV; ++v) { ngt += __builtin_popcountll(__ballot(key[v] > thr)); eq[v] = __ballot(key[v] == thr); }
        const int need = 16 - ngt;
#pragma unroll
        for (int v = 0; v < NV; ++v) { int rk;
            if (LANE_MAJOR) { rk = 0;
#pragma unroll
                for (int w = 0; w < NV; ++w) { rk += mbcnt64(eq[w]); if (w < v) rk += (int)((eq[w] >> (threadIdx.x & 63)) & 1ull); } }
            else { rk = mbcnt64(eq[v]);
#pragma unroll
                for (int w = 0; w < NV; ++w) if (w < v) rk += __builtin_popcountll(eq[w]); }
            sel[v] = key[v] > thr || (key[v] == thr && rk < need); sm[v] = __ballot(sel[v]); }
    }
    int base = 0;
#pragma unroll
    for (int v = 0; v < NV; ++v) { pos[v] = base + mbcnt64(sm[v]); base += __builtin_popcountll(sm[v]); }
}
typedef float f32x2v __attribute__((ext_vector_type(2)));
typedef int v4i __attribute__((ext_vector_type(4)));
typedef int v2i __attribute__((ext_vector_type(2)));
constexpr int PS_NSL = 16, PS_TOKG = 64, PS_NGRP = (NT + PS_TOKG - 1) / PS_TOKG;
static_assert(NT % 8 == 0, "a wave's 8 tokens of a group are all valid or all invalid");
template <int NP, int NV> DI void top16_search(const unsigned (&key)[NP][NV], unsigned (&thr)[NP], bool (&ex)[NP]) {
    int c16[NP];
#pragma unroll
    for (int p = 0; p < NP; ++p) { thr[p] = 0u; c16[p] = 64 * NV; }
    for (unsigned bm = 0x80000000u; bm != 0u; bm >>= 1) {
        unsigned cand[NP]; unsigned long long bl[NP][NV]; int cnt[NP];
#pragma unroll
        for (int p = 0; p < NP; ++p) cand[p] = thr[p] | bm;
#pragma unroll
        for (int p = 0; p < NP; ++p)
#pragma unroll
            for (int v = 0; v < NV; ++v) bl[p][v] = __ballot(key[p][v] >= cand[p]);
#pragma unroll
        for (int p = 0; p < NP; ++p) { cnt[p] = 0;
#pragma unroll
            for (int v = 0; v < NV; ++v) cnt[p] += __builtin_popcountll(bl[p][v]); }
        int diff = 0;
#pragma unroll
        for (int p = 0; p < NP; ++p) { const bool ge = cnt[p] >= 16; thr[p] = ge ? cand[p] : thr[p]; c16[p] = ge ? cnt[p] : c16[p]; diff |= c16[p] ^ 16; }
        if (diff == 0) break;
    }
#pragma unroll
    for (int p = 0; p < NP; ++p) ex[p] = c16[p] == 16;
}
template <int NV, bool LANE_MAJOR> DI void top16_finish(const unsigned (&key)[NV], unsigned thr, bool exact, bool (&sel)[NV], int (&pos)[NV]) {
    unsigned long long sm[NV];
    if (exact) {
#pragma unroll
        for (int v = 0; v < NV; ++v) { sel[v] = key[v] >= thr; sm[v] = __ballot(sel[v]); }
    } else {
        unsigned long long eq[NV]; int ngt = 0;
#pragma unroll
        for (int v = 0; v < NV; ++v) { ngt += __builtin_popcountll(__ballot(key[v] > thr)); eq[v] = __ballot(key[v] == thr); }
        const int need = 16 - ngt;
#pragma unroll
        for (int v = 0; v < NV; ++v) { int rk;
            if (LANE_MAJOR) { rk = 0;
#pragma unroll
                for (int w = 0; w < NV; ++w) { rk += mbcnt64(eq[w]); if (w < v) rk += (int)((eq[w] >> (threadIdx.x & 63)) & 1ull); } }
            else { rk = mbcnt64(eq[v]);
#pragma unroll
                for (int w = 0; w < NV; ++w) if (w < v) rk += __builtin_popcountll(eq[w]); }
            sel[v] = key[v] > thr || (key[v] == thr && rk < need); sm[v] = __ballot(sel[v]); }
    }
    int base = 0;
#pragma unroll
    for (int v = 0; v < NV; ++v) { pos[v] = base + mbcnt64(sm[v]); base += __builtin_popcountll(sm[v]); }
}
DI float row_max16(float v) { v = fmaxf(v, dppf<0xB1>(v)); v = fmaxf(v, dppf<0x4E>(v)); v = fmaxf(v, dppf<0x141>(v)); return fmaxf(v, dppf<0x140>(v)); }
DI float row_sum16(float v) { v += dppf<0xB1>(v); v += dppf<0x4E>(v); v += dppf<0x141>(v); return v + dppf<0x140>(v); }
template <int CTRL, bool BC> DI int dppi(int v) { return __builtin_amdgcn_update_dpp(0, v, CTRL, 0xF, 0xF, BC); }
DI int row_sum16i(int v) { v += dppi<0xB1, false>(v); v += dppi<0x4E, false>(v); v += dppi<0x141, false>(v); v += dppi<0x140, false>(v); return v; }
DI int row_scan16i(int v) { v += dppi<0x111, true>(v); v += dppi<0x112, true>(v); v += dppi<0x114, true>(v); v += dppi<0x118, true>(v); return v; }
DI unsigned row_max16u(unsigned v) { v = max(v, (unsigned)dppi<0xB1, false>((int)v)); v = max(v, (unsigned)dppi<0x4E, false>((int)v)); v = max(v, (unsigned)dppi<0x141, false>((int)v)); return max(v, (unsigned)dppi<0x140, false>((int)v)); }
DI unsigned row_min16u(unsigned v) { v = min(v, (unsigned)dppi<0xB1, false>((int)v)); v = min(v, (unsigned)dppi<0x4E, false>((int)v)); v = min(v, (unsigned)dppi<0x141, false>((int)v)); return min(v, (unsigned)dppi<0x140, false>((int)v)); }
template <int NK> DI unsigned row_top16_search(unsigned (&key)[NK]) {
    unsigned lm = key[0];
#pragma unroll
    for (int j = 1; j < NK; ++j) lm = max(lm, key[j]);
    const unsigned kmax = row_max16u(lm), L = row_min16u(lm), sp1 = kmax - L + 1u;
    const unsigned spw = max(max((unsigned)__builtin_amdgcn_readlane((int)sp1, 0), (unsigned)__builtin_amdgcn_readlane((int)sp1, 16)), max((unsigned)__builtin_amdgcn_readlane((int)sp1, 32), (unsigned)__builtin_amdgcn_readlane((int)sp1, 48)));
    const int B = spw == 0u ? 32 : 32 - __builtin_clz(spw);
    const unsigned M = B == 32 ? 0xFFFFFFFFu : (1u << B) - 1u, off = kmax - M, lo = L - 1u;
#pragma unroll
    for (int j = 0; j < NK; ++j) key[j] = max(key[j], lo) - off;
    unsigned thr = 0u; int c16 = 16 * NK;
    for (unsigned bm = 1u << (B - 1); bm != 0u; bm >>= 1) {
        const unsigned cand = thr | bm; int cnt = 0;
#pragma unroll
        for (int j = 0; j < NK; ++j) cnt += key[j] >= cand ? 1 : 0;
        cnt = row_sum16i(cnt);
        const bool ge = cnt >= 16; thr = ge ? cand : thr; c16 = ge ? cnt : c16;
        if (__ballot(c16 != 16) == 0ull) break;
    }
    return thr;
}
template <int NK> DI void row_top16_place(const unsigned (&key)[NK], unsigned thr, int (&pos)[NK]) {
    int cg = 0, ce = 0;
#pragma unroll
    for (int j = 0; j < NK; ++j) { cg += key[j] > thr ? 1 : 0; ce += key[j] == thr ? 1 : 0; }
    const int pk = cg | (ce << 8);
    const int exc = row_scan16i(pk) - pk, tot = row_sum16i(pk);
    int pg_ = exc & 255, pe_ = (tot & 255) + (exc >> 8);
#pragma unroll
    for (int j = 0; j < NK; ++j) { const bool g = key[j] > thr, e = key[j] == thr; pos[j] = g ? pg_ : (e ? pe_ : 16); pg_ += g ? 1 : 0; pe_ += e ? 1 : 0; }
}
DI void peer_topk(const Ctx& C, int l) {
    const int lane = C.lane, wave = C.wave, n = lane & 15, r = lane >> 4;
    LAS float* WL = (LAS float*)(C.lds + 65536 + 256 + wave * 2048 + r * 384);
    LAS int* WLi = (LAS int*)WL;
    const float* Sc = wsp<float>(C, WS_HS);
    unsigned short* EL = wsp<unsigned short>(C, WS_EL); float* GT = wsp<float>(C, WS_GT);
    static_assert(NT % 4 == 0, "token quads");
    for (int m = 4 * blockIdx.x; m < NT; m += 4 * C.G) {
        const float* sr = Sc + (size_t)(m + r) * DM + wave * 256 + 8 * n;
        f32x4 sv[2][2];
#pragma unroll
        for (int c = 0; c < 2; ++c) { sv[c][0] = *(const f32x4*)(sr + 128 * c); sv[c][1] = *(const f32x4*)(sr + 128 * c + 4); }
#pragma unroll
        for (int c = 0; c < 2; ++c) {
            unsigned key[8]; int pos[8];
#pragma unroll
            for (int j = 0; j < 8; ++j) key[j] = fkey(sv[c][j >> 2][j & 3]);
            const unsigned thr = row_top16_search<8>(key);
            row_top16_place<8>(key, thr, pos);
#pragma unroll
            for (int j = 0; j < 8; ++j) if (pos[j] < 16) { WL[32 * c + pos[j]] = sv[c][j >> 2][j & 3]; WLi[32 * c + 16 + pos[j]] = 8 * n + j; }
        }
        LDS_WAIT(); asm volatile("" ::: "memory");
        {
            const float x0 = WL[n]; const int e0 = WLi[16 + n] * 128;
            float cd[16]; unsigned key[16]; int pos[16];
#pragma unroll
            for (int q = 0; q < 4; ++q) { const f32x4 x1 = *(const LAS f32x4*)(WL + 32 + 4 * q);
#pragma unroll
                for (int e = 0; e < 4; ++e) { cd[4 * q + e] = x0 + x1[e]; key[4 * q + e] = fkey(cd[4 * q + e]); } }
            const unsigned thr = row_top16_search<16>(key);
            row_top16_place<16>(key, thr, pos);
#pragma unroll
            for (int b = 0; b < 16; ++b) if (pos[b] < 16) { WL[64 + pos[b]] = cd[b]; WLi[80 + pos[b]] = e0 + WLi[48 + b]; }
        }
        LDS_WAIT(); asm volatile("" ::: "memory");
        { const float tv = WL[64 + n];
          const float ev = expf(tv - row_max16(tv));
          const float gate = ev / row_sum16(ev);
          EL[(size_t)(m + r) * 128 + wave * 16 + n] = (unsigned short)WLi[80 + n]; GT[(size_t)(m + r) * 128 + wave * 16 + n] = gate; }
        LDS_WAIT(); asm volatile("" ::: "memory");
    }
}
template <int SIDE> DI void peer_sliced(const Ctx& C, int l, int lq) {
    const int tid = C.tid, lane = C.lane, wave = C.wave, pg = lane >> 3, dq = lane & 7;
    LAS int* slot = (LAS int*)(C.lds + MISC_OFF + 64);
    const unsigned char* TAB = C.ws + (SIDE ? WS_VB : WS_UB) + (size_t)l * NEXP * DM;
    const unsigned char* X1Q = C.ws + WS_X1Q;
    const unsigned short* EL = wsp<unsigned short>(C, WS_EL); const float* WP = wsp<float>(C, WS_WP);
    bf16* PD = wsp<bf16>(C, WS_PD); bf16* FO = wsp<bf16>(C, WS_FO);
    unsigned* const Q0 = C.ctl + CW_SQ + 64 * ((lq * 2 + SIDE) * 16);
    const int s_first = (int)((2u * xb_xcc_id()) & (PS_NSL - 1));
    int k = 0;
    for (;;) {
        __syncthreads();
        if (tid == 0) { int got = -1;
            while (k < PS_NSL) { const int s = (s_first + k) & (PS_NSL - 1); const unsigned g = atomicAdd(Q0 + 64 * s, 1u); if (g < (unsigned)PS_NGRP) { got = (s << 16) | (int)g; break; } ++k; }
            *slot = got; }
        __syncthreads();
        const int d = __builtin_amdgcn_readfirstlane(*slot);
        if (d < 0) break;
        const int s = d >> 16, g = d & 0xffff;
        const int t0 = g * PS_TOKG + wave * 8;
        if (t0 >= NT) continue;
        const unsigned char* TS = TAB + (size_t)s * NEXP * 128;
        const unsigned dq16 = (unsigned)dq * 16u;
        v4u E[2][2]; v4u R[2][16]; f32x4 A[2][4]; v4u AQ[2];
        LAS unsigned char* const WB = C.lds + wave * 4352;
        const int wofs = pg * 512 + dq * 64, rofs = (lane >> 3) * 64 + 16 * (((lane & 7) >> 1) ^ ((lane >> 3) & 3)) + 8 * (lane & 1);
#define PS_LOAD_E(b, t) do { const v4u* ep_ = (const v4u*)(EL + (size_t)(t) * 128 + 16 * pg); E[b][0] = ep_[0]; E[b][1] = ep_[1]; } while (0)
#define PS_LOAD_R(b, t) do { \
            _Pragma("unroll") for (int i = 0; i < 16; ++i) { const unsigned w_ = E[b][i >> 3][(i >> 1) & 3]; const unsigned e_ = (i & 1) ? (w_ >> 16) : (w_ & 0xffffu); \
                R[b][i] = *(const v4u*)(TS + ((e_ << 7) | dq16)); } \
            if (SIDE == 0) AQ[b] = *(const v4u*)(X1Q + (size_t)(t) * DM + 128 * s + 16 * dq); \
            else { const f32x4* ap_ = (const f32x4*)(WP + (size_t)(t) * 128 + 16 * pg); _Pragma("unroll") for (int q = 0; q < 4; ++q) A[b][q] = ap_[q]; } } while (0)
        PS_LOAD_E(0, t0); PS_LOAD_E(1, t0 + 1);
        PS_LOAD_R(0, t0);
#pragma unroll
        for (int j = 0; j < 8; ++j) {
            const int b = j & 1, t = t0 + j;
            if (j + 2 < 8) PS_LOAD_E(b, t + 2);
            if (j + 1 < 8) PS_LOAD_R(b ^ 1, t + 1);
            __builtin_amdgcn_sched_barrier(0);
            if (SIDE == 0) {
                int dd[16];
#pragma unroll
                for (int i = 0; i < 16; ++i) { int a = 0;
#pragma unroll
                    for (int q = 0; q < 4; ++q) a = __builtin_amdgcn_sdot4((int)R[b][i][q], (int)AQ[b][q], a, false);
                    dd[i] = a; }
#pragma unroll
                for (int q = 0; q < 4; ++q) *(LAS v4i*)(WB + dq * 528 + pg * 64 + 16 * q) = (v4i){dd[4 * q], dd[4 * q + 1], dd[4 * q + 2], dd[4 * q + 3]};
                v2i rs = {0, 0};
#pragma unroll
                for (int d8 = 0; d8 < 8; ++d8) rs += *(const LAS v2i*)(WB + 8 * lane + 528 * d8);
                *(unsigned*)(PD + ((size_t)t * PS_NSL + s) * 128 + 2 * lane) = pk2((float)rs.x, (float)rs.y);
            } else {
                f32x2v acc[8];
#pragma unroll
                for (int q = 0; q < 8; ++q) acc[q] = (f32x2v){0.f, 0.f};
#pragma unroll
                for (int i = 0; i < 16; ++i) { const float w = A[b][i >> 2][i & 3]; const f32x2v w2 = {w, w};
#pragma unroll
                    for (int q = 0; q < 4; ++q) { const int wd = (int)R[b][i][q]; acc[2 * q] += w2 * __builtin_amdgcn_cvt_pk_f32_fp8(wd, false); acc[2 * q + 1] += w2 * __builtin_amdgcn_cvt_pk_f32_fp8(wd, true); } }
#pragma unroll
                for (int q = 0; q < 4; ++q) *(LAS f32x4*)(WB + wofs + 16 * (q ^ (dq & 3))) = (f32x4){acc[2 * q].x, acc[2 * q].y, acc[2 * q + 1].x, acc[2 * q + 1].y};
                f32x2v rs = {0.f, 0.f};
#pragma unroll
                for (int h8 = 0; h8 < 8; ++h8) rs += *(const LAS f32x2v*)(WB + rofs + 512 * h8);
                *(unsigned*)(FO + (size_t)t * DM + 128 * s + 2 * lane) = pk2(rs.x, rs.y);
            }
        }
#undef PS_LOAD_E
#undef PS_LOAD_R
    }
}
DI void peer_gelu(const Ctx& C, int l) {
    const unsigned short* EL = wsp<unsigned short>(C, WS_EL); const float* GT = wsp<float>(C, WS_GT); const bf16* PD = wsp<bf16>(C, WS_PD); float* WP = wsp<float>(C, WS_WP);
    const float* USC = wsp<float>(C, WS_USC) + (size_t)l * NEXP; const float* VSC = USC + 2 * NEXP; const float* XQS = wsp<float>(C, WS_XQS);
    for (int idx = blockIdx.x * NTHREADS + C.tid; idx < NT * 128; idx += C.G * NTHREADS) {
        const int t = idx >> 7, p = idx & 127; const unsigned e = EL[idx];
        float h = 0.f;
#pragma unroll
        for (int s = 0; s < PS_NSL; ++s) h += bf2f(PD[((size_t)t * PS_NSL + s) * 128 + p]);
        WP[idx] = GT[idx] * gelu_erf(h * USC[e] * XQS[t]) * VSC[e];
    }
}
DI void peer_ln2(const Ctx& C, int l) {
    const int lane = C.lane;
    const bf16* X1B = wsp<bf16>(C, WS_X1B); const bf16* FO = wsp<bf16>(C, WS_FO);
    ln_stage_gb(C, C.inp(28) + (size_t)l * DM, C.inp(29) + (size_t)l * DM);
    const LAS f32x4* GL = (const LAS f32x4*)C.lds; const LAS f32x4* BL = (const LAS f32x4*)(C.lds + 8192);
    const int stride = C.G * NWAVES;
    v2u xh[8], fh[8];
#define G5_LOAD(mm) do { const v2u* xr_ = (const v2u*)(X1B + (size_t)(mm) * DM) + lane; const v2u* fr_ = (const v2u*)(FO + (size_t)(mm) * DM) + lane; \
        _Pragma("unroll") for (int j = 0; j < 8; ++j) { xh[j] = xr_[64 * j]; fh[j] = fr_[64 * j]; } } while (0)
    int m = blockIdx.x * NWAVES + C.wave;
    if (m < NT) G5_LOAD(m);
    for (; m < NT; m += stride) {
        f32x4 v[8]; float s = 0.f;
#pragma unroll
        for (int j = 0; j < 8; ++j) { v[j] = (f32x4){bflo(xh[j].x), bfhi(xh[j].x), bflo(xh[j].y), bfhi(xh[j].y)} * DN_ALPHA + (f32x4){bflo(fh[j].x), bfhi(fh[j].x), bflo(fh[j].y), bfhi(fh[j].y)}; s += (v[j][0] + v[j][1]) + (v[j][2] + v[j][3]); }
        if (m + stride < NT) G5_LOAD(m + stride);
        const float mean = wave_sum(s) * (1.f / DM); float s2 = 0.f;
#pragma unroll
        for (int j = 0; j < 8; ++j) { v[j] = v[j] - mean; s2 += (v[j][0] * v[j][0] + v[j][1] * v[j][1]) + (v[j][2] * v[j][2] + v[j][3] * v[j][3]); }
        const float rstd = __builtin_amdgcn_rsqf(wave_sum(s2) * (1.f / DM) + LN_EPS);
#pragma unroll
        for (int j = 0; j < 8; ++j) { const f32x4 gg = GL[lane + 64 * j], bb = BL[lane + 64 * j];
            const f32x4 o = v[j] * rstd * gg + bb;
            if (l == 0) {
                v2u p; p.x = pk2(o[0], o[1]); p.y = pk2(o[2], o[3]); ((v2u*)(wsp<bf16>(C, WS_XB) + (size_t)m * DM))[lane + 64 * j] = p; }
            else { float* dst = m < NTP ? C.out + O_YP + (size_t)m * DM : C.out + O_YS + (size_t)(m - NTP) * DM; ((f32x4*)dst)[lane + 64 * j] = o; } }
    }
#undef G5_LOAD
    __syncthreads();
}

#ifndef PH_MASK
#define PH_MASK 0xFF
#endif
#define IN(k) (lo <= (k) && (k) < hi)
#define EN(s) ((PH_MASK >> (s)) & 1)
#define FRESH(CX) Ctx CX = C; { CX.ws = launder_g(CX.ws); CX.out = launder_g(CX.out); int t_ = CX.tid; asm volatile("" : "+v"(t_)); CX.tid = t_; CX.lane = t_ & 63; CX.wave = __builtin_amdgcn_readfirstlane(t_ >> 6); CX.ctl = (unsigned*)(CX.ws + WS_CTL); }
#ifndef PROBE_REP
#define PROBE_REP 0
#endif
#ifndef PROBE_PMASK
#define PROBE_PMASK 31
#endif
#ifndef PROBE_CMASK
#define PROBE_CMASK 7
#endif
#define NREP(s) (((PROBE_REP >> (s)) & 1) ? 2 : 1)
#ifndef PROBE_G
#define PROBE_G 0
#endif
#define GREP(s) (((PROBE_G >> (s)) & 1) ? 2 : 1)
#define REPBAR(s, rep) do { if (NREP(s) == 2 && (rep) == 0 && (hi - lo) > 1) xcd_barrier(bar); } while (0)
#define SEAM(k) do { if (IN(k) && IN((k) + 1)) xcd_barrier(bar); } while (0)
template <int l> DI void run_layer(const Ctx& C, const XcdBarrier& bar, int lo, int hi) {
        const int pb = 1 + 11 * l;
        _Pragma("unroll") for (int rep = 0; rep < NREP(0); ++rep) if (EN(0) && IN(pb + 0)) {
            FRESH(K);
            pg8::Gemm g{wsp<bf16>(K, WS_XB), wsp<bf16>(K, WS_WIN) + (size_t)l * PLD * DM, NTP, PLD, DM}; pg8::StaticOrder S; S.init(NTP, PLD, K.G, (int)blockIdx.x);
            EpiInProj E{wsp<bf16>(K, WS_PROJ), K.out, l};
            pg8::gemm_phase<EpiInProj, pg8::StaticOrder, true, true>(K.lds, g, S, E);
            { bf16* P = wsp<bf16>(K, WS_PROJ); float* out = K.out;
              skinny_gemm(K, wsp<bf16>(K, WS_XB) + (size_t)NTP * DM, wsp<bf16>(K, WS_WIN) + (size_t)l * PLD * DM, (IN_COLS + 31) / 32, [&](int j, int col, float v) {
                  P[(size_t)(NTP + j) * PLD + col] = (unsigned short)(pk2(v, 0.f) & 0xffffu);
                  const int b = j >> 2, t = j & 3;
                  if (col < RW_COLS) { if (t == 3) out[O_SH_S + (size_t)(l * 8 + b) * RW_COLS + col] = v; }
                  else if (col >= KC_OFF && col < GL_OFF) { const int c = col - KC_OFF, reg = c >> 9, cc = c & 511;
                      if (reg == 0) out[O_CMP_S + ((size_t)l * NTS + j) * 512 + cc] = v; else if (reg == 1) out[O_SEL_S + ((size_t)l * NTS + j) * 512 + cc] = v;
                      else out[O_WIN_S + ((size_t)(l * 8 + b) * 512 + 508 + t) * 512 + cc] = v; } }); }
            REPBAR(0, rep);
        }
        SEAM(pb + 0);
        _Pragma("unroll") for (int rep = 0; rep < NREP(1); ++rep) if (EN(1) && IN(pb + 1)) { FRESH(K); phase_b(K, l, l + 2 * rep); REPBAR(1, rep); }
        SEAM(pb + 1);
        _Pragma("unroll") for (int rep = 0; rep < NREP(2); ++rep) if (EN(2) && IN(pb + 2)) { FRESH(K); phase_c(K, l + 2 * rep, rep == 0 ? 7 : PROBE_CMASK); REPBAR(2, rep); }
        SEAM(pb + 2);
        _Pragma("unroll") for (int rep = 0; rep < NREP(3); ++rep) if (EN(3) && IN(pb + 3)) {
            FRESH(K);
            pg8::Gemm g{wsp<bf16>(K, WS_MIX), wsp<bf16>(K, WS_WOUT) + (size_t)l * DM * DM, NTP, DM, DM}; pg8::StaticOrder S; S.init(NTP, DM, K.G, (int)blockIdx.x);
            EpiBf16Row E{wsp<bf16>(K, WS_HS), DM};
            pg8::gemm_phase<EpiBf16Row, pg8::StaticOrder, true, true>(K.lds, g, S, E);
            { bf16* H = wsp<bf16>(K, WS_HS) + (size_t)NTP * DM;
              skinny_gemm(K, wsp<bf16>(K, WS_MIX) + (size_t)NTP * DM, wsp<bf16>(K, WS_WOUT) + (size_t)l * DM * DM, DM / 32, [&](int j, int col, float v) { H[(size_t)j * DM + col] = (unsigned short)(pk2(v, 0.f) & 0xffffu); }); }
            REPBAR(3, rep);
        }
        SEAM(pb + 3);
        _Pragma("unroll") for (int rep = 0; rep < NREP(4); ++rep) if (EN(4) && IN(pb + 4)) { FRESH(K); phase_e(K, l); REPBAR(4, rep); }
        SEAM(pb + 4);
        _Pragma("unroll") for (int rep = 0; rep < NREP(5); ++rep) if (EN(5) && IN(pb + 5)) {
            FRESH(K);
            pg8::Gemm g{wsp<bf16>(K, WS_X1B), wsp<bf16>(K, WS_W2) + (size_t)l * DM * DM, NTP, DM, DM}; pg8::StaticOrder S; S.init(NTP, DM, K.G, (int)blockIdx.x);
            pg8::EpiF32 E{wsp<float>(K, WS_HS), DM, nullptr};
            pg8::gemm_phase<pg8::EpiF32, pg8::StaticOrder, true, true>(K.lds, g, S, E);
            { float* H = wsp<float>(K, WS_HS) + (size_t)NTP * DM;
              skinny_gemm(K, wsp<bf16>(K, WS_X1B) + (size_t)NTP * DM, wsp<bf16>(K, WS_W2) + (size_t)l * DM * DM, DM / 32, [&](int j, int col, float v) { H[(size_t)j * DM + col] = v; }); }
            REPBAR(5, rep);
        }
        SEAM(pb + 5);
        _Pragma("unroll") for (int rep = 0; rep < GREP(0); ++rep) { if (IN(pb + 6)) { FRESH(K); peer_topk(K, l); } if (GREP(0) == 2 && rep == 0) xcd_barrier(bar); }
        SEAM(pb + 6);
        _Pragma("unroll") for (int rep = 0; rep < GREP(1); ++rep) { if (IN(pb + 7)) { FRESH(K); peer_sliced<0>(K, l, l + 2 * rep); } if (GREP(1) == 2 && rep == 0) xcd_barrier(bar); }
        SEAM(pb + 7);
        _Pragma("unroll") for (int rep = 0; rep < GREP(2); ++rep) { if (IN(pb + 8)) { FRESH(K); peer_gelu(K, l); } if (GREP(2) == 2 && rep == 0) xcd_barrier(bar); }
        SEAM(pb + 8);
        _Pragma("unroll") for (int rep = 0; rep < GREP(3); ++rep) { if (IN(pb + 9)) { FRESH(K); peer_sliced<1>(K, l, l + 2 * rep); } if (GREP(3) == 2 && rep == 0) xcd_barrier(bar); }
        SEAM(pb + 9);
        _Pragma("unroll") for (int rep = 0; rep < GREP(4); ++rep) { if (IN(pb + 10)) { FRESH(K); peer_ln2(K, l); } if (GREP(4) == 2 && rep == 0) xcd_barrier(bar); }
        SEAM(pb + 10);
}
typedef ArgsK Args;
__global__ void __launch_bounds__(NTHREADS, 2) fwd_kernel(Args args) {
    extern __shared__ __attribute__((aligned(16))) unsigned char lds[];
    Ctx C;
    C.out = args.out; C.ws = args.ws; C.lds = (LAS unsigned char*)lds; C.ctl = (unsigned*)(args.ws + WS_CTL);
    C.tid = threadIdx.x; C.lane = C.tid & 63; C.wave = __builtin_amdgcn_readfirstlane(C.tid >> 6); C.G = gridDim.x;
    volatile LAS unsigned* MISC = (volatile LAS unsigned*)(C.lds + MISC_OFF);
    for (int u = C.tid; u < (LDS_BYTES - RING_BYTES) / 4; u += NTHREADS) ((LAS unsigned*)(C.lds + RING_BYTES))[u] = 0u;
    __syncthreads();
    XcdBarrier bar; bar.bar = C.ctl + CW_BAR; bar.x = 0; bar.st = nullptr;
    if (args.use_bar) bar = xcd_barrier_post(C.ctl + CW_BAR, MISC + 8);
    const int lo = args.ph_lo, hi = args.ph_hi;
#ifdef PROBE_DELAY_TICKS
    { const unsigned long long t0 = __builtin_amdgcn_s_memrealtime(); while (__builtin_amdgcn_s_memrealtime() - t0 < (unsigned long long)PROBE_DELAY_TICKS) __builtin_amdgcn_s_sleep(32); }
#endif
#ifdef PROBE_AMPLIFY
    { const unsigned long long t0 = __builtin_amdgcn_s_memrealtime(); xcd_barrier(bar);
      if (blockIdx.x == PROBE_AMPLIFY - 1) { const unsigned long long dt = __builtin_amdgcn_s_memrealtime() - t0; while (__builtin_amdgcn_s_memrealtime() - t0 < 5ull * dt) __builtin_amdgcn_s_sleep(32); } }
#endif
    _Pragma("unroll") for (int rep = 0; rep < NREP(7); ++rep) if (EN(7) && IN(0)) { FRESH(K); p0_prologue(K, NREP(7) == 1 ? 31 : (rep == 0 ? PROBE_PMASK : (31 & ~PROBE_PMASK))); REPBAR(7, rep); }
    SEAM(0);
    run_layer<0>(C, bar, lo, hi);
    run_layer<1>(C, bar, lo, hi);
#undef IN
#undef SEAM
}

#ifndef MK_ONE_LAUNCH
#define MK_ONE_LAUNCH 1
#endif
extern "C" void kernel_launch(void* const* d_in, const int* in_sizes, int n_in, void* d_out, int out_size, void* d_ws, size_t ws_size, hipStream_t stream) {
    static int grid = 0;
    if (grid == 0) {
        if (n_in != 30 || out_size != (int)O_END || ws_size < WS_END) { fprintf(stderr, "kernel_launch: unexpected shapes (n_in %d, out %d, ws %zu < %zu); nothing launched\n", n_in, out_size, ws_size, (size_t)WS_END); grid = -1; return; }
        int dev = 0, cus = 0, per_cu = 0;
        if (hipGetDevice(&dev) != hipSuccess || hipDeviceGetAttribute(&cus, hipDeviceAttributeMultiprocessorCount, dev) != hipSuccess) { grid = -1; return; }
        if (hipFuncSetAttribute((const void*)fwd_kernel, hipFuncAttributeMaxDynamicSharedMemorySize, LDS_BYTES) != hipSuccess) { fprintf(stderr, "kernel_launch: hipFuncSetAttribute failed\n"); grid = -1; return; }
        if (hipOccupancyMaxActiveBlocksPerMultiprocessor(&per_cu, (const void*)fwd_kernel, NTHREADS, LDS_BYTES) != hipSuccess || per_cu < 1) { fprintf(stderr, "kernel_launch: occupancy query says %d blocks per CU\n", per_cu); }
        (void)hipGetLastError();
        grid = cus;
    }
    if (grid < 0) return;
    if (hipMemsetAsync((char*)d_ws + WS_CTL, 0, CTL_ZERO_BYTES, stream) != hipSuccess) return;
    Args a{};
    for (int i = 0; i < 30; ++i) a.in[i] = (const float*)d_in[i];
    a.out = (float*)d_out; a.ws = (unsigned char*)d_ws;
#if MK_ONE_LAUNCH
    a.ph_lo = 0; a.ph_hi = N_PHASES; a.use_bar = 1;
    hipLaunchKernelGGL(fwd_kernel, dim3(grid), dim3(NTHREADS), LDS_BYTES, stream, a);
#else
    for (int p = 0; p < N_PHASES; ++p) { a.ph_lo = p; a.ph_hi = p + 1; a.use_bar = 0; hipLaunchKernelGGL(fwd_kernel, dim3(grid), dim3(NTHREADS), LDS_BYTES, stream, a); }
#endif
}
```
